# Optimizing an MI355X kernel written in HIP

```python
import jax, jax.numpy as jnp
from jax import lax
import numpy as np

D_MODEL = 1024
BATCH = 16
SEQ = 2048
DEPTH = 1

CTX_LEN = 256
GRID_W = 64
NA_HEADS = 8
HEAD_DIM = 64
NA_WIDTH = NA_HEADS * HEAD_DIM
NA_WIN_ROWS = 8
NA_WIN_COLS = 16
GM_GROUPS = 8
GM_CHUNK = 128
GM_WIDTH = D_MODEL // 2
GM_GROUP_DIM = GM_WIDTH // GM_GROUPS
PEER_HEADS = 8
PEER_N_KEYS = 128
PEER_EXPERTS = PEER_N_KEYS * PEER_N_KEYS
PEER_TOPK = 16
PEER_QDIM = 256
PEER_HALF = PEER_QDIM // 2
PEER_BLOCK = 128
ADA_CHUNKS = 6
EPS = 1e-6
NEG_INF = -1e30
IN_SPLITS = (NA_WIDTH, 2 * NA_WIDTH, 3 * NA_WIDTH, 3 * NA_WIDTH + GM_WIDTH,
             3 * NA_WIDTH + 2 * GM_WIDTH, 3 * NA_WIDTH + 2 * GM_WIDTH + D_MODEL)
IN_COLS = 3 * NA_WIDTH + 2 * GM_WIDTH + 2 * D_MODEL

kernel_name = 'hybrid_natten_sgmlp_peer_block'


def rmsnorm(x, g):
    xf = x.astype(jnp.float32)
    y = xf * lax.rsqrt(jnp.mean(xf * xf, axis=-1, keepdims=True) + EPS)
    return (y * g.astype(jnp.float32)).astype(x.dtype)


def layernorm(x, g):
    xf = x.astype(jnp.float32)
    xc = xf - jnp.mean(xf, axis=-1, keepdims=True)
    y = xc * lax.rsqrt(jnp.mean(xc * xc, axis=-1, keepdims=True) + EPS)
    return (y * g.astype(jnp.float32)).astype(x.dtype)


def modulate(h, shift, scale):
    return h * (1 + scale) + shift


def heads(z):
    return z.reshape(z.shape[:-1] + (NA_HEADS, HEAD_DIM))


def neighborhood_attention(q, k, v, k_ctx, v_ctx, rpb):
    B, S = q.shape[0], q.shape[1]
    rows = S // GRID_W
    kh = min(NA_WIN_ROWS, rows)
    band = kh * GRID_W
    scale = HEAD_DIM ** -0.5
    qg = q.reshape(B, rows, GRID_W, NA_HEADS, HEAD_DIM)
    kg = k.reshape(B, rows, GRID_W, NA_HEADS, HEAD_DIM)
    vg = v.reshape(B, rows, GRID_W, NA_HEADS, HEAD_DIM)
    col = jnp.arange(GRID_W)
    col_start = jnp.clip(col - NA_WIN_COLS // 2, 0, GRID_W - NA_WIN_COLS)
    col_in = (col[None, :] >= col_start[:, None]) & (col[None, :] < col_start[:, None] + NA_WIN_COLS)
    band_mask = jnp.broadcast_to(col_in[:, None, :], (GRID_W, kh, GRID_W)).reshape(GRID_W, band)
    dc_idx = jnp.clip(col[None, :] - col[:, None] + NA_WIN_COLS - 1, 0, 2 * NA_WIN_COLS - 2)

    def row_step(r):
        rs = jnp.clip(r - NA_WIN_ROWS // 2, 0, rows - kh)
        q_r = lax.dynamic_index_in_dim(qg, r, axis=1, keepdims=False)
        k_b = lax.dynamic_slice_in_dim(kg, rs, kh, axis=1).reshape(B, band, NA_HEADS, HEAD_DIM)
        v_b = lax.dynamic_slice_in_dim(vg, rs, kh, axis=1).reshape(B, band, NA_HEADS, HEAD_DIM)
        dr_idx = rs + jnp.arange(kh) - r + NA_WIN_ROWS - 1
        bias = rpb[:, dr_idx][:, :, dc_idx]
        bias = bias.transpose(0, 2, 1, 3).reshape(NA_HEADS, GRID_W, band).astype(jnp.float32)
        s_loc = jnp.einsum('bqhd,bkhd->bhqk', q_r, k_b).astype(jnp.float32) * scale + bias
        s_loc = jnp.where(band_mask, s_loc, NEG_INF)
        s_ctx = jnp.einsum('bqhd,bchd->bhqc', q_r, k_ctx).astype(jnp.float32) * scale
        p = jax.nn.softmax(jnp.concatenate([s_loc, s_ctx], axis=-1), axis=-1).astype(v.dtype)
        return (jnp.einsum('bhqk,bkhd->bqhd', p[..., :band], v_b)
                + jnp.einsum('bhqc,bchd->bqhd', p[..., band:], v_ctx))

    o = lax.map(row_step, jnp.arange(rows))
    return jnp.moveaxis(o, 0, 1).reshape(B, S, NA_WIDTH)


def context_attention(q, k, v):
    s = jnp.einsum('bqhd,bkhd->bhqk', q, k).astype(jnp.float32) * (HEAD_DIM ** -0.5)
    p = jax.nn.softmax(s, axis=-1).astype(v.dtype)
    o = jnp.einsum('bhqk,bkhd->bqhd', p, v)
    return o.reshape(o.shape[0], o.shape[1], NA_WIDTH)


def spatial_gating(gu, gv, ln_g, ws, bs):
    B, L, _ = gv.shape
    n = L // GM_CHUNK
    u = jax.nn.gelu(gu)
    vn = layernorm(jax.nn.gelu(gv), ln_g)
    vg = vn.reshape(B, n, GM_CHUNK, GM_GROUPS, GM_GROUP_DIM)
    mixed = jnp.einsum('gpq,bnqgd->bnpgd', ws, vg) + bs.T[:, :, None]
    return u * mixed.reshape(B, L, GM_WIDTH)


def merge_branches(y_a, y_b, ga, gb, w_pa, w_pb, w_out):
    m = jax.nn.sigmoid(ga) * (y_a @ w_pa) + jax.nn.sigmoid(gb) * (y_b @ w_pb)
    return m @ w_out


def peer_ffn(h, wq, sub_keys, expert_u, expert_v):
    B, L, D = h.shape
    blocks = h.reshape(B * L // PEER_BLOCK, PEER_BLOCK, D)

    def block(xb):
        q = (xb @ wq).reshape(PEER_BLOCK, PEER_HEADS, 2, PEER_HALF)
        s = jnp.einsum('thpd,hpkd->thpk', q, sub_keys).astype(jnp.float32)
        s_top, i_top = lax.top_k(s, PEER_TOPK)
        cand_s = (s_top[:, :, 0, :, None] + s_top[:, :, 1, None, :]).reshape(PEER_BLOCK, PEER_HEADS, PEER_TOPK * PEER_TOPK)
        cand_i = (i_top[:, :, 0, :, None] * PEER_N_KEYS + i_top[:, :, 1, None, :]).reshape(PEER_BLOCK, PEER_HEADS, PEER_TOPK * PEER_TOPK)
        best_s, best_pos = lax.top_k(cand_s, PEER_TOPK)
        experts = jnp.take_along_axis(cand_i, best_pos, axis=-1)
        g = jax.nn.softmax(best_s, axis=-1)
        act = jax.nn.gelu(jnp.einsum('thkd,td->thk', expert_u[experts], xb).astype(jnp.float32))
        wgt = (g * act).astype(xb.dtype)
        return jnp.einsum('thk,thkd->td', wgt, expert_v[experts])

    return lax.map(block, blocks).reshape(B, L, D)


def setup_inputs(seed: int = 0) -> dict:
    key = jax.random.key(seed)
    ks = jax.random.split(key, 21)
    nrm = jax.random.normal
    return {
        'x': nrm(ks[0], (BATCH, SEQ, D_MODEL), jnp.float32),
        'c': nrm(ks[1], (BATCH, D_MODEL), jnp.float32),
        'ctx': nrm(ks[2], (BATCH, CTX_LEN, D_MODEL), jnp.float32),
        'c_ctx': nrm(ks[3], (D_MODEL,), jnp.float32),
        'ada_w': nrm(ks[4], (DEPTH, D_MODEL, ADA_CHUNKS * D_MODEL), jnp.float32) * (0.3 * D_MODEL ** -0.5),
        'ada_b': nrm(ks[5], (DEPTH, ADA_CHUNKS * D_MODEL), jnp.float32) * 0.02,
        'norm1_g': 1.0 + 0.01 * nrm(ks[6], (DEPTH, D_MODEL), jnp.float32),
        'norm2_g': 1.0 + 0.01 * nrm(ks[7], (DEPTH, D_MODEL), jnp.float32),
        'w_in': nrm(ks[8], (DEPTH, D_MODEL, IN_COLS), jnp.float32) * D_MODEL ** -0.5,
        'na_rpb': nrm(ks[9], (DEPTH, NA_HEADS, 2 * NA_WIN_ROWS - 1, 2 * NA_WIN_COLS - 1), jnp.float32) * 0.1,
        'gm_ln_g': 1.0 + 0.01 * nrm(ks[10], (DEPTH, GM_WIDTH), jnp.float32),
        'gm_ws': nrm(ks[11], (DEPTH, GM_GROUPS, GM_CHUNK, GM_CHUNK), jnp.float32) * GM_CHUNK ** -0.5,
        'gm_bs': 1.0 + 0.02 * nrm(ks[12], (DEPTH, GM_GROUPS, GM_CHUNK), jnp.float32),
        'w_proj_a': nrm(ks[13], (DEPTH, NA_WIDTH, D_MODEL), jnp.float32) * NA_WIDTH ** -0.5,
        'w_proj_b': nrm(ks[14], (DEPTH, GM_WIDTH, D_MODEL), jnp.float32) * GM_WIDTH ** -0.5,
        'w_out': nrm(ks[15], (DEPTH, D_MODEL, D_MODEL), jnp.float32) * D_MODEL ** -0.5,
        'peer_wq': nrm(ks[16], (DEPTH, D_MODEL, PEER_HEADS * PEER_QDIM), jnp.float32) * D_MODEL ** -0.5,
        'peer_keys': nrm(ks[17], (DEPTH, PEER_HEADS, 2, PEER_N_KEYS, PEER_HALF), jnp.float32) * PEER_HALF ** -0.5,
        'peer_u': nrm(ks[18], (DEPTH, PEER_EXPERTS, D_MODEL), jnp.float32) * D_MODEL ** -0.5,
        'peer_v': nrm(ks[19], (DEPTH, PEER_EXPERTS, D_MODEL), jnp.float32) * 0.5,
        'final_g': 1.0 + 0.01 * nrm(ks[20], (D_MODEL,), jnp.float32),
    }


def reference(x, c, ctx, c_ctx, ada_w, ada_b, norm1_g, norm2_g, w_in, na_rpb, gm_ln_g, gm_ws, gm_bs,
              w_proj_a, w_proj_b, w_out, peer_wq, peer_keys, peer_u, peer_v, final_g):
    for layer in range(DEPTH):
        last = layer == DEPTH - 1
        sh1, sc1, g1, sh2, sc2, g2 = jnp.split(
            (jax.nn.silu(c) @ ada_w[layer] + ada_b[layer])[:, None, :], ADA_CHUNKS, axis=-1)
        csh1, csc1, cg1, csh2, csc2, cg2 = jnp.split(
            jax.nn.silu(c_ctx) @ ada_w[layer] + ada_b[layer], ADA_CHUNKS, axis=-1)
        w = w_in[layer]
        h = modulate(rmsnorm(x, norm1_g[layer]), sh1, sc1)
        hc = modulate(rmsnorm(ctx, norm1_g[layer]), csh1, csc1)
        q, k, v, gu, gv, ga, gb = jnp.split(h @ w, IN_SPLITS, axis=-1)
        if last:
            k_c, v_c = jnp.split(hc @ w[:, NA_WIDTH:3 * NA_WIDTH], 2, axis=-1)
        else:
            qc, k_c, v_c, guc, gvc, gac, gbc = jnp.split(hc @ w, IN_SPLITS, axis=-1)
        y_a = neighborhood_attention(heads(q), heads(k), heads(v), heads(k_c), heads(v_c), na_rpb[layer])
        y_b = spatial_gating(gu, gv, gm_ln_g[layer], gm_ws[layer], gm_bs[layer])
        x = x + g1 * merge_branches(y_a, y_b, ga, gb, w_proj_a[layer], w_proj_b[layer], w_out[layer])
        h2 = modulate(rmsnorm(x, norm2_g[layer]), sh2, sc2)
        x = x + g2 * peer_ffn(h2, peer_wq[layer], peer_keys[layer], peer_u[layer], peer_v[layer])
        if not last:
            yc_a = context_attention(heads(qc), heads(k_c), heads(v_c))
            yc_b = spatial_gating(guc, gvc, gm_ln_g[layer], gm_ws[layer], gm_bs[layer])
            ctx = ctx + cg1 * merge_branches(yc_a, yc_b, gac, gbc, w_proj_a[layer], w_proj_b[layer], w_out[layer])
            hc2 = modulate(rmsnorm(ctx, norm2_g[layer]), csh2, csc2)
            ctx = ctx + cg2 * peer_ffn(hc2, peer_wq[layer], peer_keys[layer], peer_u[layer], peer_v[layer])
    return rmsnorm(x, final_g)
```

```cpp
#include <hip/hip_runtime.h>
#include <hip/hip_cooperative_groups.h>
#include <cstdio>
namespace cg = cooperative_groups;

#define LAS __attribute__((address_space(3)))
typedef _Float16 h16;
typedef _Float16 h16x2 __attribute__((ext_vector_type(2)));
typedef _Float16 h16x4 __attribute__((ext_vector_type(4)));
typedef _Float16 h16x8 __attribute__((ext_vector_type(8)));
typedef float f32x4 __attribute__((ext_vector_type(4)));
typedef float f32x2 __attribute__((ext_vector_type(2)));
typedef int i32x4 __attribute__((ext_vector_type(4)));
typedef int i32x2 __attribute__((ext_vector_type(2)));

constexpr int NTOK = 32768, DM = 1024, NCTXT = 4096, INC = 4608, SEQ = 2048, CTXL = 256;
constexpr int LDS_BYTES = 144 * 1024;
#ifndef REP_SEL
#define REP_SEL 1
#endif
#ifndef REP_GATH
#define REP_GATH 1
#endif
#ifndef REP_P3
#define REP_P3 1
#endif

constexpr size_t al256(size_t x) { return (x + 255) & ~(size_t)255; }
constexpr size_t OFF_WINT = 0;
constexpr size_t OFF_WPAT = OFF_WINT + (size_t)INC * DM * 2;
constexpr size_t OFF_WPBT = OFF_WPAT + (size_t)1024 * 512 * 2;
constexpr size_t OFF_WOUTT = OFF_WPBT + (size_t)1024 * 512 * 2;
constexpr size_t OFF_WQT = OFF_WOUTT + (size_t)1024 * 1024 * 2;
constexpr size_t OFF_BD = OFF_WQT + (size_t)2048 * 1024 * 2;
constexpr size_t OFF_U16 = OFF_BD + (size_t)2048 * 256 * 2;
constexpr size_t OFF_V16 = OFF_U16 + (size_t)16384 * 1024 * 2;
constexpr size_t OFF_WS16 = OFF_V16 + (size_t)16384 * 1024 * 2;
constexpr size_t OFF_MODP = OFF_WS16 + (size_t)8 * 128 * 128 * 2;
constexpr size_t OFF_MOD = OFF_MODP + (size_t)16 * 17 * 6144 * 4;
constexpr size_t OFF_R1 = al256(OFF_MOD + (size_t)17 * 6144 * 4);
constexpr size_t OFF_QB = OFF_R1 + (size_t)NTOK * DM * 2;
constexpr size_t OFF_KB = OFF_QB + (size_t)NTOK * 512 * 2;
constexpr size_t OFF_VT = OFF_KB + (size_t)NTOK * 512 * 2;
constexpr size_t OFF_GUV = OFF_VT + (size_t)NTOK * 512 * 2;
constexpr size_t OFF_GATES = OFF_GUV + (size_t)NTOK * 1024 * 2;
constexpr size_t OFF_MM = OFF_GATES + (size_t)NTOK * 2048 * 2;
constexpr size_t OFF_BAR = OFF_MM + (size_t)NTOK * DM * 2;
constexpr size_t WS_END = OFF_BAR + 256;
constexpr size_t OFF_U8 = OFF_U16;
constexpr size_t OFF_USC = OFF_U16 + (size_t)16384 * 1024;
constexpr size_t OFF_V8 = OFF_V16;
constexpr size_t OFF_VSC = OFF_V16 + (size_t)16384 * 1024;
constexpr size_t OFF_M1 = OFF_QB;
constexpr size_t OFF_SC16 = OFF_QB;
constexpr size_t OFF_Q16 = OFF_GATES;
constexpr size_t OFF_HC = OFF_MM;
constexpr size_t OFF_KC = OFF_HC + (size_t)NCTXT * DM * 2;
constexpr size_t OFF_VCT = OFF_KC + (size_t)NCTXT * 512 * 2;
static_assert(OFF_M1 + (size_t)NTOK * DM * 4 <= OFF_GATES, "m1 alias");
static_assert(WS_END <= (size_t)512 * 1024 * 1024, "workspace");

struct Params {
    const float* in[21];
    float* out;
    unsigned char* ws;
};
enum { I_X = 0, I_C, I_CTX, I_CCTX, I_ADAW, I_ADAB, I_N1G, I_N2G, I_WIN, I_RPB, I_LNG, I_GMWS, I_GMBS, I_WPA, I_WPB, I_WOUT, I_WQ, I_KEYS, I_PU, I_PV, I_FG };

__device__ __forceinline__ int launder(int x) { asm volatile("" : "+v"(x)); return x; }
__device__ __forceinline__ int fresh_tid() { int t = threadIdx.x; asm volatile("" : "+v"(t)); return t; }

__device__ __forceinline__ float sigmoidf_(float x) { return __builtin_amdgcn_rcpf(1.0f + __expf(-x)); }
__device__ __forceinline__ float gelu_tanh(float x) {
    const float t = 0.7978845608028654f * (x + 0.044715f * x * x * x);
    return x * __builtin_amdgcn_rcpf(1.0f + __expf(-2.0f * t));
}
__device__ __forceinline__ float silu_(float x) { return x * __builtin_amdgcn_rcpf(1.0f + __expf(-x)); }
__device__ __forceinline__ float wave_sum(float v) {
#pragma unroll
    for (int o = 32; o > 0; o >>= 1) v += __shfl_xor(v, o);
    return v;
}
__device__ __forceinline__ h16x8 pack8(f32x4 a, f32x4 b) {
    h16x8 o;
    o[0] = (h16)a[0]; o[1] = (h16)a[1]; o[2] = (h16)a[2]; o[3] = (h16)a[3];
    o[4] = (h16)b[0]; o[5] = (h16)b[1]; o[6] = (h16)b[2]; o[7] = (h16)b[3];
    return o;
}


__device__ __forceinline__ void grid_bar(unsigned* ctr, unsigned& epoch, unsigned nblk) {
    __syncthreads();
    epoch += 1u;
    if (threadIdx.x == 0) {
        __builtin_amdgcn_fence(__ATOMIC_RELEASE, "agent");
        asm volatile("s_waitcnt vmcnt(0)" ::: "memory");
        __hip_atomic_fetch_add(ctr, 1u, __ATOMIC_RELAXED, __HIP_MEMORY_SCOPE_AGENT);
        const unsigned target = epoch * nblk;
        unsigned spins = 0;
        while (__hip_atomic_load(ctr, __ATOMIC_RELAXED, __HIP_MEMORY_SCOPE_AGENT) < target) { __builtin_amdgcn_s_sleep(2); if (++spins > (1u << 24)) break; }
        __builtin_amdgcn_fence(__ATOMIC_ACQUIRE, "agent");
        asm volatile("s_waitcnt vmcnt(0)" ::: "memory");
    }
    __syncthreads();
}

namespace pg8 {
constexpr int BM = 256, BK = 64, HALF = 128, HTB = HALF * BK * 2, STAGE_BYTES = 8 * HTB, NXCD = 8, WGM = 8;
__device__ __forceinline__ int lds_byte(int r, int c) { const int st = (r >> 4) * 2 + (c >> 5), rr = r & 15, cc = c & 31, ob = rr * 64 + cc * 2; return st * 1024 + (ob ^ (((ob >> 9) & 1) << 5)); }
__device__ __forceinline__ void stage_rc(int b, int& R, int& C) { const int st = b / 1024, sb = b % 1024, swz = sb ^ (((sb >> 9) & 1) << 5); R = (st >> 1) * 16 + swz / 64; C = (st & 1) * 32 + (swz % 64) / 2; }
__device__ __forceinline__ int perm32(int rho) { const int n = rho >> 4, i = rho & 15; return 8 * (i >> 2) + 4 * n + (i & 3); }

struct Unit { int pm, pn; };
struct Gemm { const void* A; const void* Bt; int lda, ldb, M, N, K, a_pn_bytes; };

struct StaticOrder {
    int nM, nN, nwg, G, c;
    __device__ void init(int M, int N, int G_, int c_) { nM = M / BM; nN = N / BM; nwg = nM * nN; G = G_; c = c_; }
    __device__ bool next(int i, Unit& u) const {
        const long L = (long)i * G + c; if (L >= nwg) return false;
        int wgid = (int)L; { const int q = nwg / NXCD, r = nwg % NXCD, xcd = wgid % NXCD, off = wgid / NXCD; wgid = (xcd < r ? xcd * (q + 1) : r * (q + 1) + (xcd - r) * q) + off; }
        const int nig = WGM * nN, gid = wgid / nig, fm = gid * WGM, gsz = (nM - fm) < WGM ? (nM - fm) : WGM;
        u.pm = fm + ((wgid % nig) % gsz); u.pn = (wgid % nig) / gsz; return true;
    }
};

template <class Epi>
__device__ __forceinline__ void gemm_phase(LAS unsigned char* lds, const Gemm g, const StaticOrder& S, const Epi& E) {
    const int tid = fresh_tid(), wid = __builtin_amdgcn_readfirstlane(tid >> 6), lane = tid & 63, wr = wid >> 2, wc = wid & 3, fr = lane & 15, fq = lane >> 4;
    const int K = g.K, nt = K / BK;
    unsigned voffA[2], voffB[2];
#pragma unroll
    for (int i = 0; i < 2; ++i) { int R, C; stage_rc(tid * 16 + i * 8192, R, C); const int Rb = (R & ~31) + perm32(R & 31);
        voffA[i] = (unsigned)(R * g.lda + C) * 2u; voffB[i] = (unsigned)(Rb * g.ldb + C) * 2u; }
    const size_t kstep = (size_t)(BK * 2);
    const size_t hstepA = (size_t)HALF * g.lda * 2, hstepB = (size_t)HALF * g.ldb * 2;
    const size_t tstepA = 2 * hstepA, tstepB = 2 * hstepB;
    const unsigned ldsw = (unsigned)wid * 1024u;
    const int aoff = lds_byte(wr * 64 + fr, fq * 8), boff = lds_byte(wc * 32 + fr, fq * 8);
#define PG8_SA(b, h) (((b) * 2 + (h)) * HTB)
#define PG8_SB(b, h) ((4 + (b) * 2 + (h)) * HTB)
#define PG8_STAGE(bufoff, gbase, voff) do { _Pragma("unroll") for (int _i = 0; _i < 2; ++_i) \
        __builtin_amdgcn_global_load_lds((const unsigned*)((const char*)(gbase) + (voff)[_i]), (LAS unsigned*)(lds + (bufoff) + ldsw + _i * 8192), 16, 0, 0); } while (0)
#define PG8_LDA(dst, b, h) do { _Pragma("unroll") for (int m = 0; m < 4; ++m) _Pragma("unroll") for (int k = 0; k < 2; ++k) dst[m][k] = *(const LAS h16x8*)(lds + PG8_SA(b, h) + aoff + m * 2048 + k * 1024); } while (0)
#define PG8_LDB(dst, b, h) do { _Pragma("unroll") for (int n = 0; n < 2; ++n) _Pragma("unroll") for (int k = 0; k < 2; ++k) dst[n][k] = *(const LAS h16x8*)(lds + PG8_SB(b, h) + boff + n * 2048 + k * 1024); } while (0)
#define PG8_MMA(ai, bj, At, Bt) do { __builtin_amdgcn_s_setprio(1); _Pragma("unroll") for (int m = 0; m < 4; ++m) _Pragma("unroll") for (int n = 0; n < 2; ++n) _Pragma("unroll") for (int k = 0; k < 2; ++k) \
        acc[ai][bj][m][n] = __builtin_amdgcn_mfma_f32_16x16x32_f16(Bt[n][k], At[m][k], acc[ai][bj][m][n], 0, 0, 0); __builtin_amdgcn_s_setprio(0); } while (0)
#define PG8_WAIT_V(n) asm volatile("s_waitcnt vmcnt(" #n ")" ::: "memory")
#define PG8_WAIT_L(n) asm volatile("s_waitcnt lgkmcnt(" #n ")" ::: "memory")
#define PG8_BAR __builtin_amdgcn_s_barrier()
#define PG8_SCHED __builtin_amdgcn_sched_barrier(0)
    Unit cur, nxt; int ui = 0;
    if (!S.next(0, cur)) return;
    f32x4 acc[2][2][4][2];
#pragma unroll
    for (int a = 0; a < 2; ++a)
#pragma unroll
        for (int b = 0; b < 2; ++b)
#pragma unroll
            for (int m = 0; m < 4; ++m)
#pragma unroll
                for (int n = 0; n < 2; ++n) acc[a][b][m][n] = (f32x4){0.f, 0.f, 0.f, 0.f};
    h16x8 At[4][2], B0[2][2], B1[2][2];
    const char* cA = (const char*)g.A + (size_t)cur.pm * tstepA + (size_t)cur.pn * g.a_pn_bytes; const char* cB = (const char*)g.Bt + (size_t)cur.pn * tstepB;
    PG8_STAGE(PG8_SB(0, 0), cB, voffB); PG8_STAGE(PG8_SA(0, 0), cA, voffA); PG8_STAGE(PG8_SB(0, 1), cB + hstepB, voffB); PG8_STAGE(PG8_SA(0, 1), cA + hstepA, voffA);
    if (wr == 1) PG8_BAR;
    PG8_WAIT_V(4); PG8_BAR;
    PG8_STAGE(PG8_SB(1, 0), cB + kstep, voffB); PG8_STAGE(PG8_SA(1, 0), cA + kstep, voffA); PG8_STAGE(PG8_SB(1, 1), cB + hstepB + kstep, voffB);
    PG8_WAIT_V(6); PG8_BAR;
    for (;;) {
        const bool has_next = S.next(ui + 1, nxt);
        const char* nA = has_next ? (const char*)g.A + (size_t)nxt.pm * tstepA + (size_t)nxt.pn * g.a_pn_bytes : cA; const char* nB = has_next ? (const char*)g.Bt + (size_t)nxt.pn * tstepB : cB;
        for (int t = 0; t < nt; t += 2) {
            const bool last = (t == nt - 2);
            const char* a1 = cA + (size_t)(t + 1) * kstep;
            const char* a2 = last ? nA : cA + (size_t)(t + 2) * kstep; const char* b2 = last ? nB : cB + (size_t)(t + 2) * kstep;
            const char* a3 = a2 + kstep; const char* b3 = b2 + kstep;
            PG8_LDB(B0, 0, 0); PG8_SCHED; PG8_LDA(At, 0, 0); PG8_STAGE(PG8_SA(1, 1), a1 + hstepA, voffA);
            PG8_WAIT_L(8); PG8_BAR; PG8_WAIT_L(0); PG8_MMA(0, 0, At, B0); PG8_BAR; PG8_SCHED;
            PG8_LDB(B1, 0, 1); PG8_STAGE(PG8_SB(0, 0), b2, voffB);
            PG8_BAR; PG8_WAIT_L(0); PG8_MMA(0, 1, At, B1); PG8_BAR;
            PG8_LDA(At, 0, 1); PG8_STAGE(PG8_SA(0, 0), a2, voffA);
            PG8_BAR; PG8_WAIT_L(0); PG8_MMA(1, 0, At, B0); PG8_BAR; PG8_SCHED;
            PG8_STAGE(PG8_SB(0, 1), b2 + hstepB, voffB);
            PG8_WAIT_V(6); PG8_BAR; PG8_MMA(1, 1, At, B1); PG8_BAR;
            PG8_LDB(B0, 1, 0); PG8_SCHED; PG8_LDA(At, 1, 0); PG8_STAGE(PG8_SA(0, 1), a2 + hstepA, voffA);
            PG8_WAIT_L(8); PG8_BAR; PG8_WAIT_L(0); PG8_MMA(0, 0, At, B0); PG8_BAR; PG8_SCHED;
            PG8_LDB(B1, 1, 1); PG8_STAGE(PG8_SB(1, 0), b3, voffB);
            PG8_BAR; PG8_WAIT_L(0); PG8_MMA(0, 1, At, B1); PG8_BAR;
            PG8_LDA(At, 1, 1); PG8_STAGE(PG8_SA(1, 0), a3, voffA);
            PG8_BAR; PG8_WAIT_L(0); PG8_MMA(1, 0, At, B0); PG8_BAR; PG8_SCHED;
            PG8_STAGE(PG8_SB(1, 1), b3 + hstepB, voffB);
            PG8_WAIT_V(6); PG8_BAR; PG8_MMA(1, 1, At, B1); PG8_BAR;
        }
        E(acc, cur, wr, wc, fr, fq);
        if (!has_next) break;
#pragma unroll
        for (int a = 0; a < 2; ++a)
#pragma unroll
            for (int b = 0; b < 2; ++b)
#pragma unroll
                for (int m = 0; m < 4; ++m)
#pragma unroll
                    for (int n = 0; n < 2; ++n) acc[a][b][m][n] = (f32x4){0.f, 0.f, 0.f, 0.f};
        cur = nxt; cA = nA; cB = nB; ++ui;
    }
    PG8_WAIT_V(0);
    if (wr == 0) PG8_BAR;
    PG8_BAR;
#undef PG8_SA
#undef PG8_SB
#undef PG8_STAGE
#undef PG8_LDA
#undef PG8_LDB
#undef PG8_MMA
#undef PG8_WAIT_V
#undef PG8_WAIT_L
#undef PG8_BAR
#undef PG8_SCHED
}
}
typedef f32x4 AccT[2][2][4][2];

struct EpiIn {
    h16 *qb, *kb, *vt, *guv, *gates;
    __device__ __forceinline__ void operator()(const AccT& acc, const pg8::Unit& u, int wr, int wc, int fr, int fq) const {
        const int pn = u.pn;
        const int row0 = u.pm * 256 + wr * 64 + fr;
        const int cin = wc * 32 + 8 * fq;
        const int b = (u.pm * 256) >> 11, sb = ((u.pm * 256) & 2047) + wr * 64;
        if (pn < 2) {
            h16* base = qb + (size_t)row0 * 512 + pn * 256 + cin;
#pragma unroll
            for (int ai = 0; ai < 2; ++ai)
#pragma unroll
                for (int m = 0; m < 4; ++m)
#pragma unroll
                    for (int bj = 0; bj < 2; ++bj) *(h16x8*)(base + (ai * 128 + m * 16) * 512 + bj * 128) = pack8(acc[ai][bj][m][0], acc[ai][bj][m][1]);
        } else if (pn < 4) {
#pragma unroll
            for (int bj = 0; bj < 2; ++bj) {
                const int col = (pn & 1) * 256 + bj * 128 + cin, hd = col >> 6, d0 = col & 63;
                h16* base = kb + ((size_t)(b * 8 + hd) * 2048 + sb + fr) * 64 + d0;
#pragma unroll
                for (int ai = 0; ai < 2; ++ai)
#pragma unroll
                    for (int m = 0; m < 4; ++m) *(h16x8*)(base + (ai * 128 + m * 16) * 64) = pack8(acc[ai][bj][m][0], acc[ai][bj][m][1]);
            }
        } else if (pn < 6) {
#pragma unroll
            for (int bj = 0; bj < 2; ++bj) {
                const int cv = (pn - 4) * 256 + bj * 128 + cin, hd = cv >> 6, d0 = cv & 63;
                h16* base = vt + ((size_t)(b * 8 + hd) * 256 + (sb >> 3) + (fr >> 3)) * 512 + d0 * 8 + (fr & 7);
#pragma unroll
                for (int ai = 0; ai < 2; ++ai)
#pragma unroll
                    for (int m = 0; m < 4; ++m) {
                        h16* vp = base + (ai * 16 + m * 2) * 512;
                        const f32x4 v0 = acc[ai][bj][m][0], v1 = acc[ai][bj][m][1];
#pragma unroll
                        for (int i = 0; i < 4; ++i) { vp[i * 8] = (h16)v0[i]; vp[(i + 4) * 8] = (h16)v1[i]; }
                    }
            }
        } else if (pn < 10) {
            h16* base = guv + (size_t)row0 * 1024 + (pn - 6) * 256 + cin;
#pragma unroll
            for (int ai = 0; ai < 2; ++ai)
#pragma unroll
                for (int m = 0; m < 4; ++m)
#pragma unroll
                    for (int bj = 0; bj < 2; ++bj) {
                        f32x4 v0 = acc[ai][bj][m][0], v1 = acc[ai][bj][m][1];
#pragma unroll
                        for (int i = 0; i < 4; ++i) { v0[i] = gelu_tanh(v0[i]); v1[i] = gelu_tanh(v1[i]); }
                        *(h16x8*)(base + (ai * 128 + m * 16) * 1024 + bj * 128) = pack8(v0, v1);
                    }
        } else {
            h16* base = gates + (size_t)row0 * 2048 + (pn - 10) * 256 + cin;
#pragma unroll
            for (int ai = 0; ai < 2; ++ai)
#pragma unroll
                for (int m = 0; m < 4; ++m)
#pragma unroll
                    for (int bj = 0; bj < 2; ++bj) {
                        f32x4 v0 = acc[ai][bj][m][0], v1 = acc[ai][bj][m][1];
#pragma unroll
                        for (int i = 0; i < 4; ++i) { v0[i] = sigmoidf_(v0[i]); v1[i] = sigmoidf_(v1[i]); }
                        *(h16x8*)(base + (ai * 128 + m * 16) * 2048 + bj * 128) = pack8(v0, v1);
                    }
        }
    }
};
struct EpiCtx {
    h16 *kc, *vct;
    __device__ __forceinline__ void operator()(const AccT& acc, const pg8::Unit& u, int wr, int wc, int fr, int fq) const {
        const int pn = u.pn;
        const int cin = wc * 32 + 8 * fq;
        const int b = u.pm, sb = wr * 64;
        if (pn < 2) {
#pragma unroll
            for (int bj = 0; bj < 2; ++bj) {
                const int col = pn * 256 + bj * 128 + cin, hd = col >> 6, d0 = col & 63;
                h16* base = kc + ((size_t)(b * 8 + hd) * 256 + sb + fr) * 64 + d0;
#pragma unroll
                for (int ai = 0; ai < 2; ++ai)
#pragma unroll
                    for (int m = 0; m < 4; ++m) *(h16x8*)(base + (ai * 128 + m * 16) * 64) = pack8(acc[ai][bj][m][0], acc[ai][bj][m][1]);
            }
        } else {
#pragma unroll
            for (int bj = 0; bj < 2; ++bj) {
                const int cv = (pn - 2) * 256 + bj * 128 + cin, hd = cv >> 6, d0 = cv & 63;
                h16* base = vct + ((size_t)(b * 8 + hd) * 32 + (sb >> 3) + (fr >> 3)) * 512 + d0 * 8 + (fr & 7);
#pragma unroll
                for (int ai = 0; ai < 2; ++ai)
#pragma unroll
                    for (int m = 0; m < 4; ++m) {
                        h16* vp = base + (ai * 16 + m * 2) * 512;
                        const f32x4 v0 = acc[ai][bj][m][0], v1 = acc[ai][bj][m][1];
#pragma unroll
                        for (int i = 0; i < 4; ++i) { vp[i * 8] = (h16)v0[i]; vp[(i + 4) * 8] = (h16)v1[i]; }
                    }
            }
        }
    }
};
struct EpiM1 {
    h16* m1; const h16* gates;
    __device__ __forceinline__ void operator()(const AccT& acc, const pg8::Unit& u, int wr, int wc, int fr, int fq) const {
        const int row0 = u.pm * 256 + wr * 64 + fr, col0 = u.pn * 256 + wc * 32 + 8 * fq;
#pragma unroll
        for (int ai = 0; ai < 2; ++ai)
#pragma unroll
            for (int m = 0; m < 4; ++m) {
                const int row = row0 + ai * 128 + m * 16;
#pragma unroll
                for (int bj = 0; bj < 2; ++bj) {
                    const int col = col0 + bj * 128;
                    const h16x8 gt = *(const h16x8*)(gates + (size_t)row * 2048 + col);
                    f32x4 v0 = acc[ai][bj][m][0], v1 = acc[ai][bj][m][1];
#pragma unroll
                    for (int i = 0; i < 4; ++i) { v0[i] *= (float)gt[i]; v1[i] *= (float)gt[4 + i]; }
                    *(h16x8*)(m1 + (size_t)row * 1024 + col) = pack8(v0, v1);
                }
            }
    }
};
struct EpiM2 {
    const h16* m1; const h16* gates; h16* mm;
    __device__ __forceinline__ void operator()(const AccT& acc, const pg8::Unit& u, int wr, int wc, int fr, int fq) const {
        const int row0 = u.pm * 256 + wr * 64 + fr, col0 = u.pn * 256 + wc * 32 + 8 * fq;
#pragma unroll
        for (int ai = 0; ai < 2; ++ai)
#pragma unroll
            for (int m = 0; m < 4; ++m) {
                const int row = row0 + ai * 128 + m * 16;
#pragma unroll
                for (int bj = 0; bj < 2; ++bj) {
                    const int col = col0 + bj * 128;
                    const h16x8 gt = *(const h16x8*)(gates + (size_t)row * 2048 + 1024 + col);
                    const h16x8 mi = *(const h16x8*)(m1 + (size_t)row * 1024 + col);
                    f32x4 p0 = (f32x4){(float)mi[0], (float)mi[1], (float)mi[2], (float)mi[3]}, p1 = (f32x4){(float)mi[4], (float)mi[5], (float)mi[6], (float)mi[7]};
                    const f32x4 v0 = acc[ai][bj][m][0], v1 = acc[ai][bj][m][1];
#pragma unroll
                    for (int i = 0; i < 4; ++i) { p0[i] += v0[i] * (float)gt[i]; p1[i] += v1[i] * (float)gt[4 + i]; }
                    *(h16x8*)(mm + (size_t)row * 1024 + col) = pack8(p0, p1);
                }
            }
    }
};
struct EpiX1 {
    const float* x; const float* mod; float* x1;
    __device__ __forceinline__ void operator()(const AccT& acc, const pg8::Unit& u, int wr, int wc, int fr, int fq) const {
        const int row0 = u.pm * 256 + wr * 64 + fr, col0 = u.pn * 256 + wc * 32 + 8 * fq;
        const int b = (u.pm * 256) >> 11;
#pragma unroll
        for (int bj = 0; bj < 2; ++bj) {
            const int col = col0 + bj * 128;
            const float* gp = mod + (size_t)b * 6144 + 2 * 1024 + col;
            const f32x4 g0 = *(const f32x4*)gp, g1 = *(const f32x4*)(gp + 4);
#pragma unroll
            for (int ai = 0; ai < 2; ++ai)
#pragma unroll
                for (int m = 0; m < 4; ++m) {
                    const int row = row0 + ai * 128 + m * 16;
                    const float* xi = x + (size_t)row * 1024 + col;
                    const f32x4 x0 = *(const f32x4*)xi, x1v = *(const f32x4*)(xi + 4);
                    float* o = x1 + (size_t)row * 1024 + col;
                    *(f32x4*)o = x0 + g0 * acc[ai][bj][m][0]; *(f32x4*)(o + 4) = x1v + g1 * acc[ai][bj][m][1];
                }
        }
    }
};
struct EpiH16 {
    h16* o; int ldc;
    __device__ __forceinline__ void operator()(const AccT& acc, const pg8::Unit& u, int wr, int wc, int fr, int fq) const {
        const int row0 = u.pm * 256 + wr * 64 + fr, col0 = u.pn * 256 + wc * 32 + 8 * fq;
#pragma unroll
        for (int ai = 0; ai < 2; ++ai)
#pragma unroll
            for (int m = 0; m < 4; ++m) {
                const int row = row0 + ai * 128 + m * 16;
#pragma unroll
                for (int bj = 0; bj < 2; ++bj)
                    *(h16x8*)(o + (size_t)row * ldc + col0 + bj * 128) = pack8(acc[ai][bj][m][0], acc[ai][bj][m][1]);
            }
    }
};

__device__ __forceinline__ void cvt_tile(const float* __restrict__ src, h16* __restrict__ dst, int tile) {
    const size_t i = (size_t)tile * 4096 + threadIdx.x * 8;
    const f32x4 a = *(const f32x4*)(src + i), b = *(const f32x4*)(src + i + 4);
    *(h16x8*)(dst + i) = pack8(a, b);
}
__device__ __forceinline__ void tr_tile(const float* __restrict__ src, h16* __restrict__ dst, int K, int N, int tile, float* lds) {
    const int ntn = N / 64, tk = tile / ntn, tn = tile % ntn, tid = threadIdx.x;
#pragma unroll
    for (int ps = 0; ps < 2; ++ps) {
        const int k = ps * 32 + (tid >> 4), n = (tid & 15) * 4;
        const f32x4 v = *(const f32x4*)(src + (size_t)(tk * 64 + k) * N + tn * 64 + n);
        lds[k * 65 + n] = v[0]; lds[k * 65 + n + 1] = v[1]; lds[k * 65 + n + 2] = v[2]; lds[k * 65 + n + 3] = v[3];
    }
    __syncthreads();
    {
        const int n = tid >> 3, ks = (tid & 7) * 8;
        h16x8 o;
#pragma unroll
        for (int i = 0; i < 8; ++i) o[i] = (h16)lds[(ks + i) * 65 + n];
        *(h16x8*)(dst + (size_t)(tn * 64 + n) * K + tk * 64 + ks) = o;
    }
    __syncthreads();
}
__device__ __forceinline__ void cvt8_rows(const float* __restrict__ src, unsigned char* __restrict__ dst, float* __restrict__ inv, int tile) {
    const int wid = threadIdx.x >> 6, lane = threadIdx.x & 63;
    const size_t row = (size_t)tile * 8 + wid;
    const float* r = src + row * 1024 + lane * 16;
    f32x4 a[4]; float mx = 0.f;
#pragma unroll
    for (int i = 0; i < 4; ++i) { a[i] = *(const f32x4*)(r + 4 * i); mx = fmaxf(mx, fmaxf(fmaxf(fabsf(a[i][0]), fabsf(a[i][1])), fmaxf(fabsf(a[i][2]), fabsf(a[i][3])))); }
#pragma unroll
    for (int o = 32; o > 0; o >>= 1) mx = fmaxf(mx, __shfl_xor(mx, o));
    int ex2 = 0; float sc = 1.0f;
    if (mx > 0.f) { (void)frexpf(mx, &ex2); int k = 8 - ex2; k = k > 100 ? 100 : (k < -100 ? -100 : k); sc = ldexpf(1.0f, k); }
    i32x4 w;
#pragma unroll
    for (int i = 0; i < 4; ++i) {
        int pk = __builtin_amdgcn_cvt_pk_fp8_f32(a[i][0] * sc, a[i][1] * sc, 0, false);
        pk = __builtin_amdgcn_cvt_pk_fp8_f32(a[i][2] * sc, a[i][3] * sc, pk, true);
        w[i] = pk;
    }
    *(i32x4*)(dst + row * 1024 + lane * 16) = w;
    if (lane == 0) inv[2 * row] = 1.0f / sc;
}
__device__ __forceinline__ void cvt4_rows(const float* __restrict__ src, unsigned char* __restrict__ dst, float* __restrict__ inv, int tile) {
    const int wid = threadIdx.x >> 6, lane = threadIdx.x & 63;
    const size_t row = (size_t)tile * 8 + wid;
    const float* r = src + row * 1024 + lane * 16;
    f32x4 a[4]; float mx = 0.f;
#pragma unroll
    for (int i = 0; i < 4; ++i) { a[i] = *(const f32x4*)(r + 4 * i); mx = fmaxf(mx, fmaxf(fmaxf(fabsf(a[i][0]), fabsf(a[i][1])), fmaxf(fabsf(a[i][2]), fabsf(a[i][3])))); }
#pragma unroll
    for (int o = 32; o > 0; o >>= 1) mx = fmaxf(mx, __shfl_xor(mx, o));
    const float sc = (mx > 1e-30f) ? 6.0f / mx : 1.0f;
    int w0 = 0, w1 = 0;
    w0 = __builtin_amdgcn_cvt_scalef32_pk_fp4_f32(w0, a[0][0] * sc, a[0][1] * sc, 1.0f, 0);
    w0 = __builtin_amdgcn_cvt_scalef32_pk_fp4_f32(w0, a[0][2] * sc, a[0][3] * sc, 1.0f, 1);
    w0 = __builtin_amdgcn_cvt_scalef32_pk_fp4_f32(w0, a[1][0] * sc, a[1][1] * sc, 1.0f, 2);
    w0 = __builtin_amdgcn_cvt_scalef32_pk_fp4_f32(w0, a[1][2] * sc, a[1][3] * sc, 1.0f, 3);
    w1 = __builtin_amdgcn_cvt_scalef32_pk_fp4_f32(w1, a[2][0] * sc, a[2][1] * sc, 1.0f, 0);
    w1 = __builtin_amdgcn_cvt_scalef32_pk_fp4_f32(w1, a[2][2] * sc, a[2][3] * sc, 1.0f, 1);
    w1 = __builtin_amdgcn_cvt_scalef32_pk_fp4_f32(w1, a[3][0] * sc, a[3][1] * sc, 1.0f, 2);
    w1 = __builtin_amdgcn_cvt_scalef32_pk_fp4_f32(w1, a[3][2] * sc, a[3][3] * sc, 1.0f, 3);
    *(i32x2*)(dst + row * 512 + lane * 8) = (i32x2){w0, w1};
    if (lane == 0) inv[2 * row] = 1.0f / sc;
}
__device__ __forceinline__ void wqk_tile(const float* __restrict__ wq, const float* __restrict__ keys, h16* __restrict__ wt, int tile, float* lds) {
    const int ct = tile >> 4, hp = tile & 15, tid = threadIdx.x;
    float* sA = lds;
    float* sB = lds + 64 * 129;
#pragma unroll
    for (int i = 0; i < 4; ++i) {
        const int e = (i * 512 + tid) * 4, r = e >> 7, d = e & 127;
        const f32x4 v = *(const f32x4*)(wq + (size_t)(ct * 64 + r) * 2048 + hp * 128 + d);
        sA[r * 129 + d] = v[0]; sA[r * 129 + d + 1] = v[1]; sA[r * 129 + d + 2] = v[2]; sA[r * 129 + d + 3] = v[3];
    }
#pragma unroll
    for (int i = 0; i < 8; ++i) {
        const int e = (i * 512 + tid) * 4, k = e >> 7, d = e & 127;
        const f32x4 v = *(const f32x4*)(keys + (size_t)(hp * 128 + k) * 128 + d);
        sB[k * 129 + d] = v[0]; sB[k * 129 + d + 1] = v[1]; sB[k * 129 + d + 2] = v[2]; sB[k * 129 + d + 3] = v[3];
    }
    __syncthreads();
    const int c = tid >> 3, kg = (tid & 7) * 16;
    float acc[16];
#pragma unroll
    for (int j = 0; j < 16; ++j) acc[j] = 0.f;
#pragma unroll 4
    for (int d = 0; d < 128; ++d) {
        const float a = sA[c * 129 + d];
#pragma unroll
        for (int j = 0; j < 16; ++j) acc[j] += a * sB[(kg + j) * 129 + d];
    }
#pragma unroll
    for (int j = 0; j < 16; ++j) wt[(size_t)(hp * 128 + kg + j) * 1024 + ct * 64 + c] = (h16)acc[j];
    __syncthreads();
}
__device__ void phase0(const Params& p, float* lds) {
    unsigned char* ws = p.ws;
    const int tid = threadIdx.x, wid = tid >> 6, lane = tid & 63;
    for (int ib = blockIdx.x; ib < 256; ib += gridDim.x) {
        if (wid < 6) {
            const int item = ib * 6 + wid, cg64 = item % 96, kc = item / 96;
            const int col = cg64 * 64 + lane, k0 = kc * 64;
            float sv[17], acc[17];
#pragma unroll
            for (int b = 0; b < 17; ++b) {
                const float cv = (b < 16) ? p.in[I_C][b * 1024 + k0 + lane] : p.in[I_CCTX][k0 + lane];
                sv[b] = silu_(cv); acc[b] = 0.f;
            }
            const float* wp = p.in[I_ADAW] + (size_t)k0 * 6144 + col;
            for (int j = 0; j < 64; ++j) {
                const float w = wp[(size_t)j * 6144];
#pragma unroll
                for (int b = 0; b < 17; ++b) acc[b] += __builtin_bit_cast(float, __builtin_amdgcn_readlane(__builtin_bit_cast(int, sv[b]), j)) * w;
            }
            float* mp = (float*)(ws + OFF_MODP);
#pragma unroll
            for (int b = 0; b < 17; ++b) mp[((size_t)kc * 17 + b) * 6144 + col] = acc[b];
        }
    }
    constexpr int T0 = 2048, T1 = T0 + 2048, T2 = T1 + 32, T3 = T2, T4 = T3 + 1152, T5 = T4 + 128, T6 = T5 + 128, T7 = T6 + 256, T8 = T7 + 256;
    for (int t = blockIdx.x; t < T8; t += gridDim.x) {
        if (t < T0) cvt8_rows(p.in[I_PU], ws + OFF_U8, (float*)(ws + OFF_USC), t);
        else if (t < T1) cvt8_rows(p.in[I_PV], ws + OFF_V8, (float*)(ws + OFF_USC) + 1, t - T0);
        else if (t < T2) cvt_tile(p.in[I_GMWS], (h16*)(ws + OFF_WS16), t - T1);
        else if (t < T3) {
            const int e = (t - T2) * 4096 + tid * 8;
            const int row = e >> 8, cc = e & 255, h = row >> 8, pp = (row >> 7) & 1, k = row & 127, pq = cc >> 7, d = cc & 127;
            h16x8 o = {0, 0, 0, 0, 0, 0, 0, 0};
            if (pp == pq) {
                const float* kp = p.in[I_KEYS] + ((size_t)((h * 2 + pp) * 128 + k)) * 128 + d;
                o = pack8(*(const f32x4*)kp, *(const f32x4*)(kp + 4));
            }
            *(h16x8*)((h16*)(ws + OFF_BD) + e) = o;
        }
        else if (t < T4) tr_tile(p.in[I_WIN], (h16*)(ws + OFF_WINT), 1024, INC, t - T3, lds);
        else if (t < T5) tr_tile(p.in[I_WPA], (h16*)(ws + OFF_WPAT), 512, 1024, t - T4, lds);
        else if (t < T6) tr_tile(p.in[I_WPB], (h16*)(ws + OFF_WPBT), 512, 1024, t - T5, lds);
        else if (t < T7) tr_tile(p.in[I_WOUT], (h16*)(ws + OFF_WOUTT), 1024, 1024, t - T6, lds);
        else wqk_tile(p.in[I_WQ], p.in[I_KEYS], (h16*)(ws + OFF_WQT), t - T7, lds);
    }
}

__device__ __forceinline__ void norm_rows(const float* __restrict__ src, h16* __restrict__ dst, int row_begin, int rows_per_wave, const float* sA, const float* sB) {
    const int tid_ = fresh_tid();
    const int wid = tid_ >> 6, lane = tid_ & 63;
    f32x4 a[4], bsh[4];
#pragma unroll
    for (int c = 0; c < 4; ++c) { a[c] = *(const f32x4*)(sA + c * 256 + lane * 4); bsh[c] = *(const f32x4*)(sB + c * 256 + lane * 4); }
    for (int i = 0; i < rows_per_wave; i += 2) {
        const size_t row = (size_t)row_begin + wid * rows_per_wave + i;
        f32x4 v[2][4]; float ss[2];
#pragma unroll
        for (int q = 0; q < 2; ++q) {
            ss[q] = 0.f;
#pragma unroll
            for (int c = 0; c < 4; ++c) { v[q][c] = *(const f32x4*)(src + (row + q) * 1024 + c * 256 + lane * 4); ss[q] += v[q][c][0] * v[q][c][0] + v[q][c][1] * v[q][c][1] + v[q][c][2] * v[q][c][2] + v[q][c][3] * v[q][c][3]; }
        }
#pragma unroll
        for (int o = 32; o > 0; o >>= 1) { const float t0 = __shfl_xor(ss[0], o), t1 = __shfl_xor(ss[1], o); ss[0] += t0; ss[1] += t1; }
#pragma unroll
        for (int q = 0; q < 2; ++q) {
            const float r = rsqrtf(ss[q] * (1.0f / 1024.0f) + 1e-6f);
#pragma unroll
            for (int c = 0; c < 4; ++c) {
                h16x4 o;
#pragma unroll
                for (int j = 0; j < 4; ++j) o[j] = (h16)(v[q][c][j] * r * a[c][j] + bsh[c][j]);
                *(h16x4*)(dst + (row + q) * 1024 + c * 256 + lane * 4) = o;
            }
        }
    }
}
__device__ void phase1(const Params& p, float* lds) {
    unsigned char* ws = p.ws;
    const int tid = threadIdx.x;
    const float* mp = (const float*)(ws + OFF_MODP);
    const float* bias = p.in[I_ADAB];
    float* sA = lds; float* sB = lds + 1024; float* cA = lds + 2048; float* cB = lds + 3072;
    {
        float* mod = (float*)(ws + OFF_MOD);
        for (int e = blockIdx.x * 512 + tid; e < 17 * 6144; e += gridDim.x * 512) {
            float s = bias[e % 6144];
#pragma unroll
            for (int kc = 0; kc < 16; ++kc) s += mp[(size_t)kc * 17 * 6144 + e];
            mod[e] = s;
        }
    }
    for (int col = tid; col < 1024; col += 512) {
        float sh = bias[col], sc = bias[1024 + col];
#pragma unroll
        for (int kc = 0; kc < 16; ++kc) { sh += mp[((size_t)kc * 17 + 16) * 6144 + col]; sc += mp[((size_t)kc * 17 + 16) * 6144 + 1024 + col]; }
        cA[col] = p.in[I_N1G][col] * (1.0f + sc); cB[col] = sh;
    }
    for (int rg = blockIdx.x; rg < 256; rg += gridDim.x) {
        const int b = rg >> 4;
        __syncthreads();
        for (int col = tid; col < 1024; col += 512) {
            float sh = bias[col], sc = bias[1024 + col];
#pragma unroll
            for (int kc = 0; kc < 16; ++kc) { sh += mp[((size_t)kc * 17 + b) * 6144 + col]; sc += mp[((size_t)kc * 17 + b) * 6144 + 1024 + col]; }
            sA[col] = p.in[I_N1G][col] * (1.0f + sc); sB[col] = sh;
        }
        __syncthreads();
        norm_rows(p.in[I_X], (h16*)(ws + OFF_R1), rg * 128, 16, sA, sB);
        norm_rows(p.in[I_CTX], (h16*)(ws + OFF_HC), rg * 16, 2, cA, cB);
    }
}
__device__ void phase6(const Params& p, float* lds) {
    unsigned char* ws = p.ws;
    const int tid = threadIdx.x;
    const float* mod = (const float*)(ws + OFF_MOD);
    float* sA = lds; float* sB = lds + 1024;
    for (int rg = blockIdx.x; rg < 256; rg += gridDim.x) {
        const int b = rg >> 4;
        __syncthreads();
        for (int col = tid; col < 1024; col += 512) {
            sA[col] = p.in[I_N2G][col] * (1.0f + mod[(size_t)b * 6144 + 4 * 1024 + col]); sB[col] = mod[(size_t)b * 6144 + 3 * 1024 + col];
        }
        __syncthreads();
        norm_rows(p.out, (h16*)(ws + OFF_R1), rg * 128, 16, sA, sB);
    }
}

__device__ __forceinline__ int clampi(int v, int lo, int hi) { return v < lo ? lo : (v > hi ? hi : v); }

template <bool LOCAL>
__device__ __forceinline__ void attn_core(const h16x8 (&kf)[2][2], const h16x8 (&vf)[4], const float* __restrict__ rpbrow, const int cb, const int qc, const int cs,
                                          const h16x8 (&qf)[2], float& m_run, float& l_run, f32x4 (&O)[4], const int quad) {
    f32x4 st[2];
#pragma unroll
    for (int t = 0; t < 2; ++t) {
        f32x4 a = (f32x4){0.f, 0.f, 0.f, 0.f};
#pragma unroll
        for (int ks = 0; ks < 2; ++ks) a = __builtin_amdgcn_mfma_f32_16x16x32_f16(kf[t][ks], qf[ks], a, 0, 0, 0);
        st[t] = a;
    }
    float mx = -INFINITY;
#pragma unroll
    for (int t = 0; t < 2; ++t)
#pragma unroll
        for (int j = 0; j < 4; ++j) {
            float sv = st[t][j] * 0.125f;
            if (LOCAL) {
                const int kc = cb + 16 * t + quad * 4 + j;
                const bool inw = (kc >= cs) && (kc < cs + 16);
                const int dc = clampi(kc - qc + 15, 0, 30);
                const float bv = rpbrow[dc];
                sv = inw ? (sv + bv) : -1e30f;
            }
            st[t][j] = sv; mx = fmaxf(mx, sv);
        }
    mx = fmaxf(mx, __shfl_xor(mx, 16)); mx = fmaxf(mx, __shfl_xor(mx, 32));
    const float m_new = fmaxf(m_run, mx);
    const float alpha = __expf(m_run - m_new);
    float ls = 0.f; h16x8 pf;
#pragma unroll
    for (int t = 0; t < 2; ++t)
#pragma unroll
        for (int j = 0; j < 4; ++j) { const float pe = __expf(st[t][j] - m_new); ls += pe; pf[t * 4 + j] = (h16)pe; }
    l_run = l_run * alpha + ls; m_run = m_new;
#pragma unroll
    for (int dt = 0; dt < 4; ++dt) { O[dt] *= alpha; O[dt] = __builtin_amdgcn_mfma_f32_16x16x32_f16(vf[dt], pf, O[dt], 0, 0, 0); }
}
__device__ __forceinline__ void load_kv(const h16* __restrict__ kt, const h16* __restrict__ vt, h16x8 (&kf)[2][2], h16x8 (&vf)[4], const int l15, const int quad) {
#pragma unroll
    for (int t = 0; t < 2; ++t)
#pragma unroll
        for (int ks = 0; ks < 2; ++ks) kf[t][ks] = *(const h16x8*)(kt + (16 * t + l15) * 64 + ks * 32 + quad * 8);
#pragma unroll
    for (int dt = 0; dt < 4; ++dt) {
        const h16* vp = vt + ((quad >> 1) * 64 + dt * 16 + l15) * 8 + (quad & 1) * 4;
        const h16x4 lo = *(const h16x4*)vp, hi = *(const h16x4*)(vp + 2 * 512);
        vf[dt] = (h16x8){lo[0], lo[1], lo[2], lo[3], hi[0], hi[1], hi[2], hi[3]};
    }
}

__device__ void attn_unit(const Params& p, int unit) {
    unsigned char* ws = p.ws;
    const int tid_ = fresh_tid();
    const int lane = tid_ & 63, h = tid_ >> 6, l15 = lane & 15, quad = lane >> 4;
    const int b = unit >> 5, r = unit & 31;
    const h16* QB = (const h16*)(ws + OFF_QB);
    const h16* KH = (const h16*)(ws + OFF_KB) + (size_t)(b * 8 + h) * 2048 * 64;
    const h16* VH = (const h16*)(ws + OFF_VT) + (size_t)(b * 8 + h) * 256 * 512;
    const h16* KCH = (const h16*)(ws + OFF_KC) + (size_t)(b * 8 + h) * 256 * 64;
    const h16* VCH = (const h16*)(ws + OFF_VCT) + (size_t)(b * 8 + h) * 32 * 512;
    h16* YA = (h16*)(ws + OFF_R1);
    const float* rpb = p.in[I_RPB] + (size_t)h * 15 * 31;
    const int rs = clampi(r - 4, 0, 24);
    h16x8 qf[4][2]; float m_run[4], l_run[4]; f32x4 O[4][4];
#pragma unroll
    for (int g = 0; g < 4; ++g) {
        const size_t tq = (size_t)b * 2048 + r * 64 + 16 * g + l15;
        qf[g][0] = *(const h16x8*)(QB + tq * 512 + h * 64 + quad * 8);
        qf[g][1] = *(const h16x8*)(QB + tq * 512 + h * 64 + 32 + quad * 8);
        m_run[g] = -INFINITY; l_run[g] = 0.f;
#pragma unroll
        for (int dt = 0; dt < 4; ++dt) O[g][dt] = (f32x4){0.f, 0.f, 0.f, 0.f};
    }
#pragma unroll 1
    for (int step = 0; step < 8; ++step) {
        h16x8 kf[2][2], vf[4];
        load_kv(KCH + step * 32 * 64, VCH + step * 4 * 512, kf, vf, l15, quad);
#pragma unroll
        for (int g = 0; g < 4; ++g) attn_core<false>(kf, vf, rpb, 0, 0, 0, qf[g], m_run[g], l_run[g], O[g], quad);
    }
#pragma unroll
    for (int gp = 0; gp < 4; gp += 2) {
        const int cb0 = clampi(16 * gp - 8, 0, 32), cb1 = clampi(16 * (gp + 1) - 8, 0, 32);
        const int qc0 = 16 * gp + l15, qc1 = 16 * (gp + 1) + l15;
        const int cs0 = clampi(qc0 - 8, 0, 48), cs1 = clampi(qc1 - 8, 0, 48);
        const float* rp0 = rpb + (rs - r + 7) * 31;
#pragma unroll 1
        for (int step = 0; step < 8; ++step) {
            const int t0 = (rs + step) * 64 + cb0, t1 = (rs + step) * 64 + cb1;
            h16x8 kf0[2][2], vf0[4], kf1[2][2], vf1[4];
            load_kv(KH + (size_t)t0 * 64, VH + (size_t)(t0 >> 3) * 512, kf0, vf0, l15, quad);
            load_kv(KH + (size_t)t1 * 64, VH + (size_t)(t1 >> 3) * 512, kf1, vf1, l15, quad);
            attn_core<true>(kf0, vf0, rp0 + step * 31, cb0, qc0, cs0, qf[gp], m_run[gp], l_run[gp], O[gp], quad);
            attn_core<true>(kf1, vf1, rp0 + step * 31, cb1, qc1, cs1, qf[gp + 1], m_run[gp + 1], l_run[gp + 1], O[gp + 1], quad);
        }
    }
#pragma unroll
    for (int g = 0; g < 4; ++g) {
        const size_t tq = (size_t)b * 2048 + r * 64 + 16 * g + l15;
        float l = l_run[g];
        l += __shfl_xor(l, 16); l += __shfl_xor(l, 32);
        const float inv = __builtin_amdgcn_rcpf(l);
#pragma unroll
        for (int dt = 0; dt < 4; ++dt) {
            h16x4 o;
#pragma unroll
            for (int j = 0; j < 4; ++j) o[j] = (h16)(O[g][dt][j] * inv);
            *(h16x4*)(YA + tq * 1024 + h * 64 + dt * 16 + quad * 4) = o;
        }
    }
}

__device__ void sgu_unit(const Params& p, int n, LAS unsigned char* lds) {
    unsigned char* ws = p.ws;
    const int tid = fresh_tid(), lane = tid & 63, g = tid >> 6, l15 = lane & 15, quad = lane >> 4;
    const h16* GUV = (const h16*)(ws + OFF_GUV);
    const h16* WS16 = (const h16*)(ws + OFF_WS16);
    h16* YB = (h16*)(ws + OFF_R1) + 512;
    LAS float* stat = (LAS float*)(lds + 8 * 17408);
    LAS h16* vt = (LAS h16*)(lds + g * 17408);
    const size_t t0 = (size_t)n * 128;
    __syncthreads();
    for (int i = 0; i < 16; i += 4) {
        h16x8 x[4]; float s[4], v[4];
#pragma unroll
        for (int q = 0; q < 4; ++q) {
            x[q] = *(const h16x8*)(GUV + (t0 + g * 16 + i + q) * 1024 + 512 + lane * 8);
            s[q] = 0.f;
#pragma unroll
            for (int j = 0; j < 8; ++j) s[q] += (float)x[q][j];
        }
#pragma unroll
        for (int o = 32; o > 0; o >>= 1) { float t[4];
#pragma unroll
            for (int q = 0; q < 4; ++q) t[q] = __shfl_xor(s[q], o);
#pragma unroll
            for (int q = 0; q < 4; ++q) s[q] += t[q]; }
#pragma unroll
        for (int q = 0; q < 4; ++q) {
            s[q] *= (1.0f / 512.0f); v[q] = 0.f;
#pragma unroll
            for (int j = 0; j < 8; ++j) { const float d = (float)x[q][j] - s[q]; v[q] += d * d; }
        }
#pragma unroll
        for (int o = 32; o > 0; o >>= 1) { float t[4];
#pragma unroll
            for (int q = 0; q < 4; ++q) t[q] = __shfl_xor(v[q], o);
#pragma unroll
            for (int q = 0; q < 4; ++q) v[q] += t[q]; }
        if (lane == 0) {
#pragma unroll
            for (int q = 0; q < 4; ++q) { stat[(g * 16 + i + q) * 2] = s[q]; stat[(g * 16 + i + q) * 2 + 1] = rsqrtf(v[q] * (1.0f / 512.0f) + 1e-6f); }
        }
    }
    __syncthreads();
    {
        const int ch0 = (lane & 7) * 8;
        float lg[8];
#pragma unroll
        for (int j = 0; j < 8; ++j) lg[j] = p.in[I_LNG][g * 64 + ch0 + j];
#pragma unroll 8
        for (int it = 0; it < 16; ++it) {
            const int q = it * 8 + (lane >> 3);
            const h16x8 x = *(const h16x8*)(GUV + (t0 + q) * 1024 + 512 + g * 64 + ch0);
            const float mean = stat[q * 2], rstd = stat[q * 2 + 1];
#pragma unroll
            for (int j = 0; j < 8; ++j) vt[(ch0 + j) * 136 + q] = (h16)(((float)x[j] - mean) * rstd * lg[j]);
        }
    }
    asm volatile("s_waitcnt lgkmcnt(0)" ::: "memory");
    __syncthreads();
    h16x8 af[4][4];
#pragma unroll
    for (int dt = 0; dt < 4; ++dt)
#pragma unroll
        for (int ks = 0; ks < 4; ++ks) af[dt][ks] = *(const LAS h16x8*)(vt + (dt * 16 + l15) * 136 + ks * 32 + quad * 8);
    const h16* wg = WS16 + (size_t)g * 128 * 128;
#pragma unroll 2
    for (int pt = 0; pt < 8; ++pt) {
        f32x4 acc[4];
#pragma unroll
        for (int dt = 0; dt < 4; ++dt) acc[dt] = (f32x4){0.f, 0.f, 0.f, 0.f};
#pragma unroll
        for (int ks = 0; ks < 4; ++ks) {
            const h16x8 bf = *(const h16x8*)(wg + (size_t)(pt * 16 + l15) * 128 + ks * 32 + quad * 8);
#pragma unroll
            for (int dt = 0; dt < 4; ++dt) acc[dt] = __builtin_amdgcn_mfma_f32_16x16x32_f16(af[dt][ks], bf, acc[dt], 0, 0, 0);
        }
        const int pp = pt * 16 + l15;
        const float bsv = p.in[I_GMBS][g * 128 + pp];
        const size_t tok = t0 + pp;
#pragma unroll
        for (int dt = 0; dt < 4; ++dt) {
            const int ch = g * 64 + dt * 16 + quad * 4;
            const h16x4 uu = *(const h16x4*)(GUV + tok * 1024 + ch);
            h16x4 o;
#pragma unroll
            for (int j = 0; j < 4; ++j) o[j] = (h16)((float)uu[j] * (acc[dt][j] + bsv));
            *(h16x4*)(YB + tok * 1024 + ch) = o;
        }
    }
    __syncthreads();
}

__device__ __forceinline__ unsigned key16(unsigned short u) { return (u & 0x8000u) ? ((~(unsigned)u) & 0xFFFFu) : ((unsigned)u | 0x8000u); }
__device__ __forceinline__ unsigned key32(unsigned u) { return (u & 0x80000000u) ? ~u : (u | 0x80000000u); }
__device__ __forceinline__ float dot8(h16x8 a, h16x8 b, float c) {
    c = __builtin_amdgcn_fdot2((h16x2){a[0], a[1]}, (h16x2){b[0], b[1]}, c, false);
    c = __builtin_amdgcn_fdot2((h16x2){a[2], a[3]}, (h16x2){b[2], b[3]}, c, false);
    c = __builtin_amdgcn_fdot2((h16x2){a[4], a[5]}, (h16x2){b[4], b[5]}, c, false);
    c = __builtin_amdgcn_fdot2((h16x2){a[6], a[7]}, (h16x2){b[6], b[7]}, c, false);
    return c;
}
#define LDS_FENCE() asm volatile("s_waitcnt lgkmcnt(0)" ::: "memory")

__device__ void peer_phase(const Params& p, LAS unsigned char* lds, unsigned* bar, unsigned& epoch) {
    unsigned char* ws = p.ws;
    const int tid = fresh_tid(), wid = __builtin_amdgcn_readfirstlane(tid >> 6), lane = tid & 63;
    const unsigned long long lm = (1ull << lane) - 1ull;
    LAS unsigned char* wl = lds + wid * 11264;
    LAS float* s_top = (LAS float*)(wl);
    LAS int* i_top = (LAS int*)(wl + 1024);
    LAS int* ex = (LAS int*)(wl + 2048);
    LAS float* sc = (LAS float*)(wl + 2560);
    LAS int* uns_m = (LAS int*)(wl + 3072);
    LAS float* uns_g = (LAS float*)(wl + 3584);
    LAS int* cnt = (LAS int*)(wl + 4096);
    LAS int* base = (LAS int*)(wl + 4352);
    const int lead = (wid >= 4) ? 1 : 0;
    const unsigned short* SC = (const unsigned short*)(ws + OFF_SC16);
    const h16* H2 = (const h16*)(ws + OFF_R1);
    const unsigned char* U4 = ws + OFF_U8;
    const unsigned char* V8 = ws + OFF_V8;
    const float* USC = (const float*)(ws + OFF_USC);
    const float* VSC = (const float*)(ws + OFF_VSC);
    const float* mod = (const float*)(ws + OFF_MOD);
    const int grp = lane >> 4, li = lane & 15;
    for (int tg = blockIdx.x; tg < 256; tg += gridDim.x) {
        for (int it5 = 0; it5 < 5; ++it5) {
          if (it5 < 4) {
            const int round = it5;
            const size_t tok0 = (size_t)tg * 128 + wid * 16 + round * 4;
            LAS unsigned short* se = (LAS unsigned short*)(wl + 4608 + (round & 1) * 3072);
            LAS float* sw = (LAS float*)(wl + 4608 + (round & 1) * 3072 + 1024);
            for (int tt = 0; tt < 4; ++tt) {
                const size_t tok = tok0 + tt;
                cnt[lane] = 0;
                for (int L0 = 0; L0 < 16; L0 += 4) {
                    unsigned short ra[4], rb[4]; unsigned ka[4], kb[4], T[4];
#pragma unroll
                    for (int q = 0; q < 4; ++q) {
                        const unsigned short* sr = SC + tok * 2048 + (L0 + q) * 128;
                        ra[q] = sr[lane]; rb[q] = sr[64 + lane];
                        ka[q] = key16(ra[q]); kb[q] = key16(rb[q]); T[q] = 0;
                    }
                    for (int bit = 15; bit >= 0; --bit) {
#pragma unroll
                        for (int q = 0; q < 4; ++q) {
                            const unsigned cand = T[q] | (1u << bit);
                            const int cn = __popcll(__ballot(ka[q] >= cand)) + __popcll(__ballot(kb[q] >= cand));
                            T[q] = (cn >= 16) ? cand : T[q];
                        }
                    }
#pragma unroll
                    for (int q = 0; q < 4; ++q) {
                        const int L = L0 + q;
                        const int cnt_gt = __popcll(__ballot(ka[q] > T[q])) + __popcll(__ballot(kb[q] > T[q]));
                        const int need = 16 - cnt_gt;
                        const unsigned long long ea = __ballot(ka[q] == T[q]), eb = __ballot(kb[q] == T[q]);
                        const int ra_eq = __popcll(ea & lm), rb_eq = __popcll(ea) + __popcll(eb & lm);
                        const bool sa = (ka[q] > T[q]) || (ka[q] == T[q] && ra_eq < need);
                        const bool sb = (kb[q] > T[q]) || (kb[q] == T[q] && rb_eq < need);
                        const unsigned long long ma = __ballot(sa), mb = __ballot(sb);
                        const int pa = __popcll(ma & lm), pb = __popcll(ma) + __popcll(mb & lm);
                        if (sa) { s_top[L * 16 + pa] = (float)__builtin_bit_cast(h16, ra[q]); i_top[L * 16 + pa] = lane; }
                        if (sb) { s_top[L * 16 + pb] = (float)__builtin_bit_cast(h16, rb[q]); i_top[L * 16 + pb] = 64 + lane; }
                    }
                }
                LDS_FENCE();
                for (int h0 = 0; h0 < 8; h0 += 4) {
                    float cv[4][4]; unsigned kk[4][4], T[4];
#pragma unroll
                    for (int q = 0; q < 4; ++q) {
                        const int h = h0 + q;
                        const float bj = s_top[(2 * h + 1) * 16 + li];
#pragma unroll
                        for (int m = 0; m < 4; ++m) { cv[q][m] = s_top[(2 * h) * 16 + grp + 4 * m] + bj; kk[q][m] = key32(__builtin_bit_cast(unsigned, cv[q][m])); }
                        T[q] = 0;
                    }
                    for (int bit = 31; bit >= 0; --bit) {
#pragma unroll
                        for (int q = 0; q < 4; ++q) {
                            const unsigned cand = T[q] | (1u << bit);
                            int cn = 0;
#pragma unroll
                            for (int m = 0; m < 4; ++m) cn += __popcll(__ballot(kk[q][m] >= cand));
                            T[q] = (cn >= 16) ? cand : T[q];
                        }
                    }
#pragma unroll
                    for (int q = 0; q < 4; ++q) {
                        const int h = h0 + q;
                        int cnt_gt = 0;
#pragma unroll
                        for (int m = 0; m < 4; ++m) cnt_gt += __popcll(__ballot(kk[q][m] > T[q]));
                        const int need = 16 - cnt_gt;
                        int eq_before = 0, sel_before = 0;
#pragma unroll
                        for (int m = 0; m < 4; ++m) {
                            const unsigned long long em = __ballot(kk[q][m] == T[q]);
                            const int myeq = eq_before + __popcll(em & lm);
                            const bool sel = (kk[q][m] > T[q]) || (kk[q][m] == T[q] && myeq < need);
                            const unsigned long long sm = __ballot(sel);
                            const int pos = sel_before + __popcll(sm & lm);
                            if (sel) {
                                ex[h * 16 + pos] = i_top[(2 * h) * 16 + grp + 4 * m] * 128 + i_top[(2 * h + 1) * 16 + li];
                                sc[h * 16 + pos] = cv[q][m];
                            }
                            eq_before += __popcll(em); sel_before += __popcll(sm);
                        }
                    }
                }
                LDS_FENCE();
#pragma unroll
                for (int half = 0; half < 2; ++half) {
                    const int e = half * 64 + lane;
                    const float v = sc[e];
                    float mx = v;
#pragma unroll
                    for (int o = 8; o > 0; o >>= 1) mx = fmaxf(mx, __shfl_xor(mx, o));
                    const float pe = __expf(v - mx);
                    float sm = pe;
#pragma unroll
                    for (int o = 8; o > 0; o >>= 1) sm += __shfl_xor(sm, o);
                    const float gate = pe * __builtin_amdgcn_rcpf(sm);
                    const int eid = ex[e];
                    const int pos = __hip_atomic_fetch_add(cnt + (eid >> 8), 1, __ATOMIC_RELAXED, __HIP_MEMORY_SCOPE_WORKGROUP);
                    uns_m[e] = eid | (pos << 14); uns_g[e] = gate;
                }
                LDS_FENCE();
                {
                    const int c = cnt[lane];
                    int incl = c;
#pragma unroll
                    for (int o = 1; o < 64; o <<= 1) { const int v = __shfl_up(incl, o); if (lane >= o) incl += v; }
                    base[lane] = incl - c;
                    LDS_FENCE();
#pragma unroll
                    for (int i = 0; i < 2; ++i) {
                        const int rm = uns_m[i * 64 + lane]; const float rg = uns_g[i * 64 + lane];
                        const int eid = rm & 16383, pos = rm >> 14;
                        const int dst = tt * 128 + base[eid >> 8] + pos;
                        se[dst] = (unsigned short)eid; sw[dst] = rg;
                    }
                    LDS_FENCE();
                }
            }
          }
          const int round = it5 - lead;
          if (round >= 0 && round < 4) {
            const size_t tok0 = (size_t)tg * 128 + wid * 16 + round * 4;
            LAS unsigned short* se = (LAS unsigned short*)(wl + 4608 + (round & 1) * 3072);
            LAS float* sw = (LAS float*)(wl + 4608 + (round & 1) * 3072 + 1024);
            const size_t tokg = tok0 + grp;
            const LAS unsigned short* me = se + grp * 128; LAS float* mw = sw + grp * 128;
            {
                const int li = launder(tid) & 15;
                h16x8 xr[4][2];
#pragma unroll
                for (int c = 0; c < 4; ++c) { xr[c][0] = *(const h16x8*)(H2 + tokg * 1024 + c * 256 + li * 16); xr[c][1] = *(const h16x8*)(H2 + tokg * 1024 + c * 256 + li * 16 + 8); }
                i32x4 ru[4][4]; float su[4], sv[4];
#define ULD(J, S_) do { const int e_ = me[(S_)]; const unsigned char* up_ = U4 + (size_t)e_ * 1024 + li * 16; \
        _Pragma("unroll") for (int c = 0; c < 4; ++c) ru[J][c] = *(const i32x4*)(up_ + c * 256); \
        { const f32x2 s2_ = *(const f32x2*)(USC + 2 * e_); su[J] = s2_.x; sv[J] = s2_.y; } } while (0)
#define UCP(J, S_) do { float d = 0.f; \
        _Pragma("unroll") for (int c = 0; c < 4; ++c) _Pragma("unroll") for (int k = 0; k < 4; ++k) { const h16x8 xv = xr[c][k >> 1]; const int o4 = (k & 1) * 4; const int w_ = ru[J][c][k]; \
            d = __builtin_amdgcn_fdot2(__builtin_amdgcn_cvt_scalef32_pk_f16_fp8(w_, 1.0f, false), (h16x2){xv[o4], xv[o4 + 1]}, d, false); \
            d = __builtin_amdgcn_fdot2(__builtin_amdgcn_cvt_scalef32_pk_f16_fp8(w_, 1.0f, true), (h16x2){xv[o4 + 2], xv[o4 + 3]}, d, false); } \
        _Pragma("unroll") for (int o = 8; o > 0; o >>= 1) d += __shfl_xor(d, o); \
        const float wt_ = mw[(S_)] * gelu_tanh(d * su[J]) * sv[J]; if (li == 0) mw[(S_)] = wt_; } while (0)
                ULD(0, 0); ULD(1, 1); ULD(2, 2); ULD(3, 3);
#pragma unroll 1
                for (int s = 0; s < 128; s += 4) {
                    UCP(0, s);     if (s + 4 < 128) ULD(0, s + 4);
                    UCP(1, s + 1); if (s + 5 < 128) ULD(1, s + 5);
                    UCP(2, s + 2); if (s + 6 < 128) ULD(2, s + 6);
                    UCP(3, s + 3); if (s + 7 < 128) ULD(3, s + 7);
                }
#undef ULD
#undef UCP
            }
            LDS_FENCE();
            {
                const int li = launder(tid) & 15;
                float acc[64];
#pragma unroll
                for (int i = 0; i < 64; ++i) acc[i] = 0.f;
                i32x4 rv[4][4];
#define VLD(J, S_) do { const int e_ = me[(S_)]; const unsigned char* vp_ = V8 + (size_t)e_ * 1024 + li * 16; \
        _Pragma("unroll") for (int c = 0; c < 4; ++c) rv[J][c] = *(const i32x4*)(vp_ + c * 256); } while (0)
#define VCP(J, S_) do { const float wt_ = mw[(S_)]; \
        _Pragma("unroll") for (int c = 0; c < 4; ++c) _Pragma("unroll") for (int k = 0; k < 4; ++k) { \
            const f32x2 lo = __builtin_amdgcn_cvt_pk_f32_fp8(rv[J][c][k], false), hi = __builtin_amdgcn_cvt_pk_f32_fp8(rv[J][c][k], true); \
            acc[c * 16 + 4 * k] += wt_ * lo.x; acc[c * 16 + 4 * k + 1] += wt_ * lo.y; acc[c * 16 + 4 * k + 2] += wt_ * hi.x; acc[c * 16 + 4 * k + 3] += wt_ * hi.y; } } while (0)
                VLD(0, 0); VLD(1, 1); VLD(2, 2); VLD(3, 3);
#pragma unroll 1
                for (int s = 0; s < 128; s += 4) {
                    VCP(0, s);     if (s + 4 < 128) VLD(0, s + 4);
                    VCP(1, s + 1); if (s + 5 < 128) VLD(1, s + 5);
                    VCP(2, s + 2); if (s + 6 < 128) VLD(2, s + 6);
                    VCP(3, s + 3); if (s + 7 < 128) VLD(3, s + 7);
                }
#undef VLD
#undef VCP
                float* xo = p.out + tokg * 1024 + li * 16;
                const int b = (int)(tokg >> 11);
                const float* g2 = mod + (size_t)b * 6144 + 5 * 1024 + li * 16;
                const float* fg = p.in[I_FG] + li * 16;
                float ss = 0.f;
#pragma unroll
                for (int c = 0; c < 4; ++c) {
#pragma unroll
                    for (int q4 = 0; q4 < 4; ++q4) {
                        const f32x4 xv = *(const f32x4*)(xo + c * 256 + q4 * 4), gv = *(const f32x4*)(g2 + c * 256 + q4 * 4);
#pragma unroll
                        for (int j = 0; j < 4; ++j) { const float t = xv[j] + gv[j] * acc[c * 16 + q4 * 4 + j]; acc[c * 16 + q4 * 4 + j] = t; ss += t * t; }
                    }
                    asm volatile("" : "+v"(ss) :: "memory");
                }
#pragma unroll
                for (int o = 8; o > 0; o >>= 1) ss += __shfl_xor(ss, o);
                const float r = rsqrtf(ss * (1.0f / 1024.0f) + 1e-6f);
#pragma unroll
                for (int c = 0; c < 4; ++c) {
#pragma unroll
                    for (int q4 = 0; q4 < 4; ++q4) {
                        const f32x4 fv = *(const f32x4*)(fg + c * 256 + q4 * 4);
                        f32x4 ov;
#pragma unroll
                        for (int j = 0; j < 4; ++j) ov[j] = acc[c * 16 + q4 * 4 + j] * r * fv[j];
                        *(f32x4*)(xo + c * 256 + q4 * 4) = ov;
                    }
                    asm volatile("" ::: "memory");
                }
            }
            LDS_FENCE();
          }
        }
    }
}

__global__ void __launch_bounds__(512, 2) mega(Params p) {
    extern __shared__ __attribute__((aligned(16))) unsigned char shm[];
    LAS unsigned char* lds = (LAS unsigned char*)shm;
    cg::grid_group grid = cg::this_grid();
    unsigned char* ws = p.ws;
    const int G = (int)gridDim.x, c = (int)blockIdx.x;
    unsigned* bar = (unsigned*)(ws + OFF_BAR); unsigned epoch = 0;

    if (p.ws == nullptr) grid.sync();
    phase0(p, (float*)shm);
    grid_bar(bar, epoch, (unsigned)G);
    phase1(p, (float*)shm);
    grid_bar(bar, epoch, (unsigned)G);
    {
        pg8::StaticOrder S; S.init(NTOK, INC, G, c);
        pg8::Gemm g{ws + OFF_R1, ws + OFF_WINT, 1024, 1024, NTOK, INC, 1024, 0};
        EpiIn E{(h16*)(ws + OFF_QB), (h16*)(ws + OFF_KB), (h16*)(ws + OFF_VT), (h16*)(ws + OFF_GUV), (h16*)(ws + OFF_GATES)};
        pg8::gemm_phase(lds, g, S, E);
        pg8::StaticOrder S2; S2.init(NCTXT, 1024, G, c);
        pg8::Gemm g2{ws + OFF_HC, ws + OFF_WINT + (size_t)512 * 1024 * 2, 1024, 1024, NCTXT, 1024, 1024, 0};
        EpiCtx E2{(h16*)(ws + OFF_KC), (h16*)(ws + OFF_VCT)};
        pg8::gemm_phase(lds, g2, S2, E2);
    }
    grid_bar(bar, epoch, (unsigned)G);
    {
        for (int rep3 = 0; rep3 < REP_P3; ++rep3) {
        for (int u = c; u < 512; u += G) attn_unit(p, u);
        for (int n = c; n < 256; n += G) sgu_unit(p, n, lds);
        }
    }
    grid_bar(bar, epoch, (unsigned)G);
    {
        pg8::StaticOrder S; S.init(NTOK, 1024, G, c);
        pg8::Gemm ga{ws + OFF_R1, ws + OFF_WPAT, 1024, 512, NTOK, 1024, 512, 0};
        EpiM1 E1{(h16*)(ws + OFF_M1), (const h16*)(ws + OFF_GATES)};
        pg8::gemm_phase(lds, ga, S, E1);
        pg8::Gemm gb{ws + OFF_R1 + 1024, ws + OFF_WPBT, 1024, 512, NTOK, 1024, 512, 0};
        EpiM2 E2{(const h16*)(ws + OFF_M1), (const h16*)(ws + OFF_GATES), (h16*)(ws + OFF_MM)};
        pg8::gemm_phase(lds, gb, S, E2);
    }
    grid_bar(bar, epoch, (unsigned)G);
    {
        pg8::StaticOrder S; S.init(NTOK, 1024, G, c);
        pg8::Gemm g{ws + OFF_MM, ws + OFF_WOUTT, 1024, 1024, NTOK, 1024, 1024, 0};
        EpiX1 E{p.in[I_X], (const float*)(ws + OFF_MOD), p.out};
        pg8::gemm_phase(lds, g, S, E);
    }
    grid_bar(bar, epoch, (unsigned)G);
    phase6(p, (float*)shm);
    grid_bar(bar, epoch, (unsigned)G);
    {
        pg8::StaticOrder S; S.init(NTOK, 2048, G, c);
        pg8::Gemm g{ws + OFF_R1, ws + OFF_WQT, 1024, 1024, NTOK, 2048, 1024, 0};
        EpiH16 E{(h16*)(ws + OFF_SC16), 2048};
        pg8::gemm_phase(lds, g, S, E);
    }
    grid_bar(bar, epoch, (unsigned)G);
    peer_phase(p, lds, bar, epoch);
}

extern "C" void kernel_launch(void* const* d_in, const int* in_sizes, int n_in, void* d_out, int out_size, void* d_ws, size_t ws_size, hipStream_t stream) {
    static int grid_blocks = 0;
    if (!grid_blocks) {
        int dev = 0, cus = 0, per_cu = 0;
        hipGetDevice(&dev);
        hipDeviceGetAttribute(&cus, hipDeviceAttributeMultiprocessorCount, dev);
        hipFuncSetAttribute((const void*)mega, hipFuncAttributeMaxDynamicSharedMemorySize, LDS_BYTES);
        hipOccupancyMaxActiveBlocksPerMultiprocessor(&per_cu, (const void*)mega, 512, LDS_BYTES);
        if (per_cu < 1) per_cu = 1;
        grid_blocks = cus * per_cu;
        if (ws_size < WS_END) fprintf(stderr, "kernel_launch: workspace too small: %zu < %zu\n", ws_size, (size_t)WS_END);
    }
    hipMemsetAsync((unsigned char*)d_ws + OFF_BAR, 0, 256, stream);
    Params p{};
    for (int i = 0; i < 21; ++i) p.in[i] = (const float*)d_in[i];
    p.out = (float*)d_out; p.ws = (unsigned char*)d_ws;
    void* args[] = {&p};
    hipError_t e = hipLaunchCooperativeKernel((const void*)mega, dim3(grid_blocks), dim3(512), args, LDS_BYTES, stream);
    if (e != hipSuccess) fprintf(stderr, "cooperative launch failed: %s (grid %d)\n", hipGetErrorString(e), grid_blocks);
}
```

```cpp
#include <hip/hip_runtime.h>
#include <hip/hip_cooperative_groups.h>
#include <cstdio>
namespace cg = cooperative_groups;

#define LAS __attribute__((address_space(3)))
typedef _Float16 h16;
typedef _Float16 h16x2 __attribute__((ext_vector_type(2)));
typedef _Float16 h16x4 __attribute__((ext_vector_type(4)));
typedef _Float16 h16x8 __attribute__((ext_vector_type(8)));
typedef float f32x4 __attribute__((ext_vector_type(4)));
typedef float f32x2 __attribute__((ext_vector_type(2)));
typedef int i32x4 __attribute__((ext_vector_type(4)));
typedef int i32x2 __attribute__((ext_vector_type(2)));

constexpr int NTOK = 32768, DM = 1024, NCTXT = 4096, INC = 4608, SEQ = 2048, CTXL = 256;
constexpr int LDS_BYTES = 144 * 1024;
#ifndef REP_SEL
#define REP_SEL 1
#endif
#ifndef REP_GATH
#define REP_GATH 1
#endif
#ifndef REP_P3
#define REP_P3 1
#endif

constexpr size_t al256(size_t x) { return (x + 255) & ~(size_t)255; }
constexpr size_t OFF_WINT = 0;
constexpr size_t OFF_WPAT = OFF_WINT + (size_t)INC * DM * 2;
constexpr size_t OFF_WPBT = OFF_WPAT + (size_t)1024 * 512 * 2;
constexpr size_t OFF_WOUTT = OFF_WPBT + (size_t)1024 * 512 * 2;
constexpr size_t OFF_WQT = OFF_WOUTT + (size_t)1024 * 1024 * 2;
constexpr size_t OFF_BD = OFF_WQT + (size_t)2048 * 1024 * 2;
constexpr size_t OFF_U16 = OFF_BD + (size_t)2048 * 256 * 2;
constexpr size_t OFF_V16 = OFF_U16 + (size_t)16384 * 1024 * 2;
constexpr size_t OFF_WS16 = OFF_V16 + (size_t)16384 * 1024 * 2;
constexpr size_t OFF_MODP = OFF_WS16 + (size_t)8 * 128 * 128 * 2;
constexpr size_t OFF_MOD = OFF_MODP + (size_t)16 * 17 * 6144 * 4;
constexpr size_t OFF_R1 = al256(OFF_MOD + (size_t)17 * 6144 * 4);
constexpr size_t OFF_QB = OFF_R1 + (size_t)NTOK * DM * 2;
constexpr size_t OFF_KB = OFF_QB + (size_t)NTOK * 512 * 2;
constexpr size_t OFF_VT = OFF_KB + (size_t)NTOK * 512 * 2;
constexpr size_t OFF_GUV = OFF_VT + (size_t)NTOK * 512 * 2;
constexpr size_t OFF_GATES = OFF_GUV + (size_t)NTOK * 1024 * 2;
constexpr size_t OFF_MM = OFF_GATES + (size_t)NTOK * 2048 * 2;
constexpr size_t OFF_BAR = OFF_MM + (size_t)NTOK * DM * 2;
constexpr size_t WS_END = OFF_BAR + 256;
constexpr size_t OFF_U8 = OFF_U16;
constexpr size_t OFF_USC = OFF_U16 + (size_t)16384 * 1024;
constexpr size_t OFF_V8 = OFF_V16;
constexpr size_t OFF_VSC = OFF_V16 + (size_t)16384 * 1024;
constexpr size_t OFF_M1 = OFF_QB;
constexpr size_t OFF_SC16 = OFF_QB;
constexpr size_t OFF_Q16 = OFF_GATES;
constexpr size_t OFF_HC = OFF_MM;
constexpr size_t OFF_KC = OFF_HC + (size_t)NCTXT * DM * 2;
constexpr size_t OFF_VCT = OFF_KC + (size_t)NCTXT * 512 * 2;
static_assert(OFF_M1 + (size_t)NTOK * DM * 4 <= OFF_GATES, "m1 alias");
static_assert(WS_END <= (size_t)512 * 1024 * 1024, "workspace");

struct Params {
    const float* in[21];
    float* out;
    unsigned char* ws;
};
enum { I_X = 0, I_C, I_CTX, I_CCTX, I_ADAW, I_ADAB, I_N1G, I_N2G, I_WIN, I_RPB, I_LNG, I_GMWS, I_GMBS, I_WPA, I_WPB, I_WOUT, I_WQ, I_KEYS, I_PU, I_PV, I_FG };

__device__ __forceinline__ int launder(int x) { asm volatile("" : "+v"(x)); return x; }
__device__ __forceinline__ int fresh_tid() { int t = threadIdx.x; asm volatile("" : "+v"(t)); return t; }

__device__ __forceinline__ float sigmoidf_(float x) { return __builtin_amdgcn_rcpf(1.0f + __expf(-x)); }
__device__ __forceinline__ float gelu_tanh(float x) {
    const float t = 0.7978845608028654f * (x + 0.044715f * x * x * x);
    return x * __builtin_amdgcn_rcpf(1.0f + __expf(-2.0f * t));
}
__device__ __forceinline__ float silu_(float x) { return x * __builtin_amdgcn_rcpf(1.0f + __expf(-x)); }
__device__ __forceinline__ float wave_sum(float v) {
#pragma unroll
    for (int o = 32; o > 0; o >>= 1) v += __shfl_xor(v, o);
    return v;
}
__device__ __forceinline__ h16x8 pack8(f32x4 a, f32x4 b) {
    h16x8 o;
    o[0] = (h16)a[0]; o[1] = (h16)a[1]; o[2] = (h16)a[2]; o[3] = (h16)a[3];
    o[4] = (h16)b[0]; o[5] = (h16)b[1]; o[6] = (h16)b[2]; o[7] = (h16)b[3];
    return o;
}


__device__ __forceinline__ void grid_bar(unsigned* ctr, unsigned& epoch, unsigned nblk) {
    __syncthreads();
    epoch += 1u;
    if (threadIdx.x == 0) {
        __builtin_amdgcn_fence(__ATOMIC_RELEASE, "agent");
        asm volatile("s_waitcnt vmcnt(0)" ::: "memory");
        __hip_atomic_fetch_add(ctr, 1u, __ATOMIC_RELAXED, __HIP_MEMORY_SCOPE_AGENT);
        const unsigned target = epoch * nblk;
        unsigned spins = 0;
        while (__hip_atomic_load(ctr, __ATOMIC_RELAXED, __HIP_MEMORY_SCOPE_AGENT) < target) { __builtin_amdgcn_s_sleep(2); if (++spins > (1u << 24)) break; }
        __builtin_amdgcn_fence(__ATOMIC_ACQUIRE, "agent");
        asm volatile("s_waitcnt vmcnt(0)" ::: "memory");
    }
    __syncthreads();
}

namespace pg8 {
constexpr int BM = 256, BK = 64, HALF = 128, HTB = HALF * BK * 2, STAGE_BYTES = 8 * HTB, NXCD = 8, WGM = 8;
__device__ __forceinline__ int lds_byte(int r, int c) { const int st = (r >> 4) * 2 + (c >> 5), rr = r & 15, cc = c & 31, ob = rr * 64 + cc * 2; return st * 1024 + (ob ^ (((ob >> 9) & 1) << 5)); }
__device__ __forceinline__ void stage_rc(int b, int& R, int& C) { const int st = b / 1024, sb = b % 1024, swz = sb ^ (((sb >> 9) & 1) << 5); R = (st >> 1) * 16 + swz / 64; C = (st & 1) * 32 + (swz % 64) / 2; }
__device__ __forceinline__ int perm32(int rho) { const int n = rho >> 4, i = rho & 15; return 8 * (i >> 2) + 4 * n + (i & 3); }

struct Unit { int pm, pn; };
struct Gemm { const void* A; const void* Bt; int lda, ldb, M, N, K, a_pn_bytes; };

struct StaticOrder {
    int nM, nN, nwg, G, c;
    __device__ void init(int M, int N, int G_, int c_) { nM = M / BM; nN = N / BM; nwg = nM * nN; G = G_; c = c_; }
    __device__ bool next(int i, Unit& u) const {
        const long L = (long)i * G + c; if (L >= nwg) return false;
        int wgid = (int)L; { const int q = nwg / NXCD, r = nwg % NXCD, xcd = wgid % NXCD, off = wgid / NXCD; wgid = (xcd < r ? xcd * (q + 1) : r * (q + 1) + (xcd - r) * q) + off; }
        const int nig = WGM * nN, gid = wgid / nig, fm = gid * WGM, gsz = (nM - fm) < WGM ? (nM - fm) : WGM;
        u.pm = fm + ((wgid % nig) % gsz); u.pn = (wgid % nig) / gsz; return true;
    }
};

template <class Epi>
__device__ __forceinline__ void gemm_phase(LAS unsigned char* lds, const Gemm g, const StaticOrder& S, const Epi& E) {
    const int tid = fresh_tid(), wid = __builtin_amdgcn_readfirstlane(tid >> 6), lane = tid & 63, wr = wid >> 2, wc = wid & 3, fr = lane & 15, fq = lane >> 4;
    const int K = g.K, nt = K / BK;
    unsigned voffA[2], voffB[2];
#pragma unroll
    for (int i = 0; i < 2; ++i) { int R, C; stage_rc(tid * 16 + i * 8192, R, C); const int Rb = (R & ~31) + perm32(R & 31);
        voffA[i] = (unsigned)(R * g.lda + C) * 2u; voffB[i] = (unsigned)(Rb * g.ldb + C) * 2u; }
    const size_t kstep = (size_t)(BK * 2);
    const size_t hstepA = (size_t)HALF * g.lda * 2, hstepB = (size_t)HALF * g.ldb * 2;
    const size_t tstepA = 2 * hstepA, tstepB = 2 * hstepB;
    const unsigned ldsw = (unsigned)wid * 1024u;
    const int aoff = lds_byte(wr * 64 + fr, fq * 8), boff = lds_byte(wc * 32 + fr, fq * 8);
#define PG8_SA(b, h) (((b) * 2 + (h)) * HTB)
#define PG8_SB(b, h) ((4 + (b) * 2 + (h)) * HTB)
#define PG8_STAGE(bufoff, gbase, voff) do { _Pragma("unroll") for (int _i = 0; _i < 2; ++_i) \
        __builtin_amdgcn_global_load_lds((const unsigned*)((const char*)(gbase) + (voff)[_i]), (LAS unsigned*)(lds + (bufoff) + ldsw + _i * 8192), 16, 0, 0); } while (0)
#define PG8_LDA(dst, b, h) do { _Pragma("unroll") for (int m = 0; m < 4; ++m) _Pragma("unroll") for (int k = 0; k < 2; ++k) dst[m][k] = *(const LAS h16x8*)(lds + PG8_SA(b, h) + aoff + m * 2048 + k * 1024); } while (0)
#define PG8_LDB(dst, b, h) do { _Pragma("unroll") for (int n = 0; n < 2; ++n) _Pragma("unroll") for (int k = 0; k < 2; ++k) dst[n][k] = *(const LAS h16x8*)(lds + PG8_SB(b, h) + boff + n * 2048 + k * 1024); } while (0)
#define PG8_MMA(ai, bj, At, Bt) do { __builtin_amdgcn_s_setprio(1); _Pragma("unroll") for (int m = 0; m < 4; ++m) _Pragma("unroll") for (int n = 0; n < 2; ++n) _Pragma("unroll") for (int k = 0; k < 2; ++k) \
        acc[ai][bj][m][n] = __builtin_amdgcn_mfma_f32_16x16x32_f16(Bt[n][k], At[m][k], acc[ai][bj][m][n], 0, 0, 0); __builtin_amdgcn_s_setprio(0); } while (0)
#define PG8_WAIT_V(n) asm volatile("s_waitcnt vmcnt(" #n ")" ::: "memory")
#define PG8_WAIT_L(n) asm volatile("s_waitcnt lgkmcnt(" #n ")" ::: "memory")
#define PG8_BAR __builtin_amdgcn_s_barrier()
#define PG8_SCHED __builtin_amdgcn_sched_barrier(0)
    Unit cur, nxt; int ui = 0;
    if (!S.next(0, cur)) return;
    f32x4 acc[2][2][4][2];
#pragma unroll
    for (int a = 0; a < 2; ++a)
#pragma unroll
        for (int b = 0; b < 2; ++b)
#pragma unroll
            for (int m = 0; m < 4; ++m)
#pragma unroll
                for (int n = 0; n < 2; ++n) acc[a][b][m][n] = (f32x4){0.f, 0.f, 0.f, 0.f};
    h16x8 At[4][2], B0[2][2], B1[2][2];
    const char* cA = (const char*)g.A + (size_t)cur.pm * tstepA + (size_t)cur.pn * g.a_pn_bytes; const char* cB = (const char*)g.Bt + (size_t)cur.pn * tstepB;
    PG8_STAGE(PG8_SB(0, 0), cB, voffB); PG8_STAGE(PG8_SA(0, 0), cA, voffA); PG8_STAGE(PG8_SB(0, 1), cB + hstepB, voffB); PG8_STAGE(PG8_SA(0, 1), cA + hstepA, voffA);
    if (wr == 1) PG8_BAR;
    PG8_WAIT_V(4); PG8_BAR;
    PG8_STAGE(PG8_SB(1, 0), cB + kstep, voffB); PG8_STAGE(PG8_SA(1, 0), cA + kstep, voffA); PG8_STAGE(PG8_SB(1, 1), cB + hstepB + kstep, voffB);
    PG8_WAIT_V(6); PG8_BAR;
    for (;;) {
        const bool has_next = S.next(ui + 1, nxt);
        const char* nA = has_next ? (const char*)g.A + (size_t)nxt.pm * tstepA + (size_t)nxt.pn * g.a_pn_bytes : cA; const char* nB = has_next ? (const char*)g.Bt + (size_t)nxt.pn * tstepB : cB;
        for (int t = 0; t < nt; t += 2) {
            const bool last = (t == nt - 2);
            const char* a1 = cA + (size_t)(t + 1) * kstep;
            const char* a2 = last ? nA : cA + (size_t)(t + 2) * kstep; const char* b2 = last ? nB : cB + (size_t)(t + 2) * kstep;
            const char* a3 = a2 + kstep; const char* b3 = b2 + kstep;
            PG8_LDB(B0, 0, 0); PG8_SCHED; PG8_LDA(At, 0, 0); PG8_STAGE(PG8_SA(1, 1), a1 + hstepA, voffA);
            PG8_WAIT_L(8); PG8_BAR; PG8_WAIT_L(0); PG8_MMA(0, 0, At, B0); PG8_BAR; PG8_SCHED;
            PG8_LDB(B1, 0, 1); PG8_STAGE(PG8_SB(0, 0), b2, voffB);
            PG8_BAR; PG8_WAIT_L(0); PG8_MMA(0, 1, At, B1); PG8_BAR;
            PG8_LDA(At, 0, 1); PG8_STAGE(PG8_SA(0, 0), a2, voffA);
            PG8_BAR; PG8_WAIT_L(0); PG8_MMA(1, 0, At, B0); PG8_BAR; PG8_SCHED;
            PG8_STAGE(PG8_SB(0, 1), b2 + hstepB, voffB);
            PG8_WAIT_V(6); PG8_BAR; PG8_MMA(1, 1, At, B1); PG8_BAR;
            PG8_LDB(B0, 1, 0); PG8_SCHED; PG8_LDA(At, 1, 0); PG8_STAGE(PG8_SA(0, 1), a2 + hstepA, voffA);
            PG8_WAIT_L(8); PG8_BAR; PG8_WAIT_L(0); PG8_MMA(0, 0, At, B0); PG8_BAR; PG8_SCHED;
            PG8_LDB(B1, 1, 1); PG8_STAGE(PG8_SB(1, 0), b3, voffB);
            PG8_BAR; PG8_WAIT_L(0); PG8_MMA(0, 1, At, B1); PG8_BAR;
            PG8_LDA(At, 1, 1); PG8_STAGE(PG8_SA(1, 0), a3, voffA);
            PG8_BAR; PG8_WAIT_L(0); PG8_MMA(1, 0, At, B0); PG8_BAR; PG8_SCHED;
            PG8_STAGE(PG8_SB(1, 1), b3 + hstepB, voffB);
            PG8_WAIT_V(6); PG8_BAR; PG8_MMA(1, 1, At, B1); PG8_BAR;
        }
        E(acc, cur, wr, wc, fr, fq);
        if (!has_next) break;
#pragma unroll
        for (int a = 0; a < 2; ++a)
#pragma unroll
            for (int b = 0; b < 2; ++b)
#pragma unroll
                for (int m = 0; m < 4; ++m)
#pragma unroll
                    for (int n = 0; n < 2; ++n) acc[a][b][m][n] = (f32x4){0.f, 0.f, 0.f, 0.f};
        cur = nxt; cA = nA; cB = nB; ++ui;
    }
    PG8_WAIT_V(0);
    if (wr == 0) PG8_BAR;
    PG8_BAR;
#undef PG8_SA
#undef PG8_SB
#undef PG8_STAGE
#undef PG8_LDA
#undef PG8_LDB
#undef PG8_MMA
#undef PG8_WAIT_V
#undef PG8_WAIT_L
#undef PG8_BAR
#undef PG8_SCHED
}
}
typedef f32x4 AccT[2][2][4][2];

struct EpiIn {
    h16 *qb, *kb, *vt, *guv, *gates;
    __device__ __forceinline__ void operator()(const AccT& acc, const pg8::Unit& u, int wr, int wc, int fr, int fq) const {
        const int pn = u.pn;
        const int row0 = u.pm * 256 + wr * 64 + fr;
        const int cin = wc * 32 + 8 * fq;
        const int b = (u.pm * 256) >> 11, sb = ((u.pm * 256) & 2047) + wr * 64;
        if (pn < 2) {
            h16* base = qb + (size_t)row0 * 512 + pn * 256 + cin;
#pragma unroll
            for (int ai = 0; ai < 2; ++ai)
#pragma unroll
                for (int m = 0; m < 4; ++m)
#pragma unroll
                    for (int bj = 0; bj < 2; ++bj) *(h16x8*)(base + (ai * 128 + m * 16) * 512 + bj * 128) = pack8(acc[ai][bj][m][0], acc[ai][bj][m][1]);
        } else if (pn < 4) {
#pragma unroll
            for (int bj = 0; bj < 2; ++bj) {
                const int col = (pn & 1) * 256 + bj * 128 + cin, hd = col >> 6, d0 = col & 63;
                h16* base = kb + ((size_t)(b * 8 + hd) * 2048 + sb + fr) * 64 + d0;
#pragma unroll
                for (int ai = 0; ai < 2; ++ai)
#pragma unroll
                    for (int m = 0; m < 4; ++m) *(h16x8*)(base + (ai * 128 + m * 16) * 64) = pack8(acc[ai][bj][m][0], acc[ai][bj][m][1]);
            }
        } else if (pn < 6) {
#pragma unroll
            for (int bj = 0; bj < 2; ++bj) {
                const int cv = (pn - 4) * 256 + bj * 128 + cin, hd = cv >> 6, d0 = cv & 63;
                h16* base = vt + ((size_t)(b * 8 + hd) * 256 + (sb >> 3) + (fr >> 3)) * 512 + d0 * 8 + (fr & 7);
#pragma unroll
                for (int ai = 0; ai < 2; ++ai)
#pragma unroll
                    for (int m = 0; m < 4; ++m) {
                        h16* vp = base + (ai * 16 + m * 2) * 512;
                        const f32x4 v0 = acc[ai][bj][m][0], v1 = acc[ai][bj][m][1];
#pragma unroll
                        for (int i = 0; i < 4; ++i) { vp[i * 8] = (h16)v0[i]; vp[(i + 4) * 8] = (h16)v1[i]; }
                    }
            }
        } else if (pn < 10) {
            h16* base = guv + (size_t)row0 * 1024 + (pn - 6) * 256 + cin;
#pragma unroll
            for (int ai = 0; ai < 2; ++ai)
#pragma unroll
                for (int m = 0; m < 4; ++m)
#pragma unroll
                    for (int bj = 0; bj < 2; ++bj) {
                        f32x4 v0 = acc[ai][bj][m][0], v1 = acc[ai][bj][m][1];
#pragma unroll
                        for (int i = 0; i < 4; ++i) { v0[i] = gelu_tanh(v0[i]); v1[i] = gelu_tanh(v1[i]); }
                        *(h16x8*)(base + (ai * 128 + m * 16) * 1024 + bj * 128) = pack8(v0, v1);
                    }
        } else {
            h16* base = gates + (size_t)row0 * 2048 + (pn - 10) * 256 + cin;
#pragma unroll
            for (int ai = 0; ai < 2; ++ai)
#pragma unroll
                for (int m = 0; m < 4; ++m)
#pragma unroll
                    for (int bj = 0; bj < 2; ++bj) {
                        f32x4 v0 = acc[ai][bj][m][0], v1 = acc[ai][bj][m][1];
#pragma unroll
                        for (int i = 0; i < 4; ++i) { v0[i] = sigmoidf_(v0[i]); v1[i] = sigmoidf_(v1[i]); }
                        *(h16x8*)(base + (ai * 128 + m * 16) * 2048 + bj * 128) = pack8(v0, v1);
                    }
        }
    }
};
struct EpiCtx {
    h16 *kc, *vct;
    __device__ __forceinline__ void operator()(const AccT& acc, const pg8::Unit& u, int wr, int wc, int fr, int fq) const {
        const int pn = u.pn;
        const int cin = wc * 32 + 8 * fq;
        const int b = u.pm, sb = wr * 64;
        if (pn < 2) {
#pragma unroll
            for (int bj = 0; bj < 2; ++bj) {
                const int col = pn * 256 + bj * 128 + cin, hd = col >> 6, d0 = col & 63;
                h16* base = kc + ((size_t)(b * 8 + hd) * 256 + sb + fr) * 64 + d0;
#pragma unroll
                for (int ai = 0; ai < 2; ++ai)
#pragma unroll
                    for (int m = 0; m < 4; ++m) *(h16x8*)(base + (ai * 128 + m * 16) * 64) = pack8(acc[ai][bj][m][0], acc[ai][bj][m][1]);
            }
        } else {
#pragma unroll
            for (int bj = 0; bj < 2; ++bj) {
                const int cv = (pn - 2) * 256 + bj * 128 + cin, hd = cv >> 6, d0 = cv & 63;
                h16* base = vct + ((size_t)(b * 8 + hd) * 32 + (sb >> 3) + (fr >> 3)) * 512 + d0 * 8 + (fr & 7);
#pragma unroll
                for (int ai = 0; ai < 2; ++ai)
#pragma unroll
                    for (int m = 0; m < 4; ++m) {
                        h16* vp = base + (ai * 16 + m * 2) * 512;
                        const f32x4 v0 = acc[ai][bj][m][0], v1 = acc[ai][bj][m][1];
#pragma unroll
                        for (int i = 0; i < 4; ++i) { vp[i * 8] = (h16)v0[i]; vp[(i + 4) * 8] = (h16)v1[i]; }
                    }
            }
        }
    }
};
struct EpiM1 {
    h16* m1; const h16* gates;
    __device__ __forceinline__ void operator()(const AccT& acc, const pg8::Unit& u, int wr, int wc, int fr, int fq) const {
        const int row0 = u.pm * 256 + wr * 64 + fr, col0 = u.pn * 256 + wc * 32 + 8 * fq;
#pragma unroll
        for (int ai = 0; ai < 2; ++ai)
#pragma unroll
            for (int m = 0; m < 4; ++m) {
                const int row = row0 + ai * 128 + m * 16;
#pragma unroll
                for (int bj = 0; bj < 2; ++bj) {
                    const int col = col0 + bj * 128;
                    const h16x8 gt = *(const h16x8*)(gates + (size_t)row * 2048 + col);
                    f32x4 v0 = acc[ai][bj][m][0], v1 = acc[ai][bj][m][1];
#pragma unroll
                    for (int i = 0; i < 4; ++i) { v0[i] *= (float)gt[i]; v1[i] *= (float)gt[4 + i]; }
                    *(h16x8*)(m1 + (size_t)row * 1024 + col) = pack8(v0, v1);
                }
            }
    }
};
struct EpiM2 {
    const h16* m1; const h16* gates; h16* mm;
    __device__ __forceinline__ void operator()(const AccT& acc, const pg8::Unit& u, int wr, int wc, int fr, int fq) const {
        const int row0 = u.pm * 256 + wr * 64 + fr, col0 = u.pn * 256 + wc * 32 + 8 * fq;
#pragma unroll
        for (int ai = 0; ai < 2; ++ai)
#pragma unroll
            for (int m = 0; m < 4; ++m) {
                const int row = row0 + ai * 128 + m * 16;
#pragma unroll
                for (int bj = 0; bj < 2; ++bj) {
                    const int col = col0 + bj * 128;
                    const h16x8 gt = *(const h16x8*)(gates + (size_t)row * 2048 + 1024 + col);
                    const h16x8 mi = *(const h16x8*)(m1 + (size_t)row * 1024 + col);
                    f32x4 p0 = (f32x4){(float)mi[0], (float)mi[1], (float)mi[2], (float)mi[3]}, p1 = (f32x4){(float)mi[4], (float)mi[5], (float)mi[6], (float)mi[7]};
                    const f32x4 v0 = acc[ai][bj][m][0], v1 = acc[ai][bj][m][1];
#pragma unroll
                    for (int i = 0; i < 4; ++i) { p0[i] += v0[i] * (float)gt[i]; p1[i] += v1[i] * (float)gt[4 + i]; }
                    *(h16x8*)(mm + (size_t)row * 1024 + col) = pack8(p0, p1);
                }
            }
    }
};
struct EpiX1 {
    const float* x; const float* mod; float* x1;
    __device__ __forceinline__ void operator()(const AccT& acc, const pg8::Unit& u, int wr, int wc, int fr, int fq) const {
        const int row0 = u.pm * 256 + wr * 64 + fr, col0 = u.pn * 256 + wc * 32 + 8 * fq;
        const int b = (u.pm * 256) >> 11;
#pragma unroll
        for (int bj = 0; bj < 2; ++bj) {
            const int col = col0 + bj * 128;
            const float* gp = mod + (size_t)b * 6144 + 2 * 1024 + col;
            const f32x4 g0 = *(const f32x4*)gp, g1 = *(const f32x4*)(gp + 4);
#pragma unroll
            for (int ai = 0; ai < 2; ++ai)
#pragma unroll
                for (int m = 0; m < 4; ++m) {
                    const int row = row0 + ai * 128 + m * 16;
                    const float* xi = x + (size_t)row * 1024 + col;
                    const f32x4 x0 = *(const f32x4*)xi, x1v = *(const f32x4*)(xi + 4);
                    float* o = x1 + (size_t)row * 1024 + col;
                    *(f32x4*)o = x0 + g0 * acc[ai][bj][m][0]; *(f32x4*)(o + 4) = x1v + g1 * acc[ai][bj][m][1];
                }
        }
    }
};
struct EpiH16 {
    h16* o; int ldc;
    __device__ __forceinline__ void operator()(const AccT& acc, const pg8::Unit& u, int wr, int wc, int fr, int fq) const {
        const int row0 = u.pm * 256 + wr * 64 + fr, col0 = u.pn * 256 + wc * 32 + 8 * fq;
#pragma unroll
        for (int ai = 0; ai < 2; ++ai)
#pragma unroll
            for (int m = 0; m < 4; ++m) {
                const int row = row0 + ai * 128 + m * 16;
#pragma unroll
                for (int bj = 0; bj < 2; ++bj)
                    *(h16x8*)(o + (size_t)row * ldc + col0 + bj * 128) = pack8(acc[ai][bj][m][0], acc[ai][bj][m][1]);
            }
    }
};

__device__ __forceinline__ void cvt_tile(const float* __restrict__ src, h16* __restrict__ dst, int tile) {
    const size_t i = (size_t)tile * 4096 + threadIdx.x * 8;
    const f32x4 a = *(const f32x4*)(src + i), b = *(const f32x4*)(src + i + 4);
    *(h16x8*)(dst + i) = pack8(a, b);
}
__device__ __forceinline__ void tr_tile(const float* __restrict__ src, h16* __restrict__ dst, int K, int N, int tile, float* lds) {
    const int ntn = N / 64, tk = tile / ntn, tn = tile % ntn, tid = threadIdx.x;
#pragma unroll
    for (int ps = 0; ps < 2; ++ps) {
        const int k = ps * 32 + (tid >> 4), n = (tid & 15) * 4;
        const f32x4 v = *(const f32x4*)(src + (size_t)(tk * 64 + k) * N + tn * 64 + n);
        lds[k * 65 + n] = v[0]; lds[k * 65 + n + 1] = v[1]; lds[k * 65 + n + 2] = v[2]; lds[k * 65 + n + 3] = v[3];
    }
    __syncthreads();
    {
        const int n = tid >> 3, ks = (tid & 7) * 8;
        h16x8 o;
#pragma unroll
        for (int i = 0; i < 8; ++i) o[i] = (h16)lds[(ks + i) * 65 + n];
        *(h16x8*)(dst + (size_t)(tn * 64 + n) * K + tk * 64 + ks) = o;
    }
    __syncthreads();
}
__device__ __forceinline__ void cvt8_rows(const float* __restrict__ src, unsigned char* __restrict__ dst, float* __restrict__ inv, int tile) {
    const int wid = threadIdx.x >> 6, lane = threadIdx.x & 63;
    const size_t row = (size_t)tile * 8 + wid;
    const float* r = src + row * 1024 + lane * 16;
    f32x4 a[4]; float mx = 0.f;
#pragma unroll
    for (int i = 0; i < 4; ++i) { a[i] = *(const f32x4*)(r + 4 * i); mx = fmaxf(mx, fmaxf(fmaxf(fabsf(a[i][0]), fabsf(a[i][1])), fmaxf(fabsf(a[i][2]), fabsf(a[i][3])))); }
#pragma unroll
    for (int o = 32; o > 0; o >>= 1) mx = fmaxf(mx, __shfl_xor(mx, o));
    int ex2 = 0; float sc = 1.0f;
    if (mx > 0.f) { (void)frexpf(mx, &ex2); int k = 8 - ex2; k = k > 100 ? 100 : (k < -100 ? -100 : k); sc = ldexpf(1.0f, k); }
    i32x4 w;
#pragma unroll
    for (int i = 0; i < 4; ++i) {
        int pk = __builtin_amdgcn_cvt_pk_fp8_f32(a[i][0] * sc, a[i][1] * sc, 0, false);
        pk = __builtin_amdgcn_cvt_pk_fp8_f32(a[i][2] * sc, a[i][3] * sc, pk, true);
        w[i] = pk;
    }
    *(i32x4*)(dst + row * 1024 + lane * 16) = w;
    if (lane == 0) inv[2 * row] = 1.0f / sc;
}
__device__ __forceinline__ void cvt4_rows(const float* __restrict__ src, unsigned char* __restrict__ dst, float* __restrict__ inv, int tile) {
    const int wid = threadIdx.x >> 6, lane = threadIdx.x & 63;
    const size_t row = (size_t)tile * 8 + wid;
    const float* r = src + row * 1024 + lane * 16;
    f32x4 a[4]; float mx = 0.f;
#pragma unroll
    for (int i = 0; i < 4; ++i) { a[i] = *(const f32x4*)(r + 4 * i); mx = fmaxf(mx, fmaxf(fmaxf(fabsf(a[i][0]), fabsf(a[i][1])), fmaxf(fabsf(a[i][2]), fabsf(a[i][3])))); }
#pragma unroll
    for (int o = 32; o > 0; o >>= 1) mx = fmaxf(mx, __shfl_xor(mx, o));
    const float sc = (mx > 1e-30f) ? 6.0f / mx : 1.0f;
    int w0 = 0, w1 = 0;
    w0 = __builtin_amdgcn_cvt_scalef32_pk_fp4_f32(w0, a[0][0] * sc, a[0][1] * sc, 1.0f, 0);
    w0 = __builtin_amdgcn_cvt_scalef32_pk_fp4_f32(w0, a[0][2] * sc, a[0][3] * sc, 1.0f, 1);
    w0 = __builtin_amdgcn_cvt_scalef32_pk_fp4_f32(w0, a[1][0] * sc, a[1][1] * sc, 1.0f, 2);
    w0 = __builtin_amdgcn_cvt_scalef32_pk_fp4_f32(w0, a[1][2] * sc, a[1][3] * sc, 1.0f, 3);
    w1 = __builtin_amdgcn_cvt_scalef32_pk_fp4_f32(w1, a[2][0] * sc, a[2][1] * sc, 1.0f, 0);
    w1 = __builtin_amdgcn_cvt_scalef32_pk_fp4_f32(w1, a[2][2] * sc, a[2][3] * sc, 1.0f, 1);
    w1 = __builtin_amdgcn_cvt_scalef32_pk_fp4_f32(w1, a[3][0] * sc, a[3][1] * sc, 1.0f, 2);
    w1 = __builtin_amdgcn_cvt_scalef32_pk_fp4_f32(w1, a[3][2] * sc, a[3][3] * sc, 1.0f, 3);
    *(i32x2*)(dst + row * 512 + lane * 8) = (i32x2){w0, w1};
    if (lane == 0) inv[2 * row] = 1.0f / sc;
}
__device__ __forceinline__ void wqk_tile(const float* __restrict__ wq, const float* __restrict__ keys, h16* __restrict__ wt, int tile, float* lds) {
    const int ct = tile >> 4, hp = tile & 15, tid = threadIdx.x;
    float* sA = lds;
    float* sB = lds + 64 * 129;
#pragma unroll
    for (int i = 0; i < 4; ++i) {
        const int e = (i * 512 + tid) * 4, r = e >> 7, d = e & 127;
        const f32x4 v = *(const f32x4*)(wq + (size_t)(ct * 64 + r) * 2048 + hp * 128 + d);
        sA[r * 129 + d] = v[0]; sA[r * 129 + d + 1] = v[1]; sA[r * 129 + d + 2] = v[2]; sA[r * 129 + d + 3] = v[3];
    }
#pragma unroll
    for (int i = 0; i < 8; ++i) {
        const int e = (i * 512 + tid) * 4, k = e >> 7, d = e & 127;
        const f32x4 v = *(const f32x4*)(keys + (size_t)(hp * 128 + k) * 128 + d);
        sB[k * 129 + d] = v[0]; sB[k * 129 + d + 1] = v[1]; sB[k * 129 + d + 2] = v[2]; sB[k * 129 + d + 3] = v[3];
    }
    __syncthreads();
    const int c = tid >> 3, kg = (tid & 7) * 16;
    float acc[16];
#pragma unroll
    for (int j = 0; j < 16; ++j) acc[j] = 0.f;
#pragma unroll 4
    for (int d = 0; d < 128; ++d) {
        const float a = sA[c * 129 + d];
#pragma unroll
        for (int j = 0; j < 16; ++j) acc[j] += a * sB[(kg + j) * 129 + d];
    }
#pragma unroll
    for (int j = 0; j < 16; ++j) wt[(size_t)(hp * 128 + kg + j) * 1024 + ct * 64 + c] = (h16)acc[j];
    __syncthreads();
}
__device__ void phase0(const Params& p, float* lds) {
    unsigned char* ws = p.ws;
    const int tid = threadIdx.x, wid = tid >> 6, lane = tid & 63;
    for (int ib = blockIdx.x; ib < 256; ib += gridDim.x) {
        if (wid < 6) {
            const int item = ib * 6 + wid, cg64 = item % 96, kc = item / 96;
            const int col = cg64 * 64 + lane, k0 = kc * 64;
            float sv[17], acc[17];
#pragma unroll
            for (int b = 0; b < 17; ++b) {
                const float cv = (b < 16) ? p.in[I_C][b * 1024 + k0 + lane] : p.in[I_CCTX][k0 + lane];
                sv[b] = silu_(cv); acc[b] = 0.f;
            }
            const float* wp = p.in[I_ADAW] + (size_t)k0 * 6144 + col;
            for (int j = 0; j < 64; ++j) {
                const float w = wp[(size_t)j * 6144];
#pragma unroll
                for (int b = 0; b < 17; ++b) acc[b] += __builtin_bit_cast(float, __builtin_amdgcn_readlane(__builtin_bit_cast(int, sv[b]), j)) * w;
            }
            float* mp = (float*)(ws + OFF_MODP);
#pragma unroll
            for (int b = 0; b < 17; ++b) mp[((size_t)kc * 17 + b) * 6144 + col] = acc[b];
        }
    }
    constexpr int T0 = 2048, T1 = T0 + 2048, T2 = T1 + 32, T3 = T2, T4 = T3 + 1152, T5 = T4 + 128, T6 = T5 + 128, T7 = T6 + 256, T8 = T7 + 256;
    for (int t = blockIdx.x; t < T8; t += gridDim.x) {
        if (t < T0) cvt4_rows(p.in[I_PU], ws + OFF_U8, (float*)(ws + OFF_USC), t);
        else if (t < T1) cvt8_rows(p.in[I_PV], ws + OFF_V8, (float*)(ws + OFF_USC) + 1, t - T0);
        else if (t < T2) cvt_tile(p.in[I_GMWS], (h16*)(ws + OFF_WS16), t - T1);
        else if (t < T3) {
            const int e = (t - T2) * 4096 + tid * 8;
            const int row = e >> 8, cc = e & 255, h = row >> 8, pp = (row >> 7) & 1, k = row & 127, pq = cc >> 7, d = cc & 127;
            h16x8 o = {0, 0, 0, 0, 0, 0, 0, 0};
            if (pp == pq) {
                const float* kp = p.in[I_KEYS] + ((size_t)((h * 2 + pp) * 128 + k)) * 128 + d;
                o = pack8(*(const f32x4*)kp, *(const f32x4*)(kp + 4));
            }
            *(h16x8*)((h16*)(ws + OFF_BD) + e) = o;
        }
        else if (t < T4) tr_tile(p.in[I_WIN], (h16*)(ws + OFF_WINT), 1024, INC, t - T3, lds);
        else if (t < T5) tr_tile(p.in[I_WPA], (h16*)(ws + OFF_WPAT), 512, 1024, t - T4, lds);
        else if (t < T6) tr_tile(p.in[I_WPB], (h16*)(ws + OFF_WPBT), 512, 1024, t - T5, lds);
        else if (t < T7) tr_tile(p.in[I_WOUT], (h16*)(ws + OFF_WOUTT), 1024, 1024, t - T6, lds);
        else wqk_tile(p.in[I_WQ], p.in[I_KEYS], (h16*)(ws + OFF_WQT), t - T7, lds);
    }
}

__device__ __forceinline__ void norm_rows(const float* __restrict__ src, h16* __restrict__ dst, int row_begin, int rows_per_wave, const float* sA, const float* sB) {
    const int tid_ = fresh_tid();
    const int wid = tid_ >> 6, lane = tid_ & 63;
    f32x4 a[4], bsh[4];
#pragma unroll
    for (int c = 0; c < 4; ++c) { a[c] = *(const f32x4*)(sA + c * 256 + lane * 4); bsh[c] = *(const f32x4*)(sB + c * 256 + lane * 4); }
    for (int i = 0; i < rows_per_wave; i += 2) {
        const size_t row = (size_t)row_begin + wid * rows_per_wave + i;
        f32x4 v[2][4]; float ss[2];
#pragma unroll
        for (int q = 0; q < 2; ++q) {
            ss[q] = 0.f;
#pragma unroll
            for (int c = 0; c < 4; ++c) { v[q][c] = *(const f32x4*)(src + (row + q) * 1024 + c * 256 + lane * 4); ss[q] += v[q][c][0] * v[q][c][0] + v[q][c][1] * v[q][c][1] + v[q][c][2] * v[q][c][2] + v[q][c][3] * v[q][c][3]; }
        }
#pragma unroll
        for (int o = 32; o > 0; o >>= 1) { const float t0 = __shfl_xor(ss[0], o), t1 = __shfl_xor(ss[1], o); ss[0] += t0; ss[1] += t1; }
#pragma unroll
        for (int q = 0; q < 2; ++q) {
            const float r = rsqrtf(ss[q] * (1.0f / 1024.0f) + 1e-6f);
#pragma unroll
            for (int c = 0; c < 4; ++c) {
                h16x4 o;
#pragma unroll
                for (int j = 0; j < 4; ++j) o[j] = (h16)(v[q][c][j] * r * a[c][j] + bsh[c][j]);
                *(h16x4*)(dst + (row + q) * 1024 + c * 256 + lane * 4) = o;
            }
        }
    }
}
__device__ void phase1(const Params& p, float* lds) {
    unsigned char* ws = p.ws;
    const int tid = threadIdx.x;
    const float* mp = (const float*)(ws + OFF_MODP);
    const float* bias = p.in[I_ADAB];
    float* sA = lds; float* sB = lds + 1024; float* cA = lds + 2048; float* cB = lds + 3072;
    {
        float* mod = (float*)(ws + OFF_MOD);
        for (int e = blockIdx.x * 512 + tid; e < 17 * 6144; e += gridDim.x * 512) {
            float s = bias[e % 6144];
#pragma unroll
            for (int kc = 0; kc < 16; ++kc) s += mp[(size_t)kc * 17 * 6144 + e];
            mod[e] = s;
        }
    }
    for (int col = tid; col < 1024; col += 512) {
        float sh = bias[col], sc = bias[1024 + col];
#pragma unroll
        for (int kc = 0; kc < 16; ++kc) { sh += mp[((size_t)kc * 17 + 16) * 6144 + col]; sc += mp[((size_t)kc * 17 + 16) * 6144 + 1024 + col]; }
        cA[col] = p.in[I_N1G][col] * (1.0f + sc); cB[col] = sh;
    }
    for (int rg = blockIdx.x; rg < 256; rg += gridDim.x) {
        const int b = rg >> 4;
        __syncthreads();
        for (int col = tid; col < 1024; col += 512) {
            float sh = bias[col], sc = bias[1024 + col];
#pragma unroll
            for (int kc = 0; kc < 16; ++kc) { sh += mp[((size_t)kc * 17 + b) * 6144 + col]; sc += mp[((size_t)kc * 17 + b) * 6144 + 1024 + col]; }
            sA[col] = p.in[I_N1G][col] * (1.0f + sc); sB[col] = sh;
        }
        __syncthreads();
        norm_rows(p.in[I_X], (h16*)(ws + OFF_R1), rg * 128, 16, sA, sB);
        norm_rows(p.in[I_CTX], (h16*)(ws + OFF_HC), rg * 16, 2, cA, cB);
    }
}
__device__ void phase6(const Params& p, float* lds) {
    unsigned char* ws = p.ws;
    const int tid = threadIdx.x;
    const float* mod = (const float*)(ws + OFF_MOD);
    float* sA = lds; float* sB = lds + 1024;
    for (int rg = blockIdx.x; rg < 256; rg += gridDim.x) {
        const int b = rg >> 4;
        __syncthreads();
        for (int col = tid; col < 1024; col += 512) {
            sA[col] = p.in[I_N2G][col] * (1.0f + mod[(size_t)b * 6144 + 4 * 1024 + col]); sB[col] = mod[(size_t)b * 6144 + 3 * 1024 + col];
        }
        __syncthreads();
        norm_rows(p.out, (h16*)(ws + OFF_R1), rg * 128, 16, sA, sB);
    }
}

__device__ __forceinline__ int clampi(int v, int lo, int hi) { return v < lo ? lo : (v > hi ? hi : v); }

template <bool LOCAL>
__device__ __forceinline__ void attn_core(const h16x8 (&kf)[2][2], const h16x8 (&vf)[4], const float* __restrict__ rpbrow, const int cb, const int qc, const int cs,
                                          const h16x8 (&qf)[2], float& m_run, float& l_run, f32x4 (&O)[4], const int quad) {
    f32x4 st[2];
#pragma unroll
    for (int t = 0; t < 2; ++t) {
        f32x4 a = (f32x4){0.f, 0.f, 0.f, 0.f};
#pragma unroll
        for (int ks = 0; ks < 2; ++ks) a = __builtin_amdgcn_mfma_f32_16x16x32_f16(kf[t][ks], qf[ks], a, 0, 0, 0);
        st[t] = a;
    }
    float mx = -INFINITY;
#pragma unroll
    for (int t = 0; t < 2; ++t)
#pragma unroll
        for (int j = 0; j < 4; ++j) {
            float sv = st[t][j] * 0.125f;
            if (LOCAL) {
                const int kc = cb + 16 * t + quad * 4 + j;
                const bool inw = (kc >= cs) && (kc < cs + 16);
                const int dc = clampi(kc - qc + 15, 0, 30);
                const float bv = rpbrow[dc];
                sv = inw ? (sv + bv) : -1e30f;
            }
            st[t][j] = sv; mx = fmaxf(mx, sv);
        }
    mx = fmaxf(mx, __shfl_xor(mx, 16)); mx = fmaxf(mx, __shfl_xor(mx, 32));
    const float m_new = fmaxf(m_run, mx);
    const float alpha = __expf(m_run - m_new);
    float ls = 0.f; h16x8 pf;
#pragma unroll
    for (int t = 0; t < 2; ++t)
#pragma unroll
        for (int j = 0; j < 4; ++j) { const float pe = __expf(st[t][j] - m_new); ls += pe; pf[t * 4 + j] = (h16)pe; }
    l_run = l_run * alpha + ls; m_run = m_new;
#pragma unroll
    for (int dt = 0; dt < 4; ++dt) { O[dt] *= alpha; O[dt] = __builtin_amdgcn_mfma_f32_16x16x32_f16(vf[dt], pf, O[dt], 0, 0, 0); }
}
__device__ __forceinline__ void load_kv(const h16* __restrict__ kt, const h16* __restrict__ vt, h16x8 (&kf)[2][2], h16x8 (&vf)[4], const int l15, const int quad) {
#pragma unroll
    for (int t = 0; t < 2; ++t)
#pragma unroll
        for (int ks = 0; ks < 2; ++ks) kf[t][ks] = *(const h16x8*)(kt + (16 * t + l15) * 64 + ks * 32 + quad * 8);
#pragma unroll
    for (int dt = 0; dt < 4; ++dt) {
        const h16* vp = vt + ((quad >> 1) * 64 + dt * 16 + l15) * 8 + (quad & 1) * 4;
        const h16x4 lo = *(const h16x4*)vp, hi = *(const h16x4*)(vp + 2 * 512);
        vf[dt] = (h16x8){lo[0], lo[1], lo[2], lo[3], hi[0], hi[1], hi[2], hi[3]};
    }
}

__device__ void attn_unit(const Params& p, int unit) {
    unsigned char* ws = p.ws;
    const int tid_ = fresh_tid();
    const int lane = tid_ & 63, h = tid_ >> 6, l15 = lane & 15, quad = lane >> 4;
    const int b = unit >> 5, r = unit & 31;
    const h16* QB = (const h16*)(ws + OFF_QB);
    const h16* KH = (const h16*)(ws + OFF_KB) + (size_t)(b * 8 + h) * 2048 * 64;
    const h16* VH = (const h16*)(ws + OFF_VT) + (size_t)(b * 8 + h) * 256 * 512;
    const h16* KCH = (const h16*)(ws + OFF_KC) + (size_t)(b * 8 + h) * 256 * 64;
    const h16* VCH = (const h16*)(ws + OFF_VCT) + (size_t)(b * 8 + h) * 32 * 512;
    h16* YA = (h16*)(ws + OFF_R1);
    const float* rpb = p.in[I_RPB] + (size_t)h * 15 * 31;
    const int rs = clampi(r - 4, 0, 24);
    h16x8 qf[4][2]; float m_run[4], l_run[4]; f32x4 O[4][4];
#pragma unroll
    for (int g = 0; g < 4; ++g) {
        const size_t tq = (size_t)b * 2048 + r * 64 + 16 * g + l15;
        qf[g][0] = *(const h16x8*)(QB + tq * 512 + h * 64 + quad * 8);
        qf[g][1] = *(const h16x8*)(QB + tq * 512 + h * 64 + 32 + quad * 8);
        m_run[g] = -INFINITY; l_run[g] = 0.f;
#pragma unroll
        for (int dt = 0; dt < 4; ++dt) O[g][dt] = (f32x4){0.f, 0.f, 0.f, 0.f};
    }
#pragma unroll 1
    for (int step = 0; step < 8; ++step) {
        h16x8 kf[2][2], vf[4];
        load_kv(KCH + step * 32 * 64, VCH + step * 4 * 512, kf, vf, l15, quad);
#pragma unroll
        for (int g = 0; g < 4; ++g) attn_core<false>(kf, vf, rpb, 0, 0, 0, qf[g], m_run[g], l_run[g], O[g], quad);
    }
#pragma unroll
    for (int gp = 0; gp < 4; gp += 2) {
        const int cb0 = clampi(16 * gp - 8, 0, 32), cb1 = clampi(16 * (gp + 1) - 8, 0, 32);
        const int qc0 = 16 * gp + l15, qc1 = 16 * (gp + 1) + l15;
        const int cs0 = clampi(qc0 - 8, 0, 48), cs1 = clampi(qc1 - 8, 0, 48);
        const float* rp0 = rpb + (rs - r + 7) * 31;
#pragma unroll 1
        for (int step = 0; step < 8; ++step) {
            const int t0 = (rs + step) * 64 + cb0, t1 = (rs + step) * 64 + cb1;
            h16x8 kf0[2][2], vf0[4], kf1[2][2], vf1[4];
            load_kv(KH + (size_t)t0 * 64, VH + (size_t)(t0 >> 3) * 512, kf0, vf0, l15, quad);
            load_kv(KH + (size_t)t1 * 64, VH + (size_t)(t1 >> 3) * 512, kf1, vf1, l15, quad);
            attn_core<true>(kf0, vf0, rp0 + step * 31, cb0, qc0, cs0, qf[gp], m_run[gp], l_run[gp], O[gp], quad);
            attn_core<true>(kf1, vf1, rp0 + step * 31, cb1, qc1, cs1, qf[gp + 1], m_run[gp + 1], l_run[gp + 1], O[gp + 1], quad);
        }
    }
#pragma unroll
    for (int g = 0; g < 4; ++g) {
        const size_t tq = (size_t)b * 2048 + r * 64 + 16 * g + l15;
        float l = l_run[g];
        l += __shfl_xor(l, 16); l += __shfl_xor(l, 32);
        const float inv = __builtin_amdgcn_rcpf(l);
#pragma unroll
        for (int dt = 0; dt < 4; ++dt) {
            h16x4 o;
#pragma unroll
            for (int j = 0; j < 4; ++j) o[j] = (h16)(O[g][dt][j] * inv);
            *(h16x4*)(YA + tq * 1024 + h * 64 + dt * 16 + quad * 4) = o;
        }
    }
}

__device__ void sgu_unit(const Params& p, int n, LAS unsigned char* lds) {
    unsigned char* ws = p.ws;
    const int tid = fresh_tid(), lane = tid & 63, g = tid >> 6, l15 = lane & 15, quad = lane >> 4;
    const h16* GUV = (const h16*)(ws + OFF_GUV);
    const h16* WS16 = (const h16*)(ws + OFF_WS16);
    h16* YB = (h16*)(ws + OFF_R1) + 512;
    LAS float* stat = (LAS float*)(lds + 8 * 17408);
    LAS h16* vt = (LAS h16*)(lds + g * 17408);
    const size_t t0 = (size_t)n * 128;
    __syncthreads();
    for (int i = 0; i < 16; i += 4) {
        h16x8 x[4]; float s[4], v[4];
#pragma unroll
        for (int q = 0; q < 4; ++q) {
            x[q] = *(const h16x8*)(GUV + (t0 + g * 16 + i + q) * 1024 + 512 + lane * 8);
            s[q] = 0.f;
#pragma unroll
            for (int j = 0; j < 8; ++j) s[q] += (float)x[q][j];
        }
#pragma unroll
        for (int o = 32; o > 0; o >>= 1) { float t[4];
#pragma unroll
            for (int q = 0; q < 4; ++q) t[q] = __shfl_xor(s[q], o);
#pragma unroll
            for (int q = 0; q < 4; ++q) s[q] += t[q]; }
#pragma unroll
        for (int q = 0; q < 4; ++q) {
            s[q] *= (1.0f / 512.0f); v[q] = 0.f;
#pragma unroll
            for (int j = 0; j < 8; ++j) { const float d = (float)x[q][j] - s[q]; v[q] += d * d; }
        }
#pragma unroll
        for (int o = 32; o > 0; o >>= 1) { float t[4];
#pragma unroll
            for (int q = 0; q < 4; ++q) t[q] = __shfl_xor(v[q], o);
#pragma unroll
            for (int q = 0; q < 4; ++q) v[q] += t[q]; }
        if (lane == 0) {
#pragma unroll
            for (int q = 0; q < 4; ++q) { stat[(g * 16 + i + q) * 2] = s[q]; stat[(g * 16 + i + q) * 2 + 1] = rsqrtf(v[q] * (1.0f / 512.0f) + 1e-6f); }
        }
    }
    __syncthreads();
    {
        const int ch0 = (lane & 7) * 8;
        float lg[8];
#pragma unroll
        for (int j = 0; j < 8; ++j) lg[j] = p.in[I_LNG][g * 64 + ch0 + j];
#pragma unroll 8
        for (int it = 0; it < 16; ++it) {
            const int q = it * 8 + (lane >> 3);
            const h16x8 x = *(const h16x8*)(GUV + (t0 + q) * 1024 + 512 + g * 64 + ch0);
            const float mean = stat[q * 2], rstd = stat[q * 2 + 1];
#pragma unroll
            for (int j = 0; j < 8; ++j) vt[(ch0 + j) * 136 + q] = (h16)(((float)x[j] - mean) * rstd * lg[j]);
        }
    }
    asm volatile("s_waitcnt lgkmcnt(0)" ::: "memory");
    __syncthreads();
    h16x8 af[4][4];
#pragma unroll
    for (int dt = 0; dt < 4; ++dt)
#pragma unroll
        for (int ks = 0; ks < 4; ++ks) af[dt][ks] = *(const LAS h16x8*)(vt + (dt * 16 + l15) * 136 + ks * 32 + quad * 8);
    const h16* wg = WS16 + (size_t)g * 128 * 128;
#pragma unroll 2
    for (int pt = 0; pt < 8; ++pt) {
        f32x4 acc[4];
#pragma unroll
        for (int dt = 0; dt < 4; ++dt) acc[dt] = (f32x4){0.f, 0.f, 0.f, 0.f};
#pragma unroll
        for (int ks = 0; ks < 4; ++ks) {
            const h16x8 bf = *(const h16x8*)(wg + (size_t)(pt * 16 + l15) * 128 + ks * 32 + quad * 8);
#pragma unroll
            for (int dt = 0; dt < 4; ++dt) acc[dt] = __builtin_amdgcn_mfma_f32_16x16x32_f16(af[dt][ks], bf, acc[dt], 0, 0, 0);
        }
        const int pp = pt * 16 + l15;
        const float bsv = p.in[I_GMBS][g * 128 + pp];
        const size_t tok = t0 + pp;
#pragma unroll
        for (int dt = 0; dt < 4; ++dt) {
            const int ch = g * 64 + dt * 16 + quad * 4;
            const h16x4 uu = *(const h16x4*)(GUV + tok * 1024 + ch);
            h16x4 o;
#pragma unroll
            for (int j = 0; j < 4; ++j) o[j] = (h16)((float)uu[j] * (acc[dt][j] + bsv));
            *(h16x4*)(YB + tok * 1024 + ch) = o;
        }
    }
    __syncthreads();
}

__device__ __forceinline__ float row16_sum_to_lane15(float v) {
    v += __builtin_bit_cast(float, __builtin_amdgcn_update_dpp(0, __builtin_bit_cast(int, v), 0x118, 0xf, 0xf, true));
    v += __builtin_bit_cast(float, __builtin_amdgcn_update_dpp(0, __builtin_bit_cast(int, v), 0x114, 0xf, 0xf, true));
    v += __builtin_bit_cast(float, __builtin_amdgcn_update_dpp(0, __builtin_bit_cast(int, v), 0x112, 0xf, 0xf, true));
    v += __builtin_bit_cast(float, __builtin_amdgcn_update_dpp(0, __builtin_bit_cast(int, v), 0x111, 0xf, 0xf, true));
    return v;
}
__device__ __forceinline__ unsigned key16(unsigned short u) { return (u & 0x8000u) ? ((~(unsigned)u) & 0xFFFFu) : ((unsigned)u | 0x8000u); }
__device__ __forceinline__ unsigned key32(unsigned u) { return (u & 0x80000000u) ? ~u : (u | 0x80000000u); }
__device__ __forceinline__ float dot8(h16x8 a, h16x8 b, float c) {
    c = __builtin_amdgcn_fdot2((h16x2){a[0], a[1]}, (h16x2){b[0], b[1]}, c, false);
    c = __builtin_amdgcn_fdot2((h16x2){a[2], a[3]}, (h16x2){b[2], b[3]}, c, false);
    c = __builtin_amdgcn_fdot2((h16x2){a[4], a[5]}, (h16x2){b[4], b[5]}, c, false);
    c = __builtin_amdgcn_fdot2((h16x2){a[6], a[7]}, (h16x2){b[6], b[7]}, c, false);
    return c;
}
#define LDS_FENCE() asm volatile("s_waitcnt lgkmcnt(0)" ::: "memory")

__device__ void peer_phase(const Params& p, LAS unsigned char* lds, unsigned* bar, unsigned& epoch) {
    unsigned char* ws = p.ws;
    const int tid = fresh_tid(), wid = __builtin_amdgcn_readfirstlane(tid >> 6), lane = tid & 63;
    const unsigned long long lm = (1ull << lane) - 1ull;
    LAS unsigned char* wl = lds + wid * 11264;
    LAS float* s_top = (LAS float*)(wl);
    LAS int* i_top = (LAS int*)(wl + 1024);
    LAS int* ex = (LAS int*)(wl + 2048);
    LAS float* sc = (LAS float*)(wl + 2560);
    LAS int* uns_m = (LAS int*)(wl + 3072);
    LAS float* uns_g = (LAS float*)(wl + 3584);
    LAS int* cnt = (LAS int*)(wl + 4096);
    LAS int* base = (LAS int*)(wl + 4352);
    const int lead = (wid >= 4) ? 1 : 0;
    const unsigned short* SC = (const unsigned short*)(ws + OFF_SC16);
    const h16* H2 = (const h16*)(ws + OFF_R1);
    const unsigned char* U4 = ws + OFF_U8;
    const unsigned char* V8 = ws + OFF_V8;
    const float* USC = (const float*)(ws + OFF_USC);
    const float* VSC = (const float*)(ws + OFF_VSC);
    const float* mod = (const float*)(ws + OFF_MOD);
    const int grp = lane >> 4, li = lane & 15;
    for (int tg = blockIdx.x; tg < 256; tg += gridDim.x) {
        for (int it5 = 0; it5 < 5; ++it5) {
          if (it5 < 4) {
            const int round = it5;
            const size_t tok0 = (size_t)tg * 128 + wid * 16 + round * 4;
            LAS unsigned short* se = (LAS unsigned short*)(wl + 4608 + (round & 1) * 3072);
            LAS float* sw = (LAS float*)(wl + 4608 + (round & 1) * 3072 + 1024);
            for (int tt = 0; tt < 4; ++tt) {
                const size_t tok = tok0 + tt;
                cnt[lane] = 0;
                for (int L0 = 0; L0 < 16; L0 += 4) {
                    unsigned short ra[4], rb[4]; unsigned ka[4], kb[4], T[4];
#pragma unroll
                    for (int q = 0; q < 4; ++q) {
                        const unsigned short* sr = SC + tok * 2048 + (L0 + q) * 128;
                        ra[q] = sr[lane]; rb[q] = sr[64 + lane];
                        ka[q] = key16(ra[q]); kb[q] = key16(rb[q]); T[q] = 0;
                    }
                    for (int bit = 15; bit >= 0; --bit) {
#pragma unroll
                        for (int q = 0; q < 4; ++q) {
                            const unsigned cand = T[q] | (1u << bit);
                            const int cn = __popcll(__ballot(ka[q] >= cand)) + __popcll(__ballot(kb[q] >= cand));
                            T[q] = (cn >= 16) ? cand : T[q];
                        }
                    }
#pragma unroll
                    for (int q = 0; q < 4; ++q) {
                        const int L = L0 + q;
                        const int cnt_gt = __popcll(__ballot(ka[q] > T[q])) + __popcll(__ballot(kb[q] > T[q]));
                        const int need = 16 - cnt_gt;
                        const unsigned long long ea = __ballot(ka[q] == T[q]), eb = __ballot(kb[q] == T[q]);
                        const int ra_eq = __popcll(ea & lm), rb_eq = __popcll(ea) + __popcll(eb & lm);
                        const bool sa = (ka[q] > T[q]) || (ka[q] == T[q] && ra_eq < need);
                        const bool sb = (kb[q] > T[q]) || (kb[q] == T[q] && rb_eq < need);
                        const unsigned long long ma = __ballot(sa), mb = __ballot(sb);
                        const int pa = __popcll(ma & lm), pb = __popcll(ma) + __popcll(mb & lm);
                        if (sa) { s_top[L * 16 + pa] = (float)__builtin_bit_cast(h16, ra[q]); i_top[L * 16 + pa] = lane; }
                        if (sb) { s_top[L * 16 + pb] = (float)__builtin_bit_cast(h16, rb[q]); i_top[L * 16 + pb] = 64 + lane; }
                    }
                }
                LDS_FENCE();
                for (int h0 = 0; h0 < 8; h0 += 4) {
                    float cv[4][4]; unsigned kk[4][4], T[4];
#pragma unroll
                    for (int q = 0; q < 4; ++q) {
                        const int h = h0 + q;
                        const float bj = s_top[(2 * h + 1) * 16 + li];
#pragma unroll
                        for (int m = 0; m < 4; ++m) { cv[q][m] = s_top[(2 * h) * 16 + grp + 4 * m] + bj; kk[q][m] = key32(__builtin_bit_cast(unsigned, cv[q][m])); }
                        T[q] = 0;
                    }
                    for (int bit = 31; bit >= 0; --bit) {
#pragma unroll
                        for (int q = 0; q < 4; ++q) {
                            const unsigned cand = T[q] | (1u << bit);
                            int cn = 0;
#pragma unroll
                            for (int m = 0; m < 4; ++m) cn += __popcll(__ballot(kk[q][m] >= cand));
                            T[q] = (cn >= 16) ? cand : T[q];
                        }
                    }
#pragma unroll
                    for (int q = 0; q < 4; ++q) {
                        const int h = h0 + q;
                        int cnt_gt = 0;
#pragma unroll
                        for (int m = 0; m < 4; ++m) cnt_gt += __popcll(__ballot(kk[q][m] > T[q]));
                        const int need = 16 - cnt_gt;
                        int eq_before = 0, sel_before = 0;
#pragma unroll
                        for (int m = 0; m < 4; ++m) {
                            const unsigned long long em = __ballot(kk[q][m] == T[q]);
                            const int myeq = eq_before + __popcll(em & lm);
                            const bool sel = (kk[q][m] > T[q]) || (kk[q][m] == T[q] && myeq < need);
                            const unsigned long long sm = __ballot(sel);
                            const int pos = sel_before + __popcll(sm & lm);
                            if (sel) {
                                ex[h * 16 + pos] = i_top[(2 * h) * 16 + grp + 4 * m] * 128 + i_top[(2 * h + 1) * 16 + li];
                                sc[h * 16 + pos] = cv[q][m];
                            }
                            eq_before += __popcll(em); sel_before += __popcll(sm);
                        }
                    }
                }
                LDS_FENCE();
#pragma unroll
                for (int half = 0; half < 2; ++half) {
                    const int e = half * 64 + lane;
                    const float v = sc[e];
                    float mx = v;
#pragma unroll
                    for (int o = 8; o > 0; o >>= 1) mx = fmaxf(mx, __shfl_xor(mx, o));
                    const float pe = __expf(v - mx);
                    float sm = pe;
#pragma unroll
                    for (int o = 8; o > 0; o >>= 1) sm += __shfl_xor(sm, o);
                    const float gate = pe * __builtin_amdgcn_rcpf(sm);
                    const int eid = ex[e];
                    const int pos = __hip_atomic_fetch_add(cnt + (eid >> 8), 1, __ATOMIC_RELAXED, __HIP_MEMORY_SCOPE_WORKGROUP);
                    uns_m[e] = eid | (pos << 14); uns_g[e] = gate;
                }
                LDS_FENCE();
                {
                    const int c = cnt[lane];
                    int incl = c;
#pragma unroll
                    for (int o = 1; o < 64; o <<= 1) { const int v = __shfl_up(incl, o); if (lane >= o) incl += v; }
                    base[lane] = incl - c;
                    LDS_FENCE();
#pragma unroll
                    for (int i = 0; i < 2; ++i) {
                        const int rm = uns_m[i * 64 + lane]; const float rg = uns_g[i * 64 + lane];
                        const int eid = rm & 16383, pos = rm >> 14;
                        const int dst = tt * 128 + base[eid >> 8] + pos;
                        se[dst] = (unsigned short)eid; sw[dst] = rg;
                    }
                    LDS_FENCE();
                }
            }
          }
          const int round = it5 - lead;
          if (round >= 0 && round < 4) {
            const size_t tok0 = (size_t)tg * 128 + wid * 16 + round * 4;
            LAS unsigned short* se = (LAS unsigned short*)(wl + 4608 + (round & 1) * 3072);
            LAS float* sw = (LAS float*)(wl + 4608 + (round & 1) * 3072 + 1024);
            const size_t tokg = tok0 + grp;
            const LAS unsigned short* me = se + grp * 128; LAS float* mw = sw + grp * 128;
            {
                const int li = launder(tid) & 15;
                h16x8 xr[2][4];
#pragma unroll
                for (int c = 0; c < 2; ++c)
#pragma unroll
                    for (int j = 0; j < 4; ++j) xr[c][j] = *(const h16x8*)(H2 + tokg * 1024 + c * 512 + li * 32 + 8 * j);
                i32x4 ru[4][2]; float su[4], sv[4];
#define ULD(J, S_) do { const int e_ = me[(S_)]; const unsigned char* up_ = U4 + (size_t)e_ * 512 + li * 16; ru[J][0] = *(const i32x4*)up_; ru[J][1] = *(const i32x4*)(up_ + 256); { const f32x2 s2_ = *(const f32x2*)(USC + 2 * e_); su[J] = s2_.x; sv[J] = s2_.y; } } while (0)
#define UCP(J, S_) do { float d = 0.f; \
        _Pragma("unroll") for (int c = 0; c < 2; ++c) _Pragma("unroll") for (int k = 0; k < 4; ++k) { const h16x8 xv = xr[c][k]; const int w_ = ru[J][c][k]; \
            d = __builtin_amdgcn_fdot2(__builtin_amdgcn_cvt_scalef32_pk_f16_fp4(w_, 1.0f, 0), (h16x2){xv[0], xv[1]}, d, false); \
            d = __builtin_amdgcn_fdot2(__builtin_amdgcn_cvt_scalef32_pk_f16_fp4(w_, 1.0f, 1), (h16x2){xv[2], xv[3]}, d, false); \
            d = __builtin_amdgcn_fdot2(__builtin_amdgcn_cvt_scalef32_pk_f16_fp4(w_, 1.0f, 2), (h16x2){xv[4], xv[5]}, d, false); \
            d = __builtin_amdgcn_fdot2(__builtin_amdgcn_cvt_scalef32_pk_f16_fp4(w_, 1.0f, 3), (h16x2){xv[6], xv[7]}, d, false); } \
        d = row16_sum_to_lane15(d); \
        const float wt_ = mw[(S_)] * gelu_tanh(d * su[J]) * sv[J]; if (li == 15) mw[(S_)] = wt_; } while (0)
                ULD(0, 0); ULD(1, 1); ULD(2, 2); ULD(3, 3);
#pragma unroll 1
                for (int s = 0; s < 128; s += 4) {
                    UCP(0, s);     if (s + 4 < 128) ULD(0, s + 4);
                    UCP(1, s + 1); if (s + 5 < 128) ULD(1, s + 5);
                    UCP(2, s + 2); if (s + 6 < 128) ULD(2, s + 6);
                    UCP(3, s + 3); if (s + 7 < 128) ULD(3, s + 7);
                }
#undef ULD
#undef UCP
            }
            LDS_FENCE();
            {
                const int li = launder(tid) & 15;
                float acc[64];
#pragma unroll
                for (int i = 0; i < 64; ++i) acc[i] = 0.f;
                i32x4 rv[4][4];
#define VLD(J, S_) do { const int e_ = me[(S_)]; const unsigned char* vp_ = V8 + (size_t)e_ * 1024 + li * 16; \
        _Pragma("unroll") for (int c = 0; c < 4; ++c) rv[J][c] = *(const i32x4*)(vp_ + c * 256); } while (0)
#define VCP(J, S_) do { const float wt_ = mw[(S_)]; \
        _Pragma("unroll") for (int c = 0; c < 4; ++c) _Pragma("unroll") for (int k = 0; k < 4; ++k) { \
            const f32x2 lo = __builtin_amdgcn_cvt_pk_f32_fp8(rv[J][c][k], false), hi = __builtin_amdgcn_cvt_pk_f32_fp8(rv[J][c][k], true); \
            acc[c * 16 + 4 * k] += wt_ * lo.x; acc[c * 16 + 4 * k + 1] += wt_ * lo.y; acc[c * 16 + 4 * k + 2] += wt_ * hi.x; acc[c * 16 + 4 * k + 3] += wt_ * hi.y; } } while (0)
                VLD(0, 0); VLD(1, 1); VLD(2, 2); VLD(3, 3);
#pragma unroll 1
                for (int s = 0; s < 128; s += 4) {
                    VCP(0, s);     if (s + 4 < 128) VLD(0, s + 4);
                    VCP(1, s + 1); if (s + 5 < 128) VLD(1, s + 5);
                    VCP(2, s + 2); if (s + 6 < 128) VLD(2, s + 6);
                    VCP(3, s + 3); if (s + 7 < 128) VLD(3, s + 7);
                }
#undef VLD
#undef VCP
                float* xo = p.out + tokg * 1024 + li * 16;
                const int b = (int)(tokg >> 11);
                const float* g2 = mod + (size_t)b * 6144 + 5 * 1024 + li * 16;
                const float* fg = p.in[I_FG] + li * 16;
                float ss = 0.f;
#pragma unroll
                for (int c = 0; c < 4; ++c) {
#pragma unroll
                    for (int q4 = 0; q4 < 4; ++q4) {
                        const f32x4 xv = *(const f32x4*)(xo + c * 256 + q4 * 4), gv = *(const f32x4*)(g2 + c * 256 + q4 * 4);
#pragma unroll
                        for (int j = 0; j < 4; ++j) { const float t = xv[j] + gv[j] * acc[c * 16 + q4 * 4 + j]; acc[c * 16 + q4 * 4 + j] = t; ss += t * t; }
                    }
                    asm volatile("" : "+v"(ss) :: "memory");
                }
#pragma unroll
                for (int o = 8; o > 0; o >>= 1) ss += __shfl_xor(ss, o);
                const float r = rsqrtf(ss * (1.0f / 1024.0f) + 1e-6f);
#pragma unroll
                for (int c = 0; c < 4; ++c) {
#pragma unroll
                    for (int q4 = 0; q4 < 4; ++q4) {
                        const f32x4 fv = *(const f32x4*)(fg + c * 256 + q4 * 4);
                        f32x4 ov;
#pragma unroll
                        for (int j = 0; j < 4; ++j) ov[j] = acc[c * 16 + q4 * 4 + j] * r * fv[j];
                        *(f32x4*)(xo + c * 256 + q4 * 4) = ov;
                    }
                    asm volatile("" ::: "memory");
                }
            }
            LDS_FENCE();
          }
        }
    }
}

__global__ void __launch_bounds__(512, 2) mega(Params p) {
    extern __shared__ __attribute__((aligned(16))) unsigned char shm[];
    LAS unsigned char* lds = (LAS unsigned char*)shm;
    cg::grid_group grid = cg::this_grid();
    unsigned char* ws = p.ws;
    const int G = (int)gridDim.x, c = (int)blockIdx.x;
    unsigned* bar = (unsigned*)(ws + OFF_BAR); unsigned epoch = 0;

    if (p.ws == nullptr) grid.sync();
    phase0(p, (float*)shm);
    grid_bar(bar, epoch, (unsigned)G);
    phase1(p, (float*)shm);
    grid_bar(bar, epoch, (unsigned)G);
    {
        pg8::StaticOrder S; S.init(NTOK, INC, G, c);
        pg8::Gemm g{ws + OFF_R1, ws + OFF_WINT, 1024, 1024, NTOK, INC, 1024, 0};
        EpiIn E{(h16*)(ws + OFF_QB), (h16*)(ws + OFF_KB), (h16*)(ws + OFF_VT), (h16*)(ws + OFF_GUV), (h16*)(ws + OFF_GATES)};
        pg8::gemm_phase(lds, g, S, E);
        pg8::StaticOrder S2; S2.init(NCTXT, 1024, G, c);
        pg8::Gemm g2{ws + OFF_HC, ws + OFF_WINT + (size_t)512 * 1024 * 2, 1024, 1024, NCTXT, 1024, 1024, 0};
        EpiCtx E2{(h16*)(ws + OFF_KC), (h16*)(ws + OFF_VCT)};
        pg8::gemm_phase(lds, g2, S2, E2);
    }
    grid_bar(bar, epoch, (unsigned)G);
    {
        for (int rep3 = 0; rep3 < REP_P3; ++rep3) {
        for (int u = c; u < 512; u += G) attn_unit(p, u);
        for (int n = c; n < 256; n += G) sgu_unit(p, n, lds);
        }
    }
    grid_bar(bar, epoch, (unsigned)G);
    {
        pg8::StaticOrder S; S.init(NTOK, 1024, G, c);
        pg8::Gemm ga{ws + OFF_R1, ws + OFF_WPAT, 1024, 512, NTOK, 1024, 512, 0};
        EpiM1 E1{(h16*)(ws + OFF_M1), (const h16*)(ws + OFF_GATES)};
        pg8::gemm_phase(lds, ga, S, E1);
        pg8::Gemm gb{ws + OFF_R1 + 1024, ws + OFF_WPBT, 1024, 512, NTOK, 1024, 512, 0};
        EpiM2 E2{(const h16*)(ws + OFF_M1), (const h16*)(ws + OFF_GATES), (h16*)(ws + OFF_MM)};
        pg8::gemm_phase(lds, gb, S, E2);
    }
    grid_bar(bar, epoch, (unsigned)G);
    {
        pg8::StaticOrder S; S.init(NTOK, 1024, G, c);
        pg8::Gemm g{ws + OFF_MM, ws + OFF_WOUTT, 1024, 1024, NTOK, 1024, 1024, 0};
        EpiX1 E{p.in[I_X], (const float*)(ws + OFF_MOD), p.out};
        pg8::gemm_phase(lds, g, S, E);
    }
    grid_bar(bar, epoch, (unsigned)G);
    phase6(p, (float*)shm);
    grid_bar(bar, epoch, (unsigned)G);
    {
        pg8::StaticOrder S; S.init(NTOK, 2048, G, c);
        pg8::Gemm g{ws + OFF_R1, ws + OFF_WQT, 1024, 1024, NTOK, 2048, 1024, 0};
        EpiH16 E{(h16*)(ws + OFF_SC16), 2048};
        pg8::gemm_phase(lds, g, S, E);
    }
    grid_bar(bar, epoch, (unsigned)G);
    peer_phase(p, lds, bar, epoch);
}

extern "C" void kernel_launch(void* const* d_in, const int* in_sizes, int n_in, void* d_out, int out_size, void* d_ws, size_t ws_size, hipStream_t stream) {
    static int grid_blocks = 0;
    if (!grid_blocks) {
        int dev = 0, cus = 0, per_cu = 0;
        hipGetDevice(&dev);
        hipDeviceGetAttribute(&cus, hipDeviceAttributeMultiprocessorCount, dev);
        hipFuncSetAttribute((const void*)mega, hipFuncAttributeMaxDynamicSharedMemorySize, LDS_BYTES);
        hipOccupancyMaxActiveBlocksPerMultiprocessor(&per_cu, (const void*)mega, 512, LDS_BYTES);
        if (per_cu < 1) per_cu = 1;
        grid_blocks = cus * per_cu;
        if (ws_size < WS_END) fprintf(stderr, "kernel_launch: workspace too small: %zu < %zu\n", ws_size, (size_t)WS_END);
    }
    hipMemsetAsync((unsigned char*)d_ws + OFF_BAR, 0, 256, stream);
    Params p{};
    for (int i = 0; i < 21; ++i) p.in[i] = (const float*)d_in[i];
    p.out = (float*)d_out; p.ws = (unsigned char*)d_ws;
    void* args[] = {&p};
    hipError_t e = hipLaunchCooperativeKernel((const void*)mega, dim3(grid_blocks), dim3(512), args, LDS_BYTES, stream);
    if (e != hipSuccess) fprintf(stderr, "cooperative launch failed: %s (grid %d)\n", hipGetErrorString(e), grid_blocks);
}
```

```cpp
#include <hip/hip_runtime.h>
#include <hip/hip_cooperative_groups.h>
#include <cstdio>
namespace cg = cooperative_groups;

#define LAS __attribute__((address_space(3)))
typedef _Float16 h16;
typedef _Float16 h16x2 __attribute__((ext_vector_type(2)));
typedef _Float16 h16x4 __attribute__((ext_vector_type(4)));
typedef _Float16 h16x8 __attribute__((ext_vector_type(8)));
typedef float f32x4 __attribute__((ext_vector_type(4)));
typedef float f32x2 __attribute__((ext_vector_type(2)));
typedef int i32x4 __attribute__((ext_vector_type(4)));
typedef int i32x2 __attribute__((ext_vector_type(2)));

constexpr int NTOK = 32768, DM = 1024, NCTXT = 4096, INC = 4608, SEQ = 2048, CTXL = 256;
constexpr int LDS_BYTES = 144 * 1024;
#ifndef REP_SEL
#define REP_SEL 1
#endif
#ifndef REP_GATH
#define REP_GATH 1
#endif
#ifndef REP_P3
#define REP_P3 1
#endif

constexpr size_t al256(size_t x) { return (x + 255) & ~(size_t)255; }
constexpr size_t OFF_WINT = 0;
constexpr size_t OFF_WPAT = OFF_WINT + (size_t)INC * DM * 2;
constexpr size_t OFF_WPBT = OFF_WPAT + (size_t)1024 * 512 * 2;
constexpr size_t OFF_WOUTT = OFF_WPBT + (size_t)1024 * 512 * 2;
constexpr size_t OFF_WQT = OFF_WOUTT + (size_t)1024 * 1024 * 2;
constexpr size_t OFF_BD = OFF_WQT + (size_t)2048 * 1024 * 2;
constexpr size_t OFF_U16 = OFF_BD + (size_t)2048 * 256 * 2;
constexpr size_t OFF_V16 = OFF_U16 + (size_t)16384 * 1024 * 2;
constexpr size_t OFF_WS16 = OFF_V16 + (size_t)16384 * 1024 * 2;
constexpr size_t OFF_MODP = OFF_WS16 + (size_t)8 * 128 * 128 * 2;
constexpr size_t OFF_MOD = OFF_MODP + (size_t)16 * 17 * 6144 * 4;
constexpr size_t OFF_R1 = al256(OFF_MOD + (size_t)17 * 6144 * 4);
constexpr size_t OFF_QB = OFF_R1 + (size_t)NTOK * DM * 2;
constexpr size_t OFF_KB = OFF_QB + (size_t)NTOK * 512 * 2;
constexpr size_t OFF_VT = OFF_KB + (size_t)NTOK * 512 * 2;
constexpr size_t OFF_GUV = OFF_VT + (size_t)NTOK * 512 * 2;
constexpr size_t OFF_GATES = OFF_GUV + (size_t)NTOK * 1024 * 2;
constexpr size_t OFF_MM = OFF_GATES + (size_t)NTOK * 2048 * 2;
constexpr size_t OFF_BAR = OFF_MM + (size_t)NTOK * DM * 2;
constexpr size_t WS_END = OFF_BAR + 256;
constexpr size_t OFF_U8 = OFF_U16;
constexpr size_t OFF_USC = OFF_U16 + (size_t)16384 * 1024;
constexpr size_t OFF_V8 = OFF_V16;
constexpr size_t OFF_VSC = OFF_V16 + (size_t)16384 * 1024;
constexpr size_t OFF_M1 = OFF_QB;
constexpr size_t OFF_SC16 = OFF_QB;
constexpr size_t OFF_Q16 = OFF_GATES;
constexpr size_t OFF_HC = OFF_MM;
constexpr size_t OFF_KC = OFF_HC + (size_t)NCTXT * DM * 2;
constexpr size_t OFF_VCT = OFF_KC + (size_t)NCTXT * 512 * 2;
static_assert(OFF_M1 + (size_t)NTOK * DM * 4 <= OFF_GATES, "m1 alias");
static_assert(WS_END <= (size_t)512 * 1024 * 1024, "workspace");

struct Params {
    const float* in[21];
    float* out;
    unsigned char* ws;
};
enum { I_X = 0, I_C, I_CTX, I_CCTX, I_ADAW, I_ADAB, I_N1G, I_N2G, I_WIN, I_RPB, I_LNG, I_GMWS, I_GMBS, I_WPA, I_WPB, I_WOUT, I_WQ, I_KEYS, I_PU, I_PV, I_FG };

__device__ __forceinline__ int launder(int x) { asm volatile("" : "+v"(x)); return x; }
__device__ __forceinline__ int fresh_tid() { int t = threadIdx.x; asm volatile("" : "+v"(t)); return t; }

__device__ __forceinline__ float sigmoidf_(float x) { return __builtin_amdgcn_rcpf(1.0f + __expf(-x)); }
__device__ __forceinline__ float gelu_tanh(float x) {
    const float t = 0.7978845608028654f * (x + 0.044715f * x * x * x);
    return x * __builtin_amdgcn_rcpf(1.0f + __expf(-2.0f * t));
}
__device__ __forceinline__ float silu_(float x) { return x * __builtin_amdgcn_rcpf(1.0f + __expf(-x)); }
__device__ __forceinline__ float wave_sum(float v) {
#pragma unroll
    for (int o = 32; o > 0; o >>= 1) v += __shfl_xor(v, o);
    return v;
}
__device__ __forceinline__ h16x8 pack8(f32x4 a, f32x4 b) {
    h16x8 o;
    o[0] = (h16)a[0]; o[1] = (h16)a[1]; o[2] = (h16)a[2]; o[3] = (h16)a[3];
    o[4] = (h16)b[0]; o[5] = (h16)b[1]; o[6] = (h16)b[2]; o[7] = (h16)b[3];
    return o;
}


__device__ __forceinline__ void grid_bar(unsigned* ctr, unsigned& epoch, unsigned nblk) {
    __syncthreads();
    epoch += 1u;
    if (threadIdx.x == 0) {
        __builtin_amdgcn_fence(__ATOMIC_RELEASE, "agent");
        asm volatile("s_waitcnt vmcnt(0)" ::: "memory");
        __hip_atomic_fetch_add(ctr, 1u, __ATOMIC_RELAXED, __HIP_MEMORY_SCOPE_AGENT);
        const unsigned target = epoch * nblk;
        unsigned spins = 0;
        while (__hip_atomic_load(ctr, __ATOMIC_RELAXED, __HIP_MEMORY_SCOPE_AGENT) < target) { __builtin_amdgcn_s_sleep(2); if (++spins > (1u << 24)) break; }
        __builtin_amdgcn_fence(__ATOMIC_ACQUIRE, "agent");
        asm volatile("s_waitcnt vmcnt(0)" ::: "memory");
    }
    __syncthreads();
}

namespace pg8 {
constexpr int BM = 256, BK = 64, HALF = 128, HTB = HALF * BK * 2, STAGE_BYTES = 8 * HTB, NXCD = 8, WGM = 8;
__device__ __forceinline__ int lds_byte(int r, int c) { const int st = (r >> 4) * 2 + (c >> 5), rr = r & 15, cc = c & 31, ob = rr * 64 + cc * 2; return st * 1024 + (ob ^ (((ob >> 9) & 1) << 5)); }
__device__ __forceinline__ void stage_rc(int b, int& R, int& C) { const int st = b / 1024, sb = b % 1024, swz = sb ^ (((sb >> 9) & 1) << 5); R = (st >> 1) * 16 + swz / 64; C = (st & 1) * 32 + (swz % 64) / 2; }
__device__ __forceinline__ int perm32(int rho) { const int n = rho >> 4, i = rho & 15; return 8 * (i >> 2) + 4 * n + (i & 3); }

struct Unit { int pm, pn; };
struct Gemm { const void* A; const void* Bt; int lda, ldb, M, N, K, a_pn_bytes; };

struct StaticOrder {
    int nM, nN, nwg, G, c;
    __device__ void init(int M, int N, int G_, int c_) { nM = M / BM; nN = N / BM; nwg = nM * nN; G = G_; c = c_; }
    __device__ bool next(int i, Unit& u) const {
        const long L = (long)i * G + c; if (L >= nwg) return false;
        int wgid = (int)L; { const int q = nwg / NXCD, r = nwg % NXCD, xcd = wgid % NXCD, off = wgid / NXCD; wgid = (xcd < r ? xcd * (q + 1) : r * (q + 1) + (xcd - r) * q) + off; }
        const int nig = WGM * nN, gid = wgid / nig, fm = gid * WGM, gsz = (nM - fm) < WGM ? (nM - fm) : WGM;
        u.pm = fm + ((wgid % nig) % gsz); u.pn = (wgid % nig) / gsz; return true;
    }
};

template <class Epi>
__device__ __forceinline__ void gemm_phase(LAS unsigned char* lds, const Gemm g, const StaticOrder& S, const Epi& E) {
    const int tid = fresh_tid(), wid = __builtin_amdgcn_readfirstlane(tid >> 6), lane = tid & 63, wr = wid >> 2, wc = wid & 3, fr = lane & 15, fq = lane >> 4;
    const int K = g.K, nt = K / BK;
    unsigned voffA[2], voffB[2];
#pragma unroll
    for (int i = 0; i < 2; ++i) { int R, C; stage_rc(tid * 16 + i * 8192, R, C); const int Rb = (R & ~31) + perm32(R & 31);
        voffA[i] = (unsigned)(R * g.lda + C) * 2u; voffB[i] = (unsigned)(Rb * g.ldb + C) * 2u; }
    const size_t kstep = (size_t)(BK * 2);
    const size_t hstepA = (size_t)HALF * g.lda * 2, hstepB = (size_t)HALF * g.ldb * 2;
    const size_t tstepA = 2 * hstepA, tstepB = 2 * hstepB;
    const unsigned ldsw = (unsigned)wid * 1024u;
    const int aoff = lds_byte(wr * 64 + fr, fq * 8), boff = lds_byte(wc * 32 + fr, fq * 8);
#define PG8_SA(b, h) (((b) * 2 + (h)) * HTB)
#define PG8_SB(b, h) ((4 + (b) * 2 + (h)) * HTB)
#define PG8_STAGE(bufoff, gbase, voff) do { _Pragma("unroll") for (int _i = 0; _i < 2; ++_i) \
        __builtin_amdgcn_global_load_lds((const unsigned*)((const char*)(gbase) + (voff)[_i]), (LAS unsigned*)(lds + (bufoff) + ldsw + _i * 8192), 16, 0, 0); } while (0)
#define PG8_LDA(dst, b, h) do { _Pragma("unroll") for (int m = 0; m < 4; ++m) _Pragma("unroll") for (int k = 0; k < 2; ++k) dst[m][k] = *(const LAS h16x8*)(lds + PG8_SA(b, h) + aoff + m * 2048 + k * 1024); } while (0)
#define PG8_LDB(dst, b, h) do { _Pragma("unroll") for (int n = 0; n < 2; ++n) _Pragma("unroll") for (int k = 0; k < 2; ++k) dst[n][k] = *(const LAS h16x8*)(lds + PG8_SB(b, h) + boff + n * 2048 + k * 1024); } while (0)
#define PG8_MMA(ai, bj, At, Bt) do { __builtin_amdgcn_s_setprio(1); _Pragma("unroll") for (int m = 0; m < 4; ++m) _Pragma("unroll") for (int n = 0; n < 2; ++n) _Pragma("unroll") for (int k = 0; k < 2; ++k) \
        acc[ai][bj][m][n] = __builtin_amdgcn_mfma_f32_16x16x32_f16(Bt[n][k], At[m][k], acc[ai][bj][m][n], 0, 0, 0); __builtin_amdgcn_s_setprio(0); } while (0)
#define PG8_WAIT_V(n) asm volatile("s_waitcnt vmcnt(" #n ")" ::: "memory")
#define PG8_WAIT_L(n) asm volatile("s_waitcnt lgkmcnt(" #n ")" ::: "memory")
#define PG8_BAR __builtin_amdgcn_s_barrier()
#define PG8_SCHED __builtin_amdgcn_sched_barrier(0)
    Unit cur, nxt; int ui = 0;
    if (!S.next(0, cur)) return;
    f32x4 acc[2][2][4][2];
#pragma unroll
    for (int a = 0; a < 2; ++a)
#pragma unroll
        for (int b = 0; b < 2; ++b)
#pragma unroll
            for (int m = 0; m < 4; ++m)
#pragma unroll
                for (int n = 0; n < 2; ++n) acc[a][b][m][n] = (f32x4){0.f, 0.f, 0.f, 0.f};
    h16x8 At[4][2], B0[2][2], B1[2][2];
    const char* cA = (const char*)g.A + (size_t)cur.pm * tstepA + (size_t)cur.pn * g.a_pn_bytes; const char* cB = (const char*)g.Bt + (size_t)cur.pn * tstepB;
    PG8_STAGE(PG8_SB(0, 0), cB, voffB); PG8_STAGE(PG8_SA(0, 0), cA, voffA); PG8_STAGE(PG8_SB(0, 1), cB + hstepB, voffB); PG8_STAGE(PG8_SA(0, 1), cA + hstepA, voffA);
    if (wr == 1) PG8_BAR;
    PG8_WAIT_V(4); PG8_BAR;
    PG8_STAGE(PG8_SB(1, 0), cB + kstep, voffB); PG8_STAGE(PG8_SA(1, 0), cA + kstep, voffA); PG8_STAGE(PG8_SB(1, 1), cB + hstepB + kstep, voffB);
    PG8_WAIT_V(6); PG8_BAR;
    for (;;) {
        const bool has_next = S.next(ui + 1, nxt);
        const char* nA = has_next ? (const char*)g.A + (size_t)nxt.pm * tstepA + (size_t)nxt.pn * g.a_pn_bytes : cA; const char* nB = has_next ? (const char*)g.Bt + (size_t)nxt.pn * tstepB : cB;
        for (int t = 0; t < nt; t += 2) {
            const bool last = (t == nt - 2);
            const char* a1 = cA + (size_t)(t + 1) * kstep;
            const char* a2 = last ? nA : cA + (size_t)(t + 2) * kstep; const char* b2 = last ? nB : cB + (size_t)(t + 2) * kstep;
            const char* a3 = a2 + kstep; const char* b3 = b2 + kstep;
            PG8_LDB(B0, 0, 0); PG8_SCHED; PG8_LDA(At, 0, 0); PG8_STAGE(PG8_SA(1, 1), a1 + hstepA, voffA);
            PG8_WAIT_L(8); PG8_BAR; PG8_WAIT_L(0); PG8_MMA(0, 0, At, B0); PG8_BAR; PG8_SCHED;
            PG8_LDB(B1, 0, 1); PG8_STAGE(PG8_SB(0, 0), b2, voffB);
            PG8_BAR; PG8_WAIT_L(0); PG8_MMA(0, 1, At, B1); PG8_BAR;
            PG8_LDA(At, 0, 1); PG8_STAGE(PG8_SA(0, 0), a2, voffA);
            PG8_BAR; PG8_WAIT_L(0); PG8_MMA(1, 0, At, B0); PG8_BAR; PG8_SCHED;
            PG8_STAGE(PG8_SB(0, 1), b2 + hstepB, voffB);
            PG8_WAIT_V(6); PG8_BAR; PG8_MMA(1, 1, At, B1); PG8_BAR;
            PG8_LDB(B0, 1, 0); PG8_SCHED; PG8_LDA(At, 1, 0); PG8_STAGE(PG8_SA(0, 1), a2 + hstepA, voffA);
            PG8_WAIT_L(8); PG8_BAR; PG8_WAIT_L(0); PG8_MMA(0, 0, At, B0); PG8_BAR; PG8_SCHED;
            PG8_LDB(B1, 1, 1); PG8_STAGE(PG8_SB(1, 0), b3, voffB);
            PG8_BAR; PG8_WAIT_L(0); PG8_MMA(0, 1, At, B1); PG8_BAR;
            PG8_LDA(At, 1, 1); PG8_STAGE(PG8_SA(1, 0), a3, voffA);
            PG8_BAR; PG8_WAIT_L(0); PG8_MMA(1, 0, At, B0); PG8_BAR; PG8_SCHED;
            PG8_STAGE(PG8_SB(1, 1), b3 + hstepB, voffB);
            PG8_WAIT_V(6); PG8_BAR; PG8_MMA(1, 1, At, B1); PG8_BAR;
        }
        E(acc, cur, wr, wc, fr, fq);
        if (!has_next) break;
#pragma unroll
        for (int a = 0; a < 2; ++a)
#pragma unroll
            for (int b = 0; b < 2; ++b)
#pragma unroll
                for (int m = 0; m < 4; ++m)
#pragma unroll
                    for (int n = 0; n < 2; ++n) acc[a][b][m][n] = (f32x4){0.f, 0.f, 0.f, 0.f};
        cur = nxt; cA = nA; cB = nB; ++ui;
    }
    PG8_WAIT_V(0);
    if (wr == 0) PG8_BAR;
    PG8_BAR;
#undef PG8_SA
#undef PG8_SB
#undef PG8_STAGE
#undef PG8_LDA
#undef PG8_LDB
#undef PG8_MMA
#undef PG8_WAIT_V
#undef PG8_WAIT_L
#undef PG8_BAR
#undef PG8_SCHED
}
}
typedef f32x4 AccT[2][2][4][2];

struct EpiIn {
    h16 *qb, *kb, *vt, *guv, *gates;
    __device__ __forceinline__ void operator()(const AccT& acc, const pg8::Unit& u, int wr, int wc, int fr, int fq) const {
        const int pn = u.pn;
        const int row0 = u.pm * 256 + wr * 64 + fr;
        const int cin = wc * 32 + 8 * fq;
        const int b = (u.pm * 256) >> 11, sb = ((u.pm * 256) & 2047) + wr * 64;
        if (pn < 2) {
            h16* base = qb + (size_t)row0 * 512 + pn * 256 + cin;
#pragma unroll
            for (int ai = 0; ai < 2; ++ai)
#pragma unroll
                for (int m = 0; m < 4; ++m)
#pragma unroll
                    for (int bj = 0; bj < 2; ++bj) *(h16x8*)(base + (ai * 128 + m * 16) * 512 + bj * 128) = pack8(acc[ai][bj][m][0], acc[ai][bj][m][1]);
        } else if (pn < 4) {
#pragma unroll
            for (int bj = 0; bj < 2; ++bj) {
                const int col = (pn & 1) * 256 + bj * 128 + cin, hd = col >> 6, d0 = col & 63;
                h16* base = kb + ((size_t)(b * 8 + hd) * 2048 + sb + fr) * 64 + d0;
#pragma unroll
                for (int ai = 0; ai < 2; ++ai)
#pragma unroll
                    for (int m = 0; m < 4; ++m) *(h16x8*)(base + (ai * 128 + m * 16) * 64) = pack8(acc[ai][bj][m][0], acc[ai][bj][m][1]);
            }
        } else if (pn < 6) {
#pragma unroll
            for (int bj = 0; bj < 2; ++bj) {
                const int cv = (pn - 4) * 256 + bj * 128 + cin, hd = cv >> 6, d0 = cv & 63;
                h16* base = vt + ((size_t)(b * 8 + hd) * 256 + (sb >> 3) + (fr >> 3)) * 512 + d0 * 8 + (fr & 7);
#pragma unroll
                for (int ai = 0; ai < 2; ++ai)
#pragma unroll
                    for (int m = 0; m < 4; ++m) {
                        h16* vp = base + (ai * 16 + m * 2) * 512;
                        const f32x4 v0 = acc[ai][bj][m][0], v1 = acc[ai][bj][m][1];
#pragma unroll
                        for (int i = 0; i < 4; ++i) { vp[i * 8] = (h16)v0[i]; vp[(i + 4) * 8] = (h16)v1[i]; }
                    }
            }
        } else if (pn < 10) {
            h16* base = guv + (size_t)row0 * 1024 + (pn - 6) * 256 + cin;
#pragma unroll
            for (int ai = 0; ai < 2; ++ai)
#pragma unroll
                for (int m = 0; m < 4; ++m)
#pragma unroll
                    for (int bj = 0; bj < 2; ++bj) {
                        f32x4 v0 = acc[ai][bj][m][0], v1 = acc[ai][bj][m][1];
#pragma unroll
                        for (int i = 0; i < 4; ++i) { v0[i] = gelu_tanh(v0[i]); v1[i] = gelu_tanh(v1[i]); }
                        *(h16x8*)(base + (ai * 128 + m * 16) * 1024 + bj * 128) = pack8(v0, v1);
                    }
        } else {
            h16* base = gates + (size_t)row0 * 2048 + (pn - 10) * 256 + cin;
#pragma unroll
            for (int ai = 0; ai < 2; ++ai)
#pragma unroll
                for (int m = 0; m < 4; ++m)
#pragma unroll
                    for (int bj = 0; bj < 2; ++bj) {
                        f32x4 v0 = acc[ai][bj][m][0], v1 = acc[ai][bj][m][1];
#pragma unroll
                        for (int i = 0; i < 4; ++i) { v0[i] = sigmoidf_(v0[i]); v1[i] = sigmoidf_(v1[i]); }
                        *(h16x8*)(base + (ai * 128 + m * 16) * 2048 + bj * 128) = pack8(v0, v1);
                    }
        }
    }
};
struct EpiCtx {
    h16 *kc, *vct;
    __device__ __forceinline__ void operator()(const AccT& acc, const pg8::Unit& u, int wr, int wc, int fr, int fq) const {
        const int pn = u.pn;
        const int cin = wc * 32 + 8 * fq;
        const int b = u.pm, sb = wr * 64;
        if (pn < 2) {
#pragma unroll
            for (int bj = 0; bj < 2; ++bj) {
                const int col = pn * 256 + bj * 128 + cin, hd = col >> 6, d0 = col & 63;
                h16* base = kc + ((size_t)(b * 8 + hd) * 256 + sb + fr) * 64 + d0;
#pragma unroll
                for (int ai = 0; ai < 2; ++ai)
#pragma unroll
                    for (int m = 0; m < 4; ++m) *(h16x8*)(base + (ai * 128 + m * 16) * 64) = pack8(acc[ai][bj][m][0], acc[ai][bj][m][1]);
            }
        } else {
#pragma unroll
            for (int bj = 0; bj < 2; ++bj) {
                const int cv = (pn - 2) * 256 + bj * 128 + cin, hd = cv >> 6, d0 = cv & 63;
                h16* base = vct + ((size_t)(b * 8 + hd) * 32 + (sb >> 3) + (fr >> 3)) * 512 + d0 * 8 + (fr & 7);
#pragma unroll
                for (int ai = 0; ai < 2; ++ai)
#pragma unroll
                    for (int m = 0; m < 4; ++m) {
                        h16* vp = base + (ai * 16 + m * 2) * 512;
                        const f32x4 v0 = acc[ai][bj][m][0], v1 = acc[ai][bj][m][1];
#pragma unroll
                        for (int i = 0; i < 4; ++i) { vp[i * 8] = (h16)v0[i]; vp[(i + 4) * 8] = (h16)v1[i]; }
                    }
            }
        }
    }
};
struct EpiM1 {
    h16* m1; const h16* gates;
    __device__ __forceinline__ void operator()(const AccT& acc, const pg8::Unit& u, int wr, int wc, int fr, int fq) const {
        const int row0 = u.pm * 256 + wr * 64 + fr, col0 = u.pn * 256 + wc * 32 + 8 * fq;
#pragma unroll
        for (int ai = 0; ai < 2; ++ai)
#pragma unroll
            for (int m = 0; m < 4; ++m) {
                const int row = row0 + ai * 128 + m * 16;
#pragma unroll
                for (int bj = 0; bj < 2; ++bj) {
                    const int col = col0 + bj * 128;
                    const h16x8 gt = *(const h16x8*)(gates + (size_t)row * 2048 + col);
                    f32x4 v0 = acc[ai][bj][m][0], v1 = acc[ai][bj][m][1];
#pragma unroll
                    for (int i = 0; i < 4; ++i) { v0[i] *= (float)gt[i]; v1[i] *= (float)gt[4 + i]; }
                    *(h16x8*)(m1 + (size_t)row * 1024 + col) = pack8(v0, v1);
                }
            }
    }
};
struct EpiM2 {
    const h16* m1; const h16* gates; h16* mm;
    __device__ __forceinline__ void operator()(const AccT& acc, const pg8::Unit& u, int wr, int wc, int fr, int fq) const {
        const int row0 = u.pm * 256 + wr * 64 + fr, col0 = u.pn * 256 + wc * 32 + 8 * fq;
#pragma unroll
        for (int ai = 0; ai < 2; ++ai)
#pragma unroll
            for (int m = 0; m < 4; ++m) {
                const int row = row0 + ai * 128 + m * 16;
#pragma unroll
                for (int bj = 0; bj < 2; ++bj) {
                    const int col = col0 + bj * 128;
                    const h16x8 gt = *(const h16x8*)(gates + (size_t)row * 2048 + 1024 + col);
                    const h16x8 mi = *(const h16x8*)(m1 + (size_t)row * 1024 + col);
                    f32x4 p0 = (f32x4){(float)mi[0], (float)mi[1], (float)mi[2], (float)mi[3]}, p1 = (f32x4){(float)mi[4], (float)mi[5], (float)mi[6], (float)mi[7]};
                    const f32x4 v0 = acc[ai][bj][m][0], v1 = acc[ai][bj][m][1];
#pragma unroll
                    for (int i = 0; i < 4; ++i) { p0[i] += v0[i] * (float)gt[i]; p1[i] += v1[i] * (float)gt[4 + i]; }
                    *(h16x8*)(mm + (size_t)row * 1024 + col) = pack8(p0, p1);
                }
            }
    }
};
struct EpiX1 {
    const float* x; const float* mod; float* x1;
    __device__ __forceinline__ void operator()(const AccT& acc, const pg8::Unit& u, int wr, int wc, int fr, int fq) const {
        const int row0 = u.pm * 256 + wr * 64 + fr, col0 = u.pn * 256 + wc * 32 + 8 * fq;
        const int b = (u.pm * 256) >> 11;
#pragma unroll
        for (int bj = 0; bj < 2; ++bj) {
            const int col = col0 + bj * 128;
            const float* gp = mod + (size_t)b * 6144 + 2 * 1024 + col;
            const f32x4 g0 = *(const f32x4*)gp, g1 = *(const f32x4*)(gp + 4);
#pragma unroll
            for (int ai = 0; ai < 2; ++ai)
#pragma unroll
                for (int m = 0; m < 4; ++m) {
                    const int row = row0 + ai * 128 + m * 16;
                    const float* xi = x + (size_t)row * 1024 + col;
                    const f32x4 x0 = *(const f32x4*)xi, x1v = *(const f32x4*)(xi + 4);
                    float* o = x1 + (size_t)row * 1024 + col;
                    *(f32x4*)o = x0 + g0 * acc[ai][bj][m][0]; *(f32x4*)(o + 4) = x1v + g1 * acc[ai][bj][m][1];
                }
        }
    }
};
struct EpiH16 {
    h16* o; int ldc;
    __device__ __forceinline__ void operator()(const AccT& acc, const pg8::Unit& u, int wr, int wc, int fr, int fq) const {
        const int row0 = u.pm * 256 + wr * 64 + fr, col0 = u.pn * 256 + wc * 32 + 8 * fq;
#pragma unroll
        for (int ai = 0; ai < 2; ++ai)
#pragma unroll
            for (int m = 0; m < 4; ++m) {
                const int row = row0 + ai * 128 + m * 16;
#pragma unroll
                for (int bj = 0; bj < 2; ++bj)
                    *(h16x8*)(o + (size_t)row * ldc + col0 + bj * 128) = pack8(acc[ai][bj][m][0], acc[ai][bj][m][1]);
            }
    }
};

__device__ __forceinline__ void cvt_tile(const float* __restrict__ src, h16* __restrict__ dst, int tile) {
    const size_t i = (size_t)tile * 4096 + threadIdx.x * 8;
    const f32x4 a = *(const f32x4*)(src + i), b = *(const f32x4*)(src + i + 4);
    *(h16x8*)(dst + i) = pack8(a, b);
}
__device__ __forceinline__ void tr_tile(const float* __restrict__ src, h16* __restrict__ dst, int K, int N, int tile, float* lds) {
    const int ntn = N / 64, tk = tile / ntn, tn = tile % ntn, tid = threadIdx.x;
#pragma unroll
    for (int ps = 0; ps < 2; ++ps) {
        const int k = ps * 32 + (tid >> 4), n = (tid & 15) * 4;
        const f32x4 v = *(const f32x4*)(src + (size_t)(tk * 64 + k) * N + tn * 64 + n);
        lds[k * 65 + n] = v[0]; lds[k * 65 + n + 1] = v[1]; lds[k * 65 + n + 2] = v[2]; lds[k * 65 + n + 3] = v[3];
    }
    __syncthreads();
    {
        const int n = tid >> 3, ks = (tid & 7) * 8;
        h16x8 o;
#pragma unroll
        for (int i = 0; i < 8; ++i) o[i] = (h16)lds[(ks + i) * 65 + n];
        *(h16x8*)(dst + (size_t)(tn * 64 + n) * K + tk * 64 + ks) = o;
    }
    __syncthreads();
}
__device__ __forceinline__ void cvt8_rows(const float* __restrict__ src, unsigned char* __restrict__ dst, float* __restrict__ inv, int tile) {
    const int wid = threadIdx.x >> 6, lane = threadIdx.x & 63;
    const size_t row = (size_t)tile * 8 + wid;
    const float* r = src + row * 1024 + lane * 16;
    f32x4 a[4]; float mx = 0.f;
#pragma unroll
    for (int i = 0; i < 4; ++i) { a[i] = *(const f32x4*)(r + 4 * i); mx = fmaxf(mx, fmaxf(fmaxf(fabsf(a[i][0]), fabsf(a[i][1])), fmaxf(fabsf(a[i][2]), fabsf(a[i][3])))); }
#pragma unroll
    for (int o = 32; o > 0; o >>= 1) mx = fmaxf(mx, __shfl_xor(mx, o));
    int ex2 = 0; float sc = 1.0f;
    if (mx > 0.f) { (void)frexpf(mx, &ex2); int k = 8 - ex2; k = k > 100 ? 100 : (k < -100 ? -100 : k); sc = ldexpf(1.0f, k); }
    i32x4 w;
#pragma unroll
    for (int i = 0; i < 4; ++i) {
        int pk = __builtin_amdgcn_cvt_pk_fp8_f32(a[i][0] * sc, a[i][1] * sc, 0, false);
        pk = __builtin_amdgcn_cvt_pk_fp8_f32(a[i][2] * sc, a[i][3] * sc, pk, true);
        w[i] = pk;
    }
    *(i32x4*)(dst + row * 1024 + lane * 16) = w;
    if (lane == 0) inv[2 * row] = 1.0f / sc;
}
__device__ __forceinline__ void cvt4_rows(const float* __restrict__ src, unsigned char* __restrict__ dst, float* __restrict__ inv, int tile) {
    const int wid = threadIdx.x >> 6, lane = threadIdx.x & 63;
    const size_t row = (size_t)tile * 8 + wid;
    const float* r = src + row * 1024 + lane * 16;
    f32x4 a[4]; float mx = 0.f;
#pragma unroll
    for (int i = 0; i < 4; ++i) { a[i] = *(const f32x4*)(r + 4 * i); mx = fmaxf(mx, fmaxf(fmaxf(fabsf(a[i][0]), fabsf(a[i][1])), fmaxf(fabsf(a[i][2]), fabsf(a[i][3])))); }
#pragma unroll
    for (int o = 32; o > 0; o >>= 1) mx = fmaxf(mx, __shfl_xor(mx, o));
    const float sc = (mx > 1e-30f) ? 6.0f / mx : 1.0f;
    int w0 = 0, w1 = 0;
    w0 = __builtin_amdgcn_cvt_scalef32_pk_fp4_f32(w0, a[0][0] * sc, a[0][1] * sc, 1.0f, 0);
    w0 = __builtin_amdgcn_cvt_scalef32_pk_fp4_f32(w0, a[0][2] * sc, a[0][3] * sc, 1.0f, 1);
    w0 = __builtin_amdgcn_cvt_scalef32_pk_fp4_f32(w0, a[1][0] * sc, a[1][1] * sc, 1.0f, 2);
    w0 = __builtin_amdgcn_cvt_scalef32_pk_fp4_f32(w0, a[1][2] * sc, a[1][3] * sc, 1.0f, 3);
    w1 = __builtin_amdgcn_cvt_scalef32_pk_fp4_f32(w1, a[2][0] * sc, a[2][1] * sc, 1.0f, 0);
    w1 = __builtin_amdgcn_cvt_scalef32_pk_fp4_f32(w1, a[2][2] * sc, a[2][3] * sc, 1.0f, 1);
    w1 = __builtin_amdgcn_cvt_scalef32_pk_fp4_f32(w1, a[3][0] * sc, a[3][1] * sc, 1.0f, 2);
    w1 = __builtin_amdgcn_cvt_scalef32_pk_fp4_f32(w1, a[3][2] * sc, a[3][3] * sc, 1.0f, 3);
    *(i32x2*)(dst + row * 512 + lane * 8) = (i32x2){w0, w1};
    if (lane == 0) inv[2 * row] = 1.0f / sc;
}
__device__ __forceinline__ void wqk_tile(const float* __restrict__ wq, const float* __restrict__ keys, h16* __restrict__ wt, int tile, float* lds) {
    const int ct = tile >> 4, hp = tile & 15, tid = threadIdx.x;
    float* sA = lds;
    float* sB = lds + 64 * 129;
#pragma unroll
    for (int i = 0; i < 4; ++i) {
        const int e = (i * 512 + tid) * 4, r = e >> 7, d = e & 127;
        const f32x4 v = *(const f32x4*)(wq + (size_t)(ct * 64 + r) * 2048 + hp * 128 + d);
        sA[r * 129 + d] = v[0]; sA[r * 129 + d + 1] = v[1]; sA[r * 129 + d + 2] = v[2]; sA[r * 129 + d + 3] = v[3];
    }
#pragma unroll
    for (int i = 0; i < 8; ++i) {
        const int e = (i * 512 + tid) * 4, k = e >> 7, d = e & 127;
        const f32x4 v = *(const f32x4*)(keys + (size_t)(hp * 128 + k) * 128 + d);
        sB[k * 129 + d] = v[0]; sB[k * 129 + d + 1] = v[1]; sB[k * 129 + d + 2] = v[2]; sB[k * 129 + d + 3] = v[3];
    }
    __syncthreads();
    const int c = tid >> 3, kg = (tid & 7) * 16;
    float acc[16];
#pragma unroll
    for (int j = 0; j < 16; ++j) acc[j] = 0.f;
#pragma unroll 4
    for (int d = 0; d < 128; ++d) {
        const float a = sA[c * 129 + d];
#pragma unroll
        for (int j = 0; j < 16; ++j) acc[j] += a * sB[(kg + j) * 129 + d];
    }
#pragma unroll
    for (int j = 0; j < 16; ++j) wt[(size_t)(hp * 128 + kg + j) * 1024 + ct * 64 + c] = (h16)acc[j];
    __syncthreads();
}
__device__ void phase0(const Params& p, float* lds) {
    unsigned char* ws = p.ws;
    const int tid = threadIdx.x, wid = tid >> 6, lane = tid & 63;
    for (int ib = blockIdx.x; ib < 256; ib += gridDim.x) {
        if (wid < 6) {
            const int item = ib * 6 + wid, cg64 = item % 96, kc = item / 96;
            const int col = cg64 * 64 + lane, k0 = kc * 64;
            float sv[17], acc[17];
#pragma unroll
            for (int b = 0; b < 17; ++b) {
                const float cv = (b < 16) ? p.in[I_C][b * 1024 + k0 + lane] : p.in[I_CCTX][k0 + lane];
                sv[b] = silu_(cv); acc[b] = 0.f;
            }
            const float* wp = p.in[I_ADAW] + (size_t)k0 * 6144 + col;
            for (int j = 0; j < 64; ++j) {
                const float w = wp[(size_t)j * 6144];
#pragma unroll
                for (int b = 0; b < 17; ++b) acc[b] += __builtin_bit_cast(float, __builtin_amdgcn_readlane(__builtin_bit_cast(int, sv[b]), j)) * w;
            }
            float* mp = (float*)(ws + OFF_MODP);
#pragma unroll
            for (int b = 0; b < 17; ++b) mp[((size_t)kc * 17 + b) * 6144 + col] = acc[b];
        }
    }
    constexpr int T0 = 2048, T1 = T0 + 2048, T2 = T1 + 32, T3 = T2, T4 = T3 + 1152, T5 = T4 + 128, T6 = T5 + 128, T7 = T6 + 256, T8 = T7 + 256;
    for (int t = blockIdx.x; t < T8; t += gridDim.x) {
        if (t < T0) cvt4_rows(p.in[I_PU], ws + OFF_U8, (float*)(ws + OFF_USC), t);
        else if (t < T1) cvt8_rows(p.in[I_PV], ws + OFF_V8, (float*)(ws + OFF_USC) + 1, t - T0);
        else if (t < T2) cvt_tile(p.in[I_GMWS], (h16*)(ws + OFF_WS16), t - T1);
        else if (t < T3) {
            const int e = (t - T2) * 4096 + tid * 8;
            const int row = e >> 8, cc = e & 255, h = row >> 8, pp = (row >> 7) & 1, k = row & 127, pq = cc >> 7, d = cc & 127;
            h16x8 o = {0, 0, 0, 0, 0, 0, 0, 0};
            if (pp == pq) {
                const float* kp = p.in[I_KEYS] + ((size_t)((h * 2 + pp) * 128 + k)) * 128 + d;
                o = pack8(*(const f32x4*)kp, *(const f32x4*)(kp + 4));
            }
            *(h16x8*)((h16*)(ws + OFF_BD) + e) = o;
        }
        else if (t < T4) tr_tile(p.in[I_WIN], (h16*)(ws + OFF_WINT), 1024, INC, t - T3, lds);
        else if (t < T5) tr_tile(p.in[I_WPA], (h16*)(ws + OFF_WPAT), 512, 1024, t - T4, lds);
        else if (t < T6) tr_tile(p.in[I_WPB], (h16*)(ws + OFF_WPBT), 512, 1024, t - T5, lds);
        else if (t < T7) tr_tile(p.in[I_WOUT], (h16*)(ws + OFF_WOUTT), 1024, 1024, t - T6, lds);
        else wqk_tile(p.in[I_WQ], p.in[I_KEYS], (h16*)(ws + OFF_WQT), t - T7, lds);
    }
}

__device__ __forceinline__ void norm_rows(const float* __restrict__ src, h16* __restrict__ dst, int row_begin, int rows_per_wave, const float* sA, const float* sB) {
    const int tid_ = fresh_tid();
    const int wid = tid_ >> 6, lane = tid_ & 63;
    f32x4 a[4], bsh[4];
#pragma unroll
    for (int c = 0; c < 4; ++c) { a[c] = *(const f32x4*)(sA + c * 256 + lane * 4); bsh[c] = *(const f32x4*)(sB + c * 256 + lane * 4); }
    for (int i = 0; i < rows_per_wave; i += 2) {
        const size_t row = (size_t)row_begin + wid * rows_per_wave + i;
        f32x4 v[2][4]; float ss[2];
#pragma unroll
        for (int q = 0; q < 2; ++q) {
            ss[q] = 0.f;
#pragma unroll
            for (int c = 0; c < 4; ++c) { v[q][c] = *(const f32x4*)(src + (row + q) * 1024 + c * 256 + lane * 4); ss[q] += v[q][c][0] * v[q][c][0] + v[q][c][1] * v[q][c][1] + v[q][c][2] * v[q][c][2] + v[q][c][3] * v[q][c][3]; }
        }
#pragma unroll
        for (int o = 32; o > 0; o >>= 1) { const float t0 = __shfl_xor(ss[0], o), t1 = __shfl_xor(ss[1], o); ss[0] += t0; ss[1] += t1; }
#pragma unroll
        for (int q = 0; q < 2; ++q) {
            const float r = rsqrtf(ss[q] * (1.0f / 1024.0f) + 1e-6f);
#pragma unroll
            for (int c = 0; c < 4; ++c) {
                h16x4 o;
#pragma unroll
                for (int j = 0; j < 4; ++j) o[j] = (h16)(v[q][c][j] * r * a[c][j] + bsh[c][j]);
                *(h16x4*)(dst + (row + q) * 1024 + c * 256 + lane * 4) = o;
            }
        }
    }
}
__device__ void phase1(const Params& p, float* lds) {
    unsigned char* ws = p.ws;
    const int tid = threadIdx.x;
    const float* mp = (const float*)(ws + OFF_MODP);
    const float* bias = p.in[I_ADAB];
    float* sA = lds; float* sB = lds + 1024; float* cA = lds + 2048; float* cB = lds + 3072;
    {
        float* mod = (float*)(ws + OFF_MOD);
        for (int e = blockIdx.x * 512 + tid; e < 17 * 6144; e += gridDim.x * 512) {
            float s = bias[e % 6144];
#pragma unroll
            for (int kc = 0; kc < 16; ++kc) s += mp[(size_t)kc * 17 * 6144 + e];
            mod[e] = s;
        }
    }
    for (int col = tid; col < 1024; col += 512) {
        float sh = bias[col], sc = bias[1024 + col];
#pragma unroll
        for (int kc = 0; kc < 16; ++kc) { sh += mp[((size_t)kc * 17 + 16) * 6144 + col]; sc += mp[((size_t)kc * 17 + 16) * 6144 + 1024 + col]; }
        cA[col] = p.in[I_N1G][col] * (1.0f + sc); cB[col] = sh;
    }
    for (int rg = blockIdx.x; rg < 256; rg += gridDim.x) {
        const int b = rg >> 4;
        __syncthreads();
        for (int col = tid; col < 1024; col += 512) {
            float sh = bias[col], sc = bias[1024 + col];
#pragma unroll
            for (int kc = 0; kc < 16; ++kc) { sh += mp[((size_t)kc * 17 + b) * 6144 + col]; sc += mp[((size_t)kc * 17 + b) * 6144 + 1024 + col]; }
            sA[col] = p.in[I_N1G][col] * (1.0f + sc); sB[col] = sh;
        }
        __syncthreads();
        norm_rows(p.in[I_X], (h16*)(ws + OFF_R1), rg * 128, 16, sA, sB);
        norm_rows(p.in[I_CTX], (h16*)(ws + OFF_HC), rg * 16, 2, cA, cB);
    }
}
__device__ void phase6(const Params& p, float* lds) {
    unsigned char* ws = p.ws;
    const int tid = threadIdx.x;
    const float* mod = (const float*)(ws + OFF_MOD);
    float* sA = lds; float* sB = lds + 1024;
    for (int rg = blockIdx.x; rg < 256; rg += gridDim.x) {
        const int b = rg >> 4;
        __syncthreads();
        for (int col = tid; col < 1024; col += 512) {
            sA[col] = p.in[I_N2G][col] * (1.0f + mod[(size_t)b * 6144 + 4 * 1024 + col]); sB[col] = mod[(size_t)b * 6144 + 3 * 1024 + col];
        }
        __syncthreads();
        norm_rows(p.out, (h16*)(ws + OFF_R1), rg * 128, 16, sA, sB);
    }
}

__device__ __forceinline__ int clampi(int v, int lo, int hi) { return v < lo ? lo : (v > hi ? hi : v); }

template <bool LOCAL>
__device__ __forceinline__ void attn_core(const h16x8 (&kf)[2][2], const h16x8 (&vf)[4], const float* __restrict__ rpbrow, const int cb, const int qc, const int cs,
                                          const h16x8 (&qf)[2], float& m_run, float& l_run, f32x4 (&O)[4], const int quad) {
    f32x4 st[2];
#pragma unroll
    for (int t = 0; t < 2; ++t) {
        f32x4 a = (f32x4){0.f, 0.f, 0.f, 0.f};
#pragma unroll
        for (int ks = 0; ks < 2; ++ks) a = __builtin_amdgcn_mfma_f32_16x16x32_f16(kf[t][ks], qf[ks], a, 0, 0, 0);
        st[t] = a;
    }
    float mx = -INFINITY;
#pragma unroll
    for (int t = 0; t < 2; ++t)
#pragma unroll
        for (int j = 0; j < 4; ++j) {
            float sv = st[t][j] * 0.125f;
            if (LOCAL) {
                const int kc = cb + 16 * t + quad * 4 + j;
                const bool inw = (kc >= cs) && (kc < cs + 16);
                const int dc = clampi(kc - qc + 15, 0, 30);
                const float bv = rpbrow[dc];
                sv = inw ? (sv + bv) : -1e30f;
            }
            st[t][j] = sv; mx = fmaxf(mx, sv);
        }
    mx = fmaxf(mx, __shfl_xor(mx, 16)); mx = fmaxf(mx, __shfl_xor(mx, 32));
    const float m_new = fmaxf(m_run, mx);
    const float alpha = __expf(m_run - m_new);
    float ls = 0.f; h16x8 pf;
#pragma unroll
    for (int t = 0; t < 2; ++t)
#pragma unroll
        for (int j = 0; j < 4; ++j) { const float pe = __expf(st[t][j] - m_new); ls += pe; pf[t * 4 + j] = (h16)pe; }
    l_run = l_run * alpha + ls; m_run = m_new;
#pragma unroll
    for (int dt = 0; dt < 4; ++dt) { O[dt] *= alpha; O[dt] = __builtin_amdgcn_mfma_f32_16x16x32_f16(vf[dt], pf, O[dt], 0, 0, 0); }
}
__device__ __forceinline__ void load_kv(const h16* __restrict__ kt, const h16* __restrict__ vt, h16x8 (&kf)[2][2], h16x8 (&vf)[4], const int l15, const int quad) {
#pragma unroll
    for (int t = 0; t < 2; ++t)
#pragma unroll
        for (int ks = 0; ks < 2; ++ks) kf[t][ks] = *(const h16x8*)(kt + (16 * t + l15) * 64 + ks * 32 + quad * 8);
#pragma unroll
    for (int dt = 0; dt < 4; ++dt) {
        const h16* vp = vt + ((quad >> 1) * 64 + dt * 16 + l15) * 8 + (quad & 1) * 4;
        const h16x4 lo = *(const h16x4*)vp, hi = *(const h16x4*)(vp + 2 * 512);
        vf[dt] = (h16x8){lo[0], lo[1], lo[2], lo[3], hi[0], hi[1], hi[2], hi[3]};
    }
}

__device__ void attn_unit(const Params& p, int unit) {
    unsigned char* ws = p.ws;
    const int tid_ = fresh_tid();
    const int lane = tid_ & 63, h = tid_ >> 6, l15 = lane & 15, quad = lane >> 4;
    const int b = unit >> 5, r = unit & 31;
    const h16* QB = (const h16*)(ws + OFF_QB);
    const h16* KH = (const h16*)(ws + OFF_KB) + (size_t)(b * 8 + h) * 2048 * 64;
    const h16* VH = (const h16*)(ws + OFF_VT) + (size_t)(b * 8 + h) * 256 * 512;
    const h16* KCH = (const h16*)(ws + OFF_KC) + (size_t)(b * 8 + h) * 256 * 64;
    const h16* VCH = (const h16*)(ws + OFF_VCT) + (size_t)(b * 8 + h) * 32 * 512;
    h16* YA = (h16*)(ws + OFF_R1);
    const float* rpb = p.in[I_RPB] + (size_t)h * 15 * 31;
    const int rs = clampi(r - 4, 0, 24);
    h16x8 qf[4][2]; float m_run[4], l_run[4]; f32x4 O[4][4];
#pragma unroll
    for (int g = 0; g < 4; ++g) {
        const size_t tq = (size_t)b * 2048 + r * 64 + 16 * g + l15;
        qf[g][0] = *(const h16x8*)(QB + tq * 512 + h * 64 + quad * 8);
        qf[g][1] = *(const h16x8*)(QB + tq * 512 + h * 64 + 32 + quad * 8);
        m_run[g] = -INFINITY; l_run[g] = 0.f;
#pragma unroll
        for (int dt = 0; dt < 4; ++dt) O[g][dt] = (f32x4){0.f, 0.f, 0.f, 0.f};
    }
#pragma unroll 1
    for (int step = 0; step < 8; ++step) {
        h16x8 kf[2][2], vf[4];
        load_kv(KCH + step * 32 * 64, VCH + step * 4 * 512, kf, vf, l15, quad);
#pragma unroll
        for (int g = 0; g < 4; ++g) attn_core<false>(kf, vf, rpb, 0, 0, 0, qf[g], m_run[g], l_run[g], O[g], quad);
    }
#pragma unroll
    for (int gp = 0; gp < 4; gp += 2) {
        const int cb0 = clampi(16 * gp - 8, 0, 32), cb1 = clampi(16 * (gp + 1) - 8, 0, 32);
        const int qc0 = 16 * gp + l15, qc1 = 16 * (gp + 1) + l15;
        const int cs0 = clampi(qc0 - 8, 0, 48), cs1 = clampi(qc1 - 8, 0, 48);
        const float* rp0 = rpb + (rs - r + 7) * 31;
#pragma unroll 1
        for (int step = 0; step < 8; ++step) {
            const int t0 = (rs + step) * 64 + cb0, t1 = (rs + step) * 64 + cb1;
            h16x8 kf0[2][2], vf0[4], kf1[2][2], vf1[4];
            load_kv(KH + (size_t)t0 * 64, VH + (size_t)(t0 >> 3) * 512, kf0, vf0, l15, quad);
            load_kv(KH + (size_t)t1 * 64, VH + (size_t)(t1 >> 3) * 512, kf1, vf1, l15, quad);
            attn_core<true>(kf0, vf0, rp0 + step * 31, cb0, qc0, cs0, qf[gp], m_run[gp], l_run[gp], O[gp], quad);
            attn_core<true>(kf1, vf1, rp0 + step * 31, cb1, qc1, cs1, qf[gp + 1], m_run[gp + 1], l_run[gp + 1], O[gp + 1], quad);
        }
    }
#pragma unroll
    for (int g = 0; g < 4; ++g) {
        const size_t tq = (size_t)b * 2048 + r * 64 + 16 * g + l15;
        float l = l_run[g];
        l += __shfl_xor(l, 16); l += __shfl_xor(l, 32);
        const float inv = __builtin_amdgcn_rcpf(l);
#pragma unroll
        for (int dt = 0; dt < 4; ++dt) {
            h16x4 o;
#pragma unroll
            for (int j = 0; j < 4; ++j) o[j] = (h16)(O[g][dt][j] * inv);
            *(h16x4*)(YA + tq * 1024 + h * 64 + dt * 16 + quad * 4) = o;
        }
    }
}

__device__ void sgu_unit(const Params& p, int n, LAS unsigned char* lds) {
    unsigned char* ws = p.ws;
    const int tid = fresh_tid(), lane = tid & 63, g = tid >> 6, l15 = lane & 15, quad = lane >> 4;
    const h16* GUV = (const h16*)(ws + OFF_GUV);
    const h16* WS16 = (const h16*)(ws + OFF_WS16);
    h16* YB = (h16*)(ws + OFF_R1) + 512;
    LAS float* stat = (LAS float*)(lds + 8 * 17408);
    LAS h16* vt = (LAS h16*)(lds + g * 17408);
    const size_t t0 = (size_t)n * 128;
    __syncthreads();
    for (int i = 0; i < 16; i += 4) {
        h16x8 x[4]; float s[4], v[4];
#pragma unroll
        for (int q = 0; q < 4; ++q) {
            x[q] = *(const h16x8*)(GUV + (t0 + g * 16 + i + q) * 1024 + 512 + lane * 8);
            s[q] = 0.f;
#pragma unroll
            for (int j = 0; j < 8; ++j) s[q] += (float)x[q][j];
        }
#pragma unroll
        for (int o = 32; o > 0; o >>= 1) { float t[4];
#pragma unroll
            for (int q = 0; q < 4; ++q) t[q] = __shfl_xor(s[q], o);
#pragma unroll
            for (int q = 0; q < 4; ++q) s[q] += t[q]; }
#pragma unroll
        for (int q = 0; q < 4; ++q) {
            s[q] *= (1.0f / 512.0f); v[q] = 0.f;
#pragma unroll
            for (int j = 0; j < 8; ++j) { const float d = (float)x[q][j] - s[q]; v[q] += d * d; }
        }
#pragma unroll
        for (int o = 32; o > 0; o >>= 1) { float t[4];
#pragma unroll
            for (int q = 0; q < 4; ++q) t[q] = __shfl_xor(v[q], o);
#pragma unroll
            for (int q = 0; q < 4; ++q) v[q] += t[q]; }
        if (lane == 0) {
#pragma unroll
            for (int q = 0; q < 4; ++q) { stat[(g * 16 + i + q) * 2] = s[q]; stat[(g * 16 + i + q) * 2 + 1] = rsqrtf(v[q] * (1.0f / 512.0f) + 1e-6f); }
        }
    }
    __syncthreads();
    {
        const int ch0 = (lane & 7) * 8;
        float lg[8];
#pragma unroll
        for (int j = 0; j < 8; ++j) lg[j] = p.in[I_LNG][g * 64 + ch0 + j];
#pragma unroll 8
        for (int it = 0; it < 16; ++it) {
            const int q = it * 8 + (lane >> 3);
            const h16x8 x = *(const h16x8*)(GUV + (t0 + q) * 1024 + 512 + g * 64 + ch0);
            const float mean = stat[q * 2], rstd = stat[q * 2 + 1];
#pragma unroll
            for (int j = 0; j < 8; ++j) vt[(ch0 + j) * 136 + q] = (h16)(((float)x[j] - mean) * rstd * lg[j]);
        }
    }
    asm volatile("s_waitcnt lgkmcnt(0)" ::: "memory");
    __syncthreads();
    h16x8 af[4][4];
#pragma unroll
    for (int dt = 0; dt < 4; ++dt)
#pragma unroll
        for (int ks = 0; ks < 4; ++ks) af[dt][ks] = *(const LAS h16x8*)(vt + (dt * 16 + l15) * 136 + ks * 32 + quad * 8);
    const h16* wg = WS16 + (size_t)g * 128 * 128;
#pragma unroll 2
    for (int pt = 0; pt < 8; ++pt) {
        f32x4 acc[4];
#pragma unroll
        for (int dt = 0; dt < 4; ++dt) acc[dt] = (f32x4){0.f, 0.f, 0.f, 0.f};
#pragma unroll
        for (int ks = 0; ks < 4; ++ks) {
            const h16x8 bf = *(const h16x8*)(wg + (size_t)(pt * 16 + l15) * 128 + ks * 32 + quad * 8);
#pragma unroll
            for (int dt = 0; dt < 4; ++dt) acc[dt] = __builtin_amdgcn_mfma_f32_16x16x32_f16(af[dt][ks], bf, acc[dt], 0, 0, 0);
        }
        const int pp = pt * 16 + l15;
        const float bsv = p.in[I_GMBS][g * 128 + pp];
        const size_t tok = t0 + pp;
#pragma unroll
        for (int dt = 0; dt < 4; ++dt) {
            const int ch = g * 64 + dt * 16 + quad * 4;
            const h16x4 uu = *(const h16x4*)(GUV + tok * 1024 + ch);
            h16x4 o;
#pragma unroll
            for (int j = 0; j < 4; ++j) o[j] = (h16)((float)uu[j] * (acc[dt][j] + bsv));
            *(h16x4*)(YB + tok * 1024 + ch) = o;
        }
    }
    __syncthreads();
}

__device__ __forceinline__ float row16_sum_to_lane15(float v) {
    v += __builtin_bit_cast(float, __builtin_amdgcn_update_dpp(0, __builtin_bit_cast(int, v), 0x118, 0xf, 0xf, true));
    v += __builtin_bit_cast(float, __builtin_amdgcn_update_dpp(0, __builtin_bit_cast(int, v), 0x114, 0xf, 0xf, true));
    v += __builtin_bit_cast(float, __builtin_amdgcn_update_dpp(0, __builtin_bit_cast(int, v), 0x112, 0xf, 0xf, true));
    v += __builtin_bit_cast(float, __builtin_amdgcn_update_dpp(0, __builtin_bit_cast(int, v), 0x111, 0xf, 0xf, true));
    return v;
}
#define DPPF(v, ctrl) __builtin_bit_cast(float, __builtin_amdgcn_update_dpp(__builtin_bit_cast(int, v), __builtin_bit_cast(int, v), ctrl, 0xf, 0xf, false))
__device__ __forceinline__ float row16_allsum(float v) { v += DPPF(v, 0x128); v += DPPF(v, 0x124); v += DPPF(v, 0x122); v += DPPF(v, 0x121); return v; }
__device__ __forceinline__ float row16_allmax(float v) { v = fmaxf(v, DPPF(v, 0x128)); v = fmaxf(v, DPPF(v, 0x124)); v = fmaxf(v, DPPF(v, 0x122)); v = fmaxf(v, DPPF(v, 0x121)); return v; }
__device__ __forceinline__ int wave_incl_scan(int v) {
    v += __builtin_amdgcn_update_dpp(0, v, 0x111, 0xf, 0xf, false);
    v += __builtin_amdgcn_update_dpp(0, v, 0x112, 0xf, 0xf, false);
    v += __builtin_amdgcn_update_dpp(0, v, 0x114, 0xf, 0xf, false);
    v += __builtin_amdgcn_update_dpp(0, v, 0x118, 0xf, 0xf, false);
    v += __builtin_amdgcn_update_dpp(0, v, 0x142, 0xa, 0xf, false);
    v += __builtin_amdgcn_update_dpp(0, v, 0x143, 0xc, 0xf, false);
    return v;
}
__device__ __forceinline__ unsigned key16(unsigned short u) { return (u & 0x8000u) ? ((~(unsigned)u) & 0xFFFFu) : ((unsigned)u | 0x8000u); }
__device__ __forceinline__ unsigned key32(unsigned u) { return (u & 0x80000000u) ? ~u : (u | 0x80000000u); }
__device__ __forceinline__ float dot8(h16x8 a, h16x8 b, float c) {
    c = __builtin_amdgcn_fdot2((h16x2){a[0], a[1]}, (h16x2){b[0], b[1]}, c, false);
    c = __builtin_amdgcn_fdot2((h16x2){a[2], a[3]}, (h16x2){b[2], b[3]}, c, false);
    c = __builtin_amdgcn_fdot2((h16x2){a[4], a[5]}, (h16x2){b[4], b[5]}, c, false);
    c = __builtin_amdgcn_fdot2((h16x2){a[6], a[7]}, (h16x2){b[6], b[7]}, c, false);
    return c;
}
#define LDS_FENCE() asm volatile("s_waitcnt lgkmcnt(0)" ::: "memory")

__device__ void peer_phase(const Params& p, LAS unsigned char* lds, unsigned* bar, unsigned& epoch) {
    unsigned char* ws = p.ws;
    const int tid = fresh_tid(), wid = __builtin_amdgcn_readfirstlane(tid >> 6), lane = tid & 63;
    const unsigned long long lm = (1ull << lane) - 1ull;
    LAS unsigned char* wl = lds + wid * 11264;
    LAS float* s_top = (LAS float*)(wl);
    LAS int* i_top = (LAS int*)(wl + 1024);
    LAS int* ex = (LAS int*)(wl + 2048);
    LAS float* sc = (LAS float*)(wl + 2560);
    LAS int* uns_m = (LAS int*)(wl + 3072);
    LAS float* uns_g = (LAS float*)(wl + 3584);
    LAS int* cnt = (LAS int*)(wl + 4096);
    LAS int* base = (LAS int*)(wl + 4352);
    const int lead = (wid >= 4) ? 1 : 0;
    const unsigned short* SC = (const unsigned short*)(ws + OFF_SC16);
    const h16* H2 = (const h16*)(ws + OFF_R1);
    const unsigned char* U4 = ws + OFF_U8;
    const unsigned char* V8 = ws + OFF_V8;
    const float* USC = (const float*)(ws + OFF_USC);
    const float* VSC = (const float*)(ws + OFF_VSC);
    const float* mod = (const float*)(ws + OFF_MOD);
    const int grp = lane >> 4, li = lane & 15;
    for (int tg = blockIdx.x; tg < 256; tg += gridDim.x) {
        for (int it5 = 0; it5 < 5; ++it5) {
          if (it5 < 4) {
            const int round = it5;
            const size_t tok0 = (size_t)tg * 128 + wid * 16 + round * 4;
            LAS unsigned short* se = (LAS unsigned short*)(wl + 4608 + (round & 1) * 3072);
            LAS float* sw = (LAS float*)(wl + 4608 + (round & 1) * 3072 + 1024);
            for (int tt = 0; tt < 4; ++tt) {
                const size_t tok = tok0 + tt;
                cnt[lane] = 0;
                for (int L0 = 0; L0 < 16; L0 += 4) {
                    unsigned short ra[4], rb[4]; unsigned ka[4], kb[4], T[4];
#pragma unroll
                    for (int q = 0; q < 4; ++q) {
                        const unsigned short* sr = SC + tok * 2048 + (L0 + q) * 128;
                        ra[q] = sr[lane]; rb[q] = sr[64 + lane];
                        ka[q] = key16(ra[q]); kb[q] = key16(rb[q]); T[q] = 0;
                    }
                    for (int bit = 15; bit >= 0; --bit) {
#pragma unroll
                        for (int q = 0; q < 4; ++q) {
                            const unsigned cand = T[q] | (1u << bit);
                            const int cn = __popcll(__ballot(ka[q] >= cand)) + __popcll(__ballot(kb[q] >= cand));
                            T[q] = (cn >= 16) ? cand : T[q];
                        }
                    }
#pragma unroll
                    for (int q = 0; q < 4; ++q) {
                        const int L = L0 + q;
                        const int cnt_gt = __popcll(__ballot(ka[q] > T[q])) + __popcll(__ballot(kb[q] > T[q]));
                        const int need = 16 - cnt_gt;
                        const unsigned long long ea = __ballot(ka[q] == T[q]), eb = __ballot(kb[q] == T[q]);
                        const int ra_eq = __popcll(ea & lm), rb_eq = __popcll(ea) + __popcll(eb & lm);
                        const bool sa = (ka[q] > T[q]) || (ka[q] == T[q] && ra_eq < need);
                        const bool sb = (kb[q] > T[q]) || (kb[q] == T[q] && rb_eq < need);
                        const unsigned long long ma = __ballot(sa), mb = __ballot(sb);
                        const int pa = __popcll(ma & lm), pb = __popcll(ma) + __popcll(mb & lm);
                        if (sa) { s_top[L * 16 + pa] = (float)__builtin_bit_cast(h16, ra[q]); i_top[L * 16 + pa] = lane; }
                        if (sb) { s_top[L * 16 + pb] = (float)__builtin_bit_cast(h16, rb[q]); i_top[L * 16 + pb] = 64 + lane; }
                    }
                }
                LDS_FENCE();
                for (int h0 = 0; h0 < 8; h0 += 4) {
                    float cv[4][4]; unsigned kk[4][4], T[4];
#pragma unroll
                    for (int q = 0; q < 4; ++q) {
                        const int h = h0 + q;
                        const float bj = s_top[(2 * h + 1) * 16 + li];
#pragma unroll
                        for (int m = 0; m < 4; ++m) { cv[q][m] = s_top[(2 * h) * 16 + grp + 4 * m] + bj; kk[q][m] = key32(__builtin_bit_cast(unsigned, cv[q][m])); }
                        T[q] = 0;
                    }
                    for (int bit = 31; bit >= 0; --bit) {
#pragma unroll
                        for (int q = 0; q < 4; ++q) {
                            const unsigned cand = T[q] | (1u << bit);
                            int cn = 0;
#pragma unroll
                            for (int m = 0; m < 4; ++m) cn += __popcll(__ballot(kk[q][m] >= cand));
                            T[q] = (cn >= 16) ? cand : T[q];
                        }
                    }
#pragma unroll
                    for (int q = 0; q < 4; ++q) {
                        const int h = h0 + q;
                        int cnt_gt = 0;
#pragma unroll
                        for (int m = 0; m < 4; ++m) cnt_gt += __popcll(__ballot(kk[q][m] > T[q]));
                        const int need = 16 - cnt_gt;
                        int eq_before = 0, sel_before = 0;
#pragma unroll
                        for (int m = 0; m < 4; ++m) {
                            const unsigned long long em = __ballot(kk[q][m] == T[q]);
                            const int myeq = eq_before + __popcll(em & lm);
                            const bool sel = (kk[q][m] > T[q]) || (kk[q][m] == T[q] && myeq < need);
                            const unsigned long long sm = __ballot(sel);
                            const int pos = sel_before + __popcll(sm & lm);
                            if (sel) {
                                ex[h * 16 + pos] = i_top[(2 * h) * 16 + grp + 4 * m] * 128 + i_top[(2 * h + 1) * 16 + li];
                                sc[h * 16 + pos] = cv[q][m];
                            }
                            eq_before += __popcll(em); sel_before += __popcll(sm);
                        }
                    }
                }
                LDS_FENCE();
#pragma unroll
                for (int half = 0; half < 2; ++half) {
                    const int e = half * 64 + lane;
                    const float v = sc[e];
                    const float mx = row16_allmax(v);
                    const float pe = __expf(v - mx);
                    const float sm = row16_allsum(pe);
                    const float gate = pe * __builtin_amdgcn_rcpf(sm);
                    const int eid = ex[e];
                    const int pos = __hip_atomic_fetch_add(cnt + (eid >> 8), 1, __ATOMIC_RELAXED, __HIP_MEMORY_SCOPE_WORKGROUP);
                    uns_m[e] = eid | (pos << 14); uns_g[e] = gate;
                }
                LDS_FENCE();
                {
                    const int c = cnt[lane];
                    const int incl = wave_incl_scan(c);
                    base[lane] = incl - c;
                    LDS_FENCE();
#pragma unroll
                    for (int i = 0; i < 2; ++i) {
                        const int rm = uns_m[i * 64 + lane]; const float rg = uns_g[i * 64 + lane];
                        const int eid = rm & 16383, pos = rm >> 14;
                        const int dst = tt * 128 + base[eid >> 8] + pos;
                        se[dst] = (unsigned short)eid; sw[dst] = rg;
                    }
                    LDS_FENCE();
                }
            }
          }
          const int round = it5 - lead;
          if (round >= 0 && round < 4) {
            const size_t tok0 = (size_t)tg * 128 + wid * 16 + round * 4;
            LAS unsigned short* se = (LAS unsigned short*)(wl + 4608 + (round & 1) * 3072);
            LAS float* sw = (LAS float*)(wl + 4608 + (round & 1) * 3072 + 1024);
            const size_t tokg = tok0 + grp;
            const LAS unsigned short* me = se + grp * 128; LAS float* mw = sw + grp * 128;
            {
                const int li = launder(tid) & 15;
                h16x8 xr[2][4];
#pragma unroll
                for (int c = 0; c < 2; ++c)
#pragma unroll
                    for (int j = 0; j < 4; ++j) xr[c][j] = *(const h16x8*)(H2 + tokg * 1024 + c * 512 + li * 32 + 8 * j);
                i32x4 ru[4][2]; float su[4], sv[4];
#define ULD(J, S_) do { const int e_ = me[(S_)]; const unsigned char* up_ = U4 + (size_t)e_ * 512 + li * 16; ru[J][0] = *(const i32x4*)up_; ru[J][1] = *(const i32x4*)(up_ + 256); { const f32x2 s2_ = *(const f32x2*)(USC + 2 * e_); su[J] = s2_.x; sv[J] = s2_.y; } } while (0)
#define UCP(J, S_) do { float d = 0.f; \
        _Pragma("unroll") for (int c = 0; c < 2; ++c) _Pragma("unroll") for (int k = 0; k < 4; ++k) { const h16x8 xv = xr[c][k]; const int w_ = ru[J][c][k]; \
            d = __builtin_amdgcn_fdot2(__builtin_amdgcn_cvt_scalef32_pk_f16_fp4(w_, 1.0f, 0), (h16x2){xv[0], xv[1]}, d, false); \
            d = __builtin_amdgcn_fdot2(__builtin_amdgcn_cvt_scalef32_pk_f16_fp4(w_, 1.0f, 1), (h16x2){xv[2], xv[3]}, d, false); \
            d = __builtin_amdgcn_fdot2(__builtin_amdgcn_cvt_scalef32_pk_f16_fp4(w_, 1.0f, 2), (h16x2){xv[4], xv[5]}, d, false); \
            d = __builtin_amdgcn_fdot2(__builtin_amdgcn_cvt_scalef32_pk_f16_fp4(w_, 1.0f, 3), (h16x2){xv[6], xv[7]}, d, false); } \
        d = row16_sum_to_lane15(d); \
        const float wt_ = mw[(S_)] * gelu_tanh(d * su[J]) * sv[J]; if (li == 15) mw[(S_)] = wt_; } while (0)
                ULD(0, 0); ULD(1, 1); ULD(2, 2); ULD(3, 3);
#pragma unroll 1
                for (int s = 0; s < 128; s += 4) {
                    UCP(0, s);     if (s + 4 < 128) ULD(0, s + 4);
                    UCP(1, s + 1); if (s + 5 < 128) ULD(1, s + 5);
                    UCP(2, s + 2); if (s + 6 < 128) ULD(2, s + 6);
                    UCP(3, s + 3); if (s + 7 < 128) ULD(3, s + 7);
                }
#undef ULD
#undef UCP
            }
            LDS_FENCE();
            {
                const int li = launder(tid) & 15;
                float acc[64];
#pragma unroll
                for (int i = 0; i < 64; ++i) acc[i] = 0.f;
                i32x4 rv[4][4];
#define VLD(J, S_) do { const int e_ = me[(S_)]; const unsigned char* vp_ = V8 + (size_t)e_ * 1024 + li * 16; \
        _Pragma("unroll") for (int c = 0; c < 4; ++c) rv[J][c] = *(const i32x4*)(vp_ + c * 256); } while (0)
#define VCP(J, S_) do { const float wt_ = mw[(S_)]; \
        _Pragma("unroll") for (int c = 0; c < 4; ++c) _Pragma("unroll") for (int k = 0; k < 4; ++k) { \
            const f32x2 lo = __builtin_amdgcn_cvt_pk_f32_fp8(rv[J][c][k], false), hi = __builtin_amdgcn_cvt_pk_f32_fp8(rv[J][c][k], true); \
            acc[c * 16 + 4 * k] += wt_ * lo.x; acc[c * 16 + 4 * k + 1] += wt_ * lo.y; acc[c * 16 + 4 * k + 2] += wt_ * hi.x; acc[c * 16 + 4 * k + 3] += wt_ * hi.y; } } while (0)
                VLD(0, 0); VLD(1, 1); VLD(2, 2); VLD(3, 3);
#pragma unroll 1
                for (int s = 0; s < 128; s += 4) {
                    VCP(0, s);     if (s + 4 < 128) VLD(0, s + 4);
                    VCP(1, s + 1); if (s + 5 < 128) VLD(1, s + 5);
                    VCP(2, s + 2); if (s + 6 < 128) VLD(2, s + 6);
                    VCP(3, s + 3); if (s + 7 < 128) VLD(3, s + 7);
                }
#undef VLD
#undef VCP
                float* xo = p.out + tokg * 1024 + li * 16;
                const int b = (int)(tokg >> 11);
                const float* g2 = mod + (size_t)b * 6144 + 5 * 1024 + li * 16;
                const float* fg = p.in[I_FG] + li * 16;
                float ss = 0.f;
#pragma unroll
                for (int c = 0; c < 4; ++c) {
#pragma unroll
                    for (int q4 = 0; q4 < 4; ++q4) {
                        const f32x4 xv = *(const f32x4*)(xo + c * 256 + q4 * 4), gv = *(const f32x4*)(g2 + c * 256 + q4 * 4);
#pragma unroll
                        for (int j = 0; j < 4; ++j) { const float t = xv[j] + gv[j] * acc[c * 16 + q4 * 4 + j]; acc[c * 16 + q4 * 4 + j] = t; ss += t * t; }
                    }
                    asm volatile("" : "+v"(ss) :: "memory");
                }
#pragma unroll
                for (int o = 8; o > 0; o >>= 1) ss += __shfl_xor(ss, o);
                const float r = rsqrtf(ss * (1.0f / 1024.0f) + 1e-6f);
#pragma unroll
                for (int c = 0; c < 4; ++c) {
#pragma unroll
                    for (int q4 = 0; q4 < 4; ++q4) {
                        const f32x4 fv = *(const f32x4*)(fg + c * 256 + q4 * 4);
                        f32x4 ov;
#pragma unroll
                        for (int j = 0; j < 4; ++j) ov[j] = acc[c * 16 + q4 * 4 + j] * r * fv[j];
                        *(f32x4*)(xo + c * 256 + q4 * 4) = ov;
                    }
                    asm volatile("" ::: "memory");
                }
            }
            LDS_FENCE();
          }
        }
    }
}

__global__ void __launch_bounds__(512, 2) mega(Params p) {
    extern __shared__ __attribute__((aligned(16))) unsigned char shm[];
    LAS unsigned char* lds = (LAS unsigned char*)shm;
    cg::grid_group grid = cg::this_grid();
    unsigned char* ws = p.ws;
    const int G = (int)gridDim.x, c = (int)blockIdx.x;
    unsigned* bar = (unsigned*)(ws + OFF_BAR); unsigned epoch = 0;

    if (p.ws == nullptr) grid.sync();
    phase0(p, (float*)shm);
    grid_bar(bar, epoch, (unsigned)G);
    phase1(p, (float*)shm);
    grid_bar(bar, epoch, (unsigned)G);
    {
        pg8::StaticOrder S; S.init(NTOK, INC, G, c);
        pg8::Gemm g{ws + OFF_R1, ws + OFF_WINT, 1024, 1024, NTOK, INC, 1024, 0};
        EpiIn E{(h16*)(ws + OFF_QB), (h16*)(ws + OFF_KB), (h16*)(ws + OFF_VT), (h16*)(ws + OFF_GUV), (h16*)(ws + OFF_GATES)};
        pg8::gemm_phase(lds, g, S, E);
        pg8::StaticOrder S2; S2.init(NCTXT, 1024, G, c);
        pg8::Gemm g2{ws + OFF_HC, ws + OFF_WINT + (size_t)512 * 1024 * 2, 1024, 1024, NCTXT, 1024, 1024, 0};
        EpiCtx E2{(h16*)(ws + OFF_KC), (h16*)(ws + OFF_VCT)};
        pg8::gemm_phase(lds, g2, S2, E2);
    }
    grid_bar(bar, epoch, (unsigned)G);
    {
        for (int rep3 = 0; rep3 < REP_P3; ++rep3) {
        for (int u = c; u < 512; u += G) attn_unit(p, u);
        for (int n = c; n < 256; n += G) sgu_unit(p, n, lds);
        }
    }
    grid_bar(bar, epoch, (unsigned)G);
    {
        pg8::StaticOrder S; S.init(NTOK, 1024, G, c);
        pg8::Gemm ga{ws + OFF_R1, ws + OFF_WPAT, 1024, 512, NTOK, 1024, 512, 0};
        EpiM1 E1{(h16*)(ws + OFF_M1), (const h16*)(ws + OFF_GATES)};
        pg8::gemm_phase(lds, ga, S, E1);
        pg8::Gemm gb{ws + OFF_R1 + 1024, ws + OFF_WPBT, 1024, 512, NTOK, 1024, 512, 0};
        EpiM2 E2{(const h16*)(ws + OFF_M1), (const h16*)(ws + OFF_GATES), (h16*)(ws + OFF_MM)};
        pg8::gemm_phase(lds, gb, S, E2);
    }
    grid_bar(bar, epoch, (unsigned)G);
    {
        pg8::StaticOrder S; S.init(NTOK, 1024, G, c);
        pg8::Gemm g{ws + OFF_MM, ws + OFF_WOUTT, 1024, 1024, NTOK, 1024, 1024, 0};
        EpiX1 E{p.in[I_X], (const float*)(ws + OFF_MOD), p.out};
        pg8::gemm_phase(lds, g, S, E);
    }
    grid_bar(bar, epoch, (unsigned)G);
    phase6(p, (float*)shm);
    grid_bar(bar, epoch, (unsigned)G);
    {
        pg8::StaticOrder S; S.init(NTOK, 2048, G, c);
        pg8::Gemm g{ws + OFF_R1, ws + OFF_WQT, 1024, 1024, NTOK, 2048, 1024, 0};
        EpiH16 E{(h16*)(ws + OFF_SC16), 2048};
        pg8::gemm_phase(lds, g, S, E);
    }
    grid_bar(bar, epoch, (unsigned)G);
    peer_phase(p, lds, bar, epoch);
}

extern "C" void kernel_launch(void* const* d_in, const int* in_sizes, int n_in, void* d_out, int out_size, void* d_ws, size_t ws_size, hipStream_t stream) {
    static int grid_blocks = 0;
    if (!grid_blocks) {
        int dev = 0, cus = 0, per_cu = 0;
        hipGetDevice(&dev);
        hipDeviceGetAttribute(&cus, hipDeviceAttributeMultiprocessorCount, dev);
        hipFuncSetAttribute((const void*)mega, hipFuncAttributeMaxDynamicSharedMemorySize, LDS_BYTES);
        hipOccupancyMaxActiveBlocksPerMultiprocessor(&per_cu, (const void*)mega, 512, LDS_BYTES);
        if (per_cu < 1) per_cu = 1;
        grid_blocks = cus * per_cu;
        if (ws_size < WS_END) fprintf(stderr, "kernel_launch: workspace too small: %zu < %zu\n", ws_size, (size_t)WS_END);
    }
    hipMemsetAsync((unsigned char*)d_ws + OFF_BAR, 0, 256, stream);
    Params p{};
    for (int i = 0; i < 21; ++i) p.in[i] = (const float*)d_in[i];
    p.out = (float*)d_out; p.ws = (unsigned char*)d_ws;
    void* args[] = {&p};
    hipError_t e = hipLaunchCooperativeKernel((const void*)mega, dim3(grid_blocks), dim3(512), args, LDS_BYTES, stream);
    if (e != hipSuccess) fprintf(stderr, "cooperative launch failed: %s (grid %d)\n", hipGetErrorString(e), grid_blocks);
}
```

```cpp
#include <hip/hip_runtime.h>
#include <hip/hip_cooperative_groups.h>
#include <cstdio>
namespace cg = cooperative_groups;

#define LAS __attribute__((address_space(3)))
typedef _Float16 h16;
typedef _Float16 h16x2 __attribute__((ext_vector_type(2)));
typedef _Float16 h16x4 __attribute__((ext_vector_type(4)));
typedef _Float16 h16x8 __attribute__((ext_vector_type(8)));
typedef float f32x4 __attribute__((ext_vector_type(4)));
typedef float f32x2 __attribute__((ext_vector_type(2)));
typedef int i32x4 __attribute__((ext_vector_type(4)));
typedef int i32x2 __attribute__((ext_vector_type(2)));

constexpr int NTOK = 32768, DM = 1024, NCTXT = 4096, INC = 4608, SEQ = 2048, CTXL = 256;
constexpr int LDS_BYTES = 144 * 1024;
#ifndef REP_SEL
#define REP_SEL 1
#endif
#ifndef REP_GATH
#define REP_GATH 1
#endif
#ifndef REP_P3
#define REP_P3 1
#endif

constexpr size_t al256(size_t x) { return (x + 255) & ~(size_t)255; }
constexpr size_t OFF_WINT = 0;
constexpr size_t OFF_WPAT = OFF_WINT + (size_t)INC * DM * 2;
constexpr size_t OFF_WPBT = OFF_WPAT + (size_t)1024 * 512 * 2;
constexpr size_t OFF_WOUTT = OFF_WPBT + (size_t)1024 * 512 * 2;
constexpr size_t OFF_WQT = OFF_WOUTT + (size_t)1024 * 1024 * 2;
constexpr size_t OFF_BD = OFF_WQT + (size_t)2048 * 1024 * 2;
constexpr size_t OFF_U16 = OFF_BD + (size_t)2048 * 256 * 2;
constexpr size_t OFF_V16 = OFF_U16 + (size_t)16384 * 1024 * 2;
constexpr size_t OFF_WS16 = OFF_V16 + (size_t)16384 * 1024 * 2;
constexpr size_t OFF_MODP = OFF_WS16 + (size_t)8 * 128 * 128 * 2;
constexpr size_t OFF_MOD = OFF_MODP + (size_t)16 * 17 * 6144 * 4;
constexpr size_t OFF_R1 = al256(OFF_MOD + (size_t)17 * 6144 * 4);
constexpr size_t OFF_QB = OFF_R1 + (size_t)NTOK * DM * 2;
constexpr size_t OFF_KB = OFF_QB + (size_t)NTOK * 512 * 2;
constexpr size_t OFF_VT = OFF_KB + (size_t)NTOK * 512 * 2;
constexpr size_t OFF_GUV = OFF_VT + (size_t)NTOK * 512 * 2;
constexpr size_t OFF_GATES = OFF_GUV + (size_t)NTOK * 1024 * 2;
constexpr size_t OFF_MM = OFF_GATES + (size_t)NTOK * 2048 * 2;
constexpr size_t OFF_BAR = OFF_MM + (size_t)NTOK * DM * 2;
constexpr size_t WS_END = OFF_BAR + 256;
constexpr size_t OFF_U8 = OFF_U16;
constexpr size_t OFF_USC = OFF_V16;
constexpr size_t OFF_V8 = OFF_V16;
constexpr size_t OFF_VSC = OFF_V16 + (size_t)16384 * 1024;
constexpr size_t OFF_M1 = OFF_QB;
constexpr size_t OFF_SC16 = OFF_QB;
constexpr size_t OFF_Q16 = OFF_GATES;
constexpr size_t OFF_HC = OFF_MM;
constexpr size_t OFF_KC = OFF_HC + (size_t)NCTXT * DM * 2;
constexpr size_t OFF_VCT = OFF_KC + (size_t)NCTXT * 512 * 2;
static_assert(OFF_M1 + (size_t)NTOK * DM * 4 <= OFF_GATES, "m1 alias");
static_assert(WS_END <= (size_t)512 * 1024 * 1024, "workspace");

struct Params {
    const float* in[21];
    float* out;
    unsigned char* ws;
};
enum { I_X = 0, I_C, I_CTX, I_CCTX, I_ADAW, I_ADAB, I_N1G, I_N2G, I_WIN, I_RPB, I_LNG, I_GMWS, I_GMBS, I_WPA, I_WPB, I_WOUT, I_WQ, I_KEYS, I_PU, I_PV, I_FG };

__device__ __forceinline__ int launder(int x) { asm volatile("" : "+v"(x)); return x; }
__device__ __forceinline__ int fresh_tid() { int t = threadIdx.x; asm volatile("" : "+v"(t)); return t; }

__device__ __forceinline__ float sigmoidf_(float x) { return __builtin_amdgcn_rcpf(1.0f + __expf(-x)); }
__device__ __forceinline__ float gelu_tanh(float x) {
    const float t = 0.7978845608028654f * (x + 0.044715f * x * x * x);
    return x * __builtin_amdgcn_rcpf(1.0f + __expf(-2.0f * t));
}
__device__ __forceinline__ float silu_(float x) { return x * __builtin_amdgcn_rcpf(1.0f + __expf(-x)); }
__device__ __forceinline__ float wave_sum(float v) {
#pragma unroll
    for (int o = 32; o > 0; o >>= 1) v += __shfl_xor(v, o);
    return v;
}
__device__ __forceinline__ h16x8 pack8(f32x4 a, f32x4 b) {
    h16x8 o;
    o[0] = (h16)a[0]; o[1] = (h16)a[1]; o[2] = (h16)a[2]; o[3] = (h16)a[3];
    o[4] = (h16)b[0]; o[5] = (h16)b[1]; o[6] = (h16)b[2]; o[7] = (h16)b[3];
    return o;
}


__device__ __forceinline__ void grid_bar(unsigned* ctr, unsigned& epoch, unsigned nblk) {
    __syncthreads();
    epoch += 1u;
    if (threadIdx.x == 0) {
        __builtin_amdgcn_fence(__ATOMIC_RELEASE, "agent");
        asm volatile("s_waitcnt vmcnt(0)" ::: "memory");
        __hip_atomic_fetch_add(ctr, 1u, __ATOMIC_RELAXED, __HIP_MEMORY_SCOPE_AGENT);
        const unsigned target = epoch * nblk;
        unsigned spins = 0;
        while (__hip_atomic_load(ctr, __ATOMIC_RELAXED, __HIP_MEMORY_SCOPE_AGENT) < target) { __builtin_amdgcn_s_sleep(2); if (++spins > (1u << 24)) break; }
        __builtin_amdgcn_fence(__ATOMIC_ACQUIRE, "agent");
        asm volatile("s_waitcnt vmcnt(0)" ::: "memory");
    }
    __syncthreads();
}

namespace pg8 {
constexpr int BM = 256, BK = 64, HALF = 128, HTB = HALF * BK * 2, STAGE_BYTES = 8 * HTB, NXCD = 8, WGM = 8;
__device__ __forceinline__ int lds_byte(int r, int c) { const int st = (r >> 4) * 2 + (c >> 5), rr = r & 15, cc = c & 31, ob = rr * 64 + cc * 2; return st * 1024 + (ob ^ (((ob >> 9) & 1) << 5)); }
__device__ __forceinline__ void stage_rc(int b, int& R, int& C) { const int st = b / 1024, sb = b % 1024, swz = sb ^ (((sb >> 9) & 1) << 5); R = (st >> 1) * 16 + swz / 64; C = (st & 1) * 32 + (swz % 64) / 2; }
__device__ __forceinline__ int perm32(int rho) { const int n = rho >> 4, i = rho & 15; return 8 * (i >> 2) + 4 * n + (i & 3); }

struct Unit { int pm, pn; };
struct Gemm { const void* A; const void* Bt; int lda, ldb, M, N, K, a_pn_bytes; };

struct StaticOrder {
    int nM, nN, nwg, G, c;
    __device__ void init(int M, int N, int G_, int c_) { nM = M / BM; nN = N / BM; nwg = nM * nN; G = G_; c = c_; }
    __device__ bool next(int i, Unit& u) const {
        const long L = (long)i * G + c; if (L >= nwg) return false;
        int wgid = (int)L; { const int q = nwg / NXCD, r = nwg % NXCD, xcd = wgid % NXCD, off = wgid / NXCD; wgid = (xcd < r ? xcd * (q + 1) : r * (q + 1) + (xcd - r) * q) + off; }
        const int nig = WGM * nN, gid = wgid / nig, fm = gid * WGM, gsz = (nM - fm) < WGM ? (nM - fm) : WGM;
        u.pm = fm + ((wgid % nig) % gsz); u.pn = (wgid % nig) / gsz; return true;
    }
};

template <class Epi>
__device__ __forceinline__ void gemm_phase(LAS unsigned char* lds, const Gemm g, const StaticOrder& S, const Epi& E) {
    const int tid = fresh_tid(), wid = __builtin_amdgcn_readfirstlane(tid >> 6), lane = tid & 63, wr = wid >> 2, wc = wid & 3, fr = lane & 15, fq = lane >> 4;
    const int K = g.K, nt = K / BK;
    unsigned voffA[2], voffB[2];
#pragma unroll
    for (int i = 0; i < 2; ++i) { int R, C; stage_rc(tid * 16 + i * 8192, R, C); const int Rb = (R & ~31) + perm32(R & 31);
        voffA[i] = (unsigned)(R * g.lda + C) * 2u; voffB[i] = (unsigned)(Rb * g.ldb + C) * 2u; }
    const size_t kstep = (size_t)(BK * 2);
    const size_t hstepA = (size_t)HALF * g.lda * 2, hstepB = (size_t)HALF * g.ldb * 2;
    const size_t tstepA = 2 * hstepA, tstepB = 2 * hstepB;
    const unsigned ldsw = (unsigned)wid * 1024u;
    const int aoff = lds_byte(wr * 64 + fr, fq * 8), boff = lds_byte(wc * 32 + fr, fq * 8);
#define PG8_SA(b, h) (((b) * 2 + (h)) * HTB)
#define PG8_SB(b, h) ((4 + (b) * 2 + (h)) * HTB)
#define PG8_STAGE(bufoff, gbase, voff) do { _Pragma("unroll") for (int _i = 0; _i < 2; ++_i) \
        __builtin_amdgcn_global_load_lds((const unsigned*)((const char*)(gbase) + (voff)[_i]), (LAS unsigned*)(lds + (bufoff) + ldsw + _i * 8192), 16, 0, 0); } while (0)
#define PG8_LDA(dst, b, h) do { _Pragma("unroll") for (int m = 0; m < 4; ++m) _Pragma("unroll") for (int k = 0; k < 2; ++k) dst[m][k] = *(const LAS h16x8*)(lds + PG8_SA(b, h) + aoff + m * 2048 + k * 1024); } while (0)
#define PG8_LDB(dst, b, h) do { _Pragma("unroll") for (int n = 0; n < 2; ++n) _Pragma("unroll") for (int k = 0; k < 2; ++k) dst[n][k] = *(const LAS h16x8*)(lds + PG8_SB(b, h) + boff + n * 2048 + k * 1024); } while (0)
#define PG8_MMA(ai, bj, At, Bt) do { __builtin_amdgcn_s_setprio(1); _Pragma("unroll") for (int m = 0; m < 4; ++m) _Pragma("unroll") for (int n = 0; n < 2; ++n) _Pragma("unroll") for (int k = 0; k < 2; ++k) \
        acc[ai][bj][m][n] = __builtin_amdgcn_mfma_f32_16x16x32_f16(Bt[n][k], At[m][k], acc[ai][bj][m][n], 0, 0, 0); __builtin_amdgcn_s_setprio(0); } while (0)
#define PG8_WAIT_V(n) asm volatile("s_waitcnt vmcnt(" #n ")" ::: "memory")
#define PG8_WAIT_L(n) asm volatile("s_waitcnt lgkmcnt(" #n ")" ::: "memory")
#define PG8_BAR __builtin_amdgcn_s_barrier()
#define PG8_SCHED __builtin_amdgcn_sched_barrier(0)
    Unit cur, nxt; int ui = 0;
    if (!S.next(0, cur)) return;
    f32x4 acc[2][2][4][2];
#pragma unroll
    for (int a = 0; a < 2; ++a)
#pragma unroll
        for (int b = 0; b < 2; ++b)
#pragma unroll
            for (int m = 0; m < 4; ++m)
#pragma unroll
                for (int n = 0; n < 2; ++n) acc[a][b][m][n] = (f32x4){0.f, 0.f, 0.f, 0.f};
    h16x8 At[4][2], B0[2][2], B1[2][2];
    const char* cA = (const char*)g.A + (size_t)cur.pm * tstepA + (size_t)cur.pn * g.a_pn_bytes; const char* cB = (const char*)g.Bt + (size_t)cur.pn * tstepB;
    PG8_STAGE(PG8_SB(0, 0), cB, voffB); PG8_STAGE(PG8_SA(0, 0), cA, voffA); PG8_STAGE(PG8_SB(0, 1), cB + hstepB, voffB); PG8_STAGE(PG8_SA(0, 1), cA + hstepA, voffA);
    if (wr == 1) PG8_BAR;
    PG8_WAIT_V(4); PG8_BAR;
    PG8_STAGE(PG8_SB(1, 0), cB + kstep, voffB); PG8_STAGE(PG8_SA(1, 0), cA + kstep, voffA); PG8_STAGE(PG8_SB(1, 1), cB + hstepB + kstep, voffB);
    PG8_WAIT_V(6); PG8_BAR;
    for (;;) {
        const bool has_next = S.next(ui + 1, nxt);
        const char* nA = has_next ? (const char*)g.A + (size_t)nxt.pm * tstepA + (size_t)nxt.pn * g.a_pn_bytes : cA; const char* nB = has_next ? (const char*)g.Bt + (size_t)nxt.pn * tstepB : cB;
        for (int t = 0; t < nt; t += 2) {
            const bool last = (t == nt - 2);
            const char* a1 = cA + (size_t)(t + 1) * kstep;
            const char* a2 = last ? nA : cA + (size_t)(t + 2) * kstep; const char* b2 = last ? nB : cB + (size_t)(t + 2) * kstep;
            const char* a3 = a2 + kstep; const char* b3 = b2 + kstep;
            PG8_LDB(B0, 0, 0); PG8_SCHED; PG8_LDA(At, 0, 0); PG8_STAGE(PG8_SA(1, 1), a1 + hstepA, voffA);
            PG8_WAIT_L(8); PG8_BAR; PG8_WAIT_L(0); PG8_MMA(0, 0, At, B0); PG8_BAR; PG8_SCHED;
            PG8_LDB(B1, 0, 1); PG8_STAGE(PG8_SB(0, 0), b2, voffB);
            PG8_BAR; PG8_WAIT_L(0); PG8_MMA(0, 1, At, B1); PG8_BAR;
            PG8_LDA(At, 0, 1); PG8_STAGE(PG8_SA(0, 0), a2, voffA);
            PG8_BAR; PG8_WAIT_L(0); PG8_MMA(1, 0, At, B0); PG8_BAR; PG8_SCHED;
            PG8_STAGE(PG8_SB(0, 1), b2 + hstepB, voffB);
            PG8_WAIT_V(6); PG8_BAR; PG8_MMA(1, 1, At, B1); PG8_BAR;
            PG8_LDB(B0, 1, 0); PG8_SCHED; PG8_LDA(At, 1, 0); PG8_STAGE(PG8_SA(0, 1), a2 + hstepA, voffA);
            PG8_WAIT_L(8); PG8_BAR; PG8_WAIT_L(0); PG8_MMA(0, 0, At, B0); PG8_BAR; PG8_SCHED;
            PG8_LDB(B1, 1, 1); PG8_STAGE(PG8_SB(1, 0), b3, voffB);
            PG8_BAR; PG8_WAIT_L(0); PG8_MMA(0, 1, At, B1); PG8_BAR;
            PG8_LDA(At, 1, 1); PG8_STAGE(PG8_SA(1, 0), a3, voffA);
            PG8_BAR; PG8_WAIT_L(0); PG8_MMA(1, 0, At, B0); PG8_BAR; PG8_SCHED;
            PG8_STAGE(PG8_SB(1, 1), b3 + hstepB, voffB);
            PG8_WAIT_V(6); PG8_BAR; PG8_MMA(1, 1, At, B1); PG8_BAR;
        }
        E(acc, cur, wr, wc, fr, fq);
        if (!has_next) break;
#pragma unroll
        for (int a = 0; a < 2; ++a)
#pragma unroll
            for (int b = 0; b < 2; ++b)
#pragma unroll
                for (int m = 0; m < 4; ++m)
#pragma unroll
                    for (int n = 0; n < 2; ++n) acc[a][b][m][n] = (f32x4){0.f, 0.f, 0.f, 0.f};
        cur = nxt; cA = nA; cB = nB; ++ui;
    }
    PG8_WAIT_V(0);
    if (wr == 0) PG8_BAR;
    PG8_BAR;
#undef PG8_SA
#undef PG8_SB
#undef PG8_STAGE
#undef PG8_LDA
#undef PG8_LDB
#undef PG8_MMA
#undef PG8_WAIT_V
#undef PG8_WAIT_L
#undef PG8_BAR
#undef PG8_SCHED
}
}
typedef f32x4 AccT[2][2][4][2];

struct EpiIn {
    h16 *qb, *kb, *vt, *guv, *gates;
    __device__ __forceinline__ void operator()(const AccT& acc, const pg8::Unit& u, int wr, int wc, int fr, int fq) const {
        const int pn = u.pn;
        const int row0 = u.pm * 256 + wr * 64 + fr;
        const int cin = wc * 32 + 8 * fq;
        const int b = (u.pm * 256) >> 11, sb = ((u.pm * 256) & 2047) + wr * 64;
        if (pn < 2) {
            h16* base = qb + (size_t)row0 * 512 + pn * 256 + cin;
#pragma unroll
            for (int ai = 0; ai < 2; ++ai)
#pragma unroll
                for (int m = 0; m < 4; ++m)
#pragma unroll
                    for (int bj = 0; bj < 2; ++bj) *(h16x8*)(base + (ai * 128 + m * 16) * 512 + bj * 128) = pack8(acc[ai][bj][m][0], acc[ai][bj][m][1]);
        } else if (pn < 4) {
#pragma unroll
            for (int bj = 0; bj < 2; ++bj) {
                const int col = (pn & 1) * 256 + bj * 128 + cin, hd = col >> 6, d0 = col & 63;
                h16* base = kb + ((size_t)(b * 8 + hd) * 2048 + sb + fr) * 64 + d0;
#pragma unroll
                for (int ai = 0; ai < 2; ++ai)
#pragma unroll
                    for (int m = 0; m < 4; ++m) *(h16x8*)(base + (ai * 128 + m * 16) * 64) = pack8(acc[ai][bj][m][0], acc[ai][bj][m][1]);
            }
        } else if (pn < 6) {
#pragma unroll
            for (int bj = 0; bj < 2; ++bj) {
                const int cv = (pn - 4) * 256 + bj * 128 + cin, hd = cv >> 6, d0 = cv & 63;
                h16* base = vt + ((size_t)(b * 8 + hd) * 256 + (sb >> 3) + (fr >> 3)) * 512 + d0 * 8 + (fr & 7);
#pragma unroll
                for (int ai = 0; ai < 2; ++ai)
#pragma unroll
                    for (int m = 0; m < 4; ++m) {
                        h16* vp = base + (ai * 16 + m * 2) * 512;
                        const f32x4 v0 = acc[ai][bj][m][0], v1 = acc[ai][bj][m][1];
#pragma unroll
                        for (int i = 0; i < 4; ++i) { vp[i * 8] = (h16)v0[i]; vp[(i + 4) * 8] = (h16)v1[i]; }
                    }
            }
        } else if (pn < 10) {
            h16* base = guv + (size_t)row0 * 1024 + (pn - 6) * 256 + cin;
#pragma unroll
            for (int ai = 0; ai < 2; ++ai)
#pragma unroll
                for (int m = 0; m < 4; ++m)
#pragma unroll
                    for (int bj = 0; bj < 2; ++bj) {
                        f32x4 v0 = acc[ai][bj][m][0], v1 = acc[ai][bj][m][1];
#pragma unroll
                        for (int i = 0; i < 4; ++i) { v0[i] = gelu_tanh(v0[i]); v1[i] = gelu_tanh(v1[i]); }
                        *(h16x8*)(base + (ai * 128 + m * 16) * 1024 + bj * 128) = pack8(v0, v1);
                    }
        } else {
            h16* base = gates + (size_t)row0 * 2048 + (pn - 10) * 256 + cin;
#pragma unroll
            for (int ai = 0; ai < 2; ++ai)
#pragma unroll
                for (int m = 0; m < 4; ++m)
#pragma unroll
                    for (int bj = 0; bj < 2; ++bj) {
                        f32x4 v0 = acc[ai][bj][m][0], v1 = acc[ai][bj][m][1];
#pragma unroll
                        for (int i = 0; i < 4; ++i) { v0[i] = sigmoidf_(v0[i]); v1[i] = sigmoidf_(v1[i]); }
                        *(h16x8*)(base + (ai * 128 + m * 16) * 2048 + bj * 128) = pack8(v0, v1);
                    }
        }
    }
};
struct EpiCtx {
    h16 *kc, *vct;
    __device__ __forceinline__ void operator()(const AccT& acc, const pg8::Unit& u, int wr, int wc, int fr, int fq) const {
        const int pn = u.pn;
        const int cin = wc * 32 + 8 * fq;
        const int b = u.pm, sb = wr * 64;
        if (pn < 2) {
#pragma unroll
            for (int bj = 0; bj < 2; ++bj) {
                const int col = pn * 256 + bj * 128 + cin, hd = col >> 6, d0 = col & 63;
                h16* base = kc + ((size_t)(b * 8 + hd) * 256 + sb + fr) * 64 + d0;
#pragma unroll
                for (int ai = 0; ai < 2; ++ai)
#pragma unroll
                    for (int m = 0; m < 4; ++m) *(h16x8*)(base + (ai * 128 + m * 16) * 64) = pack8(acc[ai][bj][m][0], acc[ai][bj][m][1]);
            }
        } else {
#pragma unroll
            for (int bj = 0; bj < 2; ++bj) {
                const int cv = (pn - 2) * 256 + bj * 128 + cin, hd = cv >> 6, d0 = cv & 63;
                h16* base = vct + ((size_t)(b * 8 + hd) * 32 + (sb >> 3) + (fr >> 3)) * 512 + d0 * 8 + (fr & 7);
#pragma unroll
                for (int ai = 0; ai < 2; ++ai)
#pragma unroll
                    for (int m = 0; m < 4; ++m) {
                        h16* vp = base + (ai * 16 + m * 2) * 512;
                        const f32x4 v0 = acc[ai][bj][m][0], v1 = acc[ai][bj][m][1];
#pragma unroll
                        for (int i = 0; i < 4; ++i) { vp[i * 8] = (h16)v0[i]; vp[(i + 4) * 8] = (h16)v1[i]; }
                    }
            }
        }
    }
};
struct EpiM1 {
    h16* m1; const h16* gates;
    __device__ __forceinline__ void operator()(const AccT& acc, const pg8::Unit& u, int wr, int wc, int fr, int fq) const {
        const int row0 = u.pm * 256 + wr * 64 + fr, col0 = u.pn * 256 + wc * 32 + 8 * fq;
#pragma unroll
        for (int ai = 0; ai < 2; ++ai)
#pragma unroll
            for (int m = 0; m < 4; ++m) {
                const int row = row0 + ai * 128 + m * 16;
#pragma unroll
                for (int bj = 0; bj < 2; ++bj) {
                    const int col = col0 + bj * 128;
                    const h16x8 gt = *(const h16x8*)(gates + (size_t)row * 2048 + col);
                    f32x4 v0 = acc[ai][bj][m][0], v1 = acc[ai][bj][m][1];
#pragma unroll
                    for (int i = 0; i < 4; ++i) { v0[i] *= (float)gt[i]; v1[i] *= (float)gt[4 + i]; }
                    *(h16x8*)(m1 + (size_t)row * 1024 + col) = pack8(v0, v1);
                }
            }
    }
};
struct EpiM2 {
    const h16* m1; const h16* gates; h16* mm;
    __device__ __forceinline__ void operator()(const AccT& acc, const pg8::Unit& u, int wr, int wc, int fr, int fq) const {
        const int row0 = u.pm * 256 + wr * 64 + fr, col0 = u.pn * 256 + wc * 32 + 8 * fq;
#pragma unroll
        for (int ai = 0; ai < 2; ++ai)
#pragma unroll
            for (int m = 0; m < 4; ++m) {
                const int row = row0 + ai * 128 + m * 16;
#pragma unroll
                for (int bj = 0; bj < 2; ++bj) {
                    const int col = col0 + bj * 128;
                    const h16x8 gt = *(const h16x8*)(gates + (size_t)row * 2048 + 1024 + col);
                    const h16x8 mi = *(const h16x8*)(m1 + (size_t)row * 1024 + col);
                    f32x4 p0 = (f32x4){(float)mi[0], (float)mi[1], (float)mi[2], (float)mi[3]}, p1 = (f32x4){(float)mi[4], (float)mi[5], (float)mi[6], (float)mi[7]};
                    const f32x4 v0 = acc[ai][bj][m][0], v1 = acc[ai][bj][m][1];
#pragma unroll
                    for (int i = 0; i < 4; ++i) { p0[i] += v0[i] * (float)gt[i]; p1[i] += v1[i] * (float)gt[4 + i]; }
                    *(h16x8*)(mm + (size_t)row * 1024 + col) = pack8(p0, p1);
                }
            }
    }
};
struct EpiX1 {
    const float* x; const float* mod; float* x1;
    __device__ __forceinline__ void operator()(const AccT& acc, const pg8::Unit& u, int wr, int wc, int fr, int fq) const {
        const int row0 = u.pm * 256 + wr * 64 + fr, col0 = u.pn * 256 + wc * 32 + 8 * fq;
        const int b = (u.pm * 256) >> 11;
#pragma unroll
        for (int bj = 0; bj < 2; ++bj) {
            const int col = col0 + bj * 128;
            const float* gp = mod + (size_t)b * 6144 + 2 * 1024 + col;
            const f32x4 g0 = *(const f32x4*)gp, g1 = *(const f32x4*)(gp + 4);
#pragma unroll
            for (int ai = 0; ai < 2; ++ai)
#pragma unroll
                for (int m = 0; m < 4; ++m) {
                    const int row = row0 + ai * 128 + m * 16;
                    const float* xi = x + (size_t)row * 1024 + col;
                    const f32x4 x0 = *(const f32x4*)xi, x1v = *(const f32x4*)(xi + 4);
                    float* o = x1 + (size_t)row * 1024 + col;
                    *(f32x4*)o = x0 + g0 * acc[ai][bj][m][0]; *(f32x4*)(o + 4) = x1v + g1 * acc[ai][bj][m][1];
                }
        }
    }
};
struct EpiH16 {
    h16* o; int ldc;
    __device__ __forceinline__ void operator()(const AccT& acc, const pg8::Unit& u, int wr, int wc, int fr, int fq) const {
        const int row0 = u.pm * 256 + wr * 64 + fr, col0 = u.pn * 256 + wc * 32 + 8 * fq;
#pragma unroll
        for (int ai = 0; ai < 2; ++ai)
#pragma unroll
            for (int m = 0; m < 4; ++m) {
                const int row = row0 + ai * 128 + m * 16;
#pragma unroll
                for (int bj = 0; bj < 2; ++bj)
                    *(h16x8*)(o + (size_t)row * ldc + col0 + bj * 128) = pack8(acc[ai][bj][m][0], acc[ai][bj][m][1]);
            }
    }
};

__device__ __forceinline__ void cvt_tile(const float* __restrict__ src, h16* __restrict__ dst, int tile) {
    const size_t i = (size_t)tile * 4096 + threadIdx.x * 8;
    const f32x4 a = *(const f32x4*)(src + i), b = *(const f32x4*)(src + i + 4);
    *(h16x8*)(dst + i) = pack8(a, b);
}
__device__ __forceinline__ void tr_tile(const float* __restrict__ src, h16* __restrict__ dst, int K, int N, int tile, float* lds) {
    const int ntn = N / 64, tk = tile / ntn, tn = tile % ntn, tid = threadIdx.x;
#pragma unroll
    for (int ps = 0; ps < 2; ++ps) {
        const int k = ps * 32 + (tid >> 4), n = (tid & 15) * 4;
        const f32x4 v = *(const f32x4*)(src + (size_t)(tk * 64 + k) * N + tn * 64 + n);
        lds[k * 65 + n] = v[0]; lds[k * 65 + n + 1] = v[1]; lds[k * 65 + n + 2] = v[2]; lds[k * 65 + n + 3] = v[3];
    }
    __syncthreads();
    {
        const int n = tid >> 3, ks = (tid & 7) * 8;
        h16x8 o;
#pragma unroll
        for (int i = 0; i < 8; ++i) o[i] = (h16)lds[(ks + i) * 65 + n];
        *(h16x8*)(dst + (size_t)(tn * 64 + n) * K + tk * 64 + ks) = o;
    }
    __syncthreads();
}
__device__ __forceinline__ void cvt8_rows(const float* __restrict__ src, unsigned char* __restrict__ dst, float* __restrict__ inv, int tile, int dstride = 1024) {
    const int wid = threadIdx.x >> 6, lane = threadIdx.x & 63;
    const size_t row = (size_t)tile * 8 + wid;
    const float* r = src + row * 1024 + lane * 16;
    f32x4 a[4]; float mx = 0.f;
#pragma unroll
    for (int i = 0; i < 4; ++i) { a[i] = *(const f32x4*)(r + 4 * i); mx = fmaxf(mx, fmaxf(fmaxf(fabsf(a[i][0]), fabsf(a[i][1])), fmaxf(fabsf(a[i][2]), fabsf(a[i][3])))); }
#pragma unroll
    for (int o = 32; o > 0; o >>= 1) mx = fmaxf(mx, __shfl_xor(mx, o));
    int ex2 = 0; float sc = 1.0f;
    if (mx > 0.f) { (void)frexpf(mx, &ex2); int k = 8 - ex2; k = k > 100 ? 100 : (k < -100 ? -100 : k); sc = ldexpf(1.0f, k); }
    i32x4 w;
#pragma unroll
    for (int i = 0; i < 4; ++i) {
        int pk = __builtin_amdgcn_cvt_pk_fp8_f32(a[i][0] * sc, a[i][1] * sc, 0, false);
        pk = __builtin_amdgcn_cvt_pk_fp8_f32(a[i][2] * sc, a[i][3] * sc, pk, true);
        w[i] = pk;
    }
    *(i32x4*)(dst + row * dstride + lane * 16) = w;
    if (lane == 0) inv[2 * row] = 1.0f / sc;
}
__device__ __forceinline__ void cvt4_rows(const float* __restrict__ src, unsigned char* __restrict__ dst, float* __restrict__ inv, int tile, int dstride = 512) {
    const int wid = threadIdx.x >> 6, lane = threadIdx.x & 63;
    const size_t row = (size_t)tile * 8 + wid;
    const float* r = src + row * 1024 + lane * 16;
    f32x4 a[4]; float mx = 0.f;
#pragma unroll
    for (int i = 0; i < 4; ++i) { a[i] = *(const f32x4*)(r + 4 * i); mx = fmaxf(mx, fmaxf(fmaxf(fabsf(a[i][0]), fabsf(a[i][1])), fmaxf(fabsf(a[i][2]), fabsf(a[i][3])))); }
#pragma unroll
    for (int o = 32; o > 0; o >>= 1) mx = fmaxf(mx, __shfl_xor(mx, o));
    const float sc = (mx > 1e-30f) ? 6.0f / mx : 1.0f;
    int w0 = 0, w1 = 0;
    w0 = __builtin_amdgcn_cvt_scalef32_pk_fp4_f32(w0, a[0][0] * sc, a[0][1] * sc, 1.0f, 0);
    w0 = __builtin_amdgcn_cvt_scalef32_pk_fp4_f32(w0, a[0][2] * sc, a[0][3] * sc, 1.0f, 1);
    w0 = __builtin_amdgcn_cvt_scalef32_pk_fp4_f32(w0, a[1][0] * sc, a[1][1] * sc, 1.0f, 2);
    w0 = __builtin_amdgcn_cvt_scalef32_pk_fp4_f32(w0, a[1][2] * sc, a[1][3] * sc, 1.0f, 3);
    w1 = __builtin_amdgcn_cvt_scalef32_pk_fp4_f32(w1, a[2][0] * sc, a[2][1] * sc, 1.0f, 0);
    w1 = __builtin_amdgcn_cvt_scalef32_pk_fp4_f32(w1, a[2][2] * sc, a[2][3] * sc, 1.0f, 1);
    w1 = __builtin_amdgcn_cvt_scalef32_pk_fp4_f32(w1, a[3][0] * sc, a[3][1] * sc, 1.0f, 2);
    w1 = __builtin_amdgcn_cvt_scalef32_pk_fp4_f32(w1, a[3][2] * sc, a[3][3] * sc, 1.0f, 3);
    *(i32x2*)(dst + row * dstride + lane * 8) = (i32x2){w0, w1};
    if (lane == 0) inv[2 * row] = 1.0f / sc;
}
__device__ __forceinline__ void wqk_tile(const float* __restrict__ wq, const float* __restrict__ keys, h16* __restrict__ wt, int tile, float* lds) {
    const int ct = tile >> 4, hp = tile & 15, tid = threadIdx.x;
    float* sA = lds;
    float* sB = lds + 64 * 129;
#pragma unroll
    for (int i = 0; i < 4; ++i) {
        const int e = (i * 512 + tid) * 4, r = e >> 7, d = e & 127;
        const f32x4 v = *(const f32x4*)(wq + (size_t)(ct * 64 + r) * 2048 + hp * 128 + d);
        sA[r * 129 + d] = v[0]; sA[r * 129 + d + 1] = v[1]; sA[r * 129 + d + 2] = v[2]; sA[r * 129 + d + 3] = v[3];
    }
#pragma unroll
    for (int i = 0; i < 8; ++i) {
        const int e = (i * 512 + tid) * 4, k = e >> 7, d = e & 127;
        const f32x4 v = *(const f32x4*)(keys + (size_t)(hp * 128 + k) * 128 + d);
        sB[k * 129 + d] = v[0]; sB[k * 129 + d + 1] = v[1]; sB[k * 129 + d + 2] = v[2]; sB[k * 129 + d + 3] = v[3];
    }
    __syncthreads();
    const int c = tid >> 3, kg = (tid & 7) * 16;
    float acc[16];
#pragma unroll
    for (int j = 0; j < 16; ++j) acc[j] = 0.f;
#pragma unroll 4
    for (int d = 0; d < 128; ++d) {
        const float a = sA[c * 129 + d];
#pragma unroll
        for (int j = 0; j < 16; ++j) acc[j] += a * sB[(kg + j) * 129 + d];
    }
#pragma unroll
    for (int j = 0; j < 16; ++j) wt[(size_t)(hp * 128 + kg + j) * 1024 + ct * 64 + c] = (h16)acc[j];
    __syncthreads();
}
__device__ void phase0(const Params& p, float* lds) {
    unsigned char* ws = p.ws;
    const int tid = threadIdx.x, wid = tid >> 6, lane = tid & 63;
    for (int ib = blockIdx.x; ib < 256; ib += gridDim.x) {
        if (wid < 6) {
            const int item = ib * 6 + wid, cg64 = item % 96, kc = item / 96;
            const int col = cg64 * 64 + lane, k0 = kc * 64;
            float sv[17], acc[17];
#pragma unroll
            for (int b = 0; b < 17; ++b) {
                const float cv = (b < 16) ? p.in[I_C][b * 1024 + k0 + lane] : p.in[I_CCTX][k0 + lane];
                sv[b] = silu_(cv); acc[b] = 0.f;
            }
            const float* wp = p.in[I_ADAW] + (size_t)k0 * 6144 + col;
            for (int j = 0; j < 64; ++j) {
                const float w = wp[(size_t)j * 6144];
#pragma unroll
                for (int b = 0; b < 17; ++b) acc[b] += __builtin_bit_cast(float, __builtin_amdgcn_readlane(__builtin_bit_cast(int, sv[b]), j)) * w;
            }
            float* mp = (float*)(ws + OFF_MODP);
#pragma unroll
            for (int b = 0; b < 17; ++b) mp[((size_t)kc * 17 + b) * 6144 + col] = acc[b];
        }
    }
    constexpr int T0 = 2048, T1 = T0 + 2048, T2 = T1 + 32, T3 = T2, T4 = T3 + 1152, T5 = T4 + 128, T6 = T5 + 128, T7 = T6 + 256, T8 = T7 + 256;
    for (int t = blockIdx.x; t < T8; t += gridDim.x) {
        if (t < T0) cvt4_rows(p.in[I_PU], ws + OFF_U8, (float*)(ws + OFF_USC), t, 1536);
        else if (t < T1) cvt8_rows(p.in[I_PV], ws + OFF_U8 + 512, (float*)(ws + OFF_USC) + 1, t - T0, 1536);
        else if (t < T2) cvt_tile(p.in[I_GMWS], (h16*)(ws + OFF_WS16), t - T1);
        else if (t < T3) {
            const int e = (t - T2) * 4096 + tid * 8;
            const int row = e >> 8, cc = e & 255, h = row >> 8, pp = (row >> 7) & 1, k = row & 127, pq = cc >> 7, d = cc & 127;
            h16x8 o = {0, 0, 0, 0, 0, 0, 0, 0};
            if (pp == pq) {
                const float* kp = p.in[I_KEYS] + ((size_t)((h * 2 + pp) * 128 + k)) * 128 + d;
                o = pack8(*(const f32x4*)kp, *(const f32x4*)(kp + 4));
            }
            *(h16x8*)((h16*)(ws + OFF_BD) + e) = o;
        }
        else if (t < T4) tr_tile(p.in[I_WIN], (h16*)(ws + OFF_WINT), 1024, INC, t - T3, lds);
        else if (t < T5) tr_tile(p.in[I_WPA], (h16*)(ws + OFF_WPAT), 512, 1024, t - T4, lds);
        else if (t < T6) tr_tile(p.in[I_WPB], (h16*)(ws + OFF_WPBT), 512, 1024, t - T5, lds);
        else if (t < T7) tr_tile(p.in[I_WOUT], (h16*)(ws + OFF_WOUTT), 1024, 1024, t - T6, lds);
        else wqk_tile(p.in[I_WQ], p.in[I_KEYS], (h16*)(ws + OFF_WQT), t - T7, lds);
    }
}

__device__ __forceinline__ void norm_rows(const float* __restrict__ src, h16* __restrict__ dst, int row_begin, int rows_per_wave, const float* sA, const float* sB) {
    const int tid_ = fresh_tid();
    const int wid = tid_ >> 6, lane = tid_ & 63;
    f32x4 a[4], bsh[4];
#pragma unroll
    for (int c = 0; c < 4; ++c) { a[c] = *(const f32x4*)(sA + c * 256 + lane * 4); bsh[c] = *(const f32x4*)(sB + c * 256 + lane * 4); }
    for (int i = 0; i < rows_per_wave; i += 2) {
        const size_t row = (size_t)row_begin + wid * rows_per_wave + i;
        f32x4 v[2][4]; float ss[2];
#pragma unroll
        for (int q = 0; q < 2; ++q) {
            ss[q] = 0.f;
#pragma unroll
            for (int c = 0; c < 4; ++c) { v[q][c] = *(const f32x4*)(src + (row + q) * 1024 + c * 256 + lane * 4); ss[q] += v[q][c][0] * v[q][c][0] + v[q][c][1] * v[q][c][1] + v[q][c][2] * v[q][c][2] + v[q][c][3] * v[q][c][3]; }
        }
#pragma unroll
        for (int o = 32; o > 0; o >>= 1) { const float t0 = __shfl_xor(ss[0], o), t1 = __shfl_xor(ss[1], o); ss[0] += t0; ss[1] += t1; }
#pragma unroll
        for (int q = 0; q < 2; ++q) {
            const float r = rsqrtf(ss[q] * (1.0f / 1024.0f) + 1e-6f);
#pragma unroll
            for (int c = 0; c < 4; ++c) {
                h16x4 o;
#pragma unroll
                for (int j = 0; j < 4; ++j) o[j] = (h16)(v[q][c][j] * r * a[c][j] + bsh[c][j]);
                *(h16x4*)(dst + (row + q) * 1024 + c * 256 + lane * 4) = o;
            }
        }
    }
}
__device__ void phase1(const Params& p, float* lds) {
    unsigned char* ws = p.ws;
    const int tid = threadIdx.x;
    const float* mp = (const float*)(ws + OFF_MODP);
    const float* bias = p.in[I_ADAB];
    float* sA = lds; float* sB = lds + 1024; float* cA = lds + 2048; float* cB = lds + 3072;
    {
        float* mod = (float*)(ws + OFF_MOD);
        for (int e = blockIdx.x * 512 + tid; e < 17 * 6144; e += gridDim.x * 512) {
            float s = bias[e % 6144];
#pragma unroll
            for (int kc = 0; kc < 16; ++kc) s += mp[(size_t)kc * 17 * 6144 + e];
            mod[e] = s;
        }
    }
    for (int col = tid; col < 1024; col += 512) {
        float sh = bias[col], sc = bias[1024 + col];
#pragma unroll
        for (int kc = 0; kc < 16; ++kc) { sh += mp[((size_t)kc * 17 + 16) * 6144 + col]; sc += mp[((size_t)kc * 17 + 16) * 6144 + 1024 + col]; }
        cA[col] = p.in[I_N1G][col] * (1.0f + sc); cB[col] = sh;
    }
    for (int rg = blockIdx.x; rg < 256; rg += gridDim.x) {
        const int b = rg >> 4;
        __syncthreads();
        for (int col = tid; col < 1024; col += 512) {
            float sh = bias[col], sc = bias[1024 + col];
#pragma unroll
            for (int kc = 0; kc < 16; ++kc) { sh += mp[((size_t)kc * 17 + b) * 6144 + col]; sc += mp[((size_t)kc * 17 + b) * 6144 + 1024 + col]; }
            sA[col] = p.in[I_N1G][col] * (1.0f + sc); sB[col] = sh;
        }
        __syncthreads();
        norm_rows(p.in[I_X], (h16*)(ws + OFF_R1), rg * 128, 16, sA, sB);
        norm_rows(p.in[I_CTX], (h16*)(ws + OFF_HC), rg * 16, 2, cA, cB);
    }
}
__device__ void phase6(const Params& p, float* lds) {
    unsigned char* ws = p.ws;
    const int tid = threadIdx.x;
    const float* mod = (const float*)(ws + OFF_MOD);
    float* sA = lds; float* sB = lds + 1024;
    for (int rg = blockIdx.x; rg < 256; rg += gridDim.x) {
        const int b = rg >> 4;
        __syncthreads();
        for (int col = tid; col < 1024; col += 512) {
            sA[col] = p.in[I_N2G][col] * (1.0f + mod[(size_t)b * 6144 + 4 * 1024 + col]); sB[col] = mod[(size_t)b * 6144 + 3 * 1024 + col];
        }
        __syncthreads();
        norm_rows(p.out, (h16*)(ws + OFF_R1), rg * 128, 16, sA, sB);
    }
}

__device__ __forceinline__ int clampi(int v, int lo, int hi) { return v < lo ? lo : (v > hi ? hi : v); }

template <bool LOCAL>
__device__ __forceinline__ void attn_core(const h16x8 (&kf)[2][2], const h16x8 (&vf)[4], const float* __restrict__ rpbrow, const int cb, const int qc, const int cs,
                                          const h16x8 (&qf)[2], float& m_run, float& l_run, f32x4 (&O)[4], const int quad) {
    f32x4 st[2];
#pragma unroll
    for (int t = 0; t < 2; ++t) {
        f32x4 a = (f32x4){0.f, 0.f, 0.f, 0.f};
#pragma unroll
        for (int ks = 0; ks < 2; ++ks) a = __builtin_amdgcn_mfma_f32_16x16x32_f16(kf[t][ks], qf[ks], a, 0, 0, 0);
        st[t] = a;
    }
    float mx = -INFINITY;
#pragma unroll
    for (int t = 0; t < 2; ++t)
#pragma unroll
        for (int j = 0; j < 4; ++j) {
            float sv = st[t][j] * 0.125f;
            if (LOCAL) {
                const int kc = cb + 16 * t + quad * 4 + j;
                const bool inw = (kc >= cs) && (kc < cs + 16);
                const int dc = clampi(kc - qc + 15, 0, 30);
                const float bv = rpbrow[dc];
                sv = inw ? (sv + bv) : -1e30f;
            }
            st[t][j] = sv; mx = fmaxf(mx, sv);
        }
    mx = fmaxf(mx, __shfl_xor(mx, 16)); mx = fmaxf(mx, __shfl_xor(mx, 32));
    const float m_new = fmaxf(m_run, mx);
    const float alpha = __expf(m_run - m_new);
    float ls = 0.f; h16x8 pf;
#pragma unroll
    for (int t = 0; t < 2; ++t)
#pragma unroll
        for (int j = 0; j < 4; ++j) { const float pe = __expf(st[t][j] - m_new); ls += pe; pf[t * 4 + j] = (h16)pe; }
    l_run = l_run * alpha + ls; m_run = m_new;
#pragma unroll
    for (int dt = 0; dt < 4; ++dt) { O[dt] *= alpha; O[dt] = __builtin_amdgcn_mfma_f32_16x16x32_f16(vf[dt], pf, O[dt], 0, 0, 0); }
}
__device__ __forceinline__ void load_kv(const h16* __restrict__ kt, const h16* __restrict__ vt, h16x8 (&kf)[2][2], h16x8 (&vf)[4], const int l15, const int quad) {
#pragma unroll
    for (int t = 0; t < 2; ++t)
#pragma unroll
        for (int ks = 0; ks < 2; ++ks) kf[t][ks] = *(const h16x8*)(kt + (16 * t + l15) * 64 + ks * 32 + quad * 8);
#pragma unroll
    for (int dt = 0; dt < 4; ++dt) {
        const h16* vp = vt + ((quad >> 1) * 64 + dt * 16 + l15) * 8 + (quad & 1) * 4;
        const h16x4 lo = *(const h16x4*)vp, hi = *(const h16x4*)(vp + 2 * 512);
        vf[dt] = (h16x8){lo[0], lo[1], lo[2], lo[3], hi[0], hi[1], hi[2], hi[3]};
    }
}

__device__ void attn_unit(const Params& p, int unit) {
    unsigned char* ws = p.ws;
    const int tid_ = fresh_tid();
    const int lane = tid_ & 63, h = tid_ >> 6, l15 = lane & 15, quad = lane >> 4;
    const int b = unit >> 5, r = unit & 31;
    const h16* QB = (const h16*)(ws + OFF_QB);
    const h16* KH = (const h16*)(ws + OFF_KB) + (size_t)(b * 8 + h) * 2048 * 64;
    const h16* VH = (const h16*)(ws + OFF_VT) + (size_t)(b * 8 + h) * 256 * 512;
    const h16* KCH = (const h16*)(ws + OFF_KC) + (size_t)(b * 8 + h) * 256 * 64;
    const h16* VCH = (const h16*)(ws + OFF_VCT) + (size_t)(b * 8 + h) * 32 * 512;
    h16* YA = (h16*)(ws + OFF_R1);
    const float* rpb = p.in[I_RPB] + (size_t)h * 15 * 31;
    const int rs = clampi(r - 4, 0, 24);
    h16x8 qf[4][2]; float m_run[4], l_run[4]; f32x4 O[4][4];
#pragma unroll
    for (int g = 0; g < 4; ++g) {
        const size_t tq = (size_t)b * 2048 + r * 64 + 16 * g + l15;
        qf[g][0] = *(const h16x8*)(QB + tq * 512 + h * 64 + quad * 8);
        qf[g][1] = *(const h16x8*)(QB + tq * 512 + h * 64 + 32 + quad * 8);
        m_run[g] = -INFINITY; l_run[g] = 0.f;
#pragma unroll
        for (int dt = 0; dt < 4; ++dt) O[g][dt] = (f32x4){0.f, 0.f, 0.f, 0.f};
    }
#pragma unroll 1
    for (int step = 0; step < 8; ++step) {
        h16x8 kf[2][2], vf[4];
        load_kv(KCH + step * 32 * 64, VCH + step * 4 * 512, kf, vf, l15, quad);
#pragma unroll
        for (int g = 0; g < 4; ++g) attn_core<false>(kf, vf, rpb, 0, 0, 0, qf[g], m_run[g], l_run[g], O[g], quad);
    }
#pragma unroll
    for (int gp = 0; gp < 4; gp += 2) {
        const int cb0 = clampi(16 * gp - 8, 0, 32), cb1 = clampi(16 * (gp + 1) - 8, 0, 32);
        const int qc0 = 16 * gp + l15, qc1 = 16 * (gp + 1) + l15;
        const int cs0 = clampi(qc0 - 8, 0, 48), cs1 = clampi(qc1 - 8, 0, 48);
        const float* rp0 = rpb + (rs - r + 7) * 31;
#pragma unroll 1
        for (int step = 0; step < 8; ++step) {
            const int t0 = (rs + step) * 64 + cb0, t1 = (rs + step) * 64 + cb1;
            h16x8 kf0[2][2], vf0[4], kf1[2][2], vf1[4];
            load_kv(KH + (size_t)t0 * 64, VH + (size_t)(t0 >> 3) * 512, kf0, vf0, l15, quad);
            load_kv(KH + (size_t)t1 * 64, VH + (size_t)(t1 >> 3) * 512, kf1, vf1, l15, quad);
            attn_core<true>(kf0, vf0, rp0 + step * 31, cb0, qc0, cs0, qf[gp], m_run[gp], l_run[gp], O[gp], quad);
            attn_core<true>(kf1, vf1, rp0 + step * 31, cb1, qc1, cs1, qf[gp + 1], m_run[gp + 1], l_run[gp + 1], O[gp + 1], quad);
        }
    }
#pragma unroll
    for (int g = 0; g < 4; ++g) {
        const size_t tq = (size_t)b * 2048 + r * 64 + 16 * g + l15;
        float l = l_run[g];
        l += __shfl_xor(l, 16); l += __shfl_xor(l, 32);
        const float inv = __builtin_amdgcn_rcpf(l);
#pragma unroll
        for (int dt = 0; dt < 4; ++dt) {
            h16x4 o;
#pragma unroll
            for (int j = 0; j < 4; ++j) o[j] = (h16)(O[g][dt][j] * inv);
            *(h16x4*)(YA + tq * 1024 + h * 64 + dt * 16 + quad * 4) = o;
        }
    }
}

__device__ void sgu_unit(const Params& p, int n, LAS unsigned char* lds) {
    unsigned char* ws = p.ws;
    const int tid = fresh_tid(), lane = tid & 63, g = tid >> 6, l15 = lane & 15, quad = lane >> 4;
    const h16* GUV = (const h16*)(ws + OFF_GUV);
    const h16* WS16 = (const h16*)(ws + OFF_WS16);
    h16* YB = (h16*)(ws + OFF_R1) + 512;
    LAS float* stat = (LAS float*)(lds + 8 * 17408);
    LAS h16* vt = (LAS h16*)(lds + g * 17408);
    const size_t t0 = (size_t)n * 128;
    __syncthreads();
    for (int i = 0; i < 16; i += 4) {
        h16x8 x[4]; float s[4], v[4];
#pragma unroll
        for (int q = 0; q < 4; ++q) {
            x[q] = *(const h16x8*)(GUV + (t0 + g * 16 + i + q) * 1024 + 512 + lane * 8);
            s[q] = 0.f;
#pragma unroll
            for (int j = 0; j < 8; ++j) s[q] += (float)x[q][j];
        }
#pragma unroll
        for (int o = 32; o > 0; o >>= 1) { float t[4];
#pragma unroll
            for (int q = 0; q < 4; ++q) t[q] = __shfl_xor(s[q], o);
#pragma unroll
            for (int q = 0; q < 4; ++q) s[q] += t[q]; }
#pragma unroll
        for (int q = 0; q < 4; ++q) {
            s[q] *= (1.0f / 512.0f); v[q] = 0.f;
#pragma unroll
            for (int j = 0; j < 8; ++j) { const float d = (float)x[q][j] - s[q]; v[q] += d * d; }
        }
#pragma unroll
        for (int o = 32; o > 0; o >>= 1) { float t[4];
#pragma unroll
            for (int q = 0; q < 4; ++q) t[q] = __shfl_xor(v[q], o);
#pragma unroll
            for (int q = 0; q < 4; ++q) v[q] += t[q]; }
        if (lane == 0) {
#pragma unroll
            for (int q = 0; q < 4; ++q) { stat[(g * 16 + i + q) * 2] = s[q]; stat[(g * 16 + i + q) * 2 + 1] = rsqrtf(v[q] * (1.0f / 512.0f) + 1e-6f); }
        }
    }
    __syncthreads();
    {
        const int ch0 = (lane & 7) * 8;
        float lg[8];
#pragma unroll
        for (int j = 0; j < 8; ++j) lg[j] = p.in[I_LNG][g * 64 + ch0 + j];
#pragma unroll 8
        for (int it = 0; it < 16; ++it) {
            const int q = it * 8 + (lane >> 3);
            const h16x8 x = *(const h16x8*)(GUV + (t0 + q) * 1024 + 512 + g * 64 + ch0);
            const float mean = stat[q * 2], rstd = stat[q * 2 + 1];
#pragma unroll
            for (int j = 0; j < 8; ++j) vt[(ch0 + j) * 136 + q] = (h16)(((float)x[j] - mean) * rstd * lg[j]);
        }
    }
    asm volatile("s_waitcnt lgkmcnt(0)" ::: "memory");
    __syncthreads();
    h16x8 af[4][4];
#pragma unroll
    for (int dt = 0; dt < 4; ++dt)
#pragma unroll
        for (int ks = 0; ks < 4; ++ks) af[dt][ks] = *(const LAS h16x8*)(vt + (dt * 16 + l15) * 136 + ks * 32 + quad * 8);
    const h16* wg = WS16 + (size_t)g * 128 * 128;
#pragma unroll 2
    for (int pt = 0; pt < 8; ++pt) {
        f32x4 acc[4];
#pragma unroll
        for (int dt = 0; dt < 4; ++dt) acc[dt] = (f32x4){0.f, 0.f, 0.f, 0.f};
#pragma unroll
        for (int ks = 0; ks < 4; ++ks) {
            const h16x8 bf = *(const h16x8*)(wg + (size_t)(pt * 16 + l15) * 128 + ks * 32 + quad * 8);
#pragma unroll
            for (int dt = 0; dt < 4; ++dt) acc[dt] = __builtin_amdgcn_mfma_f32_16x16x32_f16(af[dt][ks], bf, acc[dt], 0, 0, 0);
        }
        const int pp = pt * 16 + l15;
        const float bsv = p.in[I_GMBS][g * 128 + pp];
        const size_t tok = t0 + pp;
#pragma unroll
        for (int dt = 0; dt < 4; ++dt) {
            const int ch = g * 64 + dt * 16 + quad * 4;
            const h16x4 uu = *(const h16x4*)(GUV + tok * 1024 + ch);
            h16x4 o;
#pragma unroll
            for (int j = 0; j < 4; ++j) o[j] = (h16)((float)uu[j] * (acc[dt][j] + bsv));
            *(h16x4*)(YB + tok * 1024 + ch) = o;
        }
    }
    __syncthreads();
}

__device__ __forceinline__ float row16_sum_to_lane15(float v) {
    v += __builtin_bit_cast(float, __builtin_amdgcn_update_dpp(0, __builtin_bit_cast(int, v), 0x118, 0xf, 0xf, true));
    v += __builtin_bit_cast(float, __builtin_amdgcn_update_dpp(0, __builtin_bit_cast(int, v), 0x114, 0xf, 0xf, true));
    v += __builtin_bit_cast(float, __builtin_amdgcn_update_dpp(0, __builtin_bit_cast(int, v), 0x112, 0xf, 0xf, true));
    v += __builtin_bit_cast(float, __builtin_amdgcn_update_dpp(0, __builtin_bit_cast(int, v), 0x111, 0xf, 0xf, true));
    return v;
}
#define DPPF(v, ctrl) __builtin_bit_cast(float, __builtin_amdgcn_update_dpp(__builtin_bit_cast(int, v), __builtin_bit_cast(int, v), ctrl, 0xf, 0xf, false))
__device__ __forceinline__ float row16_allsum(float v) { v += DPPF(v, 0x128); v += DPPF(v, 0x124); v += DPPF(v, 0x122); v += DPPF(v, 0x121); return v; }
__device__ __forceinline__ float row16_allmax(float v) { v = fmaxf(v, DPPF(v, 0x128)); v = fmaxf(v, DPPF(v, 0x124)); v = fmaxf(v, DPPF(v, 0x122)); v = fmaxf(v, DPPF(v, 0x121)); return v; }
__device__ __forceinline__ int wave_incl_scan(int v) {
    v += __builtin_amdgcn_update_dpp(0, v, 0x111, 0xf, 0xf, false);
    v += __builtin_amdgcn_update_dpp(0, v, 0x112, 0xf, 0xf, false);
    v += __builtin_amdgcn_update_dpp(0, v, 0x114, 0xf, 0xf, false);
    v += __builtin_amdgcn_update_dpp(0, v, 0x118, 0xf, 0xf, false);
    v += __builtin_amdgcn_update_dpp(0, v, 0x142, 0xa, 0xf, false);
    v += __builtin_amdgcn_update_dpp(0, v, 0x143, 0xc, 0xf, false);
    return v;
}
__device__ __forceinline__ unsigned key16(unsigned short u) { return (u & 0x8000u) ? ((~(unsigned)u) & 0xFFFFu) : ((unsigned)u | 0x8000u); }
__device__ __forceinline__ unsigned key32(unsigned u) { return (u & 0x80000000u) ? ~u : (u | 0x80000000u); }
__device__ __forceinline__ float dot8(h16x8 a, h16x8 b, float c) {
    c = __builtin_amdgcn_fdot2((h16x2){a[0], a[1]}, (h16x2){b[0], b[1]}, c, false);
    c = __builtin_amdgcn_fdot2((h16x2){a[2], a[3]}, (h16x2){b[2], b[3]}, c, false);
    c = __builtin_amdgcn_fdot2((h16x2){a[4], a[5]}, (h16x2){b[4], b[5]}, c, false);
    c = __builtin_amdgcn_fdot2((h16x2){a[6], a[7]}, (h16x2){b[6], b[7]}, c, false);
    return c;
}
#define LDS_FENCE() asm volatile("s_waitcnt lgkmcnt(0)" ::: "memory")

__device__ void peer_phase(const Params& p, LAS unsigned char* lds, unsigned* bar, unsigned& epoch) {
    unsigned char* ws = p.ws;
    const int tid = fresh_tid(), wid = __builtin_amdgcn_readfirstlane(tid >> 6), lane = tid & 63;
    const unsigned long long lm = (1ull << lane) - 1ull;
    LAS unsigned char* wl = lds + wid * 11264;
    LAS float* s_top = (LAS float*)(wl);
    LAS int* i_top = (LAS int*)(wl + 1024);
    LAS int* ex = (LAS int*)(wl + 2048);
    LAS float* sc = (LAS float*)(wl + 2560);
    LAS int* uns_m = (LAS int*)(wl + 3072);
    LAS float* uns_g = (LAS float*)(wl + 3584);
    LAS int* cnt = (LAS int*)(wl + 4096);
    LAS int* base = (LAS int*)(wl + 4352);
    const int lead = (wid >= 4) ? 1 : 0;
    const unsigned short* SC = (const unsigned short*)(ws + OFF_SC16);
    const h16* H2 = (const h16*)(ws + OFF_R1);
    const unsigned char* U4 = ws + OFF_U8;
    const unsigned char* V8 = ws + OFF_V8;
    const float* USC = (const float*)(ws + OFF_USC);
    const float* VSC = (const float*)(ws + OFF_VSC);
    const float* mod = (const float*)(ws + OFF_MOD);
    const int grp = lane >> 4, li = lane & 15;
    for (int tg = blockIdx.x; tg < 256; tg += gridDim.x) {
        for (int it5 = 0; it5 < 5; ++it5) {
          if (it5 < 4) {
            const int round = it5;
            const size_t tok0 = (size_t)tg * 128 + wid * 16 + round * 4;
            LAS unsigned short* se = (LAS unsigned short*)(wl + 4608 + (round & 1) * 3072);
            LAS float* sw = (LAS float*)(wl + 4608 + (round & 1) * 3072 + 1024);
            for (int tt = 0; tt < 4; ++tt) {
                const size_t tok = tok0 + tt;
                cnt[lane] = 0;
                for (int L0 = 0; L0 < 16; L0 += 4) {
                    unsigned short ra[4], rb[4]; unsigned ka[4], kb[4], T[4];
#pragma unroll
                    for (int q = 0; q < 4; ++q) {
                        const unsigned short* sr = SC + tok * 2048 + (L0 + q) * 128;
                        ra[q] = sr[lane]; rb[q] = sr[64 + lane];
                        ka[q] = key16(ra[q]); kb[q] = key16(rb[q]); T[q] = 0;
                    }
                    for (int bit = 15; bit >= 0; --bit) {
#pragma unroll
                        for (int q = 0; q < 4; ++q) {
                            const unsigned cand = T[q] | (1u << bit);
                            const int cn = __popcll(__ballot(ka[q] >= cand)) + __popcll(__ballot(kb[q] >= cand));
                            T[q] = (cn >= 16) ? cand : T[q];
                        }
                    }
#pragma unroll
                    for (int q = 0; q < 4; ++q) {
                        const int L = L0 + q;
                        const int cnt_gt = __popcll(__ballot(ka[q] > T[q])) + __popcll(__ballot(kb[q] > T[q]));
                        const int need = 16 - cnt_gt;
                        const unsigned long long ea = __ballot(ka[q] == T[q]), eb = __ballot(kb[q] == T[q]);
                        const int ra_eq = __popcll(ea & lm), rb_eq = __popcll(ea) + __popcll(eb & lm);
                        const bool sa = (ka[q] > T[q]) || (ka[q] == T[q] && ra_eq < need);
                        const bool sb = (kb[q] > T[q]) || (kb[q] == T[q] && rb_eq < need);
                        const unsigned long long ma = __ballot(sa), mb = __ballot(sb);
                        const int pa = __popcll(ma & lm), pb = __popcll(ma) + __popcll(mb & lm);
                        if (sa) { s_top[L * 16 + pa] = (float)__builtin_bit_cast(h16, ra[q]); i_top[L * 16 + pa] = lane; }
                        if (sb) { s_top[L * 16 + pb] = (float)__builtin_bit_cast(h16, rb[q]); i_top[L * 16 + pb] = 64 + lane; }
                    }
                }
                LDS_FENCE();
                for (int h0 = 0; h0 < 8; h0 += 4) {
                    float cv[4][4]; unsigned kk[4][4], T[4];
#pragma unroll
                    for (int q = 0; q < 4; ++q) {
                        const int h = h0 + q;
                        const float bj = s_top[(2 * h + 1) * 16 + li];
#pragma unroll
                        for (int m = 0; m < 4; ++m) { cv[q][m] = s_top[(2 * h) * 16 + grp + 4 * m] + bj; kk[q][m] = key32(__builtin_bit_cast(unsigned, cv[q][m])); }
                        T[q] = 0;
                    }
                    for (int bit = 31; bit >= 0; --bit) {
#pragma unroll
                        for (int q = 0; q < 4; ++q) {
                            const unsigned cand = T[q] | (1u << bit);
                            int cn = 0;
#pragma unroll
                            for (int m = 0; m < 4; ++m) cn += __popcll(__ballot(kk[q][m] >= cand));
                            T[q] = (cn >= 16) ? cand : T[q];
                        }
                    }
#pragma unroll
                    for (int q = 0; q < 4; ++q) {
                        const int h = h0 + q;
                        int cnt_gt = 0;
#pragma unroll
                        for (int m = 0; m < 4; ++m) cnt_gt += __popcll(__ballot(kk[q][m] > T[q]));
                        const int need = 16 - cnt_gt;
                        int eq_before = 0, sel_before = 0;
#pragma unroll
                        for (int m = 0; m < 4; ++m) {
                            const unsigned long long em = __ballot(kk[q][m] == T[q]);
                            const int myeq = eq_before + __popcll(em & lm);
                            const bool sel = (kk[q][m] > T[q]) || (kk[q][m] == T[q] && myeq < need);
                            const unsigned long long sm = __ballot(sel);
                            const int pos = sel_before + __popcll(sm & lm);
                            if (sel) {
                                ex[h * 16 + pos] = i_top[(2 * h) * 16 + grp + 4 * m] * 128 + i_top[(2 * h + 1) * 16 + li];
                                sc[h * 16 + pos] = cv[q][m];
                            }
                            eq_before += __popcll(em); sel_before += __popcll(sm);
                        }
                    }
                }
                LDS_FENCE();
#pragma unroll
                for (int half = 0; half < 2; ++half) {
                    const int e = half * 64 + lane;
                    const float v = sc[e];
                    const float mx = row16_allmax(v);
                    const float pe = __expf(v - mx);
                    const float sm = row16_allsum(pe);
                    const float gate = pe * __builtin_amdgcn_rcpf(sm);
                    const int eid = ex[e];
                    const int pos = __hip_atomic_fetch_add(cnt + (eid >> 8), 1, __ATOMIC_RELAXED, __HIP_MEMORY_SCOPE_WORKGROUP);
                    uns_m[e] = eid | (pos << 14); uns_g[e] = gate;
                }
                LDS_FENCE();
                {
                    const int c = cnt[lane];
                    const int incl = wave_incl_scan(c);
                    base[lane] = incl - c;
                    LDS_FENCE();
#pragma unroll
                    for (int i = 0; i < 2; ++i) {
                        const int rm = uns_m[i * 64 + lane]; const float rg = uns_g[i * 64 + lane];
                        const int eid = rm & 16383, pos = rm >> 14;
                        const int dst = tt * 128 + base[eid >> 8] + pos;
                        se[dst] = (unsigned short)eid; sw[dst] = rg;
                    }
                    LDS_FENCE();
                }
            }
          }
          const int round = it5 - lead;
          if (round >= 0 && round < 4) {
            const size_t tok0 = (size_t)tg * 128 + wid * 16 + round * 4;
            LAS unsigned short* se = (LAS unsigned short*)(wl + 4608 + (round & 1) * 3072);
            LAS float* sw = (LAS float*)(wl + 4608 + (round & 1) * 3072 + 1024);
            const size_t tokg = tok0 + grp;
            const LAS unsigned short* me = se + grp * 128; LAS float* mw = sw + grp * 128;
            {
                const int li = launder(tid) & 15;
                h16x8 xr[2][4];
#pragma unroll
                for (int c = 0; c < 2; ++c)
#pragma unroll
                    for (int j = 0; j < 4; ++j) xr[c][j] = *(const h16x8*)(H2 + tokg * 1024 + c * 512 + li * 32 + 8 * j);
                float acc[64];
#pragma unroll
                for (int i = 0; i < 64; ++i) acc[i] = 0.f;
                i32x4 ru[2][2], rv[2][4]; float su[2], sv[2];
#define ELD(J, S_) do { const int e_ = me[(S_)]; const unsigned char* rp_ = U4 + (size_t)e_ * 1536 + li * 16; \
        ru[J][0] = *(const i32x4*)rp_; ru[J][1] = *(const i32x4*)(rp_ + 256); \
        _Pragma("unroll") for (int c = 0; c < 4; ++c) rv[J][c] = *(const i32x4*)(rp_ + 512 + c * 256); \
        { const f32x2 s2_ = *(const f32x2*)(USC + 2 * e_); su[J] = s2_.x; sv[J] = s2_.y; } } while (0)
#define ECP(J, S_) do { float d = 0.f; \
        _Pragma("unroll") for (int c = 0; c < 2; ++c) _Pragma("unroll") for (int k = 0; k < 4; ++k) { const h16x8 xv = xr[c][k]; const int w_ = ru[J][c][k]; \
            d = __builtin_amdgcn_fdot2(__builtin_amdgcn_cvt_scalef32_pk_f16_fp4(w_, 1.0f, 0), (h16x2){xv[0], xv[1]}, d, false); \
            d = __builtin_amdgcn_fdot2(__builtin_amdgcn_cvt_scalef32_pk_f16_fp4(w_, 1.0f, 1), (h16x2){xv[2], xv[3]}, d, false); \
            d = __builtin_amdgcn_fdot2(__builtin_amdgcn_cvt_scalef32_pk_f16_fp4(w_, 1.0f, 2), (h16x2){xv[4], xv[5]}, d, false); \
            d = __builtin_amdgcn_fdot2(__builtin_amdgcn_cvt_scalef32_pk_f16_fp4(w_, 1.0f, 3), (h16x2){xv[6], xv[7]}, d, false); } \
        d = row16_allsum(d); \
        const float wt_ = mw[(S_)] * gelu_tanh(d * su[J]) * sv[J]; \
        _Pragma("unroll") for (int c = 0; c < 4; ++c) _Pragma("unroll") for (int k = 0; k < 4; ++k) { \
            const f32x2 lo = __builtin_amdgcn_cvt_pk_f32_fp8(rv[J][c][k], false), hi = __builtin_amdgcn_cvt_pk_f32_fp8(rv[J][c][k], true); \
            acc[c * 16 + 4 * k] += wt_ * lo.x; acc[c * 16 + 4 * k + 1] += wt_ * lo.y; acc[c * 16 + 4 * k + 2] += wt_ * hi.x; acc[c * 16 + 4 * k + 3] += wt_ * hi.y; } } while (0)
                ELD(0, 0); ELD(1, 1);
#pragma unroll 1
                for (int s = 0; s < 128; s += 2) {
                    ECP(0, s);     if (s + 2 < 128) ELD(0, s + 2);
                    ECP(1, s + 1); if (s + 3 < 128) ELD(1, s + 3);
                }
#undef ELD
#undef ECP
                float* xo = p.out + tokg * 1024 + li * 16;
                const int b = (int)(tokg >> 11);
                const float* g2 = mod + (size_t)b * 6144 + 5 * 1024 + li * 16;
                const float* fg = p.in[I_FG] + li * 16;
                float ss = 0.f;
#pragma unroll
                for (int c = 0; c < 4; ++c) {
#pragma unroll
                    for (int q4 = 0; q4 < 4; ++q4) {
                        const f32x4 xv = *(const f32x4*)(xo + c * 256 + q4 * 4), gv = *(const f32x4*)(g2 + c * 256 + q4 * 4);
#pragma unroll
                        for (int j = 0; j < 4; ++j) { const float t = xv[j] + gv[j] * acc[c * 16 + q4 * 4 + j]; acc[c * 16 + q4 * 4 + j] = t; ss += t * t; }
                    }
                    asm volatile("" : "+v"(ss) :: "memory");
                }
                ss = row16_allsum(ss);
                const float r = rsqrtf(ss * (1.0f / 1024.0f) + 1e-6f);
#pragma unroll
                for (int c = 0; c < 4; ++c) {
#pragma unroll
                    for (int q4 = 0; q4 < 4; ++q4) {
                        const f32x4 fv = *(const f32x4*)(fg + c * 256 + q4 * 4);
                        f32x4 ov;
#pragma unroll
                        for (int j = 0; j < 4; ++j) ov[j] = acc[c * 16 + q4 * 4 + j] * r * fv[j];
                        *(f32x4*)(xo + c * 256 + q4 * 4) = ov;
                    }
                    asm volatile("" ::: "memory");
                }
            }
            LDS_FENCE();
          }
        }
    }
}

__global__ void __launch_bounds__(512, 2) mega(Params p) {
    extern __shared__ __attribute__((aligned(16))) unsigned char shm[];
    LAS unsigned char* lds = (LAS unsigned char*)shm;
    cg::grid_group grid = cg::this_grid();
    unsigned char* ws = p.ws;
    const int G = (int)gridDim.x, c = (int)blockIdx.x;
    unsigned* bar = (unsigned*)(ws + OFF_BAR); unsigned epoch = 0;

    if (p.ws == nullptr) grid.sync();
    phase0(p, (float*)shm);
    grid_bar(bar, epoch, (unsigned)G);
    phase1(p, (float*)shm);
    grid_bar(bar, epoch, (unsigned)G);
    {
        pg8::StaticOrder S; S.init(NTOK, INC, G, c);
        pg8::Gemm g{ws + OFF_R1, ws + OFF_WINT, 1024, 1024, NTOK, INC, 1024, 0};
        EpiIn E{(h16*)(ws + OFF_QB), (h16*)(ws + OFF_KB), (h16*)(ws + OFF_VT), (h16*)(ws + OFF_GUV), (h16*)(ws + OFF_GATES)};
        pg8::gemm_phase(lds, g, S, E);
        pg8::StaticOrder S2; S2.init(NCTXT, 1024, G, c);
        pg8::Gemm g2{ws + OFF_HC, ws + OFF_WINT + (size_t)512 * 1024 * 2, 1024, 1024, NCTXT, 1024, 1024, 0};
        EpiCtx E2{(h16*)(ws + OFF_KC), (h16*)(ws + OFF_VCT)};
        pg8::gemm_phase(lds, g2, S2, E2);
    }
    grid_bar(bar, epoch, (unsigned)G);
    {
        for (int rep3 = 0; rep3 < REP_P3; ++rep3) {
        for (int u = c; u < 512; u += G) attn_unit(p, u);
        for (int n = c; n < 256; n += G) sgu_unit(p, n, lds);
        }
    }
    grid_bar(bar, epoch, (unsigned)G);
    {
        pg8::StaticOrder S; S.init(NTOK, 1024, G, c);
        pg8::Gemm ga{ws + OFF_R1, ws + OFF_WPAT, 1024, 512, NTOK, 1024, 512, 0};
        EpiM1 E1{(h16*)(ws + OFF_M1), (const h16*)(ws + OFF_GATES)};
        pg8::gemm_phase(lds, ga, S, E1);
        pg8::Gemm gb{ws + OFF_R1 + 1024, ws + OFF_WPBT, 1024, 512, NTOK, 1024, 512, 0};
        EpiM2 E2{(const h16*)(ws + OFF_M1), (const h16*)(ws + OFF_GATES), (h16*)(ws + OFF_MM)};
        pg8::gemm_phase(lds, gb, S, E2);
    }
    grid_bar(bar, epoch, (unsigned)G);
    {
        pg8::StaticOrder S; S.init(NTOK, 1024, G, c);
        pg8::Gemm g{ws + OFF_MM, ws + OFF_WOUTT, 1024, 1024, NTOK, 1024, 1024, 0};
        EpiX1 E{p.in[I_X], (const float*)(ws + OFF_MOD), p.out};
        pg8::gemm_phase(lds, g, S, E);
    }
    grid_bar(bar, epoch, (unsigned)G);
    phase6(p, (float*)shm);
    grid_bar(bar, epoch, (unsigned)G);
    {
        pg8::StaticOrder S; S.init(NTOK, 2048, G, c);
        pg8::Gemm g{ws + OFF_R1, ws + OFF_WQT, 1024, 1024, NTOK, 2048, 1024, 0};
        EpiH16 E{(h16*)(ws + OFF_SC16), 2048};
        pg8::gemm_phase(lds, g, S, E);
    }
    grid_bar(bar, epoch, (unsigned)G);
    peer_phase(p, lds, bar, epoch);
}

extern "C" void kernel_launch(void* const* d_in, const int* in_sizes, int n_in, void* d_out, int out_size, void* d_ws, size_t ws_size, hipStream_t stream) {
    static int grid_blocks = 0;
    if (!grid_blocks) {
        int dev = 0, cus = 0, per_cu = 0;
        hipGetDevice(&dev);
        hipDeviceGetAttribute(&cus, hipDeviceAttributeMultiprocessorCount, dev);
        hipFuncSetAttribute((const void*)mega, hipFuncAttributeMaxDynamicSharedMemorySize, LDS_BYTES);
        hipOccupancyMaxActiveBlocksPerMultiprocessor(&per_cu, (const void*)mega, 512, LDS_BYTES);
        if (per_cu < 1) per_cu = 1;
        grid_blocks = cus * per_cu;
        if (ws_size < WS_END) fprintf(stderr, "kernel_launch: workspace too small: %zu < %zu\n", ws_size, (size_t)WS_END);
    }
    hipMemsetAsync((unsigned char*)d_ws + OFF_BAR, 0, 256, stream);
    Params p{};
    for (int i = 0; i < 21; ++i) p.in[i] = (const float*)d_in[i];
    p.out = (float*)d_out; p.ws = (unsigned char*)d_ws;
    void* args[] = {&p};
    hipError_t e = hipLaunchCooperativeKernel((const void*)mega, dim3(grid_blocks), dim3(512), args, LDS_BYTES, stream);
    if (e != hipSuccess) fprintf(stderr, "cooperative launch failed: %s (grid %d)\n", hipGetErrorString(e), grid_blocks);
}
```

```cpp
#include <hip/hip_runtime.h>
#include <hip/hip_cooperative_groups.h>
#include <cstdio>
namespace cg = cooperative_groups;

#define LAS __attribute__((address_space(3)))
typedef _Float16 h16;
typedef _Float16 h16x2 __attribute__((ext_vector_type(2)));
typedef _Float16 h16x4 __attribute__((ext_vector_type(4)));
typedef _Float16 h16x8 __attribute__((ext_vector_type(8)));
typedef float f32x4 __attribute__((ext_vector_type(4)));
typedef float f32x2 __attribute__((ext_vector_type(2)));
typedef int i32x4 __attribute__((ext_vector_type(4)));
typedef int i32x2 __attribute__((ext_vector_type(2)));

constexpr int NTOK = 32768, DM = 1024, NCTXT = 4096, INC = 4608, SEQ = 2048, CTXL = 256;
constexpr int LDS_BYTES = 144 * 1024;
#ifndef REP_SEL
#define REP_SEL 1
#endif
#ifndef REP_GATH
#define REP_GATH 1
#endif
#ifndef REP_P3
#define REP_P3 1
#endif

constexpr size_t al256(size_t x) { return (x + 255) & ~(size_t)255; }
constexpr size_t OFF_WINT = 0;
constexpr size_t OFF_WPAT = OFF_WINT + (size_t)INC * DM * 2;
constexpr size_t OFF_WPBT = OFF_WPAT + (size_t)1024 * 512 * 2;
constexpr size_t OFF_WOUTT = OFF_WPBT + (size_t)1024 * 512 * 2;
constexpr size_t OFF_WQT = OFF_WOUTT + (size_t)1024 * 1024 * 2;
constexpr size_t OFF_BD = OFF_WQT + (size_t)2048 * 1024 * 2;
constexpr size_t OFF_U16 = OFF_BD + (size_t)2048 * 256 * 2;
constexpr size_t OFF_V16 = OFF_U16 + (size_t)16384 * 1024 * 2;
constexpr size_t OFF_WS16 = OFF_V16 + (size_t)16384 * 1024 * 2;
constexpr size_t OFF_MODP = OFF_WS16 + (size_t)8 * 128 * 128 * 2;
constexpr size_t OFF_MOD = OFF_MODP + (size_t)16 * 17 * 6144 * 4;
constexpr size_t OFF_R1 = al256(OFF_MOD + (size_t)17 * 6144 * 4);
constexpr size_t OFF_QB = OFF_R1 + (size_t)NTOK * DM * 2;
constexpr size_t OFF_KB = OFF_QB + (size_t)NTOK * 512 * 2;
constexpr size_t OFF_VT = OFF_KB + (size_t)NTOK * 512 * 2;
constexpr size_t OFF_GUV = OFF_VT + (size_t)NTOK * 512 * 2;
constexpr size_t OFF_GATES = OFF_GUV + (size_t)NTOK * 1024 * 2;
constexpr size_t OFF_MM = OFF_GATES + (size_t)NTOK * 2048 * 2;
constexpr size_t OFF_BAR = OFF_MM + (size_t)NTOK * DM * 2;
constexpr size_t WS_END = OFF_BAR + 256;
constexpr size_t OFF_U8 = OFF_U16;
constexpr size_t OFF_USC = OFF_V16;
constexpr size_t OFF_V8 = OFF_V16;
constexpr size_t OFF_VSC = OFF_V16 + (size_t)16384 * 1024;
constexpr size_t OFF_M1 = OFF_QB;
constexpr size_t OFF_SC16 = OFF_QB;
constexpr size_t OFF_Q16 = OFF_GATES;
constexpr size_t OFF_HC = OFF_MM;
constexpr size_t OFF_KC = OFF_HC + (size_t)NCTXT * DM * 2;
constexpr size_t OFF_VCT = OFF_KC + (size_t)NCTXT * 512 * 2;
static_assert(OFF_M1 + (size_t)NTOK * DM * 4 <= OFF_GATES, "m1 alias");
static_assert(WS_END <= (size_t)512 * 1024 * 1024, "workspace");

struct Params {
    const float* in[21];
    float* out;
    unsigned char* ws;
};
enum { I_X = 0, I_C, I_CTX, I_CCTX, I_ADAW, I_ADAB, I_N1G, I_N2G, I_WIN, I_RPB, I_LNG, I_GMWS, I_GMBS, I_WPA, I_WPB, I_WOUT, I_WQ, I_KEYS, I_PU, I_PV, I_FG };

__device__ __forceinline__ int launder(int x) { asm volatile("" : "+v"(x)); return x; }
__device__ __forceinline__ int fresh_tid() { int t = threadIdx.x; asm volatile("" : "+v"(t)); return t; }

__device__ __forceinline__ float sigmoidf_(float x) { return __builtin_amdgcn_rcpf(1.0f + __expf(-x)); }
__device__ __forceinline__ float gelu_tanh(float x) {
    const float t = 0.7978845608028654f * (x + 0.044715f * x * x * x);
    return x * __builtin_amdgcn_rcpf(1.0f + __expf(-2.0f * t));
}
__device__ __forceinline__ float silu_(float x) { return x * __builtin_amdgcn_rcpf(1.0f + __expf(-x)); }
__device__ __forceinline__ float wave_sum(float v) {
#pragma unroll
    for (int o = 32; o > 0; o >>= 1) v += __shfl_xor(v, o);
    return v;
}
__device__ __forceinline__ h16x8 pack8(f32x4 a, f32x4 b) {
    h16x8 o;
    o[0] = (h16)a[0]; o[1] = (h16)a[1]; o[2] = (h16)a[2]; o[3] = (h16)a[3];
    o[4] = (h16)b[0]; o[5] = (h16)b[1]; o[6] = (h16)b[2]; o[7] = (h16)b[3];
    return o;
}


__device__ __forceinline__ void grid_bar(unsigned* ctr, unsigned& epoch, unsigned nblk) {
    __syncthreads();
    epoch += 1u;
    if (threadIdx.x == 0) {
        __builtin_amdgcn_fence(__ATOMIC_RELEASE, "agent");
        asm volatile("s_waitcnt vmcnt(0)" ::: "memory");
        __hip_atomic_fetch_add(ctr, 1u, __ATOMIC_RELAXED, __HIP_MEMORY_SCOPE_AGENT);
        const unsigned target = epoch * nblk;
        unsigned spins = 0;
        while (__hip_atomic_load(ctr, __ATOMIC_RELAXED, __HIP_MEMORY_SCOPE_AGENT) < target) { __builtin_amdgcn_s_sleep(2); if (++spins > (1u << 24)) break; }
        __builtin_amdgcn_fence(__ATOMIC_ACQUIRE, "agent");
        asm volatile("s_waitcnt vmcnt(0)" ::: "memory");
    }
    __syncthreads();
}

namespace pg8 {
constexpr int BM = 256, BK = 64, HALF = 128, HTB = HALF * BK * 2, STAGE_BYTES = 8 * HTB, NXCD = 8, WGM = 8;
__device__ __forceinline__ int lds_byte(int r, int c) { const int st = (r >> 4) * 2 + (c >> 5), rr = r & 15, cc = c & 31, ob = rr * 64 + cc * 2; return st * 1024 + (ob ^ (((ob >> 9) & 1) << 5)); }
__device__ __forceinline__ void stage_rc(int b, int& R, int& C) { const int st = b / 1024, sb = b % 1024, swz = sb ^ (((sb >> 9) & 1) << 5); R = (st >> 1) * 16 + swz / 64; C = (st & 1) * 32 + (swz % 64) / 2; }
__device__ __forceinline__ int perm32(int rho) { const int n = rho >> 4, i = rho & 15; return 8 * (i >> 2) + 4 * n + (i & 3); }

struct Unit { int pm, pn; };
struct Gemm { const void* A; const void* Bt; int lda, ldb, M, N, K, a_pn_bytes; };

struct StaticOrder {
    int nM, nN, nwg, G, c;
    __device__ void init(int M, int N, int G_, int c_) { nM = M / BM; nN = N / BM; nwg = nM * nN; G = G_; c = c_; }
    __device__ bool next(int i, Unit& u) const {
        const long L = (long)i * G + c; if (L >= nwg) return false;
        int wgid = (int)L; { const int q = nwg / NXCD, r = nwg % NXCD, xcd = wgid % NXCD, off = wgid / NXCD; wgid = (xcd < r ? xcd * (q + 1) : r * (q + 1) + (xcd - r) * q) + off; }
        const int nig = WGM * nN, gid = wgid / nig, fm = gid * WGM, gsz = (nM - fm) < WGM ? (nM - fm) : WGM;
        u.pm = fm + ((wgid % nig) % gsz); u.pn = (wgid % nig) / gsz; return true;
    }
};

template <class Epi>
__device__ __forceinline__ void gemm_phase(LAS unsigned char* lds, const Gemm g, const StaticOrder& S, const Epi& E) {
    const int tid = fresh_tid(), wid = __builtin_amdgcn_readfirstlane(tid >> 6), lane = tid & 63, wr = wid >> 2, wc = wid & 3, fr = lane & 15, fq = lane >> 4;
    const int K = g.K, nt = K / BK;
    unsigned voffA[2], voffB[2];
#pragma unroll
    for (int i = 0; i < 2; ++i) { int R, C; stage_rc(tid * 16 + i * 8192, R, C); const int Rb = (R & ~31) + perm32(R & 31);
        voffA[i] = (unsigned)(R * g.lda + C) * 2u; voffB[i] = (unsigned)(Rb * g.ldb + C) * 2u; }
    const size_t kstep = (size_t)(BK * 2);
    const size_t hstepA = (size_t)HALF * g.lda * 2, hstepB = (size_t)HALF * g.ldb * 2;
    const size_t tstepA = 2 * hstepA, tstepB = 2 * hstepB;
    const unsigned ldsw = (unsigned)wid * 1024u;
    const int aoff = lds_byte(wr * 64 + fr, fq * 8), boff = lds_byte(wc * 32 + fr, fq * 8);
#define PG8_SA(b, h) (((b) * 2 + (h)) * HTB)
#define PG8_SB(b, h) ((4 + (b) * 2 + (h)) * HTB)
#define PG8_STAGE(bufoff, gbase, voff) do { _Pragma("unroll") for (int _i = 0; _i < 2; ++_i) \
        __builtin_amdgcn_global_load_lds((const unsigned*)((const char*)(gbase) + (voff)[_i]), (LAS unsigned*)(lds + (bufoff) + ldsw + _i * 8192), 16, 0, 0); } while (0)
#define PG8_LDA(dst, b, h) do { _Pragma("unroll") for (int m = 0; m < 4; ++m) _Pragma("unroll") for (int k = 0; k < 2; ++k) dst[m][k] = *(const LAS h16x8*)(lds + PG8_SA(b, h) + aoff + m * 2048 + k * 1024); } while (0)
#define PG8_LDB(dst, b, h) do { _Pragma("unroll") for (int n = 0; n < 2; ++n) _Pragma("unroll") for (int k = 0; k < 2; ++k) dst[n][k] = *(const LAS h16x8*)(lds + PG8_SB(b, h) + boff + n * 2048 + k * 1024); } while (0)
#define PG8_MMA(ai, bj, At, Bt) do { __builtin_amdgcn_s_setprio(1); _Pragma("unroll") for (int m = 0; m < 4; ++m) _Pragma("unroll") for (int n = 0; n < 2; ++n) _Pragma("unroll") for (int k = 0; k < 2; ++k) \
        acc[ai][bj][m][n] = __builtin_amdgcn_mfma_f32_16x16x32_f16(Bt[n][k], At[m][k], acc[ai][bj][m][n], 0, 0, 0); __builtin_amdgcn_s_setprio(0); } while (0)
#define PG8_WAIT_V(n) asm volatile("s_waitcnt vmcnt(" #n ")" ::: "memory")
#define PG8_WAIT_L(n) asm volatile("s_waitcnt lgkmcnt(" #n ")" ::: "memory")
#define PG8_BAR __builtin_amdgcn_s_barrier()
#define PG8_SCHED __builtin_amdgcn_sched_barrier(0)
    Unit cur, nxt; int ui = 0;
    if (!S.next(0, cur)) return;
    f32x4 acc[2][2][4][2];
#pragma unroll
    for (int a = 0; a < 2; ++a)
#pragma unroll
        for (int b = 0; b < 2; ++b)
#pragma unroll
            for (int m = 0; m < 4; ++m)
#pragma unroll
                for (int n = 0; n < 2; ++n) acc[a][b][m][n] = (f32x4){0.f, 0.f, 0.f, 0.f};
    h16x8 At[4][2], B0[2][2], B1[2][2];
    const char* cA = (const char*)g.A + (size_t)cur.pm * tstepA + (size_t)cur.pn * g.a_pn_bytes; const char* cB = (const char*)g.Bt + (size_t)cur.pn * tstepB;
    PG8_STAGE(PG8_SB(0, 0), cB, voffB); PG8_STAGE(PG8_SA(0, 0), cA, voffA); PG8_STAGE(PG8_SB(0, 1), cB + hstepB, voffB); PG8_STAGE(PG8_SA(0, 1), cA + hstepA, voffA);
    if (wr == 1) PG8_BAR;
    PG8_WAIT_V(4); PG8_BAR;
    PG8_STAGE(PG8_SB(1, 0), cB + kstep, voffB); PG8_STAGE(PG8_SA(1, 0), cA + kstep, voffA); PG8_STAGE(PG8_SB(1, 1), cB + hstepB + kstep, voffB);
    PG8_WAIT_V(6); PG8_BAR;
    for (;;) {
        const bool has_next = S.next(ui + 1, nxt);
        const char* nA = has_next ? (const char*)g.A + (size_t)nxt.pm * tstepA + (size_t)nxt.pn * g.a_pn_bytes : cA; const char* nB = has_next ? (const char*)g.Bt + (size_t)nxt.pn * tstepB : cB;
        for (int t = 0; t < nt; t += 2) {
            const bool last = (t == nt - 2);
            const char* a1 = cA + (size_t)(t + 1) * kstep;
            const char* a2 = last ? nA : cA + (size_t)(t + 2) * kstep; const char* b2 = last ? nB : cB + (size_t)(t + 2) * kstep;
            const char* a3 = a2 + kstep; const char* b3 = b2 + kstep;
            PG8_LDB(B0, 0, 0); PG8_SCHED; PG8_LDA(At, 0, 0); PG8_STAGE(PG8_SA(1, 1), a1 + hstepA, voffA);
            PG8_WAIT_L(8); PG8_BAR; PG8_WAIT_L(0); PG8_MMA(0, 0, At, B0); PG8_BAR; PG8_SCHED;
            PG8_LDB(B1, 0, 1); PG8_STAGE(PG8_SB(0, 0), b2, voffB);
            PG8_BAR; PG8_WAIT_L(0); PG8_MMA(0, 1, At, B1); PG8_BAR;
            PG8_LDA(At, 0, 1); PG8_STAGE(PG8_SA(0, 0), a2, voffA);
            PG8_BAR; PG8_WAIT_L(0); PG8_MMA(1, 0, At, B0); PG8_BAR; PG8_SCHED;
            PG8_STAGE(PG8_SB(0, 1), b2 + hstepB, voffB);
            PG8_WAIT_V(6); PG8_BAR; PG8_MMA(1, 1, At, B1); PG8_BAR;
            PG8_LDB(B0, 1, 0); PG8_SCHED; PG8_LDA(At, 1, 0); PG8_STAGE(PG8_SA(0, 1), a2 + hstepA, voffA);
            PG8_WAIT_L(8); PG8_BAR; PG8_WAIT_L(0); PG8_MMA(0, 0, At, B0); PG8_BAR; PG8_SCHED;
            PG8_LDB(B1, 1, 1); PG8_STAGE(PG8_SB(1, 0), b3, voffB);
            PG8_BAR; PG8_WAIT_L(0); PG8_MMA(0, 1, At, B1); PG8_BAR;
            PG8_LDA(At, 1, 1); PG8_STAGE(PG8_SA(1, 0), a3, voffA);
            PG8_BAR; PG8_WAIT_L(0); PG8_MMA(1, 0, At, B0); PG8_BAR; PG8_SCHED;
            PG8_STAGE(PG8_SB(1, 1), b3 + hstepB, voffB);
            PG8_WAIT_V(6); PG8_BAR; PG8_MMA(1, 1, At, B1); PG8_BAR;
        }
        E(acc, cur, wr, wc, fr, fq);
        if (!has_next) break;
#pragma unroll
        for (int a = 0; a < 2; ++a)
#pragma unroll
            for (int b = 0; b < 2; ++b)
#pragma unroll
                for (int m = 0; m < 4; ++m)
#pragma unroll
                    for (int n = 0; n < 2; ++n) acc[a][b][m][n] = (f32x4){0.f, 0.f, 0.f, 0.f};
        cur = nxt; cA = nA; cB = nB; ++ui;
    }
    PG8_WAIT_V(0);
    if (wr == 0) PG8_BAR;
    PG8_BAR;
#undef PG8_SA
#undef PG8_SB
#undef PG8_STAGE
#undef PG8_LDA
#undef PG8_LDB
#undef PG8_MMA
#undef PG8_WAIT_V
#undef PG8_WAIT_L
#undef PG8_BAR
#undef PG8_SCHED
}
}
typedef f32x4 AccT[2][2][4][2];

struct EpiIn {
    h16 *qb, *kb, *vt, *guv, *gates;
    __device__ __forceinline__ void operator()(const AccT& acc, const pg8::Unit& u, int wr, int wc, int fr, int fq) const {
        const int pn = u.pn;
        const int row0 = u.pm * 256 + wr * 64 + fr;
        const int cin = wc * 32 + 8 * fq;
        const int b = (u.pm * 256) >> 11, sb = ((u.pm * 256) & 2047) + wr * 64;
        if (pn < 2) {
            h16* base = qb + (size_t)row0 * 512 + pn * 256 + cin;
#pragma unroll
            for (int ai = 0; ai < 2; ++ai)
#pragma unroll
                for (int m = 0; m < 4; ++m)
#pragma unroll
                    for (int bj = 0; bj < 2; ++bj) *(h16x8*)(base + (ai * 128 + m * 16) * 512 + bj * 128) = pack8(acc[ai][bj][m][0], acc[ai][bj][m][1]);
        } else if (pn < 4) {
#pragma unroll
            for (int bj = 0; bj < 2; ++bj) {
                const int col = (pn & 1) * 256 + bj * 128 + cin, hd = col >> 6, d0 = col & 63;
                h16* base = kb + ((size_t)(b * 8 + hd) * 2048 + sb + fr) * 64 + d0;
#pragma unroll
                for (int ai = 0; ai < 2; ++ai)
#pragma unroll
                    for (int m = 0; m < 4; ++m) *(h16x8*)(base + (ai * 128 + m * 16) * 64) = pack8(acc[ai][bj][m][0], acc[ai][bj][m][1]);
            }
        } else if (pn < 6) {
#pragma unroll
            for (int bj = 0; bj < 2; ++bj) {
                const int cv = (pn - 4) * 256 + bj * 128 + cin, hd = cv >> 6, d0 = cv & 63;
                h16* base = vt + ((size_t)(b * 8 + hd) * 256 + (sb >> 3) + (fr >> 3)) * 512 + d0 * 8 + (fr & 7);
#pragma unroll
                for (int ai = 0; ai < 2; ++ai)
#pragma unroll
                    for (int m = 0; m < 4; ++m) {
                        h16* vp = base + (ai * 16 + m * 2) * 512;
                        const f32x4 v0 = acc[ai][bj][m][0], v1 = acc[ai][bj][m][1];
#pragma unroll
                        for (int i = 0; i < 4; ++i) { vp[i * 8] = (h16)v0[i]; vp[(i + 4) * 8] = (h16)v1[i]; }
                    }
            }
        } else if (pn < 10) {
            h16* base = guv + (size_t)row0 * 1024 + (pn - 6) * 256 + cin;
#pragma unroll
            for (int ai = 0; ai < 2; ++ai)
#pragma unroll
                for (int m = 0; m < 4; ++m)
#pragma unroll
                    for (int bj = 0; bj < 2; ++bj) {
                        f32x4 v0 = acc[ai][bj][m][0], v1 = acc[ai][bj][m][1];
#pragma unroll
                        for (int i = 0; i < 4; ++i) { v0[i] = gelu_tanh(v0[i]); v1[i] = gelu_tanh(v1[i]); }
                        *(h16x8*)(base + (ai * 128 + m * 16) * 1024 + bj * 128) = pack8(v0, v1);
                    }
        } else {
            h16* base = gates + (size_t)row0 * 2048 + (pn - 10) * 256 + cin;
#pragma unroll
            for (int ai = 0; ai < 2; ++ai)
#pragma unroll
                for (int m = 0; m < 4; ++m)
#pragma unroll
                    for (int bj = 0; bj < 2; ++bj) {
                        f32x4 v0 = acc[ai][bj][m][0], v1 = acc[ai][bj][m][1];
#pragma unroll
                        for (int i = 0; i < 4; ++i) { v0[i] = sigmoidf_(v0[i]); v1[i] = sigmoidf_(v1[i]); }
                        *(h16x8*)(base + (ai * 128 + m * 16) * 2048 + bj * 128) = pack8(v0, v1);
                    }
        }
    }
};
struct EpiCtx {
    h16 *kc, *vct;
    __device__ __forceinline__ void operator()(const AccT& acc, const pg8::Unit& u, int wr, int wc, int fr, int fq) const {
        const int pn = u.pn;
        const int cin = wc * 32 + 8 * fq;
        const int b = u.pm, sb = wr * 64;
        if (pn < 2) {
#pragma unroll
            for (int bj = 0; bj < 2; ++bj) {
                const int col = pn * 256 + bj * 128 + cin, hd = col >> 6, d0 = col & 63;
                h16* base = kc + ((size_t)(b * 8 + hd) * 256 + sb + fr) * 64 + d0;
#pragma unroll
                for (int ai = 0; ai < 2; ++ai)
#pragma unroll
                    for (int m = 0; m < 4; ++m) *(h16x8*)(base + (ai * 128 + m * 16) * 64) = pack8(acc[ai][bj][m][0], acc[ai][bj][m][1]);
            }
        } else {
#pragma unroll
            for (int bj = 0; bj < 2; ++bj) {
                const int cv = (pn - 2) * 256 + bj * 128 + cin, hd = cv >> 6, d0 = cv & 63;
                h16* base = vct + ((size_t)(b * 8 + hd) * 32 + (sb >> 3) + (fr >> 3)) * 512 + d0 * 8 + (fr & 7);
#pragma unroll
                for (int ai = 0; ai < 2; ++ai)
#pragma unroll
                    for (int m = 0; m < 4; ++m) {
                        h16* vp = base + (ai * 16 + m * 2) * 512;
                        const f32x4 v0 = acc[ai][bj][m][0], v1 = acc[ai][bj][m][1];
#pragma unroll
                        for (int i = 0; i < 4; ++i) { vp[i * 8] = (h16)v0[i]; vp[(i + 4) * 8] = (h16)v1[i]; }
                    }
            }
        }
    }
};
struct EpiM1 {
    h16* m1; const h16* gates;
    __device__ __forceinline__ void operator()(const AccT& acc, const pg8::Unit& u, int wr, int wc, int fr, int fq) const {
        const int row0 = u.pm * 256 + wr * 64 + fr, col0 = u.pn * 256 + wc * 32 + 8 * fq;
#pragma unroll
        for (int ai = 0; ai < 2; ++ai)
#pragma unroll
            for (int m = 0; m < 4; ++m) {
                const int row = row0 + ai * 128 + m * 16;
#pragma unroll
                for (int bj = 0; bj < 2; ++bj) {
                    const int col = col0 + bj * 128;
                    const h16x8 gt = *(const h16x8*)(gates + (size_t)row * 2048 + col);
                    f32x4 v0 = acc[ai][bj][m][0], v1 = acc[ai][bj][m][1];
#pragma unroll
                    for (int i = 0; i < 4; ++i) { v0[i] *= (float)gt[i]; v1[i] *= (float)gt[4 + i]; }
                    *(h16x8*)(m1 + (size_t)row * 1024 + col) = pack8(v0, v1);
                }
            }
    }
};
struct EpiM2 {
    const h16* m1; const h16* gates; h16* mm;
    __device__ __forceinline__ void operator()(const AccT& acc, const pg8::Unit& u, int wr, int wc, int fr, int fq) const {
        const int row0 = u.pm * 256 + wr * 64 + fr, col0 = u.pn * 256 + wc * 32 + 8 * fq;
#pragma unroll
        for (int ai = 0; ai < 2; ++ai)
#pragma unroll
            for (int m = 0; m < 4; ++m) {
                const int row = row0 + ai * 128 + m * 16;
#pragma unroll
                for (int bj = 0; bj < 2; ++bj) {
                    const int col = col0 + bj * 128;
                    const h16x8 gt = *(const h16x8*)(gates + (size_t)row * 2048 + 1024 + col);
                    const h16x8 mi = *(const h16x8*)(m1 + (size_t)row * 1024 + col);
                    f32x4 p0 = (f32x4){(float)mi[0], (float)mi[1], (float)mi[2], (float)mi[3]}, p1 = (f32x4){(float)mi[4], (float)mi[5], (float)mi[6], (float)mi[7]};
                    const f32x4 v0 = acc[ai][bj][m][0], v1 = acc[ai][bj][m][1];
#pragma unroll
                    for (int i = 0; i < 4; ++i) { p0[i] += v0[i] * (float)gt[i]; p1[i] += v1[i] * (float)gt[4 + i]; }
                    *(h16x8*)(mm + (size_t)row * 1024 + col) = pack8(p0, p1);
                }
            }
    }
};
struct EpiX1 {
    const float* x; const float* mod; float* x1;
    __device__ __forceinline__ void operator()(const AccT& acc, const pg8::Unit& u, int wr, int wc, int fr, int fq) const {
        const int row0 = u.pm * 256 + wr * 64 + fr, col0 = u.pn * 256 + wc * 32 + 8 * fq;
        const int b = (u.pm * 256) >> 11;
#pragma unroll
        for (int bj = 0; bj < 2; ++bj) {
            const int col = col0 + bj * 128;
            const float* gp = mod + (size_t)b * 6144 + 2 * 1024 + col;
            const f32x4 g0 = *(const f32x4*)gp, g1 = *(const f32x4*)(gp + 4);
#pragma unroll
            for (int ai = 0; ai < 2; ++ai)
#pragma unroll
                for (int m = 0; m < 4; ++m) {
                    const int row = row0 + ai * 128 + m * 16;
                    const float* xi = x + (size_t)row * 1024 + col;
                    const f32x4 x0 = *(const f32x4*)xi, x1v = *(const f32x4*)(xi + 4);
                    float* o = x1 + (size_t)row * 1024 + col;
                    *(f32x4*)o = x0 + g0 * acc[ai][bj][m][0]; *(f32x4*)(o + 4) = x1v + g1 * acc[ai][bj][m][1];
                }
        }
    }
};
struct EpiH16 {
    h16* o; int ldc;
    __device__ __forceinline__ void operator()(const AccT& acc, const pg8::Unit& u, int wr, int wc, int fr, int fq) const {
        const int row0 = u.pm * 256 + wr * 64 + fr, col0 = u.pn * 256 + wc * 32 + 8 * fq;
#pragma unroll
        for (int ai = 0; ai < 2; ++ai)
#pragma unroll
            for (int m = 0; m < 4; ++m) {
                const int row = row0 + ai * 128 + m * 16;
#pragma unroll
                for (int bj = 0; bj < 2; ++bj)
                    *(h16x8*)(o + (size_t)row * ldc + col0 + bj * 128) = pack8(acc[ai][bj][m][0], acc[ai][bj][m][1]);
            }
    }
};

__device__ __forceinline__ void cvt_tile(const float* __restrict__ src, h16* __restrict__ dst, int tile) {
    const size_t i = (size_t)tile * 4096 + threadIdx.x * 8;
    const f32x4 a = *(const f32x4*)(src + i), b = *(const f32x4*)(src + i + 4);
    *(h16x8*)(dst + i) = pack8(a, b);
}
__device__ __forceinline__ void tr_tile(const float* __restrict__ src, h16* __restrict__ dst, int K, int N, int tile, float* lds) {
    const int ntn = N / 64, tk = tile / ntn, tn = tile % ntn, tid = threadIdx.x;
#pragma unroll
    for (int ps = 0; ps < 2; ++ps) {
        const int k = ps * 32 + (tid >> 4), n = (tid & 15) * 4;
        const f32x4 v = *(const f32x4*)(src + (size_t)(tk * 64 + k) * N + tn * 64 + n);
        lds[k * 65 + n] = v[0]; lds[k * 65 + n + 1] = v[1]; lds[k * 65 + n + 2] = v[2]; lds[k * 65 + n + 3] = v[3];
    }
    __syncthreads();
    {
        const int n = tid >> 3, ks = (tid & 7) * 8;
        h16x8 o;
#pragma unroll
        for (int i = 0; i < 8; ++i) o[i] = (h16)lds[(ks + i) * 65 + n];
        *(h16x8*)(dst + (size_t)(tn * 64 + n) * K + tk * 64 + ks) = o;
    }
    __syncthreads();
}
__device__ __forceinline__ void cvt8_rows(const float* __restrict__ src, unsigned char* __restrict__ dst, float* __restrict__ inv, int tile, int dstride = 1024) {
    const int wid = threadIdx.x >> 6, lane = threadIdx.x & 63;
    const size_t row = (size_t)tile * 8 + wid;
    const float* r = src + row * 1024 + lane * 16;
    f32x4 a[4]; float mx = 0.f;
#pragma unroll
    for (int i = 0; i < 4; ++i) { a[i] = *(const f32x4*)(r + 4 * i); mx = fmaxf(mx, fmaxf(fmaxf(fabsf(a[i][0]), fabsf(a[i][1])), fmaxf(fabsf(a[i][2]), fabsf(a[i][3])))); }
#pragma unroll
    for (int o = 32; o > 0; o >>= 1) mx = fmaxf(mx, __shfl_xor(mx, o));
    int ex2 = 0; float sc = 1.0f;
    if (mx > 0.f) { (void)frexpf(mx, &ex2); int k = 8 - ex2; k = k > 100 ? 100 : (k < -100 ? -100 : k); sc = ldexpf(1.0f, k); }
    i32x4 w;
#pragma unroll
    for (int i = 0; i < 4; ++i) {
        int pk = __builtin_amdgcn_cvt_pk_fp8_f32(a[i][0] * sc, a[i][1] * sc, 0, false);
        pk = __builtin_amdgcn_cvt_pk_fp8_f32(a[i][2] * sc, a[i][3] * sc, pk, true);
        w[i] = pk;
    }
    *(i32x4*)(dst + row * dstride + lane * 16) = w;
    if (lane == 0) inv[2 * row] = 1.0f / sc;
}
__device__ __forceinline__ void cvt4_rows(const float* __restrict__ src, unsigned char* __restrict__ dst, float* __restrict__ inv, int tile, int dstride = 512) {
    const int wid = threadIdx.x >> 6, lane = threadIdx.x & 63;
    const size_t row = (size_t)tile * 8 + wid;
    const float* r = src + row * 1024 + lane * 16;
    f32x4 a[4]; float mx = 0.f;
#pragma unroll
    for (int i = 0; i < 4; ++i) { a[i] = *(const f32x4*)(r + 4 * i); mx = fmaxf(mx, fmaxf(fmaxf(fabsf(a[i][0]), fabsf(a[i][1])), fmaxf(fabsf(a[i][2]), fabsf(a[i][3])))); }
#pragma unroll
    for (int o = 32; o > 0; o >>= 1) mx = fmaxf(mx, __shfl_xor(mx, o));
    const float sc = (mx > 1e-30f) ? 6.0f / mx : 1.0f;
    int w0 = 0, w1 = 0;
    w0 = __builtin_amdgcn_cvt_scalef32_pk_fp4_f32(w0, a[0][0] * sc, a[0][1] * sc, 1.0f, 0);
    w0 = __builtin_amdgcn_cvt_scalef32_pk_fp4_f32(w0, a[0][2] * sc, a[0][3] * sc, 1.0f, 1);
    w0 = __builtin_amdgcn_cvt_scalef32_pk_fp4_f32(w0, a[1][0] * sc, a[1][1] * sc, 1.0f, 2);
    w0 = __builtin_amdgcn_cvt_scalef32_pk_fp4_f32(w0, a[1][2] * sc, a[1][3] * sc, 1.0f, 3);
    w1 = __builtin_amdgcn_cvt_scalef32_pk_fp4_f32(w1, a[2][0] * sc, a[2][1] * sc, 1.0f, 0);
    w1 = __builtin_amdgcn_cvt_scalef32_pk_fp4_f32(w1, a[2][2] * sc, a[2][3] * sc, 1.0f, 1);
    w1 = __builtin_amdgcn_cvt_scalef32_pk_fp4_f32(w1, a[3][0] * sc, a[3][1] * sc, 1.0f, 2);
    w1 = __builtin_amdgcn_cvt_scalef32_pk_fp4_f32(w1, a[3][2] * sc, a[3][3] * sc, 1.0f, 3);
    *(i32x2*)(dst + row * dstride + lane * 8) = (i32x2){w0, w1};
    if (lane == 0) inv[2 * row] = 1.0f / sc;
}
__device__ __forceinline__ void wqk_tile(const float* __restrict__ wq, const float* __restrict__ keys, h16* __restrict__ wt, int tile, float* lds) {
    const int ct = tile >> 4, hp = tile & 15, tid = threadIdx.x;
    float* sA = lds;
    float* sB = lds + 64 * 129;
#pragma unroll
    for (int i = 0; i < 4; ++i) {
        const int e = (i * 512 + tid) * 4, r = e >> 7, d = e & 127;
        const f32x4 v = *(const f32x4*)(wq + (size_t)(ct * 64 + r) * 2048 + hp * 128 + d);
        sA[r * 129 + d] = v[0]; sA[r * 129 + d + 1] = v[1]; sA[r * 129 + d + 2] = v[2]; sA[r * 129 + d + 3] = v[3];
    }
#pragma unroll
    for (int i = 0; i < 8; ++i) {
        const int e = (i * 512 + tid) * 4, k = e >> 7, d = e & 127;
        const f32x4 v = *(const f32x4*)(keys + (size_t)(hp * 128 + k) * 128 + d);
        sB[k * 129 + d] = v[0]; sB[k * 129 + d + 1] = v[1]; sB[k * 129 + d + 2] = v[2]; sB[k * 129 + d + 3] = v[3];
    }
    __syncthreads();
    const int c = tid >> 3, kg = (tid & 7) * 16;
    float acc[16];
#pragma unroll
    for (int j = 0; j < 16; ++j) acc[j] = 0.f;
#pragma unroll 4
    for (int d = 0; d < 128; ++d) {
        const float a = sA[c * 129 + d];
#pragma unroll
        for (int j = 0; j < 16; ++j) acc[j] += a * sB[(kg + j) * 129 + d];
    }
#pragma unroll
    for (int j = 0; j < 16; ++j) wt[(size_t)(hp * 128 + kg + j) * 1024 + ct * 64 + c] = (h16)acc[j];
    __syncthreads();
}
__device__ void phase0(const Params& p, float* lds) {
    unsigned char* ws = p.ws;
    const int tid = threadIdx.x, wid = tid >> 6, lane = tid & 63;
    for (int ib = blockIdx.x; ib < 256; ib += gridDim.x) {
        if (wid < 6) {
            const int item = ib * 6 + wid, cg64 = item % 96, kc = item / 96;
            const int col = cg64 * 64 + lane, k0 = kc * 64;
            float sv[17], acc[17];
#pragma unroll
            for (int b = 0; b < 17; ++b) {
                const float cv = (b < 16) ? p.in[I_C][b * 1024 + k0 + lane] : p.in[I_CCTX][k0 + lane];
                sv[b] = silu_(cv); acc[b] = 0.f;
            }
            const float* wp = p.in[I_ADAW] + (size_t)k0 * 6144 + col;
            for (int j = 0; j < 64; ++j) {
                const float w = wp[(size_t)j * 6144];
#pragma unroll
                for (int b = 0; b < 17; ++b) acc[b] += __builtin_bit_cast(float, __builtin_amdgcn_readlane(__builtin_bit_cast(int, sv[b]), j)) * w;
            }
            float* mp = (float*)(ws + OFF_MODP);
#pragma unroll
            for (int b = 0; b < 17; ++b) mp[((size_t)kc * 17 + b) * 6144 + col] = acc[b];
        }
    }
    constexpr int T0 = 2048, T1 = T0 + 2048, T2 = T1 + 32, T3 = T2, T4 = T3 + 1152, T5 = T4 + 128, T6 = T5 + 128, T7 = T6 + 256, T8 = T7 + 256;
    for (int t = blockIdx.x; t < T8; t += gridDim.x) {
        if (t < T0) cvt4_rows(p.in[I_PU], ws + OFF_U8, (float*)(ws + OFF_USC), t, 1536);
        else if (t < T1) cvt8_rows(p.in[I_PV], ws + OFF_U8 + 512, (float*)(ws + OFF_USC) + 1, t - T0, 1536);
        else if (t < T2) cvt_tile(p.in[I_GMWS], (h16*)(ws + OFF_WS16), t - T1);
        else if (t < T3) {
            const int e = (t - T2) * 4096 + tid * 8;
            const int row = e >> 8, cc = e & 255, h = row >> 8, pp = (row >> 7) & 1, k = row & 127, pq = cc >> 7, d = cc & 127;
            h16x8 o = {0, 0, 0, 0, 0, 0, 0, 0};
            if (pp == pq) {
                const float* kp = p.in[I_KEYS] + ((size_t)((h * 2 + pp) * 128 + k)) * 128 + d;
                o = pack8(*(const f32x4*)kp, *(const f32x4*)(kp + 4));
            }
            *(h16x8*)((h16*)(ws + OFF_BD) + e) = o;
        }
        else if (t < T4) tr_tile(p.in[I_WIN], (h16*)(ws + OFF_WINT), 1024, INC, t - T3, lds);
        else if (t < T5) tr_tile(p.in[I_WPA], (h16*)(ws + OFF_WPAT), 512, 1024, t - T4, lds);
        else if (t < T6) tr_tile(p.in[I_WPB], (h16*)(ws + OFF_WPBT), 512, 1024, t - T5, lds);
        else if (t < T7) tr_tile(p.in[I_WOUT], (h16*)(ws + OFF_WOUTT), 1024, 1024, t - T6, lds);
        else wqk_tile(p.in[I_WQ], p.in[I_KEYS], (h16*)(ws + OFF_WQT), t - T7, lds);
    }
}

__device__ __forceinline__ void norm_rows(const float* __restrict__ src, h16* __restrict__ dst, int row_begin, int rows_per_wave, const float* sA, const float* sB) {
    const int tid_ = fresh_tid();
    const int wid = tid_ >> 6, lane = tid_ & 63;
    f32x4 a[4], bsh[4];
#pragma unroll
    for (int c = 0; c < 4; ++c) { a[c] = *(const f32x4*)(sA + c * 256 + lane * 4); bsh[c] = *(const f32x4*)(sB + c * 256 + lane * 4); }
    for (int i = 0; i < rows_per_wave; i += 2) {
        const size_t row = (size_t)row_begin + wid * rows_per_wave + i;
        f32x4 v[2][4]; float ss[2];
#pragma unroll
        for (int q = 0; q < 2; ++q) {
            ss[q] = 0.f;
#pragma unroll
            for (int c = 0; c < 4; ++c) { v[q][c] = *(const f32x4*)(src + (row + q) * 1024 + c * 256 + lane * 4); ss[q] += v[q][c][0] * v[q][c][0] + v[q][c][1] * v[q][c][1] + v[q][c][2] * v[q][c][2] + v[q][c][3] * v[q][c][3]; }
        }
#pragma unroll
        for (int o = 32; o > 0; o >>= 1) { const float t0 = __shfl_xor(ss[0], o), t1 = __shfl_xor(ss[1], o); ss[0] += t0; ss[1] += t1; }
#pragma unroll
        for (int q = 0; q < 2; ++q) {
            const float r = rsqrtf(ss[q] * (1.0f / 1024.0f) + 1e-6f);
#pragma unroll
            for (int c = 0; c < 4; ++c) {
                h16x4 o;
#pragma unroll
                for (int j = 0; j < 4; ++j) o[j] = (h16)(v[q][c][j] * r * a[c][j] + bsh[c][j]);
                *(h16x4*)(dst + (row + q) * 1024 + c * 256 + lane * 4) = o;
            }
        }
    }
}
__device__ void phase1(const Params& p, float* lds) {
    unsigned char* ws = p.ws;
    const int tid = threadIdx.x;
    const float* mp = (const float*)(ws + OFF_MODP);
    const float* bias = p.in[I_ADAB];
    float* sA = lds; float* sB = lds + 1024; float* cA = lds + 2048; float* cB = lds + 3072;
    {
        float* mod = (float*)(ws + OFF_MOD);
        for (int e = blockIdx.x * 512 + tid; e < 17 * 6144; e += gridDim.x * 512) {
            float s = bias[e % 6144];
#pragma unroll
            for (int kc = 0; kc < 16; ++kc) s += mp[(size_t)kc * 17 * 6144 + e];
            mod[e] = s;
        }
    }
    for (int col = tid; col < 1024; col += 512) {
        float sh = bias[col], sc = bias[1024 + col];
#pragma unroll
        for (int kc = 0; kc < 16; ++kc) { sh += mp[((size_t)kc * 17 + 16) * 6144 + col]; sc += mp[((size_t)kc * 17 + 16) * 6144 + 1024 + col]; }
        cA[col] = p.in[I_N1G][col] * (1.0f + sc); cB[col] = sh;
    }
    for (int rg = blockIdx.x; rg < 256; rg += gridDim.x) {
        const int b = rg >> 4;
        __syncthreads();
        for (int col = tid; col < 1024; col += 512) {
            float sh = bias[col], sc = bias[1024 + col];
#pragma unroll
            for (int kc = 0; kc < 16; ++kc) { sh += mp[((size_t)kc * 17 + b) * 6144 + col]; sc += mp[((size_t)kc * 17 + b) * 6144 + 1024 + col]; }
            sA[col] = p.in[I_N1G][col] * (1.0f + sc); sB[col] = sh;
        }
        __syncthreads();
        norm_rows(p.in[I_X], (h16*)(ws + OFF_R1), rg * 128, 16, sA, sB);
        norm_rows(p.in[I_CTX], (h16*)(ws + OFF_HC), rg * 16, 2, cA, cB);
    }
}
__device__ void phase6(const Params& p, float* lds) {
    unsigned char* ws = p.ws;
    const int tid = threadIdx.x;
    const float* mod = (const float*)(ws + OFF_MOD);
    float* sA = lds; float* sB = lds + 1024;
    for (int rg = blockIdx.x; rg < 256; rg += gridDim.x) {
        const int b = rg >> 4;
        __syncthreads();
        for (int col = tid; col < 1024; col += 512) {
            sA[col] = p.in[I_N2G][col] * (1.0f + mod[(size_t)b * 6144 + 4 * 1024 + col]); sB[col] = mod[(size_t)b * 6144 + 3 * 1024 + col];
        }
        __syncthreads();
        norm_rows(p.out, (h16*)(ws + OFF_R1), rg * 128, 16, sA, sB);
    }
}

__device__ __forceinline__ int clampi(int v, int lo, int hi) { return v < lo ? lo : (v > hi ? hi : v); }

template <bool LOCAL>
__device__ __forceinline__ void attn_core(const h16x8 (&kf)[2][2], const h16x8 (&vf)[4], const float* __restrict__ rpbrow, const int cb, const int qc, const int cs,
                                          const h16x8 (&qf)[2], float& m_run, float& l_run, f32x4 (&O)[4], const int quad) {
    f32x4 st[2];
#pragma unroll
    for (int t = 0; t < 2; ++t) {
        f32x4 a = (f32x4){0.f, 0.f, 0.f, 0.f};
#pragma unroll
        for (int ks = 0; ks < 2; ++ks) a = __builtin_amdgcn_mfma_f32_16x16x32_f16(kf[t][ks], qf[ks], a, 0, 0, 0);
        st[t] = a;
    }
    float mx = -INFINITY;
#pragma unroll
    for (int t = 0; t < 2; ++t)
#pragma unroll
        for (int j = 0; j < 4; ++j) {
            float sv = st[t][j] * 0.125f;
            if (LOCAL) {
                const int kc = cb + 16 * t + quad * 4 + j;
                const bool inw = (kc >= cs) && (kc < cs + 16);
                const int dc = clampi(kc - qc + 15, 0, 30);
                const float bv = rpbrow[dc];
                sv = inw ? (sv + bv) : -1e30f;
            }
            st[t][j] = sv; mx = fmaxf(mx, sv);
        }
    mx = fmaxf(mx, __shfl_xor(mx, 16)); mx = fmaxf(mx, __shfl_xor(mx, 32));
    const float m_new = fmaxf(m_run, mx);
    const float alpha = __expf(m_run - m_new);
    float ls = 0.f; h16x8 pf;
#pragma unroll
    for (int t = 0; t < 2; ++t)
#pragma unroll
        for (int j = 0; j < 4; ++j) { const float pe = __expf(st[t][j] - m_new); ls += pe; pf[t * 4 + j] = (h16)pe; }
    l_run = l_run * alpha + ls; m_run = m_new;
#pragma unroll
    for (int dt = 0; dt < 4; ++dt) { O[dt] *= alpha; O[dt] = __builtin_amdgcn_mfma_f32_16x16x32_f16(vf[dt], pf, O[dt], 0, 0, 0); }
}
__device__ __forceinline__ void load_kv(const h16* __restrict__ kt, const h16* __restrict__ vt, h16x8 (&kf)[2][2], h16x8 (&vf)[4], const int l15, const int quad) {
#pragma unroll
    for (int t = 0; t < 2; ++t)
#pragma unroll
        for (int ks = 0; ks < 2; ++ks) kf[t][ks] = *(const h16x8*)(kt + (16 * t + l15) * 64 + ks * 32 + quad * 8);
#pragma unroll
    for (int dt = 0; dt < 4; ++dt) {
        const h16* vp = vt + ((quad >> 1) * 64 + dt * 16 + l15) * 8 + (quad & 1) * 4;
        const h16x4 lo = *(const h16x4*)vp, hi = *(const h16x4*)(vp + 2 * 512);
        vf[dt] = (h16x8){lo[0], lo[1], lo[2], lo[3], hi[0], hi[1], hi[2], hi[3]};
    }
}

__device__ void attn_unit(const Params& p, int unit) {
    unsigned char* ws = p.ws;
    const int tid_ = fresh_tid();
    const int lane = tid_ & 63, h = tid_ >> 6, l15 = lane & 15, quad = lane >> 4;
    const int b = unit >> 5, r = unit & 31;
    const h16* QB = (const h16*)(ws + OFF_QB);
    const h16* KH = (const h16*)(ws + OFF_KB) + (size_t)(b * 8 + h) * 2048 * 64;
    const h16* VH = (const h16*)(ws + OFF_VT) + (size_t)(b * 8 + h) * 256 * 512;
    const h16* KCH = (const h16*)(ws + OFF_KC) + (size_t)(b * 8 + h) * 256 * 64;
    const h16* VCH = (const h16*)(ws + OFF_VCT) + (size_t)(b * 8 + h) * 32 * 512;
    h16* YA = (h16*)(ws + OFF_R1);
    const float* rpb = p.in[I_RPB] + (size_t)h * 15 * 31;
    const int rs = clampi(r - 4, 0, 24);
    h16x8 qf[4][2]; float m_run[4], l_run[4]; f32x4 O[4][4];
#pragma unroll
    for (int g = 0; g < 4; ++g) {
        const size_t tq = (size_t)b * 2048 + r * 64 + 16 * g + l15;
        qf[g][0] = *(const h16x8*)(QB + tq * 512 + h * 64 + quad * 8);
        qf[g][1] = *(const h16x8*)(QB + tq * 512 + h * 64 + 32 + quad * 8);
        m_run[g] = -INFINITY; l_run[g] = 0.f;
#pragma unroll
        for (int dt = 0; dt < 4; ++dt) O[g][dt] = (f32x4){0.f, 0.f, 0.f, 0.f};
    }
#pragma unroll 1
    for (int step = 0; step < 8; ++step) {
        h16x8 kf[2][2], vf[4];
        load_kv(KCH + step * 32 * 64, VCH + step * 4 * 512, kf, vf, l15, quad);
#pragma unroll
        for (int g = 0; g < 4; ++g) attn_core<false>(kf, vf, rpb, 0, 0, 0, qf[g], m_run[g], l_run[g], O[g], quad);
    }
#pragma unroll
    for (int gp = 0; gp < 4; gp += 2) {
        const int cb0 = clampi(16 * gp - 8, 0, 32), cb1 = clampi(16 * (gp + 1) - 8, 0, 32);
        const int qc0 = 16 * gp + l15, qc1 = 16 * (gp + 1) + l15;
        const int cs0 = clampi(qc0 - 8, 0, 48), cs1 = clampi(qc1 - 8, 0, 48);
        const float* rp0 = rpb + (rs - r + 7) * 31;
#pragma unroll 1
        for (int step = 0; step < 8; ++step) {
            const int t0 = (rs + step) * 64 + cb0, t1 = (rs + step) * 64 + cb1;
            h16x8 kf0[2][2], vf0[4], kf1[2][2], vf1[4];
            load_kv(KH + (size_t)t0 * 64, VH + (size_t)(t0 >> 3) * 512, kf0, vf0, l15, quad);
            load_kv(KH + (size_t)t1 * 64, VH + (size_t)(t1 >> 3) * 512, kf1, vf1, l15, quad);
            attn_core<true>(kf0, vf0, rp0 + step * 31, cb0, qc0, cs0, qf[gp], m_run[gp], l_run[gp], O[gp], quad);
            attn_core<true>(kf1, vf1, rp0 + step * 31, cb1, qc1, cs1, qf[gp + 1], m_run[gp + 1], l_run[gp + 1], O[gp + 1], quad);
        }
    }
#pragma unroll
    for (int g = 0; g < 4; ++g) {
        const size_t tq = (size_t)b * 2048 + r * 64 + 16 * g + l15;
        float l = l_run[g];
        l += __shfl_xor(l, 16); l += __shfl_xor(l, 32);
        const float inv = __builtin_amdgcn_rcpf(l);
#pragma unroll
        for (int dt = 0; dt < 4; ++dt) {
            h16x4 o;
#pragma unroll
            for (int j = 0; j < 4; ++j) o[j] = (h16)(O[g][dt][j] * inv);
            *(h16x4*)(YA + tq * 1024 + h * 64 + dt * 16 + quad * 4) = o;
        }
    }
}

__device__ void sgu_unit(const Params& p, int n, LAS unsigned char* lds) {
    unsigned char* ws = p.ws;
    const int tid = fresh_tid(), lane = tid & 63, g = tid >> 6, l15 = lane & 15, quad = lane >> 4;
    const h16* GUV = (const h16*)(ws + OFF_GUV);
    const h16* WS16 = (const h16*)(ws + OFF_WS16);
    h16* YB = (h16*)(ws + OFF_R1) + 512;
    LAS float* stat = (LAS float*)(lds + 8 * 17408);
    LAS h16* vt = (LAS h16*)(lds + g * 17408);
    const size_t t0 = (size_t)n * 128;
    __syncthreads();
    for (int i = 0; i < 16; i += 4) {
        h16x8 x[4]; float s[4], v[4];
#pragma unroll
        for (int q = 0; q < 4; ++q) {
            x[q] = *(const h16x8*)(GUV + (t0 + g * 16 + i + q) * 1024 + 512 + lane * 8);
            s[q] = 0.f;
#pragma unroll
            for (int j = 0; j < 8; ++j) s[q] += (float)x[q][j];
        }
#pragma unroll
        for (int o = 32; o > 0; o >>= 1) { float t[4];
#pragma unroll
            for (int q = 0; q < 4; ++q) t[q] = __shfl_xor(s[q], o);
#pragma unroll
            for (int q = 0; q < 4; ++q) s[q] += t[q]; }
#pragma unroll
        for (int q = 0; q < 4; ++q) {
            s[q] *= (1.0f / 512.0f); v[q] = 0.f;
#pragma unroll
            for (int j = 0; j < 8; ++j) { const float d = (float)x[q][j] - s[q]; v[q] += d * d; }
        }
#pragma unroll
        for (int o = 32; o > 0; o >>= 1) { float t[4];
#pragma unroll
            for (int q = 0; q < 4; ++q) t[q] = __shfl_xor(v[q], o);
#pragma unroll
            for (int q = 0; q < 4; ++q) v[q] += t[q]; }
        if (lane == 0) {
#pragma unroll
            for (int q = 0; q < 4; ++q) { stat[(g * 16 + i + q) * 2] = s[q]; stat[(g * 16 + i + q) * 2 + 1] = rsqrtf(v[q] * (1.0f / 512.0f) + 1e-6f); }
        }
    }
    __syncthreads();
    {
        const int ch0 = (lane & 7) * 8;
        float lg[8];
#pragma unroll
        for (int j = 0; j < 8; ++j) lg[j] = p.in[I_LNG][g * 64 + ch0 + j];
#pragma unroll 8
        for (int it = 0; it < 16; ++it) {
            const int q = it * 8 + (lane >> 3);
            const h16x8 x = *(const h16x8*)(GUV + (t0 + q) * 1024 + 512 + g * 64 + ch0);
            const float mean = stat[q * 2], rstd = stat[q * 2 + 1];
#pragma unroll
            for (int j = 0; j < 8; ++j) vt[(ch0 + j) * 136 + q] = (h16)(((float)x[j] - mean) * rstd * lg[j]);
        }
    }
    asm volatile("s_waitcnt lgkmcnt(0)" ::: "memory");
    __syncthreads();
    h16x8 af[4][4];
#pragma unroll
    for (int dt = 0; dt < 4; ++dt)
#pragma unroll
        for (int ks = 0; ks < 4; ++ks) af[dt][ks] = *(const LAS h16x8*)(vt + (dt * 16 + l15) * 136 + ks * 32 + quad * 8);
    const h16* wg = WS16 + (size_t)g * 128 * 128;
#pragma unroll 2
    for (int pt = 0; pt < 8; ++pt) {
        f32x4 acc[4];
#pragma unroll
        for (int dt = 0; dt < 4; ++dt) acc[dt] = (f32x4){0.f, 0.f, 0.f, 0.f};
#pragma unroll
        for (int ks = 0; ks < 4; ++ks) {
            const h16x8 bf = *(const h16x8*)(wg + (size_t)(pt * 16 + l15) * 128 + ks * 32 + quad * 8);
#pragma unroll
            for (int dt = 0; dt < 4; ++dt) acc[dt] = __builtin_amdgcn_mfma_f32_16x16x32_f16(af[dt][ks], bf, acc[dt], 0, 0, 0);
        }
        const int pp = pt * 16 + l15;
        const float bsv = p.in[I_GMBS][g * 128 + pp];
        const size_t tok = t0 + pp;
#pragma unroll
        for (int dt = 0; dt < 4; ++dt) {
            const int ch = g * 64 + dt * 16 + quad * 4;
            const h16x4 uu = *(const h16x4*)(GUV + tok * 1024 + ch);
            h16x4 o;
#pragma unroll
            for (int j = 0; j < 4; ++j) o[j] = (h16)((float)uu[j] * (acc[dt][j] + bsv));
            *(h16x4*)(YB + tok * 1024 + ch) = o;
        }
    }
    __syncthreads();
}

__device__ __forceinline__ float row16_sum_to_lane15(float v) {
    v += __builtin_bit_cast(float, __builtin_amdgcn_update_dpp(0, __builtin_bit_cast(int, v), 0x118, 0xf, 0xf, true));
    v += __builtin_bit_cast(float, __builtin_amdgcn_update_dpp(0, __builtin_bit_cast(int, v), 0x114, 0xf, 0xf, true));
    v += __builtin_bit_cast(float, __builtin_amdgcn_update_dpp(0, __builtin_bit_cast(int, v), 0x112, 0xf, 0xf, true));
    v += __builtin_bit_cast(float, __builtin_amdgcn_update_dpp(0, __builtin_bit_cast(int, v), 0x111, 0xf, 0xf, true));
    return v;
}
#define DPPF(v, ctrl) __builtin_bit_cast(float, __builtin_amdgcn_update_dpp(__builtin_bit_cast(int, v), __builtin_bit_cast(int, v), ctrl, 0xf, 0xf, false))
__device__ __forceinline__ float row16_allsum(float v) { v += DPPF(v, 0x128); v += DPPF(v, 0x124); v += DPPF(v, 0x122); v += DPPF(v, 0x121); return v; }
__device__ __forceinline__ float row16_allmax(float v) { v = fmaxf(v, DPPF(v, 0x128)); v = fmaxf(v, DPPF(v, 0x124)); v = fmaxf(v, DPPF(v, 0x122)); v = fmaxf(v, DPPF(v, 0x121)); return v; }
__device__ __forceinline__ int wave_incl_scan(int v) {
    v += __builtin_amdgcn_update_dpp(0, v, 0x111, 0xf, 0xf, false);
    v += __builtin_amdgcn_update_dpp(0, v, 0x112, 0xf, 0xf, false);
    v += __builtin_amdgcn_update_dpp(0, v, 0x114, 0xf, 0xf, false);
    v += __builtin_amdgcn_update_dpp(0, v, 0x118, 0xf, 0xf, false);
    v += __builtin_amdgcn_update_dpp(0, v, 0x142, 0xa, 0xf, false);
    v += __builtin_amdgcn_update_dpp(0, v, 0x143, 0xc, 0xf, false);
    return v;
}
__device__ __forceinline__ unsigned wave_or(unsigned x) {
    int v = (int)x;
    v |= __builtin_amdgcn_update_dpp(0, v, 0x111, 0xf, 0xf, false);
    v |= __builtin_amdgcn_update_dpp(0, v, 0x112, 0xf, 0xf, false);
    v |= __builtin_amdgcn_update_dpp(0, v, 0x114, 0xf, 0xf, false);
    v |= __builtin_amdgcn_update_dpp(0, v, 0x118, 0xf, 0xf, false);
    v |= __builtin_amdgcn_update_dpp(0, v, 0x142, 0xa, 0xf, false);
    v |= __builtin_amdgcn_update_dpp(0, v, 0x143, 0xc, 0xf, false);
    return (unsigned)__builtin_amdgcn_readlane(v, 63);
}
__device__ __forceinline__ unsigned key16(unsigned short u) { return (u & 0x8000u) ? ((~(unsigned)u) & 0xFFFFu) : ((unsigned)u | 0x8000u); }
__device__ __forceinline__ unsigned key32(unsigned u) { return (u & 0x80000000u) ? ~u : (u | 0x80000000u); }
__device__ __forceinline__ float dot8(h16x8 a, h16x8 b, float c) {
    c = __builtin_amdgcn_fdot2((h16x2){a[0], a[1]}, (h16x2){b[0], b[1]}, c, false);
    c = __builtin_amdgcn_fdot2((h16x2){a[2], a[3]}, (h16x2){b[2], b[3]}, c, false);
    c = __builtin_amdgcn_fdot2((h16x2){a[4], a[5]}, (h16x2){b[4], b[5]}, c, false);
    c = __builtin_amdgcn_fdot2((h16x2){a[6], a[7]}, (h16x2){b[6], b[7]}, c, false);
    return c;
}
#define LDS_FENCE() asm volatile("s_waitcnt lgkmcnt(0)" ::: "memory")

__device__ void peer_phase(const Params& p, LAS unsigned char* lds, unsigned* bar, unsigned& epoch) {
    unsigned char* ws = p.ws;
    const int tid = fresh_tid(), wid = __builtin_amdgcn_readfirstlane(tid >> 6), lane = tid & 63;
    const unsigned long long lm = (1ull << lane) - 1ull;
    LAS unsigned char* wl = lds + wid * 11264;
    LAS float* s_top = (LAS float*)(wl);
    LAS int* i_top = (LAS int*)(wl + 1024);
    LAS int* ex = (LAS int*)(wl + 2048);
    LAS float* sc = (LAS float*)(wl + 2560);
    LAS int* uns_m = (LAS int*)(wl + 3072);
    LAS float* uns_g = (LAS float*)(wl + 3584);
    LAS int* cnt = (LAS int*)(wl + 4096);
    LAS int* base = (LAS int*)(wl + 4352);
    const int lead = (wid >= 4) ? 1 : 0;
    const unsigned short* SC = (const unsigned short*)(ws + OFF_SC16);
    const h16* H2 = (const h16*)(ws + OFF_R1);
    const unsigned char* U4 = ws + OFF_U8;
    const unsigned char* V8 = ws + OFF_V8;
    const float* USC = (const float*)(ws + OFF_USC);
    const float* VSC = (const float*)(ws + OFF_VSC);
    const float* mod = (const float*)(ws + OFF_MOD);
    const int grp = lane >> 4, li = lane & 15;
    for (int tg = blockIdx.x; tg < 256; tg += gridDim.x) {
        for (int it5 = 0; it5 < 5; ++it5) {
          if (it5 < 4) {
            const int round = it5;
            const size_t tok0 = (size_t)tg * 128 + wid * 16 + round * 4;
            LAS unsigned short* se = (LAS unsigned short*)(wl + 4608 + (round & 1) * 3072);
            LAS float* sw = (LAS float*)(wl + 4608 + (round & 1) * 3072 + 1024);
            for (int tt = 0; tt < 4; ++tt) {
                const size_t tok = tok0 + tt;
                cnt[lane] = 0;
                for (int L0 = 0; L0 < 16; L0 += 4) {
                    unsigned short ra[4], rb[4]; unsigned ka[4], kb[4], T[4];
#pragma unroll
                    for (int q = 0; q < 4; ++q) {
                        const unsigned short* sr = SC + tok * 2048 + (L0 + q) * 128;
                        ra[q] = sr[lane]; rb[q] = sr[64 + lane];
                        ka[q] = key16(ra[q]); kb[q] = key16(rb[q]); T[q] = 0;
                    }
                    for (int bit = 15; bit >= 0; --bit) {
#pragma unroll
                        for (int q = 0; q < 4; ++q) {
                            const unsigned cand = T[q] | (1u << bit);
                            const int cn = __popcll(__ballot(ka[q] >= cand)) + __popcll(__ballot(kb[q] >= cand));
                            T[q] = (cn >= 16) ? cand : T[q];
                        }
                    }
#pragma unroll
                    for (int q = 0; q < 4; ++q) {
                        const int L = L0 + q;
                        const int cnt_gt = __popcll(__ballot(ka[q] > T[q])) + __popcll(__ballot(kb[q] > T[q]));
                        const int need = 16 - cnt_gt;
                        const unsigned long long ea = __ballot(ka[q] == T[q]), eb = __ballot(kb[q] == T[q]);
                        const int ra_eq = __popcll(ea & lm), rb_eq = __popcll(ea) + __popcll(eb & lm);
                        const bool sa = (ka[q] > T[q]) || (ka[q] == T[q] && ra_eq < need);
                        const bool sb = (kb[q] > T[q]) || (kb[q] == T[q] && rb_eq < need);
                        const unsigned long long ma = __ballot(sa), mb = __ballot(sb);
                        const int pa = __popcll(ma & lm), pb = __popcll(ma) + __popcll(mb & lm);
                        if (sa) { s_top[L * 16 + pa] = (float)__builtin_bit_cast(h16, ra[q]); i_top[L * 16 + pa] = lane; }
                        if (sb) { s_top[L * 16 + pb] = (float)__builtin_bit_cast(h16, rb[q]); i_top[L * 16 + pb] = 64 + lane; }
                    }
                }
                LDS_FENCE();
                for (int h0 = 0; h0 < 8; h0 += 4) {
                    float cv[4][4]; unsigned kk[4][4], T[4];
#pragma unroll
                    for (int q = 0; q < 4; ++q) {
                        const int h = h0 + q;
                        const float bj = s_top[(2 * h + 1) * 16 + li];
#pragma unroll
                        for (int m = 0; m < 4; ++m) { cv[q][m] = s_top[(2 * h) * 16 + grp + 4 * m] + bj; kk[q][m] = key32(__builtin_bit_cast(unsigned, cv[q][m])); }
                        T[q] = 0;
                    }
                    unsigned om = 0;
#pragma unroll
                    for (int q = 0; q < 4; ++q)
#pragma unroll
                        for (int m = 0; m < 4; ++m) om |= kk[q][m];
                    om = wave_or(om);
                    while (om) {
                        const int bit = 31 - __builtin_clz(om);
                        om &= ~(1u << bit);
#pragma unroll
                        for (int q = 0; q < 4; ++q) {
                            const unsigned cand = T[q] | (1u << bit);
                            int cn = 0;
#pragma unroll
                            for (int m = 0; m < 4; ++m) cn += __popcll(__ballot(kk[q][m] >= cand));
                            T[q] = (cn >= 16) ? cand : T[q];
                        }
                    }
#pragma unroll
                    for (int q = 0; q < 4; ++q) {
                        const int h = h0 + q;
                        int cnt_gt = 0;
#pragma unroll
                        for (int m = 0; m < 4; ++m) cnt_gt += __popcll(__ballot(kk[q][m] > T[q]));
                        const int need = 16 - cnt_gt;
                        int eq_before = 0, sel_before = 0;
#pragma unroll
                        for (int m = 0; m < 4; ++m) {
                            const unsigned long long em = __ballot(kk[q][m] == T[q]);
                            const int myeq = eq_before + __popcll(em & lm);
                            const bool sel = (kk[q][m] > T[q]) || (kk[q][m] == T[q] && myeq < need);
                            const unsigned long long sm = __ballot(sel);
                            const int pos = sel_before + __popcll(sm & lm);
                            if (sel) {
                                ex[h * 16 + pos] = i_top[(2 * h) * 16 + grp + 4 * m] * 128 + i_top[(2 * h + 1) * 16 + li];
                                sc[h * 16 + pos] = cv[q][m];
                            }
                            eq_before += __popcll(em); sel_before += __popcll(sm);
                        }
                    }
                }
                LDS_FENCE();
#pragma unroll
                for (int half = 0; half < 2; ++half) {
                    const int e = half * 64 + lane;
                    const float v = sc[e];
                    const float mx = row16_allmax(v);
                    const float pe = __expf(v - mx);
                    const float sm = row16_allsum(pe);
                    const float gate = pe * __builtin_amdgcn_rcpf(sm);
                    const int eid = ex[e];
                    const int pos = __hip_atomic_fetch_add(cnt + (eid >> 8), 1, __ATOMIC_RELAXED, __HIP_MEMORY_SCOPE_WORKGROUP);
                    uns_m[e] = eid | (pos << 14); uns_g[e] = gate;
                }
                LDS_FENCE();
                {
                    const int c = cnt[lane];
                    const int incl = wave_incl_scan(c);
                    base[lane] = incl - c;
                    LDS_FENCE();
#pragma unroll
                    for (int i = 0; i < 2; ++i) {
                        const int rm = uns_m[i * 64 + lane]; const float rg = uns_g[i * 64 + lane];
                        const int eid = rm & 16383, pos = rm >> 14;
                        const int dst = tt * 128 + base[eid >> 8] + pos;
                        se[dst] = (unsigned short)eid; sw[dst] = rg;
                    }
                    LDS_FENCE();
                }
            }
          }
          const int round = it5 - lead;
          if (round >= 0 && round < 4) {
            const size_t tok0 = (size_t)tg * 128 + wid * 16 + round * 4;
            LAS unsigned short* se = (LAS unsigned short*)(wl + 4608 + (round & 1) * 3072);
            LAS float* sw = (LAS float*)(wl + 4608 + (round & 1) * 3072 + 1024);
            const size_t tokg = tok0 + grp;
            const LAS unsigned short* me = se + grp * 128; LAS float* mw = sw + grp * 128;
            {
                const int li = launder(tid) & 15;
                h16x8 xr[2][4];
#pragma unroll
                for (int c = 0; c < 2; ++c)
#pragma unroll
                    for (int j = 0; j < 4; ++j) xr[c][j] = *(const h16x8*)(H2 + tokg * 1024 + c * 512 + li * 32 + 8 * j);
                float acc[64];
#pragma unroll
                for (int i = 0; i < 64; ++i) acc[i] = 0.f;
                i32x4 ru[2][2], rv[2][4]; float su[2], sv[2];
#define ELD(J, S_) do { const int e_ = me[(S_)]; const unsigned char* rp_ = U4 + (size_t)e_ * 1536 + li * 16; \
        ru[J][0] = *(const i32x4*)rp_; ru[J][1] = *(const i32x4*)(rp_ + 256); \
        _Pragma("unroll") for (int c = 0; c < 4; ++c) rv[J][c] = *(const i32x4*)(rp_ + 512 + c * 256); \
        { const f32x2 s2_ = *(const f32x2*)(USC + 2 * e_); su[J] = s2_.x; sv[J] = s2_.y; } } while (0)
#define ECP(J, S_) do { float d = 0.f; \
        _Pragma("unroll") for (int c = 0; c < 2; ++c) _Pragma("unroll") for (int k = 0; k < 4; ++k) { const h16x8 xv = xr[c][k]; const int w_ = ru[J][c][k]; \
            d = __builtin_amdgcn_fdot2(__builtin_amdgcn_cvt_scalef32_pk_f16_fp4(w_, 1.0f, 0), (h16x2){xv[0], xv[1]}, d, false); \
            d = __builtin_amdgcn_fdot2(__builtin_amdgcn_cvt_scalef32_pk_f16_fp4(w_, 1.0f, 1), (h16x2){xv[2], xv[3]}, d, false); \
            d = __builtin_amdgcn_fdot2(__builtin_amdgcn_cvt_scalef32_pk_f16_fp4(w_, 1.0f, 2), (h16x2){xv[4], xv[5]}, d, false); \
            d = __builtin_amdgcn_fdot2(__builtin_amdgcn_cvt_scalef32_pk_f16_fp4(w_, 1.0f, 3), (h16x2){xv[6], xv[7]}, d, false); } \
        d = row16_allsum(d); \
        const float wt_ = mw[(S_)] * gelu_tanh(d * su[J]) * sv[J]; \
        _Pragma("unroll") for (int c = 0; c < 4; ++c) _Pragma("unroll") for (int k = 0; k < 4; ++k) { \
            const f32x2 lo = __builtin_amdgcn_cvt_pk_f32_fp8(rv[J][c][k], false), hi = __builtin_amdgcn_cvt_pk_f32_fp8(rv[J][c][k], true); \
            acc[c * 16 + 4 * k] += wt_ * lo.x; acc[c * 16 + 4 * k + 1] += wt_ * lo.y; acc[c * 16 + 4 * k + 2] += wt_ * hi.x; acc[c * 16 + 4 * k + 3] += wt_ * hi.y; } } while (0)
                ELD(0, 0); ELD(1, 1);
#pragma unroll 1
                for (int s = 0; s < 128; s += 2) {
                    ECP(0, s);     if (s + 2 < 128) ELD(0, s + 2);
                    ECP(1, s + 1); if (s + 3 < 128) ELD(1, s + 3);
                }
#undef ELD
#undef ECP
                float* xo = p.out + tokg * 1024 + li * 16;
                const int b = (int)(tokg >> 11);
                const float* g2 = mod + (size_t)b * 6144 + 5 * 1024 + li * 16;
                const float* fg = p.in[I_FG] + li * 16;
                float ss = 0.f;
#pragma unroll
                for (int c = 0; c < 4; ++c) {
#pragma unroll
                    for (int q4 = 0; q4 < 4; ++q4) {
                        const f32x4 xv = *(const f32x4*)(xo + c * 256 + q4 * 4), gv = *(const f32x4*)(g2 + c * 256 + q4 * 4);
#pragma unroll
                        for (int j = 0; j < 4; ++j) { const float t = xv[j] + gv[j] * acc[c * 16 + q4 * 4 + j]; acc[c * 16 + q4 * 4 + j] = t; ss += t * t; }
                    }
                    asm volatile("" : "+v"(ss) :: "memory");
                }
                ss = row16_allsum(ss);
                const float r = rsqrtf(ss * (1.0f / 1024.0f) + 1e-6f);
#pragma unroll
                for (int c = 0; c < 4; ++c) {
#pragma unroll
                    for (int q4 = 0; q4 < 4; ++q4) {
                        const f32x4 fv = *(const f32x4*)(fg + c * 256 + q4 * 4);
                        f32x4 ov;
#pragma unroll
                        for (int j = 0; j < 4; ++j) ov[j] = acc[c * 16 + q4 * 4 + j] * r * fv[j];
                        *(f32x4*)(xo + c * 256 + q4 * 4) = ov;
                    }
                    asm volatile("" ::: "memory");
                }
            }
            LDS_FENCE();
          }
        }
    }
}

__global__ void __launch_bounds__(512, 2) mega(Params p) {
    extern __shared__ __attribute__((aligned(16))) unsigned char shm[];
    LAS unsigned char* lds = (LAS unsigned char*)shm;
    cg::grid_group grid = cg::this_grid();
    unsigned char* ws = p.ws;
    const int G = (int)gridDim.x, c = (int)blockIdx.x;
    unsigned* bar = (unsigned*)(ws + OFF_BAR); unsigned epoch = 0;

    if (p.ws == nullptr) grid.sync();
    phase0(p, (float*)shm);
    grid_bar(bar, epoch, (unsigned)G);
    phase1(p, (float*)shm);
    grid_bar(bar, epoch, (unsigned)G);
    {
        pg8::StaticOrder S; S.init(NTOK, INC, G, c);
        pg8::Gemm g{ws + OFF_R1, ws + OFF_WINT, 1024, 1024, NTOK, INC, 1024, 0};
        EpiIn E{(h16*)(ws + OFF_QB), (h16*)(ws + OFF_KB), (h16*)(ws + OFF_VT), (h16*)(ws + OFF_GUV), (h16*)(ws + OFF_GATES)};
        pg8::gemm_phase(lds, g, S, E);
        pg8::StaticOrder S2; S2.init(NCTXT, 1024, G, c);
        pg8::Gemm g2{ws + OFF_HC, ws + OFF_WINT + (size_t)512 * 1024 * 2, 1024, 1024, NCTXT, 1024, 1024, 0};
        EpiCtx E2{(h16*)(ws + OFF_KC), (h16*)(ws + OFF_VCT)};
        pg8::gemm_phase(lds, g2, S2, E2);
    }
    grid_bar(bar, epoch, (unsigned)G);
    {
        for (int rep3 = 0; rep3 < REP_P3; ++rep3) {
        for (int u = c; u < 512; u += G) attn_unit(p, u);
        for (int n = c; n < 256; n += G) sgu_unit(p, n, lds);
        }
    }
    grid_bar(bar, epoch, (unsigned)G);
    {
        pg8::StaticOrder S; S.init(NTOK, 1024, G, c);
        pg8::Gemm ga{ws + OFF_R1, ws + OFF_WPAT, 1024, 512, NTOK, 1024, 512, 0};
        EpiM1 E1{(h16*)(ws + OFF_M1), (const h16*)(ws + OFF_GATES)};
        pg8::gemm_phase(lds, ga, S, E1);
        pg8::Gemm gb{ws + OFF_R1 + 1024, ws + OFF_WPBT, 1024, 512, NTOK, 1024, 512, 0};
        EpiM2 E2{(const h16*)(ws + OFF_M1), (const h16*)(ws + OFF_GATES), (h16*)(ws + OFF_MM)};
        pg8::gemm_phase(lds, gb, S, E2);
    }
    grid_bar(bar, epoch, (unsigned)G);
    {
        pg8::StaticOrder S; S.init(NTOK, 1024, G, c);
        pg8::Gemm g{ws + OFF_MM, ws + OFF_WOUTT, 1024, 1024, NTOK, 1024, 1024, 0};
        EpiX1 E{p.in[I_X], (const float*)(ws + OFF_MOD), p.out};
        pg8::gemm_phase(lds, g, S, E);
    }
    grid_bar(bar, epoch, (unsigned)G);
    phase6(p, (float*)shm);
    grid_bar(bar, epoch, (unsigned)G);
    {
        pg8::StaticOrder S; S.init(NTOK, 2048, G, c);
        pg8::Gemm g{ws + OFF_R1, ws + OFF_WQT, 1024, 1024, NTOK, 2048, 1024, 0};
        EpiH16 E{(h16*)(ws + OFF_SC16), 2048};
        pg8::gemm_phase(lds, g, S, E);
    }
    grid_bar(bar, epoch, (unsigned)G);
    peer_phase(p, lds, bar, epoch);
}

extern "C" void kernel_launch(void* const* d_in, const int* in_sizes, int n_in, void* d_out, int out_size, void* d_ws, size_t ws_size, hipStream_t stream) {
    static int grid_blocks = 0;
    if (!grid_blocks) {
        int dev = 0, cus = 0, per_cu = 0;
        hipGetDevice(&dev);
        hipDeviceGetAttribute(&cus, hipDeviceAttributeMultiprocessorCount, dev);
        hipFuncSetAttribute((const void*)mega, hipFuncAttributeMaxDynamicSharedMemorySize, LDS_BYTES);
        hipOccupancyMaxActiveBlocksPerMultiprocessor(&per_cu, (const void*)mega, 512, LDS_BYTES);
        if (per_cu < 1) per_cu = 1;
        grid_blocks = cus * per_cu;
        if (ws_size < WS_END) fprintf(stderr, "kernel_launch: workspace too small: %zu < %zu\n", ws_size, (size_t)WS_END);
    }
    hipMemsetAsync((unsigned char*)d_ws + OFF_BAR, 0, 256, stream);
    Params p{};
    for (int i = 0; i < 21; ++i) p.in[i] = (const float*)d_in[i];
    p.out = (float*)d_out; p.ws = (unsigned char*)d_ws;
    void* args[] = {&p};
    hipError_t e = hipLaunchCooperativeKernel((const void*)mega, dim3(grid_blocks), dim3(512), args, LDS_BYTES, stream);
    if (e != hipSuccess) fprintf(stderr, "cooperative launch failed: %s (grid %d)\n", hipGetErrorString(e), grid_blocks);
}
```

```cpp
#include <hip/hip_runtime.h>
#include <hip/hip_cooperative_groups.h>
#include <cstdio>
namespace cg = cooperative_groups;

#define LAS __attribute__((address_space(3)))
typedef _Float16 h16;
typedef _Float16 h16x2 __attribute__((ext_vector_type(2)));
typedef _Float16 h16x4 __attribute__((ext_vector_type(4)));
typedef _Float16 h16x8 __attribute__((ext_vector_type(8)));
typedef float f32x4 __attribute__((ext_vector_type(4)));
typedef float f32x2 __attribute__((ext_vector_type(2)));
typedef int i32x4 __attribute__((ext_vector_type(4)));
typedef int i32x2 __attribute__((ext_vector_type(2)));

constexpr int NTOK = 32768, DM = 1024, NCTXT = 4096, INC = 4608, SEQ = 2048, CTXL = 256;
constexpr int LDS_BYTES = 144 * 1024;
#ifndef REP_SEL
#define REP_SEL 1
#endif
#ifndef REP_GATH
#define REP_GATH 1
#endif
#ifndef REP_P3
#define REP_P3 1
#endif

constexpr size_t al256(size_t x) { return (x + 255) & ~(size_t)255; }
constexpr size_t OFF_WINT = 0;
constexpr size_t OFF_WPAT = OFF_WINT + (size_t)INC * DM * 2;
constexpr size_t OFF_WPBT = OFF_WPAT + (size_t)1024 * 512 * 2;
constexpr size_t OFF_WOUTT = OFF_WPBT + (size_t)1024 * 512 * 2;
constexpr size_t OFF_WQT = OFF_WOUTT + (size_t)1024 * 1024 * 2;
constexpr size_t OFF_BD = OFF_WQT + (size_t)2048 * 1024 * 2;
constexpr size_t OFF_U16 = OFF_BD + (size_t)2048 * 256 * 2;
constexpr size_t OFF_V16 = OFF_U16 + (size_t)16384 * 1024 * 2;
constexpr size_t OFF_WS16 = OFF_V16 + (size_t)16384 * 1024 * 2;
constexpr size_t OFF_MODP = OFF_WS16 + (size_t)8 * 128 * 128 * 2;
constexpr size_t OFF_MOD = OFF_MODP + (size_t)16 * 17 * 6144 * 4;
constexpr size_t OFF_R1 = al256(OFF_MOD + (size_t)17 * 6144 * 4);
constexpr size_t OFF_QB = OFF_R1 + (size_t)NTOK * DM * 2;
constexpr size_t OFF_KB = OFF_QB + (size_t)NTOK * 512 * 2;
constexpr size_t OFF_VT = OFF_KB + (size_t)NTOK * 512 * 2;
constexpr size_t OFF_GUV = OFF_VT + (size_t)NTOK * 512 * 2;
constexpr size_t OFF_GATES = OFF_GUV + (size_t)NTOK * 1024 * 2;
constexpr size_t OFF_MM = OFF_GATES + (size_t)NTOK * 2048 * 2;
constexpr size_t OFF_BAR = OFF_MM + (size_t)NTOK * DM * 2;
constexpr size_t WS_END = OFF_BAR + 256;
constexpr size_t OFF_U8 = OFF_U16;
constexpr size_t OFF_USC = OFF_V16;
constexpr size_t OFF_V8 = OFF_V16;
constexpr size_t OFF_VSC = OFF_V16 + (size_t)16384 * 1024;
constexpr size_t OFF_M1 = OFF_QB;
constexpr size_t OFF_SC16 = OFF_QB;
constexpr size_t OFF_Q16 = OFF_GATES;
constexpr size_t OFF_HC = OFF_MM;
constexpr size_t OFF_KC = OFF_HC + (size_t)NCTXT * DM * 2;
constexpr size_t OFF_VCT = OFF_KC + (size_t)NCTXT * 512 * 2;
static_assert(OFF_M1 + (size_t)NTOK * DM * 4 <= OFF_GATES, "m1 alias");
static_assert(WS_END <= (size_t)512 * 1024 * 1024, "workspace");

struct Params {
    const float* in[21];
    float* out;
    unsigned char* ws;
};
enum { I_X = 0, I_C, I_CTX, I_CCTX, I_ADAW, I_ADAB, I_N1G, I_N2G, I_WIN, I_RPB, I_LNG, I_GMWS, I_GMBS, I_WPA, I_WPB, I_WOUT, I_WQ, I_KEYS, I_PU, I_PV, I_FG };

__device__ __forceinline__ int launder(int x) { asm volatile("" : "+v"(x)); return x; }
__device__ __forceinline__ int fresh_tid() { int t = threadIdx.x; asm volatile("" : "+v"(t)); return t; }

__device__ __forceinline__ float sigmoidf_(float x) { return __builtin_amdgcn_rcpf(1.0f + __expf(-x)); }
__device__ __forceinline__ float gelu_tanh(float x) {
    const float t = 0.7978845608028654f * (x + 0.044715f * x * x * x);
    return x * __builtin_amdgcn_rcpf(1.0f + __expf(-2.0f * t));
}
__device__ __forceinline__ float silu_(float x) { return x * __builtin_amdgcn_rcpf(1.0f + __expf(-x)); }
__device__ __forceinline__ float wave_sum(float v) {
#pragma unroll
    for (int o = 32; o > 0; o >>= 1) v += __shfl_xor(v, o);
    return v;
}
__device__ __forceinline__ h16x8 pack8(f32x4 a, f32x4 b) {
    h16x8 o;
    o[0] = (h16)a[0]; o[1] = (h16)a[1]; o[2] = (h16)a[2]; o[3] = (h16)a[3];
    o[4] = (h16)b[0]; o[5] = (h16)b[1]; o[6] = (h16)b[2]; o[7] = (h16)b[3];
    return o;
}


__device__ __forceinline__ void grid_bar(unsigned* ctr, unsigned& epoch, unsigned nblk) {
    __syncthreads();
    epoch += 1u;
    if (threadIdx.x == 0) {
        __builtin_amdgcn_fence(__ATOMIC_RELEASE, "agent");
        asm volatile("s_waitcnt vmcnt(0)" ::: "memory");
        __hip_atomic_fetch_add(ctr, 1u, __ATOMIC_RELAXED, __HIP_MEMORY_SCOPE_AGENT);
        const unsigned target = epoch * nblk;
        unsigned spins = 0;
        while (__hip_atomic_load(ctr, __ATOMIC_RELAXED, __HIP_MEMORY_SCOPE_AGENT) < target) { __builtin_amdgcn_s_sleep(2); if (++spins > (1u << 24)) break; }
        __builtin_amdgcn_fence(__ATOMIC_ACQUIRE, "agent");
        asm volatile("s_waitcnt vmcnt(0)" ::: "memory");
    }
    __syncthreads();
}

namespace pg8 {
constexpr int BM = 256, BK = 64, HALF = 128, HTB = HALF * BK * 2, STAGE_BYTES = 8 * HTB, NXCD = 8, WGM = 8;
__device__ __forceinline__ int lds_byte(int r, int c) { const int st = (r >> 4) * 2 + (c >> 5), rr = r & 15, cc = c & 31, ob = rr * 64 + cc * 2; return st * 1024 + (ob ^ (((ob >> 9) & 1) << 5)); }
__device__ __forceinline__ void stage_rc(int b, int& R, int& C) { const int st = b / 1024, sb = b % 1024, swz = sb ^ (((sb >> 9) & 1) << 5); R = (st >> 1) * 16 + swz / 64; C = (st & 1) * 32 + (swz % 64) / 2; }
__device__ __forceinline__ int perm32(int rho) { const int n = rho >> 4, i = rho & 15; return 8 * (i >> 2) + 4 * n + (i & 3); }

struct Unit { int pm, pn; };
struct Gemm { const void* A; const void* Bt; int lda, ldb, M, N, K, a_pn_bytes; };

struct StaticOrder {
    int nM, nN, nwg, G, c;
    __device__ void init(int M, int N, int G_, int c_) { nM = M / BM; nN = N / BM; nwg = nM * nN; G = G_; c = c_; }
    __device__ bool next(int i, Unit& u) const {
        const long L = (long)i * G + c; if (L >= nwg) return false;
        int wgid = (int)L; { const int q = nwg / NXCD, r = nwg % NXCD, xcd = wgid % NXCD, off = wgid / NXCD; wgid = (xcd < r ? xcd * (q + 1) : r * (q + 1) + (xcd - r) * q) + off; }
        const int nig = WGM * nN, gid = wgid / nig, fm = gid * WGM, gsz = (nM - fm) < WGM ? (nM - fm) : WGM;
        u.pm = fm + ((wgid % nig) % gsz); u.pn = (wgid % nig) / gsz; return true;
    }
};

template <class Epi>
__device__ __forceinline__ void gemm_phase(LAS unsigned char* lds, const Gemm g, const StaticOrder& S, const Epi& E) {
    const int tid = fresh_tid(), wid = __builtin_amdgcn_readfirstlane(tid >> 6), lane = tid & 63, wr = wid >> 2, wc = wid & 3, fr = lane & 15, fq = lane >> 4;
    const int K = g.K, nt = K / BK;
    unsigned voffA[2], voffB[2];
#pragma unroll
    for (int i = 0; i < 2; ++i) { int R, C; stage_rc(tid * 16 + i * 8192, R, C); const int Rb = (R & ~31) + perm32(R & 31);
        voffA[i] = (unsigned)(R * g.lda + C) * 2u; voffB[i] = (unsigned)(Rb * g.ldb + C) * 2u; }
    const size_t kstep = (size_t)(BK * 2);
    const size_t hstepA = (size_t)HALF * g.lda * 2, hstepB = (size_t)HALF * g.ldb * 2;
    const size_t tstepA = 2 * hstepA, tstepB = 2 * hstepB;
    const unsigned ldsw = (unsigned)wid * 1024u;
    const int aoff = lds_byte(wr * 64 + fr, fq * 8), boff = lds_byte(wc * 32 + fr, fq * 8);
#define PG8_SA(b, h) (((b) * 2 + (h)) * HTB)
#define PG8_SB(b, h) ((4 + (b) * 2 + (h)) * HTB)
#define PG8_STAGE(bufoff, gbase, voff) do { _Pragma("unroll") for (int _i = 0; _i < 2; ++_i) \
        __builtin_amdgcn_global_load_lds((const unsigned*)((const char*)(gbase) + (voff)[_i]), (LAS unsigned*)(lds + (bufoff) + ldsw + _i * 8192), 16, 0, 0); } while (0)
#define PG8_LDA(dst, b, h) do { _Pragma("unroll") for (int m = 0; m < 4; ++m) _Pragma("unroll") for (int k = 0; k < 2; ++k) dst[m][k] = *(const LAS h16x8*)(lds + PG8_SA(b, h) + aoff + m * 2048 + k * 1024); } while (0)
#define PG8_LDB(dst, b, h) do { _Pragma("unroll") for (int n = 0; n < 2; ++n) _Pragma("unroll") for (int k = 0; k < 2; ++k) dst[n][k] = *(const LAS h16x8*)(lds + PG8_SB(b, h) + boff + n * 2048 + k * 1024); } while (0)
#define PG8_MMA(ai, bj, At, Bt) do { __builtin_amdgcn_s_setprio(1); _Pragma("unroll") for (int m = 0; m < 4; ++m) _Pragma("unroll") for (int n = 0; n < 2; ++n) _Pragma("unroll") for (int k = 0; k < 2; ++k) \
        acc[ai][bj][m][n] = __builtin_amdgcn_mfma_f32_16x16x32_f16(Bt[n][k], At[m][k], acc[ai][bj][m][n], 0, 0, 0); __builtin_amdgcn_s_setprio(0); } while (0)
#define PG8_WAIT_V(n) asm volatile("s_waitcnt vmcnt(" #n ")" ::: "memory")
#define PG8_WAIT_L(n) asm volatile("s_waitcnt lgkmcnt(" #n ")" ::: "memory")
#define PG8_BAR __builtin_amdgcn_s_barrier()
#define PG8_SCHED __builtin_amdgcn_sched_barrier(0)
    Unit cur, nxt; int ui = 0;
    if (!S.next(0, cur)) return;
    f32x4 acc[2][2][4][2];
#pragma unroll
    for (int a = 0; a < 2; ++a)
#pragma unroll
        for (int b = 0; b < 2; ++b)
#pragma unroll
            for (int m = 0; m < 4; ++m)
#pragma unroll
                for (int n = 0; n < 2; ++n) acc[a][b][m][n] = (f32x4){0.f, 0.f, 0.f, 0.f};
    h16x8 At[4][2], B0[2][2], B1[2][2];
    const char* cA = (const char*)g.A + (size_t)cur.pm * tstepA + (size_t)cur.pn * g.a_pn_bytes; const char* cB = (const char*)g.Bt + (size_t)cur.pn * tstepB;
    PG8_STAGE(PG8_SB(0, 0), cB, voffB); PG8_STAGE(PG8_SA(0, 0), cA, voffA); PG8_STAGE(PG8_SB(0, 1), cB + hstepB, voffB); PG8_STAGE(PG8_SA(0, 1), cA + hstepA, voffA);
    if (wr == 1) PG8_BAR;
    PG8_WAIT_V(4); PG8_BAR;
    PG8_STAGE(PG8_SB(1, 0), cB + kstep, voffB); PG8_STAGE(PG8_SA(1, 0), cA + kstep, voffA); PG8_STAGE(PG8_SB(1, 1), cB + hstepB + kstep, voffB);
    PG8_WAIT_V(6); PG8_BAR;
    for (;;) {
        const bool has_next = S.next(ui + 1, nxt);
        const char* nA = has_next ? (const char*)g.A + (size_t)nxt.pm * tstepA + (size_t)nxt.pn * g.a_pn_bytes : cA; const char* nB = has_next ? (const char*)g.Bt + (size_t)nxt.pn * tstepB : cB;
        for (int t = 0; t < nt; t += 2) {
            const bool last = (t == nt - 2);
            const char* a1 = cA + (size_t)(t + 1) * kstep;
            const char* a2 = last ? nA : cA + (size_t)(t + 2) * kstep; const char* b2 = last ? nB : cB + (size_t)(t + 2) * kstep;
            const char* a3 = a2 + kstep; const char* b3 = b2 + kstep;
            PG8_LDB(B0, 0, 0); PG8_SCHED; PG8_LDA(At, 0, 0); PG8_STAGE(PG8_SA(1, 1), a1 + hstepA, voffA);
            PG8_WAIT_L(8); PG8_BAR; PG8_WAIT_L(0); PG8_MMA(0, 0, At, B0); PG8_BAR; PG8_SCHED;
            PG8_LDB(B1, 0, 1); PG8_STAGE(PG8_SB(0, 0), b2, voffB);
            PG8_BAR; PG8_WAIT_L(0); PG8_MMA(0, 1, At, B1); PG8_BAR;
            PG8_LDA(At, 0, 1); PG8_STAGE(PG8_SA(0, 0), a2, voffA);
            PG8_BAR; PG8_WAIT_L(0); PG8_MMA(1, 0, At, B0); PG8_BAR; PG8_SCHED;
            PG8_STAGE(PG8_SB(0, 1), b2 + hstepB, voffB);
            PG8_WAIT_V(6); PG8_BAR; PG8_MMA(1, 1, At, B1); PG8_BAR;
            PG8_LDB(B0, 1, 0); PG8_SCHED; PG8_LDA(At, 1, 0); PG8_STAGE(PG8_SA(0, 1), a2 + hstepA, voffA);
            PG8_WAIT_L(8); PG8_BAR; PG8_WAIT_L(0); PG8_MMA(0, 0, At, B0); PG8_BAR; PG8_SCHED;
            PG8_LDB(B1, 1, 1); PG8_STAGE(PG8_SB(1, 0), b3, voffB);
            PG8_BAR; PG8_WAIT_L(0); PG8_MMA(0, 1, At, B1); PG8_BAR;
            PG8_LDA(At, 1, 1); PG8_STAGE(PG8_SA(1, 0), a3, voffA);
            PG8_BAR; PG8_WAIT_L(0); PG8_MMA(1, 0, At, B0); PG8_BAR; PG8_SCHED;
            PG8_STAGE(PG8_SB(1, 1), b3 + hstepB, voffB);
            PG8_WAIT_V(6); PG8_BAR; PG8_MMA(1, 1, At, B1); PG8_BAR;
        }
        E(acc, cur, wr, wc, fr, fq);
        if (!has_next) break;
#pragma unroll
        for (int a = 0; a < 2; ++a)
#pragma unroll
            for (int b = 0; b < 2; ++b)
#pragma unroll
                for (int m = 0; m < 4; ++m)
#pragma unroll
                    for (int n = 0; n < 2; ++n) acc[a][b][m][n] = (f32x4){0.f, 0.f, 0.f, 0.f};
        cur = nxt; cA = nA; cB = nB; ++ui;
    }
    PG8_WAIT_V(0);
    if (wr == 0) PG8_BAR;
    PG8_BAR;
#undef PG8_SA
#undef PG8_SB
#undef PG8_STAGE
#undef PG8_LDA
#undef PG8_LDB
#undef PG8_MMA
#undef PG8_WAIT_V
#undef PG8_WAIT_L
#undef PG8_BAR
#undef PG8_SCHED
}
}
typedef f32x4 AccT[2][2][4][2];

struct EpiIn {
    h16 *qb, *kb, *vt, *guv, *gates;
    __device__ __forceinline__ void operator()(const AccT& acc, const pg8::Unit& u, int wr, int wc, int fr, int fq) const {
        const int pn = u.pn;
        const int row0 = u.pm * 256 + wr * 64 + fr;
        const int cin = wc * 32 + 8 * fq;
        const int b = (u.pm * 256) >> 11, sb = ((u.pm * 256) & 2047) + wr * 64;
        if (pn < 2) {
            h16* base = qb + (size_t)row0 * 512 + pn * 256 + cin;
#pragma unroll
            for (int ai = 0; ai < 2; ++ai)
#pragma unroll
                for (int m = 0; m < 4; ++m)
#pragma unroll
                    for (int bj = 0; bj < 2; ++bj) *(h16x8*)(base + (ai * 128 + m * 16) * 512 + bj * 128) = pack8(acc[ai][bj][m][0], acc[ai][bj][m][1]);
        } else if (pn < 4) {
#pragma unroll
            for (int bj = 0; bj < 2; ++bj) {
                const int col = (pn & 1) * 256 + bj * 128 + cin, hd = col >> 6, d0 = col & 63;
                h16* base = kb + ((size_t)(b * 8 + hd) * 2048 + sb + fr) * 64 + d0;
#pragma unroll
                for (int ai = 0; ai < 2; ++ai)
#pragma unroll
                    for (int m = 0; m < 4; ++m) *(h16x8*)(base + (ai * 128 + m * 16) * 64) = pack8(acc[ai][bj][m][0], acc[ai][bj][m][1]);
            }
        } else if (pn < 6) {
#pragma unroll
            for (int bj = 0; bj < 2; ++bj) {
                const int cv = (pn - 4) * 256 + bj * 128 + cin, hd = cv >> 6, d0 = cv & 63;
                h16* base = vt + ((size_t)(b * 8 + hd) * 256 + (sb >> 3) + (fr >> 3)) * 512 + d0 * 8 + (fr & 7);
#pragma unroll
                for (int ai = 0; ai < 2; ++ai)
#pragma unroll
                    for (int m = 0; m < 4; ++m) {
                        h16* vp = base + (ai * 16 + m * 2) * 512;
                        const f32x4 v0 = acc[ai][bj][m][0], v1 = acc[ai][bj][m][1];
#pragma unroll
                        for (int i = 0; i < 4; ++i) { vp[i * 8] = (h16)v0[i]; vp[(i + 4) * 8] = (h16)v1[i]; }
                    }
            }
        } else if (pn < 10) {
            h16* base = guv + (size_t)row0 * 1024 + (pn - 6) * 256 + cin;
#pragma unroll
            for (int ai = 0; ai < 2; ++ai)
#pragma unroll
                for (int m = 0; m < 4; ++m)
#pragma unroll
                    for (int bj = 0; bj < 2; ++bj) {
                        f32x4 v0 = acc[ai][bj][m][0], v1 = acc[ai][bj][m][1];
#pragma unroll
                        for (int i = 0; i < 4; ++i) { v0[i] = gelu_tanh(v0[i]); v1[i] = gelu_tanh(v1[i]); }
                        *(h16x8*)(base + (ai * 128 + m * 16) * 1024 + bj * 128) = pack8(v0, v1);
                    }
        } else {
            h16* base = gates + (size_t)row0 * 2048 + (pn - 10) * 256 + cin;
#pragma unroll
            for (int ai = 0; ai < 2; ++ai)
#pragma unroll
                for (int m = 0; m < 4; ++m)
#pragma unroll
                    for (int bj = 0; bj < 2; ++bj) {
                        f32x4 v0 = acc[ai][bj][m][0], v1 = acc[ai][bj][m][1];
#pragma unroll
                        for (int i = 0; i < 4; ++i) { v0[i] = sigmoidf_(v0[i]); v1[i] = sigmoidf_(v1[i]); }
                        *(h16x8*)(base + (ai * 128 + m * 16) * 2048 + bj * 128) = pack8(v0, v1);
                    }
        }
    }
};
struct EpiCtx {
    h16 *kc, *vct;
    __device__ __forceinline__ void operator()(const AccT& acc, const pg8::Unit& u, int wr, int wc, int fr, int fq) const {
        const int pn = u.pn;
        const int cin = wc * 32 + 8 * fq;
        const int b = u.pm, sb = wr * 64;
        if (pn < 2) {
#pragma unroll
            for (int bj = 0; bj < 2; ++bj) {
                const int col = pn * 256 + bj * 128 + cin, hd = col >> 6, d0 = col & 63;
                h16* base = kc + ((size_t)(b * 8 + hd) * 256 + sb + fr) * 64 + d0;
#pragma unroll
                for (int ai = 0; ai < 2; ++ai)
#pragma unroll
                    for (int m = 0; m < 4; ++m) *(h16x8*)(base + (ai * 128 + m * 16) * 64) = pack8(acc[ai][bj][m][0], acc[ai][bj][m][1]);
            }
        } else {
#pragma unroll
            for (int bj = 0; bj < 2; ++bj) {
                const int cv = (pn - 2) * 256 + bj * 128 + cin, hd = cv >> 6, d0 = cv & 63;
                h16* base = vct + ((size_t)(b * 8 + hd) * 32 + (sb >> 3) + (fr >> 3)) * 512 + d0 * 8 + (fr & 7);
#pragma unroll
                for (int ai = 0; ai < 2; ++ai)
#pragma unroll
                    for (int m = 0; m < 4; ++m) {
                        h16* vp = base + (ai * 16 + m * 2) * 512;
                        const f32x4 v0 = acc[ai][bj][m][0], v1 = acc[ai][bj][m][1];
#pragma unroll
                        for (int i = 0; i < 4; ++i) { vp[i * 8] = (h16)v0[i]; vp[(i + 4) * 8] = (h16)v1[i]; }
                    }
            }
        }
    }
};
struct EpiM1 {
    h16* m1; const h16* gates;
    __device__ __forceinline__ void operator()(const AccT& acc, const pg8::Unit& u, int wr, int wc, int fr, int fq) const {
        const int row0 = u.pm * 256 + wr * 64 + fr, col0 = u.pn * 256 + wc * 32 + 8 * fq;
#pragma unroll
        for (int ai = 0; ai < 2; ++ai)
#pragma unroll
            for (int m = 0; m < 4; ++m) {
                const int row = row0 + ai * 128 + m * 16;
#pragma unroll
                for (int bj = 0; bj < 2; ++bj) {
                    const int col = col0 + bj * 128;
                    const h16x8 gt = *(const h16x8*)(gates + (size_t)row * 2048 + col);
                    f32x4 v0 = acc[ai][bj][m][0], v1 = acc[ai][bj][m][1];
#pragma unroll
                    for (int i = 0; i < 4; ++i) { v0[i] *= (float)gt[i]; v1[i] *= (float)gt[4 + i]; }
                    *(h16x8*)(m1 + (size_t)row * 1024 + col) = pack8(v0, v1);
                }
            }
    }
};
struct EpiM2 {
    const h16* m1; const h16* gates; h16* mm;
    __device__ __forceinline__ void operator()(const AccT& acc, const pg8::Unit& u, int wr, int wc, int fr, int fq) const {
        const int row0 = u.pm * 256 + wr * 64 + fr, col0 = u.pn * 256 + wc * 32 + 8 * fq;
#pragma unroll
        for (int ai = 0; ai < 2; ++ai)
#pragma unroll
            for (int m = 0; m < 4; ++m) {
                const int row = row0 + ai * 128 + m * 16;
#pragma unroll
                for (int bj = 0; bj < 2; ++bj) {
                    const int col = col0 + bj * 128;
                    const h16x8 gt = *(const h16x8*)(gates + (size_t)row * 2048 + 1024 + col);
                    const h16x8 mi = *(const h16x8*)(m1 + (size_t)row * 1024 + col);
                    f32x4 p0 = (f32x4){(float)mi[0], (float)mi[1], (float)mi[2], (float)mi[3]}, p1 = (f32x4){(float)mi[4], (float)mi[5], (float)mi[6], (float)mi[7]};
                    const f32x4 v0 = acc[ai][bj][m][0], v1 = acc[ai][bj][m][1];
#pragma unroll
                    for (int i = 0; i < 4; ++i) { p0[i] += v0[i] * (float)gt[i]; p1[i] += v1[i] * (float)gt[4 + i]; }
                    *(h16x8*)(mm + (size_t)row * 1024 + col) = pack8(p0, p1);
                }
            }
    }
};
struct EpiX1 {
    const float* x; const float* mod; float* x1;
    __device__ __forceinline__ void operator()(const AccT& acc, const pg8::Unit& u, int wr, int wc, int fr, int fq) const {
        const int row0 = u.pm * 256 + wr * 64 + fr, col0 = u.pn * 256 + wc * 32 + 8 * fq;
        const int b = (u.pm * 256) >> 11;
#pragma unroll
        for (int bj = 0; bj < 2; ++bj) {
            const int col = col0 + bj * 128;
            const float* gp = mod + (size_t)b * 6144 + 2 * 1024 + col;
            const f32x4 g0 = *(const f32x4*)gp, g1 = *(const f32x4*)(gp + 4);
#pragma unroll
            for (int ai = 0; ai < 2; ++ai)
#pragma unroll
                for (int m = 0; m < 4; ++m) {
                    const int row = row0 + ai * 128 + m * 16;
                    const float* xi = x + (size_t)row * 1024 + col;
                    const f32x4 x0 = *(const f32x4*)xi, x1v = *(const f32x4*)(xi + 4);
                    float* o = x1 + (size_t)row * 1024 + col;
                    *(f32x4*)o = x0 + g0 * acc[ai][bj][m][0]; *(f32x4*)(o + 4) = x1v + g1 * acc[ai][bj][m][1];
                }
        }
    }
};
struct EpiH16 {
    h16* o; int ldc;
    __device__ __forceinline__ void operator()(const AccT& acc, const pg8::Unit& u, int wr, int wc, int fr, int fq) const {
        const int row0 = u.pm * 256 + wr * 64 + fr, col0 = u.pn * 256 + wc * 32 + 8 * fq;
#pragma unroll
        for (int ai = 0; ai < 2; ++ai)
#pragma unroll
            for (int m = 0; m < 4; ++m) {
                const int row = row0 + ai * 128 + m * 16;
#pragma unroll
                for (int bj = 0; bj < 2; ++bj)
                    *(h16x8*)(o + (size_t)row * ldc + col0 + bj * 128) = pack8(acc[ai][bj][m][0], acc[ai][bj][m][1]);
            }
    }
};

__device__ __forceinline__ void cvt_tile(const float* __restrict__ src, h16* __restrict__ dst, int tile) {
    const size_t i = (size_t)tile * 4096 + threadIdx.x * 8;
    const f32x4 a = *(const f32x4*)(src + i), b = *(const f32x4*)(src + i + 4);
    *(h16x8*)(dst + i) = pack8(a, b);
}
__device__ __forceinline__ void tr_tile(const float* __restrict__ src, h16* __restrict__ dst, int K, int N, int tile, float* lds) {
    const int ntn = N / 64, tk = tile / ntn, tn = tile % ntn, tid = threadIdx.x;
#pragma unroll
    for (int ps = 0; ps < 2; ++ps) {
        const int k = ps * 32 + (tid >> 4), n = (tid & 15) * 4;
        const f32x4 v = *(const f32x4*)(src + (size_t)(tk * 64 + k) * N + tn * 64 + n);
        lds[k * 65 + n] = v[0]; lds[k * 65 + n + 1] = v[1]; lds[k * 65 + n + 2] = v[2]; lds[k * 65 + n + 3] = v[3];
    }
    __syncthreads();
    {
        const int n = tid >> 3, ks = (tid & 7) * 8;
        h16x8 o;
#pragma unroll
        for (int i = 0; i < 8; ++i) o[i] = (h16)lds[(ks + i) * 65 + n];
        *(h16x8*)(dst + (size_t)(tn * 64 + n) * K + tk * 64 + ks) = o;
    }
    __syncthreads();
}
__device__ __forceinline__ void cvt8_rows(const float* __restrict__ src, unsigned char* __restrict__ dst, float* __restrict__ inv, int tile, int dstride = 1024) {
    const int wid = threadIdx.x >> 6, lane = threadIdx.x & 63;
    const size_t row = (size_t)tile * 8 + wid;
    const float* r = src + row * 1024 + lane * 16;
    f32x4 a[4]; float mx = 0.f;
#pragma unroll
    for (int i = 0; i < 4; ++i) { a[i] = *(const f32x4*)(r + 4 * i); mx = fmaxf(mx, fmaxf(fmaxf(fabsf(a[i][0]), fabsf(a[i][1])), fmaxf(fabsf(a[i][2]), fabsf(a[i][3])))); }
#pragma unroll
    for (int o = 32; o > 0; o >>= 1) mx = fmaxf(mx, __shfl_xor(mx, o));
    int ex2 = 0; float sc = 1.0f;
    if (mx > 0.f) { (void)frexpf(mx, &ex2); int k = 8 - ex2; k = k > 100 ? 100 : (k < -100 ? -100 : k); sc = ldexpf(1.0f, k); }
    i32x4 w;
#pragma unroll
    for (int i = 0; i < 4; ++i) {
        int pk = __builtin_amdgcn_cvt_pk_fp8_f32(a[i][0] * sc, a[i][1] * sc, 0, false);
        pk = __builtin_amdgcn_cvt_pk_fp8_f32(a[i][2] * sc, a[i][3] * sc, pk, true);
        w[i] = pk;
    }
    *(i32x4*)(dst + row * dstride + lane * 16) = w;
    if (lane == 0) inv[2 * row] = 1.0f / sc;
}
__device__ __forceinline__ void cvt4_rows(const float* __restrict__ src, unsigned char* __restrict__ dst, float* __restrict__ inv, int tile, int dstride = 512) {
    const int wid = threadIdx.x >> 6, lane = threadIdx.x & 63;
    const size_t row = (size_t)tile * 8 + wid;
    const float* r = src + row * 1024 + lane * 16;
    f32x4 a[4]; float mx = 0.f;
#pragma unroll
    for (int i = 0; i < 4; ++i) { a[i] = *(const f32x4*)(r + 4 * i); mx = fmaxf(mx, fmaxf(fmaxf(fabsf(a[i][0]), fabsf(a[i][1])), fmaxf(fabsf(a[i][2]), fabsf(a[i][3])))); }
#pragma unroll
    for (int o = 32; o > 0; o >>= 1) mx = fmaxf(mx, __shfl_xor(mx, o));
    const float sc = (mx > 1e-30f) ? 6.0f / mx : 1.0f;
    int w0 = 0, w1 = 0;
    w0 = __builtin_amdgcn_cvt_scalef32_pk_fp4_f32(w0, a[0][0] * sc, a[0][1] * sc, 1.0f, 0);
    w0 = __builtin_amdgcn_cvt_scalef32_pk_fp4_f32(w0, a[0][2] * sc, a[0][3] * sc, 1.0f, 1);
    w0 = __builtin_amdgcn_cvt_scalef32_pk_fp4_f32(w0, a[1][0] * sc, a[1][1] * sc, 1.0f, 2);
    w0 = __builtin_amdgcn_cvt_scalef32_pk_fp4_f32(w0, a[1][2] * sc, a[1][3] * sc, 1.0f, 3);
    w1 = __builtin_amdgcn_cvt_scalef32_pk_fp4_f32(w1, a[2][0] * sc, a[2][1] * sc, 1.0f, 0);
    w1 = __builtin_amdgcn_cvt_scalef32_pk_fp4_f32(w1, a[2][2] * sc, a[2][3] * sc, 1.0f, 1);
    w1 = __builtin_amdgcn_cvt_scalef32_pk_fp4_f32(w1, a[3][0] * sc, a[3][1] * sc, 1.0f, 2);
    w1 = __builtin_amdgcn_cvt_scalef32_pk_fp4_f32(w1, a[3][2] * sc, a[3][3] * sc, 1.0f, 3);
    *(i32x2*)(dst + row * dstride + lane * 8) = (i32x2){w0, w1};
    if (lane == 0) inv[2 * row] = 1.0f / sc;
}
__device__ __forceinline__ void wqk_tile(const float* __restrict__ wq, const float* __restrict__ keys, h16* __restrict__ wt, int tile, float* lds) {
    const int ct = tile >> 4, hp = tile & 15, tid = threadIdx.x;
    float* sA = lds;
    float* sB = lds + 64 * 129;
#pragma unroll
    for (int i = 0; i < 4; ++i) {
        const int e = (i * 512 + tid) * 4, r = e >> 7, d = e & 127;
        const f32x4 v = *(const f32x4*)(wq + (size_t)(ct * 64 + r) * 2048 + hp * 128 + d);
        sA[r * 129 + d] = v[0]; sA[r * 129 + d + 1] = v[1]; sA[r * 129 + d + 2] = v[2]; sA[r * 129 + d + 3] = v[3];
    }
#pragma unroll
    for (int i = 0; i < 8; ++i) {
        const int e = (i * 512 + tid) * 4, k = e >> 7, d = e & 127;
        const f32x4 v = *(const f32x4*)(keys + (size_t)(hp * 128 + k) * 128 + d);
        sB[k * 129 + d] = v[0]; sB[k * 129 + d + 1] = v[1]; sB[k * 129 + d + 2] = v[2]; sB[k * 129 + d + 3] = v[3];
    }
    __syncthreads();
    const int c = tid >> 3, kg = (tid & 7) * 16;
    float acc[16];
#pragma unroll
    for (int j = 0; j < 16; ++j) acc[j] = 0.f;
#pragma unroll 4
    for (int d = 0; d < 128; ++d) {
        const float a = sA[c * 129 + d];
#pragma unroll
        for (int j = 0; j < 16; ++j) acc[j] += a * sB[(kg + j) * 129 + d];
    }
#pragma unroll
    for (int j = 0; j < 16; ++j) wt[(size_t)(hp * 128 + kg + j) * 1024 + ct * 64 + c] = (h16)acc[j];
    __syncthreads();
}
__device__ void phase0(const Params& p, float* lds) {
    unsigned char* ws = p.ws;
    const int tid = threadIdx.x, wid = tid >> 6, lane = tid & 63;
    for (int ib = blockIdx.x; ib < 256; ib += gridDim.x) {
        if (wid < 6) {
            const int item = ib * 6 + wid, cg64 = item % 96, kc = item / 96;
            const int col = cg64 * 64 + lane, k0 = kc * 64;
            float sv[17], acc[17];
#pragma unroll
            for (int b = 0; b < 17; ++b) {
                const float cv = (b < 16) ? p.in[I_C][b * 1024 + k0 + lane] : p.in[I_CCTX][k0 + lane];
                sv[b] = silu_(cv); acc[b] = 0.f;
            }
            const float* wp = p.in[I_ADAW] + (size_t)k0 * 6144 + col;
            for (int j = 0; j < 64; ++j) {
                const float w = wp[(size_t)j * 6144];
#pragma unroll
                for (int b = 0; b < 17; ++b) acc[b] += __builtin_bit_cast(float, __builtin_amdgcn_readlane(__builtin_bit_cast(int, sv[b]), j)) * w;
            }
            float* mp = (float*)(ws + OFF_MODP);
#pragma unroll
            for (int b = 0; b < 17; ++b) mp[((size_t)kc * 17 + b) * 6144 + col] = acc[b];
        }
    }
    constexpr int T0 = 2048, T1 = T0 + 2048, T2 = T1 + 32, T3 = T2, T4 = T3 + 1152, T5 = T4 + 128, T6 = T5 + 128, T7 = T6 + 256, T8 = T7 + 256;
    for (int t = blockIdx.x; t < T8; t += gridDim.x) {
        if (t < T0) cvt4_rows(p.in[I_PU], ws + OFF_U8, (float*)(ws + OFF_USC), t, 1536);
        else if (t < T1) cvt8_rows(p.in[I_PV], ws + OFF_U8 + 512, (float*)(ws + OFF_USC) + 1, t - T0, 1536);
        else if (t < T2) cvt_tile(p.in[I_GMWS], (h16*)(ws + OFF_WS16), t - T1);
        else if (t < T3) {
            const int e = (t - T2) * 4096 + tid * 8;
            const int row = e >> 8, cc = e & 255, h = row >> 8, pp = (row >> 7) & 1, k = row & 127, pq = cc >> 7, d = cc & 127;
            h16x8 o = {0, 0, 0, 0, 0, 0, 0, 0};
            if (pp == pq) {
                const float* kp = p.in[I_KEYS] + ((size_t)((h * 2 + pp) * 128 + k)) * 128 + d;
                o = pack8(*(const f32x4*)kp, *(const f32x4*)(kp + 4));
            }
            *(h16x8*)((h16*)(ws + OFF_BD) + e) = o;
        }
        else if (t < T4) tr_tile(p.in[I_WIN], (h16*)(ws + OFF_WINT), 1024, INC, t - T3, lds);
        else if (t < T5) tr_tile(p.in[I_WPA], (h16*)(ws + OFF_WPAT), 512, 1024, t - T4, lds);
        else if (t < T6) tr_tile(p.in[I_WPB], (h16*)(ws + OFF_WPBT), 512, 1024, t - T5, lds);
        else if (t < T7) tr_tile(p.in[I_WOUT], (h16*)(ws + OFF_WOUTT), 1024, 1024, t - T6, lds);
        else wqk_tile(p.in[I_WQ], p.in[I_KEYS], (h16*)(ws + OFF_WQT), t - T7, lds);
    }
}

__device__ __forceinline__ void norm_rows(const float* __restrict__ src, h16* __restrict__ dst, int row_begin, int rows_per_wave, const float* sA, const float* sB) {
    const int tid_ = fresh_tid();
    const int wid = tid_ >> 6, lane = tid_ & 63;
    f32x4 a[4], bsh[4];
#pragma unroll
    for (int c = 0; c < 4; ++c) { a[c] = *(const f32x4*)(sA + c * 256 + lane * 4); bsh[c] = *(const f32x4*)(sB + c * 256 + lane * 4); }
    for (int i = 0; i < rows_per_wave; i += 2) {
        const size_t row = (size_t)row_begin + wid * rows_per_wave + i;
        f32x4 v[2][4]; float ss[2];
#pragma unroll
        for (int q = 0; q < 2; ++q) {
            ss[q] = 0.f;
#pragma unroll
            for (int c = 0; c < 4; ++c) { v[q][c] = *(const f32x4*)(src + (row + q) * 1024 + c * 256 + lane * 4); ss[q] += v[q][c][0] * v[q][c][0] + v[q][c][1] * v[q][c][1] + v[q][c][2] * v[q][c][2] + v[q][c][3] * v[q][c][3]; }
        }
#pragma unroll
        for (int o = 32; o > 0; o >>= 1) { const float t0 = __shfl_xor(ss[0], o), t1 = __shfl_xor(ss[1], o); ss[0] += t0; ss[1] += t1; }
#pragma unroll
        for (int q = 0; q < 2; ++q) {
            const float r = rsqrtf(ss[q] * (1.0f / 1024.0f) + 1e-6f);
#pragma unroll
            for (int c = 0; c < 4; ++c) {
                h16x4 o;
#pragma unroll
                for (int j = 0; j < 4; ++j) o[j] = (h16)(v[q][c][j] * r * a[c][j] + bsh[c][j]);
                *(h16x4*)(dst + (row + q) * 1024 + c * 256 + lane * 4) = o;
            }
        }
    }
}
__device__ void phase1(const Params& p, float* lds) {
    unsigned char* ws = p.ws;
    const int tid = threadIdx.x;
    const float* mp = (const float*)(ws + OFF_MODP);
    const float* bias = p.in[I_ADAB];
    float* sA = lds; float* sB = lds + 1024; float* cA = lds + 2048; float* cB = lds + 3072;
    {
        float* mod = (float*)(ws + OFF_MOD);
        for (int e = blockIdx.x * 512 + tid; e < 17 * 6144; e += gridDim.x * 512) {
            float s = bias[e % 6144];
#pragma unroll
            for (int kc = 0; kc < 16; ++kc) s += mp[(size_t)kc * 17 * 6144 + e];
            mod[e] = s;
        }
    }
    for (int col = tid; col < 1024; col += 512) {
        float sh = bias[col], sc = bias[1024 + col];
#pragma unroll
        for (int kc = 0; kc < 16; ++kc) { sh += mp[((size_t)kc * 17 + 16) * 6144 + col]; sc += mp[((size_t)kc * 17 + 16) * 6144 + 1024 + col]; }
        cA[col] = p.in[I_N1G][col] * (1.0f + sc); cB[col] = sh;
    }
    for (int rg = blockIdx.x; rg < 256; rg += gridDim.x) {
        const int b = rg >> 4;
        __syncthreads();
        for (int col = tid; col < 1024; col += 512) {
            float sh = bias[col], sc = bias[1024 + col];
#pragma unroll
            for (int kc = 0; kc < 16; ++kc) { sh += mp[((size_t)kc * 17 + b) * 6144 + col]; sc += mp[((size_t)kc * 17 + b) * 6144 + 1024 + col]; }
            sA[col] = p.in[I_N1G][col] * (1.0f + sc); sB[col] = sh;
        }
        __syncthreads();
        norm_rows(p.in[I_X], (h16*)(ws + OFF_R1), rg * 128, 16, sA, sB);
        norm_rows(p.in[I_CTX], (h16*)(ws + OFF_HC), rg * 16, 2, cA, cB);
    }
}
__device__ void phase6(const Params& p, float* lds) {
    unsigned char* ws = p.ws;
    const int tid = threadIdx.x;
    const float* mod = (const float*)(ws + OFF_MOD);
    float* sA = lds; float* sB = lds + 1024;
    for (int rg = blockIdx.x; rg < 256; rg += gridDim.x) {
        const int b = rg >> 4;
        __syncthreads();
        for (int col = tid; col < 1024; col += 512) {
            sA[col] = p.in[I_N2G][col] * (1.0f + mod[(size_t)b * 6144 + 4 * 1024 + col]); sB[col] = mod[(size_t)b * 6144 + 3 * 1024 + col];
        }
        __syncthreads();
        norm_rows(p.out, (h16*)(ws + OFF_R1), rg * 128, 16, sA, sB);
    }
}

__device__ __forceinline__ int clampi(int v, int lo, int hi) { return v < lo ? lo : (v > hi ? hi : v); }

template <bool LOCAL>
__device__ __forceinline__ void attn_core(const h16x8 (&kf)[2][2], const h16x8 (&vf)[4], const float* __restrict__ rpbrow, const int cb, const int qc, const int cs,
                                          const h16x8 (&qf)[2], float& m_run, float& l_run, f32x4 (&O)[4], const int quad) {
    f32x4 st[2];
#pragma unroll
    for (int t = 0; t < 2; ++t) {
        f32x4 a = (f32x4){0.f, 0.f, 0.f, 0.f};
#pragma unroll
        for (int ks = 0; ks < 2; ++ks) a = __builtin_amdgcn_mfma_f32_16x16x32_f16(kf[t][ks], qf[ks], a, 0, 0, 0);
        st[t] = a;
    }
    float mx = -INFINITY;
#pragma unroll
    for (int t = 0; t < 2; ++t)
#pragma unroll
        for (int j = 0; j < 4; ++j) {
            float sv = st[t][j] * 0.125f;
            if (LOCAL) {
                const int kc = cb + 16 * t + quad * 4 + j;
                const bool inw = (kc >= cs) && (kc < cs + 16);
                const int dc = clampi(kc - qc + 15, 0, 30);
                const float bv = rpbrow[dc];
                sv = inw ? (sv + bv) : -1e30f;
            }
            st[t][j] = sv; mx = fmaxf(mx, sv);
        }
    mx = fmaxf(mx, __shfl_xor(mx, 16)); mx = fmaxf(mx, __shfl_xor(mx, 32));
    const float m_new = fmaxf(m_run, mx);
    const float alpha = __expf(m_run - m_new);
    float ls = 0.f; h16x8 pf;
#pragma unroll
    for (int t = 0; t < 2; ++t)
#pragma unroll
        for (int j = 0; j < 4; ++j) { const float pe = __expf(st[t][j] - m_new); ls += pe; pf[t * 4 + j] = (h16)pe; }
    l_run = l_run * alpha + ls; m_run = m_new;
#pragma unroll
    for (int dt = 0; dt < 4; ++dt) { O[dt] *= alpha; O[dt] = __builtin_amdgcn_mfma_f32_16x16x32_f16(vf[dt], pf, O[dt], 0, 0, 0); }
}
__device__ __forceinline__ void load_kv(const h16* __restrict__ kt, const h16* __restrict__ vt, h16x8 (&kf)[2][2], h16x8 (&vf)[4], const int l15, const int quad) {
#pragma unroll
    for (int t = 0; t < 2; ++t)
#pragma unroll
        for (int ks = 0; ks < 2; ++ks) kf[t][ks] = *(const h16x8*)(kt + (16 * t + l15) * 64 + ks * 32 + quad * 8);
#pragma unroll
    for (int dt = 0; dt < 4; ++dt) {
        const h16* vp = vt + ((quad >> 1) * 64 + dt * 16 + l15) * 8 + (quad & 1) * 4;
        const h16x4 lo = *(const h16x4*)vp, hi = *(const h16x4*)(vp + 2 * 512);
        vf[dt] = (h16x8){lo[0], lo[1], lo[2], lo[3], hi[0], hi[1], hi[2], hi[3]};
    }
}

__device__ void attn_unit(const Params& p, int unit) {
    unsigned char* ws = p.ws;
    const int tid_ = fresh_tid();
    const int lane = tid_ & 63, h = tid_ >> 6, l15 = lane & 15, quad = lane >> 4;
    const int b = unit >> 5, r = unit & 31;
    const h16* QB = (const h16*)(ws + OFF_QB);
    const h16* KH = (const h16*)(ws + OFF_KB) + (size_t)(b * 8 + h) * 2048 * 64;
    const h16* VH = (const h16*)(ws + OFF_VT) + (size_t)(b * 8 + h) * 256 * 512;
    const h16* KCH = (const h16*)(ws + OFF_KC) + (size_t)(b * 8 + h) * 256 * 64;
    const h16* VCH = (const h16*)(ws + OFF_VCT) + (size_t)(b * 8 + h) * 32 * 512;
    h16* YA = (h16*)(ws + OFF_R1);
    const float* rpb = p.in[I_RPB] + (size_t)h * 15 * 31;
    const int rs = clampi(r - 4, 0, 24);
    h16x8 qf[4][2]; float m_run[4], l_run[4]; f32x4 O[4][4];
#pragma unroll
    for (int g = 0; g < 4; ++g) {
        const size_t tq = (size_t)b * 2048 + r * 64 + 16 * g + l15;
        qf[g][0] = *(const h16x8*)(QB + tq * 512 + h * 64 + quad * 8);
        qf[g][1] = *(const h16x8*)(QB + tq * 512 + h * 64 + 32 + quad * 8);
        m_run[g] = -INFINITY; l_run[g] = 0.f;
#pragma unroll
        for (int dt = 0; dt < 4; ++dt) O[g][dt] = (f32x4){0.f, 0.f, 0.f, 0.f};
    }
#pragma unroll 1
    for (int step = 0; step < 8; ++step) {
        h16x8 kf[2][2], vf[4];
        load_kv(KCH + step * 32 * 64, VCH + step * 4 * 512, kf, vf, l15, quad);
#pragma unroll
        for (int g = 0; g < 4; ++g) attn_core<false>(kf, vf, rpb, 0, 0, 0, qf[g], m_run[g], l_run[g], O[g], quad);
    }
#pragma unroll
    for (int gp = 0; gp < 4; gp += 2) {
        const int cb0 = clampi(16 * gp - 8, 0, 32), cb1 = clampi(16 * (gp + 1) - 8, 0, 32);
        const int qc0 = 16 * gp + l15, qc1 = 16 * (gp + 1) + l15;
        const int cs0 = clampi(qc0 - 8, 0, 48), cs1 = clampi(qc1 - 8, 0, 48);
        const float* rp0 = rpb + (rs - r + 7) * 31;
#pragma unroll 1
        for (int step = 0; step < 8; ++step) {
            const int t0 = (rs + step) * 64 + cb0, t1 = (rs + step) * 64 + cb1;
            h16x8 kf0[2][2], vf0[4], kf1[2][2], vf1[4];
            load_kv(KH + (size_t)t0 * 64, VH + (size_t)(t0 >> 3) * 512, kf0, vf0, l15, quad);
            load_kv(KH + (size_t)t1 * 64, VH + (size_t)(t1 >> 3) * 512, kf1, vf1, l15, quad);
            attn_core<true>(kf0, vf0, rp0 + step * 31, cb0, qc0, cs0, qf[gp], m_run[gp], l_run[gp], O[gp], quad);
            attn_core<true>(kf1, vf1, rp0 + step * 31, cb1, qc1, cs1, qf[gp + 1], m_run[gp + 1], l_run[gp + 1], O[gp + 1], quad);
        }
    }
#pragma unroll
    for (int g = 0; g < 4; ++g) {
        const size_t tq = (size_t)b * 2048 + r * 64 + 16 * g + l15;
        float l = l_run[g];
        l += __shfl_xor(l, 16); l += __shfl_xor(l, 32);
        const float inv = __builtin_amdgcn_rcpf(l);
#pragma unroll
        for (int dt = 0; dt < 4; ++dt) {
            h16x4 o;
#pragma unroll
            for (int j = 0; j < 4; ++j) o[j] = (h16)(O[g][dt][j] * inv);
            *(h16x4*)(YA + tq * 1024 + h * 64 + dt * 16 + quad * 4) = o;
        }
    }
}

__device__ void sgu_unit(const Params& p, int n, LAS unsigned char* lds) {
    unsigned char* ws = p.ws;
    const int tid = fresh_tid(), lane = tid & 63, g = tid >> 6, l15 = lane & 15, quad = lane >> 4;
    const h16* GUV = (const h16*)(ws + OFF_GUV);
    const h16* WS16 = (const h16*)(ws + OFF_WS16);
    h16* YB = (h16*)(ws + OFF_R1) + 512;
    LAS float* stat = (LAS float*)(lds + 8 * 17408);
    LAS h16* vt = (LAS h16*)(lds + g * 17408);
    const size_t t0 = (size_t)n * 128;
    __syncthreads();
    for (int i = 0; i < 16; i += 4) {
        h16x8 x[4]; float s[4], v[4];
#pragma unroll
        for (int q = 0; q < 4; ++q) {
            x[q] = *(const h16x8*)(GUV + (t0 + g * 16 + i + q) * 1024 + 512 + lane * 8);
            s[q] = 0.f;
#pragma unroll
            for (int j = 0; j < 8; ++j) s[q] += (float)x[q][j];
        }
#pragma unroll
        for (int o = 32; o > 0; o >>= 1) { float t[4];
#pragma unroll
            for (int q = 0; q < 4; ++q) t[q] = __shfl_xor(s[q], o);
#pragma unroll
            for (int q = 0; q < 4; ++q) s[q] += t[q]; }
#pragma unroll
        for (int q = 0; q < 4; ++q) {
            s[q] *= (1.0f / 512.0f); v[q] = 0.f;
#pragma unroll
            for (int j = 0; j < 8; ++j) { const float d = (float)x[q][j] - s[q]; v[q] += d * d; }
        }
#pragma unroll
        for (int o = 32; o > 0; o >>= 1) { float t[4];
#pragma unroll
            for (int q = 0; q < 4; ++q) t[q] = __shfl_xor(v[q], o);
#pragma unroll
            for (int q = 0; q < 4; ++q) v[q] += t[q]; }
        if (lane == 0) {
#pragma unroll
            for (int q = 0; q < 4; ++q) { stat[(g * 16 + i + q) * 2] = s[q]; stat[(g * 16 + i + q) * 2 + 1] = rsqrtf(v[q] * (1.0f / 512.0f) + 1e-6f); }
        }
    }
    __syncthreads();
    {
        const int ch0 = (lane & 7) * 8;
        float lg[8];
#pragma unroll
        for (int j = 0; j < 8; ++j) lg[j] = p.in[I_LNG][g * 64 + ch0 + j];
#pragma unroll 8
        for (int it = 0; it < 16; ++it) {
            const int q = it * 8 + (lane >> 3);
            const h16x8 x = *(const h16x8*)(GUV + (t0 + q) * 1024 + 512 + g * 64 + ch0);
            const float mean = stat[q * 2], rstd = stat[q * 2 + 1];
#pragma unroll
            for (int j = 0; j < 8; ++j) vt[(ch0 + j) * 136 + q] = (h16)(((float)x[j] - mean) * rstd * lg[j]);
        }
    }
    asm volatile("s_waitcnt lgkmcnt(0)" ::: "memory");
    __syncthreads();
    h16x8 af[4][4];
#pragma unroll
    for (int dt = 0; dt < 4; ++dt)
#pragma unroll
        for (int ks = 0; ks < 4; ++ks) af[dt][ks] = *(const LAS h16x8*)(vt + (dt * 16 + l15) * 136 + ks * 32 + quad * 8);
    const h16* wg = WS16 + (size_t)g * 128 * 128;
#pragma unroll 2
    for (int pt = 0; pt < 8; ++pt) {
        f32x4 acc[4];
#pragma unroll
        for (int dt = 0; dt < 4; ++dt) acc[dt] = (f32x4){0.f, 0.f, 0.f, 0.f};
#pragma unroll
        for (int ks = 0; ks < 4; ++ks) {
            const h16x8 bf = *(const h16x8*)(wg + (size_t)(pt * 16 + l15) * 128 + ks * 32 + quad * 8);
#pragma unroll
            for (int dt = 0; dt < 4; ++dt) acc[dt] = __builtin_amdgcn_mfma_f32_16x16x32_f16(af[dt][ks], bf, acc[dt], 0, 0, 0);
        }
        const int pp = pt * 16 + l15;
        const float bsv = p.in[I_GMBS][g * 128 + pp];
        const size_t tok = t0 + pp;
#pragma unroll
        for (int dt = 0; dt < 4; ++dt) {
            const int ch = g * 64 + dt * 16 + quad * 4;
            const h16x4 uu = *(const h16x4*)(GUV + tok * 1024 + ch);
            h16x4 o;
#pragma unroll
            for (int j = 0; j < 4; ++j) o[j] = (h16)((float)uu[j] * (acc[dt][j] + bsv));
            *(h16x4*)(YB + tok * 1024 + ch) = o;
        }
    }
    __syncthreads();
}

__device__ __forceinline__ float row16_sum_to_lane15(float v) {
    v += __builtin_bit_cast(float, __builtin_amdgcn_update_dpp(0, __builtin_bit_cast(int, v), 0x118, 0xf, 0xf, true));
    v += __builtin_bit_cast(float, __builtin_amdgcn_update_dpp(0, __builtin_bit_cast(int, v), 0x114, 0xf, 0xf, true));
    v += __builtin_bit_cast(float, __builtin_amdgcn_update_dpp(0, __builtin_bit_cast(int, v), 0x112, 0xf, 0xf, true));
    v += __builtin_bit_cast(float, __builtin_amdgcn_update_dpp(0, __builtin_bit_cast(int, v), 0x111, 0xf, 0xf, true));
    return v;
}
#define DPPF(v, ctrl) __builtin_bit_cast(float, __builtin_amdgcn_update_dpp(__builtin_bit_cast(int, v), __builtin_bit_cast(int, v), ctrl, 0xf, 0xf, false))
__device__ __forceinline__ float row16_allsum(float v) { v += DPPF(v, 0x128); v += DPPF(v, 0x124); v += DPPF(v, 0x122); v += DPPF(v, 0x121); return v; }
__device__ __forceinline__ float row16_allmax(float v) { v = fmaxf(v, DPPF(v, 0x128)); v = fmaxf(v, DPPF(v, 0x124)); v = fmaxf(v, DPPF(v, 0x122)); v = fmaxf(v, DPPF(v, 0x121)); return v; }
__device__ __forceinline__ int wave_incl_scan(int v) {
    v += __builtin_amdgcn_update_dpp(0, v, 0x111, 0xf, 0xf, false);
    v += __builtin_amdgcn_update_dpp(0, v, 0x112, 0xf, 0xf, false);
    v += __builtin_amdgcn_update_dpp(0, v, 0x114, 0xf, 0xf, false);
    v += __builtin_amdgcn_update_dpp(0, v, 0x118, 0xf, 0xf, false);
    v += __builtin_amdgcn_update_dpp(0, v, 0x142, 0xa, 0xf, false);
    v += __builtin_amdgcn_update_dpp(0, v, 0x143, 0xc, 0xf, false);
    return v;
}
__device__ __forceinline__ unsigned wave_or(unsigned x) {
    int v = (int)x;
    v |= __builtin_amdgcn_update_dpp(0, v, 0x111, 0xf, 0xf, false);
    v |= __builtin_amdgcn_update_dpp(0, v, 0x112, 0xf, 0xf, false);
    v |= __builtin_amdgcn_update_dpp(0, v, 0x114, 0xf, 0xf, false);
    v |= __builtin_amdgcn_update_dpp(0, v, 0x118, 0xf, 0xf, false);
    v |= __builtin_amdgcn_update_dpp(0, v, 0x142, 0xa, 0xf, false);
    v |= __builtin_amdgcn_update_dpp(0, v, 0x143, 0xc, 0xf, false);
    return (unsigned)__builtin_amdgcn_readlane(v, 63);
}
__device__ __forceinline__ unsigned wave_and(unsigned x) {
    int v = (int)x;
    v &= __builtin_amdgcn_update_dpp(-1, v, 0x111, 0xf, 0xf, false);
    v &= __builtin_amdgcn_update_dpp(-1, v, 0x112, 0xf, 0xf, false);
    v &= __builtin_amdgcn_update_dpp(-1, v, 0x114, 0xf, 0xf, false);
    v &= __builtin_amdgcn_update_dpp(-1, v, 0x118, 0xf, 0xf, false);
    v &= __builtin_amdgcn_update_dpp(-1, v, 0x142, 0xa, 0xf, false);
    v &= __builtin_amdgcn_update_dpp(-1, v, 0x143, 0xc, 0xf, false);
    return (unsigned)__builtin_amdgcn_readlane(v, 63);
}
__device__ __forceinline__ unsigned key16(unsigned short u) { return (u & 0x8000u) ? ((~(unsigned)u) & 0xFFFFu) : ((unsigned)u | 0x8000u); }
__device__ __forceinline__ unsigned key32(unsigned u) { return (u & 0x80000000u) ? ~u : (u | 0x80000000u); }
__device__ __forceinline__ float dot8(h16x8 a, h16x8 b, float c) {
    c = __builtin_amdgcn_fdot2((h16x2){a[0], a[1]}, (h16x2){b[0], b[1]}, c, false);
    c = __builtin_amdgcn_fdot2((h16x2){a[2], a[3]}, (h16x2){b[2], b[3]}, c, false);
    c = __builtin_amdgcn_fdot2((h16x2){a[4], a[5]}, (h16x2){b[4], b[5]}, c, false);
    c = __builtin_amdgcn_fdot2((h16x2){a[6], a[7]}, (h16x2){b[6], b[7]}, c, false);
    return c;
}
#define LDS_FENCE() asm volatile("s_waitcnt lgkmcnt(0)" ::: "memory")

__device__ void peer_phase(const Params& p, LAS unsigned char* lds, unsigned* bar, unsigned& epoch) {
    unsigned char* ws = p.ws;
    const int tid = fresh_tid(), wid = __builtin_amdgcn_readfirstlane(tid >> 6), lane = tid & 63;
    const unsigned long long lm = (1ull << lane) - 1ull;
    LAS unsigned char* wl = lds + wid * 11264;
    LAS float* s_top = (LAS float*)(wl);
    LAS int* i_top = (LAS int*)(wl + 1024);
    LAS int* ex = (LAS int*)(wl + 2048);
    LAS float* sc = (LAS float*)(wl + 2560);
    LAS int* uns_m = (LAS int*)(wl + 3072);
    LAS float* uns_g = (LAS float*)(wl + 3584);
    LAS int* cnt = (LAS int*)(wl + 4096);
    LAS int* base = (LAS int*)(wl + 4352);
    const int lead = (wid >= 4) ? 1 : 0;
    const unsigned short* SC = (const unsigned short*)(ws + OFF_SC16);
    const h16* H2 = (const h16*)(ws + OFF_R1);
    const unsigned char* U4 = ws + OFF_U8;
    const unsigned char* V8 = ws + OFF_V8;
    const float* USC = (const float*)(ws + OFF_USC);
    const float* VSC = (const float*)(ws + OFF_VSC);
    const float* mod = (const float*)(ws + OFF_MOD);
    const int grp = lane >> 4, li = lane & 15;
    for (int tg = blockIdx.x; tg < 256; tg += gridDim.x) {
        for (int it5 = 0; it5 < 5; ++it5) {
          if (it5 < 4) {
            const int round = it5;
            const size_t tok0 = (size_t)tg * 128 + wid * 16 + round * 4;
            LAS unsigned short* se = (LAS unsigned short*)(wl + 4608 + (round & 1) * 3072);
            LAS float* sw = (LAS float*)(wl + 4608 + (round & 1) * 3072 + 1024);
            for (int tt = 0; tt < 4; ++tt) {
                const size_t tok = tok0 + tt;
                cnt[lane] = 0;
                for (int L0 = 0; L0 < 16; L0 += 4) {
                    unsigned short ra[4], rb[4]; unsigned ka[4], kb[4], T[4];
#pragma unroll
                    for (int q = 0; q < 4; ++q) {
                        const unsigned short* sr = SC + tok * 2048 + (L0 + q) * 128;
                        ra[q] = sr[lane]; rb[q] = sr[64 + lane];
                        ka[q] = key16(ra[q]); kb[q] = key16(rb[q]); T[q] = 0;
                    }
                    for (int bit = 15; bit >= 0; --bit) {
#pragma unroll
                        for (int q = 0; q < 4; ++q) {
                            const unsigned cand = T[q] | (1u << bit);
                            const int cn = __popcll(__ballot(ka[q] >= cand)) + __popcll(__ballot(kb[q] >= cand));
                            T[q] = (cn >= 16) ? cand : T[q];
                        }
                    }
#pragma unroll
                    for (int q = 0; q < 4; ++q) {
                        const int L = L0 + q;
                        const int cnt_gt = __popcll(__ballot(ka[q] > T[q])) + __popcll(__ballot(kb[q] > T[q]));
                        const int need = 16 - cnt_gt;
                        const unsigned long long ea = __ballot(ka[q] == T[q]), eb = __ballot(kb[q] == T[q]);
                        const int ra_eq = __popcll(ea & lm), rb_eq = __popcll(ea) + __popcll(eb & lm);
                        const bool sa = (ka[q] > T[q]) || (ka[q] == T[q] && ra_eq < need);
                        const bool sb = (kb[q] > T[q]) || (kb[q] == T[q] && rb_eq < need);
                        const unsigned long long ma = __ballot(sa), mb = __ballot(sb);
                        const int pa = __popcll(ma & lm), pb = __popcll(ma) + __popcll(mb & lm);
                        if (sa) { s_top[L * 16 + pa] = (float)__builtin_bit_cast(h16, ra[q]); i_top[L * 16 + pa] = lane; }
                        if (sb) { s_top[L * 16 + pb] = (float)__builtin_bit_cast(h16, rb[q]); i_top[L * 16 + pb] = 64 + lane; }
                    }
                }
                LDS_FENCE();
                for (int h0 = 0; h0 < 8; h0 += 4) {
                    float cv[4][4]; unsigned kk[4][4], T[4];
#pragma unroll
                    for (int q = 0; q < 4; ++q) {
                        const int h = h0 + q;
                        const float bj = s_top[(2 * h + 1) * 16 + li];
#pragma unroll
                        for (int m = 0; m < 4; ++m) { cv[q][m] = s_top[(2 * h) * 16 + grp + 4 * m] + bj; kk[q][m] = key32(__builtin_bit_cast(unsigned, cv[q][m])); }
                        T[q] = 0;
                    }
                    unsigned om = 0, am = 0xFFFFFFFFu;
#pragma unroll
                    for (int q = 0; q < 4; ++q)
#pragma unroll
                        for (int m = 0; m < 4; ++m) { om |= kk[q][m]; am &= kk[q][m]; }
                    om = wave_or(om); am = wave_and(am);
                    om &= ~am;
                    while (om) {
                        const int bit = 31 - __builtin_clz(om);
                        om &= ~(1u << bit);
#pragma unroll
                        for (int q = 0; q < 4; ++q) {
                            const unsigned cand = T[q] | (1u << bit);
                            int cn = 0;
#pragma unroll
                            for (int m = 0; m < 4; ++m) cn += __popcll(__ballot((kk[q][m] & ~am) >= cand));
                            T[q] = (cn >= 16) ? cand : T[q];
                        }
                    }
#pragma unroll
                    for (int q = 0; q < 4; ++q) T[q] |= am;
#pragma unroll
                    for (int q = 0; q < 4; ++q) {
                        const int h = h0 + q;
                        int cnt_gt = 0;
#pragma unroll
                        for (int m = 0; m < 4; ++m) cnt_gt += __popcll(__ballot(kk[q][m] > T[q]));
                        const int need = 16 - cnt_gt;
                        int eq_before = 0, sel_before = 0;
#pragma unroll
                        for (int m = 0; m < 4; ++m) {
                            const unsigned long long em = __ballot(kk[q][m] == T[q]);
                            const int myeq = eq_before + __popcll(em & lm);
                            const bool sel = (kk[q][m] > T[q]) || (kk[q][m] == T[q] && myeq < need);
                            const unsigned long long sm = __ballot(sel);
                            const int pos = sel_before + __popcll(sm & lm);
                            if (sel) {
                                ex[h * 16 + pos] = i_top[(2 * h) * 16 + grp + 4 * m] * 128 + i_top[(2 * h + 1) * 16 + li];
                                sc[h * 16 + pos] = cv[q][m];
                            }
                            eq_before += __popcll(em); sel_before += __popcll(sm);
                        }
                    }
                }
                LDS_FENCE();
#pragma unroll
                for (int half = 0; half < 2; ++half) {
                    const int e = half * 64 + lane;
                    const float v = sc[e];
                    const float mx = row16_allmax(v);
                    const float pe = __expf(v - mx);
                    const float sm = row16_allsum(pe);
                    const float gate = pe * __builtin_amdgcn_rcpf(sm);
                    const int eid = ex[e];
                    const int pos = __hip_atomic_fetch_add(cnt + (eid >> 8), 1, __ATOMIC_RELAXED, __HIP_MEMORY_SCOPE_WORKGROUP);
                    uns_m[e] = eid | (pos << 14); uns_g[e] = gate;
                }
                LDS_FENCE();
                {
                    const int c = cnt[lane];
                    const int incl = wave_incl_scan(c);
                    base[lane] = incl - c;
                    LDS_FENCE();
#pragma unroll
                    for (int i = 0; i < 2; ++i) {
                        const int rm = uns_m[i * 64 + lane]; const float rg = uns_g[i * 64 + lane];
                        const int eid = rm & 16383, pos = rm >> 14;
                        const int dst = tt * 128 + base[eid >> 8] + pos;
                        se[dst] = (unsigned short)eid; sw[dst] = rg;
                    }
                    LDS_FENCE();
                }
            }
          }
          const int round = it5 - lead;
          if (round >= 0 && round < 4) {
            const size_t tok0 = (size_t)tg * 128 + wid * 16 + round * 4;
            LAS unsigned short* se = (LAS unsigned short*)(wl + 4608 + (round & 1) * 3072);
            LAS float* sw = (LAS float*)(wl + 4608 + (round & 1) * 3072 + 1024);
            const size_t tokg = tok0 + grp;
            const LAS unsigned short* me = se + grp * 128; LAS float* mw = sw + grp * 128;
            {
                const int li = launder(tid) & 15;
                h16x8 xr[2][4];
#pragma unroll
                for (int c = 0; c < 2; ++c)
#pragma unroll
                    for (int j = 0; j < 4; ++j) xr[c][j] = *(const h16x8*)(H2 + tokg * 1024 + c * 512 + li * 32 + 8 * j);
                float acc[64];
#pragma unroll
                for (int i = 0; i < 64; ++i) acc[i] = 0.f;
                i32x4 ru[2][2], rv[2][4]; float su[2], sv[2];
#define ELD(J, S_) do { const int e_ = me[(S_)]; const unsigned char* rp_ = U4 + (size_t)e_ * 1536 + li * 16; \
        ru[J][0] = *(const i32x4*)rp_; ru[J][1] = *(const i32x4*)(rp_ + 256); \
        _Pragma("unroll") for (int c = 0; c < 4; ++c) rv[J][c] = *(const i32x4*)(rp_ + 512 + c * 256); \
        { const f32x2 s2_ = *(const f32x2*)(USC + 2 * e_); su[J] = s2_.x; sv[J] = s2_.y; } } while (0)
#define ECP(J, S_) do { float d = 0.f; \
        _Pragma("unroll") for (int c = 0; c < 2; ++c) _Pragma("unroll") for (int k = 0; k < 4; ++k) { const h16x8 xv = xr[c][k]; const int w_ = ru[J][c][k]; \
            d = __builtin_amdgcn_fdot2(__builtin_amdgcn_cvt_scalef32_pk_f16_fp4(w_, 1.0f, 0), (h16x2){xv[0], xv[1]}, d, false); \
            d = __builtin_amdgcn_fdot2(__builtin_amdgcn_cvt_scalef32_pk_f16_fp4(w_, 1.0f, 1), (h16x2){xv[2], xv[3]}, d, false); \
            d = __builtin_amdgcn_fdot2(__builtin_amdgcn_cvt_scalef32_pk_f16_fp4(w_, 1.0f, 2), (h16x2){xv[4], xv[5]}, d, false); \
            d = __builtin_amdgcn_fdot2(__builtin_amdgcn_cvt_scalef32_pk_f16_fp4(w_, 1.0f, 3), (h16x2){xv[6], xv[7]}, d, false); } \
        d = row16_allsum(d); \
        const float wt_ = mw[(S_)] * gelu_tanh(d * su[J]) * sv[J]; \
        _Pragma("unroll") for (int c = 0; c < 4; ++c) _Pragma("unroll") for (int k = 0; k < 4; ++k) { \
            const f32x2 lo = __builtin_amdgcn_cvt_pk_f32_fp8(rv[J][c][k], false), hi = __builtin_amdgcn_cvt_pk_f32_fp8(rv[J][c][k], true); \
            acc[c * 16 + 4 * k] += wt_ * lo.x; acc[c * 16 + 4 * k + 1] += wt_ * lo.y; acc[c * 16 + 4 * k + 2] += wt_ * hi.x; acc[c * 16 + 4 * k + 3] += wt_ * hi.y; } } while (0)
                ELD(0, 0); ELD(1, 1);
#pragma unroll 1
                for (int s = 0; s < 128; s += 2) {
                    ECP(0, s);     if (s + 2 < 128) ELD(0, s + 2);
                    ECP(1, s + 1); if (s + 3 < 128) ELD(1, s + 3);
                }
#undef ELD
#undef ECP
                float* xo = p.out + tokg * 1024 + li * 16;
                const int b = (int)(tokg >> 11);
                const float* g2 = mod + (size_t)b * 6144 + 5 * 1024 + li * 16;
                const float* fg = p.in[I_FG] + li * 16;
                float ss = 0.f;
#pragma unroll
                for (int c = 0; c < 4; ++c) {
#pragma unroll
                    for (int q4 = 0; q4 < 4; ++q4) {
                        const f32x4 xv = *(const f32x4*)(xo + c * 256 + q4 * 4), gv = *(const f32x4*)(g2 + c * 256 + q4 * 4);
#pragma unroll
                        for (int j = 0; j < 4; ++j) { const float t = xv[j] + gv[j] * acc[c * 16 + q4 * 4 + j]; acc[c * 16 + q4 * 4 + j] = t; ss += t * t; }
                    }
                    asm volatile("" : "+v"(ss) :: "memory");
                }
                ss = row16_allsum(ss);
                const float r = rsqrtf(ss * (1.0f / 1024.0f) + 1e-6f);
#pragma unroll
                for (int c = 0; c < 4; ++c) {
#pragma unroll
                    for (int q4 = 0; q4 < 4; ++q4) {
                        const f32x4 fv = *(const f32x4*)(fg + c * 256 + q4 * 4);
                        f32x4 ov;
#pragma unroll
                        for (int j = 0; j < 4; ++j) ov[j] = acc[c * 16 + q4 * 4 + j] * r * fv[j];
                        *(f32x4*)(xo + c * 256 + q4 * 4) = ov;
                    }
                    asm volatile("" ::: "memory");
                }
            }
            LDS_FENCE();
          }
        }
    }
}

__global__ void __launch_bounds__(512, 2) mega(Params p) {
    extern __shared__ __attribute__((aligned(16))) unsigned char shm[];
    LAS unsigned char* lds = (LAS unsigned char*)shm;
    cg::grid_group grid = cg::this_grid();
    unsigned char* ws = p.ws;
    const int G = (int)gridDim.x, c = (int)blockIdx.x;
    unsigned* bar = (unsigned*)(ws + OFF_BAR); unsigned epoch = 0;

    if (p.ws == nullptr) grid.sync();
    phase0(p, (float*)shm);
    grid_bar(bar, epoch, (unsigned)G);
    phase1(p, (float*)shm);
    grid_bar(bar, epoch, (unsigned)G);
    {
        pg8::StaticOrder S; S.init(NTOK, INC, G, c);
        pg8::Gemm g{ws + OFF_R1, ws + OFF_WINT, 1024, 1024, NTOK, INC, 1024, 0};
        EpiIn E{(h16*)(ws + OFF_QB), (h16*)(ws + OFF_KB), (h16*)(ws + OFF_VT), (h16*)(ws + OFF_GUV), (h16*)(ws + OFF_GATES)};
        pg8::gemm_phase(lds, g, S, E);
        pg8::StaticOrder S2; S2.init(NCTXT, 1024, G, c);
        pg8::Gemm g2{ws + OFF_HC, ws + OFF_WINT + (size_t)512 * 1024 * 2, 1024, 1024, NCTXT, 1024, 1024, 0};
        EpiCtx E2{(h16*)(ws + OFF_KC), (h16*)(ws + OFF_VCT)};
        pg8::gemm_phase(lds, g2, S2, E2);
    }
    grid_bar(bar, epoch, (unsigned)G);
    {
        for (int rep3 = 0; rep3 < REP_P3; ++rep3) {
        for (int u = c; u < 512; u += G) attn_unit(p, u);
        for (int n = c; n < 256; n += G) sgu_unit(p, n, lds);
        }
    }
    grid_bar(bar, epoch, (unsigned)G);
    {
        pg8::StaticOrder S; S.init(NTOK, 1024, G, c);
        pg8::Gemm ga{ws + OFF_R1, ws + OFF_WPAT, 1024, 512, NTOK, 1024, 512, 0};
        EpiM1 E1{(h16*)(ws + OFF_M1), (const h16*)(ws + OFF_GATES)};
        pg8::gemm_phase(lds, ga, S, E1);
        pg8::Gemm gb{ws + OFF_R1 + 1024, ws + OFF_WPBT, 1024, 512, NTOK, 1024, 512, 0};
        EpiM2 E2{(const h16*)(ws + OFF_M1), (const h16*)(ws + OFF_GATES), (h16*)(ws + OFF_MM)};
        pg8::gemm_phase(lds, gb, S, E2);
    }
    grid_bar(bar, epoch, (unsigned)G);
    {
        pg8::StaticOrder S; S.init(NTOK, 1024, G, c);
        pg8::Gemm g{ws + OFF_MM, ws + OFF_WOUTT, 1024, 1024, NTOK, 1024, 1024, 0};
        EpiX1 E{p.in[I_X], (const float*)(ws + OFF_MOD), p.out};
        pg8::gemm_phase(lds, g, S, E);
    }
    grid_bar(bar, epoch, (unsigned)G);
    phase6(p, (float*)shm);
    grid_bar(bar, epoch, (unsigned)G);
    {
        pg8::StaticOrder S; S.init(NTOK, 2048, G, c);
        pg8::Gemm g{ws + OFF_R1, ws + OFF_WQT, 1024, 1024, NTOK, 2048, 1024, 0};
        EpiH16 E{(h16*)(ws + OFF_SC16), 2048};
        pg8::gemm_phase(lds, g, S, E);
    }
    grid_bar(bar, epoch, (unsigned)G);
    peer_phase(p, lds, bar, epoch);
}

extern "C" void kernel_launch(void* const* d_in, const int* in_sizes, int n_in, void* d_out, int out_size, void* d_ws, size_t ws_size, hipStream_t stream) {
    static int grid_blocks = 0;
    if (!grid_blocks) {
        int dev = 0, cus = 0, per_cu = 0;
        hipGetDevice(&dev);
        hipDeviceGetAttribute(&cus, hipDeviceAttributeMultiprocessorCount, dev);
        hipFuncSetAttribute((const void*)mega, hipFuncAttributeMaxDynamicSharedMemorySize, LDS_BYTES);
        hipOccupancyMaxActiveBlocksPerMultiprocessor(&per_cu, (const void*)mega, 512, LDS_BYTES);
        if (per_cu < 1) per_cu = 1;
        grid_blocks = cus * per_cu;
        if (ws_size < WS_END) fprintf(stderr, "kernel_launch: workspace too small: %zu < %zu\n", ws_size, (size_t)WS_END);
    }
    hipMemsetAsync((unsigned char*)d_ws + OFF_BAR, 0, 256, stream);
    Params p{};
    for (int i = 0; i < 21; ++i) p.in[i] = (const float*)d_in[i];
    p.out = (float*)d_out; p.ws = (unsigned char*)d_ws;
    void* args[] = {&p};
    hipError_t e = hipLaunchCooperativeKernel((const void*)mega, dim3(grid_blocks), dim3(512), args, LDS_BYTES, stream);
    if (e != hipSuccess) fprintf(stderr, "cooperative launch failed: %s (grid %d)\n", hipGetErrorString(e), grid_blocks);
}
```

```cpp
#include <hip/hip_runtime.h>
#include <hip/hip_cooperative_groups.h>
#include <cstdio>
namespace cg = cooperative_groups;

#define LAS __attribute__((address_space(3)))
typedef _Float16 h16;
typedef _Float16 h16x2 __attribute__((ext_vector_type(2)));
typedef _Float16 h16x4 __attribute__((ext_vector_type(4)));
typedef _Float16 h16x8 __attribute__((ext_vector_type(8)));
typedef float f32x4 __attribute__((ext_vector_type(4)));
typedef float f32x2 __attribute__((ext_vector_type(2)));
typedef int i32x4 __attribute__((ext_vector_type(4)));
typedef int i32x2 __attribute__((ext_vector_type(2)));

constexpr int NTOK = 32768, DM = 1024, NCTXT = 4096, INC = 4608, SEQ = 2048, CTXL = 256;
constexpr int LDS_BYTES = 144 * 1024;
#ifndef REP_SEL
#define REP_SEL 1
#endif
#ifndef REP_GATH
#define REP_GATH 1
#endif
#ifndef REP_P3
#define REP_P3 1
#endif

constexpr size_t al256(size_t x) { return (x + 255) & ~(size_t)255; }
constexpr size_t OFF_WINT = 0;
constexpr size_t OFF_WPAT = OFF_WINT + (size_t)INC * DM * 2;
constexpr size_t OFF_WPBT = OFF_WPAT + (size_t)1024 * 512 * 2;
constexpr size_t OFF_WOUTT = OFF_WPBT + (size_t)1024 * 512 * 2;
constexpr size_t OFF_WQT = OFF_WOUTT + (size_t)1024 * 1024 * 2;
constexpr size_t OFF_BD = OFF_WQT + (size_t)2048 * 1024 * 2;
constexpr size_t OFF_U16 = OFF_BD + (size_t)2048 * 256 * 2;
constexpr size_t OFF_V16 = OFF_U16 + (size_t)16384 * 1024 * 2;
constexpr size_t OFF_WS16 = OFF_V16 + (size_t)16384 * 1024 * 2;
constexpr size_t OFF_MODP = OFF_WS16 + (size_t)8 * 128 * 128 * 2;
constexpr size_t OFF_MOD = OFF_MODP + (size_t)16 * 17 * 6144 * 4;
constexpr size_t OFF_R1 = al256(OFF_MOD + (size_t)17 * 6144 * 4);
constexpr size_t OFF_QB = OFF_R1 + (size_t)NTOK * DM * 2;
constexpr size_t OFF_KB = OFF_QB + (size_t)NTOK * 512 * 2;
constexpr size_t OFF_VT = OFF_KB + (size_t)NTOK * 512 * 2;
constexpr size_t OFF_GUV = OFF_VT + (size_t)NTOK * 512 * 2;
constexpr size_t OFF_GATES = OFF_GUV + (size_t)NTOK * 1024 * 2;
constexpr size_t OFF_MM = OFF_GATES + (size_t)NTOK * 2048 * 2;
constexpr size_t OFF_BAR = OFF_MM + (size_t)NTOK * DM * 2;
constexpr size_t WS_END = OFF_BAR + 16384;
constexpr size_t OFF_U8 = OFF_U16;
constexpr size_t OFF_USC = OFF_V16;
constexpr size_t OFF_V8 = OFF_V16;
constexpr size_t OFF_VSC = OFF_V16 + (size_t)16384 * 1024;
constexpr size_t OFF_M1 = OFF_QB;
constexpr size_t OFF_SC16 = OFF_QB;
constexpr size_t OFF_Q16 = OFF_GATES;
constexpr size_t OFF_HC = OFF_MM;
constexpr size_t OFF_KC = OFF_HC + (size_t)NCTXT * DM * 2;
constexpr size_t OFF_VCT = OFF_KC + (size_t)NCTXT * 512 * 2;
static_assert(OFF_M1 + (size_t)NTOK * DM * 4 <= OFF_GATES, "m1 alias");
static_assert(WS_END <= (size_t)512 * 1024 * 1024, "workspace");

struct Params {
    const float* in[21];
    float* out;
    unsigned char* ws;
};
enum { I_X = 0, I_C, I_CTX, I_CCTX, I_ADAW, I_ADAB, I_N1G, I_N2G, I_WIN, I_RPB, I_LNG, I_GMWS, I_GMBS, I_WPA, I_WPB, I_WOUT, I_WQ, I_KEYS, I_PU, I_PV, I_FG };

__device__ __forceinline__ int launder(int x) { asm volatile("" : "+v"(x)); return x; }
__device__ __forceinline__ int fresh_tid() { int t = threadIdx.x; asm volatile("" : "+v"(t)); return t; }

__device__ __forceinline__ float sigmoidf_(float x) { return __builtin_amdgcn_rcpf(1.0f + __expf(-x)); }
__device__ __forceinline__ float gelu_tanh(float x) {
    const float t = 0.7978845608028654f * (x + 0.044715f * x * x * x);
    return x * __builtin_amdgcn_rcpf(1.0f + __expf(-2.0f * t));
}
__device__ __forceinline__ float silu_(float x) { return x * __builtin_amdgcn_rcpf(1.0f + __expf(-x)); }
__device__ __forceinline__ float wave_sum(float v) {
#pragma unroll
    for (int o = 32; o > 0; o >>= 1) v += __shfl_xor(v, o);
    return v;
}
__device__ __forceinline__ h16x8 pack8(f32x4 a, f32x4 b) {
    h16x8 o;
    o[0] = (h16)a[0]; o[1] = (h16)a[1]; o[2] = (h16)a[2]; o[3] = (h16)a[3];
    o[4] = (h16)b[0]; o[5] = (h16)b[1]; o[6] = (h16)b[2]; o[7] = (h16)b[3];
    return o;
}


__device__ __forceinline__ void grid_bar(unsigned* ctr, unsigned& epoch, unsigned nblk) {
    __syncthreads();
    epoch += 1u;
    if (threadIdx.x == 0) {
        __builtin_amdgcn_fence(__ATOMIC_RELEASE, "agent");
        asm volatile("s_waitcnt vmcnt(0)" ::: "memory");
        __hip_atomic_fetch_add(ctr, 1u, __ATOMIC_RELAXED, __HIP_MEMORY_SCOPE_AGENT);
        const unsigned target = epoch * nblk;
        unsigned spins = 0;
        while (__hip_atomic_load(ctr, __ATOMIC_RELAXED, __HIP_MEMORY_SCOPE_AGENT) < target) { __builtin_amdgcn_s_sleep(2); if (++spins > (1u << 24)) break; }
        __builtin_amdgcn_fence(__ATOMIC_ACQUIRE, "agent");
        asm volatile("s_waitcnt vmcnt(0)" ::: "memory");
    }
    __syncthreads();
}


#define XB_TMO      128
#define XB_XCNT(j)  (256  + 64 * (j))
#define XB_XSUB(j)  (1280 + 64 * (j))
#define XB_XGEN(j)  (2304 + 64 * (j))
#define XB_TOP      3328
#define XB_TOPGEN   3392
#define XCD_BAR_WORDS 3456
#define XB_SPIN_CAP (1u << 20)
__device__ __forceinline__ unsigned xb_ld(unsigned* p)              { return __hip_atomic_load(p, __ATOMIC_RELAXED, __HIP_MEMORY_SCOPE_AGENT); }
__device__ __forceinline__ unsigned xb_add(unsigned* p, unsigned v) { return __hip_atomic_fetch_add(p, v, __ATOMIC_RELAXED, __HIP_MEMORY_SCOPE_AGENT); }
__device__ __forceinline__ unsigned xb_xcc_id() { return (unsigned)__builtin_amdgcn_s_getreg((3 << 11) | 20) & 0xFu; }
#define XB_SPIN(cond, bar) do { unsigned _sp = 0; while (cond) { __builtin_amdgcn_s_sleep(1); \
    if ((++_sp & 255u) == 0u) { if (xb_ld(&(bar)[XB_TMO])) break; if (_sp > XB_SPIN_CAP) { atomicAdd(&(bar)[XB_TMO], 1u); break; } } } } while (0)
struct XcdBarrier { unsigned* bar; unsigned x; volatile LAS unsigned* st; };
__device__ __forceinline__ XcdBarrier xcd_barrier_post(unsigned* bar, volatile LAS unsigned* st) {
    XcdBarrier b; b.bar = bar; b.x = xb_xcc_id(); b.st = st;
    if (threadIdx.x == 0) (void)xb_add(&bar[XB_XCNT(b.x)], 1u);
    return b;
}
__device__ __forceinline__ void xcd_barrier_complete(unsigned* bar, unsigned x, unsigned& nloc, unsigned& nx) {
    const unsigned G = gridDim.x * gridDim.y * gridDim.z;
    unsigned sum, cnt, mine, sp = 0u;
    for (;;) {
        sum = 0u; cnt = 0u; mine = 0u;
#pragma unroll
        for (unsigned j = 0; j < 16; ++j) { const unsigned c = xb_ld(&bar[XB_XCNT(j)]); sum += c; cnt += (c > 0u) ? 1u : 0u; mine = (j == x) ? c : mine; }
        if (sum == G) break;
        __builtin_amdgcn_s_sleep(1);
        if ((++sp & 255u) == 0u) { if (xb_ld(&bar[XB_TMO])) break; if (sp > XB_SPIN_CAP) { atomicAdd(&bar[XB_TMO], 1u); break; } }
    }
    nloc = mine > 0u ? mine : 1u; nx = cnt > 0u ? cnt : 1u;
}
__device__ __forceinline__ void xcd_barrier(const XcdBarrier& b) {
    asm volatile("s_waitcnt vmcnt(0)" ::: "memory");
    __syncthreads();
    if (threadIdx.x == 0) {
        unsigned* bar = b.bar;
        __builtin_amdgcn_s_waitcnt(0);
        unsigned nloc = b.st[0], nx = b.st[1];
        if (nloc == 0u) { xcd_barrier_complete(bar, b.x, nloc, nx); b.st[0] = nloc; b.st[1] = nx; }
        const unsigned old = xb_add(&bar[XB_XSUB(b.x)], 1u);
        const unsigned gen = old / nloc;
        if (old + 1u == (gen + 1u) * nloc) {
            __builtin_amdgcn_fence(__ATOMIC_RELEASE, "agent");
            asm volatile("s_waitcnt vmcnt(0)" ::: "memory");
            const unsigned og = xb_add(&bar[XB_TOP], 1u);
            const unsigned tg = og / nx;
            if (og + 1u == (tg + 1u) * nx) xb_add(&bar[XB_TOPGEN], 1u);
            else XB_SPIN(xb_ld(&bar[XB_TOPGEN]) == tg, bar);
            __builtin_amdgcn_fence(__ATOMIC_ACQUIRE, "agent");
            xb_add(&bar[XB_XGEN(b.x)], 1u);
            asm volatile("s_waitcnt vmcnt(0)" ::: "memory");
        } else {
            XB_SPIN(xb_ld(&bar[XB_XGEN(b.x)]) == gen, bar);
            __builtin_amdgcn_fence(__ATOMIC_ACQUIRE, "agent");
            asm volatile("s_waitcnt vmcnt(0)" ::: "memory");
        }
    }
    __syncthreads();
}

namespace pg8 {
constexpr int BM = 256, BK = 64, HALF = 128, HTB = HALF * BK * 2, STAGE_BYTES = 8 * HTB, NXCD = 8, WGM = 8;
__device__ __forceinline__ int lds_byte(int r, int c) { const int st = (r >> 4) * 2 + (c >> 5), rr = r & 15, cc = c & 31, ob = rr * 64 + cc * 2; return st * 1024 + (ob ^ (((ob >> 9) & 1) << 5)); }
__device__ __forceinline__ void stage_rc(int b, int& R, int& C) { const int st = b / 1024, sb = b % 1024, swz = sb ^ (((sb >> 9) & 1) << 5); R = (st >> 1) * 16 + swz / 64; C = (st & 1) * 32 + (swz % 64) / 2; }
__device__ __forceinline__ int perm32(int rho) { const int n = rho >> 4, i = rho & 15; return 8 * (i >> 2) + 4 * n + (i & 3); }

struct Unit { int pm, pn; };
struct Gemm { const void* A; const void* Bt; int lda, ldb, M, N, K, a_pn_bytes; };

struct StaticOrder {
    int nM, nN, nwg, G, c;
    __device__ void init(int M, int N, int G_, int c_) { nM = M / BM; nN = N / BM; nwg = nM * nN; G = G_; c = c_; }
    __device__ bool next(int i, Unit& u) const {
        const long L = (long)i * G + c; if (L >= nwg) return false;
        int wgid = (int)L; { const int q = nwg / NXCD, r = nwg % NXCD, xcd = wgid % NXCD, off = wgid / NXCD; wgid = (xcd < r ? xcd * (q + 1) : r * (q + 1) + (xcd - r) * q) + off; }
        const int nig = WGM * nN, gid = wgid / nig, fm = gid * WGM, gsz = (nM - fm) < WGM ? (nM - fm) : WGM;
        u.pm = fm + ((wgid % nig) % gsz); u.pn = (wgid % nig) / gsz; return true;
    }
};

template <class Epi>
__device__ __forceinline__ void gemm_phase(LAS unsigned char* lds, const Gemm g, const StaticOrder& S, const Epi& E) {
    const int tid = fresh_tid(), wid = __builtin_amdgcn_readfirstlane(tid >> 6), lane = tid & 63, wr = wid >> 2, wc = wid & 3, fr = lane & 15, fq = lane >> 4;
    const int K = g.K, nt = K / BK;
    unsigned voffA[2], voffB[2];
#pragma unroll
    for (int i = 0; i < 2; ++i) { int R, C; stage_rc(tid * 16 + i * 8192, R, C); const int Rb = (R & ~31) + perm32(R & 31);
        voffA[i] = (unsigned)(R * g.lda + C) * 2u; voffB[i] = (unsigned)(Rb * g.ldb + C) * 2u; }
    const size_t kstep = (size_t)(BK * 2);
    const size_t hstepA = (size_t)HALF * g.lda * 2, hstepB = (size_t)HALF * g.ldb * 2;
    const size_t tstepA = 2 * hstepA, tstepB = 2 * hstepB;
    const unsigned ldsw = (unsigned)wid * 1024u;
    const int aoff = lds_byte(wr * 64 + fr, fq * 8), boff = lds_byte(wc * 32 + fr, fq * 8);
#define PG8_SA(b, h) (((b) * 2 + (h)) * HTB)
#define PG8_SB(b, h) ((4 + (b) * 2 + (h)) * HTB)
#define PG8_STAGE(bufoff, gbase, voff) do { _Pragma("unroll") for (int _i = 0; _i < 2; ++_i) \
        __builtin_amdgcn_global_load_lds((const unsigned*)((const char*)(gbase) + (voff)[_i]), (LAS unsigned*)(lds + (bufoff) + ldsw + _i * 8192), 16, 0, 0); } while (0)
#define PG8_LDA(dst, b, h) do { _Pragma("unroll") for (int m = 0; m < 4; ++m) _Pragma("unroll") for (int k = 0; k < 2; ++k) dst[m][k] = *(const LAS h16x8*)(lds + PG8_SA(b, h) + aoff + m * 2048 + k * 1024); } while (0)
#define PG8_LDB(dst, b, h) do { _Pragma("unroll") for (int n = 0; n < 2; ++n) _Pragma("unroll") for (int k = 0; k < 2; ++k) dst[n][k] = *(const LAS h16x8*)(lds + PG8_SB(b, h) + boff + n * 2048 + k * 1024); } while (0)
#define PG8_MMA(ai, bj, At, Bt) do { __builtin_amdgcn_s_setprio(1); _Pragma("unroll") for (int m = 0; m < 4; ++m) _Pragma("unroll") for (int n = 0; n < 2; ++n) _Pragma("unroll") for (int k = 0; k < 2; ++k) \
        acc[ai][bj][m][n] = __builtin_amdgcn_mfma_f32_16x16x32_f16(Bt[n][k], At[m][k], acc[ai][bj][m][n], 0, 0, 0); __builtin_amdgcn_s_setprio(0); } while (0)
#define PG8_WAIT_V(n) asm volatile("s_waitcnt vmcnt(" #n ")" ::: "memory")
#define PG8_WAIT_L(n) asm volatile("s_waitcnt lgkmcnt(" #n ")" ::: "memory")
#define PG8_BAR __builtin_amdgcn_s_barrier()
#define PG8_SCHED __builtin_amdgcn_sched_barrier(0)
    Unit cur, nxt; int ui = 0;
    if (!S.next(0, cur)) return;
    f32x4 acc[2][2][4][2];
#pragma unroll
    for (int a = 0; a < 2; ++a)
#pragma unroll
        for (int b = 0; b < 2; ++b)
#pragma unroll
            for (int m = 0; m < 4; ++m)
#pragma unroll
                for (int n = 0; n < 2; ++n) acc[a][b][m][n] = (f32x4){0.f, 0.f, 0.f, 0.f};
    h16x8 At[4][2], B0[2][2], B1[2][2];
    const char* cA = (const char*)g.A + (size_t)cur.pm * tstepA + (size_t)cur.pn * g.a_pn_bytes; const char* cB = (const char*)g.Bt + (size_t)cur.pn * tstepB;
    PG8_STAGE(PG8_SB(0, 0), cB, voffB); PG8_STAGE(PG8_SA(0, 0), cA, voffA); PG8_STAGE(PG8_SB(0, 1), cB + hstepB, voffB); PG8_STAGE(PG8_SA(0, 1), cA + hstepA, voffA);
    if (wr == 1) PG8_BAR;
    PG8_WAIT_V(4); PG8_BAR;
    PG8_STAGE(PG8_SB(1, 0), cB + kstep, voffB); PG8_STAGE(PG8_SA(1, 0), cA + kstep, voffA); PG8_STAGE(PG8_SB(1, 1), cB + hstepB + kstep, voffB);
    PG8_WAIT_V(6); PG8_BAR;
    for (;;) {
        const bool has_next = S.next(ui + 1, nxt);
        const char* nA = has_next ? (const char*)g.A + (size_t)nxt.pm * tstepA + (size_t)nxt.pn * g.a_pn_bytes : cA; const char* nB = has_next ? (const char*)g.Bt + (size_t)nxt.pn * tstepB : cB;
        for (int t = 0; t < nt; t += 2) {
            const bool last = (t == nt - 2);
            const char* a1 = cA + (size_t)(t + 1) * kstep;
            const char* a2 = last ? nA : cA + (size_t)(t + 2) * kstep; const char* b2 = last ? nB : cB + (size_t)(t + 2) * kstep;
            const char* a3 = a2 + kstep; const char* b3 = b2 + kstep;
            PG8_LDB(B0, 0, 0); PG8_SCHED; PG8_LDA(At, 0, 0); PG8_STAGE(PG8_SA(1, 1), a1 + hstepA, voffA);
            PG8_WAIT_L(8); PG8_BAR; PG8_WAIT_L(0); PG8_MMA(0, 0, At, B0); PG8_BAR; PG8_SCHED;
            PG8_LDB(B1, 0, 1); PG8_STAGE(PG8_SB(0, 0), b2, voffB);
            PG8_BAR; PG8_WAIT_L(0); PG8_MMA(0, 1, At, B1); PG8_BAR;
            PG8_LDA(At, 0, 1); PG8_STAGE(PG8_SA(0, 0), a2, voffA);
            PG8_BAR; PG8_WAIT_L(0); PG8_MMA(1, 0, At, B0); PG8_BAR; PG8_SCHED;
            PG8_STAGE(PG8_SB(0, 1), b2 + hstepB, voffB);
            PG8_WAIT_V(6); PG8_BAR; PG8_MMA(1, 1, At, B1); PG8_BAR;
            PG8_LDB(B0, 1, 0); PG8_SCHED; PG8_LDA(At, 1, 0); PG8_STAGE(PG8_SA(0, 1), a2 + hstepA, voffA);
            PG8_WAIT_L(8); PG8_BAR; PG8_WAIT_L(0); PG8_MMA(0, 0, At, B0); PG8_BAR; PG8_SCHED;
            PG8_LDB(B1, 1, 1); PG8_STAGE(PG8_SB(1, 0), b3, voffB);
            PG8_BAR; PG8_WAIT_L(0); PG8_MMA(0, 1, At, B1); PG8_BAR;
            PG8_LDA(At, 1, 1); PG8_STAGE(PG8_SA(1, 0), a3, voffA);
            PG8_BAR; PG8_WAIT_L(0); PG8_MMA(1, 0, At, B0); PG8_BAR; PG8_SCHED;
            PG8_STAGE(PG8_SB(1, 1), b3 + hstepB, voffB);
            PG8_WAIT_V(6); PG8_BAR; PG8_MMA(1, 1, At, B1); PG8_BAR;
        }
        E(acc, cur, wr, wc, fr, fq);
        if (!has_next) break;
#pragma unroll
        for (int a = 0; a < 2; ++a)
#pragma unroll
            for (int b = 0; b < 2; ++b)
#pragma unroll
                for (int m = 0; m < 4; ++m)
#pragma unroll
                    for (int n = 0; n < 2; ++n) acc[a][b][m][n] = (f32x4){0.f, 0.f, 0.f, 0.f};
        cur = nxt; cA = nA; cB = nB; ++ui;
    }
    PG8_WAIT_V(0);
    if (wr == 0) PG8_BAR;
    PG8_BAR;
#undef PG8_SA
#undef PG8_SB
#undef PG8_STAGE
#undef PG8_LDA
#undef PG8_LDB
#undef PG8_MMA
#undef PG8_WAIT_V
#undef PG8_WAIT_L
#undef PG8_BAR
#undef PG8_SCHED
}
}
typedef f32x4 AccT[2][2][4][2];

struct EpiIn {
    h16 *qb, *kb, *vt, *guv, *gates;
    __device__ __forceinline__ void operator()(const AccT& acc, const pg8::Unit& u, int wr, int wc, int fr, int fq) const {
        const int pn = u.pn;
        const int row0 = u.pm * 256 + wr * 64 + fr;
        const int cin = wc * 32 + 8 * fq;
        const int b = (u.pm * 256) >> 11, sb = ((u.pm * 256) & 2047) + wr * 64;
        if (pn < 2) {
            h16* base = qb + (size_t)row0 * 512 + pn * 256 + cin;
#pragma unroll
            for (int ai = 0; ai < 2; ++ai)
#pragma unroll
                for (int m = 0; m < 4; ++m)
#pragma unroll
                    for (int bj = 0; bj < 2; ++bj) *(h16x8*)(base + (ai * 128 + m * 16) * 512 + bj * 128) = pack8(acc[ai][bj][m][0], acc[ai][bj][m][1]);
        } else if (pn < 4) {
#pragma unroll
            for (int bj = 0; bj < 2; ++bj) {
                const int col = (pn & 1) * 256 + bj * 128 + cin, hd = col >> 6, d0 = col & 63;
                h16* base = kb + ((size_t)(b * 8 + hd) * 2048 + sb + fr) * 64 + d0;
#pragma unroll
                for (int ai = 0; ai < 2; ++ai)
#pragma unroll
                    for (int m = 0; m < 4; ++m) *(h16x8*)(base + (ai * 128 + m * 16) * 64) = pack8(acc[ai][bj][m][0], acc[ai][bj][m][1]);
            }
        } else if (pn < 6) {
#pragma unroll
            for (int bj = 0; bj < 2; ++bj) {
                const int cv = (pn - 4) * 256 + bj * 128 + cin, hd = cv >> 6, d0 = cv & 63;
                h16* base = vt + ((size_t)(b * 8 + hd) * 256 + (sb >> 3) + (fr >> 3)) * 512 + d0 * 8 + (fr & 7);
#pragma unroll
                for (int ai = 0; ai < 2; ++ai)
#pragma unroll
                    for (int m = 0; m < 4; ++m) {
                        h16* vp = base + (ai * 16 + m * 2) * 512;
                        const f32x4 v0 = acc[ai][bj][m][0], v1 = acc[ai][bj][m][1];
#pragma unroll
                        for (int i = 0; i < 4; ++i) { vp[i * 8] = (h16)v0[i]; vp[(i + 4) * 8] = (h16)v1[i]; }
                    }
            }
        } else if (pn < 10) {
            h16* base = guv + (size_t)row0 * 1024 + (pn - 6) * 256 + cin;
#pragma unroll
            for (int ai = 0; ai < 2; ++ai)
#pragma unroll
                for (int m = 0; m < 4; ++m)
#pragma unroll
                    for (int bj = 0; bj < 2; ++bj) {
                        f32x4 v0 = acc[ai][bj][m][0], v1 = acc[ai][bj][m][1];
#pragma unroll
                        for (int i = 0; i < 4; ++i) { v0[i] = gelu_tanh(v0[i]); v1[i] = gelu_tanh(v1[i]); }
                        *(h16x8*)(base + (ai * 128 + m * 16) * 1024 + bj * 128) = pack8(v0, v1);
                    }
        } else {
            h16* base = gates + (size_t)row0 * 2048 + (pn - 10) * 256 + cin;
#pragma unroll
            for (int ai = 0; ai < 2; ++ai)
#pragma unroll
                for (int m = 0; m < 4; ++m)
#pragma unroll
                    for (int bj = 0; bj < 2; ++bj) {
                        f32x4 v0 = acc[ai][bj][m][0], v1 = acc[ai][bj][m][1];
#pragma unroll
                        for (int i = 0; i < 4; ++i) { v0[i] = sigmoidf_(v0[i]); v1[i] = sigmoidf_(v1[i]); }
                        *(h16x8*)(base + (ai * 128 + m * 16) * 2048 + bj * 128) = pack8(v0, v1);
                    }
        }
    }
};
struct EpiCtx {
    h16 *kc, *vct;
    __device__ __forceinline__ void operator()(const AccT& acc, const pg8::Unit& u, int wr, int wc, int fr, int fq) const {
        const int pn = u.pn;
        const int cin = wc * 32 + 8 * fq;
        const int b = u.pm, sb = wr * 64;
        if (pn < 2) {
#pragma unroll
            for (int bj = 0; bj < 2; ++bj) {
                const int col = pn * 256 + bj * 128 + cin, hd = col >> 6, d0 = col & 63;
                h16* base = kc + ((size_t)(b * 8 + hd) * 256 + sb + fr) * 64 + d0;
#pragma unroll
                for (int ai = 0; ai < 2; ++ai)
#pragma unroll
                    for (int m = 0; m < 4; ++m) *(h16x8*)(base + (ai * 128 + m * 16) * 64) = pack8(acc[ai][bj][m][0], acc[ai][bj][m][1]);
            }
        } else {
#pragma unroll
            for (int bj = 0; bj < 2; ++bj) {
                const int cv = (pn - 2) * 256 + bj * 128 + cin, hd = cv >> 6, d0 = cv & 63;
                h16* base = vct + ((size_t)(b * 8 + hd) * 32 + (sb >> 3) + (fr >> 3)) * 512 + d0 * 8 + (fr & 7);
#pragma unroll
                for (int ai = 0; ai < 2; ++ai)
#pragma unroll
                    for (int m = 0; m < 4; ++m) {
                        h16* vp = base + (ai * 16 + m * 2) * 512;
                        const f32x4 v0 = acc[ai][bj][m][0], v1 = acc[ai][bj][m][1];
#pragma unroll
                        for (int i = 0; i < 4; ++i) { vp[i * 8] = (h16)v0[i]; vp[(i + 4) * 8] = (h16)v1[i]; }
                    }
            }
        }
    }
};
struct EpiM1 {
    h16* m1; const h16* gates;
    __device__ __forceinline__ void operator()(const AccT& acc, const pg8::Unit& u, int wr, int wc, int fr, int fq) const {
        const int row0 = u.pm * 256 + wr * 64 + fr, col0 = u.pn * 256 + wc * 32 + 8 * fq;
#pragma unroll
        for (int ai = 0; ai < 2; ++ai)
#pragma unroll
            for (int m = 0; m < 4; ++m) {
                const int row = row0 + ai * 128 + m * 16;
#pragma unroll
                for (int bj = 0; bj < 2; ++bj) {
                    const int col = col0 + bj * 128;
                    const h16x8 gt = *(const h16x8*)(gates + (size_t)row * 2048 + col);
                    f32x4 v0 = acc[ai][bj][m][0], v1 = acc[ai][bj][m][1];
#pragma unroll
                    for (int i = 0; i < 4; ++i) { v0[i] *= (float)gt[i]; v1[i] *= (float)gt[4 + i]; }
                    *(h16x8*)(m1 + (size_t)row * 1024 + col) = pack8(v0, v1);
                }
            }
    }
};
struct EpiM2 {
    const h16* m1; const h16* gates; h16* mm;
    __device__ __forceinline__ void operator()(const AccT& acc, const pg8::Unit& u, int wr, int wc, int fr, int fq) const {
        const int row0 = u.pm * 256 + wr * 64 + fr, col0 = u.pn * 256 + wc * 32 + 8 * fq;
#pragma unroll
        for (int ai = 0; ai < 2; ++ai)
#pragma unroll
            for (int m = 0; m < 4; ++m) {
                const int row = row0 + ai * 128 + m * 16;
#pragma unroll
                for (int bj = 0; bj < 2; ++bj) {
                    const int col = col0 + bj * 128;
                    const h16x8 gt = *(const h16x8*)(gates + (size_t)row * 2048 + 1024 + col);
                    const h16x8 mi = *(const h16x8*)(m1 + (size_t)row * 1024 + col);
                    f32x4 p0 = (f32x4){(float)mi[0], (float)mi[1], (float)mi[2], (float)mi[3]}, p1 = (f32x4){(float)mi[4], (float)mi[5], (float)mi[6], (float)mi[7]};
                    const f32x4 v0 = acc[ai][bj][m][0], v1 = acc[ai][bj][m][1];
#pragma unroll
                    for (int i = 0; i < 4; ++i) { p0[i] += v0[i] * (float)gt[i]; p1[i] += v1[i] * (float)gt[4 + i]; }
                    *(h16x8*)(mm + (size_t)row * 1024 + col) = pack8(p0, p1);
                }
            }
    }
};
struct EpiX1 {
    const float* x; const float* mod; float* x1;
    __device__ __forceinline__ void operator()(const AccT& acc, const pg8::Unit& u, int wr, int wc, int fr, int fq) const {
        const int row0 = u.pm * 256 + wr * 64 + fr, col0 = u.pn * 256 + wc * 32 + 8 * fq;
        const int b = (u.pm * 256) >> 11;
#pragma unroll
        for (int bj = 0; bj < 2; ++bj) {
            const int col = col0 + bj * 128;
            const float* gp = mod + (size_t)b * 6144 + 2 * 1024 + col;
            const f32x4 g0 = *(const f32x4*)gp, g1 = *(const f32x4*)(gp + 4);
#pragma unroll
            for (int ai = 0; ai < 2; ++ai)
#pragma unroll
                for (int m = 0; m < 4; ++m) {
                    const int row = row0 + ai * 128 + m * 16;
                    const float* xi = x + (size_t)row * 1024 + col;
                    const f32x4 x0 = *(const f32x4*)xi, x1v = *(const f32x4*)(xi + 4);
                    float* o = x1 + (size_t)row * 1024 + col;
                    *(f32x4*)o = x0 + g0 * acc[ai][bj][m][0]; *(f32x4*)(o + 4) = x1v + g1 * acc[ai][bj][m][1];
                }
        }
    }
};
struct EpiH16 {
    h16* o; int ldc;
    __device__ __forceinline__ void operator()(const AccT& acc, const pg8::Unit& u, int wr, int wc, int fr, int fq) const {
        const int row0 = u.pm * 256 + wr * 64 + fr, col0 = u.pn * 256 + wc * 32 + 8 * fq;
#pragma unroll
        for (int ai = 0; ai < 2; ++ai)
#pragma unroll
            for (int m = 0; m < 4; ++m) {
                const int row = row0 + ai * 128 + m * 16;
#pragma unroll
                for (int bj = 0; bj < 2; ++bj)
                    *(h16x8*)(o + (size_t)row * ldc + col0 + bj * 128) = pack8(acc[ai][bj][m][0], acc[ai][bj][m][1]);
            }
    }
};

__device__ __forceinline__ void cvt_tile(const float* __restrict__ src, h16* __restrict__ dst, int tile) {
    const size_t i = (size_t)tile * 4096 + threadIdx.x * 8;
    const f32x4 a = *(const f32x4*)(src + i), b = *(const f32x4*)(src + i + 4);
    *(h16x8*)(dst + i) = pack8(a, b);
}
__device__ __forceinline__ void tr_tile(const float* __restrict__ src, h16* __restrict__ dst, int K, int N, int tile, float* lds) {
    const int ntn = N / 64, tk = tile / ntn, tn = tile % ntn, tid = threadIdx.x;
#pragma unroll
    for (int ps = 0; ps < 2; ++ps) {
        const int k = ps * 32 + (tid >> 4), n = (tid & 15) * 4;
        const f32x4 v = *(const f32x4*)(src + (size_t)(tk * 64 + k) * N + tn * 64 + n);
        lds[k * 65 + n] = v[0]; lds[k * 65 + n + 1] = v[1]; lds[k * 65 + n + 2] = v[2]; lds[k * 65 + n + 3] = v[3];
    }
    __syncthreads();
    {
        const int n = tid >> 3, ks = (tid & 7) * 8;
        h16x8 o;
#pragma unroll
        for (int i = 0; i < 8; ++i) o[i] = (h16)lds[(ks + i) * 65 + n];
        *(h16x8*)(dst + (size_t)(tn * 64 + n) * K + tk * 64 + ks) = o;
    }
    __syncthreads();
}
__device__ __forceinline__ void cvt8_rows(const float* __restrict__ src, unsigned char* __restrict__ dst, float* __restrict__ inv, int tile, int dstride = 1024) {
    const int wid = threadIdx.x >> 6, lane = threadIdx.x & 63;
    const size_t row = (size_t)tile * 8 + wid;
    const float* r = src + row * 1024 + lane * 16;
    f32x4 a[4]; float mx = 0.f;
#pragma unroll
    for (int i = 0; i < 4; ++i) { a[i] = *(const f32x4*)(r + 4 * i); mx = fmaxf(mx, fmaxf(fmaxf(fabsf(a[i][0]), fabsf(a[i][1])), fmaxf(fabsf(a[i][2]), fabsf(a[i][3])))); }
#pragma unroll
    for (int o = 32; o > 0; o >>= 1) mx = fmaxf(mx, __shfl_xor(mx, o));
    int ex2 = 0; float sc = 1.0f;
    if (mx > 0.f) { (void)frexpf(mx, &ex2); int k = 8 - ex2; k = k > 100 ? 100 : (k < -100 ? -100 : k); sc = ldexpf(1.0f, k); }
    i32x4 w;
#pragma unroll
    for (int i = 0; i < 4; ++i) {
        int pk = __builtin_amdgcn_cvt_pk_fp8_f32(a[i][0] * sc, a[i][1] * sc, 0, false);
        pk = __builtin_amdgcn_cvt_pk_fp8_f32(a[i][2] * sc, a[i][3] * sc, pk, true);
        w[i] = pk;
    }
    *(i32x4*)(dst + row * dstride + lane * 16) = w;
    if (lane == 0) inv[2 * row] = 1.0f / sc;
}
__device__ __forceinline__ void cvt4_rows(const float* __restrict__ src, unsigned char* __restrict__ dst, float* __restrict__ inv, int tile, int dstride = 512) {
    const int wid = threadIdx.x >> 6, lane = threadIdx.x & 63;
    const size_t row = (size_t)tile * 8 + wid;
    const float* r = src + row * 1024 + lane * 16;
    f32x4 a[4]; float mx = 0.f;
#pragma unroll
    for (int i = 0; i < 4; ++i) { a[i] = *(const f32x4*)(r + 4 * i); mx = fmaxf(mx, fmaxf(fmaxf(fabsf(a[i][0]), fabsf(a[i][1])), fmaxf(fabsf(a[i][2]), fabsf(a[i][3])))); }
#pragma unroll
    for (int o = 32; o > 0; o >>= 1) mx = fmaxf(mx, __shfl_xor(mx, o));
    const float sc = (mx > 1e-30f) ? 6.0f / mx : 1.0f;
    int w0 = 0, w1 = 0;
    w0 = __builtin_amdgcn_cvt_scalef32_pk_fp4_f32(w0, a[0][0] * sc, a[0][1] * sc, 1.0f, 0);
    w0 = __builtin_amdgcn_cvt_scalef32_pk_fp4_f32(w0, a[0][2] * sc, a[0][3] * sc, 1.0f, 1);
    w0 = __builtin_amdgcn_cvt_scalef32_pk_fp4_f32(w0, a[1][0] * sc, a[1][1] * sc, 1.0f, 2);
    w0 = __builtin_amdgcn_cvt_scalef32_pk_fp4_f32(w0, a[1][2] * sc, a[1][3] * sc, 1.0f, 3);
    w1 = __builtin_amdgcn_cvt_scalef32_pk_fp4_f32(w1, a[2][0] * sc, a[2][1] * sc, 1.0f, 0);
    w1 = __builtin_amdgcn_cvt_scalef32_pk_fp4_f32(w1, a[2][2] * sc, a[2][3] * sc, 1.0f, 1);
    w1 = __builtin_amdgcn_cvt_scalef32_pk_fp4_f32(w1, a[3][0] * sc, a[3][1] * sc, 1.0f, 2);
    w1 = __builtin_amdgcn_cvt_scalef32_pk_fp4_f32(w1, a[3][2] * sc, a[3][3] * sc, 1.0f, 3);
    *(i32x2*)(dst + row * dstride + lane * 8) = (i32x2){w0, w1};
    if (lane == 0) inv[2 * row] = 1.0f / sc;
}
__device__ __forceinline__ void wqk_tile(const float* __restrict__ wq, const float* __restrict__ keys, h16* __restrict__ wt, int tile, float* lds) {
    const int ct = tile >> 4, hp = tile & 15, tid = threadIdx.x;
    float* sA = lds;
    float* sB = lds + 64 * 129;
#pragma unroll
    for (int i = 0; i < 4; ++i) {
        const int e = (i * 512 + tid) * 4, r = e >> 7, d = e & 127;
        const f32x4 v = *(const f32x4*)(wq + (size_t)(ct * 64 + r) * 2048 + hp * 128 + d);
        sA[r * 129 + d] = v[0]; sA[r * 129 + d + 1] = v[1]; sA[r * 129 + d + 2] = v[2]; sA[r * 129 + d + 3] = v[3];
    }
#pragma unroll
    for (int i = 0; i < 8; ++i) {
        const int e = (i * 512 + tid) * 4, k = e >> 7, d = e & 127;
        const f32x4 v = *(const f32x4*)(keys + (size_t)(hp * 128 + k) * 128 + d);
        sB[k * 129 + d] = v[0]; sB[k * 129 + d + 1] = v[1]; sB[k * 129 + d + 2] = v[2]; sB[k * 129 + d + 3] = v[3];
    }
    __syncthreads();
    const int c = tid >> 3, kg = (tid & 7) * 16;
    float acc[16];
#pragma unroll
    for (int j = 0; j < 16; ++j) acc[j] = 0.f;
#pragma unroll 4
    for (int d = 0; d < 128; ++d) {
        const float a = sA[c * 129 + d];
#pragma unroll
        for (int j = 0; j < 16; ++j) acc[j] += a * sB[(kg + j) * 129 + d];
    }
#pragma unroll
    for (int j = 0; j < 16; ++j) wt[(size_t)(hp * 128 + kg + j) * 1024 + ct * 64 + c] = (h16)acc[j];
    __syncthreads();
}
__device__ void phase0(const Params& p, float* lds) {
    unsigned char* ws = p.ws;
    const int tid = threadIdx.x, wid = tid >> 6, lane = tid & 63;
    for (int ib = blockIdx.x; ib < 256; ib += gridDim.x) {
        if (wid < 6) {
            const int item = ib * 6 + wid, cg64 = item % 96, kc = item / 96;
            const int col = cg64 * 64 + lane, k0 = kc * 64;
            float sv[17], acc[17];
#pragma unroll
            for (int b = 0; b < 17; ++b) {
                const float cv = (b < 16) ? p.in[I_C][b * 1024 + k0 + lane] : p.in[I_CCTX][k0 + lane];
                sv[b] = silu_(cv); acc[b] = 0.f;
            }
            const float* wp = p.in[I_ADAW] + (size_t)k0 * 6144 + col;
            for (int j = 0; j < 64; ++j) {
                const float w = wp[(size_t)j * 6144];
#pragma unroll
                for (int b = 0; b < 17; ++b) acc[b] += __builtin_bit_cast(float, __builtin_amdgcn_readlane(__builtin_bit_cast(int, sv[b]), j)) * w;
            }
            float* mp = (float*)(ws + OFF_MODP);
#pragma unroll
            for (int b = 0; b < 17; ++b) mp[((size_t)kc * 17 + b) * 6144 + col] = acc[b];
        }
    }
    constexpr int T0 = 2048, T1 = T0 + 2048, T2 = T1 + 32, T3 = T2, T4 = T3 + 1152, T5 = T4 + 128, T6 = T5 + 128, T7 = T6 + 256, T8 = T7 + 256;
    for (int t = blockIdx.x; t < T8; t += gridDim.x) {
        if (t < T0) cvt4_rows(p.in[I_PU], ws + OFF_U8, (float*)(ws + OFF_USC), t, 1536);
        else if (t < T1) cvt8_rows(p.in[I_PV], ws + OFF_U8 + 512, (float*)(ws + OFF_USC) + 1, t - T0, 1536);
        else if (t < T2) cvt_tile(p.in[I_GMWS], (h16*)(ws + OFF_WS16), t - T1);
        else if (t < T3) {
            const int e = (t - T2) * 4096 + tid * 8;
            const int row = e >> 8, cc = e & 255, h = row >> 8, pp = (row >> 7) & 1, k = row & 127, pq = cc >> 7, d = cc & 127;
            h16x8 o = {0, 0, 0, 0, 0, 0, 0, 0};
            if (pp == pq) {
                const float* kp = p.in[I_KEYS] + ((size_t)((h * 2 + pp) * 128 + k)) * 128 + d;
                o = pack8(*(const f32x4*)kp, *(const f32x4*)(kp + 4));
            }
            *(h16x8*)((h16*)(ws + OFF_BD) + e) = o;
        }
        else if (t < T4) tr_tile(p.in[I_WIN], (h16*)(ws + OFF_WINT), 1024, INC, t - T3, lds);
        else if (t < T5) tr_tile(p.in[I_WPA], (h16*)(ws + OFF_WPAT), 512, 1024, t - T4, lds);
        else if (t < T6) tr_tile(p.in[I_WPB], (h16*)(ws + OFF_WPBT), 512, 1024, t - T5, lds);
        else if (t < T7) tr_tile(p.in[I_WOUT], (h16*)(ws + OFF_WOUTT), 1024, 1024, t - T6, lds);
        else wqk_tile(p.in[I_WQ], p.in[I_KEYS], (h16*)(ws + OFF_WQT), t - T7, lds);
    }
}

__device__ __forceinline__ void norm_rows(const float* __restrict__ src, h16* __restrict__ dst, int row_begin, int rows_per_wave, const float* sA, const float* sB) {
    const int tid_ = fresh_tid();
    const int wid = tid_ >> 6, lane = tid_ & 63;
    f32x4 a[4], bsh[4];
#pragma unroll
    for (int c = 0; c < 4; ++c) { a[c] = *(const f32x4*)(sA + c * 256 + lane * 4); bsh[c] = *(const f32x4*)(sB + c * 256 + lane * 4); }
    for (int i = 0; i < rows_per_wave; i += 2) {
        const size_t row = (size_t)row_begin + wid * rows_per_wave + i;
        f32x4 v[2][4]; float ss[2];
#pragma unroll
        for (int q = 0; q < 2; ++q) {
            ss[q] = 0.f;
#pragma unroll
            for (int c = 0; c < 4; ++c) { v[q][c] = *(const f32x4*)(src + (row + q) * 1024 + c * 256 + lane * 4); ss[q] += v[q][c][0] * v[q][c][0] + v[q][c][1] * v[q][c][1] + v[q][c][2] * v[q][c][2] + v[q][c][3] * v[q][c][3]; }
        }
#pragma unroll
        for (int o = 32; o > 0; o >>= 1) { const float t0 = __shfl_xor(ss[0], o), t1 = __shfl_xor(ss[1], o); ss[0] += t0; ss[1] += t1; }
#pragma unroll
        for (int q = 0; q < 2; ++q) {
            const float r = rsqrtf(ss[q] * (1.0f / 1024.0f) + 1e-6f);
#pragma unroll
            for (int c = 0; c < 4; ++c) {
                h16x4 o;
#pragma unroll
                for (int j = 0; j < 4; ++j) o[j] = (h16)(v[q][c][j] * r * a[c][j] + bsh[c][j]);
                *(h16x4*)(dst + (row + q) * 1024 + c * 256 + lane * 4) = o;
            }
        }
    }
}
__device__ void phase1(const Params& p, float* lds) {
    unsigned char* ws = p.ws;
    const int tid = threadIdx.x;
    const float* mp = (const float*)(ws + OFF_MODP);
    const float* bias = p.in[I_ADAB];
    float* sA = lds; float* sB = lds + 1024; float* cA = lds + 2048; float* cB = lds + 3072;
    {
        float* mod = (float*)(ws + OFF_MOD);
        for (int e = blockIdx.x * 512 + tid; e < 17 * 6144; e += gridDim.x * 512) {
            float s = bias[e % 6144];
#pragma unroll
            for (int kc = 0; kc < 16; ++kc) s += mp[(size_t)kc * 17 * 6144 + e];
            mod[e] = s;
        }
    }
    for (int col = tid; col < 1024; col += 512) {
        float sh = bias[col], sc = bias[1024 + col];
#pragma unroll
        for (int kc = 0; kc < 16; ++kc) { sh += mp[((size_t)kc * 17 + 16) * 6144 + col]; sc += mp[((size_t)kc * 17 + 16) * 6144 + 1024 + col]; }
        cA[col] = p.in[I_N1G][col] * (1.0f + sc); cB[col] = sh;
    }
    for (int rg = blockIdx.x; rg < 256; rg += gridDim.x) {
        const int b = rg >> 4;
        __syncthreads();
        for (int col = tid; col < 1024; col += 512) {
            float sh = bias[col], sc = bias[1024 + col];
#pragma unroll
            for (int kc = 0; kc < 16; ++kc) { sh += mp[((size_t)kc * 17 + b) * 6144 + col]; sc += mp[((size_t)kc * 17 + b) * 6144 + 1024 + col]; }
            sA[col] = p.in[I_N1G][col] * (1.0f + sc); sB[col] = sh;
        }
        __syncthreads();
        norm_rows(p.in[I_X], (h16*)(ws + OFF_R1), rg * 128, 16, sA, sB);
        norm_rows(p.in[I_CTX], (h16*)(ws + OFF_HC), rg * 16, 2, cA, cB);
    }
}
__device__ void phase6(const Params& p, float* lds) {
    unsigned char* ws = p.ws;
    const int tid = threadIdx.x;
    const float* mod = (const float*)(ws + OFF_MOD);
    float* sA = lds; float* sB = lds + 1024;
    for (int rg = blockIdx.x; rg < 256; rg += gridDim.x) {
        const int b = rg >> 4;
        __syncthreads();
        for (int col = tid; col < 1024; col += 512) {
            sA[col] = p.in[I_N2G][col] * (1.0f + mod[(size_t)b * 6144 + 4 * 1024 + col]); sB[col] = mod[(size_t)b * 6144 + 3 * 1024 + col];
        }
        __syncthreads();
        norm_rows(p.out, (h16*)(ws + OFF_R1), rg * 128, 16, sA, sB);
    }
}

__device__ __forceinline__ int clampi(int v, int lo, int hi) { return v < lo ? lo : (v > hi ? hi : v); }

template <bool LOCAL>
__device__ __forceinline__ void attn_core(const h16x8 (&kf)[2][2], const h16x8 (&vf)[4], const float* __restrict__ rpbrow, const int cb, const int qc, const int cs,
                                          const h16x8 (&qf)[2], float& m_run, float& l_run, f32x4 (&O)[4], const int quad) {
    f32x4 st[2];
#pragma unroll
    for (int t = 0; t < 2; ++t) {
        f32x4 a = (f32x4){0.f, 0.f, 0.f, 0.f};
#pragma unroll
        for (int ks = 0; ks < 2; ++ks) a = __builtin_amdgcn_mfma_f32_16x16x32_f16(kf[t][ks], qf[ks], a, 0, 0, 0);
        st[t] = a;
    }
    float mx = -INFINITY;
#pragma unroll
    for (int t = 0; t < 2; ++t)
#pragma unroll
        for (int j = 0; j < 4; ++j) {
            float sv = st[t][j] * 0.125f;
            if (LOCAL) {
                const int kc = cb + 16 * t + quad * 4 + j;
                const bool inw = (kc >= cs) && (kc < cs + 16);
                const int dc = clampi(kc - qc + 15, 0, 30);
                const float bv = rpbrow[dc];
                sv = inw ? (sv + bv) : -1e30f;
            }
            st[t][j] = sv; mx = fmaxf(mx, sv);
        }
    mx = fmaxf(mx, __shfl_xor(mx, 16)); mx = fmaxf(mx, __shfl_xor(mx, 32));
    const float m_new = fmaxf(m_run, mx);
    const float alpha = __expf(m_run - m_new);
    float ls = 0.f; h16x8 pf;
#pragma unroll
    for (int t = 0; t < 2; ++t)
#pragma unroll
        for (int j = 0; j < 4; ++j) { const float pe = __expf(st[t][j] - m_new); ls += pe; pf[t * 4 + j] = (h16)pe; }
    l_run = l_run * alpha + ls; m_run = m_new;
#pragma unroll
    for (int dt = 0; dt < 4; ++dt) { O[dt] *= alpha; O[dt] = __builtin_amdgcn_mfma_f32_16x16x32_f16(vf[dt], pf, O[dt], 0, 0, 0); }
}
__device__ __forceinline__ void load_kv(const h16* __restrict__ kt, const h16* __restrict__ vt, h16x8 (&kf)[2][2], h16x8 (&vf)[4], const int l15, const int quad) {
#pragma unroll
    for (int t = 0; t < 2; ++t)
#pragma unroll
        for (int ks = 0; ks < 2; ++ks) kf[t][ks] = *(const h16x8*)(kt + (16 * t + l15) * 64 + ks * 32 + quad * 8);
#pragma unroll
    for (int dt = 0; dt < 4; ++dt) {
        const h16* vp = vt + ((quad >> 1) * 64 + dt * 16 + l15) * 8 + (quad & 1) * 4;
        const h16x4 lo = *(const h16x4*)vp, hi = *(const h16x4*)(vp + 2 * 512);
        vf[dt] = (h16x8){lo[0], lo[1], lo[2], lo[3], hi[0], hi[1], hi[2], hi[3]};
    }
}

__device__ void attn_unit(const Params& p, int unit) {
    unsigned char* ws = p.ws;
    const int tid_ = fresh_tid();
    const int lane = tid_ & 63, h = tid_ >> 6, l15 = lane & 15, quad = lane >> 4;
    const int b = unit >> 5, r = unit & 31;
    const h16* QB = (const h16*)(ws + OFF_QB);
    const h16* KH = (const h16*)(ws + OFF_KB) + (size_t)(b * 8 + h) * 2048 * 64;
    const h16* VH = (const h16*)(ws + OFF_VT) + (size_t)(b * 8 + h) * 256 * 512;
    const h16* KCH = (const h16*)(ws + OFF_KC) + (size_t)(b * 8 + h) * 256 * 64;
    const h16* VCH = (const h16*)(ws + OFF_VCT) + (size_t)(b * 8 + h) * 32 * 512;
    h16* YA = (h16*)(ws + OFF_R1);
    const float* rpb = p.in[I_RPB] + (size_t)h * 15 * 31;
    const int rs = clampi(r - 4, 0, 24);
    h16x8 qf[4][2]; float m_run[4], l_run[4]; f32x4 O[4][4];
#pragma unroll
    for (int g = 0; g < 4; ++g) {
        const size_t tq = (size_t)b * 2048 + r * 64 + 16 * g + l15;
        qf[g][0] = *(const h16x8*)(QB + tq * 512 + h * 64 + quad * 8);
        qf[g][1] = *(const h16x8*)(QB + tq * 512 + h * 64 + 32 + quad * 8);
        m_run[g] = -INFINITY; l_run[g] = 0.f;
#pragma unroll
        for (int dt = 0; dt < 4; ++dt) O[g][dt] = (f32x4){0.f, 0.f, 0.f, 0.f};
    }
#pragma unroll 1
    for (int step = 0; step < 8; ++step) {
        h16x8 kf[2][2], vf[4];
        load_kv(KCH + step * 32 * 64, VCH + step * 4 * 512, kf, vf, l15, quad);
#pragma unroll
        for (int g = 0; g < 4; ++g) attn_core<false>(kf, vf, rpb, 0, 0, 0, qf[g], m_run[g], l_run[g], O[g], quad);
    }
#pragma unroll
    for (int gp = 0; gp < 4; gp += 2) {
        const int cb0 = clampi(16 * gp - 8, 0, 32), cb1 = clampi(16 * (gp + 1) - 8, 0, 32);
        const int qc0 = 16 * gp + l15, qc1 = 16 * (gp + 1) + l15;
        const int cs0 = clampi(qc0 - 8, 0, 48), cs1 = clampi(qc1 - 8, 0, 48);
        const float* rp0 = rpb + (rs - r + 7) * 31;
#pragma unroll 1
        for (int step = 0; step < 8; ++step) {
            const int t0 = (rs + step) * 64 + cb0, t1 = (rs + step) * 64 + cb1;
            h16x8 kf0[2][2], vf0[4], kf1[2][2], vf1[4];
            load_kv(KH + (size_t)t0 * 64, VH + (size_t)(t0 >> 3) * 512, kf0, vf0, l15, quad);
            load_kv(KH + (size_t)t1 * 64, VH + (size_t)(t1 >> 3) * 512, kf1, vf1, l15, quad);
            attn_core<true>(kf0, vf0, rp0 + step * 31, cb0, qc0, cs0, qf[gp], m_run[gp], l_run[gp], O[gp], quad);
            attn_core<true>(kf1, vf1, rp0 + step * 31, cb1, qc1, cs1, qf[gp + 1], m_run[gp + 1], l_run[gp + 1], O[gp + 1], quad);
        }
    }
#pragma unroll
    for (int g = 0; g < 4; ++g) {
        const size_t tq = (size_t)b * 2048 + r * 64 + 16 * g + l15;
        float l = l_run[g];
        l += __shfl_xor(l, 16); l += __shfl_xor(l, 32);
        const float inv = __builtin_amdgcn_rcpf(l);
#pragma unroll
        for (int dt = 0; dt < 4; ++dt) {
            h16x4 o;
#pragma unroll
            for (int j = 0; j < 4; ++j) o[j] = (h16)(O[g][dt][j] * inv);
            *(h16x4*)(YA + tq * 1024 + h * 64 + dt * 16 + quad * 4) = o;
        }
    }
}

__device__ void sgu_unit(const Params& p, int n, LAS unsigned char* lds) {
    unsigned char* ws = p.ws;
    const int tid = fresh_tid(), lane = tid & 63, g = tid >> 6, l15 = lane & 15, quad = lane >> 4;
    const h16* GUV = (const h16*)(ws + OFF_GUV);
    const h16* WS16 = (const h16*)(ws + OFF_WS16);
    h16* YB = (h16*)(ws + OFF_R1) + 512;
    LAS float* stat = (LAS float*)(lds + 8 * 17408);
    LAS h16* vt = (LAS h16*)(lds + g * 17408);
    const size_t t0 = (size_t)n * 128;
    __syncthreads();
    for (int i = 0; i < 16; i += 4) {
        h16x8 x[4]; float s[4], v[4];
#pragma unroll
        for (int q = 0; q < 4; ++q) {
            x[q] = *(const h16x8*)(GUV + (t0 + g * 16 + i + q) * 1024 + 512 + lane * 8);
            s[q] = 0.f;
#pragma unroll
            for (int j = 0; j < 8; ++j) s[q] += (float)x[q][j];
        }
#pragma unroll
        for (int o = 32; o > 0; o >>= 1) { float t[4];
#pragma unroll
            for (int q = 0; q < 4; ++q) t[q] = __shfl_xor(s[q], o);
#pragma unroll
            for (int q = 0; q < 4; ++q) s[q] += t[q]; }
#pragma unroll
        for (int q = 0; q < 4; ++q) {
            s[q] *= (1.0f / 512.0f); v[q] = 0.f;
#pragma unroll
            for (int j = 0; j < 8; ++j) { const float d = (float)x[q][j] - s[q]; v[q] += d * d; }
        }
#pragma unroll
        for (int o = 32; o > 0; o >>= 1) { float t[4];
#pragma unroll
            for (int q = 0; q < 4; ++q) t[q] = __shfl_xor(v[q], o);
#pragma unroll
            for (int q = 0; q < 4; ++q) v[q] += t[q]; }
        if (lane == 0) {
#pragma unroll
            for (int q = 0; q < 4; ++q) { stat[(g * 16 + i + q) * 2] = s[q]; stat[(g * 16 + i + q) * 2 + 1] = rsqrtf(v[q] * (1.0f / 512.0f) + 1e-6f); }
        }
    }
    __syncthreads();
    {
        const int ch0 = (lane & 7) * 8;
        float lg[8];
#pragma unroll
        for (int j = 0; j < 8; ++j) lg[j] = p.in[I_LNG][g * 64 + ch0 + j];
#pragma unroll 8
        for (int it = 0; it < 16; ++it) {
            const int q = it * 8 + (lane >> 3);
            const h16x8 x = *(const h16x8*)(GUV + (t0 + q) * 1024 + 512 + g * 64 + ch0);
            const float mean = stat[q * 2], rstd = stat[q * 2 + 1];
#pragma unroll
            for (int j = 0; j < 8; ++j) vt[(ch0 + j) * 136 + q] = (h16)(((float)x[j] - mean) * rstd * lg[j]);
        }
    }
    asm volatile("s_waitcnt lgkmcnt(0)" ::: "memory");
    __syncthreads();
    h16x8 af[4][4];
#pragma unroll
    for (int dt = 0; dt < 4; ++dt)
#pragma unroll
        for (int ks = 0; ks < 4; ++ks) af[dt][ks] = *(const LAS h16x8*)(vt + (dt * 16 + l15) * 136 + ks * 32 + quad * 8);
    const h16* wg = WS16 + (size_t)g * 128 * 128;
#pragma unroll 2
    for (int pt = 0; pt < 8; ++pt) {
        f32x4 acc[4];
#pragma unroll
        for (int dt = 0; dt < 4; ++dt) acc[dt] = (f32x4){0.f, 0.f, 0.f, 0.f};
#pragma unroll
        for (int ks = 0; ks < 4; ++ks) {
            const h16x8 bf = *(const h16x8*)(wg + (size_t)(pt * 16 + l15) * 128 + ks * 32 + quad * 8);
#pragma unroll
            for (int dt = 0; dt < 4; ++dt) acc[dt] = __builtin_amdgcn_mfma_f32_16x16x32_f16(af[dt][ks], bf, acc[dt], 0, 0, 0);
        }
        const int pp = pt * 16 + l15;
        const float bsv = p.in[I_GMBS][g * 128 + pp];
        const size_t tok = t0 + pp;
#pragma unroll
        for (int dt = 0; dt < 4; ++dt) {
            const int ch = g * 64 + dt * 16 + quad * 4;
            const h16x4 uu = *(const h16x4*)(GUV + tok * 1024 + ch);
            h16x4 o;
#pragma unroll
            for (int j = 0; j < 4; ++j) o[j] = (h16)((float)uu[j] * (acc[dt][j] + bsv));
            *(h16x4*)(YB + tok * 1024 + ch) = o;
        }
    }
    __syncthreads();
}

__device__ __forceinline__ float row16_sum_to_lane15(float v) {
    v += __builtin_bit_cast(float, __builtin_amdgcn_update_dpp(0, __builtin_bit_cast(int, v), 0x118, 0xf, 0xf, true));
    v += __builtin_bit_cast(float, __builtin_amdgcn_update_dpp(0, __builtin_bit_cast(int, v), 0x114, 0xf, 0xf, true));
    v += __builtin_bit_cast(float, __builtin_amdgcn_update_dpp(0, __builtin_bit_cast(int, v), 0x112, 0xf, 0xf, true));
    v += __builtin_bit_cast(float, __builtin_amdgcn_update_dpp(0, __builtin_bit_cast(int, v), 0x111, 0xf, 0xf, true));
    return v;
}
#define DPPF(v, ctrl) __builtin_bit_cast(float, __builtin_amdgcn_update_dpp(__builtin_bit_cast(int, v), __builtin_bit_cast(int, v), ctrl, 0xf, 0xf, false))
__device__ __forceinline__ float row16_allsum(float v) { v += DPPF(v, 0x128); v += DPPF(v, 0x124); v += DPPF(v, 0x122); v += DPPF(v, 0x121); return v; }
__device__ __forceinline__ float row16_allmax(float v) { v = fmaxf(v, DPPF(v, 0x128)); v = fmaxf(v, DPPF(v, 0x124)); v = fmaxf(v, DPPF(v, 0x122)); v = fmaxf(v, DPPF(v, 0x121)); return v; }
__device__ __forceinline__ int wave_incl_scan(int v) {
    v += __builtin_amdgcn_update_dpp(0, v, 0x111, 0xf, 0xf, false);
    v += __builtin_amdgcn_update_dpp(0, v, 0x112, 0xf, 0xf, false);
    v += __builtin_amdgcn_update_dpp(0, v, 0x114, 0xf, 0xf, false);
    v += __builtin_amdgcn_update_dpp(0, v, 0x118, 0xf, 0xf, false);
    v += __builtin_amdgcn_update_dpp(0, v, 0x142, 0xa, 0xf, false);
    v += __builtin_amdgcn_update_dpp(0, v, 0x143, 0xc, 0xf, false);
    return v;
}
__device__ __forceinline__ unsigned wave_or(unsigned x) {
    int v = (int)x;
    v |= __builtin_amdgcn_update_dpp(0, v, 0x111, 0xf, 0xf, false);
    v |= __builtin_amdgcn_update_dpp(0, v, 0x112, 0xf, 0xf, false);
    v |= __builtin_amdgcn_update_dpp(0, v, 0x114, 0xf, 0xf, false);
    v |= __builtin_amdgcn_update_dpp(0, v, 0x118, 0xf, 0xf, false);
    v |= __builtin_amdgcn_update_dpp(0, v, 0x142, 0xa, 0xf, false);
    v |= __builtin_amdgcn_update_dpp(0, v, 0x143, 0xc, 0xf, false);
    return (unsigned)__builtin_amdgcn_readlane(v, 63);
}
__device__ __forceinline__ unsigned wave_and(unsigned x) {
    int v = (int)x;
    v &= __builtin_amdgcn_update_dpp(-1, v, 0x111, 0xf, 0xf, false);
    v &= __builtin_amdgcn_update_dpp(-1, v, 0x112, 0xf, 0xf, false);
    v &= __builtin_amdgcn_update_dpp(-1, v, 0x114, 0xf, 0xf, false);
    v &= __builtin_amdgcn_update_dpp(-1, v, 0x118, 0xf, 0xf, false);
    v &= __builtin_amdgcn_update_dpp(-1, v, 0x142, 0xa, 0xf, false);
    v &= __builtin_amdgcn_update_dpp(-1, v, 0x143, 0xc, 0xf, false);
    return (unsigned)__builtin_amdgcn_readlane(v, 63);
}
__device__ __forceinline__ unsigned key16(unsigned short u) { return (u & 0x8000u) ? ((~(unsigned)u) & 0xFFFFu) : ((unsigned)u | 0x8000u); }
__device__ __forceinline__ unsigned key32(unsigned u) { return (u & 0x80000000u) ? ~u : (u | 0x80000000u); }
__device__ __forceinline__ float dot8(h16x8 a, h16x8 b, float c) {
    c = __builtin_amdgcn_fdot2((h16x2){a[0], a[1]}, (h16x2){b[0], b[1]}, c, false);
    c = __builtin_amdgcn_fdot2((h16x2){a[2], a[3]}, (h16x2){b[2], b[3]}, c, false);
    c = __builtin_amdgcn_fdot2((h16x2){a[4], a[5]}, (h16x2){b[4], b[5]}, c, false);
    c = __builtin_amdgcn_fdot2((h16x2){a[6], a[7]}, (h16x2){b[6], b[7]}, c, false);
    return c;
}
#define LDS_FENCE() asm volatile("s_waitcnt lgkmcnt(0)" ::: "memory")

__device__ void peer_phase(const Params& p, LAS unsigned char* lds, unsigned* bar, unsigned& epoch) {
    unsigned char* ws = p.ws;
    const int tid = fresh_tid(), wid = __builtin_amdgcn_readfirstlane(tid >> 6), lane = tid & 63;
    const unsigned long long lm = (1ull << lane) - 1ull;
    LAS unsigned char* wl = lds + wid * 11264;
    LAS float* s_top = (LAS float*)(wl);
    LAS int* i_top = (LAS int*)(wl + 1024);
    LAS int* ex = (LAS int*)(wl + 2048);
    LAS float* sc = (LAS float*)(wl + 2560);
    LAS int* uns_m = (LAS int*)(wl + 3072);
    LAS float* uns_g = (LAS float*)(wl + 3584);
    LAS int* cnt = (LAS int*)(wl + 4096);
    LAS int* base = (LAS int*)(wl + 4352);
    const int lead = (wid >= 4) ? 1 : 0;
    const unsigned short* SC = (const unsigned short*)(ws + OFF_SC16);
    const h16* H2 = (const h16*)(ws + OFF_R1);
    const unsigned char* U4 = ws + OFF_U8;
    const unsigned char* V8 = ws + OFF_V8;
    const float* USC = (const float*)(ws + OFF_USC);
    const float* VSC = (const float*)(ws + OFF_VSC);
    const float* mod = (const float*)(ws + OFF_MOD);
    const int grp = lane >> 4, li = lane & 15;
    for (int tg = blockIdx.x; tg < 256; tg += gridDim.x) {
        for (int it5 = 0; it5 < 5; ++it5) {
          if (it5 < 4) {
            const int round = it5;
            const size_t tok0 = (size_t)tg * 128 + wid * 16 + round * 4;
            LAS unsigned short* se = (LAS unsigned short*)(wl + 4608 + (round & 1) * 3072);
            LAS float* sw = (LAS float*)(wl + 4608 + (round & 1) * 3072 + 1024);
            for (int tt = 0; tt < 4; ++tt) {
                const size_t tok = tok0 + tt;
                cnt[lane] = 0;
                for (int L0 = 0; L0 < 16; L0 += 4) {
                    unsigned short ra[4], rb[4]; unsigned ka[4], kb[4], T[4];
#pragma unroll
                    for (int q = 0; q < 4; ++q) {
                        const unsigned short* sr = SC + tok * 2048 + (L0 + q) * 128;
                        ra[q] = sr[lane]; rb[q] = sr[64 + lane];
                        ka[q] = key16(ra[q]); kb[q] = key16(rb[q]); T[q] = 0;
                    }
                    for (int bit = 15; bit >= 0; --bit) {
#pragma unroll
                        for (int q = 0; q < 4; ++q) {
                            const unsigned cand = T[q] | (1u << bit);
                            const int cn = __popcll(__ballot(ka[q] >= cand)) + __popcll(__ballot(kb[q] >= cand));
                            T[q] = (cn >= 16) ? cand : T[q];
                        }
                    }
#pragma unroll
                    for (int q = 0; q < 4; ++q) {
                        const int L = L0 + q;
                        const int cnt_gt = __popcll(__ballot(ka[q] > T[q])) + __popcll(__ballot(kb[q] > T[q]));
                        const int need = 16 - cnt_gt;
                        const unsigned long long ea = __ballot(ka[q] == T[q]), eb = __ballot(kb[q] == T[q]);
                        const int ra_eq = __popcll(ea & lm), rb_eq = __popcll(ea) + __popcll(eb & lm);
                        const bool sa = (ka[q] > T[q]) || (ka[q] == T[q] && ra_eq < need);
                        const bool sb = (kb[q] > T[q]) || (kb[q] == T[q] && rb_eq < need);
                        const unsigned long long ma = __ballot(sa), mb = __ballot(sb);
                        const int pa = __popcll(ma & lm), pb = __popcll(ma) + __popcll(mb & lm);
                        if (sa) { s_top[L * 16 + pa] = (float)__builtin_bit_cast(h16, ra[q]); i_top[L * 16 + pa] = lane; }
                        if (sb) { s_top[L * 16 + pb] = (float)__builtin_bit_cast(h16, rb[q]); i_top[L * 16 + pb] = 64 + lane; }
                    }
                }
                LDS_FENCE();
                for (int h0 = 0; h0 < 8; h0 += 4) {
                    float cv[4][4]; unsigned kk[4][4], T[4];
#pragma unroll
                    for (int q = 0; q < 4; ++q) {
                        const int h = h0 + q;
                        const float bj = s_top[(2 * h + 1) * 16 + li];
#pragma unroll
                        for (int m = 0; m < 4; ++m) { cv[q][m] = s_top[(2 * h) * 16 + grp + 4 * m] + bj; kk[q][m] = key32(__builtin_bit_cast(unsigned, cv[q][m])); }
                        T[q] = 0;
                    }
                    unsigned om = 0, am = 0xFFFFFFFFu;
#pragma unroll
                    for (int q = 0; q < 4; ++q)
#pragma unroll
                        for (int m = 0; m < 4; ++m) { om |= kk[q][m]; am &= kk[q][m]; }
                    om = wave_or(om); am = wave_and(am);
                    om &= ~am;
                    while (om) {
                        const int bit = 31 - __builtin_clz(om);
                        om &= ~(1u << bit);
#pragma unroll
                        for (int q = 0; q < 4; ++q) {
                            const unsigned cand = T[q] | (1u << bit);
                            int cn = 0;
#pragma unroll
                            for (int m = 0; m < 4; ++m) cn += __popcll(__ballot((kk[q][m] & ~am) >= cand));
                            T[q] = (cn >= 16) ? cand : T[q];
                        }
                    }
#pragma unroll
                    for (int q = 0; q < 4; ++q) T[q] |= am;
#pragma unroll
                    for (int q = 0; q < 4; ++q) {
                        const int h = h0 + q;
                        int cnt_gt = 0;
#pragma unroll
                        for (int m = 0; m < 4; ++m) cnt_gt += __popcll(__ballot(kk[q][m] > T[q]));
                        const int need = 16 - cnt_gt;
                        int eq_before = 0, sel_before = 0;
#pragma unroll
                        for (int m = 0; m < 4; ++m) {
                            const unsigned long long em = __ballot(kk[q][m] == T[q]);
                            const int myeq = eq_before + __popcll(em & lm);
                            const bool sel = (kk[q][m] > T[q]) || (kk[q][m] == T[q] && myeq < need);
                            const unsigned long long sm = __ballot(sel);
                            const int pos = sel_before + __popcll(sm & lm);
                            if (sel) {
                                ex[h * 16 + pos] = i_top[(2 * h) * 16 + grp + 4 * m] * 128 + i_top[(2 * h + 1) * 16 + li];
                                sc[h * 16 + pos] = cv[q][m];
                            }
                            eq_before += __popcll(em); sel_before += __popcll(sm);
                        }
                    }
                }
                LDS_FENCE();
#pragma unroll
                for (int half = 0; half < 2; ++half) {
                    const int e = half * 64 + lane;
                    const float v = sc[e];
                    const float mx = row16_allmax(v);
                    const float pe = __expf(v - mx);
                    const float sm = row16_allsum(pe);
                    const float gate = pe * __builtin_amdgcn_rcpf(sm);
                    const int eid = ex[e];
                    const int pos = __hip_atomic_fetch_add(cnt + (eid >> 8), 1, __ATOMIC_RELAXED, __HIP_MEMORY_SCOPE_WORKGROUP);
                    uns_m[e] = eid | (pos << 14); uns_g[e] = gate;
                }
                LDS_FENCE();
                {
                    const int c = cnt[lane];
                    const int incl = wave_incl_scan(c);
                    base[lane] = incl - c;
                    LDS_FENCE();
#pragma unroll
                    for (int i = 0; i < 2; ++i) {
                        const int rm = uns_m[i * 64 + lane]; const float rg = uns_g[i * 64 + lane];
                        const int eid = rm & 16383, pos = rm >> 14;
                        const int dst = tt * 128 + base[eid >> 8] + pos;
                        se[dst] = (unsigned short)eid; sw[dst] = rg;
                    }
                    LDS_FENCE();
                }
            }
          }
          const int round = it5 - lead;
          if (round >= 0 && round < 4) {
            const size_t tok0 = (size_t)tg * 128 + wid * 16 + round * 4;
            LAS unsigned short* se = (LAS unsigned short*)(wl + 4608 + (round & 1) * 3072);
            LAS float* sw = (LAS float*)(wl + 4608 + (round & 1) * 3072 + 1024);
            const size_t tokg = tok0 + grp;
            const LAS unsigned short* me = se + grp * 128; LAS float* mw = sw + grp * 128;
            {
                const int li = launder(tid) & 15;
                h16x8 xr[2][4];
#pragma unroll
                for (int c = 0; c < 2; ++c)
#pragma unroll
                    for (int j = 0; j < 4; ++j) xr[c][j] = *(const h16x8*)(H2 + tokg * 1024 + c * 512 + li * 32 + 8 * j);
                float acc[64];
#pragma unroll
                for (int i = 0; i < 64; ++i) acc[i] = 0.f;
                i32x4 ru[2][2], rv[2][4]; float su[2], sv[2];
#define ELD(J, S_) do { const int e_ = me[(S_)]; const unsigned char* rp_ = U4 + (size_t)e_ * 1536 + li * 16; \
        ru[J][0] = *(const i32x4*)rp_; ru[J][1] = *(const i32x4*)(rp_ + 256); \
        _Pragma("unroll") for (int c = 0; c < 4; ++c) rv[J][c] = *(const i32x4*)(rp_ + 512 + c * 256); \
        { const f32x2 s2_ = *(const f32x2*)(USC + 2 * e_); su[J] = s2_.x; sv[J] = s2_.y; } } while (0)
#define ECP(J, S_) do { float d = 0.f; \
        _Pragma("unroll") for (int c = 0; c < 2; ++c) _Pragma("unroll") for (int k = 0; k < 4; ++k) { const h16x8 xv = xr[c][k]; const int w_ = ru[J][c][k]; \
            d = __builtin_amdgcn_fdot2(__builtin_amdgcn_cvt_scalef32_pk_f16_fp4(w_, 1.0f, 0), (h16x2){xv[0], xv[1]}, d, false); \
            d = __builtin_amdgcn_fdot2(__builtin_amdgcn_cvt_scalef32_pk_f16_fp4(w_, 1.0f, 1), (h16x2){xv[2], xv[3]}, d, false); \
            d = __builtin_amdgcn_fdot2(__builtin_amdgcn_cvt_scalef32_pk_f16_fp4(w_, 1.0f, 2), (h16x2){xv[4], xv[5]}, d, false); \
            d = __builtin_amdgcn_fdot2(__builtin_amdgcn_cvt_scalef32_pk_f16_fp4(w_, 1.0f, 3), (h16x2){xv[6], xv[7]}, d, false); } \
        d = row16_allsum(d); \
        const float wt_ = mw[(S_)] * gelu_tanh(d * su[J]) * sv[J]; \
        _Pragma("unroll") for (int c = 0; c < 4; ++c) _Pragma("unroll") for (int k = 0; k < 4; ++k) { \
            const f32x2 lo = __builtin_amdgcn_cvt_pk_f32_fp8(rv[J][c][k], false), hi = __builtin_amdgcn_cvt_pk_f32_fp8(rv[J][c][k], true); \
            acc[c * 16 + 4 * k] += wt_ * lo.x; acc[c * 16 + 4 * k + 1] += wt_ * lo.y; acc[c * 16 + 4 * k + 2] += wt_ * hi.x; acc[c * 16 + 4 * k + 3] += wt_ * hi.y; } } while (0)
                ELD(0, 0); ELD(1, 1);
#pragma unroll 1
                for (int s = 0; s < 128; s += 2) {
                    ECP(0, s);     if (s + 2 < 128) ELD(0, s + 2);
                    ECP(1, s + 1); if (s + 3 < 128) ELD(1, s + 3);
                }
#undef ELD
#undef ECP
                float* xo = p.out + tokg * 1024 + li * 16;
                const int b = (int)(tokg >> 11);
                const float* g2 = mod + (size_t)b * 6144 + 5 * 1024 + li * 16;
                const float* fg = p.in[I_FG] + li * 16;
                float ss = 0.f;
#pragma unroll
                for (int c = 0; c < 4; ++c) {
#pragma unroll
                    for (int q4 = 0; q4 < 4; ++q4) {
                        const f32x4 xv = *(const f32x4*)(xo + c * 256 + q4 * 4), gv = *(const f32x4*)(g2 + c * 256 + q4 * 4);
#pragma unroll
                        for (int j = 0; j < 4; ++j) { const float t = xv[j] + gv[j] * acc[c * 16 + q4 * 4 + j]; acc[c * 16 + q4 * 4 + j] = t; ss += t * t; }
                    }
                    asm volatile("" : "+v"(ss) :: "memory");
                }
                ss = row16_allsum(ss);
                const float r = rsqrtf(ss * (1.0f / 1024.0f) + 1e-6f);
#pragma unroll
                for (int c = 0; c < 4; ++c) {
#pragma unroll
                    for (int q4 = 0; q4 < 4; ++q4) {
                        const f32x4 fv = *(const f32x4*)(fg + c * 256 + q4 * 4);
                        f32x4 ov;
#pragma unroll
                        for (int j = 0; j < 4; ++j) ov[j] = acc[c * 16 + q4 * 4 + j] * r * fv[j];
                        *(f32x4*)(xo + c * 256 + q4 * 4) = ov;
                    }
                    asm volatile("" ::: "memory");
                }
            }
            LDS_FENCE();
          }
        }
    }
}

__global__ void __launch_bounds__(512, 2) mega(Params p) {
    extern __shared__ __attribute__((aligned(16))) unsigned char shm[];
    LAS unsigned char* lds = (LAS unsigned char*)shm;
    cg::grid_group grid = cg::this_grid();
    unsigned char* ws = p.ws;
    const int G = (int)gridDim.x, c = (int)blockIdx.x;
    unsigned* bar = (unsigned*)(ws + OFF_BAR); unsigned epoch = 0;
    volatile LAS unsigned* xst = (volatile LAS unsigned*)(lds + (LDS_BYTES - 16));
    if (threadIdx.x < 2) xst[threadIdx.x] = 0u;
    __syncthreads();
    const XcdBarrier xb = xcd_barrier_post(bar, xst);

    if (p.ws == nullptr) grid.sync();
    phase0(p, (float*)shm);
    xcd_barrier(xb);
    phase1(p, (float*)shm);
    xcd_barrier(xb);
    {
        pg8::StaticOrder S; S.init(NTOK, INC, G, c);
        pg8::Gemm g{ws + OFF_R1, ws + OFF_WINT, 1024, 1024, NTOK, INC, 1024, 0};
        EpiIn E{(h16*)(ws + OFF_QB), (h16*)(ws + OFF_KB), (h16*)(ws + OFF_VT), (h16*)(ws + OFF_GUV), (h16*)(ws + OFF_GATES)};
        pg8::gemm_phase(lds, g, S, E);
        pg8::StaticOrder S2; S2.init(NCTXT, 1024, G, c);
        pg8::Gemm g2{ws + OFF_HC, ws + OFF_WINT + (size_t)512 * 1024 * 2, 1024, 1024, NCTXT, 1024, 1024, 0};
        EpiCtx E2{(h16*)(ws + OFF_KC), (h16*)(ws + OFF_VCT)};
        pg8::gemm_phase(lds, g2, S2, E2);
    }
    xcd_barrier(xb);
    {
        for (int rep3 = 0; rep3 < REP_P3; ++rep3) {
        for (int u = c; u < 512; u += G) attn_unit(p, u);
        for (int n = c; n < 256; n += G) sgu_unit(p, n, lds);
        }
    }
    xcd_barrier(xb);
    {
        pg8::StaticOrder S; S.init(NTOK, 1024, G, c);
        pg8::Gemm ga{ws + OFF_R1, ws + OFF_WPAT, 1024, 512, NTOK, 1024, 512, 0};
        EpiM1 E1{(h16*)(ws + OFF_M1), (const h16*)(ws + OFF_GATES)};
        pg8::gemm_phase(lds, ga, S, E1);
        pg8::Gemm gb{ws + OFF_R1 + 1024, ws + OFF_WPBT, 1024, 512, NTOK, 1024, 512, 0};
        EpiM2 E2{(const h16*)(ws + OFF_M1), (const h16*)(ws + OFF_GATES), (h16*)(ws + OFF_MM)};
        pg8::gemm_phase(lds, gb, S, E2);
    }
    xcd_barrier(xb);
    {
        pg8::StaticOrder S; S.init(NTOK, 1024, G, c);
        pg8::Gemm g{ws + OFF_MM, ws + OFF_WOUTT, 1024, 1024, NTOK, 1024, 1024, 0};
        EpiX1 E{p.in[I_X], (const float*)(ws + OFF_MOD), p.out};
        pg8::gemm_phase(lds, g, S, E);
    }
    xcd_barrier(xb);
    phase6(p, (float*)shm);
    xcd_barrier(xb);
    {
        pg8::StaticOrder S; S.init(NTOK, 2048, G, c);
        pg8::Gemm g{ws + OFF_R1, ws + OFF_WQT, 1024, 1024, NTOK, 2048, 1024, 0};
        EpiH16 E{(h16*)(ws + OFF_SC16), 2048};
        pg8::gemm_phase(lds, g, S, E);
    }
    xcd_barrier(xb);
    peer_phase(p, lds, bar, epoch);
}

extern "C" void kernel_launch(void* const* d_in, const int* in_sizes, int n_in, void* d_out, int out_size, void* d_ws, size_t ws_size, hipStream_t stream) {
    static int grid_blocks = 0;
    if (!grid_blocks) {
        int dev = 0, cus = 0, per_cu = 0;
        hipGetDevice(&dev);
        hipDeviceGetAttribute(&cus, hipDeviceAttributeMultiprocessorCount, dev);
        hipFuncSetAttribute((const void*)mega, hipFuncAttributeMaxDynamicSharedMemorySize, LDS_BYTES);
        hipOccupancyMaxActiveBlocksPerMultiprocessor(&per_cu, (const void*)mega, 512, LDS_BYTES);
        if (per_cu < 1) per_cu = 1;
        grid_blocks = cus * per_cu;
        if (ws_size < WS_END) fprintf(stderr, "kernel_launch: workspace too small: %zu < %zu\n", ws_size, (size_t)WS_END);
    }
    hipMemsetAsync((unsigned char*)d_ws + OFF_BAR, 0, 16384, stream);
    Params p{};
    for (int i = 0; i < 21; ++i) p.in[i] = (const float*)d_in[i];
    p.out = (float*)d_out; p.ws = (unsigned char*)d_ws;
    void* args[] = {&p};
    hipError_t e = hipLaunchCooperativeKernel((const void*)mega, dim3(grid_blocks), dim3(512), args, LDS_BYTES, stream);
    if (e != hipSuccess) fprintf(stderr, "cooperative launch failed: %s (grid %d)\n", hipGetErrorString(e), grid_blocks);
}
```

```cpp
#include <hip/hip_runtime.h>
#include <hip/hip_cooperative_groups.h>
#include <cstdio>
namespace cg = cooperative_groups;

#define LAS __attribute__((address_space(3)))
typedef _Float16 h16;
typedef _Float16 h16x2 __attribute__((ext_vector_type(2)));
typedef _Float16 h16x4 __attribute__((ext_vector_type(4)));
typedef _Float16 h16x8 __attribute__((ext_vector_type(8)));
typedef float f32x4 __attribute__((ext_vector_type(4)));
typedef float f32x2 __attribute__((ext_vector_type(2)));
typedef int i32x4 __attribute__((ext_vector_type(4)));
typedef int i32x2 __attribute__((ext_vector_type(2)));

constexpr int NTOK = 32768, DM = 1024, NCTXT = 4096, INC = 4608, SEQ = 2048, CTXL = 256;
constexpr int LDS_BYTES = 144 * 1024;
#ifndef REP_SEL
#define REP_SEL 1
#endif
#ifndef REP_GATH
#define REP_GATH 1
#endif
#ifndef REP_P3
#define REP_P3 1
#endif

constexpr size_t al256(size_t x) { return (x + 255) & ~(size_t)255; }
constexpr size_t OFF_WINT = 0;
constexpr size_t OFF_WPAT = OFF_WINT + (size_t)INC * DM * 2;
constexpr size_t OFF_WPBT = OFF_WPAT + (size_t)1024 * 512 * 2;
constexpr size_t OFF_WOUTT = OFF_WPBT + (size_t)1024 * 512 * 2;
constexpr size_t OFF_WQT = OFF_WOUTT + (size_t)1024 * 1024 * 2;
constexpr size_t OFF_BD = OFF_WQT + (size_t)2048 * 1024 * 2;
constexpr size_t OFF_U16 = OFF_BD + (size_t)2048 * 256 * 2;
constexpr size_t OFF_V16 = OFF_U16 + (size_t)16384 * 1024 * 2;
constexpr size_t OFF_WS16 = OFF_V16 + (size_t)16384 * 1024 * 2;
constexpr size_t OFF_MODP = OFF_WS16 + (size_t)8 * 128 * 128 * 2;
constexpr size_t OFF_MOD = OFF_MODP + (size_t)16 * 17 * 6144 * 4;
constexpr size_t OFF_R1 = al256(OFF_MOD + (size_t)17 * 6144 * 4);
constexpr size_t OFF_QB = OFF_R1 + (size_t)NTOK * DM * 2;
constexpr size_t OFF_KB = OFF_QB + (size_t)NTOK * 512 * 2;
constexpr size_t OFF_VT = OFF_KB + (size_t)NTOK * 512 * 2;
constexpr size_t OFF_GUV = OFF_VT + (size_t)NTOK * 512 * 2;
constexpr size_t OFF_GATES = OFF_GUV + (size_t)NTOK * 1024 * 2;
constexpr size_t OFF_MM = OFF_GATES + (size_t)NTOK * 2048 * 2;
constexpr size_t OFF_BAR = OFF_MM + (size_t)NTOK * DM * 2;
constexpr size_t WS_END = OFF_BAR + 16384;
constexpr size_t OFF_U8 = OFF_U16;
constexpr size_t OFF_USC = OFF_V16;
constexpr size_t OFF_V8 = OFF_V16;
constexpr size_t OFF_VSC = OFF_V16 + (size_t)16384 * 1024;
constexpr size_t OFF_M1 = OFF_QB;
constexpr size_t OFF_SC16 = OFF_QB;
constexpr size_t OFF_Q16 = OFF_GATES;
constexpr size_t OFF_X1H = OFF_GATES;
constexpr size_t OFF_HC = OFF_MM;
constexpr size_t OFF_KC = OFF_HC + (size_t)NCTXT * DM * 2;
constexpr size_t OFF_VCT = OFF_KC + (size_t)NCTXT * 512 * 2;
static_assert(OFF_M1 + (size_t)NTOK * DM * 4 <= OFF_GATES, "m1 alias");
static_assert(WS_END <= (size_t)512 * 1024 * 1024, "workspace");

struct Params {
    const float* in[21];
    float* out;
    unsigned char* ws;
};
enum { I_X = 0, I_C, I_CTX, I_CCTX, I_ADAW, I_ADAB, I_N1G, I_N2G, I_WIN, I_RPB, I_LNG, I_GMWS, I_GMBS, I_WPA, I_WPB, I_WOUT, I_WQ, I_KEYS, I_PU, I_PV, I_FG };

__device__ __forceinline__ int launder(int x) { asm volatile("" : "+v"(x)); return x; }
__device__ __forceinline__ int fresh_tid() { int t = threadIdx.x; asm volatile("" : "+v"(t)); return t; }

__device__ __forceinline__ float sigmoidf_(float x) { return __builtin_amdgcn_rcpf(1.0f + __expf(-x)); }
__device__ __forceinline__ float gelu_tanh(float x) {
    const float t = 0.7978845608028654f * (x + 0.044715f * x * x * x);
    return x * __builtin_amdgcn_rcpf(1.0f + __expf(-2.0f * t));
}
__device__ __forceinline__ float silu_(float x) { return x * __builtin_amdgcn_rcpf(1.0f + __expf(-x)); }
__device__ __forceinline__ float wave_sum(float v) {
#pragma unroll
    for (int o = 32; o > 0; o >>= 1) v += __shfl_xor(v, o);
    return v;
}
__device__ __forceinline__ h16x8 pack8(f32x4 a, f32x4 b) {
    h16x8 o;
    o[0] = (h16)a[0]; o[1] = (h16)a[1]; o[2] = (h16)a[2]; o[3] = (h16)a[3];
    o[4] = (h16)b[0]; o[5] = (h16)b[1]; o[6] = (h16)b[2]; o[7] = (h16)b[3];
    return o;
}


__device__ __forceinline__ void grid_bar(unsigned* ctr, unsigned& epoch, unsigned nblk) {
    __syncthreads();
    epoch += 1u;
    if (threadIdx.x == 0) {
        __builtin_amdgcn_fence(__ATOMIC_RELEASE, "agent");
        asm volatile("s_waitcnt vmcnt(0)" ::: "memory");
        __hip_atomic_fetch_add(ctr, 1u, __ATOMIC_RELAXED, __HIP_MEMORY_SCOPE_AGENT);
        const unsigned target = epoch * nblk;
        unsigned spins = 0;
        while (__hip_atomic_load(ctr, __ATOMIC_RELAXED, __HIP_MEMORY_SCOPE_AGENT) < target) { __builtin_amdgcn_s_sleep(2); if (++spins > (1u << 24)) break; }
        __builtin_amdgcn_fence(__ATOMIC_ACQUIRE, "agent");
        asm volatile("s_waitcnt vmcnt(0)" ::: "memory");
    }
    __syncthreads();
}


#define XB_TMO      128
#define XB_XCNT(j)  (256  + 64 * (j))
#define XB_XSUB(j)  (1280 + 64 * (j))
#define XB_XGEN(j)  (2304 + 64 * (j))
#define XB_TOP      3328
#define XB_TOPGEN   3392
#define XCD_BAR_WORDS 3456
#define XB_SPIN_CAP (1u << 20)
__device__ __forceinline__ unsigned xb_ld(unsigned* p)              { return __hip_atomic_load(p, __ATOMIC_RELAXED, __HIP_MEMORY_SCOPE_AGENT); }
__device__ __forceinline__ unsigned xb_add(unsigned* p, unsigned v) { return __hip_atomic_fetch_add(p, v, __ATOMIC_RELAXED, __HIP_MEMORY_SCOPE_AGENT); }
__device__ __forceinline__ unsigned xb_xcc_id() { return (unsigned)__builtin_amdgcn_s_getreg((3 << 11) | 20) & 0xFu; }
#define XB_SPIN(cond, bar) do { unsigned _sp = 0; while (cond) { __builtin_amdgcn_s_sleep(1); \
    if ((++_sp & 255u) == 0u) { if (xb_ld(&(bar)[XB_TMO])) break; if (_sp > XB_SPIN_CAP) { atomicAdd(&(bar)[XB_TMO], 1u); break; } } } } while (0)
struct XcdBarrier { unsigned* bar; unsigned x; volatile LAS unsigned* st; };
__device__ __forceinline__ XcdBarrier xcd_barrier_post(unsigned* bar, volatile LAS unsigned* st) {
    XcdBarrier b; b.bar = bar; b.x = xb_xcc_id(); b.st = st;
    if (threadIdx.x == 0) (void)xb_add(&bar[XB_XCNT(b.x)], 1u);
    return b;
}
__device__ __forceinline__ void xcd_barrier_complete(unsigned* bar, unsigned x, unsigned& nloc, unsigned& nx) {
    const unsigned G = gridDim.x * gridDim.y * gridDim.z;
    unsigned sum, cnt, mine, sp = 0u;
    for (;;) {
        sum = 0u; cnt = 0u; mine = 0u;
#pragma unroll
        for (unsigned j = 0; j < 16; ++j) { const unsigned c = xb_ld(&bar[XB_XCNT(j)]); sum += c; cnt += (c > 0u) ? 1u : 0u; mine = (j == x) ? c : mine; }
        if (sum == G) break;
        __builtin_amdgcn_s_sleep(1);
        if ((++sp & 255u) == 0u) { if (xb_ld(&bar[XB_TMO])) break; if (sp > XB_SPIN_CAP) { atomicAdd(&bar[XB_TMO], 1u); break; } }
    }
    nloc = mine > 0u ? mine : 1u; nx = cnt > 0u ? cnt : 1u;
}
__device__ __forceinline__ void xcd_barrier(const XcdBarrier& b) {
    asm volatile("s_waitcnt vmcnt(0)" ::: "memory");
    __syncthreads();
    if (threadIdx.x == 0) {
        unsigned* bar = b.bar;
        __builtin_amdgcn_s_waitcnt(0);
        unsigned nloc = b.st[0], nx = b.st[1];
        if (nloc == 0u) { xcd_barrier_complete(bar, b.x, nloc, nx); b.st[0] = nloc; b.st[1] = nx; }
        const unsigned old = xb_add(&bar[XB_XSUB(b.x)], 1u);
        const unsigned gen = old / nloc;
        if (old + 1u == (gen + 1u) * nloc) {
            __builtin_amdgcn_fence(__ATOMIC_RELEASE, "agent");
            asm volatile("s_waitcnt vmcnt(0)" ::: "memory");
            const unsigned og = xb_add(&bar[XB_TOP], 1u);
            const unsigned tg = og / nx;
            if (og + 1u == (tg + 1u) * nx) xb_add(&bar[XB_TOPGEN], 1u);
            else XB_SPIN(xb_ld(&bar[XB_TOPGEN]) == tg, bar);
            __builtin_amdgcn_fence(__ATOMIC_ACQUIRE, "agent");
            xb_add(&bar[XB_XGEN(b.x)], 1u);
            asm volatile("s_waitcnt vmcnt(0)" ::: "memory");
        } else {
            XB_SPIN(xb_ld(&bar[XB_XGEN(b.x)]) == gen, bar);
            __builtin_amdgcn_fence(__ATOMIC_ACQUIRE, "agent");
            asm volatile("s_waitcnt vmcnt(0)" ::: "memory");
        }
    }
    __syncthreads();
}

namespace pg8 {
constexpr int BM = 256, BK = 64, HALF = 128, HTB = HALF * BK * 2, STAGE_BYTES = 8 * HTB, NXCD = 8, WGM = 8;
__device__ __forceinline__ int lds_byte(int r, int c) { const int st = (r >> 4) * 2 + (c >> 5), rr = r & 15, cc = c & 31, ob = rr * 64 + cc * 2; return st * 1024 + (ob ^ (((ob >> 9) & 1) << 5)); }
__device__ __forceinline__ void stage_rc(int b, int& R, int& C) { const int st = b / 1024, sb = b % 1024, swz = sb ^ (((sb >> 9) & 1) << 5); R = (st >> 1) * 16 + swz / 64; C = (st & 1) * 32 + (swz % 64) / 2; }
__device__ __forceinline__ int perm32(int rho) { const int n = rho >> 4, i = rho & 15; return 8 * (i >> 2) + 4 * n + (i & 3); }

struct Unit { int pm, pn; };
struct Gemm { const void* A; const void* Bt; int lda, ldb, M, N, K, a_pn_bytes; };

struct StaticOrder {
    int nM, nN, nwg, G, c;
    __device__ void init(int M, int N, int G_, int c_) { nM = M / BM; nN = N / BM; nwg = nM * nN; G = G_; c = c_; }
    __device__ bool next(int i, Unit& u) const {
        const long L = (long)i * G + c; if (L >= nwg) return false;
        int wgid = (int)L; { const int q = nwg / NXCD, r = nwg % NXCD, xcd = wgid % NXCD, off = wgid / NXCD; wgid = (xcd < r ? xcd * (q + 1) : r * (q + 1) + (xcd - r) * q) + off; }
        const int nig = WGM * nN, gid = wgid / nig, fm = gid * WGM, gsz = (nM - fm) < WGM ? (nM - fm) : WGM;
        u.pm = fm + ((wgid % nig) % gsz); u.pn = (wgid % nig) / gsz; return true;
    }
};

template <class Epi>
__device__ __forceinline__ void gemm_phase(LAS unsigned char* lds, const Gemm g, const StaticOrder& S, const Epi& E) {
    const int tid = fresh_tid(), wid = __builtin_amdgcn_readfirstlane(tid >> 6), lane = tid & 63, wr = wid >> 2, wc = wid & 3, fr = lane & 15, fq = lane >> 4;
    const int K = g.K, nt = K / BK;
    unsigned voffA[2], voffB[2];
#pragma unroll
    for (int i = 0; i < 2; ++i) { int R, C; stage_rc(tid * 16 + i * 8192, R, C); const int Rb = (R & ~31) + perm32(R & 31);
        voffA[i] = (unsigned)(R * g.lda + C) * 2u; voffB[i] = (unsigned)(Rb * g.ldb + C) * 2u; }
    const size_t kstep = (size_t)(BK * 2);
    const size_t hstepA = (size_t)HALF * g.lda * 2, hstepB = (size_t)HALF * g.ldb * 2;
    const size_t tstepA = 2 * hstepA, tstepB = 2 * hstepB;
    const unsigned ldsw = (unsigned)wid * 1024u;
    const int aoff = lds_byte(wr * 64 + fr, fq * 8), boff = lds_byte(wc * 32 + fr, fq * 8);
#define PG8_SA(b, h) (((b) * 2 + (h)) * HTB)
#define PG8_SB(b, h) ((4 + (b) * 2 + (h)) * HTB)
#define PG8_STAGE(bufoff, gbase, voff) do { _Pragma("unroll") for (int _i = 0; _i < 2; ++_i) \
        __builtin_amdgcn_global_load_lds((const unsigned*)((const char*)(gbase) + (voff)[_i]), (LAS unsigned*)(lds + (bufoff) + ldsw + _i * 8192), 16, 0, 0); } while (0)
#define PG8_LDA(dst, b, h) do { _Pragma("unroll") for (int m = 0; m < 4; ++m) _Pragma("unroll") for (int k = 0; k < 2; ++k) dst[m][k] = *(const LAS h16x8*)(lds + PG8_SA(b, h) + aoff + m * 2048 + k * 1024); } while (0)
#define PG8_LDB(dst, b, h) do { _Pragma("unroll") for (int n = 0; n < 2; ++n) _Pragma("unroll") for (int k = 0; k < 2; ++k) dst[n][k] = *(const LAS h16x8*)(lds + PG8_SB(b, h) + boff + n * 2048 + k * 1024); } while (0)
#define PG8_MMA(ai, bj, At, Bt) do { __builtin_amdgcn_s_setprio(1); _Pragma("unroll") for (int m = 0; m < 4; ++m) _Pragma("unroll") for (int n = 0; n < 2; ++n) _Pragma("unroll") for (int k = 0; k < 2; ++k) \
        acc[ai][bj][m][n] = __builtin_amdgcn_mfma_f32_16x16x32_f16(Bt[n][k], At[m][k], acc[ai][bj][m][n], 0, 0, 0); __builtin_amdgcn_s_setprio(0); } while (0)
#define PG8_WAIT_V(n) asm volatile("s_waitcnt vmcnt(" #n ")" ::: "memory")
#define PG8_WAIT_L(n) asm volatile("s_waitcnt lgkmcnt(" #n ")" ::: "memory")
#define PG8_BAR __builtin_amdgcn_s_barrier()
#define PG8_SCHED __builtin_amdgcn_sched_barrier(0)
    Unit cur, nxt; int ui = 0;
    if (!S.next(0, cur)) return;
    f32x4 acc[2][2][4][2];
#pragma unroll
    for (int a = 0; a < 2; ++a)
#pragma unroll
        for (int b = 0; b < 2; ++b)
#pragma unroll
            for (int m = 0; m < 4; ++m)
#pragma unroll
                for (int n = 0; n < 2; ++n) acc[a][b][m][n] = (f32x4){0.f, 0.f, 0.f, 0.f};
    h16x8 At[4][2], B0[2][2], B1[2][2];
    const char* cA = (const char*)g.A + (size_t)cur.pm * tstepA + (size_t)cur.pn * g.a_pn_bytes; const char* cB = (const char*)g.Bt + (size_t)cur.pn * tstepB;
    PG8_STAGE(PG8_SB(0, 0), cB, voffB); PG8_STAGE(PG8_SA(0, 0), cA, voffA); PG8_STAGE(PG8_SB(0, 1), cB + hstepB, voffB); PG8_STAGE(PG8_SA(0, 1), cA + hstepA, voffA);
    if (wr == 1) PG8_BAR;
    PG8_WAIT_V(4); PG8_BAR;
    PG8_STAGE(PG8_SB(1, 0), cB + kstep, voffB); PG8_STAGE(PG8_SA(1, 0), cA + kstep, voffA); PG8_STAGE(PG8_SB(1, 1), cB + hstepB + kstep, voffB);
    PG8_WAIT_V(6); PG8_BAR;
    for (;;) {
        const bool has_next = S.next(ui + 1, nxt);
        const char* nA = has_next ? (const char*)g.A + (size_t)nxt.pm * tstepA + (size_t)nxt.pn * g.a_pn_bytes : cA; const char* nB = has_next ? (const char*)g.Bt + (size_t)nxt.pn * tstepB : cB;
        for (int t = 0; t < nt; t += 2) {
            const bool last = (t == nt - 2);
            const char* a1 = cA + (size_t)(t + 1) * kstep;
            const char* a2 = last ? nA : cA + (size_t)(t + 2) * kstep; const char* b2 = last ? nB : cB + (size_t)(t + 2) * kstep;
            const char* a3 = a2 + kstep; const char* b3 = b2 + kstep;
            PG8_LDB(B0, 0, 0); PG8_SCHED; PG8_LDA(At, 0, 0); PG8_STAGE(PG8_SA(1, 1), a1 + hstepA, voffA);
            PG8_WAIT_L(8); PG8_BAR; PG8_WAIT_L(0); PG8_MMA(0, 0, At, B0); PG8_BAR; PG8_SCHED;
            PG8_LDB(B1, 0, 1); PG8_STAGE(PG8_SB(0, 0), b2, voffB);
            PG8_BAR; PG8_WAIT_L(0); PG8_MMA(0, 1, At, B1); PG8_BAR;
            PG8_LDA(At, 0, 1); PG8_STAGE(PG8_SA(0, 0), a2, voffA);
            PG8_BAR; PG8_WAIT_L(0); PG8_MMA(1, 0, At, B0); PG8_BAR; PG8_SCHED;
            PG8_STAGE(PG8_SB(0, 1), b2 + hstepB, voffB);
            PG8_WAIT_V(6); PG8_BAR; PG8_MMA(1, 1, At, B1); PG8_BAR;
            PG8_LDB(B0, 1, 0); PG8_SCHED; PG8_LDA(At, 1, 0); PG8_STAGE(PG8_SA(0, 1), a2 + hstepA, voffA);
            PG8_WAIT_L(8); PG8_BAR; PG8_WAIT_L(0); PG8_MMA(0, 0, At, B0); PG8_BAR; PG8_SCHED;
            PG8_LDB(B1, 1, 1); PG8_STAGE(PG8_SB(1, 0), b3, voffB);
            PG8_BAR; PG8_WAIT_L(0); PG8_MMA(0, 1, At, B1); PG8_BAR;
            PG8_LDA(At, 1, 1); PG8_STAGE(PG8_SA(1, 0), a3, voffA);
            PG8_BAR; PG8_WAIT_L(0); PG8_MMA(1, 0, At, B0); PG8_BAR; PG8_SCHED;
            PG8_STAGE(PG8_SB(1, 1), b3 + hstepB, voffB);
            PG8_WAIT_V(6); PG8_BAR; PG8_MMA(1, 1, At, B1); PG8_BAR;
        }
        E(acc, cur, wr, wc, fr, fq);
        if (!has_next) break;
#pragma unroll
        for (int a = 0; a < 2; ++a)
#pragma unroll
            for (int b = 0; b < 2; ++b)
#pragma unroll
                for (int m = 0; m < 4; ++m)
#pragma unroll
                    for (int n = 0; n < 2; ++n) acc[a][b][m][n] = (f32x4){0.f, 0.f, 0.f, 0.f};
        cur = nxt; cA = nA; cB = nB; ++ui;
    }
    PG8_WAIT_V(0);
    if (wr == 0) PG8_BAR;
    PG8_BAR;
#undef PG8_SA
#undef PG8_SB
#undef PG8_STAGE
#undef PG8_LDA
#undef PG8_LDB
#undef PG8_MMA
#undef PG8_WAIT_V
#undef PG8_WAIT_L
#undef PG8_BAR
#undef PG8_SCHED
}
}
typedef f32x4 AccT[2][2][4][2];

struct EpiIn {
    h16 *qb, *kb, *vt, *guv, *gates;
    __device__ __forceinline__ void operator()(const AccT& acc, const pg8::Unit& u, int wr, int wc, int fr, int fq) const {
        const int pn = u.pn;
        const int row0 = u.pm * 256 + wr * 64 + fr;
        const int cin = wc * 32 + 8 * fq;
        const int b = (u.pm * 256) >> 11, sb = ((u.pm * 256) & 2047) + wr * 64;
        if (pn < 2) {
            h16* base = qb + (size_t)row0 * 512 + pn * 256 + cin;
#pragma unroll
            for (int ai = 0; ai < 2; ++ai)
#pragma unroll
                for (int m = 0; m < 4; ++m)
#pragma unroll
                    for (int bj = 0; bj < 2; ++bj) *(h16x8*)(base + (ai * 128 + m * 16) * 512 + bj * 128) = pack8(acc[ai][bj][m][0], acc[ai][bj][m][1]);
        } else if (pn < 4) {
#pragma unroll
            for (int bj = 0; bj < 2; ++bj) {
                const int col = (pn & 1) * 256 + bj * 128 + cin, hd = col >> 6, d0 = col & 63;
                h16* base = kb + ((size_t)(b * 8 + hd) * 2048 + sb + fr) * 64 + d0;
#pragma unroll
                for (int ai = 0; ai < 2; ++ai)
#pragma unroll
                    for (int m = 0; m < 4; ++m) *(h16x8*)(base + (ai * 128 + m * 16) * 64) = pack8(acc[ai][bj][m][0], acc[ai][bj][m][1]);
            }
        } else if (pn < 6) {
#pragma unroll
            for (int bj = 0; bj < 2; ++bj) {
                const int cv = (pn - 4) * 256 + bj * 128 + cin, hd = cv >> 6, d0 = cv & 63;
                h16* base = vt + ((size_t)(b * 8 + hd) * 256 + (sb >> 3) + (fr >> 3)) * 512 + d0 * 8 + (fr & 7);
#pragma unroll
                for (int ai = 0; ai < 2; ++ai)
#pragma unroll
                    for (int m = 0; m < 4; ++m) {
                        h16* vp = base + (ai * 16 + m * 2) * 512;
                        const f32x4 v0 = acc[ai][bj][m][0], v1 = acc[ai][bj][m][1];
#pragma unroll
                        for (int i = 0; i < 4; ++i) { vp[i * 8] = (h16)v0[i]; vp[(i + 4) * 8] = (h16)v1[i]; }
                    }
            }
        } else if (pn < 10) {
            h16* base = guv + (size_t)row0 * 1024 + (pn - 6) * 256 + cin;
#pragma unroll
            for (int ai = 0; ai < 2; ++ai)
#pragma unroll
                for (int m = 0; m < 4; ++m)
#pragma unroll
                    for (int bj = 0; bj < 2; ++bj) {
                        f32x4 v0 = acc[ai][bj][m][0], v1 = acc[ai][bj][m][1];
#pragma unroll
                        for (int i = 0; i < 4; ++i) { v0[i] = gelu_tanh(v0[i]); v1[i] = gelu_tanh(v1[i]); }
                        *(h16x8*)(base + (ai * 128 + m * 16) * 1024 + bj * 128) = pack8(v0, v1);
                    }
        } else {
            h16* base = gates + (size_t)row0 * 2048 + (pn - 10) * 256 + cin;
#pragma unroll
            for (int ai = 0; ai < 2; ++ai)
#pragma unroll
                for (int m = 0; m < 4; ++m)
#pragma unroll
                    for (int bj = 0; bj < 2; ++bj) {
                        f32x4 v0 = acc[ai][bj][m][0], v1 = acc[ai][bj][m][1];
#pragma unroll
                        for (int i = 0; i < 4; ++i) { v0[i] = sigmoidf_(v0[i]); v1[i] = sigmoidf_(v1[i]); }
                        *(h16x8*)(base + (ai * 128 + m * 16) * 2048 + bj * 128) = pack8(v0, v1);
                    }
        }
    }
};
struct EpiCtx {
    h16 *kc, *vct;
    __device__ __forceinline__ void operator()(const AccT& acc, const pg8::Unit& u, int wr, int wc, int fr, int fq) const {
        const int pn = u.pn;
        const int cin = wc * 32 + 8 * fq;
        const int b = u.pm, sb = wr * 64;
        if (pn < 2) {
#pragma unroll
            for (int bj = 0; bj < 2; ++bj) {
                const int col = pn * 256 + bj * 128 + cin, hd = col >> 6, d0 = col & 63;
                h16* base = kc + ((size_t)(b * 8 + hd) * 256 + sb + fr) * 64 + d0;
#pragma unroll
                for (int ai = 0; ai < 2; ++ai)
#pragma unroll
                    for (int m = 0; m < 4; ++m) *(h16x8*)(base + (ai * 128 + m * 16) * 64) = pack8(acc[ai][bj][m][0], acc[ai][bj][m][1]);
            }
        } else {
#pragma unroll
            for (int bj = 0; bj < 2; ++bj) {
                const int cv = (pn - 2) * 256 + bj * 128 + cin, hd = cv >> 6, d0 = cv & 63;
                h16* base = vct + ((size_t)(b * 8 + hd) * 32 + (sb >> 3) + (fr >> 3)) * 512 + d0 * 8 + (fr & 7);
#pragma unroll
                for (int ai = 0; ai < 2; ++ai)
#pragma unroll
                    for (int m = 0; m < 4; ++m) {
                        h16* vp = base + (ai * 16 + m * 2) * 512;
                        const f32x4 v0 = acc[ai][bj][m][0], v1 = acc[ai][bj][m][1];
#pragma unroll
                        for (int i = 0; i < 4; ++i) { vp[i * 8] = (h16)v0[i]; vp[(i + 4) * 8] = (h16)v1[i]; }
                    }
            }
        }
    }
};
struct EpiM1 {
    h16* m1; const h16* gates;
    __device__ __forceinline__ void operator()(const AccT& acc, const pg8::Unit& u, int wr, int wc, int fr, int fq) const {
        const int row0 = u.pm * 256 + wr * 64 + fr, col0 = u.pn * 256 + wc * 32 + 8 * fq;
#pragma unroll
        for (int ai = 0; ai < 2; ++ai)
#pragma unroll
            for (int m = 0; m < 4; ++m) {
                const int row = row0 + ai * 128 + m * 16;
#pragma unroll
                for (int bj = 0; bj < 2; ++bj) {
                    const int col = col0 + bj * 128;
                    const h16x8 gt = *(const h16x8*)(gates + (size_t)row * 2048 + col);
                    f32x4 v0 = acc[ai][bj][m][0], v1 = acc[ai][bj][m][1];
#pragma unroll
                    for (int i = 0; i < 4; ++i) { v0[i] *= (float)gt[i]; v1[i] *= (float)gt[4 + i]; }
                    *(h16x8*)(m1 + (size_t)row * 1024 + col) = pack8(v0, v1);
                }
            }
    }
};
struct EpiM2 {
    const h16* m1; const h16* gates; h16* mm;
    __device__ __forceinline__ void operator()(const AccT& acc, const pg8::Unit& u, int wr, int wc, int fr, int fq) const {
        const int row0 = u.pm * 256 + wr * 64 + fr, col0 = u.pn * 256 + wc * 32 + 8 * fq;
#pragma unroll
        for (int ai = 0; ai < 2; ++ai)
#pragma unroll
            for (int m = 0; m < 4; ++m) {
                const int row = row0 + ai * 128 + m * 16;
#pragma unroll
                for (int bj = 0; bj < 2; ++bj) {
                    const int col = col0 + bj * 128;
                    const h16x8 gt = *(const h16x8*)(gates + (size_t)row * 2048 + 1024 + col);
                    const h16x8 mi = *(const h16x8*)(m1 + (size_t)row * 1024 + col);
                    f32x4 p0 = (f32x4){(float)mi[0], (float)mi[1], (float)mi[2], (float)mi[3]}, p1 = (f32x4){(float)mi[4], (float)mi[5], (float)mi[6], (float)mi[7]};
                    const f32x4 v0 = acc[ai][bj][m][0], v1 = acc[ai][bj][m][1];
#pragma unroll
                    for (int i = 0; i < 4; ++i) { p0[i] += v0[i] * (float)gt[i]; p1[i] += v1[i] * (float)gt[4 + i]; }
                    *(h16x8*)(mm + (size_t)row * 1024 + col) = pack8(p0, p1);
                }
            }
    }
};
struct EpiX1 {
    const float* x; const float* mod; h16* x1;
    __device__ __forceinline__ void operator()(const AccT& acc, const pg8::Unit& u, int wr, int wc, int fr, int fq) const {
        const int row0 = u.pm * 256 + wr * 64 + fr, col0 = u.pn * 256 + wc * 32 + 8 * fq;
        const int b = (u.pm * 256) >> 11;
#pragma unroll
        for (int bj = 0; bj < 2; ++bj) {
            const int col = col0 + bj * 128;
            const float* gp = mod + (size_t)b * 6144 + 2 * 1024 + col;
            const f32x4 g0 = *(const f32x4*)gp, g1 = *(const f32x4*)(gp + 4);
#pragma unroll
            for (int ai = 0; ai < 2; ++ai)
#pragma unroll
                for (int m = 0; m < 4; ++m) {
                    const int row = row0 + ai * 128 + m * 16;
                    const float* xi = x + (size_t)row * 1024 + col;
                    const f32x4 x0 = *(const f32x4*)xi, x1v = *(const f32x4*)(xi + 4);
                    *(h16x8*)(x1 + (size_t)row * 1024 + col) = pack8(x0 + g0 * acc[ai][bj][m][0], x1v + g1 * acc[ai][bj][m][1]);
                }
        }
    }
};
struct EpiH16 {
    h16* o; int ldc;
    __device__ __forceinline__ void operator()(const AccT& acc, const pg8::Unit& u, int wr, int wc, int fr, int fq) const {
        const int row0 = u.pm * 256 + wr * 64 + fr, col0 = u.pn * 256 + wc * 32 + 8 * fq;
#pragma unroll
        for (int ai = 0; ai < 2; ++ai)
#pragma unroll
            for (int m = 0; m < 4; ++m) {
                const int row = row0 + ai * 128 + m * 16;
#pragma unroll
                for (int bj = 0; bj < 2; ++bj)
                    *(h16x8*)(o + (size_t)row * ldc + col0 + bj * 128) = pack8(acc[ai][bj][m][0], acc[ai][bj][m][1]);
            }
    }
};

__device__ __forceinline__ void cvt_tile(const float* __restrict__ src, h16* __restrict__ dst, int tile) {
    const size_t i = (size_t)tile * 4096 + threadIdx.x * 8;
    const f32x4 a = *(const f32x4*)(src + i), b = *(const f32x4*)(src + i + 4);
    *(h16x8*)(dst + i) = pack8(a, b);
}
__device__ __forceinline__ void tr_tile(const float* __restrict__ src, h16* __restrict__ dst, int K, int N, int tile, float* lds) {
    const int ntn = N / 64, tk = tile / ntn, tn = tile % ntn, tid = threadIdx.x;
#pragma unroll
    for (int ps = 0; ps < 2; ++ps) {
        const int k = ps * 32 + (tid >> 4), n = (tid & 15) * 4;
        const f32x4 v = *(const f32x4*)(src + (size_t)(tk * 64 + k) * N + tn * 64 + n);
        lds[k * 65 + n] = v[0]; lds[k * 65 + n + 1] = v[1]; lds[k * 65 + n + 2] = v[2]; lds[k * 65 + n + 3] = v[3];
    }
    __syncthreads();
    {
        const int n = tid >> 3, ks = (tid & 7) * 8;
        h16x8 o;
#pragma unroll
        for (int i = 0; i < 8; ++i) o[i] = (h16)lds[(ks + i) * 65 + n];
        *(h16x8*)(dst + (size_t)(tn * 64 + n) * K + tk * 64 + ks) = o;
    }
    __syncthreads();
}
__device__ __forceinline__ void cvt8_rows(const float* __restrict__ src, unsigned char* __restrict__ dst, float* __restrict__ inv, int tile, int dstride = 1024) {
    const int wid = threadIdx.x >> 6, lane = threadIdx.x & 63;
    const size_t row = (size_t)tile * 8 + wid;
    const float* r = src + row * 1024 + lane * 16;
    f32x4 a[4]; float mx = 0.f;
#pragma unroll
    for (int i = 0; i < 4; ++i) { a[i] = *(const f32x4*)(r + 4 * i); mx = fmaxf(mx, fmaxf(fmaxf(fabsf(a[i][0]), fabsf(a[i][1])), fmaxf(fabsf(a[i][2]), fabsf(a[i][3])))); }
#pragma unroll
    for (int o = 32; o > 0; o >>= 1) mx = fmaxf(mx, __shfl_xor(mx, o));
    int ex2 = 0; float sc = 1.0f;
    if (mx > 0.f) { (void)frexpf(mx, &ex2); int k = 8 - ex2; k = k > 100 ? 100 : (k < -100 ? -100 : k); sc = ldexpf(1.0f, k); }
    i32x4 w;
#pragma unroll
    for (int i = 0; i < 4; ++i) {
        int pk = __builtin_amdgcn_cvt_pk_fp8_f32(a[i][0] * sc, a[i][1] * sc, 0, false);
        pk = __builtin_amdgcn_cvt_pk_fp8_f32(a[i][2] * sc, a[i][3] * sc, pk, true);
        w[i] = pk;
    }
    *(i32x4*)(dst + row * dstride + lane * 16) = w;
    if (lane == 0) inv[2 * row] = 1.0f / sc;
}
__device__ __forceinline__ void cvt4_rows(const float* __restrict__ src, unsigned char* __restrict__ dst, float* __restrict__ inv, int tile, int dstride = 512) {
    const int wid = threadIdx.x >> 6, lane = threadIdx.x & 63;
    const size_t row = (size_t)tile * 8 + wid;
    const float* r = src + row * 1024 + lane * 16;
    f32x4 a[4]; float mx = 0.f;
#pragma unroll
    for (int i = 0; i < 4; ++i) { a[i] = *(const f32x4*)(r + 4 * i); mx = fmaxf(mx, fmaxf(fmaxf(fabsf(a[i][0]), fabsf(a[i][1])), fmaxf(fabsf(a[i][2]), fabsf(a[i][3])))); }
#pragma unroll
    for (int o = 32; o > 0; o >>= 1) mx = fmaxf(mx, __shfl_xor(mx, o));
    const float sc = (mx > 1e-30f) ? 6.0f / mx : 1.0f;
    int w0 = 0, w1 = 0;
    w0 = __builtin_amdgcn_cvt_scalef32_pk_fp4_f32(w0, a[0][0] * sc, a[0][1] * sc, 1.0f, 0);
    w0 = __builtin_amdgcn_cvt_scalef32_pk_fp4_f32(w0, a[0][2] * sc, a[0][3] * sc, 1.0f, 1);
    w0 = __builtin_amdgcn_cvt_scalef32_pk_fp4_f32(w0, a[1][0] * sc, a[1][1] * sc, 1.0f, 2);
    w0 = __builtin_amdgcn_cvt_scalef32_pk_fp4_f32(w0, a[1][2] * sc, a[1][3] * sc, 1.0f, 3);
    w1 = __builtin_amdgcn_cvt_scalef32_pk_fp4_f32(w1, a[2][0] * sc, a[2][1] * sc, 1.0f, 0);
    w1 = __builtin_amdgcn_cvt_scalef32_pk_fp4_f32(w1, a[2][2] * sc, a[2][3] * sc, 1.0f, 1);
    w1 = __builtin_amdgcn_cvt_scalef32_pk_fp4_f32(w1, a[3][0] * sc, a[3][1] * sc, 1.0f, 2);
    w1 = __builtin_amdgcn_cvt_scalef32_pk_fp4_f32(w1, a[3][2] * sc, a[3][3] * sc, 1.0f, 3);
    *(i32x2*)(dst + row * dstride + lane * 8) = (i32x2){w0, w1};
    if (lane == 0) inv[2 * row] = 1.0f / sc;
}
__device__ __forceinline__ void wqk_tile(const float* __restrict__ wq, const float* __restrict__ keys, h16* __restrict__ wt, int tile, float* lds) {
    const int ct = tile >> 4, hp = tile & 15, tid = threadIdx.x;
    float* sA = lds;
    float* sB = lds + 64 * 129;
#pragma unroll
    for (int i = 0; i < 4; ++i) {
        const int e = (i * 512 + tid) * 4, r = e >> 7, d = e & 127;
        const f32x4 v = *(const f32x4*)(wq + (size_t)(ct * 64 + r) * 2048 + hp * 128 + d);
        sA[r * 129 + d] = v[0]; sA[r * 129 + d + 1] = v[1]; sA[r * 129 + d + 2] = v[2]; sA[r * 129 + d + 3] = v[3];
    }
#pragma unroll
    for (int i = 0; i < 8; ++i) {
        const int e = (i * 512 + tid) * 4, k = e >> 7, d = e & 127;
        const f32x4 v = *(const f32x4*)(keys + (size_t)(hp * 128 + k) * 128 + d);
        sB[k * 129 + d] = v[0]; sB[k * 129 + d + 1] = v[1]; sB[k * 129 + d + 2] = v[2]; sB[k * 129 + d + 3] = v[3];
    }
    __syncthreads();
    const int c = tid >> 3, kg = (tid & 7) * 16;
    float acc[16];
#pragma unroll
    for (int j = 0; j < 16; ++j) acc[j] = 0.f;
#pragma unroll 4
    for (int d = 0; d < 128; ++d) {
        const float a = sA[c * 129 + d];
#pragma unroll
        for (int j = 0; j < 16; ++j) acc[j] += a * sB[(kg + j) * 129 + d];
    }
#pragma unroll
    for (int j = 0; j < 16; ++j) wt[(size_t)(hp * 128 + kg + j) * 1024 + ct * 64 + c] = (h16)acc[j];
    __syncthreads();
}
__device__ void phase0(const Params& p, float* lds) {
    unsigned char* ws = p.ws;
    const int tid = threadIdx.x, wid = tid >> 6, lane = tid & 63;
    for (int ib = blockIdx.x; ib < 256; ib += gridDim.x) {
        if (wid < 6) {
            const int item = ib * 6 + wid, cg64 = item % 96, kc = item / 96;
            const int col = cg64 * 64 + lane, k0 = kc * 64;
            float sv[17], acc[17];
#pragma unroll
            for (int b = 0; b < 17; ++b) {
                const float cv = (b < 16) ? p.in[I_C][b * 1024 + k0 + lane] : p.in[I_CCTX][k0 + lane];
                sv[b] = silu_(cv); acc[b] = 0.f;
            }
            const float* wp = p.in[I_ADAW] + (size_t)k0 * 6144 + col;
            for (int j = 0; j < 64; ++j) {
                const float w = wp[(size_t)j * 6144];
#pragma unroll
                for (int b = 0; b < 17; ++b) acc[b] += __builtin_bit_cast(float, __builtin_amdgcn_readlane(__builtin_bit_cast(int, sv[b]), j)) * w;
            }
            float* mp = (float*)(ws + OFF_MODP);
#pragma unroll
            for (int b = 0; b < 17; ++b) mp[((size_t)kc * 17 + b) * 6144 + col] = acc[b];
        }
    }
    constexpr int T0 = 2048, T1 = T0 + 2048, T2 = T1 + 32, T3 = T2, T4 = T3 + 1152, T5 = T4 + 128, T6 = T5 + 128, T7 = T6 + 256, T8 = T7 + 256;
    for (int t = blockIdx.x; t < T8; t += gridDim.x) {
        if (t < T0) cvt4_rows(p.in[I_PU], ws + OFF_U8, (float*)(ws + OFF_USC), t, 1536);
        else if (t < T1) cvt8_rows(p.in[I_PV], ws + OFF_U8 + 512, (float*)(ws + OFF_USC) + 1, t - T0, 1536);
        else if (t < T2) cvt_tile(p.in[I_GMWS], (h16*)(ws + OFF_WS16), t - T1);
        else if (t < T3) {
            const int e = (t - T2) * 4096 + tid * 8;
            const int row = e >> 8, cc = e & 255, h = row >> 8, pp = (row >> 7) & 1, k = row & 127, pq = cc >> 7, d = cc & 127;
            h16x8 o = {0, 0, 0, 0, 0, 0, 0, 0};
            if (pp == pq) {
                const float* kp = p.in[I_KEYS] + ((size_t)((h * 2 + pp) * 128 + k)) * 128 + d;
                o = pack8(*(const f32x4*)kp, *(const f32x4*)(kp + 4));
            }
            *(h16x8*)((h16*)(ws + OFF_BD) + e) = o;
        }
        else if (t < T4) tr_tile(p.in[I_WIN], (h16*)(ws + OFF_WINT), 1024, INC, t - T3, lds);
        else if (t < T5) tr_tile(p.in[I_WPA], (h16*)(ws + OFF_WPAT), 512, 1024, t - T4, lds);
        else if (t < T6) tr_tile(p.in[I_WPB], (h16*)(ws + OFF_WPBT), 512, 1024, t - T5, lds);
        else if (t < T7) tr_tile(p.in[I_WOUT], (h16*)(ws + OFF_WOUTT), 1024, 1024, t - T6, lds);
        else wqk_tile(p.in[I_WQ], p.in[I_KEYS], (h16*)(ws + OFF_WQT), t - T7, lds);
    }
}

__device__ __forceinline__ void norm_rows(const float* __restrict__ src, h16* __restrict__ dst, int row_begin, int rows_per_wave, const float* sA, const float* sB) {
    const int tid_ = fresh_tid();
    const int wid = tid_ >> 6, lane = tid_ & 63;
    f32x4 a[4], bsh[4];
#pragma unroll
    for (int c = 0; c < 4; ++c) { a[c] = *(const f32x4*)(sA + c * 256 + lane * 4); bsh[c] = *(const f32x4*)(sB + c * 256 + lane * 4); }
    for (int i = 0; i < rows_per_wave; i += 2) {
        const size_t row = (size_t)row_begin + wid * rows_per_wave + i;
        f32x4 v[2][4]; float ss[2];
#pragma unroll
        for (int q = 0; q < 2; ++q) {
            ss[q] = 0.f;
#pragma unroll
            for (int c = 0; c < 4; ++c) { v[q][c] = *(const f32x4*)(src + (row + q) * 1024 + c * 256 + lane * 4); ss[q] += v[q][c][0] * v[q][c][0] + v[q][c][1] * v[q][c][1] + v[q][c][2] * v[q][c][2] + v[q][c][3] * v[q][c][3]; }
        }
#pragma unroll
        for (int o = 32; o > 0; o >>= 1) { const float t0 = __shfl_xor(ss[0], o), t1 = __shfl_xor(ss[1], o); ss[0] += t0; ss[1] += t1; }
#pragma unroll
        for (int q = 0; q < 2; ++q) {
            const float r = rsqrtf(ss[q] * (1.0f / 1024.0f) + 1e-6f);
#pragma unroll
            for (int c = 0; c < 4; ++c) {
                h16x4 o;
#pragma unroll
                for (int j = 0; j < 4; ++j) o[j] = (h16)(v[q][c][j] * r * a[c][j] + bsh[c][j]);
                *(h16x4*)(dst + (row + q) * 1024 + c * 256 + lane * 4) = o;
            }
        }
    }
}
__device__ __forceinline__ void norm_rows_h(const h16* __restrict__ src, h16* __restrict__ dst, int row_begin, int rows_per_wave, const float* sA, const float* sB) {
    const int tid_ = fresh_tid();
    const int wid = tid_ >> 6, lane = tid_ & 63;
    f32x4 a[4], bsh[4];
#pragma unroll
    for (int c = 0; c < 4; ++c) { a[c] = *(const f32x4*)(sA + c * 256 + lane * 4); bsh[c] = *(const f32x4*)(sB + c * 256 + lane * 4); }
    for (int i = 0; i < rows_per_wave; i += 2) {
        const size_t row = (size_t)row_begin + wid * rows_per_wave + i;
        f32x4 v[2][4]; float ss[2];
#pragma unroll
        for (int q = 0; q < 2; ++q) {
            ss[q] = 0.f;
#pragma unroll
            for (int c = 0; c < 4; ++c) { const h16x4 hv = *(const h16x4*)(src + (row + q) * 1024 + c * 256 + lane * 4);
                v[q][c] = (f32x4){(float)hv[0], (float)hv[1], (float)hv[2], (float)hv[3]};
                ss[q] += v[q][c][0] * v[q][c][0] + v[q][c][1] * v[q][c][1] + v[q][c][2] * v[q][c][2] + v[q][c][3] * v[q][c][3]; }
        }
#pragma unroll
        for (int o = 32; o > 0; o >>= 1) { const float t0 = __shfl_xor(ss[0], o), t1 = __shfl_xor(ss[1], o); ss[0] += t0; ss[1] += t1; }
#pragma unroll
        for (int q = 0; q < 2; ++q) {
            const float r = rsqrtf(ss[q] * (1.0f / 1024.0f) + 1e-6f);
#pragma unroll
            for (int c = 0; c < 4; ++c) {
                h16x4 o;
#pragma unroll
                for (int j = 0; j < 4; ++j) o[j] = (h16)(v[q][c][j] * r * a[c][j] + bsh[c][j]);
                *(h16x4*)(dst + (row + q) * 1024 + c * 256 + lane * 4) = o;
            }
        }
    }
}
__device__ void phase1(const Params& p, float* lds) {
    unsigned char* ws = p.ws;
    const int tid = threadIdx.x;
    const float* mp = (const float*)(ws + OFF_MODP);
    const float* bias = p.in[I_ADAB];
    float* sA = lds; float* sB = lds + 1024; float* cA = lds + 2048; float* cB = lds + 3072;
    {
        float* mod = (float*)(ws + OFF_MOD);
        for (int e = blockIdx.x * 512 + tid; e < 17 * 6144; e += gridDim.x * 512) {
            float s = bias[e % 6144];
#pragma unroll
            for (int kc = 0; kc < 16; ++kc) s += mp[(size_t)kc * 17 * 6144 + e];
            mod[e] = s;
        }
    }
    for (int col = tid; col < 1024; col += 512) {
        float sh = bias[col], sc = bias[1024 + col];
#pragma unroll
        for (int kc = 0; kc < 16; ++kc) { sh += mp[((size_t)kc * 17 + 16) * 6144 + col]; sc += mp[((size_t)kc * 17 + 16) * 6144 + 1024 + col]; }
        cA[col] = p.in[I_N1G][col] * (1.0f + sc); cB[col] = sh;
    }
    for (int rg = blockIdx.x; rg < 256; rg += gridDim.x) {
        const int b = rg >> 4;
        __syncthreads();
        for (int col = tid; col < 1024; col += 512) {
            float sh = bias[col], sc = bias[1024 + col];
#pragma unroll
            for (int kc = 0; kc < 16; ++kc) { sh += mp[((size_t)kc * 17 + b) * 6144 + col]; sc += mp[((size_t)kc * 17 + b) * 6144 + 1024 + col]; }
            sA[col] = p.in[I_N1G][col] * (1.0f + sc); sB[col] = sh;
        }
        __syncthreads();
        norm_rows(p.in[I_X], (h16*)(ws + OFF_R1), rg * 128, 16, sA, sB);
        norm_rows(p.in[I_CTX], (h16*)(ws + OFF_HC), rg * 16, 2, cA, cB);
    }
}
__device__ void phase6(const Params& p, float* lds) {
    unsigned char* ws = p.ws;
    const int tid = threadIdx.x;
    const float* mod = (const float*)(ws + OFF_MOD);
    float* sA = lds; float* sB = lds + 1024;
    for (int rg = blockIdx.x; rg < 256; rg += gridDim.x) {
        const int b = rg >> 4;
        __syncthreads();
        for (int col = tid; col < 1024; col += 512) {
            sA[col] = p.in[I_N2G][col] * (1.0f + mod[(size_t)b * 6144 + 4 * 1024 + col]); sB[col] = mod[(size_t)b * 6144 + 3 * 1024 + col];
        }
        __syncthreads();
        norm_rows_h((const h16*)(ws + OFF_X1H), (h16*)(ws + OFF_R1), rg * 128, 16, sA, sB);
    }
}

__device__ __forceinline__ int clampi(int v, int lo, int hi) { return v < lo ? lo : (v > hi ? hi : v); }

template <bool LOCAL>
__device__ __forceinline__ void attn_core(const h16x8 (&kf)[2][2], const h16x8 (&vf)[4], const float* __restrict__ rpbrow, const int cb, const int qc, const int cs,
                                          const h16x8 (&qf)[2], float& m_run, float& l_run, f32x4 (&O)[4], const int quad) {
    f32x4 st[2];
#pragma unroll
    for (int t = 0; t < 2; ++t) {
        f32x4 a = (f32x4){0.f, 0.f, 0.f, 0.f};
#pragma unroll
        for (int ks = 0; ks < 2; ++ks) a = __builtin_amdgcn_mfma_f32_16x16x32_f16(kf[t][ks], qf[ks], a, 0, 0, 0);
        st[t] = a;
    }
    float mx = -INFINITY;
#pragma unroll
    for (int t = 0; t < 2; ++t)
#pragma unroll
        for (int j = 0; j < 4; ++j) {
            float sv = st[t][j] * 0.125f;
            if (LOCAL) {
                const int kc = cb + 16 * t + quad * 4 + j;
                const bool inw = (kc >= cs) && (kc < cs + 16);
                const int dc = clampi(kc - qc + 15, 0, 30);
                const float bv = rpbrow[dc];
                sv = inw ? (sv + bv) : -1e30f;
            }
            st[t][j] = sv; mx = fmaxf(mx, sv);
        }
    mx = fmaxf(mx, __shfl_xor(mx, 16)); mx = fmaxf(mx, __shfl_xor(mx, 32));
    const float m_new = fmaxf(m_run, mx);
    const float alpha = __expf(m_run - m_new);
    float ls = 0.f; h16x8 pf;
#pragma unroll
    for (int t = 0; t < 2; ++t)
#pragma unroll
        for (int j = 0; j < 4; ++j) { const float pe = __expf(st[t][j] - m_new); ls += pe; pf[t * 4 + j] = (h16)pe; }
    l_run = l_run * alpha + ls; m_run = m_new;
#pragma unroll
    for (int dt = 0; dt < 4; ++dt) { O[dt] *= alpha; O[dt] = __builtin_amdgcn_mfma_f32_16x16x32_f16(vf[dt], pf, O[dt], 0, 0, 0); }
}
__device__ __forceinline__ void load_kv(const h16* __restrict__ kt, const h16* __restrict__ vt, h16x8 (&kf)[2][2], h16x8 (&vf)[4], const int l15, const int quad) {
#pragma unroll
    for (int t = 0; t < 2; ++t)
#pragma unroll
        for (int ks = 0; ks < 2; ++ks) kf[t][ks] = *(const h16x8*)(kt + (16 * t + l15) * 64 + ks * 32 + quad * 8);
#pragma unroll
    for (int dt = 0; dt < 4; ++dt) {
        const h16* vp = vt + ((quad >> 1) * 64 + dt * 16 + l15) * 8 + (quad & 1) * 4;
        const h16x4 lo = *(const h16x4*)vp, hi = *(const h16x4*)(vp + 2 * 512);
        vf[dt] = (h16x8){lo[0], lo[1], lo[2], lo[3], hi[0], hi[1], hi[2], hi[3]};
    }
}

__device__ void attn_unit(const Params& p, int unit) {
    unsigned char* ws = p.ws;
    const int tid_ = fresh_tid();
    const int lane = tid_ & 63, h = tid_ >> 6, l15 = lane & 15, quad = lane >> 4;
    const int b = unit >> 5, r = unit & 31;
    const h16* QB = (const h16*)(ws + OFF_QB);
    const h16* KH = (const h16*)(ws + OFF_KB) + (size_t)(b * 8 + h) * 2048 * 64;
    const h16* VH = (const h16*)(ws + OFF_VT) + (size_t)(b * 8 + h) * 256 * 512;
    const h16* KCH = (const h16*)(ws + OFF_KC) + (size_t)(b * 8 + h) * 256 * 64;
    const h16* VCH = (const h16*)(ws + OFF_VCT) + (size_t)(b * 8 + h) * 32 * 512;
    h16* YA = (h16*)(ws + OFF_R1);
    const float* rpb = p.in[I_RPB] + (size_t)h * 15 * 31;
    const int rs = clampi(r - 4, 0, 24);
    h16x8 qf[4][2]; float m_run[4], l_run[4]; f32x4 O[4][4];
#pragma unroll
    for (int g = 0; g < 4; ++g) {
        const size_t tq = (size_t)b * 2048 + r * 64 + 16 * g + l15;
        qf[g][0] = *(const h16x8*)(QB + tq * 512 + h * 64 + quad * 8);
        qf[g][1] = *(const h16x8*)(QB + tq * 512 + h * 64 + 32 + quad * 8);
        m_run[g] = -INFINITY; l_run[g] = 0.f;
#pragma unroll
        for (int dt = 0; dt < 4; ++dt) O[g][dt] = (f32x4){0.f, 0.f, 0.f, 0.f};
    }
#pragma unroll 1
    for (int step = 0; step < 8; ++step) {
        h16x8 kf[2][2], vf[4];
        load_kv(KCH + step * 32 * 64, VCH + step * 4 * 512, kf, vf, l15, quad);
#pragma unroll
        for (int g = 0; g < 4; ++g) attn_core<false>(kf, vf, rpb, 0, 0, 0, qf[g], m_run[g], l_run[g], O[g], quad);
    }
#pragma unroll
    for (int gp = 0; gp < 4; gp += 2) {
        const int cb0 = clampi(16 * gp - 8, 0, 32), cb1 = clampi(16 * (gp + 1) - 8, 0, 32);
        const int qc0 = 16 * gp + l15, qc1 = 16 * (gp + 1) + l15;
        const int cs0 = clampi(qc0 - 8, 0, 48), cs1 = clampi(qc1 - 8, 0, 48);
        const float* rp0 = rpb + (rs - r + 7) * 31;
#pragma unroll 1
        for (int step = 0; step < 8; ++step) {
            const int t0 = (rs + step) * 64 + cb0, t1 = (rs + step) * 64 + cb1;
            h16x8 kf0[2][2], vf0[4], kf1[2][2], vf1[4];
            load_kv(KH + (size_t)t0 * 64, VH + (size_t)(t0 >> 3) * 512, kf0, vf0, l15, quad);
            load_kv(KH + (size_t)t1 * 64, VH + (size_t)(t1 >> 3) * 512, kf1, vf1, l15, quad);
            attn_core<true>(kf0, vf0, rp0 + step * 31, cb0, qc0, cs0, qf[gp], m_run[gp], l_run[gp], O[gp], quad);
            attn_core<true>(kf1, vf1, rp0 + step * 31, cb1, qc1, cs1, qf[gp + 1], m_run[gp + 1], l_run[gp + 1], O[gp + 1], quad);
        }
    }
#pragma unroll
    for (int g = 0; g < 4; ++g) {
        const size_t tq = (size_t)b * 2048 + r * 64 + 16 * g + l15;
        float l = l_run[g];
        l += __shfl_xor(l, 16); l += __shfl_xor(l, 32);
        const float inv = __builtin_amdgcn_rcpf(l);
#pragma unroll
        for (int dt = 0; dt < 4; ++dt) {
            h16x4 o;
#pragma unroll
            for (int j = 0; j < 4; ++j) o[j] = (h16)(O[g][dt][j] * inv);
            *(h16x4*)(YA + tq * 1024 + h * 64 + dt * 16 + quad * 4) = o;
        }
    }
}

__device__ void sgu_unit(const Params& p, int n, LAS unsigned char* lds) {
    unsigned char* ws = p.ws;
    const int tid = fresh_tid(), lane = tid & 63, g = tid >> 6, l15 = lane & 15, quad = lane >> 4;
    const h16* GUV = (const h16*)(ws + OFF_GUV);
    const h16* WS16 = (const h16*)(ws + OFF_WS16);
    h16* YB = (h16*)(ws + OFF_R1) + 512;
    LAS float* stat = (LAS float*)(lds + 8 * 17408);
    LAS h16* vt = (LAS h16*)(lds + g * 17408);
    const size_t t0 = (size_t)n * 128;
    __syncthreads();
    for (int i = 0; i < 16; i += 4) {
        h16x8 x[4]; float s[4], v[4];
#pragma unroll
        for (int q = 0; q < 4; ++q) {
            x[q] = *(const h16x8*)(GUV + (t0 + g * 16 + i + q) * 1024 + 512 + lane * 8);
            s[q] = 0.f;
#pragma unroll
            for (int j = 0; j < 8; ++j) s[q] += (float)x[q][j];
        }
#pragma unroll
        for (int o = 32; o > 0; o >>= 1) { float t[4];
#pragma unroll
            for (int q = 0; q < 4; ++q) t[q] = __shfl_xor(s[q], o);
#pragma unroll
            for (int q = 0; q < 4; ++q) s[q] += t[q]; }
#pragma unroll
        for (int q = 0; q < 4; ++q) {
            s[q] *= (1.0f / 512.0f); v[q] = 0.f;
#pragma unroll
            for (int j = 0; j < 8; ++j) { const float d = (float)x[q][j] - s[q]; v[q] += d * d; }
        }
#pragma unroll
        for (int o = 32; o > 0; o >>= 1) { float t[4];
#pragma unroll
            for (int q = 0; q < 4; ++q) t[q] = __shfl_xor(v[q], o);
#pragma unroll
            for (int q = 0; q < 4; ++q) v[q] += t[q]; }
        if (lane == 0) {
#pragma unroll
            for (int q = 0; q < 4; ++q) { stat[(g * 16 + i + q) * 2] = s[q]; stat[(g * 16 + i + q) * 2 + 1] = rsqrtf(v[q] * (1.0f / 512.0f) + 1e-6f); }
        }
    }
    __syncthreads();
    {
        const int ch0 = (lane & 7) * 8;
        float lg[8];
#pragma unroll
        for (int j = 0; j < 8; ++j) lg[j] = p.in[I_LNG][g * 64 + ch0 + j];
#pragma unroll 8
        for (int it = 0; it < 16; ++it) {
            const int q = it * 8 + (lane >> 3);
            const h16x8 x = *(const h16x8*)(GUV + (t0 + q) * 1024 + 512 + g * 64 + ch0);
            const float mean = stat[q * 2], rstd = stat[q * 2 + 1];
#pragma unroll
            for (int j = 0; j < 8; ++j) vt[(ch0 + j) * 136 + q] = (h16)(((float)x[j] - mean) * rstd * lg[j]);
        }
    }
    asm volatile("s_waitcnt lgkmcnt(0)" ::: "memory");
    __syncthreads();
    h16x8 af[4][4];
#pragma unroll
    for (int dt = 0; dt < 4; ++dt)
#pragma unroll
        for (int ks = 0; ks < 4; ++ks) af[dt][ks] = *(const LAS h16x8*)(vt + (dt * 16 + l15) * 136 + ks * 32 + quad * 8);
    const h16* wg = WS16 + (size_t)g * 128 * 128;
#pragma unroll 2
    for (int pt = 0; pt < 8; ++pt) {
        f32x4 acc[4];
#pragma unroll
        for (int dt = 0; dt < 4; ++dt) acc[dt] = (f32x4){0.f, 0.f, 0.f, 0.f};
#pragma unroll
        for (int ks = 0; ks < 4; ++ks) {
            const h16x8 bf = *(const h16x8*)(wg + (size_t)(pt * 16 + l15) * 128 + ks * 32 + quad * 8);
#pragma unroll
            for (int dt = 0; dt < 4; ++dt) acc[dt] = __builtin_amdgcn_mfma_f32_16x16x32_f16(af[dt][ks], bf, acc[dt], 0, 0, 0);
        }
        const int pp = pt * 16 + l15;
        const float bsv = p.in[I_GMBS][g * 128 + pp];
        const size_t tok = t0 + pp;
#pragma unroll
        for (int dt = 0; dt < 4; ++dt) {
            const int ch = g * 64 + dt * 16 + quad * 4;
            const h16x4 uu = *(const h16x4*)(GUV + tok * 1024 + ch);
            h16x4 o;
#pragma unroll
            for (int j = 0; j < 4; ++j) o[j] = (h16)((float)uu[j] * (acc[dt][j] + bsv));
            *(h16x4*)(YB + tok * 1024 + ch) = o;
        }
    }
    __syncthreads();
}

__device__ __forceinline__ float row16_sum_to_lane15(float v) {
    v += __builtin_bit_cast(float, __builtin_amdgcn_update_dpp(0, __builtin_bit_cast(int, v), 0x118, 0xf, 0xf, true));
    v += __builtin_bit_cast(float, __builtin_amdgcn_update_dpp(0, __builtin_bit_cast(int, v), 0x114, 0xf, 0xf, true));
    v += __builtin_bit_cast(float, __builtin_amdgcn_update_dpp(0, __builtin_bit_cast(int, v), 0x112, 0xf, 0xf, true));
    v += __builtin_bit_cast(float, __builtin_amdgcn_update_dpp(0, __builtin_bit_cast(int, v), 0x111, 0xf, 0xf, true));
    return v;
}
#define DPPF(v, ctrl) __builtin_bit_cast(float, __builtin_amdgcn_update_dpp(__builtin_bit_cast(int, v), __builtin_bit_cast(int, v), ctrl, 0xf, 0xf, false))
__device__ __forceinline__ float row16_allsum(float v) { v += DPPF(v, 0x128); v += DPPF(v, 0x124); v += DPPF(v, 0x122); v += DPPF(v, 0x121); return v; }
__device__ __forceinline__ float row16_allmax(float v) { v = fmaxf(v, DPPF(v, 0x128)); v = fmaxf(v, DPPF(v, 0x124)); v = fmaxf(v, DPPF(v, 0x122)); v = fmaxf(v, DPPF(v, 0x121)); return v; }
__device__ __forceinline__ int wave_incl_scan(int v) {
    v += __builtin_amdgcn_update_dpp(0, v, 0x111, 0xf, 0xf, false);
    v += __builtin_amdgcn_update_dpp(0, v, 0x112, 0xf, 0xf, false);
    v += __builtin_amdgcn_update_dpp(0, v, 0x114, 0xf, 0xf, false);
    v += __builtin_amdgcn_update_dpp(0, v, 0x118, 0xf, 0xf, false);
    v += __builtin_amdgcn_update_dpp(0, v, 0x142, 0xa, 0xf, false);
    v += __builtin_amdgcn_update_dpp(0, v, 0x143, 0xc, 0xf, false);
    return v;
}
__device__ __forceinline__ unsigned wave_or(unsigned x) {
    int v = (int)x;
    v |= __builtin_amdgcn_update_dpp(0, v, 0x111, 0xf, 0xf, false);
    v |= __builtin_amdgcn_update_dpp(0, v, 0x112, 0xf, 0xf, false);
    v |= __builtin_amdgcn_update_dpp(0, v, 0x114, 0xf, 0xf, false);
    v |= __builtin_amdgcn_update_dpp(0, v, 0x118, 0xf, 0xf, false);
    v |= __builtin_amdgcn_update_dpp(0, v, 0x142, 0xa, 0xf, false);
    v |= __builtin_amdgcn_update_dpp(0, v, 0x143, 0xc, 0xf, false);
    return (unsigned)__builtin_amdgcn_readlane(v, 63);
}
__device__ __forceinline__ unsigned wave_and(unsigned x) {
    int v = (int)x;
    v &= __builtin_amdgcn_update_dpp(-1, v, 0x111, 0xf, 0xf, false);
    v &= __builtin_amdgcn_update_dpp(-1, v, 0x112, 0xf, 0xf, false);
    v &= __builtin_amdgcn_update_dpp(-1, v, 0x114, 0xf, 0xf, false);
    v &= __builtin_amdgcn_update_dpp(-1, v, 0x118, 0xf, 0xf, false);
    v &= __builtin_amdgcn_update_dpp(-1, v, 0x142, 0xa, 0xf, false);
    v &= __builtin_amdgcn_update_dpp(-1, v, 0x143, 0xc, 0xf, false);
    return (unsigned)__builtin_amdgcn_readlane(v, 63);
}
__device__ __forceinline__ unsigned key16(unsigned short u) { return (u & 0x8000u) ? ((~(unsigned)u) & 0xFFFFu) : ((unsigned)u | 0x8000u); }
__device__ __forceinline__ unsigned key32(unsigned u) { return (u & 0x80000000u) ? ~u : (u | 0x80000000u); }
__device__ __forceinline__ float dot8(h16x8 a, h16x8 b, float c) {
    c = __builtin_amdgcn_fdot2((h16x2){a[0], a[1]}, (h16x2){b[0], b[1]}, c, false);
    c = __builtin_amdgcn_fdot2((h16x2){a[2], a[3]}, (h16x2){b[2], b[3]}, c, false);
    c = __builtin_amdgcn_fdot2((h16x2){a[4], a[5]}, (h16x2){b[4], b[5]}, c, false);
    c = __builtin_amdgcn_fdot2((h16x2){a[6], a[7]}, (h16x2){b[6], b[7]}, c, false);
    return c;
}
#define LDS_FENCE() asm volatile("s_waitcnt lgkmcnt(0)" ::: "memory")

__device__ void peer_phase(const Params& p, LAS unsigned char* lds, unsigned* bar, unsigned& epoch) {
    unsigned char* ws = p.ws;
    const int tid = fresh_tid(), wid = __builtin_amdgcn_readfirstlane(tid >> 6), lane = tid & 63;
    const unsigned long long lm = (1ull << lane) - 1ull;
    LAS unsigned char* wl = lds + wid * 11264;
    LAS float* s_top = (LAS float*)(wl);
    LAS int* i_top = (LAS int*)(wl + 1024);
    LAS int* ex = (LAS int*)(wl + 2048);
    LAS float* sc = (LAS float*)(wl + 2560);
    LAS int* uns_m = (LAS int*)(wl + 3072);
    LAS float* uns_g = (LAS float*)(wl + 3584);
    LAS int* cnt = (LAS int*)(wl + 4096);
    LAS int* base = (LAS int*)(wl + 4352);
    const int lead = (wid >= 4) ? 1 : 0;
    const unsigned short* SC = (const unsigned short*)(ws + OFF_SC16);
    const h16* H2 = (const h16*)(ws + OFF_R1);
    const unsigned char* U4 = ws + OFF_U8;
    const unsigned char* V8 = ws + OFF_V8;
    const float* USC = (const float*)(ws + OFF_USC);
    const float* VSC = (const float*)(ws + OFF_VSC);
    const float* mod = (const float*)(ws + OFF_MOD);
    const int grp = lane >> 4, li = lane & 15;
    for (int tg = blockIdx.x; tg < 256; tg += gridDim.x) {
        for (int it5 = 0; it5 < 5; ++it5) {
          if (it5 < 4) {
            const int round = it5;
            const size_t tok0 = (size_t)tg * 128 + wid * 16 + round * 4;
            LAS unsigned short* se = (LAS unsigned short*)(wl + 4608 + (round & 1) * 3072);
            LAS float* sw = (LAS float*)(wl + 4608 + (round & 1) * 3072 + 1024);
            for (int tt = 0; tt < 4; ++tt) {
                const size_t tok = tok0 + tt;
                cnt[lane] = 0;
                for (int L0 = 0; L0 < 16; L0 += 4) {
                    unsigned short ra[4], rb[4]; unsigned ka[4], kb[4], T[4];
#pragma unroll
                    for (int q = 0; q < 4; ++q) {
                        const unsigned short* sr = SC + tok * 2048 + (L0 + q) * 128;
                        ra[q] = sr[lane]; rb[q] = sr[64 + lane];
                        ka[q] = key16(ra[q]); kb[q] = key16(rb[q]); T[q] = 0;
                    }
                    for (int bit = 15; bit >= 0; --bit) {
#pragma unroll
                        for (int q = 0; q < 4; ++q) {
                            const unsigned cand = T[q] | (1u << bit);
                            const int cn = __popcll(__ballot(ka[q] >= cand)) + __popcll(__ballot(kb[q] >= cand));
                            T[q] = (cn >= 16) ? cand : T[q];
                        }
                    }
#pragma unroll
                    for (int q = 0; q < 4; ++q) {
                        const int L = L0 + q;
                        const int cnt_gt = __popcll(__ballot(ka[q] > T[q])) + __popcll(__ballot(kb[q] > T[q]));
                        const int need = 16 - cnt_gt;
                        const unsigned long long ea = __ballot(ka[q] == T[q]), eb = __ballot(kb[q] == T[q]);
                        const int ra_eq = __popcll(ea & lm), rb_eq = __popcll(ea) + __popcll(eb & lm);
                        const bool sa = (ka[q] > T[q]) || (ka[q] == T[q] && ra_eq < need);
                        const bool sb = (kb[q] > T[q]) || (kb[q] == T[q] && rb_eq < need);
                        const unsigned long long ma = __ballot(sa), mb = __ballot(sb);
                        const int pa = __popcll(ma & lm), pb = __popcll(ma) + __popcll(mb & lm);
                        if (sa) { s_top[L * 16 + pa] = (float)__builtin_bit_cast(h16, ra[q]); i_top[L * 16 + pa] = lane; }
                        if (sb) { s_top[L * 16 + pb] = (float)__builtin_bit_cast(h16, rb[q]); i_top[L * 16 + pb] = 64 + lane; }
                    }
                }
                LDS_FENCE();
                for (int h0 = 0; h0 < 8; h0 += 4) {
                    float cv[4][4]; unsigned kk[4][4], T[4];
#pragma unroll
                    for (int q = 0; q < 4; ++q) {
                        const int h = h0 + q;
                        const float bj = s_top[(2 * h + 1) * 16 + li];
#pragma unroll
                        for (int m = 0; m < 4; ++m) { cv[q][m] = s_top[(2 * h) * 16 + grp + 4 * m] + bj; kk[q][m] = key32(__builtin_bit_cast(unsigned, cv[q][m])); }
                        T[q] = 0;
                    }
                    unsigned om = 0, am = 0xFFFFFFFFu;
#pragma unroll
                    for (int q = 0; q < 4; ++q)
#pragma unroll
                        for (int m = 0; m < 4; ++m) { om |= kk[q][m]; am &= kk[q][m]; }
                    om = wave_or(om); am = wave_and(am);
                    om &= ~am;
                    while (om) {
                        const int bit = 31 - __builtin_clz(om);
                        om &= ~(1u << bit);
#pragma unroll
                        for (int q = 0; q < 4; ++q) {
                            const unsigned cand = T[q] | (1u << bit);
                            int cn = 0;
#pragma unroll
                            for (int m = 0; m < 4; ++m) cn += __popcll(__ballot((kk[q][m] & ~am) >= cand));
                            T[q] = (cn >= 16) ? cand : T[q];
                        }
                    }
#pragma unroll
                    for (int q = 0; q < 4; ++q) T[q] |= am;
#pragma unroll
                    for (int q = 0; q < 4; ++q) {
                        const int h = h0 + q;
                        int cnt_gt = 0;
#pragma unroll
                        for (int m = 0; m < 4; ++m) cnt_gt += __popcll(__ballot(kk[q][m] > T[q]));
                        const int need = 16 - cnt_gt;
                        int eq_before = 0, sel_before = 0;
#pragma unroll
                        for (int m = 0; m < 4; ++m) {
                            const unsigned long long em = __ballot(kk[q][m] == T[q]);
                            const int myeq = eq_before + __popcll(em & lm);
                            const bool sel = (kk[q][m] > T[q]) || (kk[q][m] == T[q] && myeq < need);
                            const unsigned long long sm = __ballot(sel);
                            const int pos = sel_before + __popcll(sm & lm);
                            if (sel) {
                                ex[h * 16 + pos] = i_top[(2 * h) * 16 + grp + 4 * m] * 128 + i_top[(2 * h + 1) * 16 + li];
                                sc[h * 16 + pos] = cv[q][m];
                            }
                            eq_before += __popcll(em); sel_before += __popcll(sm);
                        }
                    }
                }
                LDS_FENCE();
#pragma unroll
                for (int half = 0; half < 2; ++half) {
                    const int e = half * 64 + lane;
                    const float v = sc[e];
                    const float mx = row16_allmax(v);
                    const float pe = __expf(v - mx);
                    const float sm = row16_allsum(pe);
                    const float gate = pe * __builtin_amdgcn_rcpf(sm);
                    const int eid = ex[e];
                    const int pos = __hip_atomic_fetch_add(cnt + (eid >> 8), 1, __ATOMIC_RELAXED, __HIP_MEMORY_SCOPE_WORKGROUP);
                    uns_m[e] = eid | (pos << 14); uns_g[e] = gate;
                }
                LDS_FENCE();
                {
                    const int c = cnt[lane];
                    const int incl = wave_incl_scan(c);
                    base[lane] = incl - c;
                    LDS_FENCE();
#pragma unroll
                    for (int i = 0; i < 2; ++i) {
                        const int rm = uns_m[i * 64 + lane]; const float rg = uns_g[i * 64 + lane];
                        const int eid = rm & 16383, pos = rm >> 14;
                        const int dst = tt * 128 + base[eid >> 8] + pos;
                        se[dst] = (unsigned short)eid; sw[dst] = rg;
                    }
                    LDS_FENCE();
                }
            }
          }
          const int round = it5 - lead;
          if (round >= 0 && round < 4) {
            const size_t tok0 = (size_t)tg * 128 + wid * 16 + round * 4;
            LAS unsigned short* se = (LAS unsigned short*)(wl + 4608 + (round & 1) * 3072);
            LAS float* sw = (LAS float*)(wl + 4608 + (round & 1) * 3072 + 1024);
            const size_t tokg = tok0 + grp;
            const LAS unsigned short* me = se + grp * 128; LAS float* mw = sw + grp * 128;
            {
                const int li = launder(tid) & 15;
                h16x8 xr[2][4];
#pragma unroll
                for (int c = 0; c < 2; ++c)
#pragma unroll
                    for (int j = 0; j < 4; ++j) xr[c][j] = *(const h16x8*)(H2 + tokg * 1024 + c * 512 + li * 32 + 8 * j);
                float acc[64];
#pragma unroll
                for (int i = 0; i < 64; ++i) acc[i] = 0.f;
                i32x4 ru[2][2], rv[2][4]; float su[2], sv[2];
#define ELD(J, S_) do { const int e_ = me[(S_)]; const unsigned char* rp_ = U4 + (size_t)e_ * 1536 + li * 16; \
        ru[J][0] = *(const i32x4*)rp_; ru[J][1] = *(const i32x4*)(rp_ + 256); \
        _Pragma("unroll") for (int c = 0; c < 4; ++c) rv[J][c] = *(const i32x4*)(rp_ + 512 + c * 256); \
        { const f32x2 s2_ = *(const f32x2*)(USC + 2 * e_); su[J] = s2_.x; sv[J] = s2_.y; } } while (0)
#define ECP(J, S_) do { float d = 0.f; \
        _Pragma("unroll") for (int c = 0; c < 2; ++c) _Pragma("unroll") for (int k = 0; k < 4; ++k) { const h16x8 xv = xr[c][k]; const int w_ = ru[J][c][k]; \
            d = __builtin_amdgcn_fdot2(__builtin_amdgcn_cvt_scalef32_pk_f16_fp4(w_, 1.0f, 0), (h16x2){xv[0], xv[1]}, d, false); \
            d = __builtin_amdgcn_fdot2(__builtin_amdgcn_cvt_scalef32_pk_f16_fp4(w_, 1.0f, 1), (h16x2){xv[2], xv[3]}, d, false); \
            d = __builtin_amdgcn_fdot2(__builtin_amdgcn_cvt_scalef32_pk_f16_fp4(w_, 1.0f, 2), (h16x2){xv[4], xv[5]}, d, false); \
            d = __builtin_amdgcn_fdot2(__builtin_amdgcn_cvt_scalef32_pk_f16_fp4(w_, 1.0f, 3), (h16x2){xv[6], xv[7]}, d, false); } \
        d = row16_allsum(d); \
        const float wt_ = mw[(S_)] * gelu_tanh(d * su[J]) * sv[J]; \
        _Pragma("unroll") for (int c = 0; c < 4; ++c) _Pragma("unroll") for (int k = 0; k < 4; ++k) { \
            const f32x2 lo = __builtin_amdgcn_cvt_pk_f32_fp8(rv[J][c][k], false), hi = __builtin_amdgcn_cvt_pk_f32_fp8(rv[J][c][k], true); \
            acc[c * 16 + 4 * k] += wt_ * lo.x; acc[c * 16 + 4 * k + 1] += wt_ * lo.y; acc[c * 16 + 4 * k + 2] += wt_ * hi.x; acc[c * 16 + 4 * k + 3] += wt_ * hi.y; } } while (0)
                ELD(0, 0); ELD(1, 1);
#pragma unroll 1
                for (int s = 0; s < 128; s += 2) {
                    ECP(0, s);     if (s + 2 < 128) ELD(0, s + 2);
                    ECP(1, s + 1); if (s + 3 < 128) ELD(1, s + 3);
                }
#undef ELD
#undef ECP
                float* xo = p.out + tokg * 1024 + li * 16;
                const h16* x1h = (const h16*)(ws + OFF_X1H) + tokg * 1024 + li * 16;
                const int b = (int)(tokg >> 11);
                const float* g2 = mod + (size_t)b * 6144 + 5 * 1024 + li * 16;
                const float* fg = p.in[I_FG] + li * 16;
                float ss = 0.f;
#pragma unroll
                for (int c = 0; c < 4; ++c) {
#pragma unroll
                    for (int q4 = 0; q4 < 4; ++q4) {
                        const h16x4 xh_ = *(const h16x4*)(x1h + c * 256 + q4 * 4);
                        const f32x4 xv = (f32x4){(float)xh_[0], (float)xh_[1], (float)xh_[2], (float)xh_[3]}, gv = *(const f32x4*)(g2 + c * 256 + q4 * 4);
#pragma unroll
                        for (int j = 0; j < 4; ++j) { const float t = xv[j] + gv[j] * acc[c * 16 + q4 * 4 + j]; acc[c * 16 + q4 * 4 + j] = t; ss += t * t; }
                    }
                    asm volatile("" : "+v"(ss) :: "memory");
                }
                ss = row16_allsum(ss);
                const float r = rsqrtf(ss * (1.0f / 1024.0f) + 1e-6f);
#pragma unroll
                for (int c = 0; c < 4; ++c) {
#pragma unroll
                    for (int q4 = 0; q4 < 4; ++q4) {
                        const f32x4 fv = *(const f32x4*)(fg + c * 256 + q4 * 4);
                        f32x4 ov;
#pragma unroll
                        for (int j = 0; j < 4; ++j) ov[j] = acc[c * 16 + q4 * 4 + j] * r * fv[j];
                        *(f32x4*)(xo + c * 256 + q4 * 4) = ov;
                    }
                    asm volatile("" ::: "memory");
                }
            }
            LDS_FENCE();
          }
        }
    }
}

__global__ void __launch_bounds__(512, 2) mega(Params p) {
    extern __shared__ __attribute__((aligned(16))) unsigned char shm[];
    LAS unsigned char* lds = (LAS unsigned char*)shm;
    cg::grid_group grid = cg::this_grid();
    unsigned char* ws = p.ws;
    const int G = (int)gridDim.x, c = (int)blockIdx.x;
    unsigned* bar = (unsigned*)(ws + OFF_BAR); unsigned epoch = 0;
    volatile LAS unsigned* xst = (volatile LAS unsigned*)(lds + (LDS_BYTES - 16));
    if (threadIdx.x < 2) xst[threadIdx.x] = 0u;
    __syncthreads();
    const XcdBarrier xb = xcd_barrier_post(bar, xst);

    if (p.ws == nullptr) grid.sync();
    phase0(p, (float*)shm);
    xcd_barrier(xb);
    phase1(p, (float*)shm);
    xcd_barrier(xb);
    {
        pg8::StaticOrder S; S.init(NTOK, INC, G, c);
        pg8::Gemm g{ws + OFF_R1, ws + OFF_WINT, 1024, 1024, NTOK, INC, 1024, 0};
        EpiIn E{(h16*)(ws + OFF_QB), (h16*)(ws + OFF_KB), (h16*)(ws + OFF_VT), (h16*)(ws + OFF_GUV), (h16*)(ws + OFF_GATES)};
        pg8::gemm_phase(lds, g, S, E);
        pg8::StaticOrder S2; S2.init(NCTXT, 1024, G, c);
        pg8::Gemm g2{ws + OFF_HC, ws + OFF_WINT + (size_t)512 * 1024 * 2, 1024, 1024, NCTXT, 1024, 1024, 0};
        EpiCtx E2{(h16*)(ws + OFF_KC), (h16*)(ws + OFF_VCT)};
        pg8::gemm_phase(lds, g2, S2, E2);
    }
    xcd_barrier(xb);
    {
        for (int rep3 = 0; rep3 < REP_P3; ++rep3) {
        for (int u = c; u < 512; u += G) attn_unit(p, u);
        for (int n = c; n < 256; n += G) sgu_unit(p, n, lds);
        }
    }
    xcd_barrier(xb);
    {
        pg8::StaticOrder S; S.init(NTOK, 1024, G, c);
        pg8::Gemm ga{ws + OFF_R1, ws + OFF_WPAT, 1024, 512, NTOK, 1024, 512, 0};
        EpiM1 E1{(h16*)(ws + OFF_M1), (const h16*)(ws + OFF_GATES)};
        pg8::gemm_phase(lds, ga, S, E1);
        pg8::Gemm gb{ws + OFF_R1 + 1024, ws + OFF_WPBT, 1024, 512, NTOK, 1024, 512, 0};
        EpiM2 E2{(const h16*)(ws + OFF_M1), (const h16*)(ws + OFF_GATES), (h16*)(ws + OFF_MM)};
        pg8::gemm_phase(lds, gb, S, E2);
    }
    xcd_barrier(xb);
    {
        pg8::StaticOrder S; S.init(NTOK, 1024, G, c);
        pg8::Gemm g{ws + OFF_MM, ws + OFF_WOUTT, 1024, 1024, NTOK, 1024, 1024, 0};
        EpiX1 E{p.in[I_X], (const float*)(ws + OFF_MOD), (h16*)(ws + OFF_X1H)};
        pg8::gemm_phase(lds, g, S, E);
    }
    xcd_barrier(xb);
    phase6(p, (float*)shm);
    xcd_barrier(xb);
    {
        pg8::StaticOrder S; S.init(NTOK, 2048, G, c);
        pg8::Gemm g{ws + OFF_R1, ws + OFF_WQT, 1024, 1024, NTOK, 2048, 1024, 0};
        EpiH16 E{(h16*)(ws + OFF_SC16), 2048};
        pg8::gemm_phase(lds, g, S, E);
    }
    xcd_barrier(xb);
    peer_phase(p, lds, bar, epoch);
}

extern "C" void kernel_launch(void* const* d_in, const int* in_sizes, int n_in, void* d_out, int out_size, void* d_ws, size_t ws_size, hipStream_t stream) {
    static int grid_blocks = 0;
    if (!grid_blocks) {
        int dev = 0, cus = 0, per_cu = 0;
        hipGetDevice(&dev);
        hipDeviceGetAttribute(&cus, hipDeviceAttributeMultiprocessorCount, dev);
        hipFuncSetAttribute((const void*)mega, hipFuncAttributeMaxDynamicSharedMemorySize, LDS_BYTES);
        hipOccupancyMaxActiveBlocksPerMultiprocessor(&per_cu, (const void*)mega, 512, LDS_BYTES);
        if (per_cu < 1) per_cu = 1;
        grid_blocks = cus * per_cu;
        if (ws_size < WS_END) fprintf(stderr, "kernel_launch: workspace too small: %zu < %zu\n", ws_size, (size_t)WS_END);
    }
    hipMemsetAsync((unsigned char*)d_ws + OFF_BAR, 0, 16384, stream);
    Params p{};
    for (int i = 0; i < 21; ++i) p.in[i] = (const float*)d_in[i];
    p.out = (float*)d_out; p.ws = (unsigned char*)d_ws;
    void* args[] = {&p};
    hipError_t e = hipLaunchCooperativeKernel((const void*)mega, dim3(grid_blocks), dim3(512), args, LDS_BYTES, stream);
    if (e != hipSuccess) fprintf(stderr, "cooperative launch failed: %s (grid %d)\n", hipGetErrorString(e), grid_blocks);
}
```

```cpp
#include <hip/hip_runtime.h>
#include <hip/hip_cooperative_groups.h>
#include <cstdio>
namespace cg = cooperative_groups;

#define LAS __attribute__((address_space(3)))
typedef _Float16 h16;
typedef _Float16 h16x2 __attribute__((ext_vector_type(2)));
typedef _Float16 h16x4 __attribute__((ext_vector_type(4)));
typedef _Float16 h16x8 __attribute__((ext_vector_type(8)));
typedef float f32x4 __attribute__((ext_vector_type(4)));
typedef float f32x2 __attribute__((ext_vector_type(2)));
typedef int i32x4 __attribute__((ext_vector_type(4)));
typedef int i32x2 __attribute__((ext_vector_type(2)));

constexpr int NTOK = 32768, DM = 1024, NCTXT = 4096, INC = 4608, SEQ = 2048, CTXL = 256;
constexpr int LDS_BYTES = 144 * 1024;
#ifndef REP_SEL
#define REP_SEL 1
#endif
#ifndef REP_GATH
#define REP_GATH 1
#endif
#ifndef REP_P3
#define REP_P3 1
#endif

constexpr size_t al256(size_t x) { return (x + 255) & ~(size_t)255; }
constexpr size_t OFF_WINT = 0;
constexpr size_t OFF_WPAT = OFF_WINT + (size_t)INC * DM * 2;
constexpr size_t OFF_WPBT = OFF_WPAT + (size_t)1024 * 512 * 2;
constexpr size_t OFF_WOUTT = OFF_WPBT + (size_t)1024 * 512 * 2;
constexpr size_t OFF_WQT = OFF_WOUTT + (size_t)1024 * 1024 * 2;
constexpr size_t OFF_BD = OFF_WQT + (size_t)2048 * 1024 * 2;
constexpr size_t OFF_U16 = OFF_BD + (size_t)2048 * 256 * 2;
constexpr size_t OFF_V16 = OFF_U16 + (size_t)16384 * 1024 * 2;
constexpr size_t OFF_WS16 = OFF_V16 + (size_t)16384 * 1024 * 2;
constexpr size_t OFF_MODP = OFF_WS16 + (size_t)8 * 128 * 128 * 2;
constexpr size_t OFF_MOD = OFF_MODP + (size_t)16 * 17 * 6144 * 4;
constexpr size_t OFF_R1 = al256(OFF_MOD + (size_t)17 * 6144 * 4);
constexpr size_t OFF_QB = OFF_R1 + (size_t)NTOK * DM * 2;
constexpr size_t OFF_KB = OFF_QB + (size_t)NTOK * 512 * 2;
constexpr size_t OFF_VT = OFF_KB + (size_t)NTOK * 512 * 2;
constexpr size_t OFF_GUV = OFF_VT + (size_t)NTOK * 512 * 2;
constexpr size_t OFF_GATES = OFF_GUV + (size_t)NTOK * 1024 * 2;
constexpr size_t OFF_MM = OFF_GATES + (size_t)NTOK * 2048 * 2;
constexpr size_t OFF_BAR = OFF_MM + (size_t)NTOK * DM * 2;
constexpr size_t WS_END = OFF_BAR + 16384;
constexpr size_t OFF_U8 = OFF_U16;
constexpr size_t OFF_USC = OFF_V16;
constexpr size_t OFF_V8 = OFF_V16;
constexpr size_t OFF_VSC = OFF_V16 + (size_t)16384 * 1024;
constexpr size_t OFF_M1 = OFF_QB;
constexpr size_t OFF_SC16 = OFF_QB;
constexpr size_t OFF_Q16 = OFF_GATES;
constexpr size_t OFF_X1H = OFF_GATES;
constexpr size_t OFF_HC = OFF_MM;
constexpr size_t OFF_KC = OFF_HC + (size_t)NCTXT * DM * 2;
constexpr size_t OFF_VCT = OFF_KC + (size_t)NCTXT * 512 * 2;
static_assert(OFF_M1 + (size_t)NTOK * DM * 4 <= OFF_GATES, "m1 alias");
static_assert(WS_END <= (size_t)512 * 1024 * 1024, "workspace");

struct Params {
    const float* in[21];
    float* out;
    unsigned char* ws;
};
enum { I_X = 0, I_C, I_CTX, I_CCTX, I_ADAW, I_ADAB, I_N1G, I_N2G, I_WIN, I_RPB, I_LNG, I_GMWS, I_GMBS, I_WPA, I_WPB, I_WOUT, I_WQ, I_KEYS, I_PU, I_PV, I_FG };

__device__ __forceinline__ int launder(int x) { asm volatile("" : "+v"(x)); return x; }
__device__ __forceinline__ int fresh_tid() { int t = threadIdx.x; asm volatile("" : "+v"(t)); return t; }

__device__ __forceinline__ float sigmoidf_(float x) { return __builtin_amdgcn_rcpf(1.0f + __expf(-x)); }
__device__ __forceinline__ float gelu_tanh(float x) {
    const float t = 0.7978845608028654f * (x + 0.044715f * x * x * x);
    return x * __builtin_amdgcn_rcpf(1.0f + __expf(-2.0f * t));
}
__device__ __forceinline__ float silu_(float x) { return x * __builtin_amdgcn_rcpf(1.0f + __expf(-x)); }
__device__ __forceinline__ float wave_sum(float v) {
#pragma unroll
    for (int o = 32; o > 0; o >>= 1) v += __shfl_xor(v, o);
    return v;
}
__device__ __forceinline__ h16x8 pack8(f32x4 a, f32x4 b) {
    h16x8 o;
    o[0] = (h16)a[0]; o[1] = (h16)a[1]; o[2] = (h16)a[2]; o[3] = (h16)a[3];
    o[4] = (h16)b[0]; o[5] = (h16)b[1]; o[6] = (h16)b[2]; o[7] = (h16)b[3];
    return o;
}


__device__ __forceinline__ void grid_bar(unsigned* ctr, unsigned& epoch, unsigned nblk) {
    __syncthreads();
    epoch += 1u;
    if (threadIdx.x == 0) {
        __builtin_amdgcn_fence(__ATOMIC_RELEASE, "agent");
        asm volatile("s_waitcnt vmcnt(0)" ::: "memory");
        __hip_atomic_fetch_add(ctr, 1u, __ATOMIC_RELAXED, __HIP_MEMORY_SCOPE_AGENT);
        const unsigned target = epoch * nblk;
        unsigned spins = 0;
        while (__hip_atomic_load(ctr, __ATOMIC_RELAXED, __HIP_MEMORY_SCOPE_AGENT) < target) { __builtin_amdgcn_s_sleep(2); if (++spins > (1u << 24)) break; }
        __builtin_amdgcn_fence(__ATOMIC_ACQUIRE, "agent");
        asm volatile("s_waitcnt vmcnt(0)" ::: "memory");
    }
    __syncthreads();
}


#define XB_TMO      128
#define XB_XCNT(j)  (256  + 64 * (j))
#define XB_XSUB(j)  (1280 + 64 * (j))
#define XB_XGEN(j)  (2304 + 64 * (j))
#define XB_TOP      3328
#define XB_TOPGEN   3392
#define XCD_BAR_WORDS 3456
#define XB_SPIN_CAP (1u << 20)
__device__ __forceinline__ unsigned xb_ld(unsigned* p)              { return __hip_atomic_load(p, __ATOMIC_RELAXED, __HIP_MEMORY_SCOPE_AGENT); }
__device__ __forceinline__ unsigned xb_add(unsigned* p, unsigned v) { return __hip_atomic_fetch_add(p, v, __ATOMIC_RELAXED, __HIP_MEMORY_SCOPE_AGENT); }
__device__ __forceinline__ unsigned xb_xcc_id() { return (unsigned)__builtin_amdgcn_s_getreg((3 << 11) | 20) & 0xFu; }
#define XB_SPIN(cond, bar) do { unsigned _sp = 0; while (cond) { __builtin_amdgcn_s_sleep(1); \
    if ((++_sp & 255u) == 0u) { if (xb_ld(&(bar)[XB_TMO])) break; if (_sp > XB_SPIN_CAP) { atomicAdd(&(bar)[XB_TMO], 1u); break; } } } } while (0)
struct XcdBarrier { unsigned* bar; unsigned x; volatile LAS unsigned* st; };
__device__ __forceinline__ XcdBarrier xcd_barrier_post(unsigned* bar, volatile LAS unsigned* st) {
    XcdBarrier b; b.bar = bar; b.x = xb_xcc_id(); b.st = st;
    if (threadIdx.x == 0) (void)xb_add(&bar[XB_XCNT(b.x)], 1u);
    return b;
}
__device__ __forceinline__ void xcd_barrier_complete(unsigned* bar, unsigned x, unsigned& nloc, unsigned& nx) {
    const unsigned G = gridDim.x * gridDim.y * gridDim.z;
    unsigned sum, cnt, mine, sp = 0u;
    for (;;) {
        sum = 0u; cnt = 0u; mine = 0u;
#pragma unroll
        for (unsigned j = 0; j < 16; ++j) { const unsigned c = xb_ld(&bar[XB_XCNT(j)]); sum += c; cnt += (c > 0u) ? 1u : 0u; mine = (j == x) ? c : mine; }
        if (sum == G) break;
        __builtin_amdgcn_s_sleep(1);
        if ((++sp & 255u) == 0u) { if (xb_ld(&bar[XB_TMO])) break; if (sp > XB_SPIN_CAP) { atomicAdd(&bar[XB_TMO], 1u); break; } }
    }
    nloc = mine > 0u ? mine : 1u; nx = cnt > 0u ? cnt : 1u;
}
__device__ __forceinline__ void xcd_barrier(const XcdBarrier& b) {
    asm volatile("s_waitcnt vmcnt(0)" ::: "memory");
    __syncthreads();
    if (threadIdx.x == 0) {
        unsigned* bar = b.bar;
        __builtin_amdgcn_s_waitcnt(0);
        unsigned nloc = b.st[0], nx = b.st[1];
        if (nloc == 0u) { xcd_barrier_complete(bar, b.x, nloc, nx); b.st[0] = nloc; b.st[1] = nx; }
        const unsigned old = xb_add(&bar[XB_XSUB(b.x)], 1u);
        const unsigned gen = old / nloc;
        if (old + 1u == (gen + 1u) * nloc) {
            __builtin_amdgcn_fence(__ATOMIC_RELEASE, "agent");
            asm volatile("s_waitcnt vmcnt(0)" ::: "memory");
            const unsigned og = xb_add(&bar[XB_TOP], 1u);
            const unsigned tg = og / nx;
            if (og + 1u == (tg + 1u) * nx) xb_add(&bar[XB_TOPGEN], 1u);
            else XB_SPIN(xb_ld(&bar[XB_TOPGEN]) == tg, bar);
            __builtin_amdgcn_fence(__ATOMIC_ACQUIRE, "agent");
            xb_add(&bar[XB_XGEN(b.x)], 1u);
            asm volatile("s_waitcnt vmcnt(0)" ::: "memory");
        } else {
            XB_SPIN(xb_ld(&bar[XB_XGEN(b.x)]) == gen, bar);
            __builtin_amdgcn_fence(__ATOMIC_ACQUIRE, "agent");
            asm volatile("s_waitcnt vmcnt(0)" ::: "memory");
        }
    }
    __syncthreads();
}

namespace pg8 {
constexpr int BM = 256, BK = 64, HALF = 128, HTB = HALF * BK * 2, STAGE_BYTES = 8 * HTB, NXCD = 8, WGM = 8;
__device__ __forceinline__ int lds_byte(int r, int c) { const int st = (r >> 4) * 2 + (c >> 5), rr = r & 15, cc = c & 31, ob = rr * 64 + cc * 2; return st * 1024 + (ob ^ (((ob >> 9) & 1) << 5)); }
__device__ __forceinline__ void stage_rc(int b, int& R, int& C) { const int st = b / 1024, sb = b % 1024, swz = sb ^ (((sb >> 9) & 1) << 5); R = (st >> 1) * 16 + swz / 64; C = (st & 1) * 32 + (swz % 64) / 2; }
__device__ __forceinline__ int perm32(int rho) { const int n = rho >> 4, i = rho & 15; return 8 * (i >> 2) + 4 * n + (i & 3); }

struct Unit { int pm, pn; };
struct Gemm { const void* A; const void* Bt; int lda, ldb, M, N, K, a_pn_bytes; };

struct StaticOrder {
    int nM, nN, nwg, G, c;
    __device__ void init(int M, int N, int G_, int c_) { nM = M / BM; nN = N / BM; nwg = nM * nN; G = G_; c = c_; }
    __device__ bool next(int i, Unit& u) const {
        const long L = (long)i * G + c; if (L >= nwg) return false;
        int wgid = (int)L; { const int q = nwg / NXCD, r = nwg % NXCD, xcd = wgid % NXCD, off = wgid / NXCD; wgid = (xcd < r ? xcd * (q + 1) : r * (q + 1) + (xcd - r) * q) + off; }
        const int nig = WGM * nN, gid = wgid / nig, fm = gid * WGM, gsz = (nM - fm) < WGM ? (nM - fm) : WGM;
        u.pm = fm + ((wgid % nig) % gsz); u.pn = (wgid % nig) / gsz; return true;
    }
};

template <class Epi>
__device__ __forceinline__ void gemm_phase(LAS unsigned char* lds, const Gemm g, const StaticOrder& S, const Epi& E) {
    const int tid = fresh_tid(), wid = __builtin_amdgcn_readfirstlane(tid >> 6), lane = tid & 63, wr = wid >> 2, wc = wid & 3, fr = lane & 15, fq = lane >> 4;
    const int K = g.K, nt = K / BK;
    unsigned voffA[2], voffB[2];
#pragma unroll
    for (int i = 0; i < 2; ++i) { int R, C; stage_rc(tid * 16 + i * 8192, R, C); const int Rb = (R & ~31) + perm32(R & 31);
        voffA[i] = (unsigned)(R * g.lda + C) * 2u; voffB[i] = (unsigned)(Rb * g.ldb + C) * 2u; }
    const size_t kstep = (size_t)(BK * 2);
    const size_t hstepA = (size_t)HALF * g.lda * 2, hstepB = (size_t)HALF * g.ldb * 2;
    const size_t tstepA = 2 * hstepA, tstepB = 2 * hstepB;
    const unsigned ldsw = (unsigned)wid * 1024u;
    const int aoff = lds_byte(wr * 64 + fr, fq * 8), boff = lds_byte(wc * 32 + fr, fq * 8);
#define PG8_SA(b, h) (((b) * 2 + (h)) * HTB)
#define PG8_SB(b, h) ((4 + (b) * 2 + (h)) * HTB)
#define PG8_STAGE(bufoff, gbase, voff) do { _Pragma("unroll") for (int _i = 0; _i < 2; ++_i) \
        __builtin_amdgcn_global_load_lds((const unsigned*)((const char*)(gbase) + (voff)[_i]), (LAS unsigned*)(lds + (bufoff) + ldsw + _i * 8192), 16, 0, 0); } while (0)
#define PG8_LDA(dst, b, h) do { _Pragma("unroll") for (int m = 0; m < 4; ++m) _Pragma("unroll") for (int k = 0; k < 2; ++k) dst[m][k] = *(const LAS h16x8*)(lds + PG8_SA(b, h) + aoff + m * 2048 + k * 1024); } while (0)
#define PG8_LDB(dst, b, h) do { _Pragma("unroll") for (int n = 0; n < 2; ++n) _Pragma("unroll") for (int k = 0; k < 2; ++k) dst[n][k] = *(const LAS h16x8*)(lds + PG8_SB(b, h) + boff + n * 2048 + k * 1024); } while (0)
#define PG8_MMA(ai, bj, At, Bt) do { __builtin_amdgcn_s_setprio(1); _Pragma("unroll") for (int m = 0; m < 4; ++m) _Pragma("unroll") for (int n = 0; n < 2; ++n) _Pragma("unroll") for (int k = 0; k < 2; ++k) \
        acc[ai][bj][m][n] = __builtin_amdgcn_mfma_f32_16x16x32_f16(Bt[n][k], At[m][k], acc[ai][bj][m][n], 0, 0, 0); __builtin_amdgcn_s_setprio(0); } while (0)
#define PG8_WAIT_V(n) asm volatile("s_waitcnt vmcnt(" #n ")" ::: "memory")
#define PG8_WAIT_L(n) asm volatile("s_waitcnt lgkmcnt(" #n ")" ::: "memory")
#define PG8_BAR __builtin_amdgcn_s_barrier()
#define PG8_SCHED __builtin_amdgcn_sched_barrier(0)
    Unit cur, nxt; int ui = 0;
    if (!S.next(0, cur)) return;
    f32x4 acc[2][2][4][2];
#pragma unroll
    for (int a = 0; a < 2; ++a)
#pragma unroll
        for (int b = 0; b < 2; ++b)
#pragma unroll
            for (int m = 0; m < 4; ++m)
#pragma unroll
                for (int n = 0; n < 2; ++n) acc[a][b][m][n] = (f32x4){0.f, 0.f, 0.f, 0.f};
    h16x8 At[4][2], B0[2][2], B1[2][2];
    const char* cA = (const char*)g.A + (size_t)cur.pm * tstepA + (size_t)cur.pn * g.a_pn_bytes; const char* cB = (const char*)g.Bt + (size_t)cur.pn * tstepB;
    PG8_STAGE(PG8_SB(0, 0), cB, voffB); PG8_STAGE(PG8_SA(0, 0), cA, voffA); PG8_STAGE(PG8_SB(0, 1), cB + hstepB, voffB); PG8_STAGE(PG8_SA(0, 1), cA + hstepA, voffA);
    if (wr == 1) PG8_BAR;
    PG8_WAIT_V(4); PG8_BAR;
    PG8_STAGE(PG8_SB(1, 0), cB + kstep, voffB); PG8_STAGE(PG8_SA(1, 0), cA + kstep, voffA); PG8_STAGE(PG8_SB(1, 1), cB + hstepB + kstep, voffB);
    PG8_WAIT_V(6); PG8_BAR;
    for (;;) {
        const bool has_next = S.next(ui + 1, nxt);
        const char* nA = has_next ? (const char*)g.A + (size_t)nxt.pm * tstepA + (size_t)nxt.pn * g.a_pn_bytes : cA; const char* nB = has_next ? (const char*)g.Bt + (size_t)nxt.pn * tstepB : cB;
        for (int t = 0; t < nt; t += 2) {
            const bool last = (t == nt - 2);
            const char* a1 = cA + (size_t)(t + 1) * kstep;
            const char* a2 = last ? nA : cA + (size_t)(t + 2) * kstep; const char* b2 = last ? nB : cB + (size_t)(t + 2) * kstep;
            const char* a3 = a2 + kstep; const char* b3 = b2 + kstep;
            PG8_LDB(B0, 0, 0); PG8_SCHED; PG8_LDA(At, 0, 0); PG8_STAGE(PG8_SA(1, 1), a1 + hstepA, voffA);
            PG8_WAIT_L(8); PG8_BAR; PG8_WAIT_L(0); PG8_MMA(0, 0, At, B0); PG8_BAR; PG8_SCHED;
            PG8_LDB(B1, 0, 1); PG8_STAGE(PG8_SB(0, 0), b2, voffB);
            PG8_BAR; PG8_WAIT_L(0); PG8_MMA(0, 1, At, B1); PG8_BAR;
            PG8_LDA(At, 0, 1); PG8_STAGE(PG8_SA(0, 0), a2, voffA);
            PG8_BAR; PG8_WAIT_L(0); PG8_MMA(1, 0, At, B0); PG8_BAR; PG8_SCHED;
            PG8_STAGE(PG8_SB(0, 1), b2 + hstepB, voffB);
            PG8_WAIT_V(6); PG8_BAR; PG8_MMA(1, 1, At, B1); PG8_BAR;
            PG8_LDB(B0, 1, 0); PG8_SCHED; PG8_LDA(At, 1, 0); PG8_STAGE(PG8_SA(0, 1), a2 + hstepA, voffA);
            PG8_WAIT_L(8); PG8_BAR; PG8_WAIT_L(0); PG8_MMA(0, 0, At, B0); PG8_BAR; PG8_SCHED;
            PG8_LDB(B1, 1, 1); PG8_STAGE(PG8_SB(1, 0), b3, voffB);
            PG8_BAR; PG8_WAIT_L(0); PG8_MMA(0, 1, At, B1); PG8_BAR;
            PG8_LDA(At, 1, 1); PG8_STAGE(PG8_SA(1, 0), a3, voffA);
            PG8_BAR; PG8_WAIT_L(0); PG8_MMA(1, 0, At, B0); PG8_BAR; PG8_SCHED;
            PG8_STAGE(PG8_SB(1, 1), b3 + hstepB, voffB);
            PG8_WAIT_V(6); PG8_BAR; PG8_MMA(1, 1, At, B1); PG8_BAR;
        }
        E(acc, cur, wr, wc, fr, fq);
        if (!has_next) break;
#pragma unroll
        for (int a = 0; a < 2; ++a)
#pragma unroll
            for (int b = 0; b < 2; ++b)
#pragma unroll
                for (int m = 0; m < 4; ++m)
#pragma unroll
                    for (int n = 0; n < 2; ++n) acc[a][b][m][n] = (f32x4){0.f, 0.f, 0.f, 0.f};
        cur = nxt; cA = nA; cB = nB; ++ui;
    }
    PG8_WAIT_V(0);
    if (wr == 0) PG8_BAR;
    PG8_BAR;
#undef PG8_SA
#undef PG8_SB
#undef PG8_STAGE
#undef PG8_LDA
#undef PG8_LDB
#undef PG8_MMA
#undef PG8_WAIT_V
#undef PG8_WAIT_L
#undef PG8_BAR
#undef PG8_SCHED
}
}
typedef f32x4 AccT[2][2][4][2];

struct EpiIn {
    h16 *qb, *kb, *vt, *guv, *gates;
    __device__ __forceinline__ void operator()(const AccT& acc, const pg8::Unit& u, int wr, int wc, int fr, int fq) const {
        const int pn = u.pn;
        const int row0 = u.pm * 256 + wr * 64 + fr;
        const int cin = wc * 32 + 8 * fq;
        const int b = (u.pm * 256) >> 11, sb = ((u.pm * 256) & 2047) + wr * 64;
        if (pn < 2) {
            h16* base = qb + (size_t)row0 * 512 + pn * 256 + cin;
#pragma unroll
            for (int ai = 0; ai < 2; ++ai)
#pragma unroll
                for (int m = 0; m < 4; ++m)
#pragma unroll
                    for (int bj = 0; bj < 2; ++bj) *(h16x8*)(base + (ai * 128 + m * 16) * 512 + bj * 128) = pack8(acc[ai][bj][m][0], acc[ai][bj][m][1]);
        } else if (pn < 4) {
#pragma unroll
            for (int bj = 0; bj < 2; ++bj) {
                const int col = (pn & 1) * 256 + bj * 128 + cin, hd = col >> 6, d0 = col & 63;
                h16* base = kb + ((size_t)(b * 8 + hd) * 2048 + sb + fr) * 64 + d0;
#pragma unroll
                for (int ai = 0; ai < 2; ++ai)
#pragma unroll
                    for (int m = 0; m < 4; ++m) *(h16x8*)(base + (ai * 128 + m * 16) * 64) = pack8(acc[ai][bj][m][0], acc[ai][bj][m][1]);
            }
        } else if (pn < 6) {
#pragma unroll
            for (int bj = 0; bj < 2; ++bj) {
                const int cv = (pn - 4) * 256 + bj * 128 + cin, hd = cv >> 6, d0 = cv & 63;
                h16* base = vt + ((size_t)(b * 8 + hd) * 256 + (sb >> 3) + (fr >> 3)) * 512 + d0 * 8 + (fr & 7);
#pragma unroll
                for (int ai = 0; ai < 2; ++ai)
#pragma unroll
                    for (int m = 0; m < 4; ++m) {
                        h16* vp = base + (ai * 16 + m * 2) * 512;
                        const f32x4 v0 = acc[ai][bj][m][0], v1 = acc[ai][bj][m][1];
#pragma unroll
                        for (int i = 0; i < 4; ++i) { vp[i * 8] = (h16)v0[i]; vp[(i + 4) * 8] = (h16)v1[i]; }
                    }
            }
        } else if (pn < 10) {
            h16* base = guv + (size_t)row0 * 1024 + (pn - 6) * 256 + cin;
#pragma unroll
            for (int ai = 0; ai < 2; ++ai)
#pragma unroll
                for (int m = 0; m < 4; ++m)
#pragma unroll
                    for (int bj = 0; bj < 2; ++bj) {
                        f32x4 v0 = acc[ai][bj][m][0], v1 = acc[ai][bj][m][1];
#pragma unroll
                        for (int i = 0; i < 4; ++i) { v0[i] = gelu_tanh(v0[i]); v1[i] = gelu_tanh(v1[i]); }
                        *(h16x8*)(base + (ai * 128 + m * 16) * 1024 + bj * 128) = pack8(v0, v1);
                    }
        } else {
            h16* base = gates + (size_t)row0 * 2048 + (pn - 10) * 256 + cin;
#pragma unroll
            for (int ai = 0; ai < 2; ++ai)
#pragma unroll
                for (int m = 0; m < 4; ++m)
#pragma unroll
                    for (int bj = 0; bj < 2; ++bj) {
                        f32x4 v0 = acc[ai][bj][m][0], v1 = acc[ai][bj][m][1];
#pragma unroll
                        for (int i = 0; i < 4; ++i) { v0[i] = sigmoidf_(v0[i]); v1[i] = sigmoidf_(v1[i]); }
                        *(h16x8*)(base + (ai * 128 + m * 16) * 2048 + bj * 128) = pack8(v0, v1);
                    }
        }
    }
};
struct EpiCtx {
    h16 *kc, *vct;
    __device__ __forceinline__ void operator()(const AccT& acc, const pg8::Unit& u, int wr, int wc, int fr, int fq) const {
        const int pn = u.pn;
        const int cin = wc * 32 + 8 * fq;
        const int b = u.pm, sb = wr * 64;
        if (pn < 2) {
#pragma unroll
            for (int bj = 0; bj < 2; ++bj) {
                const int col = pn * 256 + bj * 128 + cin, hd = col >> 6, d0 = col & 63;
                h16* base = kc + ((size_t)(b * 8 + hd) * 256 + sb + fr) * 64 + d0;
#pragma unroll
                for (int ai = 0; ai < 2; ++ai)
#pragma unroll
                    for (int m = 0; m < 4; ++m) *(h16x8*)(base + (ai * 128 + m * 16) * 64) = pack8(acc[ai][bj][m][0], acc[ai][bj][m][1]);
            }
        } else {
#pragma unroll
            for (int bj = 0; bj < 2; ++bj) {
                const int cv = (pn - 2) * 256 + bj * 128 + cin, hd = cv >> 6, d0 = cv & 63;
                h16* base = vct + ((size_t)(b * 8 + hd) * 32 + (sb >> 3) + (fr >> 3)) * 512 + d0 * 8 + (fr & 7);
#pragma unroll
                for (int ai = 0; ai < 2; ++ai)
#pragma unroll
                    for (int m = 0; m < 4; ++m) {
                        h16* vp = base + (ai * 16 + m * 2) * 512;
                        const f32x4 v0 = acc[ai][bj][m][0], v1 = acc[ai][bj][m][1];
#pragma unroll
                        for (int i = 0; i < 4; ++i) { vp[i * 8] = (h16)v0[i]; vp[(i + 4) * 8] = (h16)v1[i]; }
                    }
            }
        }
    }
};
struct EpiM1 {
    h16* m1; const h16* gates;
    __device__ __forceinline__ void operator()(const AccT& acc, const pg8::Unit& u, int wr, int wc, int fr, int fq) const {
        const int row0 = u.pm * 256 + wr * 64 + fr, col0 = u.pn * 256 + wc * 32 + 8 * fq;
#pragma unroll
        for (int ai = 0; ai < 2; ++ai)
#pragma unroll
            for (int m = 0; m < 4; ++m) {
                const int row = row0 + ai * 128 + m * 16;
#pragma unroll
                for (int bj = 0; bj < 2; ++bj) {
                    const int col = col0 + bj * 128;
                    const h16x8 gt = *(const h16x8*)(gates + (size_t)row * 2048 + col);
                    f32x4 v0 = acc[ai][bj][m][0], v1 = acc[ai][bj][m][1];
#pragma unroll
                    for (int i = 0; i < 4; ++i) { v0[i] *= (float)gt[i]; v1[i] *= (float)gt[4 + i]; }
                    *(h16x8*)(m1 + (size_t)row * 1024 + col) = pack8(v0, v1);
                }
            }
    }
};
struct EpiM2 {
    const h16* m1; const h16* gates; h16* mm;
    __device__ __forceinline__ void operator()(const AccT& acc, const pg8::Unit& u, int wr, int wc, int fr, int fq) const {
        const int row0 = u.pm * 256 + wr * 64 + fr, col0 = u.pn * 256 + wc * 32 + 8 * fq;
#pragma unroll
        for (int ai = 0; ai < 2; ++ai)
#pragma unroll
            for (int m = 0; m < 4; ++m) {
                const int row = row0 + ai * 128 + m * 16;
#pragma unroll
                for (int bj = 0; bj < 2; ++bj) {
                    const int col = col0 + bj * 128;
                    const h16x8 gt = *(const h16x8*)(gates + (size_t)row * 2048 + 1024 + col);
                    const h16x8 mi = *(const h16x8*)(m1 + (size_t)row * 1024 + col);
                    f32x4 p0 = (f32x4){(float)mi[0], (float)mi[1], (float)mi[2], (float)mi[3]}, p1 = (f32x4){(float)mi[4], (float)mi[5], (float)mi[6], (float)mi[7]};
                    const f32x4 v0 = acc[ai][bj][m][0], v1 = acc[ai][bj][m][1];
#pragma unroll
                    for (int i = 0; i < 4; ++i) { p0[i] += v0[i] * (float)gt[i]; p1[i] += v1[i] * (float)gt[4 + i]; }
                    *(h16x8*)(mm + (size_t)row * 1024 + col) = pack8(p0, p1);
                }
            }
    }
};
struct EpiX1 {
    const float* x; const float* mod; h16* x1;
    __device__ __forceinline__ void operator()(const AccT& acc, const pg8::Unit& u, int wr, int wc, int fr, int fq) const {
        const int row0 = u.pm * 256 + wr * 64 + fr, col0 = u.pn * 256 + wc * 32 + 8 * fq;
        const int b = (u.pm * 256) >> 11;
#pragma unroll
        for (int bj = 0; bj < 2; ++bj) {
            const int col = col0 + bj * 128;
            const float* gp = mod + (size_t)b * 6144 + 2 * 1024 + col;
            const f32x4 g0 = *(const f32x4*)gp, g1 = *(const f32x4*)(gp + 4);
#pragma unroll
            for (int ai = 0; ai < 2; ++ai)
#pragma unroll
                for (int m = 0; m < 4; ++m) {
                    const int row = row0 + ai * 128 + m * 16;
                    const float* xi = x + (size_t)row * 1024 + col;
                    const f32x4 x0 = *(const f32x4*)xi, x1v = *(const f32x4*)(xi + 4);
                    *(h16x8*)(x1 + (size_t)row * 1024 + col) = pack8(x0 + g0 * acc[ai][bj][m][0], x1v + g1 * acc[ai][bj][m][1]);
                }
        }
    }
};
struct EpiH16 {
    h16* o; int ldc;
    __device__ __forceinline__ void operator()(const AccT& acc, const pg8::Unit& u, int wr, int wc, int fr, int fq) const {
        const int row0 = u.pm * 256 + wr * 64 + fr, col0 = u.pn * 256 + wc * 32 + 8 * fq;
#pragma unroll
        for (int ai = 0; ai < 2; ++ai)
#pragma unroll
            for (int m = 0; m < 4; ++m) {
                const int row = row0 + ai * 128 + m * 16;
#pragma unroll
                for (int bj = 0; bj < 2; ++bj)
                    *(h16x8*)(o + (size_t)row * ldc + col0 + bj * 128) = pack8(acc[ai][bj][m][0], acc[ai][bj][m][1]);
            }
    }
};

__device__ __forceinline__ void cvt_tile(const float* __restrict__ src, h16* __restrict__ dst, int tile) {
    const size_t i = (size_t)tile * 4096 + threadIdx.x * 8;
    const f32x4 a = *(const f32x4*)(src + i), b = *(const f32x4*)(src + i + 4);
    *(h16x8*)(dst + i) = pack8(a, b);
}
__device__ __forceinline__ void tr_tile(const float* __restrict__ src, h16* __restrict__ dst, int K, int N, int tile, float* lds) {
    const int ntn = N / 64, tk = tile / ntn, tn = tile % ntn, tid = threadIdx.x;
#pragma unroll
    for (int ps = 0; ps < 2; ++ps) {
        const int k = ps * 32 + (tid >> 4), n = (tid & 15) * 4;
        const f32x4 v = *(const f32x4*)(src + (size_t)(tk * 64 + k) * N + tn * 64 + n);
        lds[k * 65 + n] = v[0]; lds[k * 65 + n + 1] = v[1]; lds[k * 65 + n + 2] = v[2]; lds[k * 65 + n + 3] = v[3];
    }
    __syncthreads();
    {
        const int n = tid >> 3, ks = (tid & 7) * 8;
        h16x8 o;
#pragma unroll
        for (int i = 0; i < 8; ++i) o[i] = (h16)lds[(ks + i) * 65 + n];
        *(h16x8*)(dst + (size_t)(tn * 64 + n) * K + tk * 64 + ks) = o;
    }
    __syncthreads();
}
__device__ __forceinline__ void cvt8_rows(const float* __restrict__ src, unsigned char* __restrict__ dst, float* __restrict__ inv, int tile, int dstride = 1024) {
    const int wid = threadIdx.x >> 6, lane = threadIdx.x & 63;
    const size_t row = (size_t)tile * 8 + wid;
    const float* r = src + row * 1024 + lane * 16;
    f32x4 a[4]; float mx = 0.f;
#pragma unroll
    for (int i = 0; i < 4; ++i) { a[i] = *(const f32x4*)(r + 4 * i); mx = fmaxf(mx, fmaxf(fmaxf(fabsf(a[i][0]), fabsf(a[i][1])), fmaxf(fabsf(a[i][2]), fabsf(a[i][3])))); }
#pragma unroll
    for (int o = 32; o > 0; o >>= 1) mx = fmaxf(mx, __shfl_xor(mx, o));
    int ex2 = 0; float sc = 1.0f;
    if (mx > 0.f) { (void)frexpf(mx, &ex2); int k = 8 - ex2; k = k > 100 ? 100 : (k < -100 ? -100 : k); sc = ldexpf(1.0f, k); }
    i32x4 w;
#pragma unroll
    for (int i = 0; i < 4; ++i) {
        int pk = __builtin_amdgcn_cvt_pk_fp8_f32(a[i][0] * sc, a[i][1] * sc, 0, false);
        pk = __builtin_amdgcn_cvt_pk_fp8_f32(a[i][2] * sc, a[i][3] * sc, pk, true);
        w[i] = pk;
    }
    *(i32x4*)(dst + row * dstride + lane * 16) = w;
    if (lane == 0) inv[2 * row] = 1.0f / sc;
}
__device__ __forceinline__ void cvt4_rows(const float* __restrict__ src, unsigned char* __restrict__ dst, float* __restrict__ inv, int tile, int dstride = 512) {
    const int wid = threadIdx.x >> 6, lane = threadIdx.x & 63;
    const size_t row = (size_t)tile * 8 + wid;
    const float* r = src + row * 1024 + lane * 16;
    f32x4 a[4]; float mx = 0.f;
#pragma unroll
    for (int i = 0; i < 4; ++i) { a[i] = *(const f32x4*)(r + 4 * i); mx = fmaxf(mx, fmaxf(fmaxf(fabsf(a[i][0]), fabsf(a[i][1])), fmaxf(fabsf(a[i][2]), fabsf(a[i][3])))); }
#pragma unroll
    for (int o = 32; o > 0; o >>= 1) mx = fmaxf(mx, __shfl_xor(mx, o));
    const float sc = (mx > 1e-30f) ? 6.0f / mx : 1.0f;
    int w0 = 0, w1 = 0;
    w0 = __builtin_amdgcn_cvt_scalef32_pk_fp4_f32(w0, a[0][0] * sc, a[0][1] * sc, 1.0f, 0);
    w0 = __builtin_amdgcn_cvt_scalef32_pk_fp4_f32(w0, a[0][2] * sc, a[0][3] * sc, 1.0f, 1);
    w0 = __builtin_amdgcn_cvt_scalef32_pk_fp4_f32(w0, a[1][0] * sc, a[1][1] * sc, 1.0f, 2);
    w0 = __builtin_amdgcn_cvt_scalef32_pk_fp4_f32(w0, a[1][2] * sc, a[1][3] * sc, 1.0f, 3);
    w1 = __builtin_amdgcn_cvt_scalef32_pk_fp4_f32(w1, a[2][0] * sc, a[2][1] * sc, 1.0f, 0);
    w1 = __builtin_amdgcn_cvt_scalef32_pk_fp4_f32(w1, a[2][2] * sc, a[2][3] * sc, 1.0f, 1);
    w1 = __builtin_amdgcn_cvt_scalef32_pk_fp4_f32(w1, a[3][0] * sc, a[3][1] * sc, 1.0f, 2);
    w1 = __builtin_amdgcn_cvt_scalef32_pk_fp4_f32(w1, a[3][2] * sc, a[3][3] * sc, 1.0f, 3);
    *(i32x2*)(dst + row * dstride + lane * 8) = (i32x2){w0, w1};
    if (lane == 0) inv[2 * row] = 1.0f / sc;
}
__device__ __forceinline__ void wqk_tile(const float* __restrict__ wq, const float* __restrict__ keys, h16* __restrict__ wt, int tile, float* lds) {
    const int ct = tile >> 4, hp = tile & 15, tid = threadIdx.x;
    float* sA = lds;
    float* sB = lds + 64 * 129;
#pragma unroll
    for (int i = 0; i < 4; ++i) {
        const int e = (i * 512 + tid) * 4, r = e >> 7, d = e & 127;
        const f32x4 v = *(const f32x4*)(wq + (size_t)(ct * 64 + r) * 2048 + hp * 128 + d);
        sA[r * 129 + d] = v[0]; sA[r * 129 + d + 1] = v[1]; sA[r * 129 + d + 2] = v[2]; sA[r * 129 + d + 3] = v[3];
    }
#pragma unroll
    for (int i = 0; i < 8; ++i) {
        const int e = (i * 512 + tid) * 4, k = e >> 7, d = e & 127;
        const f32x4 v = *(const f32x4*)(keys + (size_t)(hp * 128 + k) * 128 + d);
        sB[k * 129 + d] = v[0]; sB[k * 129 + d + 1] = v[1]; sB[k * 129 + d + 2] = v[2]; sB[k * 129 + d + 3] = v[3];
    }
    __syncthreads();
    const int c = tid >> 3, kg = (tid & 7) * 16;
    float acc[16];
#pragma unroll
    for (int j = 0; j < 16; ++j) acc[j] = 0.f;
#pragma unroll 4
    for (int d = 0; d < 128; ++d) {
        const float a = sA[c * 129 + d];
#pragma unroll
        for (int j = 0; j < 16; ++j) acc[j] += a * sB[(kg + j) * 129 + d];
    }
#pragma unroll
    for (int j = 0; j < 16; ++j) wt[(size_t)(hp * 128 + kg + j) * 1024 + ct * 64 + c] = (h16)acc[j];
    __syncthreads();
}
__device__ void phase0(const Params& p, float* lds) {
    unsigned char* ws = p.ws;
    const int tid = threadIdx.x, wid = tid >> 6, lane = tid & 63;
    for (int ib = blockIdx.x; ib < 256; ib += gridDim.x) {
        if (wid < 6) {
            const int item = ib * 6 + wid, cg64 = item % 96, kc = item / 96;
            const int col = cg64 * 64 + lane, k0 = kc * 64;
            float sv[17], acc[17];
#pragma unroll
            for (int b = 0; b < 17; ++b) {
                const float cv = (b < 16) ? p.in[I_C][b * 1024 + k0 + lane] : p.in[I_CCTX][k0 + lane];
                sv[b] = silu_(cv); acc[b] = 0.f;
            }
            const float* wp = p.in[I_ADAW] + (size_t)k0 * 6144 + col;
            for (int j = 0; j < 64; ++j) {
                const float w = wp[(size_t)j * 6144];
#pragma unroll
                for (int b = 0; b < 17; ++b) acc[b] += __builtin_bit_cast(float, __builtin_amdgcn_readlane(__builtin_bit_cast(int, sv[b]), j)) * w;
            }
            float* mp = (float*)(ws + OFF_MODP);
#pragma unroll
            for (int b = 0; b < 17; ++b) mp[((size_t)kc * 17 + b) * 6144 + col] = acc[b];
        }
    }
    constexpr int T0 = 2048, T1 = T0 + 2048, T2 = T1 + 32, T3 = T2, T4 = T3 + 1152, T5 = T4 + 128, T6 = T5 + 128, T7 = T6 + 256, T8 = T7 + 256;
    for (int t = blockIdx.x; t < T8; t += gridDim.x) {
        if (t < T0) cvt4_rows(p.in[I_PU], ws + OFF_U8, (float*)(ws + OFF_USC), t, 1536);
        else if (t < T1) cvt8_rows(p.in[I_PV], ws + OFF_U8 + 512, (float*)(ws + OFF_USC) + 1, t - T0, 1536);
        else if (t < T2) cvt_tile(p.in[I_GMWS], (h16*)(ws + OFF_WS16), t - T1);
        else if (t < T3) {
            const int e = (t - T2) * 4096 + tid * 8;
            const int row = e >> 8, cc = e & 255, h = row >> 8, pp = (row >> 7) & 1, k = row & 127, pq = cc >> 7, d = cc & 127;
            h16x8 o = {0, 0, 0, 0, 0, 0, 0, 0};
            if (pp == pq) {
                const float* kp = p.in[I_KEYS] + ((size_t)((h * 2 + pp) * 128 + k)) * 128 + d;
                o = pack8(*(const f32x4*)kp, *(const f32x4*)(kp + 4));
            }
            *(h16x8*)((h16*)(ws + OFF_BD) + e) = o;
        }
        else if (t < T4) tr_tile(p.in[I_WIN], (h16*)(ws + OFF_WINT), 1024, INC, t - T3, lds);
        else if (t < T5) tr_tile(p.in[I_WPA], (h16*)(ws + OFF_WPAT), 512, 1024, t - T4, lds);
        else if (t < T6) tr_tile(p.in[I_WPB], (h16*)(ws + OFF_WPBT), 512, 1024, t - T5, lds);
        else if (t < T7) tr_tile(p.in[I_WOUT], (h16*)(ws + OFF_WOUTT), 1024, 1024, t - T6, lds);
        else wqk_tile(p.in[I_WQ], p.in[I_KEYS], (h16*)(ws + OFF_WQT), t - T7, lds);
    }
}

__device__ __forceinline__ void norm_rows(const float* __restrict__ src, h16* __restrict__ dst, int row_begin, int rows_per_wave, const float* sA, const float* sB) {
    const int tid_ = fresh_tid();
    const int wid = tid_ >> 6, lane = tid_ & 63;
    f32x4 a[4], bsh[4];
#pragma unroll
    for (int c = 0; c < 4; ++c) { a[c] = *(const f32x4*)(sA + c * 256 + lane * 4); bsh[c] = *(const f32x4*)(sB + c * 256 + lane * 4); }
    for (int i = 0; i < rows_per_wave; i += 2) {
        const size_t row = (size_t)row_begin + wid * rows_per_wave + i;
        f32x4 v[2][4]; float ss[2];
#pragma unroll
        for (int q = 0; q < 2; ++q) {
            ss[q] = 0.f;
#pragma unroll
            for (int c = 0; c < 4; ++c) { v[q][c] = *(const f32x4*)(src + (row + q) * 1024 + c * 256 + lane * 4); ss[q] += v[q][c][0] * v[q][c][0] + v[q][c][1] * v[q][c][1] + v[q][c][2] * v[q][c][2] + v[q][c][3] * v[q][c][3]; }
        }
#pragma unroll
        for (int o = 32; o > 0; o >>= 1) { const float t0 = __shfl_xor(ss[0], o), t1 = __shfl_xor(ss[1], o); ss[0] += t0; ss[1] += t1; }
#pragma unroll
        for (int q = 0; q < 2; ++q) {
            const float r = rsqrtf(ss[q] * (1.0f / 1024.0f) + 1e-6f);
#pragma unroll
            for (int c = 0; c < 4; ++c) {
                h16x4 o;
#pragma unroll
                for (int j = 0; j < 4; ++j) o[j] = (h16)(v[q][c][j] * r * a[c][j] + bsh[c][j]);
                *(h16x4*)(dst + (row + q) * 1024 + c * 256 + lane * 4) = o;
            }
        }
    }
}
__device__ __forceinline__ void norm_rows_h(const h16* __restrict__ src, h16* __restrict__ dst, int row_begin, int rows_per_wave, const float* sA, const float* sB) {
    const int tid_ = fresh_tid();
    const int wid = tid_ >> 6, lane = tid_ & 63;
    f32x4 a[4], bsh[4];
#pragma unroll
    for (int c = 0; c < 4; ++c) { a[c] = *(const f32x4*)(sA + c * 256 + lane * 4); bsh[c] = *(const f32x4*)(sB + c * 256 + lane * 4); }
    for (int i = 0; i < rows_per_wave; i += 2) {
        const size_t row = (size_t)row_begin + wid * rows_per_wave + i;
        f32x4 v[2][4]; float ss[2];
#pragma unroll
        for (int q = 0; q < 2; ++q) {
            ss[q] = 0.f;
#pragma unroll
            for (int c = 0; c < 4; ++c) { const h16x4 hv = *(const h16x4*)(src + (row + q) * 1024 + c * 256 + lane * 4);
                v[q][c] = (f32x4){(float)hv[0], (float)hv[1], (float)hv[2], (float)hv[3]};
                ss[q] += v[q][c][0] * v[q][c][0] + v[q][c][1] * v[q][c][1] + v[q][c][2] * v[q][c][2] + v[q][c][3] * v[q][c][3]; }
        }
#pragma unroll
        for (int o = 32; o > 0; o >>= 1) { const float t0 = __shfl_xor(ss[0], o), t1 = __shfl_xor(ss[1], o); ss[0] += t0; ss[1] += t1; }
#pragma unroll
        for (int q = 0; q < 2; ++q) {
            const float r = rsqrtf(ss[q] * (1.0f / 1024.0f) + 1e-6f);
#pragma unroll
            for (int c = 0; c < 4; ++c) {
                h16x4 o;
#pragma unroll
                for (int j = 0; j < 4; ++j) o[j] = (h16)(v[q][c][j] * r * a[c][j] + bsh[c][j]);
                *(h16x4*)(dst + (row + q) * 1024 + c * 256 + lane * 4) = o;
            }
        }
    }
}
__device__ void phase1(const Params& p, float* lds) {
    unsigned char* ws = p.ws;
    const int tid = threadIdx.x;
    const float* mp = (const float*)(ws + OFF_MODP);
    const float* bias = p.in[I_ADAB];
    float* sA = lds; float* sB = lds + 1024; float* cA = lds + 2048; float* cB = lds + 3072;
    {
        float* mod = (float*)(ws + OFF_MOD);
        for (int e = blockIdx.x * 512 + tid; e < 17 * 6144; e += gridDim.x * 512) {
            float s = bias[e % 6144];
#pragma unroll
            for (int kc = 0; kc < 16; ++kc) s += mp[(size_t)kc * 17 * 6144 + e];
            mod[e] = s;
        }
    }
    for (int col = tid; col < 1024; col += 512) {
        float sh = bias[col], sc = bias[1024 + col];
#pragma unroll
        for (int kc = 0; kc < 16; ++kc) { sh += mp[((size_t)kc * 17 + 16) * 6144 + col]; sc += mp[((size_t)kc * 17 + 16) * 6144 + 1024 + col]; }
        cA[col] = p.in[I_N1G][col] * (1.0f + sc); cB[col] = sh;
    }
    for (int rg = blockIdx.x; rg < 256; rg += gridDim.x) {
        const int b = rg >> 4;
        __syncthreads();
        for (int col = tid; col < 1024; col += 512) {
            float sh = bias[col], sc = bias[1024 + col];
#pragma unroll
            for (int kc = 0; kc < 16; ++kc) { sh += mp[((size_t)kc * 17 + b) * 6144 + col]; sc += mp[((size_t)kc * 17 + b) * 6144 + 1024 + col]; }
            sA[col] = p.in[I_N1G][col] * (1.0f + sc); sB[col] = sh;
        }
        __syncthreads();
        norm_rows(p.in[I_X], (h16*)(ws + OFF_R1), rg * 128, 16, sA, sB);
        norm_rows(p.in[I_CTX], (h16*)(ws + OFF_HC), rg * 16, 2, cA, cB);
    }
}
__device__ void phase6(const Params& p, float* lds) {
    unsigned char* ws = p.ws;
    const int tid = threadIdx.x;
    const float* mod = (const float*)(ws + OFF_MOD);
    float* sA = lds; float* sB = lds + 1024;
    for (int rg = blockIdx.x; rg < 256; rg += gridDim.x) {
        const int b = rg >> 4;
        __syncthreads();
        for (int col = tid; col < 1024; col += 512) {
            sA[col] = p.in[I_N2G][col] * (1.0f + mod[(size_t)b * 6144 + 4 * 1024 + col]); sB[col] = mod[(size_t)b * 6144 + 3 * 1024 + col];
        }
        __syncthreads();
        norm_rows_h((const h16*)(ws + OFF_X1H), (h16*)(ws + OFF_R1), rg * 128, 16, sA, sB);
    }
}

__device__ __forceinline__ int clampi(int v, int lo, int hi) { return v < lo ? lo : (v > hi ? hi : v); }

template <bool LOCAL>
__device__ __forceinline__ void attn_core(const h16x8 (&kf)[2][2], const h16x8 (&vf)[4], const float (&bias)[8], const int cb, const int qc, const int cs,
                                          const h16x8 (&qf)[2], float& m_run, float& l_run, f32x4 (&O)[4], const int quad) {
    f32x4 st[2];
#pragma unroll
    for (int t = 0; t < 2; ++t) {
        f32x4 a = (f32x4){0.f, 0.f, 0.f, 0.f};
#pragma unroll
        for (int ks = 0; ks < 2; ++ks) a = __builtin_amdgcn_mfma_f32_16x16x32_f16(kf[t][ks], qf[ks], a, 0, 0, 0);
        st[t] = a;
    }
    float mx = -INFINITY;
#pragma unroll
    for (int t = 0; t < 2; ++t)
#pragma unroll
        for (int j = 0; j < 4; ++j) {
            float sv = st[t][j] * 0.125f;
            if (LOCAL) {
                const int kc = cb + 16 * t + quad * 4 + j;
                const bool inw = (kc >= cs) && (kc < cs + 16);
                sv = inw ? (sv + bias[t * 4 + j]) : -1e30f;
            }
            st[t][j] = sv; mx = fmaxf(mx, sv);
        }
    mx = fmaxf(mx, __shfl_xor(mx, 16)); mx = fmaxf(mx, __shfl_xor(mx, 32));
    const float m_new = fmaxf(m_run, mx);
    const float alpha = __expf(m_run - m_new);
    float ls = 0.f; h16x8 pf;
#pragma unroll
    for (int t = 0; t < 2; ++t)
#pragma unroll
        for (int j = 0; j < 4; ++j) { const float pe = __expf(st[t][j] - m_new); ls += pe; pf[t * 4 + j] = (h16)pe; }
    l_run = l_run * alpha + ls; m_run = m_new;
#pragma unroll
    for (int dt = 0; dt < 4; ++dt) { O[dt] *= alpha; O[dt] = __builtin_amdgcn_mfma_f32_16x16x32_f16(vf[dt], pf, O[dt], 0, 0, 0); }
}
__device__ __forceinline__ void load_k(const h16* __restrict__ kt, h16x8 (&kf)[2][2], const int l15, const int quad) {
#pragma unroll
    for (int t = 0; t < 2; ++t)
#pragma unroll
        for (int ks = 0; ks < 2; ++ks) kf[t][ks] = *(const h16x8*)(kt + (16 * t + l15) * 64 + ks * 32 + quad * 8);
}
__device__ __forceinline__ void load_v(const h16* __restrict__ vt, h16x8 (&vf)[4], const int l15, const int quad) {
#pragma unroll
    for (int dt = 0; dt < 4; ++dt) {
        const h16* vp = vt + ((quad >> 1) * 64 + dt * 16 + l15) * 8 + (quad & 1) * 4;
        const h16x4 lo = *(const h16x4*)vp, hi = *(const h16x4*)(vp + 2 * 512);
        vf[dt] = (h16x8){lo[0], lo[1], lo[2], lo[3], hi[0], hi[1], hi[2], hi[3]};
    }
}
__device__ __forceinline__ void load_bias(const float* __restrict__ rpbrow, const int cb, const int qc, const int quad, float (&bias)[8]) {
#pragma unroll
    for (int t = 0; t < 2; ++t)
#pragma unroll
        for (int j = 0; j < 4; ++j) bias[t * 4 + j] = rpbrow[clampi(cb + 16 * t + quad * 4 + j - qc + 15, 0, 30)];
}

__device__ void attn_unit(const Params& p, int unit) {
    unsigned char* ws = p.ws;
    const int tid_ = fresh_tid();
    const int lane = tid_ & 63, h = tid_ >> 6, l15 = lane & 15, quad = lane >> 4;
    const int b = unit >> 5, r = unit & 31;
    const h16* QB = (const h16*)(ws + OFF_QB);
    const h16* KH = (const h16*)(ws + OFF_KB) + (size_t)(b * 8 + h) * 2048 * 64;
    const h16* VH = (const h16*)(ws + OFF_VT) + (size_t)(b * 8 + h) * 256 * 512;
    const h16* KCH = (const h16*)(ws + OFF_KC) + (size_t)(b * 8 + h) * 256 * 64;
    const h16* VCH = (const h16*)(ws + OFF_VCT) + (size_t)(b * 8 + h) * 32 * 512;
    h16* YA = (h16*)(ws + OFF_R1);
    const float* rpb = p.in[I_RPB] + (size_t)h * 15 * 31;
    const int rs = clampi(r - 4, 0, 24);
    h16x8 qf[4][2]; float m_run[4], l_run[4]; f32x4 O[4][4];
#pragma unroll
    for (int g = 0; g < 4; ++g) {
        const size_t tq = (size_t)b * 2048 + r * 64 + 16 * g + l15;
        qf[g][0] = *(const h16x8*)(QB + tq * 512 + h * 64 + quad * 8);
        qf[g][1] = *(const h16x8*)(QB + tq * 512 + h * 64 + 32 + quad * 8);
        m_run[g] = -INFINITY; l_run[g] = 0.f;
#pragma unroll
        for (int dt = 0; dt < 4; ++dt) O[g][dt] = (f32x4){0.f, 0.f, 0.f, 0.f};
    }
    {
        const float nob[8] = {0.f, 0.f, 0.f, 0.f, 0.f, 0.f, 0.f, 0.f};
        h16x8 kA[2][2], kB[2][2], vf[4];
        load_k(KCH, kA, l15, quad);
#pragma unroll 1
        for (int step = 0; step < 8; step += 2) {
            load_v(VCH + step * 4 * 512, vf, l15, quad);
            load_k(KCH + (step + 1) * 32 * 64, kB, l15, quad);
            __builtin_amdgcn_sched_barrier(0);
#pragma unroll
            for (int g = 0; g < 4; ++g) attn_core<false>(kA, vf, nob, 0, 0, 0, qf[g], m_run[g], l_run[g], O[g], quad);
            __builtin_amdgcn_sched_barrier(0);
            load_v(VCH + (step + 1) * 4 * 512, vf, l15, quad);
            if (step + 2 < 8) load_k(KCH + (step + 2) * 32 * 64, kA, l15, quad);
            __builtin_amdgcn_sched_barrier(0);
#pragma unroll
            for (int g = 0; g < 4; ++g) attn_core<false>(kB, vf, nob, 0, 0, 0, qf[g], m_run[g], l_run[g], O[g], quad);
            __builtin_amdgcn_sched_barrier(0);
        }
    }
#pragma unroll
    for (int gp = 0; gp < 4; gp += 2) {
        const int cb0 = clampi(16 * gp - 8, 0, 32), cb1 = clampi(16 * (gp + 1) - 8, 0, 32);
        const int qc0 = 16 * gp + l15, qc1 = 16 * (gp + 1) + l15;
        const int cs0 = clampi(qc0 - 8, 0, 48), cs1 = clampi(qc1 - 8, 0, 48);
        const float* rp0 = rpb + (rs - r + 7) * 31;
#pragma unroll 1
        for (int step = 0; step < 8; ++step) {
            const int t0 = (rs + step) * 64 + cb0, t1 = (rs + step) * 64 + cb1;
            h16x8 kf0[2][2], vf0[4], kf1[2][2], vf1[4]; float b0[8], b1[8];
            load_k(KH + (size_t)t0 * 64, kf0, l15, quad); load_k(KH + (size_t)t1 * 64, kf1, l15, quad);
            load_bias(rp0 + step * 31, cb0, qc0, quad, b0); load_bias(rp0 + step * 31, cb1, qc1, quad, b1);
            load_v(VH + (size_t)(t0 >> 3) * 512, vf0, l15, quad); load_v(VH + (size_t)(t1 >> 3) * 512, vf1, l15, quad);
            attn_core<true>(kf0, vf0, b0, cb0, qc0, cs0, qf[gp], m_run[gp], l_run[gp], O[gp], quad);
            attn_core<true>(kf1, vf1, b1, cb1, qc1, cs1, qf[gp + 1], m_run[gp + 1], l_run[gp + 1], O[gp + 1], quad);
        }
    }
#pragma unroll
    for (int g = 0; g < 4; ++g) {
        const size_t tq = (size_t)b * 2048 + r * 64 + 16 * g + l15;
        float l = l_run[g];
        l += __shfl_xor(l, 16); l += __shfl_xor(l, 32);
        const float inv = __builtin_amdgcn_rcpf(l);
#pragma unroll
        for (int dt = 0; dt < 4; ++dt) {
            h16x4 o;
#pragma unroll
            for (int j = 0; j < 4; ++j) o[j] = (h16)(O[g][dt][j] * inv);
            *(h16x4*)(YA + tq * 1024 + h * 64 + dt * 16 + quad * 4) = o;
        }
    }
}

__device__ void sgu_unit(const Params& p, int n, LAS unsigned char* lds) {
    unsigned char* ws = p.ws;
    const int tid = fresh_tid(), lane = tid & 63, g = tid >> 6, l15 = lane & 15, quad = lane >> 4;
    const h16* GUV = (const h16*)(ws + OFF_GUV);
    const h16* WS16 = (const h16*)(ws + OFF_WS16);
    h16* YB = (h16*)(ws + OFF_R1) + 512;
    LAS float* stat = (LAS float*)(lds + 8 * 17408);
    LAS h16* vt = (LAS h16*)(lds + g * 17408);
    const size_t t0 = (size_t)n * 128;
    __syncthreads();
    for (int i = 0; i < 16; i += 4) {
        h16x8 x[4]; float s[4], v[4];
#pragma unroll
        for (int q = 0; q < 4; ++q) {
            x[q] = *(const h16x8*)(GUV + (t0 + g * 16 + i + q) * 1024 + 512 + lane * 8);
            s[q] = 0.f;
#pragma unroll
            for (int j = 0; j < 8; ++j) s[q] += (float)x[q][j];
        }
#pragma unroll
        for (int o = 32; o > 0; o >>= 1) { float t[4];
#pragma unroll
            for (int q = 0; q < 4; ++q) t[q] = __shfl_xor(s[q], o);
#pragma unroll
            for (int q = 0; q < 4; ++q) s[q] += t[q]; }
#pragma unroll
        for (int q = 0; q < 4; ++q) {
            s[q] *= (1.0f / 512.0f); v[q] = 0.f;
#pragma unroll
            for (int j = 0; j < 8; ++j) { const float d = (float)x[q][j] - s[q]; v[q] += d * d; }
        }
#pragma unroll
        for (int o = 32; o > 0; o >>= 1) { float t[4];
#pragma unroll
            for (int q = 0; q < 4; ++q) t[q] = __shfl_xor(v[q], o);
#pragma unroll
            for (int q = 0; q < 4; ++q) v[q] += t[q]; }
        if (lane == 0) {
#pragma unroll
            for (int q = 0; q < 4; ++q) { stat[(g * 16 + i + q) * 2] = s[q]; stat[(g * 16 + i + q) * 2 + 1] = rsqrtf(v[q] * (1.0f / 512.0f) + 1e-6f); }
        }
    }
    __syncthreads();
    {
        const int ch0 = (lane & 7) * 8;
        float lg[8];
#pragma unroll
        for (int j = 0; j < 8; ++j) lg[j] = p.in[I_LNG][g * 64 + ch0 + j];
#pragma unroll 8
        for (int it = 0; it < 16; ++it) {
            const int q = it * 8 + (lane >> 3);
            const h16x8 x = *(const h16x8*)(GUV + (t0 + q) * 1024 + 512 + g * 64 + ch0);
            const float mean = stat[q * 2], rstd = stat[q * 2 + 1];
#pragma unroll
            for (int j = 0; j < 8; ++j) vt[(ch0 + j) * 136 + q] = (h16)(((float)x[j] - mean) * rstd * lg[j]);
        }
    }
    asm volatile("s_waitcnt lgkmcnt(0)" ::: "memory");
    __syncthreads();
    h16x8 af[4][4];
#pragma unroll
    for (int dt = 0; dt < 4; ++dt)
#pragma unroll
        for (int ks = 0; ks < 4; ++ks) af[dt][ks] = *(const LAS h16x8*)(vt + (dt * 16 + l15) * 136 + ks * 32 + quad * 8);
    const h16* wg = WS16 + (size_t)g * 128 * 128;
#pragma unroll 2
    for (int pt = 0; pt < 8; ++pt) {
        f32x4 acc[4];
#pragma unroll
        for (int dt = 0; dt < 4; ++dt) acc[dt] = (f32x4){0.f, 0.f, 0.f, 0.f};
#pragma unroll
        for (int ks = 0; ks < 4; ++ks) {
            const h16x8 bf = *(const h16x8*)(wg + (size_t)(pt * 16 + l15) * 128 + ks * 32 + quad * 8);
#pragma unroll
            for (int dt = 0; dt < 4; ++dt) acc[dt] = __builtin_amdgcn_mfma_f32_16x16x32_f16(af[dt][ks], bf, acc[dt], 0, 0, 0);
        }
        const int pp = pt * 16 + l15;
        const float bsv = p.in[I_GMBS][g * 128 + pp];
        const size_t tok = t0 + pp;
#pragma unroll
        for (int dt = 0; dt < 4; ++dt) {
            const int ch = g * 64 + dt * 16 + quad * 4;
            const h16x4 uu = *(const h16x4*)(GUV + tok * 1024 + ch);
            h16x4 o;
#pragma unroll
            for (int j = 0; j < 4; ++j) o[j] = (h16)((float)uu[j] * (acc[dt][j] + bsv));
            *(h16x4*)(YB + tok * 1024 + ch) = o;
        }
    }
    __syncthreads();
}

__device__ __forceinline__ float row16_sum_to_lane15(float v) {
    v += __builtin_bit_cast(float, __builtin_amdgcn_update_dpp(0, __builtin_bit_cast(int, v), 0x118, 0xf, 0xf, true));
    v += __builtin_bit_cast(float, __builtin_amdgcn_update_dpp(0, __builtin_bit_cast(int, v), 0x114, 0xf, 0xf, true));
    v += __builtin_bit_cast(float, __builtin_amdgcn_update_dpp(0, __builtin_bit_cast(int, v), 0x112, 0xf, 0xf, true));
    v += __builtin_bit_cast(float, __builtin_amdgcn_update_dpp(0, __builtin_bit_cast(int, v), 0x111, 0xf, 0xf, true));
    return v;
}
#define DPPF(v, ctrl) __builtin_bit_cast(float, __builtin_amdgcn_update_dpp(__builtin_bit_cast(int, v), __builtin_bit_cast(int, v), ctrl, 0xf, 0xf, false))
__device__ __forceinline__ float row16_allsum(float v) { v += DPPF(v, 0x128); v += DPPF(v, 0x124); v += DPPF(v, 0x122); v += DPPF(v, 0x121); return v; }
__device__ __forceinline__ float row16_allmax(float v) { v = fmaxf(v, DPPF(v, 0x128)); v = fmaxf(v, DPPF(v, 0x124)); v = fmaxf(v, DPPF(v, 0x122)); v = fmaxf(v, DPPF(v, 0x121)); return v; }
__device__ __forceinline__ int wave_incl_scan(int v) {
    v += __builtin_amdgcn_update_dpp(0, v, 0x111, 0xf, 0xf, false);
    v += __builtin_amdgcn_update_dpp(0, v, 0x112, 0xf, 0xf, false);
    v += __builtin_amdgcn_update_dpp(0, v, 0x114, 0xf, 0xf, false);
    v += __builtin_amdgcn_update_dpp(0, v, 0x118, 0xf, 0xf, false);
    v += __builtin_amdgcn_update_dpp(0, v, 0x142, 0xa, 0xf, false);
    v += __builtin_amdgcn_update_dpp(0, v, 0x143, 0xc, 0xf, false);
    return v;
}
__device__ __forceinline__ unsigned wave_or(unsigned x) {
    int v = (int)x;
    v |= __builtin_amdgcn_update_dpp(0, v, 0x111, 0xf, 0xf, false);
    v |= __builtin_amdgcn_update_dpp(0, v, 0x112, 0xf, 0xf, false);
    v |= __builtin_amdgcn_update_dpp(0, v, 0x114, 0xf, 0xf, false);
    v |= __builtin_amdgcn_update_dpp(0, v, 0x118, 0xf, 0xf, false);
    v |= __builtin_amdgcn_update_dpp(0, v, 0x142, 0xa, 0xf, false);
    v |= __builtin_amdgcn_update_dpp(0, v, 0x143, 0xc, 0xf, false);
    return (unsigned)__builtin_amdgcn_readlane(v, 63);
}
__device__ __forceinline__ unsigned wave_and(unsigned x) {
    int v = (int)x;
    v &= __builtin_amdgcn_update_dpp(-1, v, 0x111, 0xf, 0xf, false);
    v &= __builtin_amdgcn_update_dpp(-1, v, 0x112, 0xf, 0xf, false);
    v &= __builtin_amdgcn_update_dpp(-1, v, 0x114, 0xf, 0xf, false);
    v &= __builtin_amdgcn_update_dpp(-1, v, 0x118, 0xf, 0xf, false);
    v &= __builtin_amdgcn_update_dpp(-1, v, 0x142, 0xa, 0xf, false);
    v &= __builtin_amdgcn_update_dpp(-1, v, 0x143, 0xc, 0xf, false);
    return (unsigned)__builtin_amdgcn_readlane(v, 63);
}
__device__ __forceinline__ unsigned key16(unsigned short u) { return (u & 0x8000u) ? ((~(unsigned)u) & 0xFFFFu) : ((unsigned)u | 0x8000u); }
__device__ __forceinline__ unsigned key32(unsigned u) { return (u & 0x80000000u) ? ~u : (u | 0x80000000u); }
__device__ __forceinline__ float dot8(h16x8 a, h16x8 b, float c) {
    c = __builtin_amdgcn_fdot2((h16x2){a[0], a[1]}, (h16x2){b[0], b[1]}, c, false);
    c = __builtin_amdgcn_fdot2((h16x2){a[2], a[3]}, (h16x2){b[2], b[3]}, c, false);
    c = __builtin_amdgcn_fdot2((h16x2){a[4], a[5]}, (h16x2){b[4], b[5]}, c, false);
    c = __builtin_amdgcn_fdot2((h16x2){a[6], a[7]}, (h16x2){b[6], b[7]}, c, false);
    return c;
}
#define LDS_FENCE() asm volatile("s_waitcnt lgkmcnt(0)" ::: "memory")

__device__ void peer_phase(const Params& p, LAS unsigned char* lds, unsigned* bar, unsigned& epoch) {
    unsigned char* ws = p.ws;
    const int tid = fresh_tid(), wid = __builtin_amdgcn_readfirstlane(tid >> 6), lane = tid & 63;
    const unsigned long long lm = (1ull << lane) - 1ull;
    LAS unsigned char* wl = lds + wid * 11264;
    LAS float* s_top = (LAS float*)(wl);
    LAS int* i_top = (LAS int*)(wl + 1024);
    LAS int* ex = (LAS int*)(wl + 2048);
    LAS float* sc = (LAS float*)(wl + 2560);
    LAS int* uns_m = (LAS int*)(wl + 3072);
    LAS float* uns_g = (LAS float*)(wl + 3584);
    LAS int* cnt = (LAS int*)(wl + 4096);
    LAS int* base = (LAS int*)(wl + 4352);
    const int lead = (wid >= 4) ? 1 : 0;
    const unsigned short* SC = (const unsigned short*)(ws + OFF_SC16);
    const h16* H2 = (const h16*)(ws + OFF_R1);
    const unsigned char* U4 = ws + OFF_U8;
    const unsigned char* V8 = ws + OFF_V8;
    const float* USC = (const float*)(ws + OFF_USC);
    const float* VSC = (const float*)(ws + OFF_VSC);
    const float* mod = (const float*)(ws + OFF_MOD);
    const int grp = lane >> 4, li = lane & 15;
    for (int tg = blockIdx.x; tg < 256; tg += gridDim.x) {
        for (int it5 = 0; it5 < 5; ++it5) {
          if (it5 < 4) {
            const int round = it5;
            const size_t tok0 = (size_t)tg * 128 + wid * 16 + round * 4;
            LAS unsigned short* se = (LAS unsigned short*)(wl + 4608 + (round & 1) * 3072);
            LAS float* sw = (LAS float*)(wl + 4608 + (round & 1) * 3072 + 1024);
            for (int tt = 0; tt < 4; ++tt) {
                const size_t tok = tok0 + tt;
                cnt[lane] = 0;
                for (int L0 = 0; L0 < 16; L0 += 4) {
                    unsigned short ra[4], rb[4]; unsigned ka[4], kb[4], T[4];
#pragma unroll
                    for (int q = 0; q < 4; ++q) {
                        const unsigned short* sr = SC + tok * 2048 + (L0 + q) * 128;
                        ra[q] = sr[lane]; rb[q] = sr[64 + lane];
                        ka[q] = key16(ra[q]); kb[q] = key16(rb[q]); T[q] = 0;
                    }
                    for (int bit = 15; bit >= 0; --bit) {
#pragma unroll
                        for (int q = 0; q < 4; ++q) {
                            const unsigned cand = T[q] | (1u << bit);
                            const int cn = __popcll(__ballot(ka[q] >= cand)) + __popcll(__ballot(kb[q] >= cand));
                            T[q] = (cn >= 16) ? cand : T[q];
                        }
                    }
#pragma unroll
                    for (int q = 0; q < 4; ++q) {
                        const int L = L0 + q;
                        const int cnt_gt = __popcll(__ballot(ka[q] > T[q])) + __popcll(__ballot(kb[q] > T[q]));
                        const int need = 16 - cnt_gt;
                        const unsigned long long ea = __ballot(ka[q] == T[q]), eb = __ballot(kb[q] == T[q]);
                        const int ra_eq = __popcll(ea & lm), rb_eq = __popcll(ea) + __popcll(eb & lm);
                        const bool sa = (ka[q] > T[q]) || (ka[q] == T[q] && ra_eq < need);
                        const bool sb = (kb[q] > T[q]) || (kb[q] == T[q] && rb_eq < need);
                        const unsigned long long ma = __ballot(sa), mb = __ballot(sb);
                        const int pa = __popcll(ma & lm), pb = __popcll(ma) + __popcll(mb & lm);
                        if (sa) { s_top[L * 16 + pa] = (float)__builtin_bit_cast(h16, ra[q]); i_top[L * 16 + pa] = lane; }
                        if (sb) { s_top[L * 16 + pb] = (float)__builtin_bit_cast(h16, rb[q]); i_top[L * 16 + pb] = 64 + lane; }
                    }
                }
                LDS_FENCE();
                for (int h0 = 0; h0 < 8; h0 += 4) {
                    float cv[4][4]; unsigned kk[4][4], T[4];
#pragma unroll
                    for (int q = 0; q < 4; ++q) {
                        const int h = h0 + q;
                        const float bj = s_top[(2 * h + 1) * 16 + li];
#pragma unroll
                        for (int m = 0; m < 4; ++m) { cv[q][m] = s_top[(2 * h) * 16 + grp + 4 * m] + bj; kk[q][m] = key32(__builtin_bit_cast(unsigned, cv[q][m])); }
                        T[q] = 0;
                    }
                    unsigned om = 0, am = 0xFFFFFFFFu;
#pragma unroll
                    for (int q = 0; q < 4; ++q)
#pragma unroll
                        for (int m = 0; m < 4; ++m) { om |= kk[q][m]; am &= kk[q][m]; }
                    om = wave_or(om); am = wave_and(am);
                    om &= ~am;
                    while (om) {
                        const int bit = 31 - __builtin_clz(om);
                        om &= ~(1u << bit);
#pragma unroll
                        for (int q = 0; q < 4; ++q) {
                            const unsigned cand = T[q] | (1u << bit);
                            int cn = 0;
#pragma unroll
                            for (int m = 0; m < 4; ++m) cn += __popcll(__ballot((kk[q][m] & ~am) >= cand));
                            T[q] = (cn >= 16) ? cand : T[q];
                        }
                    }
#pragma unroll
                    for (int q = 0; q < 4; ++q) T[q] |= am;
#pragma unroll
                    for (int q = 0; q < 4; ++q) {
                        const int h = h0 + q;
                        int cnt_gt = 0;
#pragma unroll
                        for (int m = 0; m < 4; ++m) cnt_gt += __popcll(__ballot(kk[q][m] > T[q]));
                        const int need = 16 - cnt_gt;
                        int eq_before = 0, sel_before = 0;
#pragma unroll
                        for (int m = 0; m < 4; ++m) {
                            const unsigned long long em = __ballot(kk[q][m] == T[q]);
                            const int myeq = eq_before + __popcll(em & lm);
                            const bool sel = (kk[q][m] > T[q]) || (kk[q][m] == T[q] && myeq < need);
                            const unsigned long long sm = __ballot(sel);
                            const int pos = sel_before + __popcll(sm & lm);
                            if (sel) {
                                ex[h * 16 + pos] = i_top[(2 * h) * 16 + grp + 4 * m] * 128 + i_top[(2 * h + 1) * 16 + li];
                                sc[h * 16 + pos] = cv[q][m];
                            }
                            eq_before += __popcll(em); sel_before += __popcll(sm);
                        }
                    }
                }
                LDS_FENCE();
#pragma unroll
                for (int half = 0; half < 2; ++half) {
                    const int e = half * 64 + lane;
                    const float v = sc[e];
                    const float mx = row16_allmax(v);
                    const float pe = __expf(v - mx);
                    const float sm = row16_allsum(pe);
                    const float gate = pe * __builtin_amdgcn_rcpf(sm);
                    const int eid = ex[e];
                    const int pos = __hip_atomic_fetch_add(cnt + (eid >> 8), 1, __ATOMIC_RELAXED, __HIP_MEMORY_SCOPE_WORKGROUP);
                    uns_m[e] = eid | (pos << 14); uns_g[e] = gate;
                }
                LDS_FENCE();
                {
                    const int c = cnt[lane];
                    const int incl = wave_incl_scan(c);
                    base[lane] = incl - c;
                    LDS_FENCE();
#pragma unroll
                    for (int i = 0; i < 2; ++i) {
                        const int rm = uns_m[i * 64 + lane]; const float rg = uns_g[i * 64 + lane];
                        const int eid = rm & 16383, pos = rm >> 14;
                        const int dst = tt * 128 + base[eid >> 8] + pos;
                        se[dst] = (unsigned short)eid; sw[dst] = rg;
                    }
                    LDS_FENCE();
                }
            }
          }
          const int round = it5 - lead;
          if (round >= 0 && round < 4) {
            const size_t tok0 = (size_t)tg * 128 + wid * 16 + round * 4;
            LAS unsigned short* se = (LAS unsigned short*)(wl + 4608 + (round & 1) * 3072);
            LAS float* sw = (LAS float*)(wl + 4608 + (round & 1) * 3072 + 1024);
            const size_t tokg = tok0 + grp;
            const LAS unsigned short* me = se + grp * 128; LAS float* mw = sw + grp * 128;
            {
                const int li = launder(tid) & 15;
                h16x8 xr[2][4];
#pragma unroll
                for (int c = 0; c < 2; ++c)
#pragma unroll
                    for (int j = 0; j < 4; ++j) xr[c][j] = *(const h16x8*)(H2 + tokg * 1024 + c * 512 + li * 32 + 8 * j);
                float acc[64];
#pragma unroll
                for (int i = 0; i < 64; ++i) acc[i] = 0.f;
                i32x4 ru[2][2], rv[2][4]; float su[2], sv[2];
#define ELD(J, S_) do { const int e_ = me[(S_)]; const unsigned char* rp_ = U4 + (size_t)e_ * 1536 + li * 16; \
        ru[J][0] = *(const i32x4*)rp_; ru[J][1] = *(const i32x4*)(rp_ + 256); \
        _Pragma("unroll") for (int c = 0; c < 4; ++c) rv[J][c] = *(const i32x4*)(rp_ + 512 + c * 256); \
        { const f32x2 s2_ = *(const f32x2*)(USC + 2 * e_); su[J] = s2_.x; sv[J] = s2_.y; } } while (0)
#define ECP(J, S_) do { float d = 0.f; \
        _Pragma("unroll") for (int c = 0; c < 2; ++c) _Pragma("unroll") for (int k = 0; k < 4; ++k) { const h16x8 xv = xr[c][k]; const int w_ = ru[J][c][k]; \
            d = __builtin_amdgcn_fdot2(__builtin_amdgcn_cvt_scalef32_pk_f16_fp4(w_, 1.0f, 0), (h16x2){xv[0], xv[1]}, d, false); \
            d = __builtin_amdgcn_fdot2(__builtin_amdgcn_cvt_scalef32_pk_f16_fp4(w_, 1.0f, 1), (h16x2){xv[2], xv[3]}, d, false); \
            d = __builtin_amdgcn_fdot2(__builtin_amdgcn_cvt_scalef32_pk_f16_fp4(w_, 1.0f, 2), (h16x2){xv[4], xv[5]}, d, false); \
            d = __builtin_amdgcn_fdot2(__builtin_amdgcn_cvt_scalef32_pk_f16_fp4(w_, 1.0f, 3), (h16x2){xv[6], xv[7]}, d, false); } \
        d = row16_allsum(d); \
        const float wt_ = mw[(S_)] * gelu_tanh(d * su[J]) * sv[J]; \
        _Pragma("unroll") for (int c = 0; c < 4; ++c) _Pragma("unroll") for (int k = 0; k < 4; ++k) { \
            const f32x2 lo = __builtin_amdgcn_cvt_pk_f32_fp8(rv[J][c][k], false), hi = __builtin_amdgcn_cvt_pk_f32_fp8(rv[J][c][k], true); \
            acc[c * 16 + 4 * k] += wt_ * lo.x; acc[c * 16 + 4 * k + 1] += wt_ * lo.y; acc[c * 16 + 4 * k + 2] += wt_ * hi.x; acc[c * 16 + 4 * k + 3] += wt_ * hi.y; } } while (0)
                ELD(0, 0); ELD(1, 1);
#pragma unroll 1
                for (int s = 0; s < 128; s += 2) {
                    ECP(0, s);     if (s + 2 < 128) ELD(0, s + 2);
                    ECP(1, s + 1); if (s + 3 < 128) ELD(1, s + 3);
                }
#undef ELD
#undef ECP
                float* xo = p.out + tokg * 1024 + li * 16;
                const h16* x1h = (const h16*)(ws + OFF_X1H) + tokg * 1024 + li * 16;
                const int b = (int)(tokg >> 11);
                const float* g2 = mod + (size_t)b * 6144 + 5 * 1024 + li * 16;
                const float* fg = p.in[I_FG] + li * 16;
                float ss = 0.f;
#pragma unroll
                for (int c = 0; c < 4; ++c) {
#pragma unroll
                    for (int q4 = 0; q4 < 4; ++q4) {
                        const h16x4 xh_ = *(const h16x4*)(x1h + c * 256 + q4 * 4);
                        const f32x4 xv = (f32x4){(float)xh_[0], (float)xh_[1], (float)xh_[2], (float)xh_[3]}, gv = *(const f32x4*)(g2 + c * 256 + q4 * 4);
#pragma unroll
                        for (int j = 0; j < 4; ++j) { const float t = xv[j] + gv[j] * acc[c * 16 + q4 * 4 + j]; acc[c * 16 + q4 * 4 + j] = t; ss += t * t; }
                    }
                    asm volatile("" : "+v"(ss) :: "memory");
                }
                ss = row16_allsum(ss);
                const float r = rsqrtf(ss * (1.0f / 1024.0f) + 1e-6f);
#pragma unroll
                for (int c = 0; c < 4; ++c) {
#pragma unroll
                    for (int q4 = 0; q4 < 4; ++q4) {
                        const f32x4 fv = *(const f32x4*)(fg + c * 256 + q4 * 4);
                        f32x4 ov;
#pragma unroll
                        for (int j = 0; j < 4; ++j) ov[j] = acc[c * 16 + q4 * 4 + j] * r * fv[j];
                        *(f32x4*)(xo + c * 256 + q4 * 4) = ov;
                    }
                    asm volatile("" ::: "memory");
                }
            }
            LDS_FENCE();
          }
        }
    }
}

__global__ void __launch_bounds__(512, 2) mega(Params p) {
    extern __shared__ __attribute__((aligned(16))) unsigned char shm[];
    LAS unsigned char* lds = (LAS unsigned char*)shm;
    cg::grid_group grid = cg::this_grid();
    unsigned char* ws = p.ws;
    const int G = (int)gridDim.x, c = (int)blockIdx.x;
    unsigned* bar = (unsigned*)(ws + OFF_BAR); unsigned epoch = 0;
    volatile LAS unsigned* xst = (volatile LAS unsigned*)(lds + (LDS_BYTES - 16));
    if (threadIdx.x < 2) xst[threadIdx.x] = 0u;
    __syncthreads();
    const XcdBarrier xb = xcd_barrier_post(bar, xst);

    if (p.ws == nullptr) grid.sync();
    phase0(p, (float*)shm);
    xcd_barrier(xb);
    phase1(p, (float*)shm);
    xcd_barrier(xb);
    {
        pg8::StaticOrder S; S.init(NTOK, INC, G, c);
        pg8::Gemm g{ws + OFF_R1, ws + OFF_WINT, 1024, 1024, NTOK, INC, 1024, 0};
        EpiIn E{(h16*)(ws + OFF_QB), (h16*)(ws + OFF_KB), (h16*)(ws + OFF_VT), (h16*)(ws + OFF_GUV), (h16*)(ws + OFF_GATES)};
        pg8::gemm_phase(lds, g, S, E);
        pg8::StaticOrder S2; S2.init(NCTXT, 1024, G, c);
        pg8::Gemm g2{ws + OFF_HC, ws + OFF_WINT + (size_t)512 * 1024 * 2, 1024, 1024, NCTXT, 1024, 1024, 0};
        EpiCtx E2{(h16*)(ws + OFF_KC), (h16*)(ws + OFF_VCT)};
        pg8::gemm_phase(lds, g2, S2, E2);
    }
    xcd_barrier(xb);
    {
        for (int rep3 = 0; rep3 < REP_P3; ++rep3) {
        for (int u = c; u < 512; u += G) attn_unit(p, u);
        for (int n = c; n < 256; n += G) sgu_unit(p, n, lds);
        }
    }
    xcd_barrier(xb);
    {
        pg8::StaticOrder S; S.init(NTOK, 1024, G, c);
        pg8::Gemm ga{ws + OFF_R1, ws + OFF_WPAT, 1024, 512, NTOK, 1024, 512, 0};
        EpiM1 E1{(h16*)(ws + OFF_M1), (const h16*)(ws + OFF_GATES)};
        pg8::gemm_phase(lds, ga, S, E1);
        pg8::Gemm gb{ws + OFF_R1 + 1024, ws + OFF_WPBT, 1024, 512, NTOK, 1024, 512, 0};
        EpiM2 E2{(const h16*)(ws + OFF_M1), (const h16*)(ws + OFF_GATES), (h16*)(ws + OFF_MM)};
        pg8::gemm_phase(lds, gb, S, E2);
    }
    xcd_barrier(xb);
    {
        pg8::StaticOrder S; S.init(NTOK, 1024, G, c);
        pg8::Gemm g{ws + OFF_MM, ws + OFF_WOUTT, 1024, 1024, NTOK, 1024, 1024, 0};
        EpiX1 E{p.in[I_X], (const float*)(ws + OFF_MOD), (h16*)(ws + OFF_X1H)};
        pg8::gemm_phase(lds, g, S, E);
    }
    xcd_barrier(xb);
    phase6(p, (float*)shm);
    xcd_barrier(xb);
    {
        pg8::StaticOrder S; S.init(NTOK, 2048, G, c);
        pg8::Gemm g{ws + OFF_R1, ws + OFF_WQT, 1024, 1024, NTOK, 2048, 1024, 0};
        EpiH16 E{(h16*)(ws + OFF_SC16), 2048};
        pg8::gemm_phase(lds, g, S, E);
    }
    xcd_barrier(xb);
    peer_phase(p, lds, bar, epoch);
}

extern "C" void kernel_launch(void* const* d_in, const int* in_sizes, int n_in, void* d_out, int out_size, void* d_ws, size_t ws_size, hipStream_t stream) {
    static int grid_blocks = 0;
    if (!grid_blocks) {
        int dev = 0, cus = 0, per_cu = 0;
        hipGetDevice(&dev);
        hipDeviceGetAttribute(&cus, hipDeviceAttributeMultiprocessorCount, dev);
        hipFuncSetAttribute((const void*)mega, hipFuncAttributeMaxDynamicSharedMemorySize, LDS_BYTES);
        hipOccupancyMaxActiveBlocksPerMultiprocessor(&per_cu, (const void*)mega, 512, LDS_BYTES);
        if (per_cu < 1) per_cu = 1;
        grid_blocks = cus * per_cu;
        if (ws_size < WS_END) fprintf(stderr, "kernel_launch: workspace too small: %zu < %zu\n", ws_size, (size_t)WS_END);
    }
    hipMemsetAsync((unsigned char*)d_ws + OFF_BAR, 0, 16384, stream);
    Params p{};
    for (int i = 0; i < 21; ++i) p.in[i] = (const float*)d_in[i];
    p.out = (float*)d_out; p.ws = (unsigned char*)d_ws;
    void* args[] = {&p};
    hipError_t e = hipLaunchCooperativeKernel((const void*)mega, dim3(grid_blocks), dim3(512), args, LDS_BYTES, stream);
    if (e != hipSuccess) fprintf(stderr, "cooperative launch failed: %s (grid %d)\n", hipGetErrorString(e), grid_blocks);
}
```

```cpp
#include <hip/hip_runtime.h>
#include <hip/hip_cooperative_groups.h>
#include <cstdio>
namespace cg = cooperative_groups;

#define LAS __attribute__((address_space(3)))
typedef _Float16 h16;
typedef _Float16 h16x2 __attribute__((ext_vector_type(2)));
typedef _Float16 h16x4 __attribute__((ext_vector_type(4)));
typedef _Float16 h16x8 __attribute__((ext_vector_type(8)));
typedef float f32x4 __attribute__((ext_vector_type(4)));
typedef float f32x2 __attribute__((ext_vector_type(2)));
typedef int i32x4 __attribute__((ext_vector_type(4)));
typedef int i32x2 __attribute__((ext_vector_type(2)));

constexpr int NTOK = 32768, DM = 1024, NCTXT = 4096, INC = 4608, SEQ = 2048, CTXL = 256;
constexpr int LDS_BYTES = 144 * 1024;
#ifndef REP_SEL
#define REP_SEL 1
#endif
#ifndef REP_GATH
#define REP_GATH 1
#endif
#ifndef REP_P3
#define REP_P3 1
#endif

constexpr size_t al256(size_t x) { return (x + 255) & ~(size_t)255; }
constexpr size_t OFF_WINT = 0;
constexpr size_t OFF_WPAT = OFF_WINT + (size_t)INC * DM * 2;
constexpr size_t OFF_WPBT = OFF_WPAT + (size_t)1024 * 512 * 2;
constexpr size_t OFF_WOUTT = OFF_WPBT + (size_t)1024 * 512 * 2;
constexpr size_t OFF_WQT = OFF_WOUTT + (size_t)1024 * 1024 * 2;
constexpr size_t OFF_BD = OFF_WQT + (size_t)2048 * 1024 * 2;
constexpr size_t OFF_U16 = OFF_BD + (size_t)2048 * 256 * 2;
constexpr size_t OFF_V16 = OFF_U16 + (size_t)16384 * 1024 * 2;
constexpr size_t OFF_WS16 = OFF_V16 + (size_t)16384 * 1024 * 2;
constexpr size_t OFF_MODP = OFF_WS16 + (size_t)8 * 128 * 128 * 2;
constexpr size_t OFF_MOD = OFF_MODP + (size_t)16 * 17 * 6144 * 4;
constexpr size_t OFF_R1 = al256(OFF_MOD + (size_t)17 * 6144 * 4);
constexpr size_t OFF_QB = OFF_R1 + (size_t)NTOK * DM * 2;
constexpr size_t OFF_KB = OFF_QB + (size_t)NTOK * 512 * 2;
constexpr size_t OFF_VT = OFF_KB + (size_t)NTOK * 512 * 2;
constexpr size_t OFF_GUV = OFF_VT + (size_t)NTOK * 512 * 2;
constexpr size_t OFF_GATES = OFF_GUV + (size_t)NTOK * 1024 * 2;
constexpr size_t OFF_MM = OFF_GATES + (size_t)NTOK * 2048 * 2;
constexpr size_t OFF_BAR = OFF_MM + (size_t)NTOK * DM * 2;
constexpr size_t WS_END = OFF_BAR + 16384;
constexpr size_t OFF_U8 = OFF_U16;
constexpr size_t OFF_USC = OFF_V16;
constexpr size_t OFF_V8 = OFF_V16;
constexpr size_t OFF_VSC = OFF_V16 + (size_t)16384 * 1024;
constexpr size_t OFF_M1 = OFF_QB;
constexpr size_t OFF_SC16 = OFF_QB;
constexpr size_t OFF_Q16 = OFF_GATES;
constexpr size_t OFF_X1H = OFF_GATES;
constexpr size_t OFF_HC = OFF_MM;
constexpr size_t OFF_KC = OFF_HC + (size_t)NCTXT * DM * 2;
constexpr size_t OFF_VCT = OFF_KC + (size_t)NCTXT * 512 * 2;
static_assert(OFF_M1 + (size_t)NTOK * DM * 4 <= OFF_GATES, "m1 alias");
static_assert(WS_END <= (size_t)512 * 1024 * 1024, "workspace");

struct Params {
    const float* in[21];
    float* out;
    unsigned char* ws;
};
enum { I_X = 0, I_C, I_CTX, I_CCTX, I_ADAW, I_ADAB, I_N1G, I_N2G, I_WIN, I_RPB, I_LNG, I_GMWS, I_GMBS, I_WPA, I_WPB, I_WOUT, I_WQ, I_KEYS, I_PU, I_PV, I_FG };

__device__ __forceinline__ int launder(int x) { asm volatile("" : "+v"(x)); return x; }
__device__ __forceinline__ int fresh_tid() { int t = threadIdx.x; asm volatile("" : "+v"(t)); return t; }

__device__ __forceinline__ float sigmoidf_(float x) { return __builtin_amdgcn_rcpf(1.0f + __expf(-x)); }
__device__ __forceinline__ float gelu_tanh(float x) {
    const float t = 0.7978845608028654f * (x + 0.044715f * x * x * x);
    return x * __builtin_amdgcn_rcpf(1.0f + __expf(-2.0f * t));
}
__device__ __forceinline__ float silu_(float x) { return x * __builtin_amdgcn_rcpf(1.0f + __expf(-x)); }
__device__ __forceinline__ float wave_sum(float v) {
#pragma unroll
    for (int o = 32; o > 0; o >>= 1) v += __shfl_xor(v, o);
    return v;
}
__device__ __forceinline__ h16x8 pack8(f32x4 a, f32x4 b) {
    h16x8 o;
    o[0] = (h16)a[0]; o[1] = (h16)a[1]; o[2] = (h16)a[2]; o[3] = (h16)a[3];
    o[4] = (h16)b[0]; o[5] = (h16)b[1]; o[6] = (h16)b[2]; o[7] = (h16)b[3];
    return o;
}


__device__ __forceinline__ void grid_bar(unsigned* ctr, unsigned& epoch, unsigned nblk) {
    __syncthreads();
    epoch += 1u;
    if (threadIdx.x == 0) {
        __builtin_amdgcn_fence(__ATOMIC_RELEASE, "agent");
        asm volatile("s_waitcnt vmcnt(0)" ::: "memory");
        __hip_atomic_fetch_add(ctr, 1u, __ATOMIC_RELAXED, __HIP_MEMORY_SCOPE_AGENT);
        const unsigned target = epoch * nblk;
        unsigned spins = 0;
        while (__hip_atomic_load(ctr, __ATOMIC_RELAXED, __HIP_MEMORY_SCOPE_AGENT) < target) { __builtin_amdgcn_s_sleep(2); if (++spins > (1u << 24)) break; }
        __builtin_amdgcn_fence(__ATOMIC_ACQUIRE, "agent");
        asm volatile("s_waitcnt vmcnt(0)" ::: "memory");
    }
    __syncthreads();
}


#define XB_TMO      128
#define XB_XCNT(j)  (256  + 64 * (j))
#define XB_XSUB(j)  (1280 + 64 * (j))
#define XB_XGEN(j)  (2304 + 64 * (j))
#define XB_TOP      3328
#define XB_TOPGEN   3392
#define XCD_BAR_WORDS 3456
#define XB_SPIN_CAP (1u << 20)
__device__ __forceinline__ unsigned xb_ld(unsigned* p)              { return __hip_atomic_load(p, __ATOMIC_RELAXED, __HIP_MEMORY_SCOPE_AGENT); }
__device__ __forceinline__ unsigned xb_add(unsigned* p, unsigned v) { return __hip_atomic_fetch_add(p, v, __ATOMIC_RELAXED, __HIP_MEMORY_SCOPE_AGENT); }
__device__ __forceinline__ unsigned xb_xcc_id() { return (unsigned)__builtin_amdgcn_s_getreg((3 << 11) | 20) & 0xFu; }
#define XB_SPIN(cond, bar) do { unsigned _sp = 0; while (cond) { __builtin_amdgcn_s_sleep(1); \
    if ((++_sp & 255u) == 0u) { if (xb_ld(&(bar)[XB_TMO])) break; if (_sp > XB_SPIN_CAP) { atomicAdd(&(bar)[XB_TMO], 1u); break; } } } } while (0)
struct XcdBarrier { unsigned* bar; unsigned x; volatile LAS unsigned* st; };
__device__ __forceinline__ XcdBarrier xcd_barrier_post(unsigned* bar, volatile LAS unsigned* st) {
    XcdBarrier b; b.bar = bar; b.x = xb_xcc_id(); b.st = st;
    if (threadIdx.x == 0) (void)xb_add(&bar[XB_XCNT(b.x)], 1u);
    return b;
}
__device__ __forceinline__ void xcd_barrier_complete(unsigned* bar, unsigned x, unsigned& nloc, unsigned& nx) {
    const unsigned G = gridDim.x * gridDim.y * gridDim.z;
    unsigned sum, cnt, mine, sp = 0u;
    for (;;) {
        sum = 0u; cnt = 0u; mine = 0u;
#pragma unroll
        for (unsigned j = 0; j < 16; ++j) { const unsigned c = xb_ld(&bar[XB_XCNT(j)]); sum += c; cnt += (c > 0u) ? 1u : 0u; mine = (j == x) ? c : mine; }
        if (sum == G) break;
        __builtin_amdgcn_s_sleep(1);
        if ((++sp & 255u) == 0u) { if (xb_ld(&bar[XB_TMO])) break; if (sp > XB_SPIN_CAP) { atomicAdd(&bar[XB_TMO], 1u); break; } }
    }
    nloc = mine > 0u ? mine : 1u; nx = cnt > 0u ? cnt : 1u;
}
__device__ __forceinline__ void xcd_barrier(const XcdBarrier& b) {
    asm volatile("s_waitcnt vmcnt(0)" ::: "memory");
    __syncthreads();
    if (threadIdx.x == 0) {
        unsigned* bar = b.bar;
        __builtin_amdgcn_s_waitcnt(0);
        unsigned nloc = b.st[0], nx = b.st[1];
        if (nloc == 0u) { xcd_barrier_complete(bar, b.x, nloc, nx); b.st[0] = nloc; b.st[1] = nx; }
        const unsigned old = xb_add(&bar[XB_XSUB(b.x)], 1u);
        const unsigned gen = old / nloc;
        if (old + 1u == (gen + 1u) * nloc) {
            __builtin_amdgcn_fence(__ATOMIC_RELEASE, "agent");
            asm volatile("s_waitcnt vmcnt(0)" ::: "memory");
            const unsigned og = xb_add(&bar[XB_TOP], 1u);
            const unsigned tg = og / nx;
            if (og + 1u == (tg + 1u) * nx) xb_add(&bar[XB_TOPGEN], 1u);
            else XB_SPIN(xb_ld(&bar[XB_TOPGEN]) == tg, bar);
            __builtin_amdgcn_fence(__ATOMIC_ACQUIRE, "agent");
            xb_add(&bar[XB_XGEN(b.x)], 1u);
            asm volatile("s_waitcnt vmcnt(0)" ::: "memory");
        } else {
            XB_SPIN(xb_ld(&bar[XB_XGEN(b.x)]) == gen, bar);
            __builtin_amdgcn_fence(__ATOMIC_ACQUIRE, "agent");
            asm volatile("s_waitcnt vmcnt(0)" ::: "memory");
        }
    }
    __syncthreads();
}

namespace pg8 {
constexpr int BM = 256, BK = 64, HALF = 128, HTB = HALF * BK * 2, STAGE_BYTES = 8 * HTB, NXCD = 8, WGM = 8;
__device__ __forceinline__ int lds_byte(int r, int c) { const int st = (r >> 4) * 2 + (c >> 5), rr = r & 15, cc = c & 31, ob = rr * 64 + cc * 2; return st * 1024 + (ob ^ (((ob >> 9) & 1) << 5)); }
__device__ __forceinline__ void stage_rc(int b, int& R, int& C) { const int st = b / 1024, sb = b % 1024, swz = sb ^ (((sb >> 9) & 1) << 5); R = (st >> 1) * 16 + swz / 64; C = (st & 1) * 32 + (swz % 64) / 2; }
__device__ __forceinline__ int perm32(int rho) { const int n = rho >> 4, i = rho & 15; return 8 * (i >> 2) + 4 * n + (i & 3); }

struct Unit { int pm, pn; };
struct Gemm { const void* A; const void* Bt; int lda, ldb, M, N, K, a_pn_bytes; };

struct StaticOrder {
    int nM, nN, nwg, G, c;
    __device__ void init(int M, int N, int G_, int c_) { nM = M / BM; nN = N / BM; nwg = nM * nN; G = G_; c = c_; }
    __device__ bool next(int i, Unit& u) const {
        const long L = (long)i * G + c; if (L >= nwg) return false;
        int wgid = (int)L; { const int q = nwg / NXCD, r = nwg % NXCD, xcd = wgid % NXCD, off = wgid / NXCD; wgid = (xcd < r ? xcd * (q + 1) : r * (q + 1) + (xcd - r) * q) + off; }
        const int nig = WGM * nN, gid = wgid / nig, fm = gid * WGM, gsz = (nM - fm) < WGM ? (nM - fm) : WGM;
        u.pm = fm + ((wgid % nig) % gsz); u.pn = (wgid % nig) / gsz; return true;
    }
};

template <class Epi>
__device__ __forceinline__ void gemm_phase(LAS unsigned char* lds, const Gemm g, const StaticOrder& S, const Epi& E) {
    const int tid = fresh_tid(), wid = __builtin_amdgcn_readfirstlane(tid >> 6), lane = tid & 63, wr = wid >> 2, wc = wid & 3, fr = lane & 15, fq = lane >> 4;
    const int K = g.K, nt = K / BK;
    unsigned voffA[2], voffB[2];
#pragma unroll
    for (int i = 0; i < 2; ++i) { int R, C; stage_rc(tid * 16 + i * 8192, R, C); const int Rb = (R & ~31) + perm32(R & 31);
        voffA[i] = (unsigned)(R * g.lda + C) * 2u; voffB[i] = (unsigned)(Rb * g.ldb + C) * 2u; }
    const size_t kstep = (size_t)(BK * 2);
    const size_t hstepA = (size_t)HALF * g.lda * 2, hstepB = (size_t)HALF * g.ldb * 2;
    const size_t tstepA = 2 * hstepA, tstepB = 2 * hstepB;
    const unsigned ldsw = (unsigned)wid * 1024u;
    const int aoff = lds_byte(wr * 64 + fr, fq * 8), boff = lds_byte(wc * 32 + fr, fq * 8);
#define PG8_SA(b, h) (((b) * 2 + (h)) * HTB)
#define PG8_SB(b, h) ((4 + (b) * 2 + (h)) * HTB)
#define PG8_STAGE(bufoff, gbase, voff) do { _Pragma("unroll") for (int _i = 0; _i < 2; ++_i) \
        __builtin_amdgcn_global_load_lds((const unsigned*)((const char*)(gbase) + (voff)[_i]), (LAS unsigned*)(lds + (bufoff) + ldsw + _i * 8192), 16, 0, 0); } while (0)
#define PG8_LDA(dst, b, h) do { _Pragma("unroll") for (int m = 0; m < 4; ++m) _Pragma("unroll") for (int k = 0; k < 2; ++k) dst[m][k] = *(const LAS h16x8*)(lds + PG8_SA(b, h) + aoff + m * 2048 + k * 1024); } while (0)
#define PG8_LDB(dst, b, h) do { _Pragma("unroll") for (int n = 0; n < 2; ++n) _Pragma("unroll") for (int k = 0; k < 2; ++k) dst[n][k] = *(const LAS h16x8*)(lds + PG8_SB(b, h) + boff + n * 2048 + k * 1024); } while (0)
#define PG8_MMA(ai, bj, At, Bt) do { __builtin_amdgcn_s_setprio(1); _Pragma("unroll") for (int m = 0; m < 4; ++m) _Pragma("unroll") for (int n = 0; n < 2; ++n) _Pragma("unroll") for (int k = 0; k < 2; ++k) \
        acc[ai][bj][m][n] = __builtin_amdgcn_mfma_f32_16x16x32_f16(Bt[n][k], At[m][k], acc[ai][bj][m][n], 0, 0, 0); __builtin_amdgcn_s_setprio(0); } while (0)
#define PG8_WAIT_V(n) asm volatile("s_waitcnt vmcnt(" #n ")" ::: "memory")
#define PG8_WAIT_L(n) asm volatile("s_waitcnt lgkmcnt(" #n ")" ::: "memory")
#define PG8_BAR __builtin_amdgcn_s_barrier()
#define PG8_SCHED __builtin_amdgcn_sched_barrier(0)
    Unit cur, nxt; int ui = 0;
    if (!S.next(0, cur)) return;
    f32x4 acc[2][2][4][2];
#pragma unroll
    for (int a = 0; a < 2; ++a)
#pragma unroll
        for (int b = 0; b < 2; ++b)
#pragma unroll
            for (int m = 0; m < 4; ++m)
#pragma unroll
                for (int n = 0; n < 2; ++n) acc[a][b][m][n] = (f32x4){0.f, 0.f, 0.f, 0.f};
    h16x8 At[4][2], B0[2][2], B1[2][2];
    const char* cA = (const char*)g.A + (size_t)cur.pm * tstepA + (size_t)cur.pn * g.a_pn_bytes; const char* cB = (const char*)g.Bt + (size_t)cur.pn * tstepB;
    PG8_STAGE(PG8_SB(0, 0), cB, voffB); PG8_STAGE(PG8_SA(0, 0), cA, voffA); PG8_STAGE(PG8_SB(0, 1), cB + hstepB, voffB); PG8_STAGE(PG8_SA(0, 1), cA + hstepA, voffA);
    if (wr == 1) PG8_BAR;
    PG8_WAIT_V(4); PG8_BAR;
    PG8_STAGE(PG8_SB(1, 0), cB + kstep, voffB); PG8_STAGE(PG8_SA(1, 0), cA + kstep, voffA); PG8_STAGE(PG8_SB(1, 1), cB + hstepB + kstep, voffB);
    PG8_WAIT_V(6); PG8_BAR;
    for (;;) {
        const bool has_next = S.next(ui + 1, nxt);
        const char* nA = has_next ? (const char*)g.A + (size_t)nxt.pm * tstepA + (size_t)nxt.pn * g.a_pn_bytes : cA; const char* nB = has_next ? (const char*)g.Bt + (size_t)nxt.pn * tstepB : cB;
        for (int t = 0; t < nt; t += 2) {
            const bool last = (t == nt - 2);
            const char* a1 = cA + (size_t)(t + 1) * kstep;
            const char* a2 = last ? nA : cA + (size_t)(t + 2) * kstep; const char* b2 = last ? nB : cB + (size_t)(t + 2) * kstep;
            const char* a3 = a2 + kstep; const char* b3 = b2 + kstep;
            PG8_LDB(B0, 0, 0); PG8_SCHED; PG8_LDA(At, 0, 0); PG8_STAGE(PG8_SA(1, 1), a1 + hstepA, voffA);
            PG8_WAIT_L(8); PG8_BAR; PG8_WAIT_L(0); PG8_MMA(0, 0, At, B0); PG8_BAR; PG8_SCHED;
            PG8_LDB(B1, 0, 1); PG8_STAGE(PG8_SB(0, 0), b2, voffB);
            PG8_BAR; PG8_WAIT_L(0); PG8_MMA(0, 1, At, B1); PG8_BAR;
            PG8_LDA(At, 0, 1); PG8_STAGE(PG8_SA(0, 0), a2, voffA);
            PG8_BAR; PG8_WAIT_L(0); PG8_MMA(1, 0, At, B0); PG8_BAR; PG8_SCHED;
            PG8_STAGE(PG8_SB(0, 1), b2 + hstepB, voffB);
            PG8_WAIT_V(6); PG8_BAR; PG8_MMA(1, 1, At, B1); PG8_BAR;
            PG8_LDB(B0, 1, 0); PG8_SCHED; PG8_LDA(At, 1, 0); PG8_STAGE(PG8_SA(0, 1), a2 + hstepA, voffA);
            PG8_WAIT_L(8); PG8_BAR; PG8_WAIT_L(0); PG8_MMA(0, 0, At, B0); PG8_BAR; PG8_SCHED;
            PG8_LDB(B1, 1, 1); PG8_STAGE(PG8_SB(1, 0), b3, voffB);
            PG8_BAR; PG8_WAIT_L(0); PG8_MMA(0, 1, At, B1); PG8_BAR;
            PG8_LDA(At, 1, 1); PG8_STAGE(PG8_SA(1, 0), a3, voffA);
            PG8_BAR; PG8_WAIT_L(0); PG8_MMA(1, 0, At, B0); PG8_BAR; PG8_SCHED;
            PG8_STAGE(PG8_SB(1, 1), b3 + hstepB, voffB);
            PG8_WAIT_V(6); PG8_BAR; PG8_MMA(1, 1, At, B1); PG8_BAR;
        }
        E(acc, cur, wr, wc, fr, fq);
        if (!has_next) break;
#pragma unroll
        for (int a = 0; a < 2; ++a)
#pragma unroll
            for (int b = 0; b < 2; ++b)
#pragma unroll
                for (int m = 0; m < 4; ++m)
#pragma unroll
                    for (int n = 0; n < 2; ++n) acc[a][b][m][n] = (f32x4){0.f, 0.f, 0.f, 0.f};
        cur = nxt; cA = nA; cB = nB; ++ui;
    }
    PG8_WAIT_V(0);
    if (wr == 0) PG8_BAR;
    PG8_BAR;
#undef PG8_SA
#undef PG8_SB
#undef PG8_STAGE
#undef PG8_LDA
#undef PG8_LDB
#undef PG8_MMA
#undef PG8_WAIT_V
#undef PG8_WAIT_L
#undef PG8_BAR
#undef PG8_SCHED
}
}
typedef f32x4 AccT[2][2][4][2];

struct EpiIn {
    h16 *qb, *kb, *vt, *guv, *gates;
    __device__ __forceinline__ void operator()(const AccT& acc, const pg8::Unit& u, int wr, int wc, int fr, int fq) const {
        const int pn = u.pn;
        const int row0 = u.pm * 256 + wr * 64 + fr;
        const int cin = wc * 32 + 8 * fq;
        const int b = (u.pm * 256) >> 11, sb = ((u.pm * 256) & 2047) + wr * 64;
        if (pn < 2) {
            h16* base = qb + (size_t)row0 * 512 + pn * 256 + cin;
#pragma unroll
            for (int ai = 0; ai < 2; ++ai)
#pragma unroll
                for (int m = 0; m < 4; ++m)
#pragma unroll
                    for (int bj = 0; bj < 2; ++bj) *(h16x8*)(base + (ai * 128 + m * 16) * 512 + bj * 128) = pack8(acc[ai][bj][m][0], acc[ai][bj][m][1]);
        } else if (pn < 4) {
#pragma unroll
            for (int bj = 0; bj < 2; ++bj) {
                const int col = (pn & 1) * 256 + bj * 128 + cin, hd = col >> 6, d0 = col & 63;
                h16* base = kb + ((size_t)(b * 8 + hd) * 2048 + sb + fr) * 64 + d0;
#pragma unroll
                for (int ai = 0; ai < 2; ++ai)
#pragma unroll
                    for (int m = 0; m < 4; ++m) *(h16x8*)(base + (ai * 128 + m * 16) * 64) = pack8(acc[ai][bj][m][0], acc[ai][bj][m][1]);
            }
        } else if (pn < 6) {
#pragma unroll
            for (int bj = 0; bj < 2; ++bj) {
                const int cv = (pn - 4) * 256 + bj * 128 + cin, hd = cv >> 6, d0 = cv & 63;
                h16* base = vt + ((size_t)(b * 8 + hd) * 256 + (sb >> 3) + (fr >> 3)) * 512 + d0 * 8 + (fr & 7);
#pragma unroll
                for (int ai = 0; ai < 2; ++ai)
#pragma unroll
                    for (int m = 0; m < 4; ++m) {
                        h16* vp = base + (ai * 16 + m * 2) * 512;
                        const f32x4 v0 = acc[ai][bj][m][0], v1 = acc[ai][bj][m][1];
#pragma unroll
                        for (int i = 0; i < 4; ++i) { vp[i * 8] = (h16)v0[i]; vp[(i + 4) * 8] = (h16)v1[i]; }
                    }
            }
        } else if (pn < 10) {
            h16* base = guv + (size_t)row0 * 1024 + (pn - 6) * 256 + cin;
#pragma unroll
            for (int ai = 0; ai < 2; ++ai)
#pragma unroll
                for (int m = 0; m < 4; ++m)
#pragma unroll
                    for (int bj = 0; bj < 2; ++bj) {
                        f32x4 v0 = acc[ai][bj][m][0], v1 = acc[ai][bj][m][1];
#pragma unroll
                        for (int i = 0; i < 4; ++i) { v0[i] = gelu_tanh(v0[i]); v1[i] = gelu_tanh(v1[i]); }
                        *(h16x8*)(base + (ai * 128 + m * 16) * 1024 + bj * 128) = pack8(v0, v1);
                    }
        } else {
            h16* base = gates + (size_t)row0 * 2048 + (pn - 10) * 256 + cin;
#pragma unroll
            for (int ai = 0; ai < 2; ++ai)
#pragma unroll
                for (int m = 0; m < 4; ++m)
#pragma unroll
                    for (int bj = 0; bj < 2; ++bj) {
                        f32x4 v0 = acc[ai][bj][m][0], v1 = acc[ai][bj][m][1];
#pragma unroll
                        for (int i = 0; i < 4; ++i) { v0[i] = sigmoidf_(v0[i]); v1[i] = sigmoidf_(v1[i]); }
                        *(h16x8*)(base + (ai * 128 + m * 16) * 2048 + bj * 128) = pack8(v0, v1);
                    }
        }
    }
};
struct EpiCtx {
    h16 *kc, *vct;
    __device__ __forceinline__ void operator()(const AccT& acc, const pg8::Unit& u, int wr, int wc, int fr, int fq) const {
        const int pn = u.pn;
        const int cin = wc * 32 + 8 * fq;
        const int b = u.pm, sb = wr * 64;
        if (pn < 2) {
#pragma unroll
            for (int bj = 0; bj < 2; ++bj) {
                const int col = pn * 256 + bj * 128 + cin, hd = col >> 6, d0 = col & 63;
                h16* base = kc + ((size_t)(b * 8 + hd) * 256 + sb + fr) * 64 + d0;
#pragma unroll
                for (int ai = 0; ai < 2; ++ai)
#pragma unroll
                    for (int m = 0; m < 4; ++m) *(h16x8*)(base + (ai * 128 + m * 16) * 64) = pack8(acc[ai][bj][m][0], acc[ai][bj][m][1]);
            }
        } else {
#pragma unroll
            for (int bj = 0; bj < 2; ++bj) {
                const int cv = (pn - 2) * 256 + bj * 128 + cin, hd = cv >> 6, d0 = cv & 63;
                h16* base = vct + ((size_t)(b * 8 + hd) * 32 + (sb >> 3) + (fr >> 3)) * 512 + d0 * 8 + (fr & 7);
#pragma unroll
                for (int ai = 0; ai < 2; ++ai)
#pragma unroll
                    for (int m = 0; m < 4; ++m) {
                        h16* vp = base + (ai * 16 + m * 2) * 512;
                        const f32x4 v0 = acc[ai][bj][m][0], v1 = acc[ai][bj][m][1];
#pragma unroll
                        for (int i = 0; i < 4; ++i) { vp[i * 8] = (h16)v0[i]; vp[(i + 4) * 8] = (h16)v1[i]; }
                    }
            }
        }
    }
};
struct EpiM1 {
    h16* m1; const h16* gates;
    __device__ __forceinline__ void operator()(const AccT& acc, const pg8::Unit& u, int wr, int wc, int fr, int fq) const {
        const int row0 = u.pm * 256 + wr * 64 + fr, col0 = u.pn * 256 + wc * 32 + 8 * fq;
#pragma unroll
        for (int ai = 0; ai < 2; ++ai)
#pragma unroll
            for (int m = 0; m < 4; ++m) {
                const int row = row0 + ai * 128 + m * 16;
#pragma unroll
                for (int bj = 0; bj < 2; ++bj) {
                    const int col = col0 + bj * 128;
                    const h16x8 gt = *(const h16x8*)(gates + (size_t)row * 2048 + col);
                    f32x4 v0 = acc[ai][bj][m][0], v1 = acc[ai][bj][m][1];
#pragma unroll
                    for (int i = 0; i < 4; ++i) { v0[i] *= (float)gt[i]; v1[i] *= (float)gt[4 + i]; }
                    *(h16x8*)(m1 + (size_t)row * 1024 + col) = pack8(v0, v1);
                }
            }
    }
};
struct EpiM2 {
    const h16* m1; const h16* gates; h16* mm;
    __device__ __forceinline__ void operator()(const AccT& acc, const pg8::Unit& u, int wr, int wc, int fr, int fq) const {
        const int row0 = u.pm * 256 + wr * 64 + fr, col0 = u.pn * 256 + wc * 32 + 8 * fq;
#pragma unroll
        for (int ai = 0; ai < 2; ++ai)
#pragma unroll
            for (int m = 0; m < 4; ++m) {
                const int row = row0 + ai * 128 + m * 16;
#pragma unroll
                for (int bj = 0; bj < 2; ++bj) {
                    const int col = col0 + bj * 128;
                    const h16x8 gt = *(const h16x8*)(gates + (size_t)row * 2048 + 1024 + col);
                    const h16x8 mi = *(const h16x8*)(m1 + (size_t)row * 1024 + col);
                    f32x4 p0 = (f32x4){(float)mi[0], (float)mi[1], (float)mi[2], (float)mi[3]}, p1 = (f32x4){(float)mi[4], (float)mi[5], (float)mi[6], (float)mi[7]};
                    const f32x4 v0 = acc[ai][bj][m][0], v1 = acc[ai][bj][m][1];
#pragma unroll
                    for (int i = 0; i < 4; ++i) { p0[i] += v0[i] * (float)gt[i]; p1[i] += v1[i] * (float)gt[4 + i]; }
                    *(h16x8*)(mm + (size_t)row * 1024 + col) = pack8(p0, p1);
                }
            }
    }
};
struct EpiX1 {
    const float* x; const float* mod; h16* x1;
    __device__ __forceinline__ void operator()(const AccT& acc, const pg8::Unit& u, int wr, int wc, int fr, int fq) const {
        const int row0 = u.pm * 256 + wr * 64 + fr, col0 = u.pn * 256 + wc * 32 + 8 * fq;
        const int b = (u.pm * 256) >> 11;
#pragma unroll
        for (int bj = 0; bj < 2; ++bj) {
            const int col = col0 + bj * 128;
            const float* gp = mod + (size_t)b * 6144 + 2 * 1024 + col;
            const f32x4 g0 = *(const f32x4*)gp, g1 = *(const f32x4*)(gp + 4);
#pragma unroll
            for (int ai = 0; ai < 2; ++ai)
#pragma unroll
                for (int m = 0; m < 4; ++m) {
                    const int row = row0 + ai * 128 + m * 16;
                    const float* xi = x + (size_t)row * 1024 + col;
                    const f32x4 x0 = *(const f32x4*)xi, x1v = *(const f32x4*)(xi + 4);
                    *(h16x8*)(x1 + (size_t)row * 1024 + col) = pack8(x0 + g0 * acc[ai][bj][m][0], x1v + g1 * acc[ai][bj][m][1]);
                }
        }
    }
};
struct EpiH16 {
    h16* o; int ldc;
    __device__ __forceinline__ void operator()(const AccT& acc, const pg8::Unit& u, int wr, int wc, int fr, int fq) const {
        const int row0 = u.pm * 256 + wr * 64 + fr, col0 = u.pn * 256 + wc * 32 + 8 * fq;
#pragma unroll
        for (int ai = 0; ai < 2; ++ai)
#pragma unroll
            for (int m = 0; m < 4; ++m) {
                const int row = row0 + ai * 128 + m * 16;
#pragma unroll
                for (int bj = 0; bj < 2; ++bj)
                    *(h16x8*)(o + (size_t)row * ldc + col0 + bj * 128) = pack8(acc[ai][bj][m][0], acc[ai][bj][m][1]);
            }
    }
};

__device__ __forceinline__ void cvt_tile(const float* __restrict__ src, h16* __restrict__ dst, int tile) {
    const size_t i = (size_t)tile * 4096 + threadIdx.x * 8;
    const f32x4 a = *(const f32x4*)(src + i), b = *(const f32x4*)(src + i + 4);
    *(h16x8*)(dst + i) = pack8(a, b);
}
__device__ __forceinline__ void tr_tile(const float* __restrict__ src, h16* __restrict__ dst, int K, int N, int tile, float* lds) {
    const int ntn = N / 64, tk = tile / ntn, tn = tile % ntn, tid = threadIdx.x;
#pragma unroll
    for (int ps = 0; ps < 2; ++ps) {
        const int k = ps * 32 + (tid >> 4), n = (tid & 15) * 4;
        const f32x4 v = *(const f32x4*)(src + (size_t)(tk * 64 + k) * N + tn * 64 + n);
        lds[k * 65 + n] = v[0]; lds[k * 65 + n + 1] = v[1]; lds[k * 65 + n + 2] = v[2]; lds[k * 65 + n + 3] = v[3];
    }
    __syncthreads();
    {
        const int n = tid >> 3, ks = (tid & 7) * 8;
        h16x8 o;
#pragma unroll
        for (int i = 0; i < 8; ++i) o[i] = (h16)lds[(ks + i) * 65 + n];
        *(h16x8*)(dst + (size_t)(tn * 64 + n) * K + tk * 64 + ks) = o;
    }
    __syncthreads();
}
__device__ __forceinline__ void cvt8_rows(const float* __restrict__ src, unsigned char* __restrict__ dst, float* __restrict__ inv, int tile, int dstride = 1024) {
    const int wid = threadIdx.x >> 6, lane = threadIdx.x & 63;
    const size_t row = (size_t)tile * 8 + wid;
    const float* r = src + row * 1024 + lane * 16;
    f32x4 a[4]; float mx = 0.f;
#pragma unroll
    for (int i = 0; i < 4; ++i) { a[i] = *(const f32x4*)(r + 4 * i); mx = fmaxf(mx, fmaxf(fmaxf(fabsf(a[i][0]), fabsf(a[i][1])), fmaxf(fabsf(a[i][2]), fabsf(a[i][3])))); }
#pragma unroll
    for (int o = 32; o > 0; o >>= 1) mx = fmaxf(mx, __shfl_xor(mx, o));
    int ex2 = 0; float sc = 1.0f;
    if (mx > 0.f) { (void)frexpf(mx, &ex2); int k = 8 - ex2; k = k > 100 ? 100 : (k < -100 ? -100 : k); sc = ldexpf(1.0f, k); }
    i32x4 w;
#pragma unroll
    for (int i = 0; i < 4; ++i) {
        int pk = __builtin_amdgcn_cvt_pk_fp8_f32(a[i][0] * sc, a[i][1] * sc, 0, false);
        pk = __builtin_amdgcn_cvt_pk_fp8_f32(a[i][2] * sc, a[i][3] * sc, pk, true);
        w[i] = pk;
    }
    *(i32x4*)(dst + row * dstride + lane * 16) = w;
    if (lane == 0) inv[2 * row] = 1.0f / sc;
}
__device__ __forceinline__ void cvt4_rows(const float* __restrict__ src, unsigned char* __restrict__ dst, float* __restrict__ inv, int tile, int dstride = 512) {
    const int wid = threadIdx.x >> 6, lane = threadIdx.x & 63;
    const size_t row = (size_t)tile * 8 + wid;
    const float* r = src + row * 1024 + lane * 16;
    f32x4 a[4]; float mx = 0.f;
#pragma unroll
    for (int i = 0; i < 4; ++i) { a[i] = *(const f32x4*)(r + 4 * i); mx = fmaxf(mx, fmaxf(fmaxf(fabsf(a[i][0]), fabsf(a[i][1])), fmaxf(fabsf(a[i][2]), fabsf(a[i][3])))); }
#pragma unroll
    for (int o = 32; o > 0; o >>= 1) mx = fmaxf(mx, __shfl_xor(mx, o));
    const float sc = (mx > 1e-30f) ? 6.0f / mx : 1.0f;
    int w0 = 0, w1 = 0;
    w0 = __builtin_amdgcn_cvt_scalef32_pk_fp4_f32(w0, a[0][0] * sc, a[0][1] * sc, 1.0f, 0);
    w0 = __builtin_amdgcn_cvt_scalef32_pk_fp4_f32(w0, a[0][2] * sc, a[0][3] * sc, 1.0f, 1);
    w0 = __builtin_amdgcn_cvt_scalef32_pk_fp4_f32(w0, a[1][0] * sc, a[1][1] * sc, 1.0f, 2);
    w0 = __builtin_amdgcn_cvt_scalef32_pk_fp4_f32(w0, a[1][2] * sc, a[1][3] * sc, 1.0f, 3);
    w1 = __builtin_amdgcn_cvt_scalef32_pk_fp4_f32(w1, a[2][0] * sc, a[2][1] * sc, 1.0f, 0);
    w1 = __builtin_amdgcn_cvt_scalef32_pk_fp4_f32(w1, a[2][2] * sc, a[2][3] * sc, 1.0f, 1);
    w1 = __builtin_amdgcn_cvt_scalef32_pk_fp4_f32(w1, a[3][0] * sc, a[3][1] * sc, 1.0f, 2);
    w1 = __builtin_amdgcn_cvt_scalef32_pk_fp4_f32(w1, a[3][2] * sc, a[3][3] * sc, 1.0f, 3);
    *(i32x2*)(dst + row * dstride + lane * 8) = (i32x2){w0, w1};
    if (lane == 0) inv[2 * row] = 1.0f / sc;
}
__device__ __forceinline__ void wqk_tile(const float* __restrict__ wq, const float* __restrict__ keys, h16* __restrict__ wt, int tile, float* lds) {
    const int ct = tile >> 4, hp = tile & 15, tid = threadIdx.x;
    float* sA = lds;
    float* sB = lds + 64 * 129;
#pragma unroll
    for (int i = 0; i < 4; ++i) {
        const int e = (i * 512 + tid) * 4, r = e >> 7, d = e & 127;
        const f32x4 v = *(const f32x4*)(wq + (size_t)(ct * 64 + r) * 2048 + hp * 128 + d);
        sA[r * 129 + d] = v[0]; sA[r * 129 + d + 1] = v[1]; sA[r * 129 + d + 2] = v[2]; sA[r * 129 + d + 3] = v[3];
    }
#pragma unroll
    for (int i = 0; i < 8; ++i) {
        const int e = (i * 512 + tid) * 4, k = e >> 7, d = e & 127;
        const f32x4 v = *(const f32x4*)(keys + (size_t)(hp * 128 + k) * 128 + d);
        sB[k * 129 + d] = v[0]; sB[k * 129 + d + 1] = v[1]; sB[k * 129 + d + 2] = v[2]; sB[k * 129 + d + 3] = v[3];
    }
    __syncthreads();
    const int cg = tid >> 5, kq = tid & 31;
    float acc[4][4];
#pragma unroll
    for (int i = 0; i < 4; ++i)
#pragma unroll
        for (int j = 0; j < 4; ++j) acc[i][j] = 0.f;
#pragma unroll 4
    for (int d = 0; d < 128; ++d) {
        float a[4], bq[4];
#pragma unroll
        for (int i = 0; i < 4; ++i) a[i] = sA[(cg * 4 + i) * 129 + d];
#pragma unroll
        for (int j = 0; j < 4; ++j) bq[j] = sB[(kq + 32 * j) * 129 + d];
#pragma unroll
        for (int i = 0; i < 4; ++i)
#pragma unroll
            for (int j = 0; j < 4; ++j) acc[i][j] += a[i] * bq[j];
    }
#pragma unroll
    for (int j = 0; j < 4; ++j) {
        h16x4 o;
#pragma unroll
        for (int i = 0; i < 4; ++i) o[i] = (h16)acc[i][j];
        *(h16x4*)(wt + (size_t)(hp * 128 + kq + 32 * j) * 1024 + ct * 64 + cg * 4) = o;
    }
    __syncthreads();
}
__device__ void phase0(const Params& p, float* lds) {
    unsigned char* ws = p.ws;
    const int tid = threadIdx.x, wid = tid >> 6, lane = tid & 63;
    for (int ib = blockIdx.x; ib < 256; ib += gridDim.x) {
        if (wid < 6) {
            const int item = ib * 6 + wid, cg64 = item % 96, kc = item / 96;
            const int col = cg64 * 64 + lane, k0 = kc * 64;
            float sv[17], acc[17];
#pragma unroll
            for (int b = 0; b < 17; ++b) {
                const float cv = (b < 16) ? p.in[I_C][b * 1024 + k0 + lane] : p.in[I_CCTX][k0 + lane];
                sv[b] = silu_(cv); acc[b] = 0.f;
            }
            const float* wp = p.in[I_ADAW] + (size_t)k0 * 6144 + col;
            for (int j = 0; j < 64; ++j) {
                const float w = wp[(size_t)j * 6144];
#pragma unroll
                for (int b = 0; b < 17; ++b) acc[b] += __builtin_bit_cast(float, __builtin_amdgcn_readlane(__builtin_bit_cast(int, sv[b]), j)) * w;
            }
            float* mp = (float*)(ws + OFF_MODP);
#pragma unroll
            for (int b = 0; b < 17; ++b) mp[((size_t)kc * 17 + b) * 6144 + col] = acc[b];
        }
    }
    constexpr int T0 = 2048, T1 = T0 + 2048, T2 = T1 + 32, T3 = T2, T4 = T3 + 1152, T5 = T4 + 128, T6 = T5 + 128, T7 = T6 + 256, T8 = T7 + 256;
    for (int t = blockIdx.x; t < T8; t += gridDim.x) {
        if (t < T0) cvt4_rows(p.in[I_PU], ws + OFF_U8, (float*)(ws + OFF_USC), t, 1536);
        else if (t < T1) cvt8_rows(p.in[I_PV], ws + OFF_U8 + 512, (float*)(ws + OFF_USC) + 1, t - T0, 1536);
        else if (t < T2) cvt_tile(p.in[I_GMWS], (h16*)(ws + OFF_WS16), t - T1);
        else if (t < T3) {
            const int e = (t - T2) * 4096 + tid * 8;
            const int row = e >> 8, cc = e & 255, h = row >> 8, pp = (row >> 7) & 1, k = row & 127, pq = cc >> 7, d = cc & 127;
            h16x8 o = {0, 0, 0, 0, 0, 0, 0, 0};
            if (pp == pq) {
                const float* kp = p.in[I_KEYS] + ((size_t)((h * 2 + pp) * 128 + k)) * 128 + d;
                o = pack8(*(const f32x4*)kp, *(const f32x4*)(kp + 4));
            }
            *(h16x8*)((h16*)(ws + OFF_BD) + e) = o;
        }
        else if (t < T4) tr_tile(p.in[I_WIN], (h16*)(ws + OFF_WINT), 1024, INC, t - T3, lds);
        else if (t < T5) tr_tile(p.in[I_WPA], (h16*)(ws + OFF_WPAT), 512, 1024, t - T4, lds);
        else if (t < T6) tr_tile(p.in[I_WPB], (h16*)(ws + OFF_WPBT), 512, 1024, t - T5, lds);
        else if (t < T7) tr_tile(p.in[I_WOUT], (h16*)(ws + OFF_WOUTT), 1024, 1024, t - T6, lds);
        else wqk_tile(p.in[I_WQ], p.in[I_KEYS], (h16*)(ws + OFF_WQT), t - T7, lds);
    }
}

__device__ __forceinline__ void norm_rows(const float* __restrict__ src, h16* __restrict__ dst, int row_begin, int rows_per_wave, const float* sA, const float* sB) {
    const int tid_ = fresh_tid();
    const int wid = tid_ >> 6, lane = tid_ & 63;
    f32x4 a[4], bsh[4];
#pragma unroll
    for (int c = 0; c < 4; ++c) { a[c] = *(const f32x4*)(sA + c * 256 + lane * 4); bsh[c] = *(const f32x4*)(sB + c * 256 + lane * 4); }
    for (int i = 0; i < rows_per_wave; i += 2) {
        const size_t row = (size_t)row_begin + wid * rows_per_wave + i;
        f32x4 v[2][4]; float ss[2];
#pragma unroll
        for (int q = 0; q < 2; ++q) {
            ss[q] = 0.f;
#pragma unroll
            for (int c = 0; c < 4; ++c) { v[q][c] = *(const f32x4*)(src + (row + q) * 1024 + c * 256 + lane * 4); ss[q] += v[q][c][0] * v[q][c][0] + v[q][c][1] * v[q][c][1] + v[q][c][2] * v[q][c][2] + v[q][c][3] * v[q][c][3]; }
        }
#pragma unroll
        for (int o = 32; o > 0; o >>= 1) { const float t0 = __shfl_xor(ss[0], o), t1 = __shfl_xor(ss[1], o); ss[0] += t0; ss[1] += t1; }
#pragma unroll
        for (int q = 0; q < 2; ++q) {
            const float r = rsqrtf(ss[q] * (1.0f / 1024.0f) + 1e-6f);
#pragma unroll
            for (int c = 0; c < 4; ++c) {
                h16x4 o;
#pragma unroll
                for (int j = 0; j < 4; ++j) o[j] = (h16)(v[q][c][j] * r * a[c][j] + bsh[c][j]);
                *(h16x4*)(dst + (row + q) * 1024 + c * 256 + lane * 4) = o;
            }
        }
    }
}
__device__ __forceinline__ void norm_rows_h(const h16* __restrict__ src, h16* __restrict__ dst, int row_begin, int rows_per_wave, const float* sA, const float* sB) {
    const int tid_ = fresh_tid();
    const int wid = tid_ >> 6, lane = tid_ & 63;
    f32x4 a[4], bsh[4];
#pragma unroll
    for (int c = 0; c < 4; ++c) { a[c] = *(const f32x4*)(sA + c * 256 + lane * 4); bsh[c] = *(const f32x4*)(sB + c * 256 + lane * 4); }
    for (int i = 0; i < rows_per_wave; i += 2) {
        const size_t row = (size_t)row_begin + wid * rows_per_wave + i;
        f32x4 v[2][4]; float ss[2];
#pragma unroll
        for (int q = 0; q < 2; ++q) {
            ss[q] = 0.f;
#pragma unroll
            for (int c = 0; c < 4; ++c) { const h16x4 hv = *(const h16x4*)(src + (row + q) * 1024 + c * 256 + lane * 4);
                v[q][c] = (f32x4){(float)hv[0], (float)hv[1], (float)hv[2], (float)hv[3]};
                ss[q] += v[q][c][0] * v[q][c][0] + v[q][c][1] * v[q][c][1] + v[q][c][2] * v[q][c][2] + v[q][c][3] * v[q][c][3]; }
        }
#pragma unroll
        for (int o = 32; o > 0; o >>= 1) { const float t0 = __shfl_xor(ss[0], o), t1 = __shfl_xor(ss[1], o); ss[0] += t0; ss[1] += t1; }
#pragma unroll
        for (int q = 0; q < 2; ++q) {
            const float r = rsqrtf(ss[q] * (1.0f / 1024.0f) + 1e-6f);
#pragma unroll
            for (int c = 0; c < 4; ++c) {
                h16x4 o;
#pragma unroll
                for (int j = 0; j < 4; ++j) o[j] = (h16)(v[q][c][j] * r * a[c][j] + bsh[c][j]);
                *(h16x4*)(dst + (row + q) * 1024 + c * 256 + lane * 4) = o;
            }
        }
    }
}
__device__ void phase1(const Params& p, float* lds) {
    unsigned char* ws = p.ws;
    const int tid = threadIdx.x;
    const float* mp = (const float*)(ws + OFF_MODP);
    const float* bias = p.in[I_ADAB];
    float* sA = lds; float* sB = lds + 1024; float* cA = lds + 2048; float* cB = lds + 3072;
    {
        float* mod = (float*)(ws + OFF_MOD);
        for (int e = blockIdx.x * 512 + tid; e < 17 * 6144; e += gridDim.x * 512) {
            float s = bias[e % 6144];
#pragma unroll
            for (int kc = 0; kc < 16; ++kc) s += mp[(size_t)kc * 17 * 6144 + e];
            mod[e] = s;
        }
    }
    for (int col = tid; col < 1024; col += 512) {
        float sh = bias[col], sc = bias[1024 + col];
#pragma unroll
        for (int kc = 0; kc < 16; ++kc) { sh += mp[((size_t)kc * 17 + 16) * 6144 + col]; sc += mp[((size_t)kc * 17 + 16) * 6144 + 1024 + col]; }
        cA[col] = p.in[I_N1G][col] * (1.0f + sc); cB[col] = sh;
    }
    for (int rg = blockIdx.x; rg < 256; rg += gridDim.x) {
        const int b = rg >> 4;
        __syncthreads();
        for (int col = tid; col < 1024; col += 512) {
            float sh = bias[col], sc = bias[1024 + col];
#pragma unroll
            for (int kc = 0; kc < 16; ++kc) { sh += mp[((size_t)kc * 17 + b) * 6144 + col]; sc += mp[((size_t)kc * 17 + b) * 6144 + 1024 + col]; }
            sA[col] = p.in[I_N1G][col] * (1.0f + sc); sB[col] = sh;
        }
        __syncthreads();
        norm_rows(p.in[I_X], (h16*)(ws + OFF_R1), rg * 128, 16, sA, sB);
        norm_rows(p.in[I_CTX], (h16*)(ws + OFF_HC), rg * 16, 2, cA, cB);
    }
}
__device__ void phase6(const Params& p, float* lds) {
    unsigned char* ws = p.ws;
    const int tid = threadIdx.x;
    const float* mod = (const float*)(ws + OFF_MOD);
    float* sA = lds; float* sB = lds + 1024;
    for (int rg = blockIdx.x; rg < 256; rg += gridDim.x) {
        const int b = rg >> 4;
        __syncthreads();
        for (int col = tid; col < 1024; col += 512) {
            sA[col] = p.in[I_N2G][col] * (1.0f + mod[(size_t)b * 6144 + 4 * 1024 + col]); sB[col] = mod[(size_t)b * 6144 + 3 * 1024 + col];
        }
        __syncthreads();
        norm_rows_h((const h16*)(ws + OFF_X1H), (h16*)(ws + OFF_R1), rg * 128, 16, sA, sB);
    }
}

__device__ __forceinline__ int clampi(int v, int lo, int hi) { return v < lo ? lo : (v > hi ? hi : v); }

template <bool LOCAL>
__device__ __forceinline__ void attn_core(const h16x8 (&kf)[2][2], const h16x8 (&vf)[4], const float (&bias)[8], const int cb, const int qc, const int cs,
                                          const h16x8 (&qf)[2], float& m_run, float& l_run, f32x4 (&O)[4], const int quad) {
    f32x4 st[2];
#pragma unroll
    for (int t = 0; t < 2; ++t) {
        f32x4 a = (f32x4){0.f, 0.f, 0.f, 0.f};
#pragma unroll
        for (int ks = 0; ks < 2; ++ks) a = __builtin_amdgcn_mfma_f32_16x16x32_f16(kf[t][ks], qf[ks], a, 0, 0, 0);
        st[t] = a;
    }
    float mx = -INFINITY;
#pragma unroll
    for (int t = 0; t < 2; ++t)
#pragma unroll
        for (int j = 0; j < 4; ++j) {
            float sv = st[t][j] * 0.125f;
            if (LOCAL) {
                const int kc = cb + 16 * t + quad * 4 + j;
                const bool inw = (kc >= cs) && (kc < cs + 16);
                sv = inw ? (sv + bias[t * 4 + j]) : -1e30f;
            }
            st[t][j] = sv; mx = fmaxf(mx, sv);
        }
    mx = fmaxf(mx, __shfl_xor(mx, 16)); mx = fmaxf(mx, __shfl_xor(mx, 32));
    const float m_new = fmaxf(m_run, mx);
    const float alpha = __expf(m_run - m_new);
    float ls = 0.f; h16x8 pf;
#pragma unroll
    for (int t = 0; t < 2; ++t)
#pragma unroll
        for (int j = 0; j < 4; ++j) { const float pe = __expf(st[t][j] - m_new); ls += pe; pf[t * 4 + j] = (h16)pe; }
    l_run = l_run * alpha + ls; m_run = m_new;
#pragma unroll
    for (int dt = 0; dt < 4; ++dt) { O[dt] *= alpha; O[dt] = __builtin_amdgcn_mfma_f32_16x16x32_f16(vf[dt], pf, O[dt], 0, 0, 0); }
}
__device__ __forceinline__ void load_k(const h16* __restrict__ kt, h16x8 (&kf)[2][2], const int l15, const int quad) {
#pragma unroll
    for (int t = 0; t < 2; ++t)
#pragma unroll
        for (int ks = 0; ks < 2; ++ks) kf[t][ks] = *(const h16x8*)(kt + (16 * t + l15) * 64 + ks * 32 + quad * 8);
}
__device__ __forceinline__ void load_v(const h16* __restrict__ vt, h16x8 (&vf)[4], const int l15, const int quad) {
#pragma unroll
    for (int dt = 0; dt < 4; ++dt) {
        const h16* vp = vt + ((quad >> 1) * 64 + dt * 16 + l15) * 8 + (quad & 1) * 4;
        const h16x4 lo = *(const h16x4*)vp, hi = *(const h16x4*)(vp + 2 * 512);
        vf[dt] = (h16x8){lo[0], lo[1], lo[2], lo[3], hi[0], hi[1], hi[2], hi[3]};
    }
}
__device__ __forceinline__ void load_bias(const float* __restrict__ rpbrow, const int cb, const int qc, const int quad, float (&bias)[8]) {
#pragma unroll
    for (int t = 0; t < 2; ++t)
#pragma unroll
        for (int j = 0; j < 4; ++j) bias[t * 4 + j] = rpbrow[clampi(cb + 16 * t + quad * 4 + j - qc + 15, 0, 30)];
}

__device__ void attn_unit(const Params& p, int unit) {
    unsigned char* ws = p.ws;
    const int tid_ = fresh_tid();
    const int lane = tid_ & 63, h = tid_ >> 6, l15 = lane & 15, quad = lane >> 4;
    const int b = unit >> 5, r = unit & 31;
    const h16* QB = (const h16*)(ws + OFF_QB);
    const h16* KH = (const h16*)(ws + OFF_KB) + (size_t)(b * 8 + h) * 2048 * 64;
    const h16* VH = (const h16*)(ws + OFF_VT) + (size_t)(b * 8 + h) * 256 * 512;
    const h16* KCH = (const h16*)(ws + OFF_KC) + (size_t)(b * 8 + h) * 256 * 64;
    const h16* VCH = (const h16*)(ws + OFF_VCT) + (size_t)(b * 8 + h) * 32 * 512;
    h16* YA = (h16*)(ws + OFF_R1);
    const float* rpb = p.in[I_RPB] + (size_t)h * 15 * 31;
    const int rs = clampi(r - 4, 0, 24);
    h16x8 qf[4][2]; float m_run[4], l_run[4]; f32x4 O[4][4];
#pragma unroll
    for (int g = 0; g < 4; ++g) {
        const size_t tq = (size_t)b * 2048 + r * 64 + 16 * g + l15;
        qf[g][0] = *(const h16x8*)(QB + tq * 512 + h * 64 + quad * 8);
        qf[g][1] = *(const h16x8*)(QB + tq * 512 + h * 64 + 32 + quad * 8);
        m_run[g] = -INFINITY; l_run[g] = 0.f;
#pragma unroll
        for (int dt = 0; dt < 4; ++dt) O[g][dt] = (f32x4){0.f, 0.f, 0.f, 0.f};
    }
    {
        const float nob[8] = {0.f, 0.f, 0.f, 0.f, 0.f, 0.f, 0.f, 0.f};
        h16x8 kA[2][2], kB[2][2], vf[4];
        load_k(KCH, kA, l15, quad);
#pragma unroll 1
        for (int step = 0; step < 8; step += 2) {
            load_v(VCH + step * 4 * 512, vf, l15, quad);
            load_k(KCH + (step + 1) * 32 * 64, kB, l15, quad);
            __builtin_amdgcn_sched_barrier(0);
#pragma unroll
            for (int g = 0; g < 4; ++g) attn_core<false>(kA, vf, nob, 0, 0, 0, qf[g], m_run[g], l_run[g], O[g], quad);
            __builtin_amdgcn_sched_barrier(0);
            load_v(VCH + (step + 1) * 4 * 512, vf, l15, quad);
            if (step + 2 < 8) load_k(KCH + (step + 2) * 32 * 64, kA, l15, quad);
            __builtin_amdgcn_sched_barrier(0);
#pragma unroll
            for (int g = 0; g < 4; ++g) attn_core<false>(kB, vf, nob, 0, 0, 0, qf[g], m_run[g], l_run[g], O[g], quad);
            __builtin_amdgcn_sched_barrier(0);
        }
    }
#pragma unroll
    for (int gp = 0; gp < 4; gp += 2) {
        const int cb0 = clampi(16 * gp - 8, 0, 32), cb1 = clampi(16 * (gp + 1) - 8, 0, 32);
        const int qc0 = 16 * gp + l15, qc1 = 16 * (gp + 1) + l15;
        const int cs0 = clampi(qc0 - 8, 0, 48), cs1 = clampi(qc1 - 8, 0, 48);
        const float* rp0 = rpb + (rs - r + 7) * 31;
#pragma unroll 1
        for (int step = 0; step < 8; ++step) {
            const int t0 = (rs + step) * 64 + cb0, t1 = (rs + step) * 64 + cb1;
            h16x8 kf0[2][2], vf0[4], kf1[2][2], vf1[4]; float b0[8], b1[8];
            load_k(KH + (size_t)t0 * 64, kf0, l15, quad); load_k(KH + (size_t)t1 * 64, kf1, l15, quad);
            load_bias(rp0 + step * 31, cb0, qc0, quad, b0); load_bias(rp0 + step * 31, cb1, qc1, quad, b1);
            load_v(VH + (size_t)(t0 >> 3) * 512, vf0, l15, quad); load_v(VH + (size_t)(t1 >> 3) * 512, vf1, l15, quad);
            attn_core<true>(kf0, vf0, b0, cb0, qc0, cs0, qf[gp], m_run[gp], l_run[gp], O[gp], quad);
            attn_core<true>(kf1, vf1, b1, cb1, qc1, cs1, qf[gp + 1], m_run[gp + 1], l_run[gp + 1], O[gp + 1], quad);
        }
    }
#pragma unroll
    for (int g = 0; g < 4; ++g) {
        const size_t tq = (size_t)b * 2048 + r * 64 + 16 * g + l15;
        float l = l_run[g];
        l += __shfl_xor(l, 16); l += __shfl_xor(l, 32);
        const float inv = __builtin_amdgcn_rcpf(l);
#pragma unroll
        for (int dt = 0; dt < 4; ++dt) {
            h16x4 o;
#pragma unroll
            for (int j = 0; j < 4; ++j) o[j] = (h16)(O[g][dt][j] * inv);
            *(h16x4*)(YA + tq * 1024 + h * 64 + dt * 16 + quad * 4) = o;
        }
    }
}

__device__ void sgu_unit(const Params& p, int n, LAS unsigned char* lds) {
    unsigned char* ws = p.ws;
    const int tid = fresh_tid(), lane = tid & 63, g = tid >> 6, l15 = lane & 15, quad = lane >> 4;
    const h16* GUV = (const h16*)(ws + OFF_GUV);
    const h16* WS16 = (const h16*)(ws + OFF_WS16);
    h16* YB = (h16*)(ws + OFF_R1) + 512;
    LAS float* stat = (LAS float*)(lds + 8 * 17408);
    LAS h16* vt = (LAS h16*)(lds + g * 17408);
    const size_t t0 = (size_t)n * 128;
    __syncthreads();
    for (int i = 0; i < 16; i += 4) {
        h16x8 x[4]; float s[4], v[4];
#pragma unroll
        for (int q = 0; q < 4; ++q) {
            x[q] = *(const h16x8*)(GUV + (t0 + g * 16 + i + q) * 1024 + 512 + lane * 8);
            s[q] = 0.f;
#pragma unroll
            for (int j = 0; j < 8; ++j) s[q] += (float)x[q][j];
        }
#pragma unroll
        for (int o = 32; o > 0; o >>= 1) { float t[4];
#pragma unroll
            for (int q = 0; q < 4; ++q) t[q] = __shfl_xor(s[q], o);
#pragma unroll
            for (int q = 0; q < 4; ++q) s[q] += t[q]; }
#pragma unroll
        for (int q = 0; q < 4; ++q) {
            s[q] *= (1.0f / 512.0f); v[q] = 0.f;
#pragma unroll
            for (int j = 0; j < 8; ++j) { const float d = (float)x[q][j] - s[q]; v[q] += d * d; }
        }
#pragma unroll
        for (int o = 32; o > 0; o >>= 1) { float t[4];
#pragma unroll
            for (int q = 0; q < 4; ++q) t[q] = __shfl_xor(v[q], o);
#pragma unroll
            for (int q = 0; q < 4; ++q) v[q] += t[q]; }
        if (lane == 0) {
#pragma unroll
            for (int q = 0; q < 4; ++q) { stat[(g * 16 + i + q) * 2] = s[q]; stat[(g * 16 + i + q) * 2 + 1] = rsqrtf(v[q] * (1.0f / 512.0f) + 1e-6f); }
        }
    }
    __syncthreads();
    {
        const int ch0 = (lane & 7) * 8;
        float lg[8];
#pragma unroll
        for (int j = 0; j < 8; ++j) lg[j] = p.in[I_LNG][g * 64 + ch0 + j];
#pragma unroll 8
        for (int it = 0; it < 16; ++it) {
            const int q = it * 8 + (lane >> 3);
            const h16x8 x = *(const h16x8*)(GUV + (t0 + q) * 1024 + 512 + g * 64 + ch0);
            const float mean = stat[q * 2], rstd = stat[q * 2 + 1];
#pragma unroll
            for (int j = 0; j < 8; ++j) vt[(ch0 + j) * 136 + q] = (h16)(((float)x[j] - mean) * rstd * lg[j]);
        }
    }
    asm volatile("s_waitcnt lgkmcnt(0)" ::: "memory");
    __syncthreads();
    h16x8 af[4][4];
#pragma unroll
    for (int dt = 0; dt < 4; ++dt)
#pragma unroll
        for (int ks = 0; ks < 4; ++ks) af[dt][ks] = *(const LAS h16x8*)(vt + (dt * 16 + l15) * 136 + ks * 32 + quad * 8);
    const h16* wg = WS16 + (size_t)g * 128 * 128;
#pragma unroll 2
    for (int pt = 0; pt < 8; ++pt) {
        f32x4 acc[4];
#pragma unroll
        for (int dt = 0; dt < 4; ++dt) acc[dt] = (f32x4){0.f, 0.f, 0.f, 0.f};
#pragma unroll
        for (int ks = 0; ks < 4; ++ks) {
            const h16x8 bf = *(const h16x8*)(wg + (size_t)(pt * 16 + l15) * 128 + ks * 32 + quad * 8);
#pragma unroll
            for (int dt = 0; dt < 4; ++dt) acc[dt] = __builtin_amdgcn_mfma_f32_16x16x32_f16(af[dt][ks], bf, acc[dt], 0, 0, 0);
        }
        const int pp = pt * 16 + l15;
        const float bsv = p.in[I_GMBS][g * 128 + pp];
        const size_t tok = t0 + pp;
#pragma unroll
        for (int dt = 0; dt < 4; ++dt) {
            const int ch = g * 64 + dt * 16 + quad * 4;
            const h16x4 uu = *(const h16x4*)(GUV + tok * 1024 + ch);
            h16x4 o;
#pragma unroll
            for (int j = 0; j < 4; ++j) o[j] = (h16)((float)uu[j] * (acc[dt][j] + bsv));
            *(h16x4*)(YB + tok * 1024 + ch) = o;
        }
    }
    __syncthreads();
}

__device__ __forceinline__ float row16_sum_to_lane15(float v) {
    v += __builtin_bit_cast(float, __builtin_amdgcn_update_dpp(0, __builtin_bit_cast(int, v), 0x118, 0xf, 0xf, true));
    v += __builtin_bit_cast(float, __builtin_amdgcn_update_dpp(0, __builtin_bit_cast(int, v), 0x114, 0xf, 0xf, true));
    v += __builtin_bit_cast(float, __builtin_amdgcn_update_dpp(0, __builtin_bit_cast(int, v), 0x112, 0xf, 0xf, true));
    v += __builtin_bit_cast(float, __builtin_amdgcn_update_dpp(0, __builtin_bit_cast(int, v), 0x111, 0xf, 0xf, true));
    return v;
}
#define DPPF(v, ctrl) __builtin_bit_cast(float, __builtin_amdgcn_update_dpp(__builtin_bit_cast(int, v), __builtin_bit_cast(int, v), ctrl, 0xf, 0xf, false))
__device__ __forceinline__ float row16_allsum(float v) { v += DPPF(v, 0x128); v += DPPF(v, 0x124); v += DPPF(v, 0x122); v += DPPF(v, 0x121); return v; }
__device__ __forceinline__ float row16_allmax(float v) { v = fmaxf(v, DPPF(v, 0x128)); v = fmaxf(v, DPPF(v, 0x124)); v = fmaxf(v, DPPF(v, 0x122)); v = fmaxf(v, DPPF(v, 0x121)); return v; }
__device__ __forceinline__ int wave_incl_scan(int v) {
    v += __builtin_amdgcn_update_dpp(0, v, 0x111, 0xf, 0xf, false);
    v += __builtin_amdgcn_update_dpp(0, v, 0x112, 0xf, 0xf, false);
    v += __builtin_amdgcn_update_dpp(0, v, 0x114, 0xf, 0xf, false);
    v += __builtin_amdgcn_update_dpp(0, v, 0x118, 0xf, 0xf, false);
    v += __builtin_amdgcn_update_dpp(0, v, 0x142, 0xa, 0xf, false);
    v += __builtin_amdgcn_update_dpp(0, v, 0x143, 0xc, 0xf, false);
    return v;
}
__device__ __forceinline__ unsigned wave_or(unsigned x) {
    int v = (int)x;
    v |= __builtin_amdgcn_update_dpp(0, v, 0x111, 0xf, 0xf, false);
    v |= __builtin_amdgcn_update_dpp(0, v, 0x112, 0xf, 0xf, false);
    v |= __builtin_amdgcn_update_dpp(0, v, 0x114, 0xf, 0xf, false);
    v |= __builtin_amdgcn_update_dpp(0, v, 0x118, 0xf, 0xf, false);
    v |= __builtin_amdgcn_update_dpp(0, v, 0x142, 0xa, 0xf, false);
    v |= __builtin_amdgcn_update_dpp(0, v, 0x143, 0xc, 0xf, false);
    return (unsigned)__builtin_amdgcn_readlane(v, 63);
}
__device__ __forceinline__ unsigned wave_and(unsigned x) {
    int v = (int)x;
    v &= __builtin_amdgcn_update_dpp(-1, v, 0x111, 0xf, 0xf, false);
    v &= __builtin_amdgcn_update_dpp(-1, v, 0x112, 0xf, 0xf, false);
    v &= __builtin_amdgcn_update_dpp(-1, v, 0x114, 0xf, 0xf, false);
    v &= __builtin_amdgcn_update_dpp(-1, v, 0x118, 0xf, 0xf, false);
    v &= __builtin_amdgcn_update_dpp(-1, v, 0x142, 0xa, 0xf, false);
    v &= __builtin_amdgcn_update_dpp(-1, v, 0x143, 0xc, 0xf, false);
    return (unsigned)__builtin_amdgcn_readlane(v, 63);
}
__device__ __forceinline__ unsigned key16(unsigned short u) { return (u & 0x8000u) ? ((~(unsigned)u) & 0xFFFFu) : ((unsigned)u | 0x8000u); }
__device__ __forceinline__ unsigned key32(unsigned u) { return (u & 0x80000000u) ? ~u : (u | 0x80000000u); }
__device__ __forceinline__ float dot8(h16x8 a, h16x8 b, float c) {
    c = __builtin_amdgcn_fdot2((h16x2){a[0], a[1]}, (h16x2){b[0], b[1]}, c, false);
    c = __builtin_amdgcn_fdot2((h16x2){a[2], a[3]}, (h16x2){b[2], b[3]}, c, false);
    c = __builtin_amdgcn_fdot2((h16x2){a[4], a[5]}, (h16x2){b[4], b[5]}, c, false);
    c = __builtin_amdgcn_fdot2((h16x2){a[6], a[7]}, (h16x2){b[6], b[7]}, c, false);
    return c;
}
#define LDS_FENCE() asm volatile("s_waitcnt lgkmcnt(0)" ::: "memory")

__device__ void peer_phase(const Params& p, LAS unsigned char* lds, unsigned* bar, unsigned& epoch) {
    unsigned char* ws = p.ws;
    const int tid = fresh_tid(), wid = __builtin_amdgcn_readfirstlane(tid >> 6), lane = tid & 63;
    const unsigned long long lm = (1ull << lane) - 1ull;
    LAS unsigned char* wl = lds + wid * 11264;
    LAS float* s_top = (LAS float*)(wl);
    LAS int* i_top = (LAS int*)(wl + 1024);
    LAS int* ex = (LAS int*)(wl + 2048);
    LAS float* sc = (LAS float*)(wl + 2560);
    LAS int* uns_m = (LAS int*)(wl + 3072);
    LAS float* uns_g = (LAS float*)(wl + 3584);
    LAS int* cnt = (LAS int*)(wl + 4096);
    LAS int* base = (LAS int*)(wl + 4352);
    const int lead = (wid >= 4) ? 1 : 0;
    const unsigned short* SC = (const unsigned short*)(ws + OFF_SC16);
    const h16* H2 = (const h16*)(ws + OFF_R1);
    const unsigned char* U4 = ws + OFF_U8;
    const unsigned char* V8 = ws + OFF_V8;
    const float* USC = (const float*)(ws + OFF_USC);
    const float* VSC = (const float*)(ws + OFF_VSC);
    const float* mod = (const float*)(ws + OFF_MOD);
    const int grp = lane >> 4, li = lane & 15;
    for (int tg = blockIdx.x; tg < 256; tg += gridDim.x) {
        for (int it5 = 0; it5 < 5; ++it5) {
          if (it5 < 4) {
            const int round = it5;
            const size_t tok0 = (size_t)tg * 128 + wid * 16 + round * 4;
            LAS unsigned short* se = (LAS unsigned short*)(wl + 4608 + (round & 1) * 3072);
            LAS float* sw = (LAS float*)(wl + 4608 + (round & 1) * 3072 + 1024);
            for (int tt = 0; tt < 4; ++tt) {
                const size_t tok = tok0 + tt;
                cnt[lane] = 0;
                for (int L0 = 0; L0 < 16; L0 += 4) {
                    unsigned short ra[4], rb[4]; unsigned ka[4], kb[4], T[4];
#pragma unroll
                    for (int q = 0; q < 4; ++q) {
                        const unsigned short* sr = SC + tok * 2048 + (L0 + q) * 128;
                        ra[q] = sr[lane]; rb[q] = sr[64 + lane];
                        ka[q] = key16(ra[q]); kb[q] = key16(rb[q]); T[q] = 0;
                    }
                    for (int bit = 15; bit >= 0; --bit) {
#pragma unroll
                        for (int q = 0; q < 4; ++q) {
                            const unsigned cand = T[q] | (1u << bit);
                            const int cn = __popcll(__ballot(ka[q] >= cand)) + __popcll(__ballot(kb[q] >= cand));
                            T[q] = (cn >= 16) ? cand : T[q];
                        }
                    }
#pragma unroll
                    for (int q = 0; q < 4; ++q) {
                        const int L = L0 + q;
                        const int cnt_gt = __popcll(__ballot(ka[q] > T[q])) + __popcll(__ballot(kb[q] > T[q]));
                        const int need = 16 - cnt_gt;
                        const unsigned long long ea = __ballot(ka[q] == T[q]), eb = __ballot(kb[q] == T[q]);
                        const int ra_eq = __popcll(ea & lm), rb_eq = __popcll(ea) + __popcll(eb & lm);
                        const bool sa = (ka[q] > T[q]) || (ka[q] == T[q] && ra_eq < need);
                        const bool sb = (kb[q] > T[q]) || (kb[q] == T[q] && rb_eq < need);
                        const unsigned long long ma = __ballot(sa), mb = __ballot(sb);
                        const int pa = __popcll(ma & lm), pb = __popcll(ma) + __popcll(mb & lm);
                        if (sa) { s_top[L * 16 + pa] = (float)__builtin_bit_cast(h16, ra[q]); i_top[L * 16 + pa] = lane; }
                        if (sb) { s_top[L * 16 + pb] = (float)__builtin_bit_cast(h16, rb[q]); i_top[L * 16 + pb] = 64 + lane; }
                    }
                }
                LDS_FENCE();
                for (int h0 = 0; h0 < 8; h0 += 4) {
                    float cv[4][4]; unsigned kk[4][4], T[4];
#pragma unroll
                    for (int q = 0; q < 4; ++q) {
                        const int h = h0 + q;
                        const float bj = s_top[(2 * h + 1) * 16 + li];
#pragma unroll
                        for (int m = 0; m < 4; ++m) { cv[q][m] = s_top[(2 * h) * 16 + grp + 4 * m] + bj; kk[q][m] = key32(__builtin_bit_cast(unsigned, cv[q][m])); }
                        T[q] = 0;
                    }
                    unsigned om = 0, am = 0xFFFFFFFFu;
#pragma unroll
                    for (int q = 0; q < 4; ++q)
#pragma unroll
                        for (int m = 0; m < 4; ++m) { om |= kk[q][m]; am &= kk[q][m]; }
                    om = wave_or(om); am = wave_and(am);
                    om &= ~am;
                    while (om) {
                        const int bit = 31 - __builtin_clz(om);
                        om &= ~(1u << bit);
#pragma unroll
                        for (int q = 0; q < 4; ++q) {
                            const unsigned cand = T[q] | (1u << bit);
                            int cn = 0;
#pragma unroll
                            for (int m = 0; m < 4; ++m) cn += __popcll(__ballot((kk[q][m] & ~am) >= cand));
                            T[q] = (cn >= 16) ? cand : T[q];
                        }
                    }
#pragma unroll
                    for (int q = 0; q < 4; ++q) T[q] |= am;
#pragma unroll
                    for (int q = 0; q < 4; ++q) {
                        const int h = h0 + q;
                        int cnt_gt = 0;
#pragma unroll
                        for (int m = 0; m < 4; ++m) cnt_gt += __popcll(__ballot(kk[q][m] > T[q]));
                        const int need = 16 - cnt_gt;
                        int eq_before = 0, sel_before = 0;
#pragma unroll
                        for (int m = 0; m < 4; ++m) {
                            const unsigned long long em = __ballot(kk[q][m] == T[q]);
                            const int myeq = eq_before + __popcll(em & lm);
                            const bool sel = (kk[q][m] > T[q]) || (kk[q][m] == T[q] && myeq < need);
                            const unsigned long long sm = __ballot(sel);
                            const int pos = sel_before + __popcll(sm & lm);
                            if (sel) {
                                ex[h * 16 + pos] = i_top[(2 * h) * 16 + grp + 4 * m] * 128 + i_top[(2 * h + 1) * 16 + li];
                                sc[h * 16 + pos] = cv[q][m];
                            }
                            eq_before += __popcll(em); sel_before += __popcll(sm);
                        }
                    }
                }
                LDS_FENCE();
#pragma unroll
                for (int half = 0; half < 2; ++half) {
                    const int e = half * 64 + lane;
                    const float v = sc[e];
                    const float mx = row16_allmax(v);
                    const float pe = __expf(v - mx);
                    const float sm = row16_allsum(pe);
                    const float gate = pe * __builtin_amdgcn_rcpf(sm);
                    const int eid = ex[e];
                    const int pos = __hip_atomic_fetch_add(cnt + (eid >> 8), 1, __ATOMIC_RELAXED, __HIP_MEMORY_SCOPE_WORKGROUP);
                    uns_m[e] = eid | (pos << 14); uns_g[e] = gate;
                }
                LDS_FENCE();
                {
                    const int c = cnt[lane];
                    const int incl = wave_incl_scan(c);
                    base[lane] = incl - c;
                    LDS_FENCE();
#pragma unroll
                    for (int i = 0; i < 2; ++i) {
                        const int rm = uns_m[i * 64 + lane]; const float rg = uns_g[i * 64 + lane];
                        const int eid = rm & 16383, pos = rm >> 14;
                        const int dst = tt * 128 + base[eid >> 8] + pos;
                        se[dst] = (unsigned short)eid; sw[dst] = rg;
                    }
                    LDS_FENCE();
                }
            }
          }
          const int round = it5 - lead;
          if (round >= 0 && round < 4) {
            const size_t tok0 = (size_t)tg * 128 + wid * 16 + round * 4;
            LAS unsigned short* se = (LAS unsigned short*)(wl + 4608 + (round & 1) * 3072);
            LAS float* sw = (LAS float*)(wl + 4608 + (round & 1) * 3072 + 1024);
            const size_t tokg = tok0 + grp;
            const LAS unsigned short* me = se + grp * 128; LAS float* mw = sw + grp * 128;
            {
                const int li = launder(tid) & 15;
                h16x8 xr[2][4];
#pragma unroll
                for (int c = 0; c < 2; ++c)
#pragma unroll
                    for (int j = 0; j < 4; ++j) xr[c][j] = *(const h16x8*)(H2 + tokg * 1024 + c * 512 + li * 32 + 8 * j);
                float acc[64];
#pragma unroll
                for (int i = 0; i < 64; ++i) acc[i] = 0.f;
                i32x4 ru[2][2], rv[2][4]; float su[2], sv[2];
#define ELD(J, S_) do { const int e_ = me[(S_)]; const unsigned char* rp_ = U4 + (size_t)e_ * 1536 + li * 16; \
        ru[J][0] = *(const i32x4*)rp_; ru[J][1] = *(const i32x4*)(rp_ + 256); \
        _Pragma("unroll") for (int c = 0; c < 4; ++c) rv[J][c] = *(const i32x4*)(rp_ + 512 + c * 256); \
        { const f32x2 s2_ = *(const f32x2*)(USC + 2 * e_); su[J] = s2_.x; sv[J] = s2_.y; } } while (0)
#define ECP(J, S_) do { float d = 0.f; \
        _Pragma("unroll") for (int c = 0; c < 2; ++c) _Pragma("unroll") for (int k = 0; k < 4; ++k) { const h16x8 xv = xr[c][k]; const int w_ = ru[J][c][k]; \
            d = __builtin_amdgcn_fdot2(__builtin_amdgcn_cvt_scalef32_pk_f16_fp4(w_, 1.0f, 0), (h16x2){xv[0], xv[1]}, d, false); \
            d = __builtin_amdgcn_fdot2(__builtin_amdgcn_cvt_scalef32_pk_f16_fp4(w_, 1.0f, 1), (h16x2){xv[2], xv[3]}, d, false); \
            d = __builtin_amdgcn_fdot2(__builtin_amdgcn_cvt_scalef32_pk_f16_fp4(w_, 1.0f, 2), (h16x2){xv[4], xv[5]}, d, false); \
            d = __builtin_amdgcn_fdot2(__builtin_amdgcn_cvt_scalef32_pk_f16_fp4(w_, 1.0f, 3), (h16x2){xv[6], xv[7]}, d, false); } \
        d = row16_allsum(d); \
        const float wt_ = mw[(S_)] * gelu_tanh(d * su[J]) * sv[J]; \
        _Pragma("unroll") for (int c = 0; c < 4; ++c) _Pragma("unroll") for (int k = 0; k < 4; ++k) { \
            const f32x2 lo = __builtin_amdgcn_cvt_pk_f32_fp8(rv[J][c][k], false), hi = __builtin_amdgcn_cvt_pk_f32_fp8(rv[J][c][k], true); \
            acc[c * 16 + 4 * k] += wt_ * lo.x; acc[c * 16 + 4 * k + 1] += wt_ * lo.y; acc[c * 16 + 4 * k + 2] += wt_ * hi.x; acc[c * 16 + 4 * k + 3] += wt_ * hi.y; } } while (0)
                ELD(0, 0); ELD(1, 1);
#pragma unroll 1
                for (int s = 0; s < 128; s += 2) {
                    ECP(0, s);     if (s + 2 < 128) ELD(0, s + 2);
                    ECP(1, s + 1); if (s + 3 < 128) ELD(1, s + 3);
                }
#undef ELD
#undef ECP
                float* xo = p.out + tokg * 1024 + li * 16;
                const h16* x1h = (const h16*)(ws + OFF_X1H) + tokg * 1024 + li * 16;
                const int b = (int)(tokg >> 11);
                const float* g2 = mod + (size_t)b * 6144 + 5 * 1024 + li * 16;
                const float* fg = p.in[I_FG] + li * 16;
                float ss = 0.f;
#pragma unroll
                for (int c = 0; c < 4; ++c) {
#pragma unroll
                    for (int q4 = 0; q4 < 4; ++q4) {
                        const h16x4 xh_ = *(const h16x4*)(x1h + c * 256 + q4 * 4);
                        const f32x4 xv = (f32x4){(float)xh_[0], (float)xh_[1], (float)xh_[2], (float)xh_[3]}, gv = *(const f32x4*)(g2 + c * 256 + q4 * 4);
#pragma unroll
                        for (int j = 0; j < 4; ++j) { const float t = xv[j] + gv[j] * acc[c * 16 + q4 * 4 + j]; acc[c * 16 + q4 * 4 + j] = t; ss += t * t; }
                    }
                    asm volatile("" : "+v"(ss) :: "memory");
                }
                ss = row16_allsum(ss);
                const float r = rsqrtf(ss * (1.0f / 1024.0f) + 1e-6f);
#pragma unroll
                for (int c = 0; c < 4; ++c) {
#pragma unroll
                    for (int q4 = 0; q4 < 4; ++q4) {
                        const f32x4 fv = *(const f32x4*)(fg + c * 256 + q4 * 4);
                        f32x4 ov;
#pragma unroll
                        for (int j = 0; j < 4; ++j) ov[j] = acc[c * 16 + q4 * 4 + j] * r * fv[j];
                        *(f32x4*)(xo + c * 256 + q4 * 4) = ov;
                    }
                    asm volatile("" ::: "memory");
                }
            }
            LDS_FENCE();
          }
        }
    }
}

__global__ void __launch_bounds__(512, 2) mega(Params p) {
    extern __shared__ __attribute__((aligned(16))) unsigned char shm[];
    LAS unsigned char* lds = (LAS unsigned char*)shm;
    cg::grid_group grid = cg::this_grid();
    unsigned char* ws = p.ws;
    const int G = (int)gridDim.x, c = (int)blockIdx.x;
    unsigned* bar = (unsigned*)(ws + OFF_BAR); unsigned epoch = 0;
    volatile LAS unsigned* xst = (volatile LAS unsigned*)(lds + (LDS_BYTES - 16));
    if (threadIdx.x < 2) xst[threadIdx.x] = 0u;
    __syncthreads();
    const XcdBarrier xb = xcd_barrier_post(bar, xst);

    if (p.ws == nullptr) grid.sync();
    phase0(p, (float*)shm);
    xcd_barrier(xb);
    phase1(p, (float*)shm);
    xcd_barrier(xb);
    {
        pg8::StaticOrder S; S.init(NTOK, INC, G, c);
        pg8::Gemm g{ws + OFF_R1, ws + OFF_WINT, 1024, 1024, NTOK, INC, 1024, 0};
        EpiIn E{(h16*)(ws + OFF_QB), (h16*)(ws + OFF_KB), (h16*)(ws + OFF_VT), (h16*)(ws + OFF_GUV), (h16*)(ws + OFF_GATES)};
        pg8::gemm_phase(lds, g, S, E);
        pg8::StaticOrder S2; S2.init(NCTXT, 1024, G, c);
        pg8::Gemm g2{ws + OFF_HC, ws + OFF_WINT + (size_t)512 * 1024 * 2, 1024, 1024, NCTXT, 1024, 1024, 0};
        EpiCtx E2{(h16*)(ws + OFF_KC), (h16*)(ws + OFF_VCT)};
        pg8::gemm_phase(lds, g2, S2, E2);
    }
    xcd_barrier(xb);
    {
        for (int rep3 = 0; rep3 < REP_P3; ++rep3) {
        for (int u = c; u < 512; u += G) attn_unit(p, u);
        for (int n = c; n < 256; n += G) sgu_unit(p, n, lds);
        }
    }
    xcd_barrier(xb);
    {
        pg8::StaticOrder S; S.init(NTOK, 1024, G, c);
        pg8::Gemm ga{ws + OFF_R1, ws + OFF_WPAT, 1024, 512, NTOK, 1024, 512, 0};
        EpiM1 E1{(h16*)(ws + OFF_M1), (const h16*)(ws + OFF_GATES)};
        pg8::gemm_phase(lds, ga, S, E1);
        pg8::Gemm gb{ws + OFF_R1 + 1024, ws + OFF_WPBT, 1024, 512, NTOK, 1024, 512, 0};
        EpiM2 E2{(const h16*)(ws + OFF_M1), (const h16*)(ws + OFF_GATES), (h16*)(ws + OFF_MM)};
        pg8::gemm_phase(lds, gb, S, E2);
    }
    xcd_barrier(xb);
    {
        pg8::StaticOrder S; S.init(NTOK, 1024, G, c);
        pg8::Gemm g{ws + OFF_MM, ws + OFF_WOUTT, 1024, 1024, NTOK, 1024, 1024, 0};
        EpiX1 E{p.in[I_X], (const float*)(ws + OFF_MOD), (h16*)(ws + OFF_X1H)};
        pg8::gemm_phase(lds, g, S, E);
    }
    xcd_barrier(xb);
    phase6(p, (float*)shm);
    xcd_barrier(xb);
    {
        pg8::StaticOrder S; S.init(NTOK, 2048, G, c);
        pg8::Gemm g{ws + OFF_R1, ws + OFF_WQT, 1024, 1024, NTOK, 2048, 1024, 0};
        EpiH16 E{(h16*)(ws + OFF_SC16), 2048};
        pg8::gemm_phase(lds, g, S, E);
    }
    xcd_barrier(xb);
    peer_phase(p, lds, bar, epoch);
}

extern "C" void kernel_launch(void* const* d_in, const int* in_sizes, int n_in, void* d_out, int out_size, void* d_ws, size_t ws_size, hipStream_t stream) {
    static int grid_blocks = 0;
    if (!grid_blocks) {
        int dev = 0, cus = 0, per_cu = 0;
        hipGetDevice(&dev);
        hipDeviceGetAttribute(&cus, hipDeviceAttributeMultiprocessorCount, dev);
        hipFuncSetAttribute((const void*)mega, hipFuncAttributeMaxDynamicSharedMemorySize, LDS_BYTES);
        hipOccupancyMaxActiveBlocksPerMultiprocessor(&per_cu, (const void*)mega, 512, LDS_BYTES);
        if (per_cu < 1) per_cu = 1;
        grid_blocks = cus * per_cu;
        if (ws_size < WS_END) fprintf(stderr, "kernel_launch: workspace too small: %zu < %zu\n", ws_size, (size_t)WS_END);
    }
    hipMemsetAsync((unsigned char*)d_ws + OFF_BAR, 0, 16384, stream);
    Params p{};
    for (int i = 0; i < 21; ++i) p.in[i] = (const float*)d_in[i];
    p.out = (float*)d_out; p.ws = (unsigned char*)d_ws;
    void* args[] = {&p};
    hipError_t e = hipLaunchCooperativeKernel((const void*)mega, dim3(grid_blocks), dim3(512), args, LDS_BYTES, stream);
    if (e != hipSuccess) fprintf(stderr, "cooperative launch failed: %s (grid %d)\n", hipGetErrorString(e), grid_blocks);
}
```

```cpp
#include <hip/hip_runtime.h>
#include <hip/hip_cooperative_groups.h>
#include <cstdio>
namespace cg = cooperative_groups;

#define LAS __attribute__((address_space(3)))
typedef _Float16 h16;
typedef _Float16 h16x2 __attribute__((ext_vector_type(2)));
typedef _Float16 h16x4 __attribute__((ext_vector_type(4)));
typedef _Float16 h16x8 __attribute__((ext_vector_type(8)));
typedef float f32x4 __attribute__((ext_vector_type(4)));
typedef float f32x2 __attribute__((ext_vector_type(2)));
typedef int i32x4 __attribute__((ext_vector_type(4)));
typedef int i32x2 __attribute__((ext_vector_type(2)));

constexpr int NTOK = 32768, DM = 1024, NCTXT = 4096, INC = 4608, SEQ = 2048, CTXL = 256;
constexpr int LDS_BYTES = 144 * 1024;
#ifndef REP_SEL
#define REP_SEL 1
#endif
#ifndef REP_GATH
#define REP_GATH 1
#endif
#ifndef REP_P3
#define REP_P3 1
#endif

constexpr size_t al256(size_t x) { return (x + 255) & ~(size_t)255; }
constexpr size_t OFF_WINT = 0;
constexpr size_t OFF_WPAT = OFF_WINT + (size_t)INC * DM * 2;
constexpr size_t OFF_WPBT = OFF_WPAT + (size_t)1024 * 512 * 2;
constexpr size_t OFF_WOUTT = OFF_WPBT + (size_t)1024 * 512 * 2;
constexpr size_t OFF_WQT = OFF_WOUTT + (size_t)1024 * 1024 * 2;
constexpr size_t OFF_BD = OFF_WQT + (size_t)2048 * 1024 * 2;
constexpr size_t OFF_U16 = OFF_BD + (size_t)2048 * 256 * 2;
constexpr size_t OFF_V16 = OFF_U16 + (size_t)16384 * 1024 * 2;
constexpr size_t OFF_WS16 = OFF_V16 + (size_t)16384 * 1024 * 2;
constexpr size_t OFF_MODP = OFF_WS16 + (size_t)8 * 128 * 128 * 2;
constexpr size_t OFF_MOD = OFF_MODP + (size_t)16 * 17 * 6144 * 4;
constexpr size_t OFF_R1 = al256(OFF_MOD + (size_t)17 * 6144 * 4);
constexpr size_t OFF_QB = OFF_R1 + (size_t)NTOK * DM * 2;
constexpr size_t OFF_KB = OFF_QB + (size_t)NTOK * 512 * 2;
constexpr size_t OFF_VT = OFF_KB + (size_t)NTOK * 512 * 2;
constexpr size_t OFF_GUV = OFF_VT + (size_t)NTOK * 512 * 2;
constexpr size_t OFF_GATES = OFF_GUV + (size_t)NTOK * 1024 * 2;
constexpr size_t OFF_MM = OFF_GATES + (size_t)NTOK * 2048 * 2;
constexpr size_t OFF_BAR = OFF_MM + (size_t)NTOK * DM * 2;
constexpr size_t WS_END = OFF_BAR + 16384;
constexpr size_t OFF_U8 = OFF_U16;
constexpr size_t OFF_USC = OFF_V16;
constexpr size_t OFF_V8 = OFF_V16;
constexpr size_t OFF_VSC = OFF_V16 + (size_t)16384 * 1024;
constexpr size_t OFF_M1 = OFF_QB;
constexpr size_t OFF_SC16 = OFF_QB;
constexpr size_t OFF_Q16 = OFF_GATES;
constexpr size_t OFF_X1H = OFF_GATES;
constexpr size_t OFF_HC = OFF_MM;
constexpr size_t OFF_KC = OFF_HC + (size_t)NCTXT * DM * 2;
constexpr size_t OFF_VCT = OFF_KC + (size_t)NCTXT * 512 * 2;
static_assert(OFF_M1 + (size_t)NTOK * DM * 4 <= OFF_GATES, "m1 alias");
static_assert(WS_END <= (size_t)512 * 1024 * 1024, "workspace");

struct Params {
    const float* in[21];
    float* out;
    unsigned char* ws;
};
enum { I_X = 0, I_C, I_CTX, I_CCTX, I_ADAW, I_ADAB, I_N1G, I_N2G, I_WIN, I_RPB, I_LNG, I_GMWS, I_GMBS, I_WPA, I_WPB, I_WOUT, I_WQ, I_KEYS, I_PU, I_PV, I_FG };

__device__ __forceinline__ int launder(int x) { asm volatile("" : "+v"(x)); return x; }
__device__ __forceinline__ int fresh_tid() { int t = threadIdx.x; asm volatile("" : "+v"(t)); return t; }

__device__ __forceinline__ float sigmoidf_(float x) { return __builtin_amdgcn_rcpf(1.0f + __expf(-x)); }
__device__ __forceinline__ float gelu_tanh(float x) {
    const float t = 0.7978845608028654f * (x + 0.044715f * x * x * x);
    return x * __builtin_amdgcn_rcpf(1.0f + __expf(-2.0f * t));
}
__device__ __forceinline__ float silu_(float x) { return x * __builtin_amdgcn_rcpf(1.0f + __expf(-x)); }
__device__ __forceinline__ float wave_sum(float v) {
#pragma unroll
    for (int o = 32; o > 0; o >>= 1) v += __shfl_xor(v, o);
    return v;
}
__device__ __forceinline__ h16x8 pack8(f32x4 a, f32x4 b) {
    h16x8 o;
    o[0] = (h16)a[0]; o[1] = (h16)a[1]; o[2] = (h16)a[2]; o[3] = (h16)a[3];
    o[4] = (h16)b[0]; o[5] = (h16)b[1]; o[6] = (h16)b[2]; o[7] = (h16)b[3];
    return o;
}


__device__ __forceinline__ void grid_bar(unsigned* ctr, unsigned& epoch, unsigned nblk) {
    __syncthreads();
    epoch += 1u;
    if (threadIdx.x == 0) {
        __builtin_amdgcn_fence(__ATOMIC_RELEASE, "agent");
        asm volatile("s_waitcnt vmcnt(0)" ::: "memory");
        __hip_atomic_fetch_add(ctr, 1u, __ATOMIC_RELAXED, __HIP_MEMORY_SCOPE_AGENT);
        const unsigned target = epoch * nblk;
        unsigned spins = 0;
        while (__hip_atomic_load(ctr, __ATOMIC_RELAXED, __HIP_MEMORY_SCOPE_AGENT) < target) { __builtin_amdgcn_s_sleep(2); if (++spins > (1u << 24)) break; }
        __builtin_amdgcn_fence(__ATOMIC_ACQUIRE, "agent");
        asm volatile("s_waitcnt vmcnt(0)" ::: "memory");
    }
    __syncthreads();
}


#define XB_TMO      128
#define XB_XCNT(j)  (256  + 64 * (j))
#define XB_XSUB(j)  (1280 + 64 * (j))
#define XB_XGEN(j)  (2304 + 64 * (j))
#define XB_TOP      3328
#define XB_TOPGEN   3392
#define XCD_BAR_WORDS 3456
#define XB_SPIN_CAP (1u << 20)
__device__ __forceinline__ unsigned xb_ld(unsigned* p)              { return __hip_atomic_load(p, __ATOMIC_RELAXED, __HIP_MEMORY_SCOPE_AGENT); }
__device__ __forceinline__ unsigned xb_add(unsigned* p, unsigned v) { return __hip_atomic_fetch_add(p, v, __ATOMIC_RELAXED, __HIP_MEMORY_SCOPE_AGENT); }
__device__ __forceinline__ unsigned xb_xcc_id() { return (unsigned)__builtin_amdgcn_s_getreg((3 << 11) | 20) & 0xFu; }
#define XB_SPIN(cond, bar) do { unsigned _sp = 0; while (cond) { __builtin_amdgcn_s_sleep(1); \
    if ((++_sp & 255u) == 0u) { if (xb_ld(&(bar)[XB_TMO])) break; if (_sp > XB_SPIN_CAP) { atomicAdd(&(bar)[XB_TMO], 1u); break; } } } } while (0)
struct XcdBarrier { unsigned* bar; unsigned x; volatile LAS unsigned* st; };
__device__ __forceinline__ XcdBarrier xcd_barrier_post(unsigned* bar, volatile LAS unsigned* st) {
    XcdBarrier b; b.bar = bar; b.x = xb_xcc_id(); b.st = st;
    if (threadIdx.x == 0) (void)xb_add(&bar[XB_XCNT(b.x)], 1u);
    return b;
}
__device__ __forceinline__ void xcd_barrier_complete(unsigned* bar, unsigned x, unsigned& nloc, unsigned& nx) {
    const unsigned G = gridDim.x * gridDim.y * gridDim.z;
    unsigned sum, cnt, mine, sp = 0u;
    for (;;) {
        sum = 0u; cnt = 0u; mine = 0u;
#pragma unroll
        for (unsigned j = 0; j < 16; ++j) { const unsigned c = xb_ld(&bar[XB_XCNT(j)]); sum += c; cnt += (c > 0u) ? 1u : 0u; mine = (j == x) ? c : mine; }
        if (sum == G) break;
        __builtin_amdgcn_s_sleep(1);
        if ((++sp & 255u) == 0u) { if (xb_ld(&bar[XB_TMO])) break; if (sp > XB_SPIN_CAP) { atomicAdd(&bar[XB_TMO], 1u); break; } }
    }
    nloc = mine > 0u ? mine : 1u; nx = cnt > 0u ? cnt : 1u;
}
__device__ __forceinline__ void xcd_barrier(const XcdBarrier& b) {
    asm volatile("s_waitcnt vmcnt(0)" ::: "memory");
    __syncthreads();
    if (threadIdx.x == 0) {
        unsigned* bar = b.bar;
        __builtin_amdgcn_s_waitcnt(0);
        unsigned nloc = b.st[0], nx = b.st[1];
        if (nloc == 0u) { xcd_barrier_complete(bar, b.x, nloc, nx); b.st[0] = nloc; b.st[1] = nx; }
        const unsigned old = xb_add(&bar[XB_XSUB(b.x)], 1u);
        const unsigned gen = old / nloc;
        if (old + 1u == (gen + 1u) * nloc) {
            __builtin_amdgcn_fence(__ATOMIC_RELEASE, "agent");
            asm volatile("s_waitcnt vmcnt(0)" ::: "memory");
            const unsigned og = xb_add(&bar[XB_TOP], 1u);
            const unsigned tg = og / nx;
            if (og + 1u == (tg + 1u) * nx) xb_add(&bar[XB_TOPGEN], 1u);
            else XB_SPIN(xb_ld(&bar[XB_TOPGEN]) == tg, bar);
            __builtin_amdgcn_fence(__ATOMIC_ACQUIRE, "agent");
            xb_add(&bar[XB_XGEN(b.x)], 1u);
            asm volatile("s_waitcnt vmcnt(0)" ::: "memory");
        } else {
            XB_SPIN(xb_ld(&bar[XB_XGEN(b.x)]) == gen, bar);
            __builtin_amdgcn_fence(__ATOMIC_ACQUIRE, "agent");
            asm volatile("s_waitcnt vmcnt(0)" ::: "memory");
        }
    }
    __syncthreads();
}

namespace pg8 {
constexpr int BM = 256, BK = 64, HALF = 128, HTB = HALF * BK * 2, STAGE_BYTES = 8 * HTB, NXCD = 8, WGM = 8;
__device__ __forceinline__ int lds_byte(int r, int c) { const int st = (r >> 4) * 2 + (c >> 5), rr = r & 15, cc = c & 31, ob = rr * 64 + cc * 2; return st * 1024 + (ob ^ (((ob >> 9) & 1) << 5)); }
__device__ __forceinline__ void stage_rc(int b, int& R, int& C) { const int st = b / 1024, sb = b % 1024, swz = sb ^ (((sb >> 9) & 1) << 5); R = (st >> 1) * 16 + swz / 64; C = (st & 1) * 32 + (swz % 64) / 2; }
__device__ __forceinline__ int perm32(int rho) { const int n = rho >> 4, i = rho & 15; return 8 * (i >> 2) + 4 * n + (i & 3); }

struct Unit { int pm, pn; };
struct Gemm { const void* A; const void* Bt; int lda, ldb, M, N, K, a_pn_bytes; };

struct StaticOrder {
    int nM, nN, nwg, G, c;
    __device__ void init(int M, int N, int G_, int c_) { nM = M / BM; nN = N / BM; nwg = nM * nN; G = G_; c = c_; }
    __device__ bool next(int i, Unit& u) const {
        const long L = (long)i * G + c; if (L >= nwg) return false;
        int wgid = (int)L; { const int q = nwg / NXCD, r = nwg % NXCD, xcd = wgid % NXCD, off = wgid / NXCD; wgid = (xcd < r ? xcd * (q + 1) : r * (q + 1) + (xcd - r) * q) + off; }
        const int nig = WGM * nN, gid = wgid / nig, fm = gid * WGM, gsz = (nM - fm) < WGM ? (nM - fm) : WGM;
        u.pm = fm + ((wgid % nig) % gsz); u.pn = (wgid % nig) / gsz; return true;
    }
};

template <class Epi>
__device__ __forceinline__ void gemm_phase(LAS unsigned char* lds, const Gemm g, const StaticOrder& S, const Epi& E) {
    const int tid = fresh_tid(), wid = __builtin_amdgcn_readfirstlane(tid >> 6), lane = tid & 63, wr = wid >> 2, wc = wid & 3, fr = lane & 15, fq = lane >> 4;
    const int K = g.K, nt = K / BK;
    unsigned voffA[2], voffB[2];
#pragma unroll
    for (int i = 0; i < 2; ++i) { int R, C; stage_rc(tid * 16 + i * 8192, R, C); const int Rb = (R & ~31) + perm32(R & 31);
        voffA[i] = (unsigned)(R * g.lda + C) * 2u; voffB[i] = (unsigned)(Rb * g.ldb + C) * 2u; }
    const size_t kstep = (size_t)(BK * 2);
    const size_t hstepA = (size_t)HALF * g.lda * 2, hstepB = (size_t)HALF * g.ldb * 2;
    const size_t tstepA = 2 * hstepA, tstepB = 2 * hstepB;
    const unsigned ldsw = (unsigned)wid * 1024u;
    const int aoff = lds_byte(wr * 64 + fr, fq * 8), boff = lds_byte(wc * 32 + fr, fq * 8);
#define PG8_SA(b, h) (((b) * 2 + (h)) * HTB)
#define PG8_SB(b, h) ((4 + (b) * 2 + (h)) * HTB)
#define PG8_STAGE(bufoff, gbase, voff) do { _Pragma("unroll") for (int _i = 0; _i < 2; ++_i) \
        __builtin_amdgcn_global_load_lds((const unsigned*)((const char*)(gbase) + (voff)[_i]), (LAS unsigned*)(lds + (bufoff) + ldsw + _i * 8192), 16, 0, 0); } while (0)
#define PG8_LDA(dst, b, h) do { _Pragma("unroll") for (int m = 0; m < 4; ++m) _Pragma("unroll") for (int k = 0; k < 2; ++k) dst[m][k] = *(const LAS h16x8*)(lds + PG8_SA(b, h) + aoff + m * 2048 + k * 1024); } while (0)
#define PG8_LDB(dst, b, h) do { _Pragma("unroll") for (int n = 0; n < 2; ++n) _Pragma("unroll") for (int k = 0; k < 2; ++k) dst[n][k] = *(const LAS h16x8*)(lds + PG8_SB(b, h) + boff + n * 2048 + k * 1024); } while (0)
#define PG8_MMA(ai, bj, At, Bt) do { __builtin_amdgcn_s_setprio(1); _Pragma("unroll") for (int m = 0; m < 4; ++m) _Pragma("unroll") for (int n = 0; n < 2; ++n) _Pragma("unroll") for (int k = 0; k < 2; ++k) \
        acc[ai][bj][m][n] = __builtin_amdgcn_mfma_f32_16x16x32_f16(Bt[n][k], At[m][k], acc[ai][bj][m][n], 0, 0, 0); __builtin_amdgcn_s_setprio(0); } while (0)
#define PG8_WAIT_V(n) asm volatile("s_waitcnt vmcnt(" #n ")" ::: "memory")
#define PG8_WAIT_L(n) asm volatile("s_waitcnt lgkmcnt(" #n ")" ::: "memory")
#define PG8_BAR __builtin_amdgcn_s_barrier()
#define PG8_SCHED __builtin_amdgcn_sched_barrier(0)
    Unit cur, nxt; int ui = 0;
    if (!S.next(0, cur)) return;
    f32x4 acc[2][2][4][2];
#pragma unroll
    for (int a = 0; a < 2; ++a)
#pragma unroll
        for (int b = 0; b < 2; ++b)
#pragma unroll
            for (int m = 0; m < 4; ++m)
#pragma unroll
                for (int n = 0; n < 2; ++n) acc[a][b][m][n] = (f32x4){0.f, 0.f, 0.f, 0.f};
    h16x8 At[4][2], B0[2][2], B1[2][2];
    const char* cA = (const char*)g.A + (size_t)cur.pm * tstepA + (size_t)cur.pn * g.a_pn_bytes; const char* cB = (const char*)g.Bt + (size_t)cur.pn * tstepB;
    PG8_STAGE(PG8_SB(0, 0), cB, voffB); PG8_STAGE(PG8_SA(0, 0), cA, voffA); PG8_STAGE(PG8_SB(0, 1), cB + hstepB, voffB); PG8_STAGE(PG8_SA(0, 1), cA + hstepA, voffA);
    if (wr == 1) PG8_BAR;
    PG8_WAIT_V(4); PG8_BAR;
    PG8_STAGE(PG8_SB(1, 0), cB + kstep, voffB); PG8_STAGE(PG8_SA(1, 0), cA + kstep, voffA); PG8_STAGE(PG8_SB(1, 1), cB + hstepB + kstep, voffB);
    PG8_WAIT_V(6); PG8_BAR;
    for (;;) {
        const bool has_next = S.next(ui + 1, nxt);
        const char* nA = has_next ? (const char*)g.A + (size_t)nxt.pm * tstepA + (size_t)nxt.pn * g.a_pn_bytes : cA; const char* nB = has_next ? (const char*)g.Bt + (size_t)nxt.pn * tstepB : cB;
        for (int t = 0; t < nt; t += 2) {
            const bool last = (t == nt - 2);
            const char* a1 = cA + (size_t)(t + 1) * kstep;
            const char* a2 = last ? nA : cA + (size_t)(t + 2) * kstep; const char* b2 = last ? nB : cB + (size_t)(t + 2) * kstep;
            const char* a3 = a2 + kstep; const char* b3 = b2 + kstep;
            PG8_LDB(B0, 0, 0); PG8_SCHED; PG8_LDA(At, 0, 0); PG8_STAGE(PG8_SA(1, 1), a1 + hstepA, voffA);
            PG8_WAIT_L(8); PG8_BAR; PG8_WAIT_L(0); PG8_MMA(0, 0, At, B0); PG8_BAR; PG8_SCHED;
            PG8_LDB(B1, 0, 1); PG8_STAGE(PG8_SB(0, 0), b2, voffB);
            PG8_BAR; PG8_WAIT_L(0); PG8_MMA(0, 1, At, B1); PG8_BAR;
            PG8_LDA(At, 0, 1); PG8_STAGE(PG8_SA(0, 0), a2, voffA);
            PG8_BAR; PG8_WAIT_L(0); PG8_MMA(1, 0, At, B0); PG8_BAR; PG8_SCHED;
            PG8_STAGE(PG8_SB(0, 1), b2 + hstepB, voffB);
            PG8_WAIT_V(6); PG8_BAR; PG8_MMA(1, 1, At, B1); PG8_BAR;
            PG8_LDB(B0, 1, 0); PG8_SCHED; PG8_LDA(At, 1, 0); PG8_STAGE(PG8_SA(0, 1), a2 + hstepA, voffA);
            PG8_WAIT_L(8); PG8_BAR; PG8_WAIT_L(0); PG8_MMA(0, 0, At, B0); PG8_BAR; PG8_SCHED;
            PG8_LDB(B1, 1, 1); PG8_STAGE(PG8_SB(1, 0), b3, voffB);
            PG8_BAR; PG8_WAIT_L(0); PG8_MMA(0, 1, At, B1); PG8_BAR;
            PG8_LDA(At, 1, 1); PG8_STAGE(PG8_SA(1, 0), a3, voffA);
            PG8_BAR; PG8_WAIT_L(0); PG8_MMA(1, 0, At, B0); PG8_BAR; PG8_SCHED;
            PG8_STAGE(PG8_SB(1, 1), b3 + hstepB, voffB);
            PG8_WAIT_V(6); PG8_BAR; PG8_MMA(1, 1, At, B1); PG8_BAR;
        }
        E(acc, cur, wr, wc, fr, fq);
        if (!has_next) break;
#pragma unroll
        for (int a = 0; a < 2; ++a)
#pragma unroll
            for (int b = 0; b < 2; ++b)
#pragma unroll
                for (int m = 0; m < 4; ++m)
#pragma unroll
                    for (int n = 0; n < 2; ++n) acc[a][b][m][n] = (f32x4){0.f, 0.f, 0.f, 0.f};
        cur = nxt; cA = nA; cB = nB; ++ui;
    }
    PG8_WAIT_V(0);
    if (wr == 0) PG8_BAR;
    PG8_BAR;
#undef PG8_SA
#undef PG8_SB
#undef PG8_STAGE
#undef PG8_LDA
#undef PG8_LDB
#undef PG8_MMA
#undef PG8_WAIT_V
#undef PG8_WAIT_L
#undef PG8_BAR
#undef PG8_SCHED
}
}
typedef f32x4 AccT[2][2][4][2];

struct EpiIn {
    h16 *qb, *kb, *vt, *guv, *gates;
    __device__ __forceinline__ void operator()(const AccT& acc, const pg8::Unit& u, int wr, int wc, int fr, int fq) const {
        const int pn = u.pn;
        const int row0 = u.pm * 256 + wr * 64 + fr;
        const int cin = wc * 32 + 8 * fq;
        const int b = (u.pm * 256) >> 11, sb = ((u.pm * 256) & 2047) + wr * 64;
        if (pn < 2) {
            h16* base = qb + (size_t)row0 * 512 + pn * 256 + cin;
#pragma unroll
            for (int ai = 0; ai < 2; ++ai)
#pragma unroll
                for (int m = 0; m < 4; ++m)
#pragma unroll
                    for (int bj = 0; bj < 2; ++bj) *(h16x8*)(base + (ai * 128 + m * 16) * 512 + bj * 128) = pack8(acc[ai][bj][m][0], acc[ai][bj][m][1]);
        } else if (pn < 4) {
#pragma unroll
            for (int bj = 0; bj < 2; ++bj) {
                const int col = (pn & 1) * 256 + bj * 128 + cin, hd = col >> 6, d0 = col & 63;
                h16* base = kb + ((size_t)(b * 8 + hd) * 2048 + sb + fr) * 64 + d0;
#pragma unroll
                for (int ai = 0; ai < 2; ++ai)
#pragma unroll
                    for (int m = 0; m < 4; ++m) *(h16x8*)(base + (ai * 128 + m * 16) * 64) = pack8(acc[ai][bj][m][0], acc[ai][bj][m][1]);
            }
        } else if (pn < 6) {
#pragma unroll
            for (int bj = 0; bj < 2; ++bj) {
                const int cv = (pn - 4) * 256 + bj * 128 + cin, hd = cv >> 6, d0 = cv & 63;
                h16* base = vt + ((size_t)(b * 8 + hd) * 256 + (sb >> 3) + (fr >> 3)) * 512 + d0 * 8 + (fr & 7);
#pragma unroll
                for (int ai = 0; ai < 2; ++ai)
#pragma unroll
                    for (int m = 0; m < 4; ++m) {
                        h16* vp = base + (ai * 16 + m * 2) * 512;
                        const f32x4 v0 = acc[ai][bj][m][0], v1 = acc[ai][bj][m][1];
#pragma unroll
                        for (int i = 0; i < 4; ++i) { vp[i * 8] = (h16)v0[i]; vp[(i + 4) * 8] = (h16)v1[i]; }
                    }
            }
        } else if (pn < 10) {
            h16* base = guv + (size_t)row0 * 1024 + (pn - 6) * 256 + cin;
#pragma unroll
            for (int ai = 0; ai < 2; ++ai)
#pragma unroll
                for (int m = 0; m < 4; ++m)
#pragma unroll
                    for (int bj = 0; bj < 2; ++bj) {
                        f32x4 v0 = acc[ai][bj][m][0], v1 = acc[ai][bj][m][1];
#pragma unroll
                        for (int i = 0; i < 4; ++i) { v0[i] = gelu_tanh(v0[i]); v1[i] = gelu_tanh(v1[i]); }
                        *(h16x8*)(base + (ai * 128 + m * 16) * 1024 + bj * 128) = pack8(v0, v1);
                    }
        } else {
            h16* base = gates + (size_t)row0 * 2048 + (pn - 10) * 256 + cin;
#pragma unroll
            for (int ai = 0; ai < 2; ++ai)
#pragma unroll
                for (int m = 0; m < 4; ++m)
#pragma unroll
                    for (int bj = 0; bj < 2; ++bj) {
                        f32x4 v0 = acc[ai][bj][m][0], v1 = acc[ai][bj][m][1];
#pragma unroll
                        for (int i = 0; i < 4; ++i) { v0[i] = sigmoidf_(v0[i]); v1[i] = sigmoidf_(v1[i]); }
                        *(h16x8*)(base + (ai * 128 + m * 16) * 2048 + bj * 128) = pack8(v0, v1);
                    }
        }
    }
};
struct EpiCtx {
    h16 *kc, *vct;
    __device__ __forceinline__ void operator()(const AccT& acc, const pg8::Unit& u, int wr, int wc, int fr, int fq) const {
        const int pn = u.pn;
        const int cin = wc * 32 + 8 * fq;
        const int b = u.pm, sb = wr * 64;
        if (pn < 2) {
#pragma unroll
            for (int bj = 0; bj < 2; ++bj) {
                const int col = pn * 256 + bj * 128 + cin, hd = col >> 6, d0 = col & 63;
                h16* base = kc + ((size_t)(b * 8 + hd) * 256 + sb + fr) * 64 + d0;
#pragma unroll
                for (int ai = 0; ai < 2; ++ai)
#pragma unroll
                    for (int m = 0; m < 4; ++m) *(h16x8*)(base + (ai * 128 + m * 16) * 64) = pack8(acc[ai][bj][m][0], acc[ai][bj][m][1]);
            }
        } else {
#pragma unroll
            for (int bj = 0; bj < 2; ++bj) {
                const int cv = (pn - 2) * 256 + bj * 128 + cin, hd = cv >> 6, d0 = cv & 63;
                h16* base = vct + ((size_t)(b * 8 + hd) * 32 + (sb >> 3) + (fr >> 3)) * 512 + d0 * 8 + (fr & 7);
#pragma unroll
                for (int ai = 0; ai < 2; ++ai)
#pragma unroll
                    for (int m = 0; m < 4; ++m) {
                        h16* vp = base + (ai * 16 + m * 2) * 512;
                        const f32x4 v0 = acc[ai][bj][m][0], v1 = acc[ai][bj][m][1];
#pragma unroll
                        for (int i = 0; i < 4; ++i) { vp[i * 8] = (h16)v0[i]; vp[(i + 4) * 8] = (h16)v1[i]; }
                    }
            }
        }
    }
};
struct EpiM1 {
    h16* m1; const h16* gates;
    __device__ __forceinline__ void operator()(const AccT& acc, const pg8::Unit& u, int wr, int wc, int fr, int fq) const {
        const int row0 = u.pm * 256 + wr * 64 + fr, col0 = u.pn * 256 + wc * 32 + 8 * fq;
#pragma unroll
        for (int ai = 0; ai < 2; ++ai)
#pragma unroll
            for (int m = 0; m < 4; ++m) {
                const int row = row0 + ai * 128 + m * 16;
#pragma unroll
                for (int bj = 0; bj < 2; ++bj) {
                    const int col = col0 + bj * 128;
                    const h16x8 gt = *(const h16x8*)(gates + (size_t)row * 2048 + col);
                    f32x4 v0 = acc[ai][bj][m][0], v1 = acc[ai][bj][m][1];
#pragma unroll
                    for (int i = 0; i < 4; ++i) { v0[i] *= (float)gt[i]; v1[i] *= (float)gt[4 + i]; }
                    *(h16x8*)(m1 + (size_t)row * 1024 + col) = pack8(v0, v1);
                }
            }
    }
};
struct EpiM2 {
    const h16* m1; const h16* gates; h16* mm;
    __device__ __forceinline__ void operator()(const AccT& acc, const pg8::Unit& u, int wr, int wc, int fr, int fq) const {
        const int row0 = u.pm * 256 + wr * 64 + fr, col0 = u.pn * 256 + wc * 32 + 8 * fq;
#pragma unroll
        for (int ai = 0; ai < 2; ++ai)
#pragma unroll
            for (int m = 0; m < 4; ++m) {
                const int row = row0 + ai * 128 + m * 16;
#pragma unroll
                for (int bj = 0; bj < 2; ++bj) {
                    const int col = col0 + bj * 128;
                    const h16x8 gt = *(const h16x8*)(gates + (size_t)row * 2048 + 1024 + col);
                    const h16x8 mi = *(const h16x8*)(m1 + (size_t)row * 1024 + col);
                    f32x4 p0 = (f32x4){(float)mi[0], (float)mi[1], (float)mi[2], (float)mi[3]}, p1 = (f32x4){(float)mi[4], (float)mi[5], (float)mi[6], (float)mi[7]};
                    const f32x4 v0 = acc[ai][bj][m][0], v1 = acc[ai][bj][m][1];
#pragma unroll
                    for (int i = 0; i < 4; ++i) { p0[i] += v0[i] * (float)gt[i]; p1[i] += v1[i] * (float)gt[4 + i]; }
                    *(h16x8*)(mm + (size_t)row * 1024 + col) = pack8(p0, p1);
                }
            }
    }
};
struct EpiX1 {
    const float* x; const float* mod; h16* x1;
    __device__ __forceinline__ void operator()(const AccT& acc, const pg8::Unit& u, int wr, int wc, int fr, int fq) const {
        const int row0 = u.pm * 256 + wr * 64 + fr, col0 = u.pn * 256 + wc * 32 + 8 * fq;
        const int b = (u.pm * 256) >> 11;
#pragma unroll
        for (int bj = 0; bj < 2; ++bj) {
            const int col = col0 + bj * 128;
            const float* gp = mod + (size_t)b * 6144 + 2 * 1024 + col;
            const f32x4 g0 = *(const f32x4*)gp, g1 = *(const f32x4*)(gp + 4);
#pragma unroll
            for (int ai = 0; ai < 2; ++ai)
#pragma unroll
                for (int m = 0; m < 4; ++m) {
                    const int row = row0 + ai * 128 + m * 16;
                    const float* xi = x + (size_t)row * 1024 + col;
                    const f32x4 x0 = *(const f32x4*)xi, x1v = *(const f32x4*)(xi + 4);
                    *(h16x8*)(x1 + (size_t)row * 1024 + col) = pack8(x0 + g0 * acc[ai][bj][m][0], x1v + g1 * acc[ai][bj][m][1]);
                }
        }
    }
};
struct EpiH16 {
    h16* o; int ldc;
    __device__ __forceinline__ void operator()(const AccT& acc, const pg8::Unit& u, int wr, int wc, int fr, int fq) const {
        const int row0 = u.pm * 256 + wr * 64 + fr, col0 = u.pn * 256 + wc * 32 + 8 * fq;
#pragma unroll
        for (int ai = 0; ai < 2; ++ai)
#pragma unroll
            for (int m = 0; m < 4; ++m) {
                const int row = row0 + ai * 128 + m * 16;
#pragma unroll
                for (int bj = 0; bj < 2; ++bj)
                    *(h16x8*)(o + (size_t)row * ldc + col0 + bj * 128) = pack8(acc[ai][bj][m][0], acc[ai][bj][m][1]);
            }
    }
};

__device__ __forceinline__ void cvt_tile(const float* __restrict__ src, h16* __restrict__ dst, int tile) {
    const size_t i = (size_t)tile * 4096 + threadIdx.x * 8;
    const f32x4 a = *(const f32x4*)(src + i), b = *(const f32x4*)(src + i + 4);
    *(h16x8*)(dst + i) = pack8(a, b);
}
__device__ __forceinline__ void tr_tile(const float* __restrict__ src, h16* __restrict__ dst, int K, int N, int tile, float* lds) {
    const int ntn = N / 64, tk = tile / ntn, tn = tile % ntn, tid = threadIdx.x;
#pragma unroll
    for (int ps = 0; ps < 2; ++ps) {
        const int k = ps * 32 + (tid >> 4), n = (tid & 15) * 4;
        const f32x4 v = *(const f32x4*)(src + (size_t)(tk * 64 + k) * N + tn * 64 + n);
        lds[k * 65 + n] = v[0]; lds[k * 65 + n + 1] = v[1]; lds[k * 65 + n + 2] = v[2]; lds[k * 65 + n + 3] = v[3];
    }
    __syncthreads();
    {
        const int n = tid >> 3, ks = (tid & 7) * 8;
        h16x8 o;
#pragma unroll
        for (int i = 0; i < 8; ++i) o[i] = (h16)lds[(ks + i) * 65 + n];
        *(h16x8*)(dst + (size_t)(tn * 64 + n) * K + tk * 64 + ks) = o;
    }
    __syncthreads();
}
__device__ __forceinline__ void cvt8_rows(const float* __restrict__ src, unsigned char* __restrict__ dst, float* __restrict__ inv, int tile, int dstride = 1024) {
    const int wid = threadIdx.x >> 6, lane = threadIdx.x & 63;
    const size_t row = (size_t)tile * 8 + wid;
    const float* r = src + row * 1024 + lane * 16;
    f32x4 a[4]; float mx = 0.f;
#pragma unroll
    for (int i = 0; i < 4; ++i) { a[i] = *(const f32x4*)(r + 4 * i); mx = fmaxf(mx, fmaxf(fmaxf(fabsf(a[i][0]), fabsf(a[i][1])), fmaxf(fabsf(a[i][2]), fabsf(a[i][3])))); }
#pragma unroll
    for (int o = 32; o > 0; o >>= 1) mx = fmaxf(mx, __shfl_xor(mx, o));
    int ex2 = 0; float sc = 1.0f;
    if (mx > 0.f) { (void)frexpf(mx, &ex2); int k = 8 - ex2; k = k > 100 ? 100 : (k < -100 ? -100 : k); sc = ldexpf(1.0f, k); }
    i32x4 w;
#pragma unroll
    for (int i = 0; i < 4; ++i) {
        int pk = __builtin_amdgcn_cvt_pk_fp8_f32(a[i][0] * sc, a[i][1] * sc, 0, false);
        pk = __builtin_amdgcn_cvt_pk_fp8_f32(a[i][2] * sc, a[i][3] * sc, pk, true);
        w[i] = pk;
    }
    *(i32x4*)(dst + row * dstride + lane * 16) = w;
    if (lane == 0) inv[2 * row] = 1.0f / sc;
}
__device__ __forceinline__ void cvt4_rows(const float* __restrict__ src, unsigned char* __restrict__ dst, float* __restrict__ inv, int tile, int dstride = 512) {
    const int wid = threadIdx.x >> 6, lane = threadIdx.x & 63;
    const size_t row = (size_t)tile * 8 + wid;
    const float* r = src + row * 1024 + lane * 16;
    f32x4 a[4]; float mx = 0.f;
#pragma unroll
    for (int i = 0; i < 4; ++i) { a[i] = *(const f32x4*)(r + 4 * i); mx = fmaxf(mx, fmaxf(fmaxf(fabsf(a[i][0]), fabsf(a[i][1])), fmaxf(fabsf(a[i][2]), fabsf(a[i][3])))); }
#pragma unroll
    for (int o = 32; o > 0; o >>= 1) mx = fmaxf(mx, __shfl_xor(mx, o));
    const float sc = (mx > 1e-30f) ? 6.0f / mx : 1.0f;
    int w0 = 0, w1 = 0;
    w0 = __builtin_amdgcn_cvt_scalef32_pk_fp4_f32(w0, a[0][0] * sc, a[0][1] * sc, 1.0f, 0);
    w0 = __builtin_amdgcn_cvt_scalef32_pk_fp4_f32(w0, a[0][2] * sc, a[0][3] * sc, 1.0f, 1);
    w0 = __builtin_amdgcn_cvt_scalef32_pk_fp4_f32(w0, a[1][0] * sc, a[1][1] * sc, 1.0f, 2);
    w0 = __builtin_amdgcn_cvt_scalef32_pk_fp4_f32(w0, a[1][2] * sc, a[1][3] * sc, 1.0f, 3);
    w1 = __builtin_amdgcn_cvt_scalef32_pk_fp4_f32(w1, a[2][0] * sc, a[2][1] * sc, 1.0f, 0);
    w1 = __builtin_amdgcn_cvt_scalef32_pk_fp4_f32(w1, a[2][2] * sc, a[2][3] * sc, 1.0f, 1);
    w1 = __builtin_amdgcn_cvt_scalef32_pk_fp4_f32(w1, a[3][0] * sc, a[3][1] * sc, 1.0f, 2);
    w1 = __builtin_amdgcn_cvt_scalef32_pk_fp4_f32(w1, a[3][2] * sc, a[3][3] * sc, 1.0f, 3);
    *(i32x2*)(dst + row * dstride + lane * 8) = (i32x2){w0, w1};
    if (lane == 0) inv[2 * row] = 1.0f / sc;
}
__device__ __forceinline__ void wqk_tile(const float* __restrict__ wq, const float* __restrict__ keys, h16* __restrict__ wt, int tile, float* lds) {
    const int ct = tile >> 4, hp = tile & 15, tid = threadIdx.x;
    float* sA = lds;
    float* sB = lds + 64 * 129;
#pragma unroll
    for (int i = 0; i < 4; ++i) {
        const int e = (i * 512 + tid) * 4, r = e >> 7, d = e & 127;
        const f32x4 v = *(const f32x4*)(wq + (size_t)(ct * 64 + r) * 2048 + hp * 128 + d);
        sA[r * 129 + d] = v[0]; sA[r * 129 + d + 1] = v[1]; sA[r * 129 + d + 2] = v[2]; sA[r * 129 + d + 3] = v[3];
    }
#pragma unroll
    for (int i = 0; i < 8; ++i) {
        const int e = (i * 512 + tid) * 4, k = e >> 7, d = e & 127;
        const f32x4 v = *(const f32x4*)(keys + (size_t)(hp * 128 + k) * 128 + d);
        sB[k * 129 + d] = v[0]; sB[k * 129 + d + 1] = v[1]; sB[k * 129 + d + 2] = v[2]; sB[k * 129 + d + 3] = v[3];
    }
    __syncthreads();
    const int cg = tid >> 5, kq = tid & 31;
    float acc[4][4];
#pragma unroll
    for (int i = 0; i < 4; ++i)
#pragma unroll
        for (int j = 0; j < 4; ++j) acc[i][j] = 0.f;
#pragma unroll 4
    for (int d = 0; d < 128; ++d) {
        float a[4], bq[4];
#pragma unroll
        for (int i = 0; i < 4; ++i) a[i] = sA[(cg * 4 + i) * 129 + d];
#pragma unroll
        for (int j = 0; j < 4; ++j) bq[j] = sB[(kq + 32 * j) * 129 + d];
#pragma unroll
        for (int i = 0; i < 4; ++i)
#pragma unroll
            for (int j = 0; j < 4; ++j) acc[i][j] += a[i] * bq[j];
    }
#pragma unroll
    for (int j = 0; j < 4; ++j) {
        h16x4 o;
#pragma unroll
        for (int i = 0; i < 4; ++i) o[i] = (h16)acc[i][j];
        *(h16x4*)(wt + (size_t)(hp * 128 + kq + 32 * j) * 1024 + ct * 64 + cg * 4) = o;
    }
    __syncthreads();
}
__device__ void phase0(const Params& p, float* lds) {
    unsigned char* ws = p.ws;
    const int tid = threadIdx.x, wid = tid >> 6, lane = tid & 63;
    for (int ib = blockIdx.x; ib < 256; ib += gridDim.x) {
        if (wid < 6) {
            const int item = ib * 6 + wid, cg64 = item % 96, kc = item / 96;
            const int col = cg64 * 64 + lane, k0 = kc * 64;
            float sv[17], acc[17];
#pragma unroll
            for (int b = 0; b < 17; ++b) {
                const float cv = (b < 16) ? p.in[I_C][b * 1024 + k0 + lane] : p.in[I_CCTX][k0 + lane];
                sv[b] = silu_(cv); acc[b] = 0.f;
            }
            const float* wp = p.in[I_ADAW] + (size_t)k0 * 6144 + col;
#pragma unroll 16
            for (int j = 0; j < 64; ++j) {
                const float w = wp[(size_t)j * 6144];
#pragma unroll
                for (int b = 0; b < 17; ++b) acc[b] += __builtin_bit_cast(float, __builtin_amdgcn_readlane(__builtin_bit_cast(int, sv[b]), j)) * w;
            }
            float* mp = (float*)(ws + OFF_MODP);
#pragma unroll
            for (int b = 0; b < 17; ++b) mp[((size_t)kc * 17 + b) * 6144 + col] = acc[b];
        }
    }
    constexpr int T0 = 2048, T1 = T0 + 2048, T2 = T1 + 32, T3 = T2, T4 = T3 + 1152, T5 = T4 + 128, T6 = T5 + 128, T7 = T6 + 256, T8 = T7 + 256;
    for (int t = blockIdx.x; t < T8; t += gridDim.x) {
        if (t < T0) cvt4_rows(p.in[I_PU], ws + OFF_U8, (float*)(ws + OFF_USC), t, 1536);
        else if (t < T1) cvt8_rows(p.in[I_PV], ws + OFF_U8 + 512, (float*)(ws + OFF_USC) + 1, t - T0, 1536);
        else if (t < T2) cvt_tile(p.in[I_GMWS], (h16*)(ws + OFF_WS16), t - T1);
        else if (t < T3) {
            const int e = (t - T2) * 4096 + tid * 8;
            const int row = e >> 8, cc = e & 255, h = row >> 8, pp = (row >> 7) & 1, k = row & 127, pq = cc >> 7, d = cc & 127;
            h16x8 o = {0, 0, 0, 0, 0, 0, 0, 0};
            if (pp == pq) {
                const float* kp = p.in[I_KEYS] + ((size_t)((h * 2 + pp) * 128 + k)) * 128 + d;
                o = pack8(*(const f32x4*)kp, *(const f32x4*)(kp + 4));
            }
            *(h16x8*)((h16*)(ws + OFF_BD) + e) = o;
        }
        else if (t < T4) tr_tile(p.in[I_WIN], (h16*)(ws + OFF_WINT), 1024, INC, t - T3, lds);
        else if (t < T5) tr_tile(p.in[I_WPA], (h16*)(ws + OFF_WPAT), 512, 1024, t - T4, lds);
        else if (t < T6) tr_tile(p.in[I_WPB], (h16*)(ws + OFF_WPBT), 512, 1024, t - T5, lds);
        else if (t < T7) tr_tile(p.in[I_WOUT], (h16*)(ws + OFF_WOUTT), 1024, 1024, t - T6, lds);
        else wqk_tile(p.in[I_WQ], p.in[I_KEYS], (h16*)(ws + OFF_WQT), t - T7, lds);
    }
}

__device__ __forceinline__ void norm_rows(const float* __restrict__ src, h16* __restrict__ dst, int row_begin, int rows_per_wave, const float* sA, const float* sB) {
    const int tid_ = fresh_tid();
    const int wid = tid_ >> 6, lane = tid_ & 63;
    f32x4 a[4], bsh[4];
#pragma unroll
    for (int c = 0; c < 4; ++c) { a[c] = *(const f32x4*)(sA + c * 256 + lane * 4); bsh[c] = *(const f32x4*)(sB + c * 256 + lane * 4); }
    for (int i = 0; i < rows_per_wave; i += 2) {
        const size_t row = (size_t)row_begin + wid * rows_per_wave + i;
        f32x4 v[2][4]; float ss[2];
#pragma unroll
        for (int q = 0; q < 2; ++q) {
            ss[q] = 0.f;
#pragma unroll
            for (int c = 0; c < 4; ++c) { v[q][c] = *(const f32x4*)(src + (row + q) * 1024 + c * 256 + lane * 4); ss[q] += v[q][c][0] * v[q][c][0] + v[q][c][1] * v[q][c][1] + v[q][c][2] * v[q][c][2] + v[q][c][3] * v[q][c][3]; }
        }
#pragma unroll
        for (int o = 32; o > 0; o >>= 1) { const float t0 = __shfl_xor(ss[0], o), t1 = __shfl_xor(ss[1], o); ss[0] += t0; ss[1] += t1; }
#pragma unroll
        for (int q = 0; q < 2; ++q) {
            const float r = rsqrtf(ss[q] * (1.0f / 1024.0f) + 1e-6f);
#pragma unroll
            for (int c = 0; c < 4; ++c) {
                h16x4 o;
#pragma unroll
                for (int j = 0; j < 4; ++j) o[j] = (h16)(v[q][c][j] * r * a[c][j] + bsh[c][j]);
                *(h16x4*)(dst + (row + q) * 1024 + c * 256 + lane * 4) = o;
            }
        }
    }
}
__device__ __forceinline__ void norm_rows_h(const h16* __restrict__ src, h16* __restrict__ dst, int row_begin, int rows_per_wave, const float* sA, const float* sB) {
    const int tid_ = fresh_tid();
    const int wid = tid_ >> 6, lane = tid_ & 63;
    f32x4 a[4], bsh[4];
#pragma unroll
    for (int c = 0; c < 4; ++c) { a[c] = *(const f32x4*)(sA + c * 256 + lane * 4); bsh[c] = *(const f32x4*)(sB + c * 256 + lane * 4); }
    for (int i = 0; i < rows_per_wave; i += 2) {
        const size_t row = (size_t)row_begin + wid * rows_per_wave + i;
        f32x4 v[2][4]; float ss[2];
#pragma unroll
        for (int q = 0; q < 2; ++q) {
            ss[q] = 0.f;
#pragma unroll
            for (int c = 0; c < 4; ++c) { const h16x4 hv = *(const h16x4*)(src + (row + q) * 1024 + c * 256 + lane * 4);
                v[q][c] = (f32x4){(float)hv[0], (float)hv[1], (float)hv[2], (float)hv[3]};
                ss[q] += v[q][c][0] * v[q][c][0] + v[q][c][1] * v[q][c][1] + v[q][c][2] * v[q][c][2] + v[q][c][3] * v[q][c][3]; }
        }
#pragma unroll
        for (int o = 32; o > 0; o >>= 1) { const float t0 = __shfl_xor(ss[0], o), t1 = __shfl_xor(ss[1], o); ss[0] += t0; ss[1] += t1; }
#pragma unroll
        for (int q = 0; q < 2; ++q) {
            const float r = rsqrtf(ss[q] * (1.0f / 1024.0f) + 1e-6f);
#pragma unroll
            for (int c = 0; c < 4; ++c) {
                h16x4 o;
#pragma unroll
                for (int j = 0; j < 4; ++j) o[j] = (h16)(v[q][c][j] * r * a[c][j] + bsh[c][j]);
                *(h16x4*)(dst + (row + q) * 1024 + c * 256 + lane * 4) = o;
            }
        }
    }
}
__device__ void phase1(const Params& p, float* lds) {
    unsigned char* ws = p.ws;
    const int tid = threadIdx.x;
    const float* mp = (const float*)(ws + OFF_MODP);
    const float* bias = p.in[I_ADAB];
    float* sA = lds; float* sB = lds + 1024; float* cA = lds + 2048; float* cB = lds + 3072;
    {
        float* mod = (float*)(ws + OFF_MOD);
        for (int e = blockIdx.x * 512 + tid; e < 17 * 6144; e += gridDim.x * 512) {
            float s = bias[e % 6144];
#pragma unroll
            for (int kc = 0; kc < 16; ++kc) s += mp[(size_t)kc * 17 * 6144 + e];
            mod[e] = s;
        }
    }
    for (int col = tid; col < 1024; col += 512) {
        float sh = bias[col], sc = bias[1024 + col];
#pragma unroll
        for (int kc = 0; kc < 16; ++kc) { sh += mp[((size_t)kc * 17 + 16) * 6144 + col]; sc += mp[((size_t)kc * 17 + 16) * 6144 + 1024 + col]; }
        cA[col] = p.in[I_N1G][col] * (1.0f + sc); cB[col] = sh;
    }
    for (int rg = blockIdx.x; rg < 256; rg += gridDim.x) {
        const int b = rg >> 4;
        __syncthreads();
        for (int col = tid; col < 1024; col += 512) {
            float sh = bias[col], sc = bias[1024 + col];
#pragma unroll
            for (int kc = 0; kc < 16; ++kc) { sh += mp[((size_t)kc * 17 + b) * 6144 + col]; sc += mp[((size_t)kc * 17 + b) * 6144 + 1024 + col]; }
            sA[col] = p.in[I_N1G][col] * (1.0f + sc); sB[col] = sh;
        }
        __syncthreads();
        norm_rows(p.in[I_X], (h16*)(ws + OFF_R1), rg * 128, 16, sA, sB);
        norm_rows(p.in[I_CTX], (h16*)(ws + OFF_HC), rg * 16, 2, cA, cB);
    }
}
__device__ void phase6(const Params& p, float* lds) {
    unsigned char* ws = p.ws;
    const int tid = threadIdx.x;
    const float* mod = (const float*)(ws + OFF_MOD);
    float* sA = lds; float* sB = lds + 1024;
    for (int rg = blockIdx.x; rg < 256; rg += gridDim.x) {
        const int b = rg >> 4;
        __syncthreads();
        for (int col = tid; col < 1024; col += 512) {
            sA[col] = p.in[I_N2G][col] * (1.0f + mod[(size_t)b * 6144 + 4 * 1024 + col]); sB[col] = mod[(size_t)b * 6144 + 3 * 1024 + col];
        }
        __syncthreads();
        norm_rows_h((const h16*)(ws + OFF_X1H), (h16*)(ws + OFF_R1), rg * 128, 16, sA, sB);
    }
}

__device__ __forceinline__ int clampi(int v, int lo, int hi) { return v < lo ? lo : (v > hi ? hi : v); }

template <bool LOCAL>
__device__ __forceinline__ void attn_core(const h16x8 (&kf)[2][2], const h16x8 (&vf)[4], const float (&bias)[8], const int cb, const int qc, const int cs,
                                          const h16x8 (&qf)[2], float& m_run, float& l_run, f32x4 (&O)[4], const int quad) {
    f32x4 st[2];
#pragma unroll
    for (int t = 0; t < 2; ++t) {
        f32x4 a = (f32x4){0.f, 0.f, 0.f, 0.f};
#pragma unroll
        for (int ks = 0; ks < 2; ++ks) a = __builtin_amdgcn_mfma_f32_16x16x32_f16(kf[t][ks], qf[ks], a, 0, 0, 0);
        st[t] = a;
    }
    float mx = -INFINITY;
#pragma unroll
    for (int t = 0; t < 2; ++t)
#pragma unroll
        for (int j = 0; j < 4; ++j) {
            float sv = st[t][j] * 0.125f;
            if (LOCAL) {
                const int kc = cb + 16 * t + quad * 4 + j;
                const bool inw = (kc >= cs) && (kc < cs + 16);
                sv = inw ? (sv + bias[t * 4 + j]) : -1e30f;
            }
            st[t][j] = sv; mx = fmaxf(mx, sv);
        }
    mx = fmaxf(mx, __shfl_xor(mx, 16)); mx = fmaxf(mx, __shfl_xor(mx, 32));
    const float m_new = fmaxf(m_run, mx);
    const float alpha = __expf(m_run - m_new);
    float ls = 0.f; h16x8 pf;
#pragma unroll
    for (int t = 0; t < 2; ++t)
#pragma unroll
        for (int j = 0; j < 4; ++j) { const float pe = __expf(st[t][j] - m_new); ls += pe; pf[t * 4 + j] = (h16)pe; }
    l_run = l_run * alpha + ls; m_run = m_new;
#pragma unroll
    for (int dt = 0; dt < 4; ++dt) { O[dt] *= alpha; O[dt] = __builtin_amdgcn_mfma_f32_16x16x32_f16(vf[dt], pf, O[dt], 0, 0, 0); }
}
__device__ __forceinline__ void load_k(const h16* __restrict__ kt, h16x8 (&kf)[2][2], const int l15, const int quad) {
#pragma unroll
    for (int t = 0; t < 2; ++t)
#pragma unroll
        for (int ks = 0; ks < 2; ++ks) kf[t][ks] = *(const h16x8*)(kt + (16 * t + l15) * 64 + ks * 32 + quad * 8);
}
__device__ __forceinline__ void load_v(const h16* __restrict__ vt, h16x8 (&vf)[4], const int l15, const int quad) {
#pragma unroll
    for (int dt = 0; dt < 4; ++dt) {
        const h16* vp = vt + ((quad >> 1) * 64 + dt * 16 + l15) * 8 + (quad & 1) * 4;
        const h16x4 lo = *(const h16x4*)vp, hi = *(const h16x4*)(vp + 2 * 512);
        vf[dt] = (h16x8){lo[0], lo[1], lo[2], lo[3], hi[0], hi[1], hi[2], hi[3]};
    }
}
__device__ __forceinline__ void load_bias(const float* __restrict__ rpbrow, const int cb, const int qc, const int quad, float (&bias)[8]) {
#pragma unroll
    for (int t = 0; t < 2; ++t)
#pragma unroll
        for (int j = 0; j < 4; ++j) bias[t * 4 + j] = rpbrow[clampi(cb + 16 * t + quad * 4 + j - qc + 15, 0, 30)];
}

__device__ void attn_unit(const Params& p, int unit) {
    unsigned char* ws = p.ws;
    const int tid_ = fresh_tid();
    const int lane = tid_ & 63, h = tid_ >> 6, l15 = lane & 15, quad = lane >> 4;
    const int b = unit >> 5, r = unit & 31;
    const h16* QB = (const h16*)(ws + OFF_QB);
    const h16* KH = (const h16*)(ws + OFF_KB) + (size_t)(b * 8 + h) * 2048 * 64;
    const h16* VH = (const h16*)(ws + OFF_VT) + (size_t)(b * 8 + h) * 256 * 512;
    const h16* KCH = (const h16*)(ws + OFF_KC) + (size_t)(b * 8 + h) * 256 * 64;
    const h16* VCH = (const h16*)(ws + OFF_VCT) + (size_t)(b * 8 + h) * 32 * 512;
    h16* YA = (h16*)(ws + OFF_R1);
    const float* rpb = p.in[I_RPB] + (size_t)h * 15 * 31;
    const int rs = clampi(r - 4, 0, 24);
    h16x8 qf[4][2]; float m_run[4], l_run[4]; f32x4 O[4][4];
#pragma unroll
    for (int g = 0; g < 4; ++g) {
        const size_t tq = (size_t)b * 2048 + r * 64 + 16 * g + l15;
        qf[g][0] = *(const h16x8*)(QB + tq * 512 + h * 64 + quad * 8);
        qf[g][1] = *(const h16x8*)(QB + tq * 512 + h * 64 + 32 + quad * 8);
        m_run[g] = -INFINITY; l_run[g] = 0.f;
#pragma unroll
        for (int dt = 0; dt < 4; ++dt) O[g][dt] = (f32x4){0.f, 0.f, 0.f, 0.f};
    }
    {
        const float nob[8] = {0.f, 0.f, 0.f, 0.f, 0.f, 0.f, 0.f, 0.f};
        h16x8 kA[2][2], kB[2][2], vf[4];
        load_k(KCH, kA, l15, quad);
#pragma unroll 1
        for (int step = 0; step < 8; step += 2) {
            load_v(VCH + step * 4 * 512, vf, l15, quad);
            load_k(KCH + (step + 1) * 32 * 64, kB, l15, quad);
            __builtin_amdgcn_sched_barrier(0);
#pragma unroll
            for (int g = 0; g < 4; ++g) attn_core<false>(kA, vf, nob, 0, 0, 0, qf[g], m_run[g], l_run[g], O[g], quad);
            __builtin_amdgcn_sched_barrier(0);
            load_v(VCH + (step + 1) * 4 * 512, vf, l15, quad);
            if (step + 2 < 8) load_k(KCH + (step + 2) * 32 * 64, kA, l15, quad);
            __builtin_amdgcn_sched_barrier(0);
#pragma unroll
            for (int g = 0; g < 4; ++g) attn_core<false>(kB, vf, nob, 0, 0, 0, qf[g], m_run[g], l_run[g], O[g], quad);
            __builtin_amdgcn_sched_barrier(0);
        }
    }
#pragma unroll
    for (int gp = 0; gp < 4; gp += 2) {
        const int cb0 = clampi(16 * gp - 8, 0, 32), cb1 = clampi(16 * (gp + 1) - 8, 0, 32);
        const int qc0 = 16 * gp + l15, qc1 = 16 * (gp + 1) + l15;
        const int cs0 = clampi(qc0 - 8, 0, 48), cs1 = clampi(qc1 - 8, 0, 48);
        const float* rp0 = rpb + (rs - r + 7) * 31;
#pragma unroll 1
        for (int step = 0; step < 8; ++step) {
            const int t0 = (rs + step) * 64 + cb0, t1 = (rs + step) * 64 + cb1;
            h16x8 kf0[2][2], vf0[4], kf1[2][2], vf1[4]; float b0[8], b1[8];
            load_k(KH + (size_t)t0 * 64, kf0, l15, quad); load_k(KH + (size_t)t1 * 64, kf1, l15, quad);
            load_bias(rp0 + step * 31, cb0, qc0, quad, b0); load_bias(rp0 + step * 31, cb1, qc1, quad, b1);
            load_v(VH + (size_t)(t0 >> 3) * 512, vf0, l15, quad); load_v(VH + (size_t)(t1 >> 3) * 512, vf1, l15, quad);
            attn_core<true>(kf0, vf0, b0, cb0, qc0, cs0, qf[gp], m_run[gp], l_run[gp], O[gp], quad);
            attn_core<true>(kf1, vf1, b1, cb1, qc1, cs1, qf[gp + 1], m_run[gp + 1], l_run[gp + 1], O[gp + 1], quad);
        }
    }
#pragma unroll
    for (int g = 0; g < 4; ++g) {
        const size_t tq = (size_t)b * 2048 + r * 64 + 16 * g + l15;
        float l = l_run[g];
        l += __shfl_xor(l, 16); l += __shfl_xor(l, 32);
        const float inv = __builtin_amdgcn_rcpf(l);
#pragma unroll
        for (int dt = 0; dt < 4; ++dt) {
            h16x4 o;
#pragma unroll
            for (int j = 0; j < 4; ++j) o[j] = (h16)(O[g][dt][j] * inv);
            *(h16x4*)(YA + tq * 1024 + h * 64 + dt * 16 + quad * 4) = o;
        }
    }
}

__device__ void sgu_unit(const Params& p, int n, LAS unsigned char* lds) {
    unsigned char* ws = p.ws;
    const int tid = fresh_tid(), lane = tid & 63, g = tid >> 6, l15 = lane & 15, quad = lane >> 4;
    const h16* GUV = (const h16*)(ws + OFF_GUV);
    const h16* WS16 = (const h16*)(ws + OFF_WS16);
    h16* YB = (h16*)(ws + OFF_R1) + 512;
    LAS float* stat = (LAS float*)(lds + 8 * 17408);
    LAS h16* vt = (LAS h16*)(lds + g * 17408);
    const size_t t0 = (size_t)n * 128;
    __syncthreads();
    for (int i = 0; i < 16; i += 4) {
        h16x8 x[4]; float s[4], v[4];
#pragma unroll
        for (int q = 0; q < 4; ++q) {
            x[q] = *(const h16x8*)(GUV + (t0 + g * 16 + i + q) * 1024 + 512 + lane * 8);
            s[q] = 0.f;
#pragma unroll
            for (int j = 0; j < 8; ++j) s[q] += (float)x[q][j];
        }
#pragma unroll
        for (int o = 32; o > 0; o >>= 1) { float t[4];
#pragma unroll
            for (int q = 0; q < 4; ++q) t[q] = __shfl_xor(s[q], o);
#pragma unroll
            for (int q = 0; q < 4; ++q) s[q] += t[q]; }
#pragma unroll
        for (int q = 0; q < 4; ++q) {
            s[q] *= (1.0f / 512.0f); v[q] = 0.f;
#pragma unroll
            for (int j = 0; j < 8; ++j) { const float d = (float)x[q][j] - s[q]; v[q] += d * d; }
        }
#pragma unroll
        for (int o = 32; o > 0; o >>= 1) { float t[4];
#pragma unroll
            for (int q = 0; q < 4; ++q) t[q] = __shfl_xor(v[q], o);
#pragma unroll
            for (int q = 0; q < 4; ++q) v[q] += t[q]; }
        if (lane == 0) {
#pragma unroll
            for (int q = 0; q < 4; ++q) { stat[(g * 16 + i + q) * 2] = s[q]; stat[(g * 16 + i + q) * 2 + 1] = rsqrtf(v[q] * (1.0f / 512.0f) + 1e-6f); }
        }
    }
    __syncthreads();
    {
        const int ch0 = (lane & 7) * 8;
        float lg[8];
#pragma unroll
        for (int j = 0; j < 8; ++j) lg[j] = p.in[I_LNG][g * 64 + ch0 + j];
#pragma unroll 8
        for (int it = 0; it < 16; ++it) {
            const int q = it * 8 + (lane >> 3);
            const h16x8 x = *(const h16x8*)(GUV + (t0 + q) * 1024 + 512 + g * 64 + ch0);
            const float mean = stat[q * 2], rstd = stat[q * 2 + 1];
#pragma unroll
            for (int j = 0; j < 8; ++j) vt[(ch0 + j) * 136 + ((((q >> 3) ^ (lane & 7)) << 3) | (q & 7))] = (h16)(((float)x[j] - mean) * rstd * lg[j]);
        }
    }
    asm volatile("s_waitcnt lgkmcnt(0)" ::: "memory");
    __syncthreads();
    h16x8 af[4][4];
#pragma unroll
    for (int dt = 0; dt < 4; ++dt)
#pragma unroll
        for (int ks = 0; ks < 4; ++ks) af[dt][ks] = *(const LAS h16x8*)(vt + (dt * 16 + l15) * 136 + (((ks * 4 + quad) ^ (dt * 2 + (l15 >> 3))) << 3));
    const h16* wg = WS16 + (size_t)g * 128 * 128;
#pragma unroll 2
    for (int pt = 0; pt < 8; ++pt) {
        f32x4 acc[4];
#pragma unroll
        for (int dt = 0; dt < 4; ++dt) acc[dt] = (f32x4){0.f, 0.f, 0.f, 0.f};
#pragma unroll
        for (int ks = 0; ks < 4; ++ks) {
            const h16x8 bf = *(const h16x8*)(wg + (size_t)(pt * 16 + l15) * 128 + ks * 32 + quad * 8);
#pragma unroll
            for (int dt = 0; dt < 4; ++dt) acc[dt] = __builtin_amdgcn_mfma_f32_16x16x32_f16(af[dt][ks], bf, acc[dt], 0, 0, 0);
        }
        const int pp = pt * 16 + l15;
        const float bsv = p.in[I_GMBS][g * 128 + pp];
        const size_t tok = t0 + pp;
#pragma unroll
        for (int dt = 0; dt < 4; ++dt) {
            const int ch = g * 64 + dt * 16 + quad * 4;
            const h16x4 uu = *(const h16x4*)(GUV + tok * 1024 + ch);
            h16x4 o;
#pragma unroll
            for (int j = 0; j < 4; ++j) o[j] = (h16)((float)uu[j] * (acc[dt][j] + bsv));
            *(h16x4*)(YB + tok * 1024 + ch) = o;
        }
    }
    __syncthreads();
}

__device__ __forceinline__ float row16_sum_to_lane15(float v) {
    v += __builtin_bit_cast(float, __builtin_amdgcn_update_dpp(0, __builtin_bit_cast(int, v), 0x118, 0xf, 0xf, true));
    v += __builtin_bit_cast(float, __builtin_amdgcn_update_dpp(0, __builtin_bit_cast(int, v), 0x114, 0xf, 0xf, true));
    v += __builtin_bit_cast(float, __builtin_amdgcn_update_dpp(0, __builtin_bit_cast(int, v), 0x112, 0xf, 0xf, true));
    v += __builtin_bit_cast(float, __builtin_amdgcn_update_dpp(0, __builtin_bit_cast(int, v), 0x111, 0xf, 0xf, true));
    return v;
}
#define DPPF(v, ctrl) __builtin_bit_cast(float, __builtin_amdgcn_update_dpp(__builtin_bit_cast(int, v), __builtin_bit_cast(int, v), ctrl, 0xf, 0xf, false))
__device__ __forceinline__ float row16_allsum(float v) { v += DPPF(v, 0x128); v += DPPF(v, 0x124); v += DPPF(v, 0x122); v += DPPF(v, 0x121); return v; }
__device__ __forceinline__ float row16_allmax(float v) { v = fmaxf(v, DPPF(v, 0x128)); v = fmaxf(v, DPPF(v, 0x124)); v = fmaxf(v, DPPF(v, 0x122)); v = fmaxf(v, DPPF(v, 0x121)); return v; }
__device__ __forceinline__ int wave_incl_scan(int v) {
    v += __builtin_amdgcn_update_dpp(0, v, 0x111, 0xf, 0xf, false);
    v += __builtin_amdgcn_update_dpp(0, v, 0x112, 0xf, 0xf, false);
    v += __builtin_amdgcn_update_dpp(0, v, 0x114, 0xf, 0xf, false);
    v += __builtin_amdgcn_update_dpp(0, v, 0x118, 0xf, 0xf, false);
    v += __builtin_amdgcn_update_dpp(0, v, 0x142, 0xa, 0xf, false);
    v += __builtin_amdgcn_update_dpp(0, v, 0x143, 0xc, 0xf, false);
    return v;
}
__device__ __forceinline__ unsigned wave_or(unsigned x) {
    int v = (int)x;
    v |= __builtin_amdgcn_update_dpp(0, v, 0x111, 0xf, 0xf, false);
    v |= __builtin_amdgcn_update_dpp(0, v, 0x112, 0xf, 0xf, false);
    v |= __builtin_amdgcn_update_dpp(0, v, 0x114, 0xf, 0xf, false);
    v |= __builtin_amdgcn_update_dpp(0, v, 0x118, 0xf, 0xf, false);
    v |= __builtin_amdgcn_update_dpp(0, v, 0x142, 0xa, 0xf, false);
    v |= __builtin_amdgcn_update_dpp(0, v, 0x143, 0xc, 0xf, false);
    return (unsigned)__builtin_amdgcn_readlane(v, 63);
}
__device__ __forceinline__ unsigned wave_and(unsigned x) {
    int v = (int)x;
    v &= __builtin_amdgcn_update_dpp(-1, v, 0x111, 0xf, 0xf, false);
    v &= __builtin_amdgcn_update_dpp(-1, v, 0x112, 0xf, 0xf, false);
    v &= __builtin_amdgcn_update_dpp(-1, v, 0x114, 0xf, 0xf, false);
    v &= __builtin_amdgcn_update_dpp(-1, v, 0x118, 0xf, 0xf, false);
    v &= __builtin_amdgcn_update_dpp(-1, v, 0x142, 0xa, 0xf, false);
    v &= __builtin_amdgcn_update_dpp(-1, v, 0x143, 0xc, 0xf, false);
    return (unsigned)__builtin_amdgcn_readlane(v, 63);
}
__device__ __forceinline__ unsigned key16(unsigned short u) { return (u & 0x8000u) ? ((~(unsigned)u) & 0xFFFFu) : ((unsigned)u | 0x8000u); }
__device__ __forceinline__ unsigned key32(unsigned u) { return (u & 0x80000000u) ? ~u : (u | 0x80000000u); }
__device__ __forceinline__ float dot8(h16x8 a, h16x8 b, float c) {
    c = __builtin_amdgcn_fdot2((h16x2){a[0], a[1]}, (h16x2){b[0], b[1]}, c, false);
    c = __builtin_amdgcn_fdot2((h16x2){a[2], a[3]}, (h16x2){b[2], b[3]}, c, false);
    c = __builtin_amdgcn_fdot2((h16x2){a[4], a[5]}, (h16x2){b[4], b[5]}, c, false);
    c = __builtin_amdgcn_fdot2((h16x2){a[6], a[7]}, (h16x2){b[6], b[7]}, c, false);
    return c;
}
#define LDS_FENCE() asm volatile("s_waitcnt lgkmcnt(0)" ::: "memory")

__device__ void peer_phase(const Params& p, LAS unsigned char* lds, unsigned* bar, unsigned& epoch) {
    unsigned char* ws = p.ws;
    const int tid = fresh_tid(), wid = __builtin_amdgcn_readfirstlane(tid >> 6), lane = tid & 63;
    const unsigned long long lm = (1ull << lane) - 1ull;
    LAS unsigned char* wl = lds + wid * 11264;
    LAS float* s_top = (LAS float*)(wl);
    LAS int* i_top = (LAS int*)(wl + 1024);
    LAS int* ex = (LAS int*)(wl + 2048);
    LAS float* sc = (LAS float*)(wl + 2560);
    LAS int* uns_m = (LAS int*)(wl + 3072);
    LAS float* uns_g = (LAS float*)(wl + 3584);
    LAS int* cnt = (LAS int*)(wl + 4096);
    LAS int* base = (LAS int*)(wl + 4352);
    const int lead = (wid >= 4) ? 1 : 0;
    const unsigned short* SC = (const unsigned short*)(ws + OFF_SC16);
    const h16* H2 = (const h16*)(ws + OFF_R1);
    const unsigned char* U4 = ws + OFF_U8;
    const unsigned char* V8 = ws + OFF_V8;
    const float* USC = (const float*)(ws + OFF_USC);
    const float* VSC = (const float*)(ws + OFF_VSC);
    const float* mod = (const float*)(ws + OFF_MOD);
    const int grp = lane >> 4, li = lane & 15;
    for (int tg = blockIdx.x; tg < 256; tg += gridDim.x) {
        for (int it5 = 0; it5 < 5; ++it5) {
          if (it5 < 4) {
            const int round = it5;
            const size_t tok0 = (size_t)tg * 128 + wid * 16 + round * 4;
            LAS unsigned short* se = (LAS unsigned short*)(wl + 4608 + (round & 1) * 3072);
            LAS float* sw = (LAS float*)(wl + 4608 + (round & 1) * 3072 + 1024);
            for (int tt = 0; tt < 4; ++tt) {
                const size_t tok = tok0 + tt;
                cnt[lane] = 0;
                for (int L0 = 0; L0 < 16; L0 += 4) {
                    unsigned short ra[4], rb[4]; unsigned ka[4], kb[4], T[4];
#pragma unroll
                    for (int q = 0; q < 4; ++q) {
                        const unsigned short* sr = SC + tok * 2048 + (L0 + q) * 128;
                        ra[q] = sr[lane]; rb[q] = sr[64 + lane];
                        ka[q] = key16(ra[q]); kb[q] = key16(rb[q]); T[q] = 0;
                    }
                    for (int bit = 15; bit >= 0; --bit) {
#pragma unroll
                        for (int q = 0; q < 4; ++q) {
                            const unsigned cand = T[q] | (1u << bit);
                            const int cn = __popcll(__ballot(ka[q] >= cand)) + __popcll(__ballot(kb[q] >= cand));
                            T[q] = (cn >= 16) ? cand : T[q];
                        }
                    }
#pragma unroll
                    for (int q = 0; q < 4; ++q) {
                        const int L = L0 + q;
                        const int cnt_gt = __popcll(__ballot(ka[q] > T[q])) + __popcll(__ballot(kb[q] > T[q]));
                        const int need = 16 - cnt_gt;
                        const unsigned long long ea = __ballot(ka[q] == T[q]), eb = __ballot(kb[q] == T[q]);
                        const int ra_eq = __popcll(ea & lm), rb_eq = __popcll(ea) + __popcll(eb & lm);
                        const bool sa = (ka[q] > T[q]) || (ka[q] == T[q] && ra_eq < need);
                        const bool sb = (kb[q] > T[q]) || (kb[q] == T[q] && rb_eq < need);
                        const unsigned long long ma = __ballot(sa), mb = __ballot(sb);
                        const int pa = __popcll(ma & lm), pb = __popcll(ma) + __popcll(mb & lm);
                        if (sa) { s_top[L * 16 + pa] = (float)__builtin_bit_cast(h16, ra[q]); i_top[L * 16 + pa] = lane; }
                        if (sb) { s_top[L * 16 + pb] = (float)__builtin_bit_cast(h16, rb[q]); i_top[L * 16 + pb] = 64 + lane; }
                    }
                }
                LDS_FENCE();
                for (int h0 = 0; h0 < 8; h0 += 4) {
                    float cv[4][4]; unsigned kk[4][4], T[4];
#pragma unroll
                    for (int q = 0; q < 4; ++q) {
                        const int h = h0 + q;
                        const float bj = s_top[(2 * h + 1) * 16 + li];
#pragma unroll
                        for (int m = 0; m < 4; ++m) { cv[q][m] = s_top[(2 * h) * 16 + grp + 4 * m] + bj; kk[q][m] = key32(__builtin_bit_cast(unsigned, cv[q][m])); }
                        T[q] = 0;
                    }
                    unsigned om = 0, am = 0xFFFFFFFFu;
#pragma unroll
                    for (int q = 0; q < 4; ++q)
#pragma unroll
                        for (int m = 0; m < 4; ++m) { om |= kk[q][m]; am &= kk[q][m]; }
                    om = wave_or(om); am = wave_and(am);
                    om &= ~am;
                    while (om) {
                        const int bit = 31 - __builtin_clz(om);
                        om &= ~(1u << bit);
#pragma unroll
                        for (int q = 0; q < 4; ++q) {
                            const unsigned cand = T[q] | (1u << bit);
                            int cn = 0;
#pragma unroll
                            for (int m = 0; m < 4; ++m) cn += __popcll(__ballot((kk[q][m] & ~am) >= cand));
                            T[q] = (cn >= 16) ? cand : T[q];
                        }
                    }
#pragma unroll
                    for (int q = 0; q < 4; ++q) T[q] |= am;
#pragma unroll
                    for (int q = 0; q < 4; ++q) {
                        const int h = h0 + q;
                        int cnt_gt = 0;
#pragma unroll
                        for (int m = 0; m < 4; ++m) cnt_gt += __popcll(__ballot(kk[q][m] > T[q]));
                        const int need = 16 - cnt_gt;
                        int eq_before = 0, sel_before = 0;
#pragma unroll
                        for (int m = 0; m < 4; ++m) {
                            const unsigned long long em = __ballot(kk[q][m] == T[q]);
                            const int myeq = eq_before + __popcll(em & lm);
                            const bool sel = (kk[q][m] > T[q]) || (kk[q][m] == T[q] && myeq < need);
                            const unsigned long long sm = __ballot(sel);
                            const int pos = sel_before + __popcll(sm & lm);
                            if (sel) {
                                ex[h * 16 + pos] = i_top[(2 * h) * 16 + grp + 4 * m] * 128 + i_top[(2 * h + 1) * 16 + li];
                                sc[h * 16 + pos] = cv[q][m];
                            }
                            eq_before += __popcll(em); sel_before += __popcll(sm);
                        }
                    }
                }
                LDS_FENCE();
#pragma unroll
                for (int half = 0; half < 2; ++half) {
                    const int e = half * 64 + lane;
                    const float v = sc[e];
                    const float mx = row16_allmax(v);
                    const float pe = __expf(v - mx);
                    const float sm = row16_allsum(pe);
                    const float gate = pe * __builtin_amdgcn_rcpf(sm);
                    const int eid = ex[e];
                    const int pos = __hip_atomic_fetch_add(cnt + (eid >> 8), 1, __ATOMIC_RELAXED, __HIP_MEMORY_SCOPE_WORKGROUP);
                    uns_m[e] = eid | (pos << 14); uns_g[e] = gate;
                }
                LDS_FENCE();
                {
                    const int c = cnt[lane];
                    const int incl = wave_incl_scan(c);
                    base[lane] = incl - c;
                    LDS_FENCE();
#pragma unroll
                    for (int i = 0; i < 2; ++i) {
                        const int rm = uns_m[i * 64 + lane]; const float rg = uns_g[i * 64 + lane];
                        const int eid = rm & 16383, pos = rm >> 14;
                        const int dst = tt * 128 + base[eid >> 8] + pos;
                        se[dst] = (unsigned short)eid; sw[dst] = rg;
                    }
                    LDS_FENCE();
                }
            }
          }
          const int round = it5 - lead;
          if (round >= 0 && round < 4) {
            const size_t tok0 = (size_t)tg * 128 + wid * 16 + round * 4;
            LAS unsigned short* se = (LAS unsigned short*)(wl + 4608 + (round & 1) * 3072);
            LAS float* sw = (LAS float*)(wl + 4608 + (round & 1) * 3072 + 1024);
            const size_t tokg = tok0 + grp;
            const LAS unsigned short* me = se + grp * 128; LAS float* mw = sw + grp * 128;
            {
                const int li = launder(tid) & 15;
                h16x8 xr[2][4];
#pragma unroll
                for (int c = 0; c < 2; ++c)
#pragma unroll
                    for (int j = 0; j < 4; ++j) xr[c][j] = *(const h16x8*)(H2 + tokg * 1024 + c * 512 + li * 32 + 8 * j);
                float acc[64];
#pragma unroll
                for (int i = 0; i < 64; ++i) acc[i] = 0.f;
                i32x4 ru[2][2], rv[2][4]; float su[2], sv[2];
#define ELD(J, S_) do { const int e_ = me[(S_)]; const unsigned char* rp_ = U4 + (size_t)e_ * 1536 + li * 16; \
        ru[J][0] = *(const i32x4*)rp_; ru[J][1] = *(const i32x4*)(rp_ + 256); \
        _Pragma("unroll") for (int c = 0; c < 4; ++c) rv[J][c] = *(const i32x4*)(rp_ + 512 + c * 256); \
        { const f32x2 s2_ = *(const f32x2*)(USC + 2 * e_); su[J] = s2_.x; sv[J] = s2_.y; } } while (0)
#define ECP(J, S_) do { float d = 0.f; \
        _Pragma("unroll") for (int c = 0; c < 2; ++c) _Pragma("unroll") for (int k = 0; k < 4; ++k) { const h16x8 xv = xr[c][k]; const int w_ = ru[J][c][k]; \
            d = __builtin_amdgcn_fdot2(__builtin_amdgcn_cvt_scalef32_pk_f16_fp4(w_, 1.0f, 0), (h16x2){xv[0], xv[1]}, d, false); \
            d = __builtin_amdgcn_fdot2(__builtin_amdgcn_cvt_scalef32_pk_f16_fp4(w_, 1.0f, 1), (h16x2){xv[2], xv[3]}, d, false); \
            d = __builtin_amdgcn_fdot2(__builtin_amdgcn_cvt_scalef32_pk_f16_fp4(w_, 1.0f, 2), (h16x2){xv[4], xv[5]}, d, false); \
            d = __builtin_amdgcn_fdot2(__builtin_amdgcn_cvt_scalef32_pk_f16_fp4(w_, 1.0f, 3), (h16x2){xv[6], xv[7]}, d, false); } \
        d = row16_allsum(d); \
        const float wt_ = mw[(S_)] * gelu_tanh(d * su[J]) * sv[J]; \
        _Pragma("unroll") for (int c = 0; c < 4; ++c) _Pragma("unroll") for (int k = 0; k < 4; ++k) { \
            const f32x2 lo = __builtin_amdgcn_cvt_pk_f32_fp8(rv[J][c][k], false), hi = __builtin_amdgcn_cvt_pk_f32_fp8(rv[J][c][k], true); \
            acc[c * 16 + 4 * k] += wt_ * lo.x; acc[c * 16 + 4 * k + 1] += wt_ * lo.y; acc[c * 16 + 4 * k + 2] += wt_ * hi.x; acc[c * 16 + 4 * k + 3] += wt_ * hi.y; } } while (0)
                ELD(0, 0); ELD(1, 1);
#pragma unroll 1
                for (int s = 0; s < 128; s += 2) {
                    ECP(0, s);     if (s + 2 < 128) ELD(0, s + 2);
                    ECP(1, s + 1); if (s + 3 < 128) ELD(1, s + 3);
                }
#undef ELD
#undef ECP
                float* xo = p.out + tokg * 1024 + li * 16;
                const h16* x1h = (const h16*)(ws + OFF_X1H) + tokg * 1024 + li * 16;
                const int b = (int)(tokg >> 11);
                const float* g2 = mod + (size_t)b * 6144 + 5 * 1024 + li * 16;
                const float* fg = p.in[I_FG] + li * 16;
                float ss = 0.f;
#pragma unroll
                for (int c = 0; c < 4; ++c) {
#pragma unroll
                    for (int q4 = 0; q4 < 4; ++q4) {
                        const h16x4 xh_ = *(const h16x4*)(x1h + c * 256 + q4 * 4);
                        const f32x4 xv = (f32x4){(float)xh_[0], (float)xh_[1], (float)xh_[2], (float)xh_[3]}, gv = *(const f32x4*)(g2 + c * 256 + q4 * 4);
#pragma unroll
                        for (int j = 0; j < 4; ++j) { const float t = xv[j] + gv[j] * acc[c * 16 + q4 * 4 + j]; acc[c * 16 + q4 * 4 + j] = t; ss += t * t; }
                    }
                    asm volatile("" : "+v"(ss) :: "memory");
                }
                ss = row16_allsum(ss);
                const float r = rsqrtf(ss * (1.0f / 1024.0f) + 1e-6f);
#pragma unroll
                for (int c = 0; c < 4; ++c) {
#pragma unroll
                    for (int q4 = 0; q4 < 4; ++q4) {
                        const f32x4 fv = *(const f32x4*)(fg + c * 256 + q4 * 4);
                        f32x4 ov;
#pragma unroll
                        for (int j = 0; j < 4; ++j) ov[j] = acc[c * 16 + q4 * 4 + j] * r * fv[j];
                        *(f32x4*)(xo + c * 256 + q4 * 4) = ov;
                    }
                    asm volatile("" ::: "memory");
                }
            }
            LDS_FENCE();
          }
        }
    }
}

__global__ void __launch_bounds__(512, 2) mega(Params p) {
    extern __shared__ __attribute__((aligned(16))) unsigned char shm[];
    LAS unsigned char* lds = (LAS unsigned char*)shm;
    cg::grid_group grid = cg::this_grid();
    unsigned char* ws = p.ws;
    const int G = (int)gridDim.x, c = (int)blockIdx.x;
    unsigned* bar = (unsigned*)(ws + OFF_BAR); unsigned epoch = 0;
    volatile LAS unsigned* xst = (volatile LAS unsigned*)(lds + (LDS_BYTES - 16));
    if (threadIdx.x < 2) xst[threadIdx.x] = 0u;
    __syncthreads();
    const XcdBarrier xb = xcd_barrier_post(bar, xst);

    if (p.ws == nullptr) grid.sync();
    phase0(p, (float*)shm);
    xcd_barrier(xb);
    phase1(p, (float*)shm);
    xcd_barrier(xb);
    {
        pg8::StaticOrder S; S.init(NTOK, INC, G, c);
        pg8::Gemm g{ws + OFF_R1, ws + OFF_WINT, 1024, 1024, NTOK, INC, 1024, 0};
        EpiIn E{(h16*)(ws + OFF_QB), (h16*)(ws + OFF_KB), (h16*)(ws + OFF_VT), (h16*)(ws + OFF_GUV), (h16*)(ws + OFF_GATES)};
        pg8::gemm_phase(lds, g, S, E);
        pg8::StaticOrder S2; S2.init(NCTXT, 1024, G, c);
        pg8::Gemm g2{ws + OFF_HC, ws + OFF_WINT + (size_t)512 * 1024 * 2, 1024, 1024, NCTXT, 1024, 1024, 0};
        EpiCtx E2{(h16*)(ws + OFF_KC), (h16*)(ws + OFF_VCT)};
        pg8::gemm_phase(lds, g2, S2, E2);
    }
    xcd_barrier(xb);
    {
        for (int rep3 = 0; rep3 < REP_P3; ++rep3) {
        for (int u = c; u < 512; u += G) attn_unit(p, u);
        for (int n = c; n < 256; n += G) sgu_unit(p, n, lds);
        }
    }
    xcd_barrier(xb);
    {
        pg8::StaticOrder S; S.init(NTOK, 1024, G, c);
        pg8::Gemm ga{ws + OFF_R1, ws + OFF_WPAT, 1024, 512, NTOK, 1024, 512, 0};
        EpiM1 E1{(h16*)(ws + OFF_M1), (const h16*)(ws + OFF_GATES)};
        pg8::gemm_phase(lds, ga, S, E1);
        pg8::Gemm gb{ws + OFF_R1 + 1024, ws + OFF_WPBT, 1024, 512, NTOK, 1024, 512, 0};
        EpiM2 E2{(const h16*)(ws + OFF_M1), (const h16*)(ws + OFF_GATES), (h16*)(ws + OFF_MM)};
        pg8::gemm_phase(lds, gb, S, E2);
    }
    xcd_barrier(xb);
    {
        pg8::StaticOrder S; S.init(NTOK, 1024, G, c);
        pg8::Gemm g{ws + OFF_MM, ws + OFF_WOUTT, 1024, 1024, NTOK, 1024, 1024, 0};
        EpiX1 E{p.in[I_X], (const float*)(ws + OFF_MOD), (h16*)(ws + OFF_X1H)};
        pg8::gemm_phase(lds, g, S, E);
    }
    xcd_barrier(xb);
    phase6(p, (float*)shm);
    xcd_barrier(xb);
    {
        pg8::StaticOrder S; S.init(NTOK, 2048, G, c);
        pg8::Gemm g{ws + OFF_R1, ws + OFF_WQT, 1024, 1024, NTOK, 2048, 1024, 0};
        EpiH16 E{(h16*)(ws + OFF_SC16), 2048};
        pg8::gemm_phase(lds, g, S, E);
    }
    xcd_barrier(xb);
    peer_phase(p, lds, bar, epoch);
}

extern "C" void kernel_launch(void* const* d_in, const int* in_sizes, int n_in, void* d_out, int out_size, void* d_ws, size_t ws_size, hipStream_t stream) {
    static int grid_blocks = 0;
    if (!grid_blocks) {
        int dev = 0, cus = 0, per_cu = 0;
        hipGetDevice(&dev);
        hipDeviceGetAttribute(&cus, hipDeviceAttributeMultiprocessorCount, dev);
        hipFuncSetAttribute((const void*)mega, hipFuncAttributeMaxDynamicSharedMemorySize, LDS_BYTES);
        hipOccupancyMaxActiveBlocksPerMultiprocessor(&per_cu, (const void*)mega, 512, LDS_BYTES);
        if (per_cu < 1) per_cu = 1;
        grid_blocks = cus * per_cu;
        if (ws_size < WS_END) fprintf(stderr, "kernel_launch: workspace too small: %zu < %zu\n", ws_size, (size_t)WS_END);
    }
    hipMemsetAsync((unsigned char*)d_ws + OFF_BAR, 0, 16384, stream);
    Params p{};
    for (int i = 0; i < 21; ++i) p.in[i] = (const float*)d_in[i];
    p.out = (float*)d_out; p.ws = (unsigned char*)d_ws;
    void* args[] = {&p};
    hipError_t e = hipLaunchCooperativeKernel((const void*)mega, dim3(grid_blocks), dim3(512), args, LDS_BYTES, stream);
    if (e != hipSuccess) fprintf(stderr, "cooperative launch failed: %s (grid %d)\n", hipGetErrorString(e), grid_blocks);
}
```

```cpp
#include <hip/hip_runtime.h>
#include <hip/hip_cooperative_groups.h>
#include <cstdio>
namespace cg = cooperative_groups;

#define LAS __attribute__((address_space(3)))
typedef _Float16 h16;
typedef _Float16 h16x2 __attribute__((ext_vector_type(2)));
typedef _Float16 h16x4 __attribute__((ext_vector_type(4)));
typedef _Float16 h16x8 __attribute__((ext_vector_type(8)));
typedef float f32x4 __attribute__((ext_vector_type(4)));
typedef float f32x2 __attribute__((ext_vector_type(2)));
typedef int i32x4 __attribute__((ext_vector_type(4)));
typedef int i32x2 __attribute__((ext_vector_type(2)));

constexpr int NTOK = 32768, DM = 1024, NCTXT = 4096, INC = 4608, SEQ = 2048, CTXL = 256;
constexpr int LDS_BYTES = 144 * 1024;
#ifndef REP_SEL
#define REP_SEL 1
#endif
#ifndef REP_GATH
#define REP_GATH 1
#endif
#ifndef REP_P3
#define REP_P3 1
#endif

constexpr size_t al256(size_t x) { return (x + 255) & ~(size_t)255; }
constexpr size_t OFF_WINT = 0;
constexpr size_t OFF_WPAT = OFF_WINT + (size_t)INC * DM * 2;
constexpr size_t OFF_WPBT = OFF_WPAT + (size_t)1024 * 512 * 2;
constexpr size_t OFF_WOUTT = OFF_WPBT + (size_t)1024 * 512 * 2;
constexpr size_t OFF_WQT = OFF_WOUTT + (size_t)1024 * 1024 * 2;
constexpr size_t OFF_BD = OFF_WQT + (size_t)2048 * 1024 * 2;
constexpr size_t OFF_U16 = OFF_BD + (size_t)2048 * 256 * 2;
constexpr size_t OFF_V16 = OFF_U16 + (size_t)16384 * 1024 * 2;
constexpr size_t OFF_WS16 = OFF_V16 + (size_t)16384 * 1024 * 2;
constexpr size_t OFF_MODP = OFF_WS16 + (size_t)8 * 128 * 128 * 2;
constexpr size_t OFF_MOD = OFF_MODP + (size_t)16 * 17 * 6144 * 4;
constexpr size_t OFF_R1 = al256(OFF_MOD + (size_t)17 * 6144 * 4);
constexpr size_t OFF_QB = OFF_R1 + (size_t)NTOK * DM * 2;
constexpr size_t OFF_KB = OFF_QB + (size_t)NTOK * 512 * 2;
constexpr size_t OFF_VT = OFF_KB + (size_t)NTOK * 512 * 2;
constexpr size_t OFF_GUV = OFF_VT + (size_t)NTOK * 512 * 2;
constexpr size_t OFF_GATES = OFF_GUV + (size_t)NTOK * 1024 * 2;
constexpr size_t OFF_MM = OFF_GATES + (size_t)NTOK * 2048 * 2;
constexpr size_t OFF_BAR = OFF_MM + (size_t)NTOK * DM * 2;
constexpr size_t WS_END = OFF_BAR + 16384;
constexpr size_t OFF_U8 = OFF_U16;
constexpr size_t OFF_USC = OFF_V16;
constexpr size_t OFF_V8 = OFF_V16;
constexpr size_t OFF_VSC = OFF_V16 + (size_t)16384 * 1024;
constexpr size_t OFF_M1 = OFF_QB;
constexpr size_t OFF_SC16 = OFF_QB;
constexpr size_t OFF_Q16 = OFF_GATES;
constexpr size_t OFF_X1H = OFF_GATES;
constexpr size_t OFF_HC = OFF_MM;
constexpr size_t OFF_KC = OFF_HC + (size_t)NCTXT * DM * 2;
constexpr size_t OFF_VCT = OFF_KC + (size_t)NCTXT * 512 * 2;
static_assert(OFF_M1 + (size_t)NTOK * DM * 4 <= OFF_GATES, "m1 alias");
static_assert(WS_END <= (size_t)512 * 1024 * 1024, "workspace");

struct Params {
    const float* in[21];
    float* out;
    unsigned char* ws;
};
enum { I_X = 0, I_C, I_CTX, I_CCTX, I_ADAW, I_ADAB, I_N1G, I_N2G, I_WIN, I_RPB, I_LNG, I_GMWS, I_GMBS, I_WPA, I_WPB, I_WOUT, I_WQ, I_KEYS, I_PU, I_PV, I_FG };

__device__ __forceinline__ int launder(int x) { asm volatile("" : "+v"(x)); return x; }
__device__ __forceinline__ int fresh_tid() { int t = threadIdx.x; asm volatile("" : "+v"(t)); return t; }

__device__ __forceinline__ float sigmoidf_(float x) { return __builtin_amdgcn_rcpf(1.0f + __expf(-x)); }
__device__ __forceinline__ float gelu_tanh(float x) {
    const float t = 0.7978845608028654f * (x + 0.044715f * x * x * x);
    return x * __builtin_amdgcn_rcpf(1.0f + __expf(-2.0f * t));
}
__device__ __forceinline__ float silu_(float x) { return x * __builtin_amdgcn_rcpf(1.0f + __expf(-x)); }
__device__ __forceinline__ float wave_sum(float v) {
#pragma unroll
    for (int o = 32; o > 0; o >>= 1) v += __shfl_xor(v, o);
    return v;
}
__device__ __forceinline__ h16x8 pack8(f32x4 a, f32x4 b) {
    h16x8 o;
    o[0] = (h16)a[0]; o[1] = (h16)a[1]; o[2] = (h16)a[2]; o[3] = (h16)a[3];
    o[4] = (h16)b[0]; o[5] = (h16)b[1]; o[6] = (h16)b[2]; o[7] = (h16)b[3];
    return o;
}


__device__ __forceinline__ void grid_bar(unsigned* ctr, unsigned& epoch, unsigned nblk) {
    __syncthreads();
    epoch += 1u;
    if (threadIdx.x == 0) {
        __builtin_amdgcn_fence(__ATOMIC_RELEASE, "agent");
        asm volatile("s_waitcnt vmcnt(0)" ::: "memory");
        __hip_atomic_fetch_add(ctr, 1u, __ATOMIC_RELAXED, __HIP_MEMORY_SCOPE_AGENT);
        const unsigned target = epoch * nblk;
        unsigned spins = 0;
        while (__hip_atomic_load(ctr, __ATOMIC_RELAXED, __HIP_MEMORY_SCOPE_AGENT) < target) { __builtin_amdgcn_s_sleep(2); if (++spins > (1u << 24)) break; }
        __builtin_amdgcn_fence(__ATOMIC_ACQUIRE, "agent");
        asm volatile("s_waitcnt vmcnt(0)" ::: "memory");
    }
    __syncthreads();
}


#define XB_TMO      128
#define XB_XCNT(j)  (256  + 64 * (j))
#define XB_XSUB(j)  (1280 + 64 * (j))
#define XB_XGEN(j)  (2304 + 64 * (j))
#define XB_TOP      3328
#define XB_TOPGEN   3392
#define XCD_BAR_WORDS 3456
#define XB_SPIN_CAP (1u << 20)
__device__ __forceinline__ unsigned xb_ld(unsigned* p)              { return __hip_atomic_load(p, __ATOMIC_RELAXED, __HIP_MEMORY_SCOPE_AGENT); }
__device__ __forceinline__ unsigned xb_add(unsigned* p, unsigned v) { return __hip_atomic_fetch_add(p, v, __ATOMIC_RELAXED, __HIP_MEMORY_SCOPE_AGENT); }
__device__ __forceinline__ unsigned xb_xcc_id() { return (unsigned)__builtin_amdgcn_s_getreg((3 << 11) | 20) & 0xFu; }
#define XB_SPIN(cond, bar) do { unsigned _sp = 0; while (cond) { __builtin_amdgcn_s_sleep(1); \
    if ((++_sp & 255u) == 0u) { if (xb_ld(&(bar)[XB_TMO])) break; if (_sp > XB_SPIN_CAP) { atomicAdd(&(bar)[XB_TMO], 1u); break; } } } } while (0)
struct XcdBarrier { unsigned* bar; unsigned x; volatile LAS unsigned* st; };
__device__ __forceinline__ XcdBarrier xcd_barrier_post(unsigned* bar, volatile LAS unsigned* st) {
    XcdBarrier b; b.bar = bar; b.x = xb_xcc_id(); b.st = st;
    if (threadIdx.x == 0) (void)xb_add(&bar[XB_XCNT(b.x)], 1u);
    return b;
}
__device__ __forceinline__ void xcd_barrier_complete(unsigned* bar, unsigned x, unsigned& nloc, unsigned& nx) {
    const unsigned G = gridDim.x * gridDim.y * gridDim.z;
    unsigned sum, cnt, mine, sp = 0u;
    for (;;) {
        sum = 0u; cnt = 0u; mine = 0u;
#pragma unroll
        for (unsigned j = 0; j < 16; ++j) { const unsigned c = xb_ld(&bar[XB_XCNT(j)]); sum += c; cnt += (c > 0u) ? 1u : 0u; mine = (j == x) ? c : mine; }
        if (sum == G) break;
        __builtin_amdgcn_s_sleep(1);
        if ((++sp & 255u) == 0u) { if (xb_ld(&bar[XB_TMO])) break; if (sp > XB_SPIN_CAP) { atomicAdd(&bar[XB_TMO], 1u); break; } }
    }
    nloc = mine > 0u ? mine : 1u; nx = cnt > 0u ? cnt : 1u;
}
__device__ __forceinline__ void xcd_barrier(const XcdBarrier& b) {
    asm volatile("s_waitcnt vmcnt(0)" ::: "memory");
    __syncthreads();
    if (threadIdx.x == 0) {
        unsigned* bar = b.bar;
        __builtin_amdgcn_s_waitcnt(0);
        unsigned nloc = b.st[0], nx = b.st[1];
        if (nloc == 0u) { xcd_barrier_complete(bar, b.x, nloc, nx); b.st[0] = nloc; b.st[1] = nx; }
        const unsigned old = xb_add(&bar[XB_XSUB(b.x)], 1u);
        const unsigned gen = old / nloc;
        if (old + 1u == (gen + 1u) * nloc) {
            __builtin_amdgcn_fence(__ATOMIC_RELEASE, "agent");
            asm volatile("s_waitcnt vmcnt(0)" ::: "memory");
            const unsigned og = xb_add(&bar[XB_TOP], 1u);
            const unsigned tg = og / nx;
            if (og + 1u == (tg + 1u) * nx) xb_add(&bar[XB_TOPGEN], 1u);
            else XB_SPIN(xb_ld(&bar[XB_TOPGEN]) == tg, bar);
            __builtin_amdgcn_fence(__ATOMIC_ACQUIRE, "agent");
            xb_add(&bar[XB_XGEN(b.x)], 1u);
            asm volatile("s_waitcnt vmcnt(0)" ::: "memory");
        } else {
            XB_SPIN(xb_ld(&bar[XB_XGEN(b.x)]) == gen, bar);
            __builtin_amdgcn_fence(__ATOMIC_ACQUIRE, "agent");
            asm volatile("s_waitcnt vmcnt(0)" ::: "memory");
        }
    }
    __syncthreads();
}

namespace pg8 {
constexpr int BM = 256, BK = 64, HALF = 128, HTB = HALF * BK * 2, STAGE_BYTES = 8 * HTB, NXCD = 8, WGM = 8;
__device__ __forceinline__ int lds_byte(int r, int c) { const int st = (r >> 4) * 2 + (c >> 5), rr = r & 15, cc = c & 31, ob = rr * 64 + cc * 2; return st * 1024 + (ob ^ (((ob >> 9) & 1) << 5)); }
__device__ __forceinline__ void stage_rc(int b, int& R, int& C) { const int st = b / 1024, sb = b % 1024, swz = sb ^ (((sb >> 9) & 1) << 5); R = (st >> 1) * 16 + swz / 64; C = (st & 1) * 32 + (swz % 64) / 2; }
__device__ __forceinline__ int perm32(int rho) { const int n = rho >> 4, i = rho & 15; return 8 * (i >> 2) + 4 * n + (i & 3); }

struct Unit { int pm, pn; };
struct Gemm { const void* A; const void* Bt; int lda, ldb, M, N, K, a_pn_bytes; };

struct StaticOrder {
    int nM, nN, nwg, G, c;
    __device__ void init(int M, int N, int G_, int c_) { nM = M / BM; nN = N / BM; nwg = nM * nN; G = G_; c = c_; }
    __device__ bool next(int i, Unit& u) const {
        const long L = (long)i * G + c; if (L >= nwg) return false;
        int wgid = (int)L; { const int q = nwg / NXCD, r = nwg % NXCD, xcd = wgid % NXCD, off = wgid / NXCD; wgid = (xcd < r ? xcd * (q + 1) : r * (q + 1) + (xcd - r) * q) + off; }
        const int nig = WGM * nN, gid = wgid / nig, fm = gid * WGM, gsz = (nM - fm) < WGM ? (nM - fm) : WGM;
        u.pm = fm + ((wgid % nig) % gsz); u.pn = (wgid % nig) / gsz; return true;
    }
};

template <class Epi>
__device__ __forceinline__ void gemm_phase(LAS unsigned char* lds, const Gemm g, const StaticOrder& S, const Epi& E) {
    const int tid = fresh_tid(), wid = __builtin_amdgcn_readfirstlane(tid >> 6), lane = tid & 63, wr = wid >> 2, wc = wid & 3, fr = lane & 15, fq = lane >> 4;
    const int K = g.K, nt = K / BK;
    unsigned voffA[2], voffB[2];
#pragma unroll
    for (int i = 0; i < 2; ++i) { int R, C; stage_rc(tid * 16 + i * 8192, R, C); const int Rb = (R & ~31) + perm32(R & 31);
        voffA[i] = (unsigned)(R * g.lda + C) * 2u; voffB[i] = (unsigned)(Rb * g.ldb + C) * 2u; }
    const size_t kstep = (size_t)(BK * 2);
    const size_t hstepA = (size_t)HALF * g.lda * 2, hstepB = (size_t)HALF * g.ldb * 2;
    const size_t tstepA = 2 * hstepA, tstepB = 2 * hstepB;
    const unsigned ldsw = (unsigned)wid * 1024u;
    const int aoff = lds_byte(wr * 64 + fr, fq * 8), boff = lds_byte(wc * 32 + fr, fq * 8);
#define PG8_SA(b, h) (((b) * 2 + (h)) * HTB)
#define PG8_SB(b, h) ((4 + (b) * 2 + (h)) * HTB)
#define PG8_STAGE(bufoff, gbase, voff) do { _Pragma("unroll") for (int _i = 0; _i < 2; ++_i) \
        __builtin_amdgcn_global_load_lds((const unsigned*)((const char*)(gbase) + (voff)[_i]), (LAS unsigned*)(lds + (bufoff) + ldsw + _i * 8192), 16, 0, 0); } while (0)
#define PG8_LDA(dst, b, h) do { _Pragma("unroll") for (int m = 0; m < 4; ++m) _Pragma("unroll") for (int k = 0; k < 2; ++k) dst[m][k] = *(const LAS h16x8*)(lds + PG8_SA(b, h) + aoff + m * 2048 + k * 1024); } while (0)
#define PG8_LDB(dst, b, h) do { _Pragma("unroll") for (int n = 0; n < 2; ++n) _Pragma("unroll") for (int k = 0; k < 2; ++k) dst[n][k] = *(const LAS h16x8*)(lds + PG8_SB(b, h) + boff + n * 2048 + k * 1024); } while (0)
#define PG8_MMA(ai, bj, At, Bt) do { __builtin_amdgcn_s_setprio(1); _Pragma("unroll") for (int m = 0; m < 4; ++m) _Pragma("unroll") for (int n = 0; n < 2; ++n) _Pragma("unroll") for (int k = 0; k < 2; ++k) \
        acc[ai][bj][m][n] = __builtin_amdgcn_mfma_f32_16x16x32_f16(Bt[n][k], At[m][k], acc[ai][bj][m][n], 0, 0, 0); __builtin_amdgcn_s_setprio(0); } while (0)
#define PG8_WAIT_V(n) asm volatile("s_waitcnt vmcnt(" #n ")" ::: "memory")
#define PG8_WAIT_L(n) asm volatile("s_waitcnt lgkmcnt(" #n ")" ::: "memory")
#define PG8_BAR __builtin_amdgcn_s_barrier()
#define PG8_SCHED __builtin_amdgcn_sched_barrier(0)
    Unit cur, nxt; int ui = 0;
    if (!S.next(0, cur)) return;
    f32x4 acc[2][2][4][2];
#pragma unroll
    for (int a = 0; a < 2; ++a)
#pragma unroll
        for (int b = 0; b < 2; ++b)
#pragma unroll
            for (int m = 0; m < 4; ++m)
#pragma unroll
                for (int n = 0; n < 2; ++n) acc[a][b][m][n] = (f32x4){0.f, 0.f, 0.f, 0.f};
    h16x8 At[4][2], B0[2][2], B1[2][2];
    const char* cA = (const char*)g.A + (size_t)cur.pm * tstepA + (size_t)cur.pn * g.a_pn_bytes; const char* cB = (const char*)g.Bt + (size_t)cur.pn * tstepB;
    PG8_STAGE(PG8_SB(0, 0), cB, voffB); PG8_STAGE(PG8_SA(0, 0), cA, voffA); PG8_STAGE(PG8_SB(0, 1), cB + hstepB, voffB); PG8_STAGE(PG8_SA(0, 1), cA + hstepA, voffA);
    if (wr == 1) PG8_BAR;
    PG8_WAIT_V(4); PG8_BAR;
    PG8_STAGE(PG8_SB(1, 0), cB + kstep, voffB); PG8_STAGE(PG8_SA(1, 0), cA + kstep, voffA); PG8_STAGE(PG8_SB(1, 1), cB + hstepB + kstep, voffB);
    PG8_WAIT_V(6); PG8_BAR;
    for (;;) {
        const bool has_next = S.next(ui + 1, nxt);
        const char* nA = has_next ? (const char*)g.A + (size_t)nxt.pm * tstepA + (size_t)nxt.pn * g.a_pn_bytes : cA; const char* nB = has_next ? (const char*)g.Bt + (size_t)nxt.pn * tstepB : cB;
        for (int t = 0; t < nt; t += 2) {
            const bool last = (t == nt - 2);
            const char* a1 = cA + (size_t)(t + 1) * kstep;
            const char* a2 = last ? nA : cA + (size_t)(t + 2) * kstep; const char* b2 = last ? nB : cB + (size_t)(t + 2) * kstep;
            const char* a3 = a2 + kstep; const char* b3 = b2 + kstep;
            PG8_LDB(B0, 0, 0); PG8_SCHED; PG8_LDA(At, 0, 0); PG8_STAGE(PG8_SA(1, 1), a1 + hstepA, voffA);
            PG8_WAIT_L(8); PG8_BAR; PG8_WAIT_L(0); PG8_MMA(0, 0, At, B0); PG8_BAR; PG8_SCHED;
            PG8_LDB(B1, 0, 1); PG8_STAGE(PG8_SB(0, 0), b2, voffB);
            PG8_BAR; PG8_WAIT_L(0); PG8_MMA(0, 1, At, B1); PG8_BAR;
            PG8_LDA(At, 0, 1); PG8_STAGE(PG8_SA(0, 0), a2, voffA);
            PG8_BAR; PG8_WAIT_L(0); PG8_MMA(1, 0, At, B0); PG8_BAR; PG8_SCHED;
            PG8_STAGE(PG8_SB(0, 1), b2 + hstepB, voffB);
            PG8_WAIT_V(6); PG8_BAR; PG8_MMA(1, 1, At, B1); PG8_BAR;
            PG8_LDB(B0, 1, 0); PG8_SCHED; PG8_LDA(At, 1, 0); PG8_STAGE(PG8_SA(0, 1), a2 + hstepA, voffA);
            PG8_WAIT_L(8); PG8_BAR; PG8_WAIT_L(0); PG8_MMA(0, 0, At, B0); PG8_BAR; PG8_SCHED;
            PG8_LDB(B1, 1, 1); PG8_STAGE(PG8_SB(1, 0), b3, voffB);
            PG8_BAR; PG8_WAIT_L(0); PG8_MMA(0, 1, At, B1); PG8_BAR;
            PG8_LDA(At, 1, 1); PG8_STAGE(PG8_SA(1, 0), a3, voffA);
            PG8_BAR; PG8_WAIT_L(0); PG8_MMA(1, 0, At, B0); PG8_BAR; PG8_SCHED;
            PG8_STAGE(PG8_SB(1, 1), b3 + hstepB, voffB);
            PG8_WAIT_V(6); PG8_BAR; PG8_MMA(1, 1, At, B1); PG8_BAR;
        }
        E(acc, cur, wr, wc, fr, fq);
        if (!has_next) break;
#pragma unroll
        for (int a = 0; a < 2; ++a)
#pragma unroll
            for (int b = 0; b < 2; ++b)
#pragma unroll
                for (int m = 0; m < 4; ++m)
#pragma unroll
                    for (int n = 0; n < 2; ++n) acc[a][b][m][n] = (f32x4){0.f, 0.f, 0.f, 0.f};
        cur = nxt; cA = nA; cB = nB; ++ui;
    }
    PG8_WAIT_V(0);
    if (wr == 0) PG8_BAR;
    PG8_BAR;
#undef PG8_SA
#undef PG8_SB
#undef PG8_STAGE
#undef PG8_LDA
#undef PG8_LDB
#undef PG8_MMA
#undef PG8_WAIT_V
#undef PG8_WAIT_L
#undef PG8_BAR
#undef PG8_SCHED
}
}
typedef f32x4 AccT[2][2][4][2];

struct EpiIn {
    h16 *qb, *kb, *vt, *guv, *gates;
    __device__ __forceinline__ void operator()(const AccT& acc, const pg8::Unit& u, int wr, int wc, int fr, int fq) const {
        const int pn = u.pn;
        const int row0 = u.pm * 256 + wr * 64 + fr;
        const int cin = wc * 32 + 8 * fq;
        const int b = (u.pm * 256) >> 11, sb = ((u.pm * 256) & 2047) + wr * 64;
        if (pn < 2) {
            h16* base = qb + (size_t)row0 * 512 + pn * 256 + cin;
#pragma unroll
            for (int ai = 0; ai < 2; ++ai)
#pragma unroll
                for (int m = 0; m < 4; ++m)
#pragma unroll
                    for (int bj = 0; bj < 2; ++bj) *(h16x8*)(base + (ai * 128 + m * 16) * 512 + bj * 128) = pack8(acc[ai][bj][m][0], acc[ai][bj][m][1]);
        } else if (pn < 4) {
#pragma unroll
            for (int bj = 0; bj < 2; ++bj) {
                const int col = (pn & 1) * 256 + bj * 128 + cin, hd = col >> 6, d0 = col & 63;
                h16* base = kb + ((size_t)(b * 8 + hd) * 2048 + sb + fr) * 64 + d0;
#pragma unroll
                for (int ai = 0; ai < 2; ++ai)
#pragma unroll
                    for (int m = 0; m < 4; ++m) *(h16x8*)(base + (ai * 128 + m * 16) * 64) = pack8(acc[ai][bj][m][0], acc[ai][bj][m][1]);
            }
        } else if (pn < 6) {
#pragma unroll
            for (int bj = 0; bj < 2; ++bj) {
                const int cv = (pn - 4) * 256 + bj * 128 + cin, hd = cv >> 6, d0 = cv & 63;
                h16* base = vt + ((size_t)(b * 8 + hd) * 256 + (sb >> 3) + (fr >> 3)) * 512 + d0 * 8 + (fr & 7);
#pragma unroll
                for (int ai = 0; ai < 2; ++ai)
#pragma unroll
                    for (int m = 0; m < 4; ++m) {
                        h16* vp = base + (ai * 16 + m * 2) * 512;
                        const f32x4 v0 = acc[ai][bj][m][0], v1 = acc[ai][bj][m][1];
#pragma unroll
                        for (int i = 0; i < 4; ++i) { vp[i * 8] = (h16)v0[i]; vp[(i + 4) * 8] = (h16)v1[i]; }
                    }
            }
        } else if (pn < 10) {
            h16* base = guv + (size_t)row0 * 1024 + (pn - 6) * 256 + cin;
#pragma unroll
            for (int ai = 0; ai < 2; ++ai)
#pragma unroll
                for (int m = 0; m < 4; ++m)
#pragma unroll
                    for (int bj = 0; bj < 2; ++bj) {
                        f32x4 v0 = acc[ai][bj][m][0], v1 = acc[ai][bj][m][1];
#pragma unroll
                        for (int i = 0; i < 4; ++i) { v0[i] = gelu_tanh(v0[i]); v1[i] = gelu_tanh(v1[i]); }
                        *(h16x8*)(base + (ai * 128 + m * 16) * 1024 + bj * 128) = pack8(v0, v1);
                    }
        } else {
            h16* base = gates + (size_t)row0 * 2048 + (pn - 10) * 256 + cin;
#pragma unroll
            for (int ai = 0; ai < 2; ++ai)
#pragma unroll
                for (int m = 0; m < 4; ++m)
#pragma unroll
                    for (int bj = 0; bj < 2; ++bj) {
                        f32x4 v0 = acc[ai][bj][m][0], v1 = acc[ai][bj][m][1];
#pragma unroll
                        for (int i = 0; i < 4; ++i) { v0[i] = sigmoidf_(v0[i]); v1[i] = sigmoidf_(v1[i]); }
                        *(h16x8*)(base + (ai * 128 + m * 16) * 2048 + bj * 128) = pack8(v0, v1);
                    }
        }
    }
};
struct EpiCtx {
    h16 *kc, *vct;
    __device__ __forceinline__ void operator()(const AccT& acc, const pg8::Unit& u, int wr, int wc, int fr, int fq) const {
        const int pn = u.pn;
        const int cin = wc * 32 + 8 * fq;
        const int b = u.pm, sb = wr * 64;
        if (pn < 2) {
#pragma unroll
            for (int bj = 0; bj < 2; ++bj) {
                const int col = pn * 256 + bj * 128 + cin, hd = col >> 6, d0 = col & 63;
                h16* base = kc + ((size_t)(b * 8 + hd) * 256 + sb + fr) * 64 + d0;
#pragma unroll
                for (int ai = 0; ai < 2; ++ai)
#pragma unroll
                    for (int m = 0; m < 4; ++m) *(h16x8*)(base + (ai * 128 + m * 16) * 64) = pack8(acc[ai][bj][m][0], acc[ai][bj][m][1]);
            }
        } else {
#pragma unroll
            for (int bj = 0; bj < 2; ++bj) {
                const int cv = (pn - 2) * 256 + bj * 128 + cin, hd = cv >> 6, d0 = cv & 63;
                h16* base = vct + ((size_t)(b * 8 + hd) * 32 + (sb >> 3) + (fr >> 3)) * 512 + d0 * 8 + (fr & 7);
#pragma unroll
                for (int ai = 0; ai < 2; ++ai)
#pragma unroll
                    for (int m = 0; m < 4; ++m) {
                        h16* vp = base + (ai * 16 + m * 2) * 512;
                        const f32x4 v0 = acc[ai][bj][m][0], v1 = acc[ai][bj][m][1];
#pragma unroll
                        for (int i = 0; i < 4; ++i) { vp[i * 8] = (h16)v0[i]; vp[(i + 4) * 8] = (h16)v1[i]; }
                    }
            }
        }
    }
};
struct EpiM1 {
    h16* m1; const h16* gates;
    __device__ __forceinline__ void operator()(const AccT& acc, const pg8::Unit& u, int wr, int wc, int fr, int fq) const {
        const int row0 = u.pm * 256 + wr * 64 + fr, col0 = u.pn * 256 + wc * 32 + 8 * fq;
#pragma unroll
        for (int ai = 0; ai < 2; ++ai)
#pragma unroll
            for (int m = 0; m < 4; ++m) {
                const int row = row0 + ai * 128 + m * 16;
#pragma unroll
                for (int bj = 0; bj < 2; ++bj) {
                    const int col = col0 + bj * 128;
                    const h16x8 gt = *(const h16x8*)(gates + (size_t)row * 2048 + col);
                    f32x4 v0 = acc[ai][bj][m][0], v1 = acc[ai][bj][m][1];
#pragma unroll
                    for (int i = 0; i < 4; ++i) { v0[i] *= (float)gt[i]; v1[i] *= (float)gt[4 + i]; }
                    *(h16x8*)(m1 + (size_t)row * 1024 + col) = pack8(v0, v1);
                }
            }
    }
};
struct EpiM2 {
    const h16* m1; const h16* gates; h16* mm;
    __device__ __forceinline__ void operator()(const AccT& acc, const pg8::Unit& u, int wr, int wc, int fr, int fq) const {
        const int row0 = u.pm * 256 + wr * 64 + fr, col0 = u.pn * 256 + wc * 32 + 8 * fq;
#pragma unroll
        for (int ai = 0; ai < 2; ++ai)
#pragma unroll
            for (int m = 0; m < 4; ++m) {
                const int row = row0 + ai * 128 + m * 16;
#pragma unroll
                for (int bj = 0; bj < 2; ++bj) {
                    const int col = col0 + bj * 128;
                    const h16x8 gt = *(const h16x8*)(gates + (size_t)row * 2048 + 1024 + col);
                    const h16x8 mi = *(const h16x8*)(m1 + (size_t)row * 1024 + col);
                    f32x4 p0 = (f32x4){(float)mi[0], (float)mi[1], (float)mi[2], (float)mi[3]}, p1 = (f32x4){(float)mi[4], (float)mi[5], (float)mi[6], (float)mi[7]};
                    const f32x4 v0 = acc[ai][bj][m][0], v1 = acc[ai][bj][m][1];
#pragma unroll
                    for (int i = 0; i < 4; ++i) { p0[i] += v0[i] * (float)gt[i]; p1[i] += v1[i] * (float)gt[4 + i]; }
                    *(h16x8*)(mm + (size_t)row * 1024 + col) = pack8(p0, p1);
                }
            }
    }
};
struct EpiX1 {
    const float* x; const float* mod; h16* x1;
    __device__ __forceinline__ void operator()(const AccT& acc, const pg8::Unit& u, int wr, int wc, int fr, int fq) const {
        const int row0 = u.pm * 256 + wr * 64 + fr, col0 = u.pn * 256 + wc * 32 + 8 * fq;
        const int b = (u.pm * 256) >> 11;
#pragma unroll
        for (int bj = 0; bj < 2; ++bj) {
            const int col = col0 + bj * 128;
            const float* gp = mod + (size_t)b * 6144 + 2 * 1024 + col;
            const f32x4 g0 = *(const f32x4*)gp, g1 = *(const f32x4*)(gp + 4);
#pragma unroll
            for (int ai = 0; ai < 2; ++ai)
#pragma unroll
                for (int m = 0; m < 4; ++m) {
                    const int row = row0 + ai * 128 + m * 16;
                    const float* xi = x + (size_t)row * 1024 + col;
                    const f32x4 x0 = *(const f32x4*)xi, x1v = *(const f32x4*)(xi + 4);
                    *(h16x8*)(x1 + (size_t)row * 1024 + col) = pack8(x0 + g0 * acc[ai][bj][m][0], x1v + g1 * acc[ai][bj][m][1]);
                }
        }
    }
};
struct EpiH16 {
    h16* o; int ldc;
    __device__ __forceinline__ void operator()(const AccT& acc, const pg8::Unit& u, int wr, int wc, int fr, int fq) const {
        const int row0 = u.pm * 256 + wr * 64 + fr, col0 = u.pn * 256 + wc * 32 + 8 * fq;
#pragma unroll
        for (int ai = 0; ai < 2; ++ai)
#pragma unroll
            for (int m = 0; m < 4; ++m) {
                const int row = row0 + ai * 128 + m * 16;
#pragma unroll
                for (int bj = 0; bj < 2; ++bj)
                    *(h16x8*)(o + (size_t)row * ldc + col0 + bj * 128) = pack8(acc[ai][bj][m][0], acc[ai][bj][m][1]);
            }
    }
};

__device__ __forceinline__ void cvt_tile(const float* __restrict__ src, h16* __restrict__ dst, int tile) {
    const size_t i = (size_t)tile * 4096 + threadIdx.x * 8;
    const f32x4 a = *(const f32x4*)(src + i), b = *(const f32x4*)(src + i + 4);
    *(h16x8*)(dst + i) = pack8(a, b);
}
__device__ __forceinline__ void tr_tile(const float* __restrict__ src, h16* __restrict__ dst, int K, int N, int tile, float* lds) {
    const int ntn = N / 64, tk = tile / ntn, tn = tile % ntn, tid = threadIdx.x;
#pragma unroll
    for (int ps = 0; ps < 2; ++ps) {
        const int k = ps * 32 + (tid >> 4), n = (tid & 15) * 4;
        const f32x4 v = *(const f32x4*)(src + (size_t)(tk * 64 + k) * N + tn * 64 + n);
        lds[k * 65 + n] = v[0]; lds[k * 65 + n + 1] = v[1]; lds[k * 65 + n + 2] = v[2]; lds[k * 65 + n + 3] = v[3];
    }
    __syncthreads();
    {
        const int n = tid >> 3, ks = (tid & 7) * 8;
        h16x8 o;
#pragma unroll
        for (int i = 0; i < 8; ++i) o[i] = (h16)lds[(ks + i) * 65 + n];
        *(h16x8*)(dst + (size_t)(tn * 64 + n) * K + tk * 64 + ks) = o;
    }
    __syncthreads();
}
__device__ __forceinline__ void cvt8_rows(const float* __restrict__ src, unsigned char* __restrict__ dst, float* __restrict__ inv, int tile, int dstride = 1024) {
    const int wid = threadIdx.x >> 6, lane = threadIdx.x & 63;
    const size_t row = (size_t)tile * 8 + wid;
    const float* r = src + row * 1024 + lane * 16;
    f32x4 a[4]; float mx = 0.f;
#pragma unroll
    for (int i = 0; i < 4; ++i) { a[i] = *(const f32x4*)(r + 4 * i); mx = fmaxf(mx, fmaxf(fmaxf(fabsf(a[i][0]), fabsf(a[i][1])), fmaxf(fabsf(a[i][2]), fabsf(a[i][3])))); }
#pragma unroll
    for (int o = 32; o > 0; o >>= 1) mx = fmaxf(mx, __shfl_xor(mx, o));
    int ex2 = 0; float sc = 1.0f;
    if (mx > 0.f) { (void)frexpf(mx, &ex2); int k = 8 - ex2; k = k > 100 ? 100 : (k < -100 ? -100 : k); sc = ldexpf(1.0f, k); }
    i32x4 w;
#pragma unroll
    for (int i = 0; i < 4; ++i) {
        int pk = __builtin_amdgcn_cvt_pk_fp8_f32(a[i][0] * sc, a[i][1] * sc, 0, false);
        pk = __builtin_amdgcn_cvt_pk_fp8_f32(a[i][2] * sc, a[i][3] * sc, pk, true);
        w[i] = pk;
    }
    *(i32x4*)(dst + row * dstride + lane * 16) = w;
    if (lane == 0) inv[2 * row] = 1.0f / sc;
}
__device__ __forceinline__ void cvt4_rows(const float* __restrict__ src, unsigned char* __restrict__ dst, float* __restrict__ inv, int tile, int dstride = 512) {
    const int wid = threadIdx.x >> 6, lane = threadIdx.x & 63;
    const size_t row = (size_t)tile * 8 + wid;
    const float* r = src + row * 1024 + lane * 16;
    f32x4 a[4]; float mx = 0.f;
#pragma unroll
    for (int i = 0; i < 4; ++i) { a[i] = *(const f32x4*)(r + 4 * i); mx = fmaxf(mx, fmaxf(fmaxf(fabsf(a[i][0]), fabsf(a[i][1])), fmaxf(fabsf(a[i][2]), fabsf(a[i][3])))); }
#pragma unroll
    for (int o = 32; o > 0; o >>= 1) mx = fmaxf(mx, __shfl_xor(mx, o));
    const float sc = (mx > 1e-30f) ? 6.0f / mx : 1.0f;
    int w0 = 0, w1 = 0;
    w0 = __builtin_amdgcn_cvt_scalef32_pk_fp4_f32(w0, a[0][0] * sc, a[0][1] * sc, 1.0f, 0);
    w0 = __builtin_amdgcn_cvt_scalef32_pk_fp4_f32(w0, a[0][2] * sc, a[0][3] * sc, 1.0f, 1);
    w0 = __builtin_amdgcn_cvt_scalef32_pk_fp4_f32(w0, a[1][0] * sc, a[1][1] * sc, 1.0f, 2);
    w0 = __builtin_amdgcn_cvt_scalef32_pk_fp4_f32(w0, a[1][2] * sc, a[1][3] * sc, 1.0f, 3);
    w1 = __builtin_amdgcn_cvt_scalef32_pk_fp4_f32(w1, a[2][0] * sc, a[2][1] * sc, 1.0f, 0);
    w1 = __builtin_amdgcn_cvt_scalef32_pk_fp4_f32(w1, a[2][2] * sc, a[2][3] * sc, 1.0f, 1);
    w1 = __builtin_amdgcn_cvt_scalef32_pk_fp4_f32(w1, a[3][0] * sc, a[3][1] * sc, 1.0f, 2);
    w1 = __builtin_amdgcn_cvt_scalef32_pk_fp4_f32(w1, a[3][2] * sc, a[3][3] * sc, 1.0f, 3);
    *(i32x2*)(dst + row * dstride + lane * 8) = (i32x2){w0, w1};
    if (lane == 0) inv[2 * row] = 1.0f / sc;
}
__device__ __forceinline__ void wqk_tile(const float* __restrict__ wq, const float* __restrict__ keys, h16* __restrict__ wt, int tile, float* lds) {
    const int ct = tile >> 4, hp = tile & 15, tid = threadIdx.x;
    float* sA = lds;
    float* sB = lds + 64 * 129;
#pragma unroll
    for (int i = 0; i < 4; ++i) {
        const int e = (i * 512 + tid) * 4, r = e >> 7, d = e & 127;
        const f32x4 v = *(const f32x4*)(wq + (size_t)(ct * 64 + r) * 2048 + hp * 128 + d);
        sA[r * 129 + d] = v[0]; sA[r * 129 + d + 1] = v[1]; sA[r * 129 + d + 2] = v[2]; sA[r * 129 + d + 3] = v[3];
    }
#pragma unroll
    for (int i = 0; i < 8; ++i) {
        const int e = (i * 512 + tid) * 4, k = e >> 7, d = e & 127;
        const f32x4 v = *(const f32x4*)(keys + (size_t)(hp * 128 + k) * 128 + d);
        sB[k * 129 + d] = v[0]; sB[k * 129 + d + 1] = v[1]; sB[k * 129 + d + 2] = v[2]; sB[k * 129 + d + 3] = v[3];
    }
    __syncthreads();
    const int cg = tid >> 5, kq = tid & 31;
    float acc[4][4];
#pragma unroll
    for (int i = 0; i < 4; ++i)
#pragma unroll
        for (int j = 0; j < 4; ++j) acc[i][j] = 0.f;
#pragma unroll 4
    for (int d = 0; d < 128; ++d) {
        float a[4], bq[4];
#pragma unroll
        for (int i = 0; i < 4; ++i) a[i] = sA[(cg * 4 + i) * 129 + d];
#pragma unroll
        for (int j = 0; j < 4; ++j) bq[j] = sB[(kq + 32 * j) * 129 + d];
#pragma unroll
        for (int i = 0; i < 4; ++i)
#pragma unroll
            for (int j = 0; j < 4; ++j) acc[i][j] += a[i] * bq[j];
    }
#pragma unroll
    for (int j = 0; j < 4; ++j) {
        h16x4 o;
#pragma unroll
        for (int i = 0; i < 4; ++i) o[i] = (h16)acc[i][j];
        *(h16x4*)(wt + (size_t)(hp * 128 + kq + 32 * j) * 1024 + ct * 64 + cg * 4) = o;
    }
    __syncthreads();
}
__device__ void phase0(const Params& p, float* lds) {
    unsigned char* ws = p.ws;
    const int tid = threadIdx.x, wid = tid >> 6, lane = tid & 63;
    for (int ib = blockIdx.x; ib < 256; ib += gridDim.x) {
        if (wid < 6) {
            const int item = ib * 6 + wid, cg64 = item % 96, kc = item / 96;
            const int col = cg64 * 64 + lane, k0 = kc * 64;
            float sv[17], acc[17];
#pragma unroll
            for (int b = 0; b < 17; ++b) {
                const float cv = (b < 16) ? p.in[I_C][b * 1024 + k0 + lane] : p.in[I_CCTX][k0 + lane];
                sv[b] = silu_(cv); acc[b] = 0.f;
            }
            const float* wp = p.in[I_ADAW] + (size_t)k0 * 6144 + col;
#pragma unroll 16
            for (int j = 0; j < 64; ++j) {
                const float w = wp[(size_t)j * 6144];
#pragma unroll
                for (int b = 0; b < 17; ++b) acc[b] += __builtin_bit_cast(float, __builtin_amdgcn_readlane(__builtin_bit_cast(int, sv[b]), j)) * w;
            }
            float* mp = (float*)(ws + OFF_MODP);
#pragma unroll
            for (int b = 0; b < 17; ++b) mp[((size_t)kc * 17 + b) * 6144 + col] = acc[b];
        }
    }
    constexpr int T0 = 2048, T1 = T0 + 2048, T2 = T1 + 32, T3 = T2, T4 = T3 + 1152, T5 = T4 + 128, T6 = T5 + 128, T7 = T6 + 256, T8 = T7 + 256;
    for (int t = blockIdx.x; t < T8; t += gridDim.x) {
        if (t < T0) cvt4_rows(p.in[I_PU], ws + OFF_U8, (float*)(ws + OFF_USC), t, 1536);
        else if (t < T1) cvt8_rows(p.in[I_PV], ws + OFF_U8 + 512, (float*)(ws + OFF_USC) + 1, t - T0, 1536);
        else if (t < T2) cvt_tile(p.in[I_GMWS], (h16*)(ws + OFF_WS16), t - T1);
        else if (t < T3) {
            const int e = (t - T2) * 4096 + tid * 8;
            const int row = e >> 8, cc = e & 255, h = row >> 8, pp = (row >> 7) & 1, k = row & 127, pq = cc >> 7, d = cc & 127;
            h16x8 o = {0, 0, 0, 0, 0, 0, 0, 0};
            if (pp == pq) {
                const float* kp = p.in[I_KEYS] + ((size_t)((h * 2 + pp) * 128 + k)) * 128 + d;
                o = pack8(*(const f32x4*)kp, *(const f32x4*)(kp + 4));
            }
            *(h16x8*)((h16*)(ws + OFF_BD) + e) = o;
        }
        else if (t < T4) tr_tile(p.in[I_WIN], (h16*)(ws + OFF_WINT), 1024, INC, t - T3, lds);
        else if (t < T5) tr_tile(p.in[I_WPA], (h16*)(ws + OFF_WPAT), 512, 1024, t - T4, lds);
        else if (t < T6) tr_tile(p.in[I_WPB], (h16*)(ws + OFF_WPBT), 512, 1024, t - T5, lds);
        else if (t < T7) tr_tile(p.in[I_WOUT], (h16*)(ws + OFF_WOUTT), 1024, 1024, t - T6, lds);
        else wqk_tile(p.in[I_WQ], p.in[I_KEYS], (h16*)(ws + OFF_WQT), t - T7, lds);
    }
}

__device__ __forceinline__ void norm_rows(const float* __restrict__ src, h16* __restrict__ dst, int row_begin, int rows_per_wave, const float* sA, const float* sB) {
    const int tid_ = fresh_tid();
    const int wid = tid_ >> 6, lane = tid_ & 63;
    f32x4 a[4], bsh[4];
#pragma unroll
    for (int c = 0; c < 4; ++c) { a[c] = *(const f32x4*)(sA + c * 256 + lane * 4); bsh[c] = *(const f32x4*)(sB + c * 256 + lane * 4); }
    for (int i = 0; i < rows_per_wave; i += 2) {
        const size_t row = (size_t)row_begin + wid * rows_per_wave + i;
        f32x4 v[2][4]; float ss[2];
#pragma unroll
        for (int q = 0; q < 2; ++q) {
            ss[q] = 0.f;
#pragma unroll
            for (int c = 0; c < 4; ++c) { v[q][c] = *(const f32x4*)(src + (row + q) * 1024 + c * 256 + lane * 4); ss[q] += v[q][c][0] * v[q][c][0] + v[q][c][1] * v[q][c][1] + v[q][c][2] * v[q][c][2] + v[q][c][3] * v[q][c][3]; }
        }
#pragma unroll
        for (int o = 32; o > 0; o >>= 1) { const float t0 = __shfl_xor(ss[0], o), t1 = __shfl_xor(ss[1], o); ss[0] += t0; ss[1] += t1; }
#pragma unroll
        for (int q = 0; q < 2; ++q) {
            const float r = rsqrtf(ss[q] * (1.0f / 1024.0f) + 1e-6f);
#pragma unroll
            for (int c = 0; c < 4; ++c) {
                h16x4 o;
#pragma unroll
                for (int j = 0; j < 4; ++j) o[j] = (h16)(v[q][c][j] * r * a[c][j] + bsh[c][j]);
                *(h16x4*)(dst + (row + q) * 1024 + c * 256 + lane * 4) = o;
            }
        }
    }
}
__device__ __forceinline__ void norm_rows_h(const h16* __restrict__ src, h16* __restrict__ dst, int row_begin, int rows_per_wave, const float* sA, const float* sB) {
    const int tid_ = fresh_tid();
    const int wid = tid_ >> 6, lane = tid_ & 63;
    f32x4 a[4], bsh[4];
#pragma unroll
    for (int c = 0; c < 4; ++c) { a[c] = *(const f32x4*)(sA + c * 256 + lane * 4); bsh[c] = *(const f32x4*)(sB + c * 256 + lane * 4); }
    for (int i = 0; i < rows_per_wave; i += 2) {
        const size_t row = (size_t)row_begin + wid * rows_per_wave + i;
        f32x4 v[2][4]; float ss[2];
#pragma unroll
        for (int q = 0; q < 2; ++q) {
            ss[q] = 0.f;
#pragma unroll
            for (int c = 0; c < 4; ++c) { const h16x4 hv = *(const h16x4*)(src + (row + q) * 1024 + c * 256 + lane * 4);
                v[q][c] = (f32x4){(float)hv[0], (float)hv[1], (float)hv[2], (float)hv[3]};
                ss[q] += v[q][c][0] * v[q][c][0] + v[q][c][1] * v[q][c][1] + v[q][c][2] * v[q][c][2] + v[q][c][3] * v[q][c][3]; }
        }
#pragma unroll
        for (int o = 32; o > 0; o >>= 1) { const float t0 = __shfl_xor(ss[0], o), t1 = __shfl_xor(ss[1], o); ss[0] += t0; ss[1] += t1; }
#pragma unroll
        for (int q = 0; q < 2; ++q) {
            const float r = rsqrtf(ss[q] * (1.0f / 1024.0f) + 1e-6f);
#pragma unroll
            for (int c = 0; c < 4; ++c) {
                h16x4 o;
#pragma unroll
                for (int j = 0; j < 4; ++j) o[j] = (h16)(v[q][c][j] * r * a[c][j] + bsh[c][j]);
                *(h16x4*)(dst + (row + q) * 1024 + c * 256 + lane * 4) = o;
            }
        }
    }
}
__device__ void phase1(const Params& p, float* lds) {
    unsigned char* ws = p.ws;
    const int tid = threadIdx.x;
    const float* mp = (const float*)(ws + OFF_MODP);
    const float* bias = p.in[I_ADAB];
    float* sA = lds; float* sB = lds + 1024; float* cA = lds + 2048; float* cB = lds + 3072;
    {
        float* mod = (float*)(ws + OFF_MOD);
        for (int e = blockIdx.x * 512 + tid; e < 17 * 6144; e += gridDim.x * 512) {
            float s = bias[e % 6144];
#pragma unroll
            for (int kc = 0; kc < 16; ++kc) s += mp[(size_t)kc * 17 * 6144 + e];
            mod[e] = s;
        }
    }
    for (int col = tid; col < 1024; col += 512) {
        float sh = bias[col], sc = bias[1024 + col];
#pragma unroll
        for (int kc = 0; kc < 16; ++kc) { sh += mp[((size_t)kc * 17 + 16) * 6144 + col]; sc += mp[((size_t)kc * 17 + 16) * 6144 + 1024 + col]; }
        cA[col] = p.in[I_N1G][col] * (1.0f + sc); cB[col] = sh;
    }
    for (int rg = blockIdx.x; rg < 256; rg += gridDim.x) {
        const int b = rg >> 4;
        __syncthreads();
        for (int col = tid; col < 1024; col += 512) {
            float sh = bias[col], sc = bias[1024 + col];
#pragma unroll
            for (int kc = 0; kc < 16; ++kc) { sh += mp[((size_t)kc * 17 + b) * 6144 + col]; sc += mp[((size_t)kc * 17 + b) * 6144 + 1024 + col]; }
            sA[col] = p.in[I_N1G][col] * (1.0f + sc); sB[col] = sh;
        }
        __syncthreads();
        norm_rows(p.in[I_X], (h16*)(ws + OFF_R1), rg * 128, 16, sA, sB);
        norm_rows(p.in[I_CTX], (h16*)(ws + OFF_HC), rg * 16, 2, cA, cB);
    }
}
__device__ void phase6(const Params& p, float* lds) {
    unsigned char* ws = p.ws;
    const int tid = threadIdx.x;
    const float* mod = (const float*)(ws + OFF_MOD);
    float* sA = lds; float* sB = lds + 1024;
    for (int rg = blockIdx.x; rg < 256; rg += gridDim.x) {
        const int b = rg >> 4;
        __syncthreads();
        for (int col = tid; col < 1024; col += 512) {
            sA[col] = p.in[I_N2G][col] * (1.0f + mod[(size_t)b * 6144 + 4 * 1024 + col]); sB[col] = mod[(size_t)b * 6144 + 3 * 1024 + col];
        }
        __syncthreads();
        norm_rows_h((const h16*)(ws + OFF_X1H), (h16*)(ws + OFF_R1), rg * 128, 16, sA, sB);
    }
}

__device__ __forceinline__ int clampi(int v, int lo, int hi) { return v < lo ? lo : (v > hi ? hi : v); }

template <bool LOCAL>
__device__ __forceinline__ void attn_core(const h16x8 (&kf)[2][2], const h16x8 (&vf)[4], const float (&bias)[8], const int cb, const int qc, const int cs,
                                          const h16x8 (&qf)[2], float& m_run, float& l_run, f32x4 (&O)[4], const int quad) {
    f32x4 st[2];
#pragma unroll
    for (int t = 0; t < 2; ++t) {
        f32x4 a = (f32x4){0.f, 0.f, 0.f, 0.f};
#pragma unroll
        for (int ks = 0; ks < 2; ++ks) a = __builtin_amdgcn_mfma_f32_16x16x32_f16(kf[t][ks], qf[ks], a, 0, 0, 0);
        st[t] = a;
    }
    float mx = -INFINITY;
#pragma unroll
    for (int t = 0; t < 2; ++t)
#pragma unroll
        for (int j = 0; j < 4; ++j) {
            float sv = st[t][j] * 0.125f;
            if (LOCAL) {
                const int kc = cb + 16 * t + quad * 4 + j;
                const bool inw = (kc >= cs) && (kc < cs + 16);
                sv = inw ? (sv + bias[t * 4 + j]) : -1e30f;
            }
            st[t][j] = sv; mx = fmaxf(mx, sv);
        }
    mx = fmaxf(mx, __shfl_xor(mx, 16)); mx = fmaxf(mx, __shfl_xor(mx, 32));
    const float m_new = fmaxf(m_run, mx);
    const float alpha = __expf(m_run - m_new);
    float ls = 0.f; h16x8 pf;
#pragma unroll
    for (int t = 0; t < 2; ++t)
#pragma unroll
        for (int j = 0; j < 4; ++j) { const float pe = __expf(st[t][j] - m_new); ls += pe; pf[t * 4 + j] = (h16)pe; }
    l_run = l_run * alpha + ls; m_run = m_new;
#pragma unroll
    for (int dt = 0; dt < 4; ++dt) { O[dt] *= alpha; O[dt] = __builtin_amdgcn_mfma_f32_16x16x32_f16(vf[dt], pf, O[dt], 0, 0, 0); }
}
__device__ __forceinline__ void load_k(const h16* __restrict__ kt, h16x8 (&kf)[2][2], const int l15, const int quad) {
#pragma unroll
    for (int t = 0; t < 2; ++t)
#pragma unroll
        for (int ks = 0; ks < 2; ++ks) kf[t][ks] = *(const h16x8*)(kt + (16 * t + l15) * 64 + ks * 32 + quad * 8);
}
__device__ __forceinline__ void load_v(const h16* __restrict__ vt, h16x8 (&vf)[4], const int l15, const int quad) {
#pragma unroll
    for (int dt = 0; dt < 4; ++dt) {
        const h16* vp = vt + ((quad >> 1) * 64 + dt * 16 + l15) * 8 + (quad & 1) * 4;
        const h16x4 lo = *(const h16x4*)vp, hi = *(const h16x4*)(vp + 2 * 512);
        vf[dt] = (h16x8){lo[0], lo[1], lo[2], lo[3], hi[0], hi[1], hi[2], hi[3]};
    }
}
__device__ __forceinline__ void load_bias(const float* __restrict__ rpbrow, const int cb, const int qc, const int quad, float (&bias)[8]) {
#pragma unroll
    for (int t = 0; t < 2; ++t)
#pragma unroll
        for (int j = 0; j < 4; ++j) bias[t * 4 + j] = rpbrow[clampi(cb + 16 * t + quad * 4 + j - qc + 15, 0, 30)];
}

__device__ void attn_unit(const Params& p, int unit) {
    unsigned char* ws = p.ws;
    const int tid_ = fresh_tid();
    const int lane = tid_ & 63, h = tid_ >> 6, l15 = lane & 15, quad = lane >> 4;
    const int b = unit >> 5, r = unit & 31;
    const h16* QB = (const h16*)(ws + OFF_QB);
    const h16* KH = (const h16*)(ws + OFF_KB) + (size_t)(b * 8 + h) * 2048 * 64;
    const h16* VH = (const h16*)(ws + OFF_VT) + (size_t)(b * 8 + h) * 256 * 512;
    const h16* KCH = (const h16*)(ws + OFF_KC) + (size_t)(b * 8 + h) * 256 * 64;
    const h16* VCH = (const h16*)(ws + OFF_VCT) + (size_t)(b * 8 + h) * 32 * 512;
    h16* YA = (h16*)(ws + OFF_R1);
    const float* rpb = p.in[I_RPB] + (size_t)h * 15 * 31;
    const int rs = clampi(r - 4, 0, 24);
    h16x8 qf[4][2]; float m_run[4], l_run[4]; f32x4 O[4][4];
#pragma unroll
    for (int g = 0; g < 4; ++g) {
        const size_t tq = (size_t)b * 2048 + r * 64 + 16 * g + l15;
        qf[g][0] = *(const h16x8*)(QB + tq * 512 + h * 64 + quad * 8);
        qf[g][1] = *(const h16x8*)(QB + tq * 512 + h * 64 + 32 + quad * 8);
        m_run[g] = -INFINITY; l_run[g] = 0.f;
#pragma unroll
        for (int dt = 0; dt < 4; ++dt) O[g][dt] = (f32x4){0.f, 0.f, 0.f, 0.f};
    }
    {
        const float nob[8] = {0.f, 0.f, 0.f, 0.f, 0.f, 0.f, 0.f, 0.f};
        h16x8 kA[2][2], kB[2][2], vf[4];
        load_k(KCH, kA, l15, quad);
#pragma unroll 1
        for (int step = 0; step < 8; step += 2) {
            load_v(VCH + step * 4 * 512, vf, l15, quad);
            load_k(KCH + (step + 1) * 32 * 64, kB, l15, quad);
            __builtin_amdgcn_sched_barrier(0);
#pragma unroll
            for (int g = 0; g < 4; ++g) attn_core<false>(kA, vf, nob, 0, 0, 0, qf[g], m_run[g], l_run[g], O[g], quad);
            __builtin_amdgcn_sched_barrier(0);
            load_v(VCH + (step + 1) * 4 * 512, vf, l15, quad);
            if (step + 2 < 8) load_k(KCH + (step + 2) * 32 * 64, kA, l15, quad);
            __builtin_amdgcn_sched_barrier(0);
#pragma unroll
            for (int g = 0; g < 4; ++g) attn_core<false>(kB, vf, nob, 0, 0, 0, qf[g], m_run[g], l_run[g], O[g], quad);
            __builtin_amdgcn_sched_barrier(0);
        }
    }
#pragma unroll
    for (int gp = 0; gp < 4; gp += 2) {
        const int cb0 = clampi(16 * gp - 8, 0, 32), cb1 = clampi(16 * (gp + 1) - 8, 0, 32);
        const int qc0 = 16 * gp + l15, qc1 = 16 * (gp + 1) + l15;
        const int cs0 = clampi(qc0 - 8, 0, 48), cs1 = clampi(qc1 - 8, 0, 48);
        const float* rp0 = rpb + (rs - r + 7) * 31;
#pragma unroll 1
        for (int step = 0; step < 8; ++step) {
            const int t0 = (rs + step) * 64 + cb0, t1 = (rs + step) * 64 + cb1;
            h16x8 kf0[2][2], vf0[4], kf1[2][2], vf1[4]; float b0[8], b1[8];
            load_k(KH + (size_t)t0 * 64, kf0, l15, quad); load_k(KH + (size_t)t1 * 64, kf1, l15, quad);
            load_bias(rp0 + step * 31, cb0, qc0, quad, b0); load_bias(rp0 + step * 31, cb1, qc1, quad, b1);
            load_v(VH + (size_t)(t0 >> 3) * 512, vf0, l15, quad); load_v(VH + (size_t)(t1 >> 3) * 512, vf1, l15, quad);
            attn_core<true>(kf0, vf0, b0, cb0, qc0, cs0, qf[gp], m_run[gp], l_run[gp], O[gp], quad);
            attn_core<true>(kf1, vf1, b1, cb1, qc1, cs1, qf[gp + 1], m_run[gp + 1], l_run[gp + 1], O[gp + 1], quad);
        }
    }
#pragma unroll
    for (int g = 0; g < 4; ++g) {
        const size_t tq = (size_t)b * 2048 + r * 64 + 16 * g + l15;
        float l = l_run[g];
        l += __shfl_xor(l, 16); l += __shfl_xor(l, 32);
        const float inv = __builtin_amdgcn_rcpf(l);
#pragma unroll
        for (int dt = 0; dt < 4; ++dt) {
            h16x4 o;
#pragma unroll
            for (int j = 0; j < 4; ++j) o[j] = (h16)(O[g][dt][j] * inv);
            *(h16x4*)(YA + tq * 1024 + h * 64 + dt * 16 + quad * 4) = o;
        }
    }
}

__device__ void sgu_unit(const Params& p, int n, LAS unsigned char* lds) {
    unsigned char* ws = p.ws;
    const int tid = fresh_tid(), lane = tid & 63, g = tid >> 6, l15 = lane & 15, quad = lane >> 4;
    const h16* GUV = (const h16*)(ws + OFF_GUV);
    const h16* WS16 = (const h16*)(ws + OFF_WS16);
    h16* YB = (h16*)(ws + OFF_R1) + 512;
    LAS float* stat = (LAS float*)(lds + 8 * 17408);
    LAS h16* vt = (LAS h16*)(lds + g * 17408);
    const size_t t0 = (size_t)n * 128;
    __syncthreads();
    for (int i = 0; i < 16; i += 4) {
        h16x8 x[4]; float s[4], v[4];
#pragma unroll
        for (int q = 0; q < 4; ++q) {
            x[q] = *(const h16x8*)(GUV + (t0 + g * 16 + i + q) * 1024 + 512 + lane * 8);
            s[q] = 0.f;
#pragma unroll
            for (int j = 0; j < 8; ++j) s[q] += (float)x[q][j];
        }
#pragma unroll
        for (int o = 32; o > 0; o >>= 1) { float t[4];
#pragma unroll
            for (int q = 0; q < 4; ++q) t[q] = __shfl_xor(s[q], o);
#pragma unroll
            for (int q = 0; q < 4; ++q) s[q] += t[q]; }
#pragma unroll
        for (int q = 0; q < 4; ++q) {
            s[q] *= (1.0f / 512.0f); v[q] = 0.f;
#pragma unroll
            for (int j = 0; j < 8; ++j) { const float d = (float)x[q][j] - s[q]; v[q] += d * d; }
        }
#pragma unroll
        for (int o = 32; o > 0; o >>= 1) { float t[4];
#pragma unroll
            for (int q = 0; q < 4; ++q) t[q] = __shfl_xor(v[q], o);
#pragma unroll
            for (int q = 0; q < 4; ++q) v[q] += t[q]; }
        if (lane == 0) {
#pragma unroll
            for (int q = 0; q < 4; ++q) { stat[(g * 16 + i + q) * 2] = s[q]; stat[(g * 16 + i + q) * 2 + 1] = rsqrtf(v[q] * (1.0f / 512.0f) + 1e-6f); }
        }
    }
    __syncthreads();
    {
        const int ch0 = (lane & 7) * 8;
        float lg[8];
#pragma unroll
        for (int j = 0; j < 8; ++j) lg[j] = p.in[I_LNG][g * 64 + ch0 + j];
#pragma unroll 8
        for (int it = 0; it < 16; ++it) {
            const int q = it * 8 + (lane >> 3);
            const h16x8 x = *(const h16x8*)(GUV + (t0 + q) * 1024 + 512 + g * 64 + ch0);
            const float mean = stat[q * 2], rstd = stat[q * 2 + 1];
#pragma unroll
            for (int j = 0; j < 8; ++j) vt[(ch0 + j) * 136 + ((((q >> 3) ^ (lane & 7)) << 3) | (q & 7))] = (h16)(((float)x[j] - mean) * rstd * lg[j]);
        }
    }
    asm volatile("s_waitcnt lgkmcnt(0)" ::: "memory");
    __syncthreads();
    h16x8 af[4][4];
#pragma unroll
    for (int dt = 0; dt < 4; ++dt)
#pragma unroll
        for (int ks = 0; ks < 4; ++ks) af[dt][ks] = *(const LAS h16x8*)(vt + (dt * 16 + l15) * 136 + (((ks * 4 + quad) ^ (dt * 2 + (l15 >> 3))) << 3));
    const h16* wg = WS16 + (size_t)g * 128 * 128;
#pragma unroll 2
    for (int pt = 0; pt < 8; ++pt) {
        f32x4 acc[4];
#pragma unroll
        for (int dt = 0; dt < 4; ++dt) acc[dt] = (f32x4){0.f, 0.f, 0.f, 0.f};
#pragma unroll
        for (int ks = 0; ks < 4; ++ks) {
            const h16x8 bf = *(const h16x8*)(wg + (size_t)(pt * 16 + l15) * 128 + ks * 32 + quad * 8);
#pragma unroll
            for (int dt = 0; dt < 4; ++dt) acc[dt] = __builtin_amdgcn_mfma_f32_16x16x32_f16(af[dt][ks], bf, acc[dt], 0, 0, 0);
        }
        const int pp = pt * 16 + l15;
        const float bsv = p.in[I_GMBS][g * 128 + pp];
        const size_t tok = t0 + pp;
#pragma unroll
        for (int dt = 0; dt < 4; ++dt) {
            const int ch = g * 64 + dt * 16 + quad * 4;
            const h16x4 uu = *(const h16x4*)(GUV + tok * 1024 + ch);
            h16x4 o;
#pragma unroll
            for (int j = 0; j < 4; ++j) o[j] = (h16)((float)uu[j] * (acc[dt][j] + bsv));
            *(h16x4*)(YB + tok * 1024 + ch) = o;
        }
    }
    __syncthreads();
}

__device__ __forceinline__ float row16_sum_to_lane15(float v) {
    v += __builtin_bit_cast(float, __builtin_amdgcn_update_dpp(0, __builtin_bit_cast(int, v), 0x118, 0xf, 0xf, true));
    v += __builtin_bit_cast(float, __builtin_amdgcn_update_dpp(0, __builtin_bit_cast(int, v), 0x114, 0xf, 0xf, true));
    v += __builtin_bit_cast(float, __builtin_amdgcn_update_dpp(0, __builtin_bit_cast(int, v), 0x112, 0xf, 0xf, true));
    v += __builtin_bit_cast(float, __builtin_amdgcn_update_dpp(0, __builtin_bit_cast(int, v), 0x111, 0xf, 0xf, true));
    return v;
}
#define DPPF(v, ctrl) __builtin_bit_cast(float, __builtin_amdgcn_update_dpp(__builtin_bit_cast(int, v), __builtin_bit_cast(int, v), ctrl, 0xf, 0xf, false))
__device__ __forceinline__ float row16_allsum(float v) { v += DPPF(v, 0x128); v += DPPF(v, 0x124); v += DPPF(v, 0x122); v += DPPF(v, 0x121); return v; }
__device__ __forceinline__ float row16_allmax(float v) { v = fmaxf(v, DPPF(v, 0x128)); v = fmaxf(v, DPPF(v, 0x124)); v = fmaxf(v, DPPF(v, 0x122)); v = fmaxf(v, DPPF(v, 0x121)); return v; }
__device__ __forceinline__ int wave_incl_scan(int v) {
    v += __builtin_amdgcn_update_dpp(0, v, 0x111, 0xf, 0xf, false);
    v += __builtin_amdgcn_update_dpp(0, v, 0x112, 0xf, 0xf, false);
    v += __builtin_amdgcn_update_dpp(0, v, 0x114, 0xf, 0xf, false);
    v += __builtin_amdgcn_update_dpp(0, v, 0x118, 0xf, 0xf, false);
    v += __builtin_amdgcn_update_dpp(0, v, 0x142, 0xa, 0xf, false);
    v += __builtin_amdgcn_update_dpp(0, v, 0x143, 0xc, 0xf, false);
    return v;
}
__device__ __forceinline__ unsigned wave_or(unsigned x) {
    int v = (int)x;
    v |= __builtin_amdgcn_update_dpp(0, v, 0x111, 0xf, 0xf, false);
    v |= __builtin_amdgcn_update_dpp(0, v, 0x112, 0xf, 0xf, false);
    v |= __builtin_amdgcn_update_dpp(0, v, 0x114, 0xf, 0xf, false);
    v |= __builtin_amdgcn_update_dpp(0, v, 0x118, 0xf, 0xf, false);
    v |= __builtin_amdgcn_update_dpp(0, v, 0x142, 0xa, 0xf, false);
    v |= __builtin_amdgcn_update_dpp(0, v, 0x143, 0xc, 0xf, false);
    return (unsigned)__builtin_amdgcn_readlane(v, 63);
}
__device__ __forceinline__ unsigned wave_and(unsigned x) {
    int v = (int)x;
    v &= __builtin_amdgcn_update_dpp(-1, v, 0x111, 0xf, 0xf, false);
    v &= __builtin_amdgcn_update_dpp(-1, v, 0x112, 0xf, 0xf, false);
    v &= __builtin_amdgcn_update_dpp(-1, v, 0x114, 0xf, 0xf, false);
    v &= __builtin_amdgcn_update_dpp(-1, v, 0x118, 0xf, 0xf, false);
    v &= __builtin_amdgcn_update_dpp(-1, v, 0x142, 0xa, 0xf, false);
    v &= __builtin_amdgcn_update_dpp(-1, v, 0x143, 0xc, 0xf, false);
    return (unsigned)__builtin_amdgcn_readlane(v, 63);
}
__device__ __forceinline__ unsigned key16(unsigned short u) { return (u & 0x8000u) ? ((~(unsigned)u) & 0xFFFFu) : ((unsigned)u | 0x8000u); }
__device__ __forceinline__ unsigned key32(unsigned u) { return (u & 0x80000000u) ? ~u : (u | 0x80000000u); }
__device__ __forceinline__ float dot8(h16x8 a, h16x8 b, float c) {
    c = __builtin_amdgcn_fdot2((h16x2){a[0], a[1]}, (h16x2){b[0], b[1]}, c, false);
    c = __builtin_amdgcn_fdot2((h16x2){a[2], a[3]}, (h16x2){b[2], b[3]}, c, false);
    c = __builtin_amdgcn_fdot2((h16x2){a[4], a[5]}, (h16x2){b[4], b[5]}, c, false);
    c = __builtin_amdgcn_fdot2((h16x2){a[6], a[7]}, (h16x2){b[6], b[7]}, c, false);
    return c;
}
#define LDS_FENCE() asm volatile("s_waitcnt lgkmcnt(0)" ::: "memory")

__device__ void peer_phase(const Params& p, LAS unsigned char* lds, unsigned* bar, unsigned& epoch) {
    unsigned char* ws = p.ws;
    const int tid = fresh_tid(), wid = __builtin_amdgcn_readfirstlane(tid >> 6), lane = tid & 63;
    const unsigned long long lm = (1ull << lane) - 1ull;
    LAS unsigned char* wl = lds + wid * 11264;
    LAS float* s_top = (LAS float*)(wl);
    LAS int* i_top = (LAS int*)(wl + 1024);
    LAS int* ex = (LAS int*)(wl + 2048);
    LAS float* sc = (LAS float*)(wl + 2560);
    LAS int* uns_m = (LAS int*)(wl + 3072);
    LAS float* uns_g = (LAS float*)(wl + 3584);
    LAS int* cnt = (LAS int*)(wl + 4096);
    LAS int* base = (LAS int*)(wl + 4352);
    const int lead = (wid >= 4) ? 1 : 0;
    const unsigned short* SC = (const unsigned short*)(ws + OFF_SC16);
    const h16* H2 = (const h16*)(ws + OFF_R1);
    const unsigned char* U4 = ws + OFF_U8;
    const unsigned char* V8 = ws + OFF_V8;
    const float* USC = (const float*)(ws + OFF_USC);
    const float* VSC = (const float*)(ws + OFF_VSC);
    const float* mod = (const float*)(ws + OFF_MOD);
    const int grp = lane >> 4, li = lane & 15;
    for (int tg = blockIdx.x; tg < 256; tg += gridDim.x) {
        for (int it5 = 0; it5 < 5; ++it5) {
          if (it5 < 4) {
            const int round = it5;
            const size_t tok0 = (size_t)tg * 128 + wid * 16 + round * 4;
            LAS unsigned short* se = (LAS unsigned short*)(wl + 4608 + (round & 1) * 3072);
            LAS float* sw = (LAS float*)(wl + 4608 + (round & 1) * 3072 + 1024);
            for (int tt = 0; tt < 4; ++tt) {
                const size_t tok = tok0 + tt;
                cnt[lane] = 0;
                for (int L0 = 0; L0 < 16; L0 += 8) {
                    unsigned short ra[8], rb[8]; unsigned ka[8], kb[8], T[8];
#pragma unroll
                    for (int q = 0; q < 8; ++q) {
                        const unsigned short* sr = SC + tok * 2048 + (L0 + q) * 128;
                        ra[q] = sr[lane]; rb[q] = sr[64 + lane];
                        ka[q] = key16(ra[q]); kb[q] = key16(rb[q]); T[q] = 0;
                    }
                    for (int bit = 15; bit >= 0; --bit) {
#pragma unroll
                        for (int q = 0; q < 8; ++q) {
                            const unsigned cand = T[q] | (1u << bit);
                            const int cn = __popcll(__ballot(ka[q] >= cand)) + __popcll(__ballot(kb[q] >= cand));
                            T[q] = (cn >= 16) ? cand : T[q];
                        }
                    }
#pragma unroll
                    for (int q = 0; q < 8; ++q) {
                        const int L = L0 + q;
                        const int cnt_gt = __popcll(__ballot(ka[q] > T[q])) + __popcll(__ballot(kb[q] > T[q]));
                        const int need = 16 - cnt_gt;
                        const unsigned long long ea = __ballot(ka[q] == T[q]), eb = __ballot(kb[q] == T[q]);
                        const int ra_eq = __popcll(ea & lm), rb_eq = __popcll(ea) + __popcll(eb & lm);
                        const bool sa = (ka[q] > T[q]) || (ka[q] == T[q] && ra_eq < need);
                        const bool sb = (kb[q] > T[q]) || (kb[q] == T[q] && rb_eq < need);
                        const unsigned long long ma = __ballot(sa), mb = __ballot(sb);
                        const int pa = __popcll(ma & lm), pb = __popcll(ma) + __popcll(mb & lm);
                        if (sa) { s_top[L * 16 + pa] = (float)__builtin_bit_cast(h16, ra[q]); i_top[L * 16 + pa] = lane; }
                        if (sb) { s_top[L * 16 + pb] = (float)__builtin_bit_cast(h16, rb[q]); i_top[L * 16 + pb] = 64 + lane; }
                    }
                }
                LDS_FENCE();
                for (int h0 = 0; h0 < 8; h0 += 4) {
                    float cv[4][4]; unsigned kk[4][4], T[4];
#pragma unroll
                    for (int q = 0; q < 4; ++q) {
                        const int h = h0 + q;
                        const float bj = s_top[(2 * h + 1) * 16 + li];
#pragma unroll
                        for (int m = 0; m < 4; ++m) { cv[q][m] = s_top[(2 * h) * 16 + grp + 4 * m] + bj; kk[q][m] = key32(__builtin_bit_cast(unsigned, cv[q][m])); }
                        T[q] = 0;
                    }
                    unsigned om = 0, am = 0xFFFFFFFFu;
#pragma unroll
                    for (int q = 0; q < 4; ++q)
#pragma unroll
                        for (int m = 0; m < 4; ++m) { om |= kk[q][m]; am &= kk[q][m]; }
                    om = wave_or(om); am = wave_and(am);
                    om &= ~am;
                    while (om) {
                        const int bit = 31 - __builtin_clz(om);
                        om &= ~(1u << bit);
#pragma unroll
                        for (int q = 0; q < 4; ++q) {
                            const unsigned cand = T[q] | (1u << bit);
                            int cn = 0;
#pragma unroll
                            for (int m = 0; m < 4; ++m) cn += __popcll(__ballot((kk[q][m] & ~am) >= cand));
                            T[q] = (cn >= 16) ? cand : T[q];
                        }
                    }
#pragma unroll
                    for (int q = 0; q < 4; ++q) T[q] |= am;
#pragma unroll
                    for (int q = 0; q < 4; ++q) {
                        const int h = h0 + q;
                        int cnt_gt = 0;
#pragma unroll
                        for (int m = 0; m < 4; ++m) cnt_gt += __popcll(__ballot(kk[q][m] > T[q]));
                        const int need = 16 - cnt_gt;
                        int eq_before = 0, sel_before = 0;
#pragma unroll
                        for (int m = 0; m < 4; ++m) {
                            const unsigned long long em = __ballot(kk[q][m] == T[q]);
                            const int myeq = eq_before + __popcll(em & lm);
                            const bool sel = (kk[q][m] > T[q]) || (kk[q][m] == T[q] && myeq < need);
                            const unsigned long long sm = __ballot(sel);
                            const int pos = sel_before + __popcll(sm & lm);
                            if (sel) {
                                ex[h * 16 + pos] = i_top[(2 * h) * 16 + grp + 4 * m] * 128 + i_top[(2 * h + 1) * 16 + li];
                                sc[h * 16 + pos] = cv[q][m];
                            }
                            eq_before += __popcll(em); sel_before += __popcll(sm);
                        }
                    }
                }
                LDS_FENCE();
#pragma unroll
                for (int half = 0; half < 2; ++half) {
                    const int e = half * 64 + lane;
                    const float v = sc[e];
                    const float mx = row16_allmax(v);
                    const float pe = __expf(v - mx);
                    const float sm = row16_allsum(pe);
                    const float gate = pe * __builtin_amdgcn_rcpf(sm);
                    const int eid = ex[e];
                    const int pos = __hip_atomic_fetch_add(cnt + (eid >> 8), 1, __ATOMIC_RELAXED, __HIP_MEMORY_SCOPE_WORKGROUP);
                    uns_m[e] = eid | (pos << 14); uns_g[e] = gate;
                }
                LDS_FENCE();
                {
                    const int c = cnt[lane];
                    const int incl = wave_incl_scan(c);
                    base[lane] = incl - c;
                    LDS_FENCE();
#pragma unroll
                    for (int i = 0; i < 2; ++i) {
                        const int rm = uns_m[i * 64 + lane]; const float rg = uns_g[i * 64 + lane];
                        const int eid = rm & 16383, pos = rm >> 14;
                        const int dst = tt * 128 + base[eid >> 8] + pos;
                        se[dst] = (unsigned short)eid; sw[dst] = rg;
                    }
                    LDS_FENCE();
                }
            }
          }
          const int round = it5 - lead;
          if (round >= 0 && round < 4) {
            const size_t tok0 = (size_t)tg * 128 + wid * 16 + round * 4;
            LAS unsigned short* se = (LAS unsigned short*)(wl + 4608 + (round & 1) * 3072);
            LAS float* sw = (LAS float*)(wl + 4608 + (round & 1) * 3072 + 1024);
            const size_t tokg = tok0 + grp;
            const LAS unsigned short* me = se + grp * 128; LAS float* mw = sw + grp * 128;
            {
                const int li = launder(tid) & 15;
                h16x8 xr[2][4];
#pragma unroll
                for (int c = 0; c < 2; ++c)
#pragma unroll
                    for (int j = 0; j < 4; ++j) xr[c][j] = *(const h16x8*)(H2 + tokg * 1024 + c * 512 + li * 32 + 8 * j);
                float acc[64];
#pragma unroll
                for (int i = 0; i < 64; ++i) acc[i] = 0.f;
                i32x4 ru[2][2], rv[2][4]; float su[2], sv[2];
#define ELD(J, S_) do { const int e_ = me[(S_)]; const unsigned char* rp_ = U4 + (size_t)e_ * 1536 + li * 16; \
        ru[J][0] = *(const i32x4*)rp_; ru[J][1] = *(const i32x4*)(rp_ + 256); \
        _Pragma("unroll") for (int c = 0; c < 4; ++c) rv[J][c] = *(const i32x4*)(rp_ + 512 + c * 256); \
        { const f32x2 s2_ = *(const f32x2*)(USC + 2 * e_); su[J] = s2_.x; sv[J] = s2_.y; } } while (0)
#define ECP(J, S_) do { float d = 0.f; \
        _Pragma("unroll") for (int c = 0; c < 2; ++c) _Pragma("unroll") for (int k = 0; k < 4; ++k) { const h16x8 xv = xr[c][k]; const int w_ = ru[J][c][k]; \
            d = __builtin_amdgcn_fdot2(__builtin_amdgcn_cvt_scalef32_pk_f16_fp4(w_, 1.0f, 0), (h16x2){xv[0], xv[1]}, d, false); \
            d = __builtin_amdgcn_fdot2(__builtin_amdgcn_cvt_scalef32_pk_f16_fp4(w_, 1.0f, 1), (h16x2){xv[2], xv[3]}, d, false); \
            d = __builtin_amdgcn_fdot2(__builtin_amdgcn_cvt_scalef32_pk_f16_fp4(w_, 1.0f, 2), (h16x2){xv[4], xv[5]}, d, false); \
            d = __builtin_amdgcn_fdot2(__builtin_amdgcn_cvt_scalef32_pk_f16_fp4(w_, 1.0f, 3), (h16x2){xv[6], xv[7]}, d, false); } \
        d = row16_allsum(d); \
        const float wt_ = mw[(S_)] * gelu_tanh(d * su[J]) * sv[J]; \
        _Pragma("unroll") for (int c = 0; c < 4; ++c) _Pragma("unroll") for (int k = 0; k < 4; ++k) { \
            const f32x2 lo = __builtin_amdgcn_cvt_pk_f32_fp8(rv[J][c][k], false), hi = __builtin_amdgcn_cvt_pk_f32_fp8(rv[J][c][k], true); \
            acc[c * 16 + 4 * k] += wt_ * lo.x; acc[c * 16 + 4 * k + 1] += wt_ * lo.y; acc[c * 16 + 4 * k + 2] += wt_ * hi.x; acc[c * 16 + 4 * k + 3] += wt_ * hi.y; } } while (0)
                ELD(0, 0); ELD(1, 1);
#pragma unroll 1
                for (int s = 0; s < 128; s += 2) {
                    ECP(0, s);     if (s + 2 < 128) ELD(0, s + 2);
                    ECP(1, s + 1); if (s + 3 < 128) ELD(1, s + 3);
                }
#undef ELD
#undef ECP
                float* xo = p.out + tokg * 1024 + li * 16;
                const h16* x1h = (const h16*)(ws + OFF_X1H) + tokg * 1024 + li * 16;
                const int b = (int)(tokg >> 11);
                const float* g2 = mod + (size_t)b * 6144 + 5 * 1024 + li * 16;
                const float* fg = p.in[I_FG] + li * 16;
                float ss = 0.f;
#pragma unroll
                for (int c = 0; c < 4; ++c) {
#pragma unroll
                    for (int q4 = 0; q4 < 4; ++q4) {
                        const h16x4 xh_ = *(const h16x4*)(x1h + c * 256 + q4 * 4);
                        const f32x4 xv = (f32x4){(float)xh_[0], (float)xh_[1], (float)xh_[2], (float)xh_[3]}, gv = *(const f32x4*)(g2 + c * 256 + q4 * 4);
#pragma unroll
                        for (int j = 0; j < 4; ++j) { const float t = xv[j] + gv[j] * acc[c * 16 + q4 * 4 + j]; acc[c * 16 + q4 * 4 + j] = t; ss += t * t; }
                    }
                    asm volatile("" : "+v"(ss) :: "memory");
                }
                ss = row16_allsum(ss);
                const float r = rsqrtf(ss * (1.0f / 1024.0f) + 1e-6f);
#pragma unroll
                for (int c = 0; c < 4; ++c) {
#pragma unroll
                    for (int q4 = 0; q4 < 4; ++q4) {
                        const f32x4 fv = *(const f32x4*)(fg + c * 256 + q4 * 4);
                        f32x4 ov;
#pragma unroll
                        for (int j = 0; j < 4; ++j) ov[j] = acc[c * 16 + q4 * 4 + j] * r * fv[j];
                        *(f32x4*)(xo + c * 256 + q4 * 4) = ov;
                    }
                    asm volatile("" ::: "memory");
                }
            }
            LDS_FENCE();
          }
        }
    }
}

__global__ void __launch_bounds__(512, 2) mega(Params p) {
    extern __shared__ __attribute__((aligned(16))) unsigned char shm[];
    LAS unsigned char* lds = (LAS unsigned char*)shm;
    cg::grid_group grid = cg::this_grid();
    unsigned char* ws = p.ws;
    const int G = (int)gridDim.x, c = (int)blockIdx.x;
    unsigned* bar = (unsigned*)(ws + OFF_BAR); unsigned epoch = 0;
    volatile LAS unsigned* xst = (volatile LAS unsigned*)(lds + (LDS_BYTES - 16));
    if (threadIdx.x < 2) xst[threadIdx.x] = 0u;
    __syncthreads();
    const XcdBarrier xb = xcd_barrier_post(bar, xst);

    if (p.ws == nullptr) grid.sync();
    phase0(p, (float*)shm);
    xcd_barrier(xb);
    phase1(p, (float*)shm);
    xcd_barrier(xb);
    {
        pg8::StaticOrder S; S.init(NTOK, INC, G, c);
        pg8::Gemm g{ws + OFF_R1, ws + OFF_WINT, 1024, 1024, NTOK, INC, 1024, 0};
        EpiIn E{(h16*)(ws + OFF_QB), (h16*)(ws + OFF_KB), (h16*)(ws + OFF_VT), (h16*)(ws + OFF_GUV), (h16*)(ws + OFF_GATES)};
        pg8::gemm_phase(lds, g, S, E);
        pg8::StaticOrder S2; S2.init(NCTXT, 1024, G, c);
        pg8::Gemm g2{ws + OFF_HC, ws + OFF_WINT + (size_t)512 * 1024 * 2, 1024, 1024, NCTXT, 1024, 1024, 0};
        EpiCtx E2{(h16*)(ws + OFF_KC), (h16*)(ws + OFF_VCT)};
        pg8::gemm_phase(lds, g2, S2, E2);
    }
    xcd_barrier(xb);
    {
        for (int rep3 = 0; rep3 < REP_P3; ++rep3) {
        for (int u = c; u < 512; u += G) attn_unit(p, u);
        for (int n = c; n < 256; n += G) sgu_unit(p, n, lds);
        }
    }
    xcd_barrier(xb);
    {
        pg8::StaticOrder S; S.init(NTOK, 1024, G, c);
        pg8::Gemm ga{ws + OFF_R1, ws + OFF_WPAT, 1024, 512, NTOK, 1024, 512, 0};
        EpiM1 E1{(h16*)(ws + OFF_M1), (const h16*)(ws + OFF_GATES)};
        pg8::gemm_phase(lds, ga, S, E1);
        pg8::Gemm gb{ws + OFF_R1 + 1024, ws + OFF_WPBT, 1024, 512, NTOK, 1024, 512, 0};
        EpiM2 E2{(const h16*)(ws + OFF_M1), (const h16*)(ws + OFF_GATES), (h16*)(ws + OFF_MM)};
        pg8::gemm_phase(lds, gb, S, E2);
    }
    xcd_barrier(xb);
    {
        pg8::StaticOrder S; S.init(NTOK, 1024, G, c);
        pg8::Gemm g{ws + OFF_MM, ws + OFF_WOUTT, 1024, 1024, NTOK, 1024, 1024, 0};
        EpiX1 E{p.in[I_X], (const float*)(ws + OFF_MOD), (h16*)(ws + OFF_X1H)};
        pg8::gemm_phase(lds, g, S, E);
    }
    xcd_barrier(xb);
    phase6(p, (float*)shm);
    xcd_barrier(xb);
    {
        pg8::StaticOrder S; S.init(NTOK, 2048, G, c);
        pg8::Gemm g{ws + OFF_R1, ws + OFF_WQT, 1024, 1024, NTOK, 2048, 1024, 0};
        EpiH16 E{(h16*)(ws + OFF_SC16), 2048};
        pg8::gemm_phase(lds, g, S, E);
    }
    xcd_barrier(xb);
    peer_phase(p, lds, bar, epoch);
}

extern "C" void kernel_launch(void* const* d_in, const int* in_sizes, int n_in, void* d_out, int out_size, void* d_ws, size_t ws_size, hipStream_t stream) {
    static int grid_blocks = 0;
    if (!grid_blocks) {
        int dev = 0, cus = 0, per_cu = 0;
        hipGetDevice(&dev);
        hipDeviceGetAttribute(&cus, hipDeviceAttributeMultiprocessorCount, dev);
        hipFuncSetAttribute((const void*)mega, hipFuncAttributeMaxDynamicSharedMemorySize, LDS_BYTES);
        hipOccupancyMaxActiveBlocksPerMultiprocessor(&per_cu, (const void*)mega, 512, LDS_BYTES);
        if (per_cu < 1) per_cu = 1;
        grid_blocks = cus * per_cu;
        if (ws_size < WS_END) fprintf(stderr, "kernel_launch: workspace too small: %zu < %zu\n", ws_size, (size_t)WS_END);
    }
    hipMemsetAsync((unsigned char*)d_ws + OFF_BAR, 0, 16384, stream);
    Params p{};
    for (int i = 0; i < 21; ++i) p.in[i] = (const float*)d_in[i];
    p.out = (float*)d_out; p.ws = (unsigned char*)d_ws;
    void* args[] = {&p};
    hipError_t e = hipLaunchCooperativeKernel((const void*)mega, dim3(grid_blocks), dim3(512), args, LDS_BYTES, stream);
    if (e != hipSuccess) fprintf(stderr, "cooperative launch failed: %s (grid %d)\n", hipGetErrorString(e), grid_blocks);
}
```

```cpp
#include <hip/hip_runtime.h>
#include <hip/hip_cooperative_groups.h>
#include <cstdio>
namespace cg = cooperative_groups;

#define LAS __attribute__((address_space(3)))
typedef _Float16 h16;
typedef _Float16 h16x2 __attribute__((ext_vector_type(2)));
typedef _Float16 h16x4 __attribute__((ext_vector_type(4)));
typedef _Float16 h16x8 __attribute__((ext_vector_type(8)));
typedef float f32x4 __attribute__((ext_vector_type(4)));
typedef float f32x2 __attribute__((ext_vector_type(2)));
typedef int i32x4 __attribute__((ext_vector_type(4)));
typedef int i32x2 __attribute__((ext_vector_type(2)));

constexpr int NTOK = 32768, DM = 1024, NCTXT = 4096, INC = 4608, SEQ = 2048, CTXL = 256;
constexpr int LDS_BYTES = 144 * 1024;
#ifndef REP_SEL
#define REP_SEL 1
#endif
#ifndef REP_GATH
#define REP_GATH 1
#endif
#ifndef REP_P3
#define REP_P3 1
#endif

constexpr size_t al256(size_t x) { return (x + 255) & ~(size_t)255; }
constexpr size_t OFF_WINT = 0;
constexpr size_t OFF_WPAT = OFF_WINT + (size_t)INC * DM * 2;
constexpr size_t OFF_WPBT = OFF_WPAT + (size_t)1024 * 512 * 2;
constexpr size_t OFF_WOUTT = OFF_WPBT + (size_t)1024 * 512 * 2;
constexpr size_t OFF_WQT = OFF_WOUTT + (size_t)1024 * 1024 * 2;
constexpr size_t OFF_BD = OFF_WQT + (size_t)2048 * 1024 * 2;
constexpr size_t OFF_U16 = OFF_BD + (size_t)2048 * 256 * 2;
constexpr size_t OFF_V16 = OFF_U16 + (size_t)16384 * 1024 * 2;
constexpr size_t OFF_WS16 = OFF_V16 + (size_t)16384 * 1024 * 2;
constexpr size_t OFF_MODP = OFF_WS16 + (size_t)8 * 128 * 128 * 2;
constexpr size_t OFF_MOD = OFF_MODP + (size_t)16 * 17 * 6144 * 4;
constexpr size_t OFF_R1 = al256(OFF_MOD + (size_t)17 * 6144 * 4);
constexpr size_t OFF_QB = OFF_R1 + (size_t)NTOK * DM * 2;
constexpr size_t OFF_KB = OFF_QB + (size_t)NTOK * 512 * 2;
constexpr size_t OFF_VT = OFF_KB + (size_t)NTOK * 512 * 2;
constexpr size_t OFF_GUV = OFF_VT + (size_t)NTOK * 512 * 2;
constexpr size_t OFF_GATES = OFF_GUV + (size_t)NTOK * 1024 * 2;
constexpr size_t OFF_MM = OFF_GATES + (size_t)NTOK * 2048 * 2;
constexpr size_t OFF_BAR = OFF_MM + (size_t)NTOK * DM * 2;
constexpr size_t WS_END = OFF_BAR + 16384;
constexpr size_t OFF_U8 = OFF_U16;
constexpr size_t OFF_USC = OFF_V16;
constexpr size_t OFF_V8 = OFF_V16;
constexpr size_t OFF_VSC = OFF_V16 + (size_t)16384 * 1024;
constexpr size_t OFF_M1 = OFF_QB;
constexpr size_t OFF_SC16 = OFF_QB;
constexpr size_t OFF_Q16 = OFF_GATES;
constexpr size_t OFF_X1H = OFF_GATES;
constexpr size_t OFF_HC = OFF_MM;
constexpr size_t OFF_KC = OFF_HC + (size_t)NCTXT * DM * 2;
constexpr size_t OFF_VCT = OFF_KC + (size_t)NCTXT * 512 * 2;
static_assert(OFF_M1 + (size_t)NTOK * DM * 4 <= OFF_GATES, "m1 alias");
static_assert(WS_END <= (size_t)512 * 1024 * 1024, "workspace");

struct Params {
    const float* in[21];
    float* out;
    unsigned char* ws;
};
enum { I_X = 0, I_C, I_CTX, I_CCTX, I_ADAW, I_ADAB, I_N1G, I_N2G, I_WIN, I_RPB, I_LNG, I_GMWS, I_GMBS, I_WPA, I_WPB, I_WOUT, I_WQ, I_KEYS, I_PU, I_PV, I_FG };

__device__ __forceinline__ int launder(int x) { asm volatile("" : "+v"(x)); return x; }
__device__ __forceinline__ int fresh_tid() { int t = threadIdx.x; asm volatile("" : "+v"(t)); return t; }

__device__ __forceinline__ float sigmoidf_(float x) { return __builtin_amdgcn_rcpf(1.0f + __expf(-x)); }
__device__ __forceinline__ float gelu_tanh(float x) {
    const float t = 0.7978845608028654f * (x + 0.044715f * x * x * x);
    return x * __builtin_amdgcn_rcpf(1.0f + __expf(-2.0f * t));
}
__device__ __forceinline__ float silu_(float x) { return x * __builtin_amdgcn_rcpf(1.0f + __expf(-x)); }
__device__ __forceinline__ float wave_sum(float v) {
#pragma unroll
    for (int o = 32; o > 0; o >>= 1) v += __shfl_xor(v, o);
    return v;
}
__device__ __forceinline__ h16x8 pack8(f32x4 a, f32x4 b) {
    h16x8 o;
    o[0] = (h16)a[0]; o[1] = (h16)a[1]; o[2] = (h16)a[2]; o[3] = (h16)a[3];
    o[4] = (h16)b[0]; o[5] = (h16)b[1]; o[6] = (h16)b[2]; o[7] = (h16)b[3];
    return o;
}


__device__ __forceinline__ void grid_bar(unsigned* ctr, unsigned& epoch, unsigned nblk) {
    __syncthreads();
    epoch += 1u;
    if (threadIdx.x == 0) {
        __builtin_amdgcn_fence(__ATOMIC_RELEASE, "agent");
        asm volatile("s_waitcnt vmcnt(0)" ::: "memory");
        __hip_atomic_fetch_add(ctr, 1u, __ATOMIC_RELAXED, __HIP_MEMORY_SCOPE_AGENT);
        const unsigned target = epoch * nblk;
        unsigned spins = 0;
        while (__hip_atomic_load(ctr, __ATOMIC_RELAXED, __HIP_MEMORY_SCOPE_AGENT) < target) { __builtin_amdgcn_s_sleep(2); if (++spins > (1u << 24)) break; }
        __builtin_amdgcn_fence(__ATOMIC_ACQUIRE, "agent");
        asm volatile("s_waitcnt vmcnt(0)" ::: "memory");
    }
    __syncthreads();
}


#define XB_TMO      128
#define XB_XCNT(j)  (256  + 64 * (j))
#define XB_XSUB(j)  (1280 + 64 * (j))
#define XB_XGEN(j)  (2304 + 64 * (j))
#define XB_TOP      3328
#define XB_TOPGEN   3392
#define XCD_BAR_WORDS 3456
#define XB_SPIN_CAP (1u << 20)
__device__ __forceinline__ unsigned xb_ld(unsigned* p)              { return __hip_atomic_load(p, __ATOMIC_RELAXED, __HIP_MEMORY_SCOPE_AGENT); }
__device__ __forceinline__ unsigned xb_add(unsigned* p, unsigned v) { return __hip_atomic_fetch_add(p, v, __ATOMIC_RELAXED, __HIP_MEMORY_SCOPE_AGENT); }
__device__ __forceinline__ unsigned xb_xcc_id() { return (unsigned)__builtin_amdgcn_s_getreg((3 << 11) | 20) & 0xFu; }
#define XB_SPIN(cond, bar) do { unsigned _sp = 0; while (cond) { __builtin_amdgcn_s_sleep(1); \
    if ((++_sp & 255u) == 0u) { if (xb_ld(&(bar)[XB_TMO])) break; if (_sp > XB_SPIN_CAP) { atomicAdd(&(bar)[XB_TMO], 1u); break; } } } } while (0)
struct XcdBarrier { unsigned* bar; unsigned x; volatile LAS unsigned* st; };
__device__ __forceinline__ XcdBarrier xcd_barrier_post(unsigned* bar, volatile LAS unsigned* st) {
    XcdBarrier b; b.bar = bar; b.x = xb_xcc_id(); b.st = st;
    if (threadIdx.x == 0) (void)xb_add(&bar[XB_XCNT(b.x)], 1u);
    return b;
}
__device__ __forceinline__ void xcd_barrier_complete(unsigned* bar, unsigned x, unsigned& nloc, unsigned& nx) {
    const unsigned G = gridDim.x * gridDim.y * gridDim.z;
    unsigned sum, cnt, mine, sp = 0u;
    for (;;) {
        sum = 0u; cnt = 0u; mine = 0u;
#pragma unroll
        for (unsigned j = 0; j < 16; ++j) { const unsigned c = xb_ld(&bar[XB_XCNT(j)]); sum += c; cnt += (c > 0u) ? 1u : 0u; mine = (j == x) ? c : mine; }
        if (sum == G) break;
        __builtin_amdgcn_s_sleep(1);
        if ((++sp & 255u) == 0u) { if (xb_ld(&bar[XB_TMO])) break; if (sp > XB_SPIN_CAP) { atomicAdd(&bar[XB_TMO], 1u); break; } }
    }
    nloc = mine > 0u ? mine : 1u; nx = cnt > 0u ? cnt : 1u;
}
__device__ __forceinline__ void xcd_barrier(const XcdBarrier& b) {
    asm volatile("s_waitcnt vmcnt(0)" ::: "memory");
    __syncthreads();
    if (threadIdx.x == 0) {
        unsigned* bar = b.bar;
        __builtin_amdgcn_s_waitcnt(0);
        unsigned nloc = b.st[0], nx = b.st[1];
        if (nloc == 0u) { xcd_barrier_complete(bar, b.x, nloc, nx); b.st[0] = nloc; b.st[1] = nx; }
        const unsigned old = xb_add(&bar[XB_XSUB(b.x)], 1u);
        const unsigned gen = old / nloc;
        if (old + 1u == (gen + 1u) * nloc) {
            __builtin_amdgcn_fence(__ATOMIC_RELEASE, "agent");
            asm volatile("s_waitcnt vmcnt(0)" ::: "memory");
            const unsigned og = xb_add(&bar[XB_TOP], 1u);
            const unsigned tg = og / nx;
            if (og + 1u == (tg + 1u) * nx) xb_add(&bar[XB_TOPGEN], 1u);
            else XB_SPIN(xb_ld(&bar[XB_TOPGEN]) == tg, bar);
            __builtin_amdgcn_fence(__ATOMIC_ACQUIRE, "agent");
            xb_add(&bar[XB_XGEN(b.x)], 1u);
            asm volatile("s_waitcnt vmcnt(0)" ::: "memory");
        } else {
            XB_SPIN(xb_ld(&bar[XB_XGEN(b.x)]) == gen, bar);
            __builtin_amdgcn_fence(__ATOMIC_ACQUIRE, "agent");
            asm volatile("s_waitcnt vmcnt(0)" ::: "memory");
        }
    }
    __syncthreads();
}

namespace pg8 {
constexpr int BM = 256, BK = 64, HALF = 128, HTB = HALF * BK * 2, STAGE_BYTES = 8 * HTB, NXCD = 8, WGM = 8;
__device__ __forceinline__ int lds_byte(int r, int c) { const int st = (r >> 4) * 2 + (c >> 5), rr = r & 15, cc = c & 31, ob = rr * 64 + cc * 2; return st * 1024 + (ob ^ (((ob >> 9) & 1) << 5)); }
__device__ __forceinline__ void stage_rc(int b, int& R, int& C) { const int st = b / 1024, sb = b % 1024, swz = sb ^ (((sb >> 9) & 1) << 5); R = (st >> 1) * 16 + swz / 64; C = (st & 1) * 32 + (swz % 64) / 2; }
__device__ __forceinline__ int perm32(int rho) { const int n = rho >> 4, i = rho & 15; return 8 * (i >> 2) + 4 * n + (i & 3); }

struct Unit { int pm, pn; };
struct Gemm { const void* A; const void* Bt; int lda, ldb, M, N, K, a_pn_bytes; };

struct StaticOrder {
    int nM, nN, nwg, G, c;
    __device__ void init(int M, int N, int G_, int c_) { nM = M / BM; nN = N / BM; nwg = nM * nN; G = G_; c = c_; }
    __device__ bool next(int i, Unit& u) const {
        const long L = (long)i * G + c; if (L >= nwg) return false;
        int wgid = (int)L; { const int q = nwg / NXCD, r = nwg % NXCD, xcd = wgid % NXCD, off = wgid / NXCD; wgid = (xcd < r ? xcd * (q + 1) : r * (q + 1) + (xcd - r) * q) + off; }
        const int nig = WGM * nN, gid = wgid / nig, fm = gid * WGM, gsz = (nM - fm) < WGM ? (nM - fm) : WGM;
        u.pm = fm + ((wgid % nig) % gsz); u.pn = (wgid % nig) / gsz; return true;
    }
};

template <class Epi>
__device__ __forceinline__ void gemm_phase(LAS unsigned char* lds, const Gemm g, const StaticOrder& S, const Epi& E) {
    const int tid = fresh_tid(), wid = __builtin_amdgcn_readfirstlane(tid >> 6), lane = tid & 63, wr = wid >> 2, wc = wid & 3, fr = lane & 15, fq = lane >> 4;
    const int K = g.K, nt = K / BK;
    unsigned voffA[2], voffB[2];
#pragma unroll
    for (int i = 0; i < 2; ++i) { int R, C; stage_rc(tid * 16 + i * 8192, R, C); const int Rb = (R & ~31) + perm32(R & 31);
        voffA[i] = (unsigned)(R * g.lda + C) * 2u; voffB[i] = (unsigned)(Rb * g.ldb + C) * 2u; }
    const size_t kstep = (size_t)(BK * 2);
    const size_t hstepA = (size_t)HALF * g.lda * 2, hstepB = (size_t)HALF * g.ldb * 2;
    const size_t tstepA = 2 * hstepA, tstepB = 2 * hstepB;
    const unsigned ldsw = (unsigned)wid * 1024u;
    const int aoff = lds_byte(wr * 64 + fr, fq * 8), boff = lds_byte(wc * 32 + fr, fq * 8);
#define PG8_SA(b, h) (((b) * 2 + (h)) * HTB)
#define PG8_SB(b, h) ((4 + (b) * 2 + (h)) * HTB)
#define PG8_STAGE(bufoff, gbase, voff) do { _Pragma("unroll") for (int _i = 0; _i < 2; ++_i) \
        __builtin_amdgcn_global_load_lds((const unsigned*)((const char*)(gbase) + (voff)[_i]), (LAS unsigned*)(lds + (bufoff) + ldsw + _i * 8192), 16, 0, 0); } while (0)
#define PG8_LDA(dst, b, h) do { _Pragma("unroll") for (int m = 0; m < 4; ++m) _Pragma("unroll") for (int k = 0; k < 2; ++k) dst[m][k] = *(const LAS h16x8*)(lds + PG8_SA(b, h) + aoff + m * 2048 + k * 1024); } while (0)
#define PG8_LDB(dst, b, h) do { _Pragma("unroll") for (int n = 0; n < 2; ++n) _Pragma("unroll") for (int k = 0; k < 2; ++k) dst[n][k] = *(const LAS h16x8*)(lds + PG8_SB(b, h) + boff + n * 2048 + k * 1024); } while (0)
#define PG8_MMA(ai, bj, At, Bt) do { __builtin_amdgcn_s_setprio(1); _Pragma("unroll") for (int m = 0; m < 4; ++m) _Pragma("unroll") for (int n = 0; n < 2; ++n) _Pragma("unroll") for (int k = 0; k < 2; ++k) \
        acc[ai][bj][m][n] = __builtin_amdgcn_mfma_f32_16x16x32_f16(Bt[n][k], At[m][k], acc[ai][bj][m][n], 0, 0, 0); __builtin_amdgcn_s_setprio(0); } while (0)
#define PG8_WAIT_V(n) asm volatile("s_waitcnt vmcnt(" #n ")" ::: "memory")
#define PG8_WAIT_L(n) asm volatile("s_waitcnt lgkmcnt(" #n ")" ::: "memory")
#define PG8_BAR __builtin_amdgcn_s_barrier()
#define PG8_SCHED __builtin_amdgcn_sched_barrier(0)
    Unit cur, nxt; int ui = 0;
    if (!S.next(0, cur)) return;
    f32x4 acc[2][2][4][2];
#pragma unroll
    for (int a = 0; a < 2; ++a)
#pragma unroll
        for (int b = 0; b < 2; ++b)
#pragma unroll
            for (int m = 0; m < 4; ++m)
#pragma unroll
                for (int n = 0; n < 2; ++n) acc[a][b][m][n] = (f32x4){0.f, 0.f, 0.f, 0.f};
    h16x8 At[4][2], B0[2][2], B1[2][2];
    const char* cA = (const char*)g.A + (size_t)cur.pm * tstepA + (size_t)cur.pn * g.a_pn_bytes; const char* cB = (const char*)g.Bt + (size_t)cur.pn * tstepB;
    PG8_STAGE(PG8_SB(0, 0), cB, voffB); PG8_STAGE(PG8_SA(0, 0), cA, voffA); PG8_STAGE(PG8_SB(0, 1), cB + hstepB, voffB); PG8_STAGE(PG8_SA(0, 1), cA + hstepA, voffA);
    if (wr == 1) PG8_BAR;
    PG8_WAIT_V(4); PG8_BAR;
    PG8_STAGE(PG8_SB(1, 0), cB + kstep, voffB); PG8_STAGE(PG8_SA(1, 0), cA + kstep, voffA); PG8_STAGE(PG8_SB(1, 1), cB + hstepB + kstep, voffB);
    PG8_WAIT_V(6); PG8_BAR;
    for (;;) {
        const bool has_next = S.next(ui + 1, nxt);
        const char* nA = has_next ? (const char*)g.A + (size_t)nxt.pm * tstepA + (size_t)nxt.pn * g.a_pn_bytes : cA; const char* nB = has_next ? (const char*)g.Bt + (size_t)nxt.pn * tstepB : cB;
        for (int t = 0; t < nt; t += 2) {
            const bool last = (t == nt - 2);
            const char* a1 = cA + (size_t)(t + 1) * kstep;
            const char* a2 = last ? nA : cA + (size_t)(t + 2) * kstep; const char* b2 = last ? nB : cB + (size_t)(t + 2) * kstep;
            const char* a3 = a2 + kstep; const char* b3 = b2 + kstep;
            PG8_LDB(B0, 0, 0); PG8_SCHED; PG8_LDA(At, 0, 0); PG8_STAGE(PG8_SA(1, 1), a1 + hstepA, voffA);
            PG8_WAIT_L(8); PG8_BAR; PG8_WAIT_L(0); PG8_MMA(0, 0, At, B0); PG8_BAR; PG8_SCHED;
            PG8_LDB(B1, 0, 1); PG8_STAGE(PG8_SB(0, 0), b2, voffB);
            PG8_BAR; PG8_WAIT_L(0); PG8_MMA(0, 1, At, B1); PG8_BAR;
            PG8_LDA(At, 0, 1); PG8_STAGE(PG8_SA(0, 0), a2, voffA);
            PG8_BAR; PG8_WAIT_L(0); PG8_MMA(1, 0, At, B0); PG8_BAR; PG8_SCHED;
            PG8_STAGE(PG8_SB(0, 1), b2 + hstepB, voffB);
            PG8_WAIT_V(6); PG8_BAR; PG8_MMA(1, 1, At, B1); PG8_BAR;
            PG8_LDB(B0, 1, 0); PG8_SCHED; PG8_LDA(At, 1, 0); PG8_STAGE(PG8_SA(0, 1), a2 + hstepA, voffA);
            PG8_WAIT_L(8); PG8_BAR; PG8_WAIT_L(0); PG8_MMA(0, 0, At, B0); PG8_BAR; PG8_SCHED;
            PG8_LDB(B1, 1, 1); PG8_STAGE(PG8_SB(1, 0), b3, voffB);
            PG8_BAR; PG8_WAIT_L(0); PG8_MMA(0, 1, At, B1); PG8_BAR;
            PG8_LDA(At, 1, 1); PG8_STAGE(PG8_SA(1, 0), a3, voffA);
            PG8_BAR; PG8_WAIT_L(0); PG8_MMA(1, 0, At, B0); PG8_BAR; PG8_SCHED;
            PG8_STAGE(PG8_SB(1, 1), b3 + hstepB, voffB);
            PG8_WAIT_V(6); PG8_BAR; PG8_MMA(1, 1, At, B1); PG8_BAR;
        }
        E(acc, cur, wr, wc, fr, fq);
        if (!has_next) break;
#pragma unroll
        for (int a = 0; a < 2; ++a)
#pragma unroll
            for (int b = 0; b < 2; ++b)
#pragma unroll
                for (int m = 0; m < 4; ++m)
#pragma unroll
                    for (int n = 0; n < 2; ++n) acc[a][b][m][n] = (f32x4){0.f, 0.f, 0.f, 0.f};
        cur = nxt; cA = nA; cB = nB; ++ui;
    }
    PG8_WAIT_V(0);
    if (wr == 0) PG8_BAR;
    PG8_BAR;
#undef PG8_SA
#undef PG8_SB
#undef PG8_STAGE
#undef PG8_LDA
#undef PG8_LDB
#undef PG8_MMA
#undef PG8_WAIT_V
#undef PG8_WAIT_L
#undef PG8_BAR
#undef PG8_SCHED
}
}
typedef f32x4 AccT[2][2][4][2];

struct EpiIn {
    h16 *qb, *kb, *vt, *guv, *gates;
    __device__ __forceinline__ void operator()(const AccT& acc, const pg8::Unit& u, int wr, int wc, int fr, int fq) const {
        const int pn = u.pn;
        const int row0 = u.pm * 256 + wr * 64 + fr;
        const int cin = wc * 32 + 8 * fq;
        const int b = (u.pm * 256) >> 11, sb = ((u.pm * 256) & 2047) + wr * 64;
        if (pn < 2) {
            h16* base = qb + (size_t)row0 * 512 + pn * 256 + cin;
#pragma unroll
            for (int ai = 0; ai < 2; ++ai)
#pragma unroll
                for (int m = 0; m < 4; ++m)
#pragma unroll
                    for (int bj = 0; bj < 2; ++bj) *(h16x8*)(base + (ai * 128 + m * 16) * 512 + bj * 128) = pack8(acc[ai][bj][m][0], acc[ai][bj][m][1]);
        } else if (pn < 4) {
#pragma unroll
            for (int bj = 0; bj < 2; ++bj) {
                const int col = (pn & 1) * 256 + bj * 128 + cin, hd = col >> 6, d0 = col & 63;
                h16* base = kb + ((size_t)(b * 8 + hd) * 2048 + sb + fr) * 64 + d0;
#pragma unroll
                for (int ai = 0; ai < 2; ++ai)
#pragma unroll
                    for (int m = 0; m < 4; ++m) *(h16x8*)(base + (ai * 128 + m * 16) * 64) = pack8(acc[ai][bj][m][0], acc[ai][bj][m][1]);
            }
        } else if (pn < 6) {
#pragma unroll
            for (int bj = 0; bj < 2; ++bj) {
                const int cv = (pn - 4) * 256 + bj * 128 + cin, hd = cv >> 6, d0 = cv & 63;
                h16* base = vt + ((size_t)(b * 8 + hd) * 256 + (sb >> 3) + (fr >> 3)) * 512 + d0 * 8 + (fr & 7);
#pragma unroll
                for (int ai = 0; ai < 2; ++ai)
#pragma unroll
                    for (int m = 0; m < 4; ++m) {
                        h16* vp = base + (ai * 16 + m * 2) * 512;
                        const f32x4 v0 = acc[ai][bj][m][0], v1 = acc[ai][bj][m][1];
#pragma unroll
                        for (int i = 0; i < 4; ++i) { vp[i * 8] = (h16)v0[i]; vp[(i + 4) * 8] = (h16)v1[i]; }
                    }
            }
        } else if (pn < 10) {
            h16* base = guv + (size_t)row0 * 1024 + (pn - 6) * 256 + cin;
#pragma unroll
            for (int ai = 0; ai < 2; ++ai)
#pragma unroll
                for (int m = 0; m < 4; ++m)
#pragma unroll
                    for (int bj = 0; bj < 2; ++bj) {
                        f32x4 v0 = acc[ai][bj][m][0], v1 = acc[ai][bj][m][1];
#pragma unroll
                        for (int i = 0; i < 4; ++i) { v0[i] = gelu_tanh(v0[i]); v1[i] = gelu_tanh(v1[i]); }
                        *(h16x8*)(base + (ai * 128 + m * 16) * 1024 + bj * 128) = pack8(v0, v1);
                    }
        } else {
            h16* base = gates + (size_t)row0 * 2048 + (pn - 10) * 256 + cin;
#pragma unroll
            for (int ai = 0; ai < 2; ++ai)
#pragma unroll
                for (int m = 0; m < 4; ++m)
#pragma unroll
                    for (int bj = 0; bj < 2; ++bj) {
                        f32x4 v0 = acc[ai][bj][m][0], v1 = acc[ai][bj][m][1];
#pragma unroll
                        for (int i = 0; i < 4; ++i) { v0[i] = sigmoidf_(v0[i]); v1[i] = sigmoidf_(v1[i]); }
                        *(h16x8*)(base + (ai * 128 + m * 16) * 2048 + bj * 128) = pack8(v0, v1);
                    }
        }
    }
};
struct EpiCtx {
    h16 *kc, *vct;
    __device__ __forceinline__ void operator()(const AccT& acc, const pg8::Unit& u, int wr, int wc, int fr, int fq) const {
        const int pn = u.pn;
        const int cin = wc * 32 + 8 * fq;
        const int b = u.pm, sb = wr * 64;
        if (pn < 2) {
#pragma unroll
            for (int bj = 0; bj < 2; ++bj) {
                const int col = pn * 256 + bj * 128 + cin, hd = col >> 6, d0 = col & 63;
                h16* base = kc + ((size_t)(b * 8 + hd) * 256 + sb + fr) * 64 + d0;
#pragma unroll
                for (int ai = 0; ai < 2; ++ai)
#pragma unroll
                    for (int m = 0; m < 4; ++m) *(h16x8*)(base + (ai * 128 + m * 16) * 64) = pack8(acc[ai][bj][m][0], acc[ai][bj][m][1]);
            }
        } else {
#pragma unroll
            for (int bj = 0; bj < 2; ++bj) {
                const int cv = (pn - 2) * 256 + bj * 128 + cin, hd = cv >> 6, d0 = cv & 63;
                h16* base = vct + ((size_t)(b * 8 + hd) * 32 + (sb >> 3) + (fr >> 3)) * 512 + d0 * 8 + (fr & 7);
#pragma unroll
                for (int ai = 0; ai < 2; ++ai)
#pragma unroll
                    for (int m = 0; m < 4; ++m) {
                        h16* vp = base + (ai * 16 + m * 2) * 512;
                        const f32x4 v0 = acc[ai][bj][m][0], v1 = acc[ai][bj][m][1];
#pragma unroll
                        for (int i = 0; i < 4; ++i) { vp[i * 8] = (h16)v0[i]; vp[(i + 4) * 8] = (h16)v1[i]; }
                    }
            }
        }
    }
};
struct EpiM1 {
    h16* m1; const h16* gates;
    __device__ __forceinline__ void operator()(const AccT& acc, const pg8::Unit& u, int wr, int wc, int fr, int fq) const {
        const int row0 = u.pm * 256 + wr * 64 + fr, col0 = u.pn * 256 + wc * 32 + 8 * fq;
#pragma unroll
        for (int ai = 0; ai < 2; ++ai)
#pragma unroll
            for (int m = 0; m < 4; ++m) {
                const int row = row0 + ai * 128 + m * 16;
#pragma unroll
                for (int bj = 0; bj < 2; ++bj) {
                    const int col = col0 + bj * 128;
                    const h16x8 gt = *(const h16x8*)(gates + (size_t)row * 2048 + col);
                    f32x4 v0 = acc[ai][bj][m][0], v1 = acc[ai][bj][m][1];
#pragma unroll
                    for (int i = 0; i < 4; ++i) { v0[i] *= (float)gt[i]; v1[i] *= (float)gt[4 + i]; }
                    *(h16x8*)(m1 + (size_t)row * 1024 + col) = pack8(v0, v1);
                }
            }
    }
};
struct EpiM2 {
    const h16* m1; const h16* gates; h16* mm;
    __device__ __forceinline__ void operator()(const AccT& acc, const pg8::Unit& u, int wr, int wc, int fr, int fq) const {
        const int row0 = u.pm * 256 + wr * 64 + fr, col0 = u.pn * 256 + wc * 32 + 8 * fq;
#pragma unroll
        for (int ai = 0; ai < 2; ++ai)
#pragma unroll
            for (int m = 0; m < 4; ++m) {
                const int row = row0 + ai * 128 + m * 16;
#pragma unroll
                for (int bj = 0; bj < 2; ++bj) {
                    const int col = col0 + bj * 128;
                    const h16x8 gt = *(const h16x8*)(gates + (size_t)row * 2048 + 1024 + col);
                    const h16x8 mi = *(const h16x8*)(m1 + (size_t)row * 1024 + col);
                    f32x4 p0 = (f32x4){(float)mi[0], (float)mi[1], (float)mi[2], (float)mi[3]}, p1 = (f32x4){(float)mi[4], (float)mi[5], (float)mi[6], (float)mi[7]};
                    const f32x4 v0 = acc[ai][bj][m][0], v1 = acc[ai][bj][m][1];
#pragma unroll
                    for (int i = 0; i < 4; ++i) { p0[i] += v0[i] * (float)gt[i]; p1[i] += v1[i] * (float)gt[4 + i]; }
                    *(h16x8*)(mm + (size_t)row * 1024 + col) = pack8(p0, p1);
                }
            }
    }
};
struct EpiX1 {
    const float* x; const float* mod; h16* x1;
    __device__ __forceinline__ void operator()(const AccT& acc, const pg8::Unit& u, int wr, int wc, int fr, int fq) const {
        const int row0 = u.pm * 256 + wr * 64 + fr, col0 = u.pn * 256 + wc * 32 + 8 * fq;
        const int b = (u.pm * 256) >> 11;
#pragma unroll
        for (int bj = 0; bj < 2; ++bj) {
            const int col = col0 + bj * 128;
            const float* gp = mod + (size_t)b * 6144 + 2 * 1024 + col;
            const f32x4 g0 = *(const f32x4*)gp, g1 = *(const f32x4*)(gp + 4);
#pragma unroll
            for (int ai = 0; ai < 2; ++ai)
#pragma unroll
                for (int m = 0; m < 4; ++m) {
                    const int row = row0 + ai * 128 + m * 16;
                    const float* xi = x + (size_t)row * 1024 + col;
                    const f32x4 x0 = *(const f32x4*)xi, x1v = *(const f32x4*)(xi + 4);
                    *(h16x8*)(x1 + (size_t)row * 1024 + col) = pack8(x0 + g0 * acc[ai][bj][m][0], x1v + g1 * acc[ai][bj][m][1]);
                }
        }
    }
};
struct EpiH16 {
    h16* o; int ldc;
    __device__ __forceinline__ void operator()(const AccT& acc, const pg8::Unit& u, int wr, int wc, int fr, int fq) const {
        const int row0 = u.pm * 256 + wr * 64 + fr, col0 = u.pn * 256 + wc * 32 + 8 * fq;
#pragma unroll
        for (int ai = 0; ai < 2; ++ai)
#pragma unroll
            for (int m = 0; m < 4; ++m) {
                const int row = row0 + ai * 128 + m * 16;
#pragma unroll
                for (int bj = 0; bj < 2; ++bj)
                    *(h16x8*)(o + (size_t)row * ldc + col0 + bj * 128) = pack8(acc[ai][bj][m][0], acc[ai][bj][m][1]);
            }
    }
};

__device__ __forceinline__ void cvt_tile(const float* __restrict__ src, h16* __restrict__ dst, int tile) {
    const size_t i = (size_t)tile * 4096 + threadIdx.x * 8;
    const f32x4 a = *(const f32x4*)(src + i), b = *(const f32x4*)(src + i + 4);
    *(h16x8*)(dst + i) = pack8(a, b);
}
__device__ __forceinline__ void tr_tile(const float* __restrict__ src, h16* __restrict__ dst, int K, int N, int tile, float* lds) {
    const int ntn = N / 64, tk = tile / ntn, tn = tile % ntn, tid = threadIdx.x;
#pragma unroll
    for (int ps = 0; ps < 2; ++ps) {
        const int k = ps * 32 + (tid >> 4), n = (tid & 15) * 4;
        const f32x4 v = *(const f32x4*)(src + (size_t)(tk * 64 + k) * N + tn * 64 + n);
        lds[k * 65 + n] = v[0]; lds[k * 65 + n + 1] = v[1]; lds[k * 65 + n + 2] = v[2]; lds[k * 65 + n + 3] = v[3];
    }
    __syncthreads();
    {
        const int n = tid >> 3, ks = (tid & 7) * 8;
        h16x8 o;
#pragma unroll
        for (int i = 0; i < 8; ++i) o[i] = (h16)lds[(ks + i) * 65 + n];
        *(h16x8*)(dst + (size_t)(tn * 64 + n) * K + tk * 64 + ks) = o;
    }
    __syncthreads();
}
__device__ __forceinline__ void cvt8_rows(const float* __restrict__ src, unsigned char* __restrict__ dst, float* __restrict__ inv, int tile, int dstride = 1024) {
    const int wid = threadIdx.x >> 6, lane = threadIdx.x & 63;
    const size_t row = (size_t)tile * 8 + wid;
    const float* r = src + row * 1024 + lane * 16;
    f32x4 a[4]; float mx = 0.f;
#pragma unroll
    for (int i = 0; i < 4; ++i) { a[i] = *(const f32x4*)(r + 4 * i); mx = fmaxf(mx, fmaxf(fmaxf(fabsf(a[i][0]), fabsf(a[i][1])), fmaxf(fabsf(a[i][2]), fabsf(a[i][3])))); }
#pragma unroll
    for (int o = 32; o > 0; o >>= 1) mx = fmaxf(mx, __shfl_xor(mx, o));
    int ex2 = 0; float sc = 1.0f;
    if (mx > 0.f) { (void)frexpf(mx, &ex2); int k = 8 - ex2; k = k > 100 ? 100 : (k < -100 ? -100 : k); sc = ldexpf(1.0f, k); }
    i32x4 w;
#pragma unroll
    for (int i = 0; i < 4; ++i) {
        int pk = __builtin_amdgcn_cvt_pk_fp8_f32(a[i][0] * sc, a[i][1] * sc, 0, false);
        pk = __builtin_amdgcn_cvt_pk_fp8_f32(a[i][2] * sc, a[i][3] * sc, pk, true);
        w[i] = pk;
    }
    *(i32x4*)(dst + row * dstride + lane * 16) = w;
    if (lane == 0) inv[2 * row] = 1.0f / sc;
}
__device__ __forceinline__ void cvt4_rows(const float* __restrict__ src, unsigned char* __restrict__ dst, float* __restrict__ inv, int tile, int dstride = 512) {
    const int wid = threadIdx.x >> 6, lane = threadIdx.x & 63;
    const size_t row = (size_t)tile * 8 + wid;
    const float* r = src + row * 1024 + lane * 16;
    f32x4 a[4]; float mx = 0.f;
#pragma unroll
    for (int i = 0; i < 4; ++i) { a[i] = *(const f32x4*)(r + 4 * i); mx = fmaxf(mx, fmaxf(fmaxf(fabsf(a[i][0]), fabsf(a[i][1])), fmaxf(fabsf(a[i][2]), fabsf(a[i][3])))); }
#pragma unroll
    for (int o = 32; o > 0; o >>= 1) mx = fmaxf(mx, __shfl_xor(mx, o));
    const float sc = (mx > 1e-30f) ? 6.0f / mx : 1.0f;
    int w0 = 0, w1 = 0;
    w0 = __builtin_amdgcn_cvt_scalef32_pk_fp4_f32(w0, a[0][0] * sc, a[0][1] * sc, 1.0f, 0);
    w0 = __builtin_amdgcn_cvt_scalef32_pk_fp4_f32(w0, a[0][2] * sc, a[0][3] * sc, 1.0f, 1);
    w0 = __builtin_amdgcn_cvt_scalef32_pk_fp4_f32(w0, a[1][0] * sc, a[1][1] * sc, 1.0f, 2);
    w0 = __builtin_amdgcn_cvt_scalef32_pk_fp4_f32(w0, a[1][2] * sc, a[1][3] * sc, 1.0f, 3);
    w1 = __builtin_amdgcn_cvt_scalef32_pk_fp4_f32(w1, a[2][0] * sc, a[2][1] * sc, 1.0f, 0);
    w1 = __builtin_amdgcn_cvt_scalef32_pk_fp4_f32(w1, a[2][2] * sc, a[2][3] * sc, 1.0f, 1);
    w1 = __builtin_amdgcn_cvt_scalef32_pk_fp4_f32(w1, a[3][0] * sc, a[3][1] * sc, 1.0f, 2);
    w1 = __builtin_amdgcn_cvt_scalef32_pk_fp4_f32(w1, a[3][2] * sc, a[3][3] * sc, 1.0f, 3);
    *(i32x2*)(dst + row * dstride + lane * 8) = (i32x2){w0, w1};
    if (lane == 0) inv[2 * row] = 1.0f / sc;
}
__device__ __forceinline__ void wqk_tile(const float* __restrict__ wq, const float* __restrict__ keys, h16* __restrict__ wt, int tile, float* lds) {
    const int ct = tile >> 4, hp = tile & 15, tid = threadIdx.x;
    float* sA = lds;
    float* sB = lds + 64 * 129;
#pragma unroll
    for (int i = 0; i < 4; ++i) {
        const int e = (i * 512 + tid) * 4, r = e >> 7, d = e & 127;
        const f32x4 v = *(const f32x4*)(wq + (size_t)(ct * 64 + r) * 2048 + hp * 128 + d);
        sA[r * 129 + d] = v[0]; sA[r * 129 + d + 1] = v[1]; sA[r * 129 + d + 2] = v[2]; sA[r * 129 + d + 3] = v[3];
    }
#pragma unroll
    for (int i = 0; i < 8; ++i) {
        const int e = (i * 512 + tid) * 4, k = e >> 7, d = e & 127;
        const f32x4 v = *(const f32x4*)(keys + (size_t)(hp * 128 + k) * 128 + d);
        sB[k * 129 + d] = v[0]; sB[k * 129 + d + 1] = v[1]; sB[k * 129 + d + 2] = v[2]; sB[k * 129 + d + 3] = v[3];
    }
    __syncthreads();
    const int cg = tid >> 5, kq = tid & 31;
    float acc[4][4];
#pragma unroll
    for (int i = 0; i < 4; ++i)
#pragma unroll
        for (int j = 0; j < 4; ++j) acc[i][j] = 0.f;
#pragma unroll 4
    for (int d = 0; d < 128; ++d) {
        float a[4], bq[4];
#pragma unroll
        for (int i = 0; i < 4; ++i) a[i] = sA[(cg * 4 + i) * 129 + d];
#pragma unroll
        for (int j = 0; j < 4; ++j) bq[j] = sB[(kq + 32 * j) * 129 + d];
#pragma unroll
        for (int i = 0; i < 4; ++i)
#pragma unroll
            for (int j = 0; j < 4; ++j) acc[i][j] += a[i] * bq[j];
    }
#pragma unroll
    for (int j = 0; j < 4; ++j) {
        h16x4 o;
#pragma unroll
        for (int i = 0; i < 4; ++i) o[i] = (h16)acc[i][j];
        *(h16x4*)(wt + (size_t)(hp * 128 + kq + 32 * j) * 1024 + ct * 64 + cg * 4) = o;
    }
    __syncthreads();
}
__device__ void phase0(const Params& p, float* lds) {
    unsigned char* ws = p.ws;
    const int tid = threadIdx.x, wid = tid >> 6, lane = tid & 63;
    for (int ib = blockIdx.x; ib < 256; ib += gridDim.x) {
        if (wid < 6) {
            const int item = ib * 6 + wid, cg64 = item % 96, kc = item / 96;
            const int col = cg64 * 64 + lane, k0 = kc * 64;
            float sv[17], acc[17];
#pragma unroll
            for (int b = 0; b < 17; ++b) {
                const float cv = (b < 16) ? p.in[I_C][b * 1024 + k0 + lane] : p.in[I_CCTX][k0 + lane];
                sv[b] = silu_(cv); acc[b] = 0.f;
            }
            const float* wp = p.in[I_ADAW] + (size_t)k0 * 6144 + col;
#pragma unroll 16
            for (int j = 0; j < 64; ++j) {
                const float w = wp[(size_t)j * 6144];
#pragma unroll
                for (int b = 0; b < 17; ++b) acc[b] += __builtin_bit_cast(float, __builtin_amdgcn_readlane(__builtin_bit_cast(int, sv[b]), j)) * w;
            }
            float* mp = (float*)(ws + OFF_MODP);
#pragma unroll
            for (int b = 0; b < 17; ++b) mp[((size_t)kc * 17 + b) * 6144 + col] = acc[b];
        }
    }
    constexpr int T0 = 2048, T1 = T0 + 2048, T2 = T1 + 32, T3 = T2, T4 = T3 + 1152, T5 = T4 + 128, T6 = T5 + 128, T7 = T6 + 256, T8 = T7 + 256;
    for (int t = blockIdx.x; t < T8; t += gridDim.x) {
        if (t < T0) cvt4_rows(p.in[I_PU], ws + OFF_U8, (float*)(ws + OFF_USC), t, 1536);
        else if (t < T1) cvt8_rows(p.in[I_PV], ws + OFF_U8 + 512, (float*)(ws + OFF_USC) + 1, t - T0, 1536);
        else if (t < T2) cvt_tile(p.in[I_GMWS], (h16*)(ws + OFF_WS16), t - T1);
        else if (t < T3) {
            const int e = (t - T2) * 4096 + tid * 8;
            const int row = e >> 8, cc = e & 255, h = row >> 8, pp = (row >> 7) & 1, k = row & 127, pq = cc >> 7, d = cc & 127;
            h16x8 o = {0, 0, 0, 0, 0, 0, 0, 0};
            if (pp == pq) {
                const float* kp = p.in[I_KEYS] + ((size_t)((h * 2 + pp) * 128 + k)) * 128 + d;
                o = pack8(*(const f32x4*)kp, *(const f32x4*)(kp + 4));
            }
            *(h16x8*)((h16*)(ws + OFF_BD) + e) = o;
        }
        else if (t < T4) tr_tile(p.in[I_WIN], (h16*)(ws + OFF_WINT), 1024, INC, t - T3, lds);
        else if (t < T5) tr_tile(p.in[I_WPA], (h16*)(ws + OFF_WPAT), 512, 1024, t - T4, lds);
        else if (t < T6) tr_tile(p.in[I_WPB], (h16*)(ws + OFF_WPBT), 512, 1024, t - T5, lds);
        else if (t < T7) tr_tile(p.in[I_WOUT], (h16*)(ws + OFF_WOUTT), 1024, 1024, t - T6, lds);
        else wqk_tile(p.in[I_WQ], p.in[I_KEYS], (h16*)(ws + OFF_WQT), t - T7, lds);
    }
}

__device__ __forceinline__ void norm_rows(const float* __restrict__ src, h16* __restrict__ dst, int row_begin, int rows_per_wave, const float* sA, const float* sB) {
    const int tid_ = fresh_tid();
    const int wid = tid_ >> 6, lane = tid_ & 63;
    f32x4 a[4], bsh[4];
#pragma unroll
    for (int c = 0; c < 4; ++c) { a[c] = *(const f32x4*)(sA + c * 256 + lane * 4); bsh[c] = *(const f32x4*)(sB + c * 256 + lane * 4); }
    for (int i = 0; i < rows_per_wave; i += 2) {
        const size_t row = (size_t)row_begin + wid * rows_per_wave + i;
        f32x4 v[2][4]; float ss[2];
#pragma unroll
        for (int q = 0; q < 2; ++q) {
            ss[q] = 0.f;
#pragma unroll
            for (int c = 0; c < 4; ++c) { v[q][c] = *(const f32x4*)(src + (row + q) * 1024 + c * 256 + lane * 4); ss[q] += v[q][c][0] * v[q][c][0] + v[q][c][1] * v[q][c][1] + v[q][c][2] * v[q][c][2] + v[q][c][3] * v[q][c][3]; }
        }
#pragma unroll
        for (int o = 32; o > 0; o >>= 1) { const float t0 = __shfl_xor(ss[0], o), t1 = __shfl_xor(ss[1], o); ss[0] += t0; ss[1] += t1; }
#pragma unroll
        for (int q = 0; q < 2; ++q) {
            const float r = rsqrtf(ss[q] * (1.0f / 1024.0f) + 1e-6f);
#pragma unroll
            for (int c = 0; c < 4; ++c) {
                h16x4 o;
#pragma unroll
                for (int j = 0; j < 4; ++j) o[j] = (h16)(v[q][c][j] * r * a[c][j] + bsh[c][j]);
                *(h16x4*)(dst + (row + q) * 1024 + c * 256 + lane * 4) = o;
            }
        }
    }
}
__device__ __forceinline__ void norm_rows_h(const h16* __restrict__ src, h16* __restrict__ dst, int row_begin, int rows_per_wave, const float* sA, const float* sB) {
    const int tid_ = fresh_tid();
    const int wid = tid_ >> 6, lane = tid_ & 63;
    f32x4 a[4], bsh[4];
#pragma unroll
    for (int c = 0; c < 4; ++c) { a[c] = *(const f32x4*)(sA + c * 256 + lane * 4); bsh[c] = *(const f32x4*)(sB + c * 256 + lane * 4); }
    for (int i = 0; i < rows_per_wave; i += 2) {
        const size_t row = (size_t)row_begin + wid * rows_per_wave + i;
        f32x4 v[2][4]; float ss[2];
#pragma unroll
        for (int q = 0; q < 2; ++q) {
            ss[q] = 0.f;
#pragma unroll
            for (int c = 0; c < 4; ++c) { const h16x4 hv = *(const h16x4*)(src + (row + q) * 1024 + c * 256 + lane * 4);
                v[q][c] = (f32x4){(float)hv[0], (float)hv[1], (float)hv[2], (float)hv[3]};
                ss[q] += v[q][c][0] * v[q][c][0] + v[q][c][1] * v[q][c][1] + v[q][c][2] * v[q][c][2] + v[q][c][3] * v[q][c][3]; }
        }
#pragma unroll
        for (int o = 32; o > 0; o >>= 1) { const float t0 = __shfl_xor(ss[0], o), t1 = __shfl_xor(ss[1], o); ss[0] += t0; ss[1] += t1; }
#pragma unroll
        for (int q = 0; q < 2; ++q) {
            const float r = rsqrtf(ss[q] * (1.0f / 1024.0f) + 1e-6f);
#pragma unroll
            for (int c = 0; c < 4; ++c) {
                h16x4 o;
#pragma unroll
                for (int j = 0; j < 4; ++j) o[j] = (h16)(v[q][c][j] * r * a[c][j] + bsh[c][j]);
                *(h16x4*)(dst + (row + q) * 1024 + c * 256 + lane * 4) = o;
            }
        }
    }
}
__device__ void phase1(const Params& p, float* lds) {
    unsigned char* ws = p.ws;
    const int tid = threadIdx.x;
    const float* mp = (const float*)(ws + OFF_MODP);
    const float* bias = p.in[I_ADAB];
    float* sA = lds; float* sB = lds + 1024; float* cA = lds + 2048; float* cB = lds + 3072;
    {
        float* mod = (float*)(ws + OFF_MOD);
        for (int e = blockIdx.x * 512 + tid; e < 17 * 6144; e += gridDim.x * 512) {
            float s = bias[e % 6144];
#pragma unroll
            for (int kc = 0; kc < 16; ++kc) s += mp[(size_t)kc * 17 * 6144 + e];
            mod[e] = s;
        }
    }
    for (int col = tid; col < 1024; col += 512) {
        float sh = bias[col], sc = bias[1024 + col];
#pragma unroll
        for (int kc = 0; kc < 16; ++kc) { sh += mp[((size_t)kc * 17 + 16) * 6144 + col]; sc += mp[((size_t)kc * 17 + 16) * 6144 + 1024 + col]; }
        cA[col] = p.in[I_N1G][col] * (1.0f + sc); cB[col] = sh;
    }
    for (int rg = blockIdx.x; rg < 256; rg += gridDim.x) {
        const int b = rg >> 4;
        __syncthreads();
        for (int col = tid; col < 1024; col += 512) {
            float sh = bias[col], sc = bias[1024 + col];
#pragma unroll
            for (int kc = 0; kc < 16; ++kc) { sh += mp[((size_t)kc * 17 + b) * 6144 + col]; sc += mp[((size_t)kc * 17 + b) * 6144 + 1024 + col]; }
            sA[col] = p.in[I_N1G][col] * (1.0f + sc); sB[col] = sh;
        }
        __syncthreads();
        norm_rows(p.in[I_X], (h16*)(ws + OFF_R1), rg * 128, 16, sA, sB);
        norm_rows(p.in[I_CTX], (h16*)(ws + OFF_HC), rg * 16, 2, cA, cB);
    }
}
__device__ void phase6(const Params& p, float* lds) {
    unsigned char* ws = p.ws;
    const int tid = threadIdx.x;
    const float* mod = (const float*)(ws + OFF_MOD);
    float* sA = lds; float* sB = lds + 1024;
    for (int rg = blockIdx.x; rg < 256; rg += gridDim.x) {
        const int b = rg >> 4;
        __syncthreads();
        for (int col = tid; col < 1024; col += 512) {
            sA[col] = p.in[I_N2G][col] * (1.0f + mod[(size_t)b * 6144 + 4 * 1024 + col]); sB[col] = mod[(size_t)b * 6144 + 3 * 1024 + col];
        }
        __syncthreads();
        norm_rows_h((const h16*)(ws + OFF_X1H), (h16*)(ws + OFF_R1), rg * 128, 16, sA, sB);
    }
}

__device__ __forceinline__ int clampi(int v, int lo, int hi) { return v < lo ? lo : (v > hi ? hi : v); }

template <bool LOCAL>
__device__ __forceinline__ void attn_core(const h16x8 (&kf)[2][2], const h16x8 (&vf)[4], const float (&bias)[8], const int cb, const int qc, const int cs,
                                          const h16x8 (&qf)[2], float& m_run, float& l_run, f32x4 (&O)[4], const int quad) {
    f32x4 st[2];
#pragma unroll
    for (int t = 0; t < 2; ++t) {
        f32x4 a = (f32x4){0.f, 0.f, 0.f, 0.f};
#pragma unroll
        for (int ks = 0; ks < 2; ++ks) a = __builtin_amdgcn_mfma_f32_16x16x32_f16(kf[t][ks], qf[ks], a, 0, 0, 0);
        st[t] = a;
    }
    float mx = -INFINITY;
#pragma unroll
    for (int t = 0; t < 2; ++t)
#pragma unroll
        for (int j = 0; j < 4; ++j) {
            float sv = st[t][j] * 0.125f;
            if (LOCAL) {
                const int kc = cb + 16 * t + quad * 4 + j;
                const bool inw = (kc >= cs) && (kc < cs + 16);
                sv = inw ? (sv + bias[t * 4 + j]) : -1e30f;
            }
            st[t][j] = sv; mx = fmaxf(mx, sv);
        }
    mx = fmaxf(mx, __shfl_xor(mx, 16)); mx = fmaxf(mx, __shfl_xor(mx, 32));
    const float m_new = fmaxf(m_run, mx);
    const float alpha = __expf(m_run - m_new);
    float ls = 0.f; h16x8 pf;
#pragma unroll
    for (int t = 0; t < 2; ++t)
#pragma unroll
        for (int j = 0; j < 4; ++j) { const float pe = __expf(st[t][j] - m_new); ls += pe; pf[t * 4 + j] = (h16)pe; }
    l_run = l_run * alpha + ls; m_run = m_new;
#pragma unroll
    for (int dt = 0; dt < 4; ++dt) { O[dt] *= alpha; O[dt] = __builtin_amdgcn_mfma_f32_16x16x32_f16(vf[dt], pf, O[dt], 0, 0, 0); }
}
__device__ __forceinline__ void load_k(const h16* __restrict__ kt, h16x8 (&kf)[2][2], const int l15, const int quad) {
#pragma unroll
    for (int t = 0; t < 2; ++t)
#pragma unroll
        for (int ks = 0; ks < 2; ++ks) kf[t][ks] = *(const h16x8*)(kt + (16 * t + l15) * 64 + ks * 32 + quad * 8);
}
__device__ __forceinline__ void load_v(const h16* __restrict__ vt, h16x8 (&vf)[4], const int l15, const int quad) {
#pragma unroll
    for (int dt = 0; dt < 4; ++dt) {
        const h16* vp = vt + ((quad >> 1) * 64 + dt * 16 + l15) * 8 + (quad & 1) * 4;
        const h16x4 lo = *(const h16x4*)vp, hi = *(const h16x4*)(vp + 2 * 512);
        vf[dt] = (h16x8){lo[0], lo[1], lo[2], lo[3], hi[0], hi[1], hi[2], hi[3]};
    }
}
__device__ __forceinline__ void load_bias(const float* __restrict__ rpbrow, const int cb, const int qc, const int quad, float (&bias)[8]) {
#pragma unroll
    for (int t = 0; t < 2; ++t)
#pragma unroll
        for (int j = 0; j < 4; ++j) bias[t * 4 + j] = rpbrow[clampi(cb + 16 * t + quad * 4 + j - qc + 15, 0, 30)];
}

__device__ void attn_unit(const Params& p, int unit) {
    unsigned char* ws = p.ws;
    const int tid_ = fresh_tid();
    const int lane = tid_ & 63, h = tid_ >> 6, l15 = lane & 15, quad = lane >> 4;
    const int b = unit >> 5, r = unit & 31;
    const h16* QB = (const h16*)(ws + OFF_QB);
    const h16* KH = (const h16*)(ws + OFF_KB) + (size_t)(b * 8 + h) * 2048 * 64;
    const h16* VH = (const h16*)(ws + OFF_VT) + (size_t)(b * 8 + h) * 256 * 512;
    const h16* KCH = (const h16*)(ws + OFF_KC) + (size_t)(b * 8 + h) * 256 * 64;
    const h16* VCH = (const h16*)(ws + OFF_VCT) + (size_t)(b * 8 + h) * 32 * 512;
    h16* YA = (h16*)(ws + OFF_R1);
    const float* rpb = p.in[I_RPB] + (size_t)h * 15 * 31;
    const int rs = clampi(r - 4, 0, 24);
    h16x8 qf[4][2]; float m_run[4], l_run[4]; f32x4 O[4][4];
#pragma unroll
    for (int g = 0; g < 4; ++g) {
        const size_t tq = (size_t)b * 2048 + r * 64 + 16 * g + l15;
        qf[g][0] = *(const h16x8*)(QB + tq * 512 + h * 64 + quad * 8);
        qf[g][1] = *(const h16x8*)(QB + tq * 512 + h * 64 + 32 + quad * 8);
        m_run[g] = -INFINITY; l_run[g] = 0.f;
#pragma unroll
        for (int dt = 0; dt < 4; ++dt) O[g][dt] = (f32x4){0.f, 0.f, 0.f, 0.f};
    }
    {
        const float nob[8] = {0.f, 0.f, 0.f, 0.f, 0.f, 0.f, 0.f, 0.f};
        h16x8 kA[2][2], kB[2][2], vf[4];
        load_k(KCH, kA, l15, quad);
#pragma unroll 1
        for (int step = 0; step < 8; step += 2) {
            load_v(VCH + step * 4 * 512, vf, l15, quad);
            load_k(KCH + (step + 1) * 32 * 64, kB, l15, quad);
            __builtin_amdgcn_sched_barrier(0);
#pragma unroll
            for (int g = 0; g < 4; ++g) attn_core<false>(kA, vf, nob, 0, 0, 0, qf[g], m_run[g], l_run[g], O[g], quad);
            __builtin_amdgcn_sched_barrier(0);
            load_v(VCH + (step + 1) * 4 * 512, vf, l15, quad);
            if (step + 2 < 8) load_k(KCH + (step + 2) * 32 * 64, kA, l15, quad);
            __builtin_amdgcn_sched_barrier(0);
#pragma unroll
            for (int g = 0; g < 4; ++g) attn_core<false>(kB, vf, nob, 0, 0, 0, qf[g], m_run[g], l_run[g], O[g], quad);
            __builtin_amdgcn_sched_barrier(0);
        }
    }
#pragma unroll
    for (int gp = 0; gp < 4; gp += 2) {
        const int cb0 = clampi(16 * gp - 8, 0, 32), cb1 = clampi(16 * (gp + 1) - 8, 0, 32);
        const int qc0 = 16 * gp + l15, qc1 = 16 * (gp + 1) + l15;
        const int cs0 = clampi(qc0 - 8, 0, 48), cs1 = clampi(qc1 - 8, 0, 48);
        const float* rp0 = rpb + (rs - r + 7) * 31;
#pragma unroll 1
        for (int step = 0; step < 8; ++step) {
            const int t0 = (rs + step) * 64 + cb0, t1 = (rs + step) * 64 + cb1;
            h16x8 kf0[2][2], vf0[4], kf1[2][2], vf1[4]; float b0[8], b1[8];
            load_k(KH + (size_t)t0 * 64, kf0, l15, quad); load_k(KH + (size_t)t1 * 64, kf1, l15, quad);
            load_bias(rp0 + step * 31, cb0, qc0, quad, b0); load_bias(rp0 + step * 31, cb1, qc1, quad, b1);
            load_v(VH + (size_t)(t0 >> 3) * 512, vf0, l15, quad); load_v(VH + (size_t)(t1 >> 3) * 512, vf1, l15, quad);
            attn_core<true>(kf0, vf0, b0, cb0, qc0, cs0, qf[gp], m_run[gp], l_run[gp], O[gp], quad);
            attn_core<true>(kf1, vf1, b1, cb1, qc1, cs1, qf[gp + 1], m_run[gp + 1], l_run[gp + 1], O[gp + 1], quad);
        }
    }
#pragma unroll
    for (int g = 0; g < 4; ++g) {
        const size_t tq = (size_t)b * 2048 + r * 64 + 16 * g + l15;
        float l = l_run[g];
        l += __shfl_xor(l, 16); l += __shfl_xor(l, 32);
        const float inv = __builtin_amdgcn_rcpf(l);
#pragma unroll
        for (int dt = 0; dt < 4; ++dt) {
            h16x4 o;
#pragma unroll
            for (int j = 0; j < 4; ++j) o[j] = (h16)(O[g][dt][j] * inv);
            *(h16x4*)(YA + tq * 1024 + h * 64 + dt * 16 + quad * 4) = o;
        }
    }
}

__device__ void sgu_unit(const Params& p, int n, LAS unsigned char* lds) {
    unsigned char* ws = p.ws;
    const int tid = fresh_tid(), lane = tid & 63, g = tid >> 6, l15 = lane & 15, quad = lane >> 4;
    const h16* GUV = (const h16*)(ws + OFF_GUV);
    const h16* WS16 = (const h16*)(ws + OFF_WS16);
    h16* YB = (h16*)(ws + OFF_R1) + 512;
    LAS float* stat = (LAS float*)(lds + 8 * 17408);
    LAS h16* vt = (LAS h16*)(lds + g * 17408);
    const size_t t0 = (size_t)n * 128;
    __syncthreads();
    for (int i = 0; i < 16; i += 4) {
        h16x8 x[4]; float s[4], v[4];
#pragma unroll
        for (int q = 0; q < 4; ++q) {
            x[q] = *(const h16x8*)(GUV + (t0 + g * 16 + i + q) * 1024 + 512 + lane * 8);
            s[q] = 0.f;
#pragma unroll
            for (int j = 0; j < 8; ++j) s[q] += (float)x[q][j];
        }
#pragma unroll
        for (int o = 32; o > 0; o >>= 1) { float t[4];
#pragma unroll
            for (int q = 0; q < 4; ++q) t[q] = __shfl_xor(s[q], o);
#pragma unroll
            for (int q = 0; q < 4; ++q) s[q] += t[q]; }
#pragma unroll
        for (int q = 0; q < 4; ++q) {
            s[q] *= (1.0f / 512.0f); v[q] = 0.f;
#pragma unroll
            for (int j = 0; j < 8; ++j) { const float d = (float)x[q][j] - s[q]; v[q] += d * d; }
        }
#pragma unroll
        for (int o = 32; o > 0; o >>= 1) { float t[4];
#pragma unroll
            for (int q = 0; q < 4; ++q) t[q] = __shfl_xor(v[q], o);
#pragma unroll
            for (int q = 0; q < 4; ++q) v[q] += t[q]; }
        if (lane == 0) {
#pragma unroll
            for (int q = 0; q < 4; ++q) { stat[(g * 16 + i + q) * 2] = s[q]; stat[(g * 16 + i + q) * 2 + 1] = rsqrtf(v[q] * (1.0f / 512.0f) + 1e-6f); }
        }
    }
    __syncthreads();
    {
        const int ch0 = (lane & 7) * 8;
        float lg[8];
#pragma unroll
        for (int j = 0; j < 8; ++j) lg[j] = p.in[I_LNG][g * 64 + ch0 + j];
#pragma unroll 8
        for (int it = 0; it < 16; ++it) {
            const int q = it * 8 + (lane >> 3);
            const h16x8 x = *(const h16x8*)(GUV + (t0 + q) * 1024 + 512 + g * 64 + ch0);
            const float mean = stat[q * 2], rstd = stat[q * 2 + 1];
#pragma unroll
            for (int j = 0; j < 8; ++j) vt[(ch0 + j) * 136 + ((((q >> 3) ^ (lane & 7)) << 3) | (q & 7))] = (h16)(((float)x[j] - mean) * rstd * lg[j]);
        }
    }
    asm volatile("s_waitcnt lgkmcnt(0)" ::: "memory");
    __syncthreads();
    h16x8 af[4][4];
#pragma unroll
    for (int dt = 0; dt < 4; ++dt)
#pragma unroll
        for (int ks = 0; ks < 4; ++ks) af[dt][ks] = *(const LAS h16x8*)(vt + (dt * 16 + l15) * 136 + (((ks * 4 + quad) ^ (dt * 2 + (l15 >> 3))) << 3));
    const h16* wg = WS16 + (size_t)g * 128 * 128;
#pragma unroll 2
    for (int pt = 0; pt < 8; ++pt) {
        f32x4 acc[4];
#pragma unroll
        for (int dt = 0; dt < 4; ++dt) acc[dt] = (f32x4){0.f, 0.f, 0.f, 0.f};
#pragma unroll
        for (int ks = 0; ks < 4; ++ks) {
            const h16x8 bf = *(const h16x8*)(wg + (size_t)(pt * 16 + l15) * 128 + ks * 32 + quad * 8);
#pragma unroll
            for (int dt = 0; dt < 4; ++dt) acc[dt] = __builtin_amdgcn_mfma_f32_16x16x32_f16(af[dt][ks], bf, acc[dt], 0, 0, 0);
        }
        const int pp = pt * 16 + l15;
        const float bsv = p.in[I_GMBS][g * 128 + pp];
        const size_t tok = t0 + pp;
#pragma unroll
        for (int dt = 0; dt < 4; ++dt) {
            const int ch = g * 64 + dt * 16 + quad * 4;
            const h16x4 uu = *(const h16x4*)(GUV + tok * 1024 + ch);
            h16x4 o;
#pragma unroll
            for (int j = 0; j < 4; ++j) o[j] = (h16)((float)uu[j] * (acc[dt][j] + bsv));
            *(h16x4*)(YB + tok * 1024 + ch) = o;
        }
    }
    __syncthreads();
}

__device__ __forceinline__ float row16_sum_to_lane15(float v) {
    v += __builtin_bit_cast(float, __builtin_amdgcn_update_dpp(0, __builtin_bit_cast(int, v), 0x118, 0xf, 0xf, true));
    v += __builtin_bit_cast(float, __builtin_amdgcn_update_dpp(0, __builtin_bit_cast(int, v), 0x114, 0xf, 0xf, true));
    v += __builtin_bit_cast(float, __builtin_amdgcn_update_dpp(0, __builtin_bit_cast(int, v), 0x112, 0xf, 0xf, true));
    v += __builtin_bit_cast(float, __builtin_amdgcn_update_dpp(0, __builtin_bit_cast(int, v), 0x111, 0xf, 0xf, true));
    return v;
}
#define DPPF(v, ctrl) __builtin_bit_cast(float, __builtin_amdgcn_update_dpp(__builtin_bit_cast(int, v), __builtin_bit_cast(int, v), ctrl, 0xf, 0xf, false))
__device__ __forceinline__ float row16_allsum(float v) { v += DPPF(v, 0x128); v += DPPF(v, 0x124); v += DPPF(v, 0x122); v += DPPF(v, 0x121); return v; }
__device__ __forceinline__ float row16_allmax(float v) { v = fmaxf(v, DPPF(v, 0x128)); v = fmaxf(v, DPPF(v, 0x124)); v = fmaxf(v, DPPF(v, 0x122)); v = fmaxf(v, DPPF(v, 0x121)); return v; }
__device__ __forceinline__ int wave_incl_scan(int v) {
    v += __builtin_amdgcn_update_dpp(0, v, 0x111, 0xf, 0xf, false);
    v += __builtin_amdgcn_update_dpp(0, v, 0x112, 0xf, 0xf, false);
    v += __builtin_amdgcn_update_dpp(0, v, 0x114, 0xf, 0xf, false);
    v += __builtin_amdgcn_update_dpp(0, v, 0x118, 0xf, 0xf, false);
    v += __builtin_amdgcn_update_dpp(0, v, 0x142, 0xa, 0xf, false);
    v += __builtin_amdgcn_update_dpp(0, v, 0x143, 0xc, 0xf, false);
    return v;
}
__device__ __forceinline__ unsigned wave_or(unsigned x) {
    int v = (int)x;
    v |= __builtin_amdgcn_update_dpp(0, v, 0x111, 0xf, 0xf, false);
    v |= __builtin_amdgcn_update_dpp(0, v, 0x112, 0xf, 0xf, false);
    v |= __builtin_amdgcn_update_dpp(0, v, 0x114, 0xf, 0xf, false);
    v |= __builtin_amdgcn_update_dpp(0, v, 0x118, 0xf, 0xf, false);
    v |= __builtin_amdgcn_update_dpp(0, v, 0x142, 0xa, 0xf, false);
    v |= __builtin_amdgcn_update_dpp(0, v, 0x143, 0xc, 0xf, false);
    return (unsigned)__builtin_amdgcn_readlane(v, 63);
}
__device__ __forceinline__ unsigned wave_and(unsigned x) {
    int v = (int)x;
    v &= __builtin_amdgcn_update_dpp(-1, v, 0x111, 0xf, 0xf, false);
    v &= __builtin_amdgcn_update_dpp(-1, v, 0x112, 0xf, 0xf, false);
    v &= __builtin_amdgcn_update_dpp(-1, v, 0x114, 0xf, 0xf, false);
    v &= __builtin_amdgcn_update_dpp(-1, v, 0x118, 0xf, 0xf, false);
    v &= __builtin_amdgcn_update_dpp(-1, v, 0x142, 0xa, 0xf, false);
    v &= __builtin_amdgcn_update_dpp(-1, v, 0x143, 0xc, 0xf, false);
    return (unsigned)__builtin_amdgcn_readlane(v, 63);
}
__device__ __forceinline__ unsigned key16(unsigned short u) { return (u & 0x8000u) ? ((~(unsigned)u) & 0xFFFFu) : ((unsigned)u | 0x8000u); }
__device__ __forceinline__ unsigned key32(unsigned u) { return (u & 0x80000000u) ? ~u : (u | 0x80000000u); }
__device__ __forceinline__ float dot8(h16x8 a, h16x8 b, float c) {
    c = __builtin_amdgcn_fdot2((h16x2){a[0], a[1]}, (h16x2){b[0], b[1]}, c, false);
    c = __builtin_amdgcn_fdot2((h16x2){a[2], a[3]}, (h16x2){b[2], b[3]}, c, false);
    c = __builtin_amdgcn_fdot2((h16x2){a[4], a[5]}, (h16x2){b[4], b[5]}, c, false);
    c = __builtin_amdgcn_fdot2((h16x2){a[6], a[7]}, (h16x2){b[6], b[7]}, c, false);
    return c;
}
#define LDS_FENCE() asm volatile("s_waitcnt lgkmcnt(0)" ::: "memory")

__device__ void peer_phase(const Params& p, LAS unsigned char* lds, unsigned* bar, unsigned& epoch) {
    unsigned char* ws = p.ws;
    const int tid = fresh_tid(), wid = __builtin_amdgcn_readfirstlane(tid >> 6), lane = tid & 63;
    const unsigned long long lm = (1ull << lane) - 1ull;
    LAS unsigned char* wl = lds + wid * 11264;
    LAS float* s_top = (LAS float*)(wl);
    LAS int* i_top = (LAS int*)(wl + 1024);
    LAS int* ex = (LAS int*)(wl + 2048);
    LAS float* sc = (LAS float*)(wl + 2560);
    LAS int* uns_m = (LAS int*)(wl + 3072);
    LAS float* uns_g = (LAS float*)(wl + 3584);
    LAS int* cnt = (LAS int*)(wl + 4096);
    LAS int* base = (LAS int*)(wl + 4352);
    const int lead = (wid >= 4) ? 1 : 0;
    const unsigned short* SC = (const unsigned short*)(ws + OFF_SC16);
    const h16* H2 = (const h16*)(ws + OFF_R1);
    const unsigned char* U4 = ws + OFF_U8;
    const unsigned char* V8 = ws + OFF_V8;
    const float* USC = (const float*)(ws + OFF_USC);
    const float* VSC = (const float*)(ws + OFF_VSC);
    const float* mod = (const float*)(ws + OFF_MOD);
    const int grp = lane >> 4, li = lane & 15;
    for (int tg = blockIdx.x; tg < 256; tg += gridDim.x) {
        for (int it5 = 0; it5 < 5; ++it5) {
          if (it5 < 4) {
            const int round = it5;
            const size_t tok0 = (size_t)tg * 128 + wid * 16 + round * 4;
            LAS unsigned short* se = (LAS unsigned short*)(wl + 4608 + (round & 1) * 3072);
            LAS float* sw = (LAS float*)(wl + 4608 + (round & 1) * 3072 + 1024);
            for (int tt = 0; tt < 4; ++tt) {
                const size_t tok = tok0 + tt;
                cnt[lane] = 0;
                for (int L0 = 0; L0 < 16; L0 += 16) {
                    unsigned short ra[16], rb[16]; unsigned ka[16], kb[16], T[16];
#pragma unroll
                    for (int q = 0; q < 16; ++q) {
                        const unsigned short* sr = SC + tok * 2048 + (L0 + q) * 128;
                        ra[q] = sr[lane]; rb[q] = sr[64 + lane];
                        ka[q] = key16(ra[q]); kb[q] = key16(rb[q]); T[q] = 0;
                    }
                    for (int bit = 15; bit >= 0; --bit) {
#pragma unroll
                        for (int q = 0; q < 16; ++q) {
                            const unsigned cand = T[q] | (1u << bit);
                            const int cn = __popcll(__ballot(ka[q] >= cand)) + __popcll(__ballot(kb[q] >= cand));
                            T[q] = (cn >= 16) ? cand : T[q];
                        }
                    }
#pragma unroll
                    for (int q = 0; q < 16; ++q) {
                        const int L = L0 + q;
                        const int cnt_gt = __popcll(__ballot(ka[q] > T[q])) + __popcll(__ballot(kb[q] > T[q]));
                        const int need = 16 - cnt_gt;
                        const unsigned long long ea = __ballot(ka[q] == T[q]), eb = __ballot(kb[q] == T[q]);
                        const int ra_eq = __popcll(ea & lm), rb_eq = __popcll(ea) + __popcll(eb & lm);
                        const bool sa = (ka[q] > T[q]) || (ka[q] == T[q] && ra_eq < need);
                        const bool sb = (kb[q] > T[q]) || (kb[q] == T[q] && rb_eq < need);
                        const unsigned long long ma = __ballot(sa), mb = __ballot(sb);
                        const int pa = __popcll(ma & lm), pb = __popcll(ma) + __popcll(mb & lm);
                        if (sa) { s_top[L * 16 + pa] = (float)__builtin_bit_cast(h16, ra[q]); i_top[L * 16 + pa] = lane; }
                        if (sb) { s_top[L * 16 + pb] = (float)__builtin_bit_cast(h16, rb[q]); i_top[L * 16 + pb] = 64 + lane; }
                    }
                }
                LDS_FENCE();
                for (int h0 = 0; h0 < 8; h0 += 4) {
                    float cv[4][4]; unsigned kk[4][4], T[4];
#pragma unroll
                    for (int q = 0; q < 4; ++q) {
                        const int h = h0 + q;
                        const float bj = s_top[(2 * h + 1) * 16 + li];
#pragma unroll
                        for (int m = 0; m < 4; ++m) { cv[q][m] = s_top[(2 * h) * 16 + grp + 4 * m] + bj; kk[q][m] = key32(__builtin_bit_cast(unsigned, cv[q][m])); }
                        T[q] = 0;
                    }
                    unsigned om = 0, am = 0xFFFFFFFFu;
#pragma unroll
                    for (int q = 0; q < 4; ++q)
#pragma unroll
                        for (int m = 0; m < 4; ++m) { om |= kk[q][m]; am &= kk[q][m]; }
                    om = wave_or(om); am = wave_and(am);
                    om &= ~am;
                    while (om) {
                        const int bit = 31 - __builtin_clz(om);
                        om &= ~(1u << bit);
#pragma unroll
                        for (int q = 0; q < 4; ++q) {
                            const unsigned cand = T[q] | (1u << bit);
                            int cn = 0;
#pragma unroll
                            for (int m = 0; m < 4; ++m) cn += __popcll(__ballot((kk[q][m] & ~am) >= cand));
                            T[q] = (cn >= 16) ? cand : T[q];
                        }
                    }
#pragma unroll
                    for (int q = 0; q < 4; ++q) T[q] |= am;
#pragma unroll
                    for (int q = 0; q < 4; ++q) {
                        const int h = h0 + q;
                        int cnt_gt = 0;
#pragma unroll
                        for (int m = 0; m < 4; ++m) cnt_gt += __popcll(__ballot(kk[q][m] > T[q]));
                        const int need = 16 - cnt_gt;
                        int eq_before = 0, sel_before = 0;
#pragma unroll
                        for (int m = 0; m < 4; ++m) {
                            const unsigned long long em = __ballot(kk[q][m] == T[q]);
                            const int myeq = eq_before + __popcll(em & lm);
                            const bool sel = (kk[q][m] > T[q]) || (kk[q][m] == T[q] && myeq < need);
                            const unsigned long long sm = __ballot(sel);
                            const int pos = sel_before + __popcll(sm & lm);
                            if (sel) {
                                ex[h * 16 + pos] = i_top[(2 * h) * 16 + grp + 4 * m] * 128 + i_top[(2 * h + 1) * 16 + li];
                                sc[h * 16 + pos] = cv[q][m];
                            }
                            eq_before += __popcll(em); sel_before += __popcll(sm);
                        }
                    }
                }
                LDS_FENCE();
#pragma unroll
                for (int half = 0; half < 2; ++half) {
                    const int e = half * 64 + lane;
                    const float v = sc[e];
                    const float mx = row16_allmax(v);
                    const float pe = __expf(v - mx);
                    const float sm = row16_allsum(pe);
                    const float gate = pe * __builtin_amdgcn_rcpf(sm);
                    const int eid = ex[e];
                    const int pos = __hip_atomic_fetch_add(cnt + (eid >> 8), 1, __ATOMIC_RELAXED, __HIP_MEMORY_SCOPE_WORKGROUP);
                    uns_m[e] = eid | (pos << 14); uns_g[e] = gate;
                }
                LDS_FENCE();
                {
                    const int c = cnt[lane];
                    const int incl = wave_incl_scan(c);
                    base[lane] = incl - c;
                    LDS_FENCE();
#pragma unroll
                    for (int i = 0; i < 2; ++i) {
                        const int rm = uns_m[i * 64 + lane]; const float rg = uns_g[i * 64 + lane];
                        const int eid = rm & 16383, pos = rm >> 14;
                        const int dst = tt * 128 + base[eid >> 8] + pos;
                        se[dst] = (unsigned short)eid; sw[dst] = rg;
                    }
                    LDS_FENCE();
                }
            }
          }
          const int round = it5 - lead;
          if (round >= 0 && round < 4) {
            const size_t tok0 = (size_t)tg * 128 + wid * 16 + round * 4;
            LAS unsigned short* se = (LAS unsigned short*)(wl + 4608 + (round & 1) * 3072);
            LAS float* sw = (LAS float*)(wl + 4608 + (round & 1) * 3072 + 1024);
            const size_t tokg = tok0 + grp;
            const LAS unsigned short* me = se + grp * 128; LAS float* mw = sw + grp * 128;
            {
                const int li = launder(tid) & 15;
                h16x8 xr[2][4];
#pragma unroll
                for (int c = 0; c < 2; ++c)
#pragma unroll
                    for (int j = 0; j < 4; ++j) xr[c][j] = *(const h16x8*)(H2 + tokg * 1024 + c * 512 + li * 32 + 8 * j);
                float acc[64];
#pragma unroll
                for (int i = 0; i < 64; ++i) acc[i] = 0.f;
                i32x4 ru[2][2], rv[2][4]; float su[2], sv[2];
#define ELD(J, S_) do { const int e_ = me[(S_)]; const unsigned char* rp_ = U4 + (size_t)e_ * 1536 + li * 16; \
        ru[J][0] = *(const i32x4*)rp_; ru[J][1] = *(const i32x4*)(rp_ + 256); \
        _Pragma("unroll") for (int c = 0; c < 4; ++c) rv[J][c] = *(const i32x4*)(rp_ + 512 + c * 256); \
        { const f32x2 s2_ = *(const f32x2*)(USC + 2 * e_); su[J] = s2_.x; sv[J] = s2_.y; } } while (0)
#define ECP(J, S_) do { float d = 0.f; \
        _Pragma("unroll") for (int c = 0; c < 2; ++c) _Pragma("unroll") for (int k = 0; k < 4; ++k) { const h16x8 xv = xr[c][k]; const int w_ = ru[J][c][k]; \
            d = __builtin_amdgcn_fdot2(__builtin_amdgcn_cvt_scalef32_pk_f16_fp4(w_, 1.0f, 0), (h16x2){xv[0], xv[1]}, d, false); \
            d = __builtin_amdgcn_fdot2(__builtin_amdgcn_cvt_scalef32_pk_f16_fp4(w_, 1.0f, 1), (h16x2){xv[2], xv[3]}, d, false); \
            d = __builtin_amdgcn_fdot2(__builtin_amdgcn_cvt_scalef32_pk_f16_fp4(w_, 1.0f, 2), (h16x2){xv[4], xv[5]}, d, false); \
            d = __builtin_amdgcn_fdot2(__builtin_amdgcn_cvt_scalef32_pk_f16_fp4(w_, 1.0f, 3), (h16x2){xv[6], xv[7]}, d, false); } \
        d = row16_allsum(d); \
        const float wt_ = mw[(S_)] * gelu_tanh(d * su[J]) * sv[J]; \
        _Pragma("unroll") for (int c = 0; c < 4; ++c) _Pragma("unroll") for (int k = 0; k < 4; ++k) { \
            const f32x2 lo = __builtin_amdgcn_cvt_pk_f32_fp8(rv[J][c][k], false), hi = __builtin_amdgcn_cvt_pk_f32_fp8(rv[J][c][k], true); \
            acc[c * 16 + 4 * k] += wt_ * lo.x; acc[c * 16 + 4 * k + 1] += wt_ * lo.y; acc[c * 16 + 4 * k + 2] += wt_ * hi.x; acc[c * 16 + 4 * k + 3] += wt_ * hi.y; } } while (0)
                ELD(0, 0); ELD(1, 1);
#pragma unroll 1
                for (int s = 0; s < 128; s += 2) {
                    ECP(0, s);     if (s + 2 < 128) ELD(0, s + 2);
                    ECP(1, s + 1); if (s + 3 < 128) ELD(1, s + 3);
                }
#undef ELD
#undef ECP
                float* xo = p.out + tokg * 1024 + li * 16;
                const h16* x1h = (const h16*)(ws + OFF_X1H) + tokg * 1024 + li * 16;
                const int b = (int)(tokg >> 11);
                const float* g2 = mod + (size_t)b * 6144 + 5 * 1024 + li * 16;
                const float* fg = p.in[I_FG] + li * 16;
                float ss = 0.f;
#pragma unroll
                for (int c = 0; c < 4; ++c) {
#pragma unroll
                    for (int q4 = 0; q4 < 4; ++q4) {
                        const h16x4 xh_ = *(const h16x4*)(x1h + c * 256 + q4 * 4);
                        const f32x4 xv = (f32x4){(float)xh_[0], (float)xh_[1], (float)xh_[2], (float)xh_[3]}, gv = *(const f32x4*)(g2 + c * 256 + q4 * 4);
#pragma unroll
                        for (int j = 0; j < 4; ++j) { const float t = xv[j] + gv[j] * acc[c * 16 + q4 * 4 + j]; acc[c * 16 + q4 * 4 + j] = t; ss += t * t; }
                    }
                    asm volatile("" : "+v"(ss) :: "memory");
                }
                ss = row16_allsum(ss);
                const float r = rsqrtf(ss * (1.0f / 1024.0f) + 1e-6f);
#pragma unroll
                for (int c = 0; c < 4; ++c) {
#pragma unroll
                    for (int q4 = 0; q4 < 4; ++q4) {
                        const f32x4 fv = *(const f32x4*)(fg + c * 256 + q4 * 4);
                        f32x4 ov;
#pragma unroll
                        for (int j = 0; j < 4; ++j) ov[j] = acc[c * 16 + q4 * 4 + j] * r * fv[j];
                        *(f32x4*)(xo + c * 256 + q4 * 4) = ov;
                    }
                    asm volatile("" ::: "memory");
                }
            }
            LDS_FENCE();
          }
        }
    }
}

__global__ void __launch_bounds__(512, 2) mega(Params p) {
    extern __shared__ __attribute__((aligned(16))) unsigned char shm[];
    LAS unsigned char* lds = (LAS unsigned char*)shm;
    cg::grid_group grid = cg::this_grid();
    unsigned char* ws = p.ws;
    const int G = (int)gridDim.x, c = (int)blockIdx.x;
    unsigned* bar = (unsigned*)(ws + OFF_BAR); unsigned epoch = 0;
    volatile LAS unsigned* xst = (volatile LAS unsigned*)(lds + (LDS_BYTES - 16));
    if (threadIdx.x < 2) xst[threadIdx.x] = 0u;
    __syncthreads();
    const XcdBarrier xb = xcd_barrier_post(bar, xst);

    if (p.ws == nullptr) grid.sync();
    phase0(p, (float*)shm);
    xcd_barrier(xb);
    phase1(p, (float*)shm);
    xcd_barrier(xb);
    {
        pg8::StaticOrder S; S.init(NTOK, INC, G, c);
        pg8::Gemm g{ws + OFF_R1, ws + OFF_WINT, 1024, 1024, NTOK, INC, 1024, 0};
        EpiIn E{(h16*)(ws + OFF_QB), (h16*)(ws + OFF_KB), (h16*)(ws + OFF_VT), (h16*)(ws + OFF_GUV), (h16*)(ws + OFF_GATES)};
        pg8::gemm_phase(lds, g, S, E);
        pg8::StaticOrder S2; S2.init(NCTXT, 1024, G, c);
        pg8::Gemm g2{ws + OFF_HC, ws + OFF_WINT + (size_t)512 * 1024 * 2, 1024, 1024, NCTXT, 1024, 1024, 0};
        EpiCtx E2{(h16*)(ws + OFF_KC), (h16*)(ws + OFF_VCT)};
        pg8::gemm_phase(lds, g2, S2, E2);
    }
    xcd_barrier(xb);
    {
        for (int rep3 = 0; rep3 < REP_P3; ++rep3) {
        for (int u = c; u < 512; u += G) attn_unit(p, u);
        for (int n = c; n < 256; n += G) sgu_unit(p, n, lds);
        }
    }
    xcd_barrier(xb);
    {
        pg8::StaticOrder S; S.init(NTOK, 1024, G, c);
        pg8::Gemm ga{ws + OFF_R1, ws + OFF_WPAT, 1024, 512, NTOK, 1024, 512, 0};
        EpiM1 E1{(h16*)(ws + OFF_M1), (const h16*)(ws + OFF_GATES)};
        pg8::gemm_phase(lds, ga, S, E1);
        pg8::Gemm gb{ws + OFF_R1 + 1024, ws + OFF_WPBT, 1024, 512, NTOK, 1024, 512, 0};
        EpiM2 E2{(const h16*)(ws + OFF_M1), (const h16*)(ws + OFF_GATES), (h16*)(ws + OFF_MM)};
        pg8::gemm_phase(lds, gb, S, E2);
    }
    xcd_barrier(xb);
    {
        pg8::StaticOrder S; S.init(NTOK, 1024, G, c);
        pg8::Gemm g{ws + OFF_MM, ws + OFF_WOUTT, 1024, 1024, NTOK, 1024, 1024, 0};
        EpiX1 E{p.in[I_X], (const float*)(ws + OFF_MOD), (h16*)(ws + OFF_X1H)};
        pg8::gemm_phase(lds, g, S, E);
    }
    xcd_barrier(xb);
    phase6(p, (float*)shm);
    xcd_barrier(xb);
    {
        pg8::StaticOrder S; S.init(NTOK, 2048, G, c);
        pg8::Gemm g{ws + OFF_R1, ws + OFF_WQT, 1024, 1024, NTOK, 2048, 1024, 0};
        EpiH16 E{(h16*)(ws + OFF_SC16), 2048};
        pg8::gemm_phase(lds, g, S, E);
    }
    xcd_barrier(xb);
    peer_phase(p, lds, bar, epoch);
}

extern "C" void kernel_launch(void* const* d_in, const int* in_sizes, int n_in, void* d_out, int out_size, void* d_ws, size_t ws_size, hipStream_t stream) {
    static int grid_blocks = 0;
    if (!grid_blocks) {
        int dev = 0, cus = 0, per_cu = 0;
        hipGetDevice(&dev);
        hipDeviceGetAttribute(&cus, hipDeviceAttributeMultiprocessorCount, dev);
        hipFuncSetAttribute((const void*)mega, hipFuncAttributeMaxDynamicSharedMemorySize, LDS_BYTES);
        hipOccupancyMaxActiveBlocksPerMultiprocessor(&per_cu, (const void*)mega, 512, LDS_BYTES);
        if (per_cu < 1) per_cu = 1;
        grid_blocks = cus * per_cu;
        if (ws_size < WS_END) fprintf(stderr, "kernel_launch: workspace too small: %zu < %zu\n", ws_size, (size_t)WS_END);
    }
    hipMemsetAsync((unsigned char*)d_ws + OFF_BAR, 0, 16384, stream);
    Params p{};
    for (int i = 0; i < 21; ++i) p.in[i] = (const float*)d_in[i];
    p.out = (float*)d_out; p.ws = (unsigned char*)d_ws;
    void* args[] = {&p};
    hipError_t e = hipLaunchCooperativeKernel((const void*)mega, dim3(grid_blocks), dim3(512), args, LDS_BYTES, stream);
    if (e != hipSuccess) fprintf(stderr, "cooperative launch failed: %s (grid %d)\n", hipGetErrorString(e), grid_blocks);
}
```

```cpp
#include <hip/hip_runtime.h>
#include <hip/hip_cooperative_groups.h>
#include <cstdio>
namespace cg = cooperative_groups;

#define LAS __attribute__((address_space(3)))
typedef _Float16 h16;
typedef _Float16 h16x2 __attribute__((ext_vector_type(2)));
typedef _Float16 h16x4 __attribute__((ext_vector_type(4)));
typedef _Float16 h16x8 __attribute__((ext_vector_type(8)));
typedef float f32x4 __attribute__((ext_vector_type(4)));
typedef float f32x2 __attribute__((ext_vector_type(2)));
typedef int i32x4 __attribute__((ext_vector_type(4)));
typedef int i32x2 __attribute__((ext_vector_type(2)));

constexpr int NTOK = 32768, DM = 1024, NCTXT = 4096, INC = 4608, SEQ = 2048, CTXL = 256;
constexpr int LDS_BYTES = 144 * 1024;
#ifndef REP_SEL
#define REP_SEL 1
#endif
#ifndef REP_GATH
#define REP_GATH 1
#endif
#ifndef REP_P3
#define REP_P3 1
#endif

constexpr size_t al256(size_t x) { return (x + 255) & ~(size_t)255; }
constexpr size_t OFF_WINT = 0;
constexpr size_t OFF_WPAT = OFF_WINT + (size_t)INC * DM * 2;
constexpr size_t OFF_WPBT = OFF_WPAT + (size_t)1024 * 512 * 2;
constexpr size_t OFF_WOUTT = OFF_WPBT + (size_t)1024 * 512 * 2;
constexpr size_t OFF_WQT = OFF_WOUTT + (size_t)1024 * 1024 * 2;
constexpr size_t OFF_BD = OFF_WQT + (size_t)2048 * 1024 * 2;
constexpr size_t OFF_U16 = OFF_BD + (size_t)2048 * 256 * 2;
constexpr size_t OFF_V16 = OFF_U16 + (size_t)16384 * 1024 * 2;
constexpr size_t OFF_WS16 = OFF_V16 + (size_t)16384 * 1024 * 2;
constexpr size_t OFF_MODP = OFF_WS16 + (size_t)8 * 128 * 128 * 2;
constexpr size_t OFF_MOD = OFF_MODP + (size_t)16 * 17 * 6144 * 4;
constexpr size_t OFF_R1 = al256(OFF_MOD + (size_t)17 * 6144 * 4);
constexpr size_t OFF_QB = OFF_R1 + (size_t)NTOK * DM * 2;
constexpr size_t OFF_KB = OFF_QB + (size_t)NTOK * 512 * 2;
constexpr size_t OFF_VT = OFF_KB + (size_t)NTOK * 512 * 2;
constexpr size_t OFF_GUV = OFF_VT + (size_t)NTOK * 512 * 2;
constexpr size_t OFF_GATES = OFF_GUV + (size_t)NTOK * 1024 * 2;
constexpr size_t OFF_MM = OFF_GATES + (size_t)NTOK * 2048 * 2;
constexpr size_t OFF_BAR = OFF_MM + (size_t)NTOK * DM * 2;
constexpr size_t WS_END = OFF_BAR + 16384;
constexpr size_t OFF_U8 = OFF_U16;
constexpr size_t OFF_USC = OFF_V16;
constexpr size_t OFF_V8 = OFF_V16;
constexpr size_t OFF_VSC = OFF_V16 + (size_t)16384 * 1024;
constexpr size_t OFF_M1 = OFF_QB;
constexpr size_t OFF_SC16 = OFF_QB;
constexpr size_t OFF_Q16 = OFF_GATES;
constexpr size_t OFF_X1H = OFF_GATES;
constexpr size_t OFF_HC = OFF_MM;
constexpr size_t OFF_KC = OFF_HC + (size_t)NCTXT * DM * 2;
constexpr size_t OFF_VCT = OFF_KC + (size_t)NCTXT * 512 * 2;
static_assert(OFF_M1 + (size_t)NTOK * DM * 4 <= OFF_GATES, "m1 alias");
static_assert(WS_END <= (size_t)512 * 1024 * 1024, "workspace");

struct Params {
    const float* in[21];
    float* out;
    unsigned char* ws;
};
enum { I_X = 0, I_C, I_CTX, I_CCTX, I_ADAW, I_ADAB, I_N1G, I_N2G, I_WIN, I_RPB, I_LNG, I_GMWS, I_GMBS, I_WPA, I_WPB, I_WOUT, I_WQ, I_KEYS, I_PU, I_PV, I_FG };

__device__ __forceinline__ int launder(int x) { asm volatile("" : "+v"(x)); return x; }
__device__ __forceinline__ int fresh_tid() { int t = threadIdx.x; asm volatile("" : "+v"(t)); return t; }

__device__ __forceinline__ float sigmoidf_(float x) { return __builtin_amdgcn_rcpf(1.0f + __expf(-x)); }
__device__ __forceinline__ float gelu_tanh(float x) {
    const float t = 0.7978845608028654f * (x + 0.044715f * x * x * x);
    return x * __builtin_amdgcn_rcpf(1.0f + __expf(-2.0f * t));
}
__device__ __forceinline__ float silu_(float x) { return x * __builtin_amdgcn_rcpf(1.0f + __expf(-x)); }
__device__ __forceinline__ float wave_sum(float v) {
#pragma unroll
    for (int o = 32; o > 0; o >>= 1) v += __shfl_xor(v, o);
    return v;
}
__device__ __forceinline__ h16x8 pack8(f32x4 a, f32x4 b) {
    h16x8 o;
    o[0] = (h16)a[0]; o[1] = (h16)a[1]; o[2] = (h16)a[2]; o[3] = (h16)a[3];
    o[4] = (h16)b[0]; o[5] = (h16)b[1]; o[6] = (h16)b[2]; o[7] = (h16)b[3];
    return o;
}


__device__ __forceinline__ void grid_bar(unsigned* ctr, unsigned& epoch, unsigned nblk) {
    __syncthreads();
    epoch += 1u;
    if (threadIdx.x == 0) {
        __builtin_amdgcn_fence(__ATOMIC_RELEASE, "agent");
        asm volatile("s_waitcnt vmcnt(0)" ::: "memory");
        __hip_atomic_fetch_add(ctr, 1u, __ATOMIC_RELAXED, __HIP_MEMORY_SCOPE_AGENT);
        const unsigned target = epoch * nblk;
        unsigned spins = 0;
        while (__hip_atomic_load(ctr, __ATOMIC_RELAXED, __HIP_MEMORY_SCOPE_AGENT) < target) { __builtin_amdgcn_s_sleep(2); if (++spins > (1u << 24)) break; }
        __builtin_amdgcn_fence(__ATOMIC_ACQUIRE, "agent");
        asm volatile("s_waitcnt vmcnt(0)" ::: "memory");
    }
    __syncthreads();
}


#define XB_TMO      128
#define XB_XCNT(j)  (256  + 64 * (j))
#define XB_XSUB(j)  (1280 + 64 * (j))
#define XB_XGEN(j)  (2304 + 64 * (j))
#define XB_TOP      3328
#define XB_TOPGEN   3392
#define XCD_BAR_WORDS 3456
#define XB_SPIN_CAP (1u << 20)
__device__ __forceinline__ unsigned xb_ld(unsigned* p)              { return __hip_atomic_load(p, __ATOMIC_RELAXED, __HIP_MEMORY_SCOPE_AGENT); }
__device__ __forceinline__ unsigned xb_add(unsigned* p, unsigned v) { return __hip_atomic_fetch_add(p, v, __ATOMIC_RELAXED, __HIP_MEMORY_SCOPE_AGENT); }
__device__ __forceinline__ unsigned xb_xcc_id() { return (unsigned)__builtin_amdgcn_s_getreg((3 << 11) | 20) & 0xFu; }
#define XB_SPIN(cond, bar) do { unsigned _sp = 0; while (cond) { __builtin_amdgcn_s_sleep(1); \
    if ((++_sp & 255u) == 0u) { if (xb_ld(&(bar)[XB_TMO])) break; if (_sp > XB_SPIN_CAP) { atomicAdd(&(bar)[XB_TMO], 1u); break; } } } } while (0)
struct XcdBarrier { unsigned* bar; unsigned x; volatile LAS unsigned* st; };
__device__ __forceinline__ XcdBarrier xcd_barrier_post(unsigned* bar, volatile LAS unsigned* st) {
    XcdBarrier b; b.bar = bar; b.x = xb_xcc_id(); b.st = st;
    if (threadIdx.x == 0) (void)xb_add(&bar[XB_XCNT(b.x)], 1u);
    return b;
}
__device__ __forceinline__ void xcd_barrier_complete(unsigned* bar, unsigned x, unsigned& nloc, unsigned& nx) {
    const unsigned G = gridDim.x * gridDim.y * gridDim.z;
    unsigned sum, cnt, mine, sp = 0u;
    for (;;) {
        sum = 0u; cnt = 0u; mine = 0u;
#pragma unroll
        for (unsigned j = 0; j < 16; ++j) { const unsigned c = xb_ld(&bar[XB_XCNT(j)]); sum += c; cnt += (c > 0u) ? 1u : 0u; mine = (j == x) ? c : mine; }
        if (sum == G) break;
        __builtin_amdgcn_s_sleep(1);
        if ((++sp & 255u) == 0u) { if (xb_ld(&bar[XB_TMO])) break; if (sp > XB_SPIN_CAP) { atomicAdd(&bar[XB_TMO], 1u); break; } }
    }
    nloc = mine > 0u ? mine : 1u; nx = cnt > 0u ? cnt : 1u;
}
__device__ __forceinline__ void xcd_barrier(const XcdBarrier& b) {
    asm volatile("s_waitcnt vmcnt(0)" ::: "memory");
    __syncthreads();
    if (threadIdx.x == 0) {
        unsigned* bar = b.bar;
        __builtin_amdgcn_s_waitcnt(0);
        unsigned nloc = b.st[0], nx = b.st[1];
        if (nloc == 0u) { xcd_barrier_complete(bar, b.x, nloc, nx); b.st[0] = nloc; b.st[1] = nx; }
        const unsigned old = xb_add(&bar[XB_XSUB(b.x)], 1u);
        const unsigned gen = old / nloc;
        if (old + 1u == (gen + 1u) * nloc) {
            __builtin_amdgcn_fence(__ATOMIC_RELEASE, "agent");
            asm volatile("s_waitcnt vmcnt(0)" ::: "memory");
            const unsigned og = xb_add(&bar[XB_TOP], 1u);
            const unsigned tg = og / nx;
            if (og + 1u == (tg + 1u) * nx) xb_add(&bar[XB_TOPGEN], 1u);
            else XB_SPIN(xb_ld(&bar[XB_TOPGEN]) == tg, bar);
            __builtin_amdgcn_fence(__ATOMIC_ACQUIRE, "agent");
            xb_add(&bar[XB_XGEN(b.x)], 1u);
            asm volatile("s_waitcnt vmcnt(0)" ::: "memory");
        } else {
            XB_SPIN(xb_ld(&bar[XB_XGEN(b.x)]) == gen, bar);
            __builtin_amdgcn_fence(__ATOMIC_ACQUIRE, "agent");
            asm volatile("s_waitcnt vmcnt(0)" ::: "memory");
        }
    }
    __syncthreads();
}

namespace pg8 {
constexpr int BM = 256, BK = 64, HALF = 128, HTB = HALF * BK * 2, STAGE_BYTES = 8 * HTB, NXCD = 8, WGM = 8;
__device__ __forceinline__ int lds_byte(int r, int c) { const int st = (r >> 4) * 2 + (c >> 5), rr = r & 15, cc = c & 31, ob = rr * 64 + cc * 2; return st * 1024 + (ob ^ (((ob >> 9) & 1) << 5)); }
__device__ __forceinline__ void stage_rc(int b, int& R, int& C) { const int st = b / 1024, sb = b % 1024, swz = sb ^ (((sb >> 9) & 1) << 5); R = (st >> 1) * 16 + swz / 64; C = (st & 1) * 32 + (swz % 64) / 2; }
__device__ __forceinline__ int perm32(int rho) { const int n = rho >> 4, i = rho & 15; return 8 * (i >> 2) + 4 * n + (i & 3); }

struct Unit { int pm, pn; };
struct Gemm { const void* A; const void* Bt; int lda, ldb, M, N, K, a_pn_bytes; };

struct StaticOrder {
    int nM, nN, nwg, G, c;
    __device__ void init(int M, int N, int G_, int c_) { nM = M / BM; nN = N / BM; nwg = nM * nN; G = G_; c = c_; }
    __device__ bool next(int i, Unit& u) const {
        const long L = (long)i * G + c; if (L >= nwg) return false;
        int wgid = (int)L; { const int q = nwg / NXCD, r = nwg % NXCD, xcd = wgid % NXCD, off = wgid / NXCD; wgid = (xcd < r ? xcd * (q + 1) : r * (q + 1) + (xcd - r) * q) + off; }
        const int nig = WGM * nN, gid = wgid / nig, fm = gid * WGM, gsz = (nM - fm) < WGM ? (nM - fm) : WGM;
        u.pm = fm + ((wgid % nig) % gsz); u.pn = (wgid % nig) / gsz; return true;
    }
};

template <class Epi>
__device__ __forceinline__ void gemm_phase(LAS unsigned char* lds, const Gemm g, const StaticOrder& S, const Epi& E) {
    const int tid = fresh_tid(), wid = __builtin_amdgcn_readfirstlane(tid >> 6), lane = tid & 63, wr = wid >> 2, wc = wid & 3, fr = lane & 15, fq = lane >> 4;
    const int K = g.K, nt = K / BK;
    unsigned voffA[2], voffB[2];
#pragma unroll
    for (int i = 0; i < 2; ++i) { int R, C; stage_rc(tid * 16 + i * 8192, R, C); const int Rb = (R & ~31) + perm32(R & 31);
        voffA[i] = (unsigned)(R * g.lda + C) * 2u; voffB[i] = (unsigned)(Rb * g.ldb + C) * 2u; }
    const size_t kstep = (size_t)(BK * 2);
    const size_t hstepA = (size_t)HALF * g.lda * 2, hstepB = (size_t)HALF * g.ldb * 2;
    const size_t tstepA = 2 * hstepA, tstepB = 2 * hstepB;
    const unsigned ldsw = (unsigned)wid * 1024u;
    const int aoff = lds_byte(wr * 64 + fr, fq * 8), boff = lds_byte(wc * 32 + fr, fq * 8);
#define PG8_SA(b, h) (((b) * 2 + (h)) * HTB)
#define PG8_SB(b, h) ((4 + (b) * 2 + (h)) * HTB)
#define PG8_STAGE(bufoff, gbase, voff) do { _Pragma("unroll") for (int _i = 0; _i < 2; ++_i) \
        __builtin_amdgcn_global_load_lds((const unsigned*)((const char*)(gbase) + (voff)[_i]), (LAS unsigned*)(lds + (bufoff) + ldsw + _i * 8192), 16, 0, 0); } while (0)
#define PG8_LDA(dst, b, h) do { _Pragma("unroll") for (int m = 0; m < 4; ++m) _Pragma("unroll") for (int k = 0; k < 2; ++k) dst[m][k] = *(const LAS h16x8*)(lds + PG8_SA(b, h) + aoff + m * 2048 + k * 1024); } while (0)
#define PG8_LDB(dst, b, h) do { _Pragma("unroll") for (int n = 0; n < 2; ++n) _Pragma("unroll") for (int k = 0; k < 2; ++k) dst[n][k] = *(const LAS h16x8*)(lds + PG8_SB(b, h) + boff + n * 2048 + k * 1024); } while (0)
#define PG8_MMA(ai, bj, At, Bt) do { __builtin_amdgcn_s_setprio(1); _Pragma("unroll") for (int m = 0; m < 4; ++m) _Pragma("unroll") for (int n = 0; n < 2; ++n) _Pragma("unroll") for (int k = 0; k < 2; ++k) \
        acc[ai][bj][m][n] = __builtin_amdgcn_mfma_f32_16x16x32_f16(Bt[n][k], At[m][k], acc[ai][bj][m][n], 0, 0, 0); __builtin_amdgcn_s_setprio(0); } while (0)
#define PG8_WAIT_V(n) asm volatile("s_waitcnt vmcnt(" #n ")" ::: "memory")
#define PG8_WAIT_L(n) asm volatile("s_waitcnt lgkmcnt(" #n ")" ::: "memory")
#define PG8_BAR __builtin_amdgcn_s_barrier()
#define PG8_SCHED __builtin_amdgcn_sched_barrier(0)
    Unit cur, nxt; int ui = 0;
    if (!S.next(0, cur)) return;
    f32x4 acc[2][2][4][2];
#pragma unroll
    for (int a = 0; a < 2; ++a)
#pragma unroll
        for (int b = 0; b < 2; ++b)
#pragma unroll
            for (int m = 0; m < 4; ++m)
#pragma unroll
                for (int n = 0; n < 2; ++n) acc[a][b][m][n] = (f32x4){0.f, 0.f, 0.f, 0.f};
    h16x8 At[4][2], B0[2][2], B1[2][2];
    const char* cA = (const char*)g.A + (size_t)cur.pm * tstepA + (size_t)cur.pn * g.a_pn_bytes; const char* cB = (const char*)g.Bt + (size_t)cur.pn * tstepB;
    PG8_STAGE(PG8_SB(0, 0), cB, voffB); PG8_STAGE(PG8_SA(0, 0), cA, voffA); PG8_STAGE(PG8_SB(0, 1), cB + hstepB, voffB); PG8_STAGE(PG8_SA(0, 1), cA + hstepA, voffA);
    if (wr == 1) PG8_BAR;
    PG8_WAIT_V(4); PG8_BAR;
    PG8_STAGE(PG8_SB(1, 0), cB + kstep, voffB); PG8_STAGE(PG8_SA(1, 0), cA + kstep, voffA); PG8_STAGE(PG8_SB(1, 1), cB + hstepB + kstep, voffB);
    PG8_WAIT_V(6); PG8_BAR;
    for (;;) {
        const bool has_next = S.next(ui + 1, nxt);
        const char* nA = has_next ? (const char*)g.A + (size_t)nxt.pm * tstepA + (size_t)nxt.pn * g.a_pn_bytes : cA; const char* nB = has_next ? (const char*)g.Bt + (size_t)nxt.pn * tstepB : cB;
        for (int t = 0; t < nt; t += 2) {
            const bool last = (t == nt - 2);
            const char* a1 = cA + (size_t)(t + 1) * kstep;
            const char* a2 = last ? nA : cA + (size_t)(t + 2) * kstep; const char* b2 = last ? nB : cB + (size_t)(t + 2) * kstep;
            const char* a3 = a2 + kstep; const char* b3 = b2 + kstep;
            PG8_LDB(B0, 0, 0); PG8_SCHED; PG8_LDA(At, 0, 0); PG8_STAGE(PG8_SA(1, 1), a1 + hstepA, voffA);
            PG8_WAIT_L(8); PG8_BAR; PG8_WAIT_L(0); PG8_MMA(0, 0, At, B0); PG8_BAR; PG8_SCHED;
            PG8_LDB(B1, 0, 1); PG8_STAGE(PG8_SB(0, 0), b2, voffB);
            PG8_BAR; PG8_WAIT_L(0); PG8_MMA(0, 1, At, B1); PG8_BAR;
            PG8_LDA(At, 0, 1); PG8_STAGE(PG8_SA(0, 0), a2, voffA);
            PG8_BAR; PG8_WAIT_L(0); PG8_MMA(1, 0, At, B0); PG8_BAR; PG8_SCHED;
            PG8_STAGE(PG8_SB(0, 1), b2 + hstepB, voffB);
            PG8_WAIT_V(6); PG8_BAR; PG8_MMA(1, 1, At, B1); PG8_BAR;
            PG8_LDB(B0, 1, 0); PG8_SCHED; PG8_LDA(At, 1, 0); PG8_STAGE(PG8_SA(0, 1), a2 + hstepA, voffA);
            PG8_WAIT_L(8); PG8_BAR; PG8_WAIT_L(0); PG8_MMA(0, 0, At, B0); PG8_BAR; PG8_SCHED;
            PG8_LDB(B1, 1, 1); PG8_STAGE(PG8_SB(1, 0), b3, voffB);
            PG8_BAR; PG8_WAIT_L(0); PG8_MMA(0, 1, At, B1); PG8_BAR;
            PG8_LDA(At, 1, 1); PG8_STAGE(PG8_SA(1, 0), a3, voffA);
            PG8_BAR; PG8_WAIT_L(0); PG8_MMA(1, 0, At, B0); PG8_BAR; PG8_SCHED;
            PG8_STAGE(PG8_SB(1, 1), b3 + hstepB, voffB);
            PG8_WAIT_V(6); PG8_BAR; PG8_MMA(1, 1, At, B1); PG8_BAR;
        }
        E(acc, cur, wr, wc, fr, fq);
        if (!has_next) break;
#pragma unroll
        for (int a = 0; a < 2; ++a)
#pragma unroll
            for (int b = 0; b < 2; ++b)
#pragma unroll
                for (int m = 0; m < 4; ++m)
#pragma unroll
                    for (int n = 0; n < 2; ++n) acc[a][b][m][n] = (f32x4){0.f, 0.f, 0.f, 0.f};
        cur = nxt; cA = nA; cB = nB; ++ui;
    }
    PG8_WAIT_V(0);
    if (wr == 0) PG8_BAR;
    PG8_BAR;
#undef PG8_SA
#undef PG8_SB
#undef PG8_STAGE
#undef PG8_LDA
#undef PG8_LDB
#undef PG8_MMA
#undef PG8_WAIT_V
#undef PG8_WAIT_L
#undef PG8_BAR
#undef PG8_SCHED
}
}
typedef f32x4 AccT[2][2][4][2];

struct EpiIn {
    h16 *qb, *kb, *vt, *guv, *gates;
    __device__ __forceinline__ void operator()(const AccT& acc, const pg8::Unit& u, int wr, int wc, int fr, int fq) const {
        const int pn = u.pn;
        const int row0 = u.pm * 256 + wr * 64 + fr;
        const int cin = wc * 32 + 8 * fq;
        const int b = (u.pm * 256) >> 11, sb = ((u.pm * 256) & 2047) + wr * 64;
        if (pn < 2) {
            h16* base = qb + (size_t)row0 * 512 + pn * 256 + cin;
#pragma unroll
            for (int ai = 0; ai < 2; ++ai)
#pragma unroll
                for (int m = 0; m < 4; ++m)
#pragma unroll
                    for (int bj = 0; bj < 2; ++bj) *(h16x8*)(base + (ai * 128 + m * 16) * 512 + bj * 128) = pack8(acc[ai][bj][m][0], acc[ai][bj][m][1]);
        } else if (pn < 4) {
#pragma unroll
            for (int bj = 0; bj < 2; ++bj) {
                const int col = (pn & 1) * 256 + bj * 128 + cin, hd = col >> 6, d0 = col & 63;
                h16* base = kb + ((size_t)(b * 8 + hd) * 2048 + sb + fr) * 64 + d0;
#pragma unroll
                for (int ai = 0; ai < 2; ++ai)
#pragma unroll
                    for (int m = 0; m < 4; ++m) *(h16x8*)(base + (ai * 128 + m * 16) * 64) = pack8(acc[ai][bj][m][0], acc[ai][bj][m][1]);
            }
        } else if (pn < 6) {
#pragma unroll
            for (int bj = 0; bj < 2; ++bj) {
                const int cv = (pn - 4) * 256 + bj * 128 + cin, hd = cv >> 6, d0 = cv & 63;
                h16* base = vt + ((size_t)(b * 8 + hd) * 256 + (sb >> 3) + (fr >> 3)) * 512 + d0 * 8 + (fr & 7);
#pragma unroll
                for (int ai = 0; ai < 2; ++ai)
#pragma unroll
                    for (int m = 0; m < 4; ++m) {
                        h16* vp = base + (ai * 16 + m * 2) * 512;
                        const f32x4 v0 = acc[ai][bj][m][0], v1 = acc[ai][bj][m][1];
#pragma unroll
                        for (int i = 0; i < 4; ++i) { vp[i * 8] = (h16)v0[i]; vp[(i + 4) * 8] = (h16)v1[i]; }
                    }
            }
        } else if (pn < 10) {
            h16* base = guv + (size_t)row0 * 1024 + (pn - 6) * 256 + cin;
#pragma unroll
            for (int ai = 0; ai < 2; ++ai)
#pragma unroll
                for (int m = 0; m < 4; ++m)
#pragma unroll
                    for (int bj = 0; bj < 2; ++bj) {
                        f32x4 v0 = acc[ai][bj][m][0], v1 = acc[ai][bj][m][1];
#pragma unroll
                        for (int i = 0; i < 4; ++i) { v0[i] = gelu_tanh(v0[i]); v1[i] = gelu_tanh(v1[i]); }
                        *(h16x8*)(base + (ai * 128 + m * 16) * 1024 + bj * 128) = pack8(v0, v1);
                    }
        } else {
            h16* base = gates + (size_t)row0 * 2048 + (pn - 10) * 256 + cin;
#pragma unroll
            for (int ai = 0; ai < 2; ++ai)
#pragma unroll
                for (int m = 0; m < 4; ++m)
#pragma unroll
                    for (int bj = 0; bj < 2; ++bj) {
                        f32x4 v0 = acc[ai][bj][m][0], v1 = acc[ai][bj][m][1];
#pragma unroll
                        for (int i = 0; i < 4; ++i) { v0[i] = sigmoidf_(v0[i]); v1[i] = sigmoidf_(v1[i]); }
                        *(h16x8*)(base + (ai * 128 + m * 16) * 2048 + bj * 128) = pack8(v0, v1);
                    }
        }
    }
};
struct EpiCtx {
    h16 *kc, *vct;
    __device__ __forceinline__ void operator()(const AccT& acc, const pg8::Unit& u, int wr, int wc, int fr, int fq) const {
        const int pn = u.pn;
        const int cin = wc * 32 + 8 * fq;
        const int b = u.pm, sb = wr * 64;
        if (pn < 2) {
#pragma unroll
            for (int bj = 0; bj < 2; ++bj) {
                const int col = pn * 256 + bj * 128 + cin, hd = col >> 6, d0 = col & 63;
                h16* base = kc + ((size_t)(b * 8 + hd) * 256 + sb + fr) * 64 + d0;
#pragma unroll
                for (int ai = 0; ai < 2; ++ai)
#pragma unroll
                    for (int m = 0; m < 4; ++m) *(h16x8*)(base + (ai * 128 + m * 16) * 64) = pack8(acc[ai][bj][m][0], acc[ai][bj][m][1]);
            }
        } else {
#pragma unroll
            for (int bj = 0; bj < 2; ++bj) {
                const int cv = (pn - 2) * 256 + bj * 128 + cin, hd = cv >> 6, d0 = cv & 63;
                h16* base = vct + ((size_t)(b * 8 + hd) * 32 + (sb >> 3) + (fr >> 3)) * 512 + d0 * 8 + (fr & 7);
#pragma unroll
                for (int ai = 0; ai < 2; ++ai)
#pragma unroll
                    for (int m = 0; m < 4; ++m) {
                        h16* vp = base + (ai * 16 + m * 2) * 512;
                        const f32x4 v0 = acc[ai][bj][m][0], v1 = acc[ai][bj][m][1];
#pragma unroll
                        for (int i = 0; i < 4; ++i) { vp[i * 8] = (h16)v0[i]; vp[(i + 4) * 8] = (h16)v1[i]; }
                    }
            }
        }
    }
};
struct EpiM1 {
    h16* m1; const h16* gates;
    __device__ __forceinline__ void operator()(const AccT& acc, const pg8::Unit& u, int wr, int wc, int fr, int fq) const {
        const int row0 = u.pm * 256 + wr * 64 + fr, col0 = u.pn * 256 + wc * 32 + 8 * fq;
#pragma unroll
        for (int ai = 0; ai < 2; ++ai)
#pragma unroll
            for (int m = 0; m < 4; ++m) {
                const int row = row0 + ai * 128 + m * 16;
#pragma unroll
                for (int bj = 0; bj < 2; ++bj) {
                    const int col = col0 + bj * 128;
                    const h16x8 gt = *(const h16x8*)(gates + (size_t)row * 2048 + col);
                    f32x4 v0 = acc[ai][bj][m][0], v1 = acc[ai][bj][m][1];
#pragma unroll
                    for (int i = 0; i < 4; ++i) { v0[i] *= (float)gt[i]; v1[i] *= (float)gt[4 + i]; }
                    *(h16x8*)(m1 + (size_t)row * 1024 + col) = pack8(v0, v1);
                }
            }
    }
};
struct EpiM2 {
    const h16* m1; const h16* gates; h16* mm;
    __device__ __forceinline__ void operator()(const AccT& acc, const pg8::Unit& u, int wr, int wc, int fr, int fq) const {
        const int row0 = u.pm * 256 + wr * 64 + fr, col0 = u.pn * 256 + wc * 32 + 8 * fq;
#pragma unroll
        for (int ai = 0; ai < 2; ++ai)
#pragma unroll
            for (int m = 0; m < 4; ++m) {
                const int row = row0 + ai * 128 + m * 16;
#pragma unroll
                for (int bj = 0; bj < 2; ++bj) {
                    const int col = col0 + bj * 128;
                    const h16x8 gt = *(const h16x8*)(gates + (size_t)row * 2048 + 1024 + col);
                    const h16x8 mi = *(const h16x8*)(m1 + (size_t)row * 1024 + col);
                    f32x4 p0 = (f32x4){(float)mi[0], (float)mi[1], (float)mi[2], (float)mi[3]}, p1 = (f32x4){(float)mi[4], (float)mi[5], (float)mi[6], (float)mi[7]};
                    const f32x4 v0 = acc[ai][bj][m][0], v1 = acc[ai][bj][m][1];
#pragma unroll
                    for (int i = 0; i < 4; ++i) { p0[i] += v0[i] * (float)gt[i]; p1[i] += v1[i] * (float)gt[4 + i]; }
                    *(h16x8*)(mm + (size_t)row * 1024 + col) = pack8(p0, p1);
                }
            }
    }
};
struct EpiX1 {
    const float* x; const float* mod; h16* x1;
    __device__ __forceinline__ void operator()(const AccT& acc, const pg8::Unit& u, int wr, int wc, int fr, int fq) const {
        const int row0 = u.pm * 256 + wr * 64 + fr, col0 = u.pn * 256 + wc * 32 + 8 * fq;
        const int b = (u.pm * 256) >> 11;
#pragma unroll
        for (int bj = 0; bj < 2; ++bj) {
            const int col = col0 + bj * 128;
            const float* gp = mod + (size_t)b * 6144 + 2 * 1024 + col;
            const f32x4 g0 = *(const f32x4*)gp, g1 = *(const f32x4*)(gp + 4);
#pragma unroll
            for (int ai = 0; ai < 2; ++ai)
#pragma unroll
                for (int m = 0; m < 4; ++m) {
                    const int row = row0 + ai * 128 + m * 16;
                    const float* xi = x + (size_t)row * 1024 + col;
                    const f32x4 x0 = *(const f32x4*)xi, x1v = *(const f32x4*)(xi + 4);
                    *(h16x8*)(x1 + (size_t)row * 1024 + col) = pack8(x0 + g0 * acc[ai][bj][m][0], x1v + g1 * acc[ai][bj][m][1]);
                }
        }
    }
};
struct EpiH16 {
    h16* o; int ldc;
    __device__ __forceinline__ void operator()(const AccT& acc, const pg8::Unit& u, int wr, int wc, int fr, int fq) const {
        const int row0 = u.pm * 256 + wr * 64 + fr, col0 = u.pn * 256 + wc * 32 + 8 * fq;
#pragma unroll
        for (int ai = 0; ai < 2; ++ai)
#pragma unroll
            for (int m = 0; m < 4; ++m) {
                const int row = row0 + ai * 128 + m * 16;
#pragma unroll
                for (int bj = 0; bj < 2; ++bj)
                    *(h16x8*)(o + (size_t)row * ldc + col0 + bj * 128) = pack8(acc[ai][bj][m][0], acc[ai][bj][m][1]);
            }
    }
};

__device__ __forceinline__ void cvt_tile(const float* __restrict__ src, h16* __restrict__ dst, int tile) {
    const size_t i = (size_t)tile * 4096 + threadIdx.x * 8;
    const f32x4 a = *(const f32x4*)(src + i), b = *(const f32x4*)(src + i + 4);
    *(h16x8*)(dst + i) = pack8(a, b);
}
__device__ __forceinline__ void tr_tile(const float* __restrict__ src, h16* __restrict__ dst, int K, int N, int tile, float* lds) {
    const int ntn = N / 64, tk = tile / ntn, tn = tile % ntn, tid = threadIdx.x;
#pragma unroll
    for (int ps = 0; ps < 2; ++ps) {
        const int k = ps * 32 + (tid >> 4), n = (tid & 15) * 4;
        const f32x4 v = *(const f32x4*)(src + (size_t)(tk * 64 + k) * N + tn * 64 + n);
        lds[k * 65 + n] = v[0]; lds[k * 65 + n + 1] = v[1]; lds[k * 65 + n + 2] = v[2]; lds[k * 65 + n + 3] = v[3];
    }
    __syncthreads();
    {
        const int n = tid >> 3, ks = (tid & 7) * 8;
        h16x8 o;
#pragma unroll
        for (int i = 0; i < 8; ++i) o[i] = (h16)lds[(ks + i) * 65 + n];
        *(h16x8*)(dst + (size_t)(tn * 64 + n) * K + tk * 64 + ks) = o;
    }
    __syncthreads();
}
__device__ __forceinline__ void cvt8_rows(const float* __restrict__ src, unsigned char* __restrict__ dst, float* __restrict__ inv, int tile, int dstride = 1024) {
    const int wid = threadIdx.x >> 6, lane = threadIdx.x & 63;
    const size_t row = (size_t)tile * 8 + wid;
    const float* r = src + row * 1024 + lane * 16;
    f32x4 a[4]; float mx = 0.f;
#pragma unroll
    for (int i = 0; i < 4; ++i) { a[i] = *(const f32x4*)(r + 4 * i); mx = fmaxf(mx, fmaxf(fmaxf(fabsf(a[i][0]), fabsf(a[i][1])), fmaxf(fabsf(a[i][2]), fabsf(a[i][3])))); }
#pragma unroll
    for (int o = 32; o > 0; o >>= 1) mx = fmaxf(mx, __shfl_xor(mx, o));
    int ex2 = 0; float sc = 1.0f;
    if (mx > 0.f) { (void)frexpf(mx, &ex2); int k = 8 - ex2; k = k > 100 ? 100 : (k < -100 ? -100 : k); sc = ldexpf(1.0f, k); }
    i32x4 w;
#pragma unroll
    for (int i = 0; i < 4; ++i) {
        int pk = __builtin_amdgcn_cvt_pk_fp8_f32(a[i][0] * sc, a[i][1] * sc, 0, false);
        pk = __builtin_amdgcn_cvt_pk_fp8_f32(a[i][2] * sc, a[i][3] * sc, pk, true);
        w[i] = pk;
    }
    *(i32x4*)(dst + row * dstride + lane * 16) = w;
    if (lane == 0) inv[2 * row] = 1.0f / sc;
}
__device__ __forceinline__ void cvt4_rows(const float* __restrict__ src, unsigned char* __restrict__ dst, float* __restrict__ inv, int tile, int dstride = 512) {
    const int wid = threadIdx.x >> 6, lane = threadIdx.x & 63;
    const size_t row = (size_t)tile * 8 + wid;
    const float* r = src + row * 1024 + lane * 16;
    f32x4 a[4]; float mx = 0.f;
#pragma unroll
    for (int i = 0; i < 4; ++i) { a[i] = *(const f32x4*)(r + 4 * i); mx = fmaxf(mx, fmaxf(fmaxf(fabsf(a[i][0]), fabsf(a[i][1])), fmaxf(fabsf(a[i][2]), fabsf(a[i][3])))); }
#pragma unroll
    for (int o = 32; o > 0; o >>= 1) mx = fmaxf(mx, __shfl_xor(mx, o));
    const float sc = (mx > 1e-30f) ? 6.0f / mx : 1.0f;
    int w0 = 0, w1 = 0;
    w0 = __builtin_amdgcn_cvt_scalef32_pk_fp4_f32(w0, a[0][0] * sc, a[0][1] * sc, 1.0f, 0);
    w0 = __builtin_amdgcn_cvt_scalef32_pk_fp4_f32(w0, a[0][2] * sc, a[0][3] * sc, 1.0f, 1);
    w0 = __builtin_amdgcn_cvt_scalef32_pk_fp4_f32(w0, a[1][0] * sc, a[1][1] * sc, 1.0f, 2);
    w0 = __builtin_amdgcn_cvt_scalef32_pk_fp4_f32(w0, a[1][2] * sc, a[1][3] * sc, 1.0f, 3);
    w1 = __builtin_amdgcn_cvt_scalef32_pk_fp4_f32(w1, a[2][0] * sc, a[2][1] * sc, 1.0f, 0);
    w1 = __builtin_amdgcn_cvt_scalef32_pk_fp4_f32(w1, a[2][2] * sc, a[2][3] * sc, 1.0f, 1);
    w1 = __builtin_amdgcn_cvt_scalef32_pk_fp4_f32(w1, a[3][0] * sc, a[3][1] * sc, 1.0f, 2);
    w1 = __builtin_amdgcn_cvt_scalef32_pk_fp4_f32(w1, a[3][2] * sc, a[3][3] * sc, 1.0f, 3);
    *(i32x2*)(dst + row * dstride + lane * 8) = (i32x2){w0, w1};
    if (lane == 0) inv[2 * row] = 1.0f / sc;
}
__device__ __forceinline__ void wqk_tile(const float* __restrict__ wq, const float* __restrict__ keys, h16* __restrict__ wt, int tile, float* lds) {
    const int ct = tile >> 4, hp = tile & 15, tid = threadIdx.x;
    float* sA = lds;
    float* sB = lds + 64 * 129;
#pragma unroll
    for (int i = 0; i < 4; ++i) {
        const int e = (i * 512 + tid) * 4, r = e >> 7, d = e & 127;
        const f32x4 v = *(const f32x4*)(wq + (size_t)(ct * 64 + r) * 2048 + hp * 128 + d);
        sA[r * 129 + d] = v[0]; sA[r * 129 + d + 1] = v[1]; sA[r * 129 + d + 2] = v[2]; sA[r * 129 + d + 3] = v[3];
    }
#pragma unroll
    for (int i = 0; i < 8; ++i) {
        const int e = (i * 512 + tid) * 4, k = e >> 7, d = e & 127;
        const f32x4 v = *(const f32x4*)(keys + (size_t)(hp * 128 + k) * 128 + d);
        sB[k * 129 + d] = v[0]; sB[k * 129 + d + 1] = v[1]; sB[k * 129 + d + 2] = v[2]; sB[k * 129 + d + 3] = v[3];
    }
    __syncthreads();
    const int cg = tid >> 5, kq = tid & 31;
    float acc[4][4];
#pragma unroll
    for (int i = 0; i < 4; ++i)
#pragma unroll
        for (int j = 0; j < 4; ++j) acc[i][j] = 0.f;
#pragma unroll 4
    for (int d = 0; d < 128; ++d) {
        float a[4], bq[4];
#pragma unroll
        for (int i = 0; i < 4; ++i) a[i] = sA[(cg * 4 + i) * 129 + d];
#pragma unroll
        for (int j = 0; j < 4; ++j) bq[j] = sB[(kq + 32 * j) * 129 + d];
#pragma unroll
        for (int i = 0; i < 4; ++i)
#pragma unroll
            for (int j = 0; j < 4; ++j) acc[i][j] += a[i] * bq[j];
    }
#pragma unroll
    for (int j = 0; j < 4; ++j) {
        h16x4 o;
#pragma unroll
        for (int i = 0; i < 4; ++i) o[i] = (h16)acc[i][j];
        *(h16x4*)(wt + (size_t)(hp * 128 + kq + 32 * j) * 1024 + ct * 64 + cg * 4) = o;
    }
    __syncthreads();
}
__device__ void phase0(const Params& p, float* lds) {
    unsigned char* ws = p.ws;
    const int tid = threadIdx.x, wid = tid >> 6, lane = tid & 63;
    for (int ib = blockIdx.x; ib < 256; ib += gridDim.x) {
        if (wid < 6) {
            const int item = ib * 6 + wid, cg64 = item % 96, kc = item / 96;
            const int col = cg64 * 64 + lane, k0 = kc * 64;
            float sv[17], acc[17];
#pragma unroll
            for (int b = 0; b < 17; ++b) {
                const float cv = (b < 16) ? p.in[I_C][b * 1024 + k0 + lane] : p.in[I_CCTX][k0 + lane];
                sv[b] = silu_(cv); acc[b] = 0.f;
            }
            const float* wp = p.in[I_ADAW] + (size_t)k0 * 6144 + col;
#pragma unroll 16
            for (int j = 0; j < 64; ++j) {
                const float w = wp[(size_t)j * 6144];
#pragma unroll
                for (int b = 0; b < 17; ++b) acc[b] += __builtin_bit_cast(float, __builtin_amdgcn_readlane(__builtin_bit_cast(int, sv[b]), j)) * w;
            }
            float* mp = (float*)(ws + OFF_MODP);
#pragma unroll
            for (int b = 0; b < 17; ++b) mp[((size_t)kc * 17 + b) * 6144 + col] = acc[b];
        }
    }
    constexpr int T0 = 2048, T1 = T0 + 2048, T2 = T1 + 32, T3 = T2, T4 = T3 + 1152, T5 = T4 + 128, T6 = T5 + 128, T7 = T6 + 256, T8 = T7 + 256;
    for (int t = blockIdx.x; t < T8; t += gridDim.x) {
        if (t < T0) cvt4_rows(p.in[I_PU], ws + OFF_U8, (float*)(ws + OFF_USC), t, 1536);
        else if (t < T1) cvt8_rows(p.in[I_PV], ws + OFF_U8 + 512, (float*)(ws + OFF_USC) + 1, t - T0, 1536);
        else if (t < T2) cvt_tile(p.in[I_GMWS], (h16*)(ws + OFF_WS16), t - T1);
        else if (t < T3) {
            const int e = (t - T2) * 4096 + tid * 8;
            const int row = e >> 8, cc = e & 255, h = row >> 8, pp = (row >> 7) & 1, k = row & 127, pq = cc >> 7, d = cc & 127;
            h16x8 o = {0, 0, 0, 0, 0, 0, 0, 0};
            if (pp == pq) {
                const float* kp = p.in[I_KEYS] + ((size_t)((h * 2 + pp) * 128 + k)) * 128 + d;
                o = pack8(*(const f32x4*)kp, *(const f32x4*)(kp + 4));
            }
            *(h16x8*)((h16*)(ws + OFF_BD) + e) = o;
        }
        else if (t < T4) tr_tile(p.in[I_WIN], (h16*)(ws + OFF_WINT), 1024, INC, t - T3, lds);
        else if (t < T5) tr_tile(p.in[I_WPA], (h16*)(ws + OFF_WPAT), 512, 1024, t - T4, lds);
        else if (t < T6) tr_tile(p.in[I_WPB], (h16*)(ws + OFF_WPBT), 512, 1024, t - T5, lds);
        else if (t < T7) tr_tile(p.in[I_WOUT], (h16*)(ws + OFF_WOUTT), 1024, 1024, t - T6, lds);
        else wqk_tile(p.in[I_WQ], p.in[I_KEYS], (h16*)(ws + OFF_WQT), t - T7, lds);
    }
}

__device__ __forceinline__ void norm_rows(const float* __restrict__ src, h16* __restrict__ dst, int row_begin, int rows_per_wave, const float* sA, const float* sB) {
    const int tid_ = fresh_tid();
    const int wid = tid_ >> 6, lane = tid_ & 63;
    f32x4 a[4], bsh[4];
#pragma unroll
    for (int c = 0; c < 4; ++c) { a[c] = *(const f32x4*)(sA + c * 256 + lane * 4); bsh[c] = *(const f32x4*)(sB + c * 256 + lane * 4); }
    for (int i = 0; i < rows_per_wave; i += 2) {
        const size_t row = (size_t)row_begin + wid * rows_per_wave + i;
        f32x4 v[2][4]; float ss[2];
#pragma unroll
        for (int q = 0; q < 2; ++q) {
            ss[q] = 0.f;
#pragma unroll
            for (int c = 0; c < 4; ++c) { v[q][c] = *(const f32x4*)(src + (row + q) * 1024 + c * 256 + lane * 4); ss[q] += v[q][c][0] * v[q][c][0] + v[q][c][1] * v[q][c][1] + v[q][c][2] * v[q][c][2] + v[q][c][3] * v[q][c][3]; }
        }
#pragma unroll
        for (int o = 32; o > 0; o >>= 1) { const float t0 = __shfl_xor(ss[0], o), t1 = __shfl_xor(ss[1], o); ss[0] += t0; ss[1] += t1; }
#pragma unroll
        for (int q = 0; q < 2; ++q) {
            const float r = rsqrtf(ss[q] * (1.0f / 1024.0f) + 1e-6f);
#pragma unroll
            for (int c = 0; c < 4; ++c) {
                h16x4 o;
#pragma unroll
                for (int j = 0; j < 4; ++j) o[j] = (h16)(v[q][c][j] * r * a[c][j] + bsh[c][j]);
                *(h16x4*)(dst + (row + q) * 1024 + c * 256 + lane * 4) = o;
            }
        }
    }
}
__device__ __forceinline__ void norm_rows_h(const h16* __restrict__ src, h16* __restrict__ dst, int row_begin, int rows_per_wave, const float* sA, const float* sB) {
    const int tid_ = fresh_tid();
    const int wid = tid_ >> 6, lane = tid_ & 63;
    f32x4 a[4], bsh[4];
#pragma unroll
    for (int c = 0; c < 4; ++c) { a[c] = *(const f32x4*)(sA + c * 256 + lane * 4); bsh[c] = *(const f32x4*)(sB + c * 256 + lane * 4); }
    for (int i = 0; i < rows_per_wave; i += 2) {
        const size_t row = (size_t)row_begin + wid * rows_per_wave + i;
        f32x4 v[2][4]; float ss[2];
#pragma unroll
        for (int q = 0; q < 2; ++q) {
            ss[q] = 0.f;
#pragma unroll
            for (int c = 0; c < 4; ++c) { const h16x4 hv = *(const h16x4*)(src + (row + q) * 1024 + c * 256 + lane * 4);
                v[q][c] = (f32x4){(float)hv[0], (float)hv[1], (float)hv[2], (float)hv[3]};
                ss[q] += v[q][c][0] * v[q][c][0] + v[q][c][1] * v[q][c][1] + v[q][c][2] * v[q][c][2] + v[q][c][3] * v[q][c][3]; }
        }
#pragma unroll
        for (int o = 32; o > 0; o >>= 1) { const float t0 = __shfl_xor(ss[0], o), t1 = __shfl_xor(ss[1], o); ss[0] += t0; ss[1] += t1; }
#pragma unroll
        for (int q = 0; q < 2; ++q) {
            const float r = rsqrtf(ss[q] * (1.0f / 1024.0f) + 1e-6f);
#pragma unroll
            for (int c = 0; c < 4; ++c) {
                h16x4 o;
#pragma unroll
                for (int j = 0; j < 4; ++j) o[j] = (h16)(v[q][c][j] * r * a[c][j] + bsh[c][j]);
                *(h16x4*)(dst + (row + q) * 1024 + c * 256 + lane * 4) = o;
            }
        }
    }
}
__device__ void phase1(const Params& p, float* lds) {
    unsigned char* ws = p.ws;
    const int tid = threadIdx.x;
    const float* mp = (const float*)(ws + OFF_MODP);
    const float* bias = p.in[I_ADAB];
    float* sA = lds; float* sB = lds + 1024; float* cA = lds + 2048; float* cB = lds + 3072;
    {
        float* mod = (float*)(ws + OFF_MOD);
        for (int e = blockIdx.x * 512 + tid; e < 17 * 6144; e += gridDim.x * 512) {
            float s = bias[e % 6144];
#pragma unroll
            for (int kc = 0; kc < 16; ++kc) s += mp[(size_t)kc * 17 * 6144 + e];
            mod[e] = s;
        }
    }
    for (int col = tid; col < 1024; col += 512) {
        float sh = bias[col], sc = bias[1024 + col];
#pragma unroll
        for (int kc = 0; kc < 16; ++kc) { sh += mp[((size_t)kc * 17 + 16) * 6144 + col]; sc += mp[((size_t)kc * 17 + 16) * 6144 + 1024 + col]; }
        cA[col] = p.in[I_N1G][col] * (1.0f + sc); cB[col] = sh;
    }
    for (int rg = blockIdx.x; rg < 256; rg += gridDim.x) {
        const int b = rg >> 4;
        __syncthreads();
        for (int col = tid; col < 1024; col += 512) {
            float sh = bias[col], sc = bias[1024 + col];
#pragma unroll
            for (int kc = 0; kc < 16; ++kc) { sh += mp[((size_t)kc * 17 + b) * 6144 + col]; sc += mp[((size_t)kc * 17 + b) * 6144 + 1024 + col]; }
            sA[col] = p.in[I_N1G][col] * (1.0f + sc); sB[col] = sh;
        }
        __syncthreads();
        norm_rows(p.in[I_X], (h16*)(ws + OFF_R1), rg * 128, 16, sA, sB);
        norm_rows(p.in[I_CTX], (h16*)(ws + OFF_HC), rg * 16, 2, cA, cB);
    }
}
__device__ void phase6(const Params& p, float* lds) {
    unsigned char* ws = p.ws;
    const int tid = threadIdx.x;
    const float* mod = (const float*)(ws + OFF_MOD);
    float* sA = lds; float* sB = lds + 1024;
    for (int rg = blockIdx.x; rg < 256; rg += gridDim.x) {
        const int b = rg >> 4;
        __syncthreads();
        for (int col = tid; col < 1024; col += 512) {
            sA[col] = p.in[I_N2G][col] * (1.0f + mod[(size_t)b * 6144 + 4 * 1024 + col]); sB[col] = mod[(size_t)b * 6144 + 3 * 1024 + col];
        }
        __syncthreads();
        norm_rows_h((const h16*)(ws + OFF_X1H), (h16*)(ws + OFF_R1), rg * 128, 16, sA, sB);
    }
}

__device__ __forceinline__ int clampi(int v, int lo, int hi) { return v < lo ? lo : (v > hi ? hi : v); }

template <bool LOCAL>
__device__ __forceinline__ void attn_core(const h16x8 (&kf)[2][2], const h16x8 (&vf)[4], const float (&bias)[8], const int cb, const int qc, const int cs,
                                          const h16x8 (&qf)[2], float& m_run, float& l_run, f32x4 (&O)[4], const int quad) {
    f32x4 st[2];
#pragma unroll
    for (int t = 0; t < 2; ++t) {
        f32x4 a = (f32x4){0.f, 0.f, 0.f, 0.f};
#pragma unroll
        for (int ks = 0; ks < 2; ++ks) a = __builtin_amdgcn_mfma_f32_16x16x32_f16(kf[t][ks], qf[ks], a, 0, 0, 0);
        st[t] = a;
    }
    float mx = -INFINITY;
#pragma unroll
    for (int t = 0; t < 2; ++t)
#pragma unroll
        for (int j = 0; j < 4; ++j) {
            float sv = st[t][j] * 0.125f;
            if (LOCAL) {
                const int kc = cb + 16 * t + quad * 4 + j;
                const bool inw = (kc >= cs) && (kc < cs + 16);
                sv = inw ? (sv + bias[t * 4 + j]) : -1e30f;
            }
            st[t][j] = sv; mx = fmaxf(mx, sv);
        }
    mx = fmaxf(mx, __shfl_xor(mx, 16)); mx = fmaxf(mx, __shfl_xor(mx, 32));
    const float m_new = fmaxf(m_run, mx);
    const float alpha = __expf(m_run - m_new);
    float ls = 0.f; h16x8 pf;
#pragma unroll
    for (int t = 0; t < 2; ++t)
#pragma unroll
        for (int j = 0; j < 4; ++j) { const float pe = __expf(st[t][j] - m_new); ls += pe; pf[t * 4 + j] = (h16)pe; }
    l_run = l_run * alpha + ls; m_run = m_new;
#pragma unroll
    for (int dt = 0; dt < 4; ++dt) { O[dt] *= alpha; O[dt] = __builtin_amdgcn_mfma_f32_16x16x32_f16(vf[dt], pf, O[dt], 0, 0, 0); }
}
__device__ __forceinline__ void load_k(const h16* __restrict__ kt, h16x8 (&kf)[2][2], const int l15, const int quad) {
#pragma unroll
    for (int t = 0; t < 2; ++t)
#pragma unroll
        for (int ks = 0; ks < 2; ++ks) kf[t][ks] = *(const h16x8*)(kt + (16 * t + l15) * 64 + ks * 32 + quad * 8);
}
__device__ __forceinline__ void load_v(const h16* __restrict__ vt, h16x8 (&vf)[4], const int l15, const int quad) {
#pragma unroll
    for (int dt = 0; dt < 4; ++dt) {
        const h16* vp = vt + ((quad >> 1) * 64 + dt * 16 + l15) * 8 + (quad & 1) * 4;
        const h16x4 lo = *(const h16x4*)vp, hi = *(const h16x4*)(vp + 2 * 512);
        vf[dt] = (h16x8){lo[0], lo[1], lo[2], lo[3], hi[0], hi[1], hi[2], hi[3]};
    }
}
__device__ __forceinline__ void load_bias(const float* __restrict__ rpbrow, const int cb, const int qc, const int quad, float (&bias)[8]) {
#pragma unroll
    for (int t = 0; t < 2; ++t)
#pragma unroll
        for (int j = 0; j < 4; ++j) bias[t * 4 + j] = rpbrow[clampi(cb + 16 * t + quad * 4 + j - qc + 15, 0, 30)];
}

__device__ void attn_unit(const Params& p, int unit) {
    unsigned char* ws = p.ws;
    const int tid_ = fresh_tid();
    const int lane = tid_ & 63, h = tid_ >> 6, l15 = lane & 15, quad = lane >> 4;
    const int b = unit >> 5, r = unit & 31;
    const h16* QB = (const h16*)(ws + OFF_QB);
    const h16* KH = (const h16*)(ws + OFF_KB) + (size_t)(b * 8 + h) * 2048 * 64;
    const h16* VH = (const h16*)(ws + OFF_VT) + (size_t)(b * 8 + h) * 256 * 512;
    const h16* KCH = (const h16*)(ws + OFF_KC) + (size_t)(b * 8 + h) * 256 * 64;
    const h16* VCH = (const h16*)(ws + OFF_VCT) + (size_t)(b * 8 + h) * 32 * 512;
    h16* YA = (h16*)(ws + OFF_R1);
    const float* rpb = p.in[I_RPB] + (size_t)h * 15 * 31;
    const int rs = clampi(r - 4, 0, 24);
    h16x8 qf[4][2]; float m_run[4], l_run[4]; f32x4 O[4][4];
#pragma unroll
    for (int g = 0; g < 4; ++g) {
        const size_t tq = (size_t)b * 2048 + r * 64 + 16 * g + l15;
        qf[g][0] = *(const h16x8*)(QB + tq * 512 + h * 64 + quad * 8);
        qf[g][1] = *(const h16x8*)(QB + tq * 512 + h * 64 + 32 + quad * 8);
        m_run[g] = -INFINITY; l_run[g] = 0.f;
#pragma unroll
        for (int dt = 0; dt < 4; ++dt) O[g][dt] = (f32x4){0.f, 0.f, 0.f, 0.f};
    }
    {
        const float nob[8] = {0.f, 0.f, 0.f, 0.f, 0.f, 0.f, 0.f, 0.f};
        h16x8 kA[2][2], kB[2][2], vf[4];
        load_k(KCH, kA, l15, quad);
#pragma unroll 1
        for (int step = 0; step < 8; step += 2) {
            load_v(VCH + step * 4 * 512, vf, l15, quad);
            load_k(KCH + (step + 1) * 32 * 64, kB, l15, quad);
            __builtin_amdgcn_sched_barrier(0);
#pragma unroll
            for (int g = 0; g < 4; ++g) attn_core<false>(kA, vf, nob, 0, 0, 0, qf[g], m_run[g], l_run[g], O[g], quad);
            __builtin_amdgcn_sched_barrier(0);
            load_v(VCH + (step + 1) * 4 * 512, vf, l15, quad);
            if (step + 2 < 8) load_k(KCH + (step + 2) * 32 * 64, kA, l15, quad);
            __builtin_amdgcn_sched_barrier(0);
#pragma unroll
            for (int g = 0; g < 4; ++g) attn_core<false>(kB, vf, nob, 0, 0, 0, qf[g], m_run[g], l_run[g], O[g], quad);
            __builtin_amdgcn_sched_barrier(0);
        }
    }
#pragma unroll
    for (int gp = 0; gp < 4; gp += 2) {
        const int cb0 = clampi(16 * gp - 8, 0, 32), cb1 = clampi(16 * (gp + 1) - 8, 0, 32);
        const int qc0 = 16 * gp + l15, qc1 = 16 * (gp + 1) + l15;
        const int cs0 = clampi(qc0 - 8, 0, 48), cs1 = clampi(qc1 - 8, 0, 48);
        const float* rp0 = rpb + (rs - r + 7) * 31;
#pragma unroll 1
        for (int step = 0; step < 8; ++step) {
            const int t0 = (rs + step) * 64 + cb0, t1 = (rs + step) * 64 + cb1;
            h16x8 kf0[2][2], vf0[4], kf1[2][2], vf1[4]; float b0[8], b1[8];
            load_k(KH + (size_t)t0 * 64, kf0, l15, quad); load_k(KH + (size_t)t1 * 64, kf1, l15, quad);
            load_bias(rp0 + step * 31, cb0, qc0, quad, b0); load_bias(rp0 + step * 31, cb1, qc1, quad, b1);
            load_v(VH + (size_t)(t0 >> 3) * 512, vf0, l15, quad); load_v(VH + (size_t)(t1 >> 3) * 512, vf1, l15, quad);
            attn_core<true>(kf0, vf0, b0, cb0, qc0, cs0, qf[gp], m_run[gp], l_run[gp], O[gp], quad);
            attn_core<true>(kf1, vf1, b1, cb1, qc1, cs1, qf[gp + 1], m_run[gp + 1], l_run[gp + 1], O[gp + 1], quad);
        }
    }
#pragma unroll
    for (int g = 0; g < 4; ++g) {
        const size_t tq = (size_t)b * 2048 + r * 64 + 16 * g + l15;
        float l = l_run[g];
        l += __shfl_xor(l, 16); l += __shfl_xor(l, 32);
        const float inv = __builtin_amdgcn_rcpf(l);
#pragma unroll
        for (int dt = 0; dt < 4; ++dt) {
            h16x4 o;
#pragma unroll
            for (int j = 0; j < 4; ++j) o[j] = (h16)(O[g][dt][j] * inv);
            *(h16x4*)(YA + tq * 1024 + h * 64 + dt * 16 + quad * 4) = o;
        }
    }
}

__device__ void sgu_unit(const Params& p, int n, LAS unsigned char* lds) {
    unsigned char* ws = p.ws;
    const int tid = fresh_tid(), lane = tid & 63, g = tid >> 6, l15 = lane & 15, quad = lane >> 4;
    const h16* GUV = (const h16*)(ws + OFF_GUV);
    const h16* WS16 = (const h16*)(ws + OFF_WS16);
    h16* YB = (h16*)(ws + OFF_R1) + 512;
    LAS float* stat = (LAS float*)(lds + 8 * 17408);
    LAS h16* vt = (LAS h16*)(lds + g * 17408);
    const size_t t0 = (size_t)n * 128;
    __syncthreads();
    for (int i = 0; i < 16; i += 4) {
        h16x8 x[4]; float s[4], v[4];
#pragma unroll
        for (int q = 0; q < 4; ++q) {
            x[q] = *(const h16x8*)(GUV + (t0 + g * 16 + i + q) * 1024 + 512 + lane * 8);
            s[q] = 0.f;
#pragma unroll
            for (int j = 0; j < 8; ++j) s[q] += (float)x[q][j];
        }
#pragma unroll
        for (int o = 32; o > 0; o >>= 1) { float t[4];
#pragma unroll
            for (int q = 0; q < 4; ++q) t[q] = __shfl_xor(s[q], o);
#pragma unroll
            for (int q = 0; q < 4; ++q) s[q] += t[q]; }
#pragma unroll
        for (int q = 0; q < 4; ++q) {
            s[q] *= (1.0f / 512.0f); v[q] = 0.f;
#pragma unroll
            for (int j = 0; j < 8; ++j) { const float d = (float)x[q][j] - s[q]; v[q] += d * d; }
        }
#pragma unroll
        for (int o = 32; o > 0; o >>= 1) { float t[4];
#pragma unroll
            for (int q = 0; q < 4; ++q) t[q] = __shfl_xor(v[q], o);
#pragma unroll
            for (int q = 0; q < 4; ++q) v[q] += t[q]; }
        if (lane == 0) {
#pragma unroll
            for (int q = 0; q < 4; ++q) { stat[(g * 16 + i + q) * 2] = s[q]; stat[(g * 16 + i + q) * 2 + 1] = rsqrtf(v[q] * (1.0f / 512.0f) + 1e-6f); }
        }
    }
    __syncthreads();
    {
        const int ch0 = (lane & 7) * 8;
        float lg[8];
#pragma unroll
        for (int j = 0; j < 8; ++j) lg[j] = p.in[I_LNG][g * 64 + ch0 + j];
#pragma unroll 8
        for (int it = 0; it < 16; ++it) {
            const int q = it * 8 + (lane >> 3);
            const h16x8 x = *(const h16x8*)(GUV + (t0 + q) * 1024 + 512 + g * 64 + ch0);
            const float mean = stat[q * 2], rstd = stat[q * 2 + 1];
#pragma unroll
            for (int j = 0; j < 8; ++j) vt[(ch0 + j) * 136 + ((((q >> 3) ^ (lane & 7)) << 3) | (q & 7))] = (h16)(((float)x[j] - mean) * rstd * lg[j]);
        }
    }
    asm volatile("s_waitcnt lgkmcnt(0)" ::: "memory");
    __syncthreads();
    h16x8 af[4][4];
#pragma unroll
    for (int dt = 0; dt < 4; ++dt)
#pragma unroll
        for (int ks = 0; ks < 4; ++ks) af[dt][ks] = *(const LAS h16x8*)(vt + (dt * 16 + l15) * 136 + (((ks * 4 + quad) ^ (dt * 2 + (l15 >> 3))) << 3));
    const h16* wg = WS16 + (size_t)g * 128 * 128;
#pragma unroll 2
    for (int pt = 0; pt < 8; ++pt) {
        f32x4 acc[4];
#pragma unroll
        for (int dt = 0; dt < 4; ++dt) acc[dt] = (f32x4){0.f, 0.f, 0.f, 0.f};
#pragma unroll
        for (int ks = 0; ks < 4; ++ks) {
            const h16x8 bf = *(const h16x8*)(wg + (size_t)(pt * 16 + l15) * 128 + ks * 32 + quad * 8);
#pragma unroll
            for (int dt = 0; dt < 4; ++dt) acc[dt] = __builtin_amdgcn_mfma_f32_16x16x32_f16(af[dt][ks], bf, acc[dt], 0, 0, 0);
        }
        const int pp = pt * 16 + l15;
        const float bsv = p.in[I_GMBS][g * 128 + pp];
        const size_t tok = t0 + pp;
#pragma unroll
        for (int dt = 0; dt < 4; ++dt) {
            const int ch = g * 64 + dt * 16 + quad * 4;
            const h16x4 uu = *(const h16x4*)(GUV + tok * 1024 + ch);
            h16x4 o;
#pragma unroll
            for (int j = 0; j < 4; ++j) o[j] = (h16)((float)uu[j] * (acc[dt][j] + bsv));
            *(h16x4*)(YB + tok * 1024 + ch) = o;
        }
    }
    __syncthreads();
}

__device__ __forceinline__ float row16_sum_to_lane15(float v) {
    v += __builtin_bit_cast(float, __builtin_amdgcn_update_dpp(0, __builtin_bit_cast(int, v), 0x118, 0xf, 0xf, true));
    v += __builtin_bit_cast(float, __builtin_amdgcn_update_dpp(0, __builtin_bit_cast(int, v), 0x114, 0xf, 0xf, true));
    v += __builtin_bit_cast(float, __builtin_amdgcn_update_dpp(0, __builtin_bit_cast(int, v), 0x112, 0xf, 0xf, true));
    v += __builtin_bit_cast(float, __builtin_amdgcn_update_dpp(0, __builtin_bit_cast(int, v), 0x111, 0xf, 0xf, true));
    return v;
}
#define DPPF(v, ctrl) __builtin_bit_cast(float, __builtin_amdgcn_update_dpp(__builtin_bit_cast(int, v), __builtin_bit_cast(int, v), ctrl, 0xf, 0xf, false))
__device__ __forceinline__ float row16_allsum(float v) { v += DPPF(v, 0x128); v += DPPF(v, 0x124); v += DPPF(v, 0x122); v += DPPF(v, 0x121); return v; }
__device__ __forceinline__ float row16_allmax(float v) { v = fmaxf(v, DPPF(v, 0x128)); v = fmaxf(v, DPPF(v, 0x124)); v = fmaxf(v, DPPF(v, 0x122)); v = fmaxf(v, DPPF(v, 0x121)); return v; }
__device__ __forceinline__ int wave_incl_scan(int v) {
    v += __builtin_amdgcn_update_dpp(0, v, 0x111, 0xf, 0xf, false);
    v += __builtin_amdgcn_update_dpp(0, v, 0x112, 0xf, 0xf, false);
    v += __builtin_amdgcn_update_dpp(0, v, 0x114, 0xf, 0xf, false);
    v += __builtin_amdgcn_update_dpp(0, v, 0x118, 0xf, 0xf, false);
    v += __builtin_amdgcn_update_dpp(0, v, 0x142, 0xa, 0xf, false);
    v += __builtin_amdgcn_update_dpp(0, v, 0x143, 0xc, 0xf, false);
    return v;
}
__device__ __forceinline__ unsigned wave_or(unsigned x) {
    int v = (int)x;
    v |= __builtin_amdgcn_update_dpp(0, v, 0x111, 0xf, 0xf, false);
    v |= __builtin_amdgcn_update_dpp(0, v, 0x112, 0xf, 0xf, false);
    v |= __builtin_amdgcn_update_dpp(0, v, 0x114, 0xf, 0xf, false);
    v |= __builtin_amdgcn_update_dpp(0, v, 0x118, 0xf, 0xf, false);
    v |= __builtin_amdgcn_update_dpp(0, v, 0x142, 0xa, 0xf, false);
    v |= __builtin_amdgcn_update_dpp(0, v, 0x143, 0xc, 0xf, false);
    return (unsigned)__builtin_amdgcn_readlane(v, 63);
}
__device__ __forceinline__ unsigned wave_and(unsigned x) {
    int v = (int)x;
    v &= __builtin_amdgcn_update_dpp(-1, v, 0x111, 0xf, 0xf, false);
    v &= __builtin_amdgcn_update_dpp(-1, v, 0x112, 0xf, 0xf, false);
    v &= __builtin_amdgcn_update_dpp(-1, v, 0x114, 0xf, 0xf, false);
    v &= __builtin_amdgcn_update_dpp(-1, v, 0x118, 0xf, 0xf, false);
    v &= __builtin_amdgcn_update_dpp(-1, v, 0x142, 0xa, 0xf, false);
    v &= __builtin_amdgcn_update_dpp(-1, v, 0x143, 0xc, 0xf, false);
    return (unsigned)__builtin_amdgcn_readlane(v, 63);
}
__device__ __forceinline__ unsigned key16(unsigned short u) { return (u & 0x8000u) ? ((~(unsigned)u) & 0xFFFFu) : ((unsigned)u | 0x8000u); }
__device__ __forceinline__ unsigned key32(unsigned u) { return (u & 0x80000000u) ? ~u : (u | 0x80000000u); }
__device__ __forceinline__ float dot8(h16x8 a, h16x8 b, float c) {
    c = __builtin_amdgcn_fdot2((h16x2){a[0], a[1]}, (h16x2){b[0], b[1]}, c, false);
    c = __builtin_amdgcn_fdot2((h16x2){a[2], a[3]}, (h16x2){b[2], b[3]}, c, false);
    c = __builtin_amdgcn_fdot2((h16x2){a[4], a[5]}, (h16x2){b[4], b[5]}, c, false);
    c = __builtin_amdgcn_fdot2((h16x2){a[6], a[7]}, (h16x2){b[6], b[7]}, c, false);
    return c;
}
#define LDS_FENCE() asm volatile("s_waitcnt lgkmcnt(0)" ::: "memory")

__device__ void peer_phase(const Params& p, LAS unsigned char* lds, unsigned* bar, unsigned& epoch) {
    unsigned char* ws = p.ws;
    const int tid = fresh_tid(), wid = __builtin_amdgcn_readfirstlane(tid >> 6), lane = tid & 63;
    const unsigned long long lm = (1ull << lane) - 1ull;
    LAS unsigned char* wl = lds + wid * 11264;
    LAS float* s_top = (LAS float*)(wl);
    LAS int* i_top = (LAS int*)(wl + 1024);
    LAS int* ex = (LAS int*)(wl + 2048);
    LAS float* sc = (LAS float*)(wl + 2560);
    LAS int* uns_m = (LAS int*)(wl + 3072);
    LAS float* uns_g = (LAS float*)(wl + 3584);
    LAS int* cnt = (LAS int*)(wl + 4096);
    LAS int* base = (LAS int*)(wl + 4352);
    const int lead = (wid >= 4) ? 1 : 0;
    const unsigned short* SC = (const unsigned short*)(ws + OFF_SC16);
    const h16* H2 = (const h16*)(ws + OFF_R1);
    const unsigned char* U4 = ws + OFF_U8;
    const unsigned char* V8 = ws + OFF_V8;
    const float* USC = (const float*)(ws + OFF_USC);
    const float* VSC = (const float*)(ws + OFF_VSC);
    const float* mod = (const float*)(ws + OFF_MOD);
    const int grp = lane >> 4, li = lane & 15;
    for (int tg = blockIdx.x; tg < 256; tg += gridDim.x) {
        for (int it5 = 0; it5 < 5; ++it5) {
          if (it5 < 4) {
            const int round = it5;
            const size_t tok0 = (size_t)tg * 128 + wid * 16 + round * 4;
            LAS unsigned short* se = (LAS unsigned short*)(wl + 4608 + (round & 1) * 3072);
            LAS float* sw = (LAS float*)(wl + 4608 + (round & 1) * 3072 + 1024);
            for (int tt = 0; tt < 4; ++tt) {
                const size_t tok = tok0 + tt;
                cnt[lane] = 0;
                for (int L0 = 0; L0 < 16; L0 += 16) {
                    unsigned short ra[16], rb[16]; unsigned ka[16], kb[16], T[16];
#pragma unroll
                    for (int q = 0; q < 16; ++q) {
                        const unsigned short* sr = SC + tok * 2048 + (L0 + q) * 128;
                        ra[q] = sr[lane]; rb[q] = sr[64 + lane];
                        ka[q] = key16(ra[q]); kb[q] = key16(rb[q]); T[q] = 0;
                    }
                    for (int bit = 15; bit >= 0; --bit) {
#pragma unroll
                        for (int q = 0; q < 16; ++q) {
                            const unsigned cand = T[q] | (1u << bit);
                            const int cn = __popcll(__ballot(ka[q] >= cand)) + __popcll(__ballot(kb[q] >= cand));
                            T[q] = (cn >= 16) ? cand : T[q];
                        }
                    }
#pragma unroll
                    for (int q = 0; q < 16; ++q) {
                        const int L = L0 + q;
                        const int cnt_gt = __popcll(__ballot(ka[q] > T[q])) + __popcll(__ballot(kb[q] > T[q]));
                        const int need = 16 - cnt_gt;
                        const unsigned long long ea = __ballot(ka[q] == T[q]), eb = __ballot(kb[q] == T[q]);
                        const int ra_eq = __popcll(ea & lm), rb_eq = __popcll(ea) + __popcll(eb & lm);
                        const bool sa = (ka[q] > T[q]) || (ka[q] == T[q] && ra_eq < need);
                        const bool sb = (kb[q] > T[q]) || (kb[q] == T[q] && rb_eq < need);
                        const unsigned long long ma = __ballot(sa), mb = __ballot(sb);
                        const int pa = __popcll(ma & lm), pb = __popcll(ma) + __popcll(mb & lm);
                        if (sa) { s_top[L * 16 + pa] = (float)__builtin_bit_cast(h16, ra[q]); i_top[L * 16 + pa] = lane; }
                        if (sb) { s_top[L * 16 + pb] = (float)__builtin_bit_cast(h16, rb[q]); i_top[L * 16 + pb] = 64 + lane; }
                    }
                }
                LDS_FENCE();
                for (int h0 = 0; h0 < 8; h0 += 4) {
                    float cv[4][4]; unsigned kk[4][4], T[4];
#pragma unroll
                    for (int q = 0; q < 4; ++q) {
                        const int h = h0 + q;
                        const float bj = s_top[(2 * h + 1) * 16 + li];
#pragma unroll
                        for (int m = 0; m < 4; ++m) { cv[q][m] = s_top[(2 * h) * 16 + grp + 4 * m] + bj; kk[q][m] = key32(__builtin_bit_cast(unsigned, cv[q][m])); }
                        T[q] = 0;
                    }
                    unsigned om = 0, am = 0xFFFFFFFFu;
#pragma unroll
                    for (int q = 0; q < 4; ++q)
#pragma unroll
                        for (int m = 0; m < 4; ++m) { om |= kk[q][m]; am &= kk[q][m]; }
                    om = wave_or(om); am = wave_and(am);
                    om &= ~am;
                    while (om) {
                        const int bit = 31 - __builtin_clz(om);
                        om &= ~(1u << bit);
#pragma unroll
                        for (int q = 0; q < 4; ++q) {
                            const unsigned cand = T[q] | (1u << bit);
                            int cn = 0;
#pragma unroll
                            for (int m = 0; m < 4; ++m) cn += __popcll(__ballot((kk[q][m] & ~am) >= cand));
                            T[q] = (cn >= 16) ? cand : T[q];
                        }
                    }
#pragma unroll
                    for (int q = 0; q < 4; ++q) T[q] |= am;
#pragma unroll
                    for (int q = 0; q < 4; ++q) {
                        const int h = h0 + q;
                        int cnt_gt = 0;
#pragma unroll
                        for (int m = 0; m < 4; ++m) cnt_gt += __popcll(__ballot(kk[q][m] > T[q]));
                        const int need = 16 - cnt_gt;
                        int eq_before = 0, sel_before = 0;
#pragma unroll
                        for (int m = 0; m < 4; ++m) {
                            const unsigned long long em = __ballot(kk[q][m] == T[q]);
                            const int myeq = eq_before + __popcll(em & lm);
                            const bool sel = (kk[q][m] > T[q]) || (kk[q][m] == T[q] && myeq < need);
                            const unsigned long long sm = __ballot(sel);
                            const int pos = sel_before + __popcll(sm & lm);
                            if (sel) {
                                ex[h * 16 + pos] = i_top[(2 * h) * 16 + grp + 4 * m] * 128 + i_top[(2 * h + 1) * 16 + li];
                                sc[h * 16 + pos] = cv[q][m];
                            }
                            eq_before += __popcll(em); sel_before += __popcll(sm);
                        }
                    }
                }
                LDS_FENCE();
#pragma unroll
                for (int half = 0; half < 2; ++half) {
                    const int e = half * 64 + lane;
                    const float v = sc[e];
                    const float mx = row16_allmax(v);
                    const float pe = __expf(v - mx);
                    const float sm = row16_allsum(pe);
                    const float gate = pe * __builtin_amdgcn_rcpf(sm);
                    const int eid = ex[e];
                    const int pos = __hip_atomic_fetch_add(cnt + (eid >> 8), 1, __ATOMIC_RELAXED, __HIP_MEMORY_SCOPE_WORKGROUP);
                    uns_m[e] = eid | (pos << 14); uns_g[e] = gate;
                }
                LDS_FENCE();
                {
                    const int c = cnt[lane];
                    const int incl = wave_incl_scan(c);
                    base[lane] = incl - c;
                    LDS_FENCE();
#pragma unroll
                    for (int i = 0; i < 2; ++i) {
                        const int rm = uns_m[i * 64 + lane]; const float rg = uns_g[i * 64 + lane];
                        const int eid = rm & 16383, pos = rm >> 14;
                        const int dst = tt * 128 + base[eid >> 8] + pos;
                        se[dst] = (unsigned short)eid; sw[dst] = rg;
                    }
                    LDS_FENCE();
                }
            }
          }
          const int round = it5 - lead;
          if (round >= 0 && round < 4) {
            const size_t tok0 = (size_t)tg * 128 + wid * 16 + round * 4;
            LAS unsigned short* se = (LAS unsigned short*)(wl + 4608 + (round & 1) * 3072);
            LAS float* sw = (LAS float*)(wl + 4608 + (round & 1) * 3072 + 1024);
            const size_t tokg = tok0 + grp;
            const LAS unsigned short* me = se + grp * 128; LAS float* mw = sw + grp * 128;
            {
                const int li = launder(tid) & 15;
                h16x8 xr[2][4];
#pragma unroll
                for (int c = 0; c < 2; ++c)
#pragma unroll
                    for (int j = 0; j < 4; ++j) xr[c][j] = *(const h16x8*)(H2 + tokg * 1024 + c * 512 + li * 32 + 8 * j);
                float acc[64];
#pragma unroll
                for (int i = 0; i < 64; ++i) acc[i] = 0.f;
                i32x4 ru[2][2], rv[2][4]; float su[2], sv[2];
#define ELD(J, S_) do { const int e_ = me[(S_)]; const unsigned char* rp_ = U4 + (size_t)e_ * 1536 + li * 16; \
        ru[J][0] = *(const i32x4*)rp_; ru[J][1] = *(const i32x4*)(rp_ + 256); \
        _Pragma("unroll") for (int c = 0; c < 4; ++c) rv[J][c] = *(const i32x4*)(rp_ + 512 + c * 256); \
        { const f32x2 s2_ = *(const f32x2*)(USC + 2 * e_); su[J] = s2_.x; sv[J] = s2_.y; } } while (0)
#define ECP(J, S_) do { float d = 0.f; \
        _Pragma("unroll") for (int c = 0; c < 2; ++c) _Pragma("unroll") for (int k = 0; k < 4; ++k) { const h16x8 xv = xr[c][k]; const int w_ = ru[J][c][k]; \
            d = __builtin_amdgcn_fdot2(__builtin_amdgcn_cvt_scalef32_pk_f16_fp4(w_, 1.0f, 0), (h16x2){xv[0], xv[1]}, d, false); \
            d = __builtin_amdgcn_fdot2(__builtin_amdgcn_cvt_scalef32_pk_f16_fp4(w_, 1.0f, 1), (h16x2){xv[2], xv[3]}, d, false); \
            d = __builtin_amdgcn_fdot2(__builtin_amdgcn_cvt_scalef32_pk_f16_fp4(w_, 1.0f, 2), (h16x2){xv[4], xv[5]}, d, false); \
            d = __builtin_amdgcn_fdot2(__builtin_amdgcn_cvt_scalef32_pk_f16_fp4(w_, 1.0f, 3), (h16x2){xv[6], xv[7]}, d, false); } \
        d = row16_allsum(d); \
        const float wt_ = mw[(S_)] * gelu_tanh(d * su[J]) * sv[J]; \
        _Pragma("unroll") for (int c = 0; c < 4; ++c) _Pragma("unroll") for (int k = 0; k < 4; ++k) { \
            const f32x2 lo = __builtin_amdgcn_cvt_pk_f32_fp8(rv[J][c][k], false), hi = __builtin_amdgcn_cvt_pk_f32_fp8(rv[J][c][k], true); \
            acc[c * 16 + 4 * k] += wt_ * lo.x; acc[c * 16 + 4 * k + 1] += wt_ * lo.y; acc[c * 16 + 4 * k + 2] += wt_ * hi.x; acc[c * 16 + 4 * k + 3] += wt_ * hi.y; } } while (0)
                ELD(0, 0); ELD(1, 1);
#pragma unroll 1
                for (int s = 0; s < 128; s += 2) {
                    ECP(0, s);     if (s + 2 < 128) ELD(0, s + 2);
                    ECP(1, s + 1); if (s + 3 < 128) ELD(1, s + 3);
                }
#undef ELD
#undef ECP
                float* xo = p.out + tokg * 1024 + li * 16;
                const h16* x1h = (const h16*)(ws + OFF_X1H) + tokg * 1024 + li * 16;
                const int b = (int)(tokg >> 11);
                const float* g2 = mod + (size_t)b * 6144 + 5 * 1024 + li * 16;
                const float* fg = p.in[I_FG] + li * 16;
                float ss = 0.f;
#pragma unroll
                for (int c = 0; c < 4; ++c) {
#pragma unroll
                    for (int q4 = 0; q4 < 4; ++q4) {
                        const h16x4 xh_ = *(const h16x4*)(x1h + c * 256 + q4 * 4);
                        const f32x4 xv = (f32x4){(float)xh_[0], (float)xh_[1], (float)xh_[2], (float)xh_[3]}, gv = *(const f32x4*)(g2 + c * 256 + q4 * 4);
#pragma unroll
                        for (int j = 0; j < 4; ++j) { const float t = xv[j] + gv[j] * acc[c * 16 + q4 * 4 + j]; acc[c * 16 + q4 * 4 + j] = t; ss += t * t; }
                    }
                    asm volatile("" : "+v"(ss) :: "memory");
                }
                ss = row16_allsum(ss);
                const float r = rsqrtf(ss * (1.0f / 1024.0f) + 1e-6f);
#pragma unroll
                for (int c = 0; c < 4; ++c) {
#pragma unroll
                    for (int q4 = 0; q4 < 4; ++q4) {
                        const f32x4 fv = *(const f32x4*)(fg + c * 256 + q4 * 4);
                        f32x4 ov;
#pragma unroll
                        for (int j = 0; j < 4; ++j) ov[j] = acc[c * 16 + q4 * 4 + j] * r * fv[j];
                        *(f32x4*)(xo + c * 256 + q4 * 4) = ov;
                    }
                    asm volatile("" ::: "memory");
                }
            }
            LDS_FENCE();
          }
        }
    }
}

__global__ void __launch_bounds__(512, 2) mega(Params p) {
    extern __shared__ __attribute__((aligned(16))) unsigned char shm[];
    LAS unsigned char* lds = (LAS unsigned char*)shm;
    cg::grid_group grid = cg::this_grid();
    unsigned char* ws = p.ws;
    const int G = (int)gridDim.x, c = (int)blockIdx.x;
    unsigned* bar = (unsigned*)(ws + OFF_BAR); unsigned epoch = 0;
    volatile LAS unsigned* xst = (volatile LAS unsigned*)(lds + (LDS_BYTES - 16));
    if (threadIdx.x < 2) xst[threadIdx.x] = 0u;
    __syncthreads();
    const XcdBarrier xb = xcd_barrier_post(bar, xst);

    if (p.ws == nullptr) grid.sync();
    phase0(p, (float*)shm);
    xcd_barrier(xb);
    phase1(p, (float*)shm);
    xcd_barrier(xb);
    {
        pg8::StaticOrder S; S.init(NTOK, INC, G, c);
        pg8::Gemm g{ws + OFF_R1, ws + OFF_WINT, 1024, 1024, NTOK, INC, 1024, 0};
        EpiIn E{(h16*)(ws + OFF_QB), (h16*)(ws + OFF_KB), (h16*)(ws + OFF_VT), (h16*)(ws + OFF_GUV), (h16*)(ws + OFF_GATES)};
        pg8::gemm_phase(lds, g, S, E);
        pg8::StaticOrder S2; S2.init(NCTXT, 1024, G, c);
        pg8::Gemm g2{ws + OFF_HC, ws + OFF_WINT + (size_t)512 * 1024 * 2, 1024, 1024, NCTXT, 1024, 1024, 0};
        EpiCtx E2{(h16*)(ws + OFF_KC), (h16*)(ws + OFF_VCT)};
        pg8::gemm_phase(lds, g2, S2, E2);
    }
    xcd_barrier(xb);
    {
        for (int rep3 = 0; rep3 < REP_P3; ++rep3) {
        if (G == 256) {
            const int x = c & 7, k = c >> 3;
            attn_unit(p, x * 64 + k * 2); attn_unit(p, x * 64 + k * 2 + 1);
        } else
        for (int u = c; u < 512; u += G) attn_unit(p, u);
        for (int n = c; n < 256; n += G) sgu_unit(p, n, lds);
        }
    }
    xcd_barrier(xb);
    {
        pg8::StaticOrder S; S.init(NTOK, 1024, G, c);
        pg8::Gemm ga{ws + OFF_R1, ws + OFF_WPAT, 1024, 512, NTOK, 1024, 512, 0};
        EpiM1 E1{(h16*)(ws + OFF_M1), (const h16*)(ws + OFF_GATES)};
        pg8::gemm_phase(lds, ga, S, E1);
        pg8::Gemm gb{ws + OFF_R1 + 1024, ws + OFF_WPBT, 1024, 512, NTOK, 1024, 512, 0};
        EpiM2 E2{(const h16*)(ws + OFF_M1), (const h16*)(ws + OFF_GATES), (h16*)(ws + OFF_MM)};
        pg8::gemm_phase(lds, gb, S, E2);
    }
    xcd_barrier(xb);
    {
        pg8::StaticOrder S; S.init(NTOK, 1024, G, c);
        pg8::Gemm g{ws + OFF_MM, ws + OFF_WOUTT, 1024, 1024, NTOK, 1024, 1024, 0};
        EpiX1 E{p.in[I_X], (const float*)(ws + OFF_MOD), (h16*)(ws + OFF_X1H)};
        pg8::gemm_phase(lds, g, S, E);
    }
    xcd_barrier(xb);
    phase6(p, (float*)shm);
    xcd_barrier(xb);
    {
        pg8::StaticOrder S; S.init(NTOK, 2048, G, c);
        pg8::Gemm g{ws + OFF_R1, ws + OFF_WQT, 1024, 1024, NTOK, 2048, 1024, 0};
        EpiH16 E{(h16*)(ws + OFF_SC16), 2048};
        pg8::gemm_phase(lds, g, S, E);
    }
    xcd_barrier(xb);
    peer_phase(p, lds, bar, epoch);
}

extern "C" void kernel_launch(void* const* d_in, const int* in_sizes, int n_in, void* d_out, int out_size, void* d_ws, size_t ws_size, hipStream_t stream) {
    static int grid_blocks = 0;
    if (!grid_blocks) {
        int dev = 0, cus = 0, per_cu = 0;
        hipGetDevice(&dev);
        hipDeviceGetAttribute(&cus, hipDeviceAttributeMultiprocessorCount, dev);
        hipFuncSetAttribute((const void*)mega, hipFuncAttributeMaxDynamicSharedMemorySize, LDS_BYTES);
        hipOccupancyMaxActiveBlocksPerMultiprocessor(&per_cu, (const void*)mega, 512, LDS_BYTES);
        if (per_cu < 1) per_cu = 1;
        grid_blocks = cus * per_cu;
        if (ws_size < WS_END) fprintf(stderr, "kernel_launch: workspace too small: %zu < %zu\n", ws_size, (size_t)WS_END);
    }
    hipMemsetAsync((unsigned char*)d_ws + OFF_BAR, 0, 16384, stream);
    Params p{};
    for (int i = 0; i < 21; ++i) p.in[i] = (const float*)d_in[i];
    p.out = (float*)d_out; p.ws = (unsigned char*)d_ws;
    void* args[] = {&p};
    hipError_t e = hipLaunchCooperativeKernel((const void*)mega, dim3(grid_blocks), dim3(512), args, LDS_BYTES, stream);
    if (e != hipSuccess) fprintf(stderr, "cooperative launch failed: %s (grid %d)\n", hipGetErrorString(e), grid_blocks);
}
```
